# Optimizing an MI355X kernel written in HIP

```python
import math
import numpy as np
import jax, jax.numpy as jnp
from jax import lax

D_MODEL = 1024
BATCH = 16
SEQ = 256
DEPTH = 2
DEC_BATCH = 2
DEC_SEQ = 1024
PAST_LEN = 512

GRID_W = 64
Q_BLOCK = 128
EPS = 1e-6
ROPE_BASE = 10000.0

MLA_HEADS = 8
MLA_Q_RANK = 256
MLA_KV_RANK = 128
MLA_NOPE = 64
MLA_ROPE = 32
MLA_V = 64
MLA_QK = MLA_NOPE + MLA_ROPE
RET_HEADS = 4
RET_DK = 64
RET_DV = 128
RET_CHUNK = 64
DIFF_HEADS = 4
DIFF_DH = 64
DIFF_W = DIFF_HEADS * 2 * DIFF_DH
RWKV_HEADS = 8
RWKV_HS = 64
RWKV_W = RWKV_HEADS * RWKV_HS
RWKV_W_LORA = 64
RWKV_A_LORA = 64
RWKV_G_LORA = 128
D_FF = 2816

EVEN_SIZES = (MLA_Q_RANK, MLA_KV_RANK, MLA_ROPE, RET_HEADS * RET_DK, RET_HEADS * RET_DK, RET_HEADS * RET_DV, RET_HEADS * RET_DV)
EVEN_IN = sum(EVEN_SIZES)
RWKV_SIZES = (RWKV_W, RWKV_W, RWKV_W, RWKV_W_LORA, RWKV_W_LORA, RWKV_A_LORA, RWKV_A_LORA, RWKV_G_LORA)
RWKV_IN = sum(RWKV_SIZES)
ODD_SIZES = (DIFF_W, DIFF_W, DIFF_W, RWKV_IN)
ODD_IN = sum(ODD_SIZES)

kernel_name = 'hybrid_diffusion_prefix_trunk_step'


def rms_norm(x, g):
    xf = x.astype(jnp.float32)
    y = xf * lax.rsqrt(jnp.mean(jnp.square(xf), axis=-1, keepdims=True) + EPS)
    return (y * g.astype(jnp.float32)).astype(x.dtype)


def split_cols(x, sizes):
    idx = np.cumsum(sizes)[:-1].tolist()
    return jnp.split(x, idx, axis=-1)


def modulation(cond, ada_w, ada_b):
    m = (jax.nn.silu(cond) @ ada_w + ada_b)[:, None, :]
    return jnp.split(m, 6, axis=-1)


def axial_rope(row, col, rot_dim):
    n_freq = rot_dim // 4
    inv = ROPE_BASE ** (-jnp.arange(n_freq, dtype=jnp.float32) / n_freq)
    ang = jnp.concatenate([row.astype(jnp.float32)[:, None] * inv, col.astype(jnp.float32)[:, None] * inv], -1)
    return jnp.cos(ang), jnp.sin(ang)


def apply_rope(x, cos, sin):
    shape = (x.shape[1],) + (1,) * (x.ndim - 3) + (cos.shape[-1],)
    cos, sin = cos.reshape(shape), sin.reshape(shape)
    xf = x.astype(jnp.float32)
    x1, x2 = xf[..., 0::2], xf[..., 1::2]
    out = jnp.stack([x1 * cos - x2 * sin, x1 * sin + x2 * cos], -1).reshape(x.shape)
    return out.astype(x.dtype)


def rope_tail(x, cos, sin):
    r = 2 * cos.shape[-1]
    return jnp.concatenate([x[..., :-r], apply_rope(x[..., -r:], cos, sin)], -1)


def centred_neighbours(x):
    xp = jnp.pad(x, ((0, 0), (1, 1), (0, 0)))
    return 0.5 * (xp[:, :-2] + xp[:, 2:])


def dwconv3(x, w, b):
    xp = jnp.pad(x, ((0, 0), (1, 1), (0, 0)))
    return xp[:, :-2] * w[0] + x * w[1] + xp[:, 2:] * w[2] + b


def attend_blocks(q, k, v):
    b, nq, h, dq = q.shape
    nb = nq // Q_BLOCK
    scale = dq ** -0.5
    qb = jnp.moveaxis(q.reshape(b, nb, Q_BLOCK, h, dq), 1, 0)

    def one_block(qi):
        s = jnp.einsum('bqhd,bkhd->bhqk', qi, k).astype(jnp.float32) * scale
        p = jax.nn.softmax(s, axis=-1).astype(v.dtype)
        return jnp.einsum('bhqk,bkhe->bqhe', p, v)

    o = lax.map(one_block, qb)
    return jnp.moveaxis(o, 0, 1).reshape(b, nq, h, v.shape[-1])


def diff_attend_blocks(q, k, v, lam):
    b, nq, h, _, d = q.shape
    nb = nq // Q_BLOCK
    scale = d ** -0.5
    qb = jnp.moveaxis(q.reshape(b, nb, Q_BLOCK, h, 2, d), 1, 0)

    def one_block(qi):
        s = jnp.einsum('bqhcd,bkhcd->bchqk', qi, k).astype(jnp.float32) * scale
        p = jax.nn.softmax(s, axis=-1)
        w = (p[:, 0] - lam * p[:, 1]).astype(v.dtype)
        return jnp.einsum('bhqk,bkhe->bqhe', w, v)

    o = lax.map(one_block, qb)
    return jnp.moveaxis(o, 0, 1).reshape(b, nq, h, v.shape[-1])


def retention_chunks(q, k, v, log_g, s0):
    b, n, h, _ = q.shape
    dv = v.shape[-1]
    nc = n // RET_CHUNK

    def chunks(t):
        return jnp.moveaxis(t.astype(jnp.float32).reshape(b, nc, RET_CHUNK, h, t.shape[-1]), 1, 0)

    pos = jnp.arange(RET_CHUNK, dtype=jnp.float32)
    diff = pos[:, None] - pos[None, :]
    intra = jnp.where(diff >= 0, jnp.exp(log_g[:, None, None] * jnp.maximum(diff, 0.0)), 0.0)
    q_dec = jnp.exp(log_g[None, :] * (pos[:, None] + 1.0))
    k_dec = jnp.exp(log_g[None, :] * (RET_CHUNK - 1.0 - pos[:, None]))
    c_dec = jnp.exp(log_g * RET_CHUNK)

    def step(state, inp):
        qc, kc, vc = inp
        scores = jnp.einsum('bihd,bjhd->bhij', qc, kc) * intra
        o = jnp.einsum('bhij,bjhe->bihe', scores, vc) + jnp.einsum('bihd,bhde->bihe', qc * q_dec[:, :, None], state)
        state = state * c_dec[:, None, None] + jnp.einsum('bjhd,bjhe->bhde', kc * k_dec[:, :, None], vc)
        return state, o

    state, o = lax.scan(step, s0.astype(jnp.float32), (chunks(q), chunks(k), chunks(v)))
    return jnp.moveaxis(o, 0, 1).reshape(b, n, h, dv), state


def retention_bidir(q, k, v, decay_logit, s0f, s0b):
    log_g = -jax.nn.softplus(-decay_logit.astype(jnp.float32))
    o_f, s_f = retention_chunks(q, k, v, log_g[0], s0f)
    o_b, s_b = retention_chunks(q[:, ::-1], k[:, ::-1], v[:, ::-1], log_g[1], s0b)
    return o_f + o_b[:, ::-1], s_f, s_b


def rwkv7_scan(r, decay, k, v, kk, a, s0):
    def step(state, inp):
        r_t, w_t, k_t, v_t, kk_t, a_t = inp
        sa = jnp.einsum('bhvk,bhk->bhv', state, kk_t)
        state = (state * w_t[:, :, None, :] - sa[..., None] * (kk_t * a_t)[:, :, None, :]
                 + v_t[..., None] * k_t[:, :, None, :])
        return state, jnp.einsum('bhvk,bhk->bhv', state, r_t)

    xs = tuple(jnp.moveaxis(t, 1, 0) for t in (r, decay, k, v, kk, a))
    state, y = lax.scan(step, s0.astype(jnp.float32), xs)
    return jnp.moveaxis(y, 0, 1), state


def rwkv_inputs(p, mu, w0, w_up, a0, a_up, g_up, k_k, k_a):
    b, n, _ = p.shape
    p = p + (centred_neighbours(p) - p) * mu
    r, k, v, wdf, wdb, adf, adb, gd = split_cols(p, RWKV_SIZES)
    hs = (b, n, RWKV_HEADS, RWKV_HS)
    r, k, v = (t.astype(jnp.float32).reshape(hs) for t in (r, k, v))
    kk = k * k_k.reshape(RWKV_HEADS, RWKV_HS)
    kk = kk * lax.rsqrt(jnp.sum(kk * kk, axis=-1, keepdims=True) + EPS)
    g = jax.nn.sigmoid(gd) @ g_up
    dirs = []
    for d, (wd, ad) in enumerate(((wdf, adf), (wdb, adb))):
        pre = (w0[d] + jnp.tanh(wd) @ w_up[d]).astype(jnp.float32)
        decay = jnp.exp(-jnp.exp(-jax.nn.softplus(-pre) - 0.5)).reshape(hs)
        a = jax.nn.sigmoid((a0[d] + ad @ a_up[d]).astype(jnp.float32)).reshape(hs)
        k_d = k * (1.0 + (a - 1.0) * k_a.reshape(RWKV_HEADS, RWKV_HS))
        dirs.append((decay, a, k_d))
    return r, v, kk, g, dirs


def rwkv_mix(rw, s0f, s0b, r_k, gn):
    r, v, kk, g, dirs = rw
    (w_f, a_f, k_f), (w_b, a_b, k_b) = dirs
    b, n = r.shape[:2]
    y_f, s_f = rwkv7_scan(r, w_f, k_f, v, kk, a_f, s0f)
    y_b, s_b = rwkv7_scan(r[:, ::-1], w_b[:, ::-1], k_b[:, ::-1], v[:, ::-1], kk[:, ::-1], a_b[:, ::-1], s0b)
    y = rms_norm(y_f + y_b[:, ::-1], gn.reshape(RWKV_HEADS, RWKV_HS))
    bonus = (jnp.sum(r * k_f * r_k, -1, keepdims=True) + jnp.sum(r * k_b * r_k, -1, keepdims=True)) * v
    return (y + bonus).reshape(b, n, RWKV_W) * g, s_f, s_b


def mla_keys_values(ckv, krope, w_ukv, kn):
    b, n, _ = ckv.shape
    kv = (ckv @ w_ukv).reshape(b, n, MLA_HEADS, MLA_NOPE + MLA_V)
    k_nope, v = kv[..., :MLA_NOPE], kv[..., MLA_NOPE:]
    k_rope = jnp.broadcast_to(krope[:, :, None, :], (b, n, MLA_HEADS, MLA_ROPE))
    return rms_norm(jnp.concatenate([k_nope, k_rope], -1), kn), v


def even_inputs(h, pe):
    w_in, q_norm, kv_norm, w_uq, w_ukv, qn, kn = pe[:7]
    b, n, _ = h.shape
    cq, ckv, krope, rq, rk, rv, rg = split_cols(h @ w_in, EVEN_SIZES)
    q = rms_norm((rms_norm(cq, q_norm) @ w_uq).reshape(b, n, MLA_HEADS, MLA_QK), qn)
    ckv = rms_norm(ckv, kv_norm)
    k, v = mla_keys_values(ckv, krope, w_ukv, kn)
    rq = rq.reshape(b, n, RET_HEADS, RET_DK)
    rk = rk.reshape(b, n, RET_HEADS, RET_DK) * (RET_DK ** -0.5)
    rv = rv.reshape(b, n, RET_HEADS, RET_DV)
    return q, k, v, ckv, krope, rq, rk, rv, rg


def even_output(mla_o, ret_o, rg, ret_gn, dtype):
    b, n = mla_o.shape[:2]
    ret = jax.nn.silu(rg) * rms_norm(ret_o, ret_gn.reshape(RET_HEADS, RET_DV)).reshape(b, n, -1)
    return jnp.concatenate([mla_o.reshape(b, n, -1).astype(dtype), ret.astype(dtype)], -1)


def even_context(h, pe):
    q, k, v, ckv, krope, rq, rk, rv, rg = even_inputs(h, pe)
    mla_o = attend_blocks(q, k, v)
    s0 = jnp.zeros((h.shape[0], RET_HEADS, RET_DK, RET_DV), jnp.float32)
    ret_o, s_f, s_b = retention_bidir(rq, rk, rv, pe[7], s0, s0)
    out = even_output(mla_o, ret_o, rg, pe[8], h.dtype)
    return out, ckv, krope, jnp.stack([s_f, s_b], 1).astype(h.dtype)


def even_latent(h, ckv_c, krope_c, st, pe, cos, sin):
    q, k, v, _, _, rq, rk, rv, rg = even_inputs(h, pe)
    q, k = rope_tail(q, cos, sin), rope_tail(k, cos, sin)
    k_c, v_c = mla_keys_values(ckv_c, krope_c, pe[4], pe[6])
    mla_o = attend_blocks(q, jnp.concatenate([k, k_c], 1), jnp.concatenate([v, v_c], 1))
    ret_o, _, _ = retention_bidir(rq, rk, rv, pe[7], st[:, 0], st[:, 1])
    return even_output(mla_o, ret_o, rg, pe[8], h.dtype)


def odd_inputs(h, po):
    w_in, qn, kn = po[:3]
    b, n, _ = h.shape
    dq, dk, dv, p = split_cols(h @ w_in, ODD_SIZES)
    q = rms_norm(dq.reshape(b, n, DIFF_HEADS, 2, DIFF_DH), qn)
    k = rms_norm(dk.reshape(b, n, DIFF_HEADS, 2, DIFF_DH), kn)
    v = dv.reshape(b, n, DIFF_HEADS, 2 * DIFF_DH)
    rw = rwkv_inputs(p, *po[5:13])
    return q, k, v, rw


def diff_lambda(lam_vec, lam_init):
    lv = lam_vec.astype(jnp.float32)
    return jnp.exp(jnp.sum(lv[0] * lv[1])) - jnp.exp(jnp.sum(lv[2] * lv[3])) + lam_init


def odd_output(diff_o, rw_o, diff_gn, lam_init, dtype):
    b, n = diff_o.shape[:2]
    d = rms_norm(diff_o, diff_gn.reshape(DIFF_HEADS, 2 * DIFF_DH)) * (1.0 - lam_init)
    return jnp.concatenate([d.reshape(b, n, -1).astype(dtype), rw_o.astype(dtype)], -1)


def odd_context(h, po, lam_init):
    q, k, v, rw = odd_inputs(h, po)
    diff_o = diff_attend_blocks(q, k, v, diff_lambda(po[3], lam_init))
    s0 = jnp.zeros((h.shape[0], RWKV_HEADS, RWKV_HS, RWKV_HS), jnp.float32)
    rw_o, s_f, s_b = rwkv_mix(rw, s0, s0, po[13], po[14])
    out = odd_output(diff_o, rw_o, po[4], lam_init, h.dtype)
    return out, k, v, jnp.stack([s_f, s_b], 1).astype(h.dtype)


def odd_latent(h, k_c, v_c, st, po, lam_init, cos, sin):
    q, k, v, rw = odd_inputs(h, po)
    q, k = apply_rope(q, cos, sin), apply_rope(k, cos, sin)
    diff_o = diff_attend_blocks(q, jnp.concatenate([k, k_c], 1), jnp.concatenate([v, v_c], 1),
                                diff_lambda(po[3], lam_init))
    rw_o, _, _ = rwkv_mix(rw, st[:, 0], st[:, 1], po[13], po[14])
    return odd_output(diff_o, rw_o, po[4], lam_init, h.dtype)


def conv_ffn(h, up, cw, cb, down):
    u = dwconv3(h @ up, cw, cb)
    a, b = jnp.split(u, 2, axis=-1)
    return (jax.nn.silu(a) * b) @ down


def setup_inputs(seed: int = 0) -> dict:
    key = jax.random.key(seed)
    kit = iter(jax.random.split(key, 64))

    def nrm(shape, s=1.0):
        return s * jax.random.normal(next(kit), shape, jnp.float32)

    def gain(shape):
        return 1.0 + 0.02 * jax.random.normal(next(kit), shape, jnp.float32)

    ne, no = (DEPTH + 1) // 2, DEPTH // 2
    d = D_MODEL
    eps = 2.0 ** (-5.0 - jnp.arange(RET_HEADS, dtype=jnp.float32))
    ret_base = jnp.log((1.0 - eps) / eps)
    conv_centre = jnp.zeros((3, 1), jnp.float32).at[1].set(1.0)
    return {
        'x_prompt': nrm((BATCH, SEQ, d)),
        'x_sample': nrm((DEC_BATCH, DEC_SEQ, d)),
        'cache_mla_ckv': nrm((DEC_BATCH, ne, PAST_LEN, MLA_KV_RANK)),
        'cache_mla_krope': nrm((DEC_BATCH, ne, PAST_LEN, MLA_ROPE)),
        'state_ret': nrm((DEC_BATCH, ne, 2, RET_HEADS, RET_DK, RET_DV)),
        'cache_diff_k': nrm((DEC_BATCH, no, PAST_LEN, DIFF_HEADS, 2, DIFF_DH)),
        'cache_diff_v': nrm((DEC_BATCH, no, PAST_LEN, DIFF_HEADS, 2 * DIFF_DH)),
        'state_rwkv': nrm((DEC_BATCH, no, 2, RWKV_HEADS, RWKV_HS, RWKV_HS), 0.3),
        'c': nrm((DEC_BATCH, d)),
        'c_ctx': nrm((d,)),
        'ada_w': nrm((DEPTH, d, 6 * d), 0.5 * d ** -0.5),
        'ada_b': nrm((DEPTH, 6 * d), 0.01),
        'norm_mix_g': gain((DEPTH, d)),
        'norm_ffn_g': gain((DEPTH, d)),
        'w_out': nrm((DEPTH, d, d), d ** -0.5),
        'ffn_up': nrm((DEPTH, d, 2 * D_FF), d ** -0.5),
        'ffn_conv_w': conv_centre + nrm((DEPTH, 3, 2 * D_FF), 0.3),
        'ffn_conv_b': nrm((DEPTH, 2 * D_FF), 0.01),
        'ffn_down': nrm((DEPTH, D_FF, d), D_FF ** -0.5),
        'a_w_in': nrm((ne, d, EVEN_IN), d ** -0.5),
        'mla_q_norm': gain((ne, MLA_Q_RANK)),
        'mla_kv_norm': gain((ne, MLA_KV_RANK)),
        'mla_w_uq': nrm((ne, MLA_Q_RANK, MLA_HEADS * MLA_QK), MLA_Q_RANK ** -0.5),
        'mla_w_ukv': nrm((ne, MLA_KV_RANK, MLA_HEADS * (MLA_NOPE + MLA_V)), MLA_KV_RANK ** -0.5),
        'mla_qn': gain((ne, MLA_QK)),
        'mla_kn': gain((ne, MLA_QK)),
        'ret_decay': ret_base + nrm((ne, 2, RET_HEADS), 0.1),
        'ret_gn': gain((ne, RET_HEADS * RET_DV)),
        'b_w_in': nrm((no, d, ODD_IN), d ** -0.5),
        'diff_qn': gain((no, DIFF_DH)),
        'diff_kn': gain((no, DIFF_DH)),
        'diff_lam': nrm((no, 4, DIFF_DH), 0.1),
        'diff_gn': gain((no, DIFF_W)),
        'rwkv_mu': jax.random.uniform(next(kit), (no, RWKV_IN), jnp.float32),
        'rwkv_w0': -2.0 + nrm((no, 2, RWKV_W)),
        'rwkv_w_up': nrm((no, 2, RWKV_W_LORA, RWKV_W), 0.5 * RWKV_W_LORA ** -0.5),
        'rwkv_a0': nrm((no, 2, RWKV_W), 0.5),
        'rwkv_a_up': nrm((no, 2, RWKV_A_LORA, RWKV_W), RWKV_A_LORA ** -0.5),
        'rwkv_g_up': nrm((no, RWKV_G_LORA, RWKV_W), RWKV_G_LORA ** -0.5),
        'rwkv_k_k': 0.85 + nrm((no, RWKV_W), 0.05),
        'rwkv_k_a': gain((no, RWKV_W)),
        'rwkv_r_k': nrm((no, RWKV_HEADS, RWKV_HS), 0.1),
        'rwkv_gn': gain((no, RWKV_W)),
    }


def reference(x_prompt, x_sample, cache_mla_ckv, cache_mla_krope, state_ret, cache_diff_k, cache_diff_v, state_rwkv,
              c, c_ctx, ada_w, ada_b, norm_mix_g, norm_ffn_g, w_out, ffn_up, ffn_conv_w, ffn_conv_b, ffn_down,
              a_w_in, mla_q_norm, mla_kv_norm, mla_w_uq, mla_w_ukv, mla_qn, mla_kn, ret_decay, ret_gn,
              b_w_in, diff_qn, diff_kn, diff_lam, diff_gn, rwkv_mu, rwkv_w0, rwkv_w_up, rwkv_a0, rwkv_a_up,
              rwkv_g_up, rwkv_k_k, rwkv_k_a, rwkv_r_k, rwkv_gn):
    n_lat = x_sample.shape[1]
    rows = n_lat // GRID_W
    t = jnp.arange(rows * GRID_W)
    row, col = t // GRID_W, t % GRID_W
    cos_m, sin_m = axial_rope(row, col, MLA_ROPE)
    cos_d, sin_d = axial_rope(row, col, DIFF_DH)
    cond_ctx = c_ctx[None, :]
    xc, xl = x_prompt, x_sample
    new_ckv, new_krope, new_ret, new_dk, new_dv, new_rwkv = [], [], [], [], [], []
    for l in range(DEPTH):
        sh_c, sc_c, ga_c, shf_c, scf_c, gf_c = modulation(cond_ctx, ada_w[l], ada_b[l])
        sh_l, sc_l, ga_l, shf_l, scf_l, gf_l = modulation(c, ada_w[l], ada_b[l])
        hc = rms_norm(xc, norm_mix_g[l]) * (1.0 + sc_c) + sh_c
        hl = rms_norm(xl, norm_mix_g[l]) * (1.0 + sc_l) + sh_l
        j = l // 2
        if l % 2 == 0:
            pe = (a_w_in[j], mla_q_norm[j], mla_kv_norm[j], mla_w_uq[j], mla_w_ukv[j], mla_qn[j], mla_kn[j],
                  ret_decay[j], ret_gn[j])
            oc, ckv, krope, st = even_context(hc, pe)
            ol = even_latent(hl, cache_mla_ckv[:, j], cache_mla_krope[:, j], state_ret[:, j], pe, cos_m, sin_m)
            new_ckv.append(ckv)
            new_krope.append(krope)
            new_ret.append(st)
        else:
            lam_init = 0.8 - 0.6 * math.exp(-0.3 * l)
            po = (b_w_in[j], diff_qn[j], diff_kn[j], diff_lam[j], diff_gn[j], rwkv_mu[j], rwkv_w0[j], rwkv_w_up[j],
                  rwkv_a0[j], rwkv_a_up[j], rwkv_g_up[j], rwkv_k_k[j], rwkv_k_a[j], rwkv_r_k[j], rwkv_gn[j])
            oc, k_new, v_new, st = odd_context(hc, po, lam_init)
            ol = odd_latent(hl, cache_diff_k[:, j], cache_diff_v[:, j], state_rwkv[:, j], po, lam_init, cos_d, sin_d)
            new_dk.append(k_new)
            new_dv.append(v_new)
            new_rwkv.append(st)
        xc = xc + ga_c * (oc @ w_out[l])
        xl = xl + ga_l * (ol @ w_out[l])
        hc = rms_norm(xc, norm_ffn_g[l]) * (1.0 + scf_c) + shf_c
        hl = rms_norm(xl, norm_ffn_g[l]) * (1.0 + scf_l) + shf_l
        xc = xc + gf_c * conv_ffn(hc, ffn_up[l], ffn_conv_w[l], ffn_conv_b[l], ffn_down[l])
        xl = xl + gf_l * conv_ffn(hl, ffn_up[l], ffn_conv_w[l], ffn_conv_b[l], ffn_down[l])
    return (xc, xl, jnp.stack(new_ckv, 1), jnp.stack(new_krope, 1), jnp.stack(new_ret, 1),
            jnp.stack(new_dk, 1), jnp.stack(new_dv, 1), jnp.stack(new_rwkv, 1))
```

```cpp
#include <hip/hip_runtime.h>
#include <cstdio>
#include <cstdint>

#define LAS __attribute__((address_space(3)))
typedef unsigned short bf16_t;
typedef short bf16x8 __attribute__((ext_vector_type(8)));
typedef short bf16x4 __attribute__((ext_vector_type(4)));
typedef float f32x4 __attribute__((ext_vector_type(4)));
typedef float f32x2 __attribute__((ext_vector_type(2)));
typedef unsigned u32x2 __attribute__((ext_vector_type(2)));
typedef unsigned u32x4 __attribute__((ext_vector_type(4)));

#ifndef ONE_LAUNCH
#define ONE_LAUNCH 0
#endif

constexpr int NTHREADS = 512;
constexpr int LDS_BYTES = 144 * 1024;
constexpr int LDS_WORK = 1024;
constexpr int DM = 1024, NCTX = 4096, NLAT = 2048, NTOK = 6144, NKROW = 7168, DFF = 2816;
constexpr float EPS = 1e-6f;

constexpr size_t al256(size_t x) { return (x + 255) & ~(size_t)255; }
constexpr size_t WS_BAR = 0;
constexpr size_t WS_MOD = WS_BAR + 16384;
constexpr size_t WS_WAIN = al256(WS_MOD + 2 * 3 * 6144 * 4);
constexpr size_t WS_WUQ = WS_WAIN + (size_t)2048 * 1024 * 2;
constexpr size_t WS_WUKV = WS_WUQ + (size_t)768 * 256 * 2;
constexpr size_t WS_WOUT = WS_WUKV + (size_t)1024 * 128 * 2;
constexpr size_t WS_WUP = WS_WOUT + (size_t)2 * 1024 * 1024 * 2;
constexpr size_t WS_WDN = WS_WUP + (size_t)2 * 5632 * 1024 * 2;
constexpr size_t WS_WBIN = WS_WDN + (size_t)2 * 1024 * 2816 * 2;
constexpr size_t WS_WWUP = WS_WBIN + (size_t)3584 * 1024 * 2;
constexpr size_t WS_WAUP = WS_WWUP + (size_t)2 * 512 * 64 * 2;
constexpr size_t WS_WGUP = WS_WAUP + (size_t)2 * 512 * 64 * 2;
constexpr size_t WS_HB = WS_WGUP + (size_t)512 * 128 * 2;
constexpr size_t WS_OB = WS_HB + (size_t)NTOK * 1024 * 2;
constexpr size_t WS_BIG = WS_OB + (size_t)NTOK * 1024 * 2;
constexpr size_t WS_P0 = WS_BIG;
constexpr size_t WS_CQN = WS_P0 + (size_t)NTOK * 2048 * 4;
constexpr size_t WS_CKVN = WS_CQN + (size_t)NTOK * 256 * 2;
constexpr size_t WS_QRAW = WS_CKVN + (size_t)NKROW * 128 * 2;
constexpr size_t WS_KVRAW = WS_QRAW + (size_t)NTOK * 768 * 4;
constexpr size_t WS_Q0 = WS_KVRAW + (size_t)NKROW * 1024 * 4;
constexpr size_t WS_K0 = WS_Q0 + (size_t)NTOK * 768 * 2;
constexpr size_t WS_VT0 = WS_K0 + (size_t)NKROW * 768 * 2;
constexpr size_t WS_KVS = WS_VT0 + (size_t)NKROW * 512 * 2;
constexpr size_t WS_L0END = WS_KVS + (size_t)384 * 2 * 8192 * 4;
constexpr size_t WS_U = WS_BIG;
constexpr size_t WS_ACT = WS_U + (size_t)NTOK * 5632 * 2;
constexpr size_t WS_FFNEND = WS_ACT + (size_t)NTOK * 2816 * 2;
constexpr size_t WS_P1 = WS_BIG;
constexpr size_t WS_DEC = WS_BIG;
constexpr size_t WS_AA = WS_DEC + (size_t)2 * NTOK * 512 * 4;
constexpr size_t WS_GG = WS_AA + (size_t)2 * NTOK * 512 * 4;
constexpr size_t WS_YY = WS_GG + (size_t)NTOK * 512 * 4;
constexpr size_t WS_QD = WS_P1 + (size_t)NTOK * 3584 * 4;
constexpr size_t WS_KD = WS_QD + (size_t)NTOK * 512 * 2;
constexpr size_t WS_VDT = WS_KD + (size_t)NKROW * 512 * 2;
constexpr size_t WS_RR = WS_VDT + (size_t)NKROW * 512 * 2;
constexpr size_t WS_KR = WS_RR + (size_t)NTOK * 512 * 4;
constexpr size_t WS_VV = WS_KR + (size_t)NTOK * 512 * 4;
constexpr size_t WS_KK = WS_VV + (size_t)NTOK * 512 * 4;
constexpr size_t WS_TW = WS_KK + (size_t)NTOK * 512 * 4;
constexpr size_t WS_AD = WS_TW + (size_t)NTOK * 128 * 2;
constexpr size_t WS_SG = WS_AD + (size_t)NTOK * 128 * 2;
constexpr size_t WS_L1END = WS_SG + (size_t)NTOK * 128 * 2;
constexpr size_t cmax(size_t a, size_t b) { return a > b ? a : b; }
constexpr size_t WS_END = cmax(cmax(WS_L0END, WS_FFNEND), WS_L1END);
static_assert(WS_YY + (size_t)2 * NTOK * 512 * 4 <= WS_QD, "layer-1 overlay");
static_assert(WS_END <= (size_t)256 * 1024 * 1024, "workspace exceeds 256 MiB");

constexpr size_t OUT_X = 0;
constexpr size_t OUT_CKV = (size_t)NTOK * 1024;
constexpr size_t OUT_KROPE = OUT_CKV + (size_t)NCTX * 128;
constexpr size_t OUT_SRET = OUT_KROPE + (size_t)NCTX * 32;
constexpr size_t OUT_DK = OUT_SRET + (size_t)16 * 2 * 4 * 8192;
constexpr size_t OUT_DV = OUT_DK + (size_t)NCTX * 512;
constexpr size_t OUT_SRWKV = OUT_DV + (size_t)NCTX * 512;
constexpr size_t OUT_END = OUT_SRWKV + (size_t)16 * 2 * 8 * 4096;

struct Params {
    const float* in[43];
    float* out;
    unsigned char* ws;
    int ph_lo, ph_hi;
};

struct PRef {
    const LAS unsigned* w;
    __device__ __forceinline__ unsigned long long q(int i) const {
        const unsigned lo = (unsigned)__builtin_amdgcn_readfirstlane((int)w[2 * i]), hi = (unsigned)__builtin_amdgcn_readfirstlane((int)w[2 * i + 1]);
        return ((unsigned long long)hi << 32) | lo; }
    __device__ __forceinline__ const float* in(int k) const { return (const float*)(const __attribute__((address_space(1))) float*)q(k); }
    __device__ __forceinline__ float* out() const { return (float*)(__attribute__((address_space(1))) float*)q(43); }
    __device__ __forceinline__ unsigned char* ws() const { return (unsigned char*)(__attribute__((address_space(1))) unsigned char*)q(44); }
};

__device__ __forceinline__ bf16_t f2bf(float f) { unsigned u = __float_as_uint(f); u += 0x7fffu + ((u >> 16) & 1u); return (bf16_t)(u >> 16); }
__device__ __forceinline__ unsigned pack2(float a, float b) { return (unsigned)f2bf(a) | ((unsigned)f2bf(b) << 16); }
__device__ __forceinline__ float bf2f(unsigned b) { return __uint_as_float(b << 16); }
__device__ __forceinline__ float wave_sum(float v) {
#pragma unroll
    for (int o = 32; o; o >>= 1) v += __shfl_xor(v, o);
    return v;
}
__device__ __forceinline__ float sigmoidf_(float x) { return 1.0f / (1.0f + __expf(-x)); }
__device__ __forceinline__ float siluf_(float x) { return x * sigmoidf_(x); }
__device__ __forceinline__ float tanhf_(float x) { return 1.0f - 2.0f / (__expf(2.0f * x) + 1.0f); }
__device__ __forceinline__ int cond_of(int row) { return row < NCTX ? 0 : 1 + ((row - NCTX) >> 10); }

#define XB_TMO      128
#define XB_XCNT(j)  (256  + 64 * (j))
#define XB_XSUB(j)  (1280 + 64 * (j))
#define XB_XGEN(j)  (2304 + 64 * (j))
#define XB_TOP      3328
#define XB_TOPGEN   3392
#define XCD_BAR_WORDS 3456
#define XB_SPIN_CAP (1u << 20)
__device__ __forceinline__ unsigned xb_ld(unsigned* p) { return __hip_atomic_load(p, __ATOMIC_RELAXED, __HIP_MEMORY_SCOPE_AGENT); }
__device__ __forceinline__ unsigned xb_add(unsigned* p, unsigned v) { return __hip_atomic_fetch_add(p, v, __ATOMIC_RELAXED, __HIP_MEMORY_SCOPE_AGENT); }
__device__ __forceinline__ unsigned xb_xcc_id() { return (unsigned)__builtin_amdgcn_s_getreg((3 << 11) | 20) & 0xFu; }
#define XB_SPIN(cond, bar) do { unsigned _sp = 0; while (cond) { __builtin_amdgcn_s_sleep(1); \
    if ((++_sp & 255u) == 0u) { if (xb_ld(&(bar)[XB_TMO])) break; if (_sp > XB_SPIN_CAP) { atomicAdd(&(bar)[XB_TMO], 1u); break; } } } } while (0)
struct XcdBarrier { unsigned* bar; unsigned x; volatile LAS unsigned* st; };
__device__ __forceinline__ XcdBarrier xcd_barrier_post(unsigned* bar, volatile LAS unsigned* st) {
    XcdBarrier b; b.bar = bar; b.x = xb_xcc_id(); b.st = st;
    if (threadIdx.x == 0) (void)xb_add(&bar[XB_XCNT(b.x)], 1u);
    return b;
}
__device__ __forceinline__ void xcd_barrier_complete(unsigned* bar, unsigned x, unsigned& nloc, unsigned& nx) {
    const unsigned G = gridDim.x * gridDim.y * gridDim.z;
    unsigned sum, cnt, mine, sp = 0u;
    for (;;) {
        sum = 0u; cnt = 0u; mine = 0u;
#pragma unroll
        for (unsigned j = 0; j < 16; ++j) { const unsigned c = xb_ld(&bar[XB_XCNT(j)]); sum += c; cnt += (c > 0u) ? 1u : 0u; mine = (j == x) ? c : mine; }
        if (sum == G) break;
        __builtin_amdgcn_s_sleep(1);
        if ((++sp & 255u) == 0u) { if (xb_ld(&bar[XB_TMO])) break; if (sp > XB_SPIN_CAP) { atomicAdd(&bar[XB_TMO], 1u); break; } }
    }
    nloc = mine > 0u ? mine : 1u; nx = cnt > 0u ? cnt : 1u;
}
__device__ __forceinline__ void xcd_barrier(const XcdBarrier& b) {
    asm volatile("s_waitcnt vmcnt(0)" ::: "memory");
    __syncthreads();
    if (threadIdx.x == 0) {
        unsigned* bar = b.bar;
        __builtin_amdgcn_s_waitcnt(0);
        unsigned nloc = b.st[0], nx = b.st[1];
        if (nloc == 0u) { xcd_barrier_complete(bar, b.x, nloc, nx); b.st[0] = nloc; b.st[1] = nx; }
        const unsigned old = xb_add(&bar[XB_XSUB(b.x)], 1u);
        const unsigned gen = old / nloc;
        if (old + 1u == (gen + 1u) * nloc) {
            __builtin_amdgcn_fence(__ATOMIC_RELEASE, "agent");
            asm volatile("s_waitcnt vmcnt(0)" ::: "memory");
            const unsigned og = xb_add(&bar[XB_TOP], 1u);
            const unsigned tg = og / nx;
            if (og + 1u == (tg + 1u) * nx) xb_add(&bar[XB_TOPGEN], 1u);
            else XB_SPIN(xb_ld(&bar[XB_TOPGEN]) == tg, bar);
            __builtin_amdgcn_fence(__ATOMIC_ACQUIRE, "agent");
            xb_add(&bar[XB_XGEN(b.x)], 1u);
            asm volatile("s_waitcnt vmcnt(0)" ::: "memory");
        } else {
            XB_SPIN(xb_ld(&bar[XB_XGEN(b.x)]) == gen, bar);
            __builtin_amdgcn_fence(__ATOMIC_ACQUIRE, "agent");
            asm volatile("s_waitcnt vmcnt(0)" ::: "memory");
        }
    }
    __syncthreads();
}

struct Frame {
    LAS unsigned char* lds;
    int tid, lane, wave, G, bid;
};
#define FOR_UNITS(u, n, rot) for (int u = (int)((F.bid + F.G - ((rot) % F.G)) % F.G); u < (n); u += F.G)

__device__ __forceinline__ int lds_byte(int r, int c) { const int st = (r >> 4) * 2 + (c >> 5), rr = r & 15, cc = c & 31, ob = rr * 64 + cc * 2; return st * 1024 + (ob ^ (((ob >> 9) & 1) << 5)); }
__device__ __forceinline__ void stage_rc(int b, int& R, int& C) { const int st = b / 1024, sb = b % 1024, swz = sb ^ (((sb >> 9) & 1) << 5); R = (st >> 1) * 16 + swz / 64; C = (st & 1) * 32 + (swz % 64) / 2; }

struct GemmDesc { const bf16_t* A; const bf16_t* Bt; int lda, ldb, M, N, K; };

struct EpiF32 { float* C; int ldc, ncols;
    __device__ __forceinline__ void operator()(int r, int c, f32x4 v) const { if (c < ncols) *(f32x4*)(C + (size_t)r * ldc + c) = v; } };
struct EpiBf16 { bf16_t* C; int ldc, ncols;
    __device__ __forceinline__ void operator()(int r, int c, f32x4 v) const { if (c < ncols) { u32x2 w; w.x = pack2(v[0], v[1]); w.y = pack2(v[2], v[3]); *(u32x2*)(C + (size_t)r * ldc + c) = w; } } };
struct EpiResid { const float* xa; const float* xb; float* xo; const float* gate;
    __device__ __forceinline__ void operator()(int r, int c, f32x4 v) const {
        const float* xs = r < NCTX ? xa + (size_t)r * 1024 : xb + (size_t)(r - NCTX) * 1024;
        const f32x4 x = *(const f32x4*)(xs + c); const f32x4 g = *(const f32x4*)(gate + cond_of(r) * 6144 + c);
        *(f32x4*)(xo + (size_t)r * 1024 + c) = x + g * v; } };
struct EpiDecay { float* C; const float* w0;
    __device__ __forceinline__ void operator()(int r, int c, f32x4 v) const { const f32x4 b = *(const f32x4*)(w0 + c); f32x4 o;
#pragma unroll
        for (int j = 0; j < 4; ++j) o[j] = __expf(-0.60653065971f * sigmoidf_(b[j] + v[j]));
        *(f32x4*)(C + (size_t)r * 512 + c) = o; } };
struct EpiSigm { float* C; const float* a0;
    __device__ __forceinline__ void operator()(int r, int c, f32x4 v) const { const f32x4 b = *(const f32x4*)(a0 + c); f32x4 o;
#pragma unroll
        for (int j = 0; j < 4; ++j) o[j] = sigmoidf_(b[j] + v[j]);
        *(f32x4*)(C + (size_t)r * 512 + c) = o; } };

template <class Epi>
__device__ __forceinline__ void gemm_s(const Frame& F, const GemmDesc g, const Epi& E, int rot) {
    LAS unsigned char* lds = F.lds;
    const int tid = F.tid, wid = F.wave, lane = F.lane, wr = wid >> 2, wc = wid & 3, fr = lane & 15, fq = lane >> 4;
    const int nM = g.M / 128, nN = g.N / 128, nU = nM * nN, nt = g.K / 64;
    int R0, C0, R1, C1; stage_rc(tid * 16, R0, C0); stage_rc(tid * 16 + 8192, R1, C1);
    const int aoff = lds_byte(wr * 64 + fr, fq * 8), boff = lds_byte(wc * 32 + fr, fq * 8);
    const unsigned ldsw = (unsigned)wid * 1024u;
#define GS_STAGE(buf, t) do { \
        __builtin_amdgcn_global_load_lds((const unsigned*)(Ag + (size_t)R0 * g.lda + (t) * 64 + C0), (LAS unsigned*)(lds + (buf) * 32768 + ldsw), 16, 0, 0); \
        __builtin_amdgcn_global_load_lds((const unsigned*)(Ag + (size_t)R1 * g.lda + (t) * 64 + C1), (LAS unsigned*)(lds + (buf) * 32768 + ldsw + 8192), 16, 0, 0); \
        __builtin_amdgcn_global_load_lds((const unsigned*)(Bg + (size_t)R0 * g.ldb + (t) * 64 + C0), (LAS unsigned*)(lds + (buf) * 32768 + 16384 + ldsw), 16, 0, 0); \
        __builtin_amdgcn_global_load_lds((const unsigned*)(Bg + (size_t)R1 * g.ldb + (t) * 64 + C1), (LAS unsigned*)(lds + (buf) * 32768 + 16384 + ldsw + 8192), 16, 0, 0); } while (0)
    FOR_UNITS(u, nU, rot) {
        const int pm = u % nM, pn = u / nM;
        const bf16_t* Ag = g.A + (size_t)(pm * 128) * g.lda; const bf16_t* Bg = g.Bt + (size_t)(pn * 128) * g.ldb;
        f32x4 acc[4][2];
#pragma unroll
        for (int m = 0; m < 4; ++m)
#pragma unroll
            for (int n = 0; n < 2; ++n) acc[m][n] = (f32x4){0.f, 0.f, 0.f, 0.f};
        GS_STAGE(0, 0);
        for (int t = 0; t < nt; ++t) {
            const int b = t & 1;
            if (t + 1 < nt) { GS_STAGE(b ^ 1, t + 1); asm volatile("s_waitcnt vmcnt(4)" ::: "memory"); }
            else asm volatile("s_waitcnt vmcnt(0)" ::: "memory");
            __builtin_amdgcn_s_barrier(); asm volatile("" ::: "memory");
            bf16x8 Af[4][2], Bf[2][2];
#pragma unroll
            for (int m = 0; m < 4; ++m)
#pragma unroll
                for (int k = 0; k < 2; ++k) Af[m][k] = *(const LAS bf16x8*)(lds + b * 32768 + aoff + m * 2048 + k * 1024);
#pragma unroll
            for (int n = 0; n < 2; ++n)
#pragma unroll
                for (int k = 0; k < 2; ++k) Bf[n][k] = *(const LAS bf16x8*)(lds + b * 32768 + 16384 + boff + n * 2048 + k * 1024);
#pragma unroll
            for (int k = 0; k < 2; ++k)
#pragma unroll
                for (int m = 0; m < 4; ++m)
#pragma unroll
                    for (int n = 0; n < 2; ++n) acc[m][n] = __builtin_amdgcn_mfma_f32_16x16x32_bf16(Bf[n][k], Af[m][k], acc[m][n], 0, 0, 0);
            asm volatile("s_waitcnt lgkmcnt(0)" ::: "memory");
            __builtin_amdgcn_s_barrier(); asm volatile("" ::: "memory");
        }
#pragma unroll
        for (int m = 0; m < 4; ++m)
#pragma unroll
            for (int n = 0; n < 2; ++n) E(pm * 128 + wr * 64 + m * 16 + fr, pn * 128 + wc * 32 + n * 16 + 4 * fq, acc[m][n]);
    }
#undef GS_STAGE
}

struct CvtJob { const float* src; bf16_t* dst; int K, N, Npad, tiles; };
__device__ __forceinline__ void cvt_tile(const Frame& F, const CvtJob& j, int t) {
    LAS float* tile = (LAS float*)F.lds;
    const int tk = j.K / 64, kt = t % tk, ntile = t / tk, k0 = kt * 64, n0 = ntile * 64;
    const int tid = F.tid;
    {
        const int r = tid >> 4, c4 = (tid & 15) * 4;
#pragma unroll
        for (int i = 0; i < 2; ++i) {
            const int kr = r + 32 * i;
            f32x4 v = (f32x4){0.f, 0.f, 0.f, 0.f};
            if (n0 + c4 < j.N) v = *(const f32x4*)(j.src + (size_t)(k0 + kr) * j.N + n0 + c4);
            tile[kr * 65 + c4 + 0] = v[0]; tile[kr * 65 + c4 + 1] = v[1]; tile[kr * 65 + c4 + 2] = v[2]; tile[kr * 65 + c4 + 3] = v[3];
        }
    }
    __syncthreads();
    {
        const int n = tid >> 3, kq = (tid & 7) * 8;
        u32x4 w;
        w.x = pack2(tile[(kq + 0) * 65 + n], tile[(kq + 1) * 65 + n]); w.y = pack2(tile[(kq + 2) * 65 + n], tile[(kq + 3) * 65 + n]);
        w.z = pack2(tile[(kq + 4) * 65 + n], tile[(kq + 5) * 65 + n]); w.w = pack2(tile[(kq + 6) * 65 + n], tile[(kq + 7) * 65 + n]);
        *(u32x4*)(j.dst + (size_t)(n0 + n) * j.K + k0 + kq) = w;
    }
    __syncthreads();
}

__device__ void phase_prep(const Frame& F, const PRef& p) {
    unsigned char* ws = p.ws();
    {
        LAS float* sc = (LAS float*)F.lds;
        LAS float* red = sc + 3 * 1024;
        for (int i = F.tid; i < 3 * 1024; i += NTHREADS) {
            const int c = i >> 10, k = i & 1023;
            const float v = c == 0 ? p.in(9)[k] : p.in(8)[(c - 1) * 1024 + k];
            sc[i] = siluf_(v);
        }
        __syncthreads();
        float* mod = (float*)(ws + WS_MOD);
        FOR_UNITS(u, 192, 0) {
            const int l = u / 96, n0 = (u % 96) * 64, col = F.tid & 63, kg = F.tid >> 6;
            const float* w = p.in(10) + (size_t)l * 1024 * 6144 + (size_t)(kg * 128) * 6144 + n0 + col;
            float a0 = 0.f, a1 = 0.f, a2 = 0.f;
#pragma unroll 8
            for (int k = 0; k < 128; ++k) { const float wv = w[(size_t)k * 6144]; const int kk = kg * 128 + k; a0 += sc[kk] * wv; a1 += sc[1024 + kk] * wv; a2 += sc[2048 + kk] * wv; }
            red[(kg * 3 + 0) * 64 + col] = a0; red[(kg * 3 + 1) * 64 + col] = a1; red[(kg * 3 + 2) * 64 + col] = a2;
            __syncthreads();
            if (F.tid < 192) {
                const int c = F.tid >> 6, cc = F.tid & 63; float s = 0.f;
#pragma unroll
                for (int q = 0; q < 8; ++q) s += red[(q * 3 + c) * 64 + cc];
                mod[(size_t)(l * 3 + c) * 6144 + n0 + cc] = s + p.in(11)[l * 6144 + n0 + cc];
            }
            __syncthreads();
        }
    }
    int rot = 192;
#define CVT(srcp, dstoff, K_, N_, Npad_) do { CvtJob jb; jb.src = (srcp); jb.dst = (bf16_t*)(ws + (dstoff)); jb.K = (K_); jb.N = (N_); jb.Npad = (Npad_); jb.tiles = ((K_) / 64) * ((Npad_) / 64); \
        FOR_UNITS(t, jb.tiles, rot) cvt_tile(F, jb, t); rot += jb.tiles; } while (0)
    CVT(p.in(19), WS_WAIN, 1024, 1952, 2048);
    CVT(p.in(22), WS_WUQ, 256, 768, 768);
    CVT(p.in(23), WS_WUKV, 128, 1024, 1024);
    CVT(p.in(14), WS_WOUT, 1024, 1024, 1024);
    CVT(p.in(15), WS_WUP, 1024, 5632, 5632);
    CVT(p.in(18), WS_WDN, 2816, 1024, 1024);
    CVT(p.in(28), WS_WBIN, 1024, 3456, 3584);
    CVT(p.in(14) + (size_t)1024 * 1024, WS_WOUT + (size_t)1024 * 1024 * 2, 1024, 1024, 1024);
    CVT(p.in(15) + (size_t)1024 * 5632, WS_WUP + (size_t)5632 * 1024 * 2, 1024, 5632, 5632);
    CVT(p.in(18) + (size_t)2816 * 1024, WS_WDN + (size_t)1024 * 2816 * 2, 2816, 1024, 1024);
    CVT(p.in(35), WS_WWUP, 64, 512, 512);
    CVT(p.in(35) + 64 * 512, WS_WWUP + 512 * 64 * 2, 64, 512, 512);
    CVT(p.in(37), WS_WAUP, 64, 512, 512);
    CVT(p.in(37) + 64 * 512, WS_WAUP + 512 * 64 * 2, 64, 512, 512);
    CVT(p.in(38), WS_WGUP, 128, 512, 512);
#undef CVT
}

__device__ void phase_norm(const Frame& F, const float* xa, const float* xb, const float* g, const float* sc, const float* sh, bf16_t* hb) {
    const int nw = F.G * 8;
    for (int row = F.bid * 8 + F.wave; row < NTOK; row += nw) {
        const float* x = row < NCTX ? xa + (size_t)row * 1024 : xb + (size_t)(row - NCTX) * 1024;
        const int c = cond_of(row);
        f32x4 v[4]; float ss = 0.f;
#pragma unroll
        for (int i = 0; i < 4; ++i) { v[i] = *(const f32x4*)(x + i * 256 + F.lane * 4); ss += v[i][0] * v[i][0] + v[i][1] * v[i][1] + v[i][2] * v[i][2] + v[i][3] * v[i][3]; }
        ss = wave_sum(ss);
        const float rstd = rsqrtf(ss * (1.0f / 1024.0f) + EPS);
#pragma unroll
        for (int i = 0; i < 4; ++i) {
            const int col = i * 256 + F.lane * 4;
            const f32x4 gg = *(const f32x4*)(g + col), s1 = *(const f32x4*)(sc + c * 6144 + col), s0 = *(const f32x4*)(sh + c * 6144 + col);
            f32x4 h;
#pragma unroll
            for (int j = 0; j < 4; ++j) h[j] = v[i][j] * rstd * gg[j] * (1.0f + s1[j]) + s0[j];
            u32x2 w; w.x = pack2(h[0], h[1]); w.y = pack2(h[2], h[3]);
            *(u32x2*)(hb + (size_t)row * 1024 + col) = w;
        }
    }
}

__device__ __forceinline__ void seq_of_unit384(int u, int& s, int& c, int& h, int& tok0, int& nc) {
    if (u < 256) { s = u >> 4; c = (u >> 2) & 3; h = u & 3; tok0 = s * 256 + c * 64; nc = 4; }
    else { const int v = u - 256; s = 16 + (v >> 6); c = (v >> 2) & 15; h = v & 3; tok0 = NCTX + (s - 16) * 1024 + c * 64; nc = 16; }
}
__device__ void phase_l0_tok(const Frame& F, const PRef& p) {
    unsigned char* ws = p.ws();
    const float* P = (const float*)(ws + WS_P0);
    bf16_t* cqn = (bf16_t*)(ws + WS_CQN); bf16_t* ckvn = (bf16_t*)(ws + WS_CKVN);
    const int nw = F.G * 8;
    for (int row = F.bid * 8 + F.wave; row < NKROW; row += nw) {
        if (row < NTOK) {
            const float* pr = P + (size_t)row * 2048;
            const f32x4 q = *(const f32x4*)(pr + F.lane * 4);
            float ss = wave_sum(q[0] * q[0] + q[1] * q[1] + q[2] * q[2] + q[3] * q[3]);
            float rstd = rsqrtf(ss * (1.0f / 256.0f) + EPS);
            const f32x4 gq = *(const f32x4*)(p.in(20) + F.lane * 4);
            u32x2 w; w.x = pack2(q[0] * rstd * gq[0], q[1] * rstd * gq[1]); w.y = pack2(q[2] * rstd * gq[2], q[3] * rstd * gq[3]);
            *(u32x2*)(cqn + (size_t)row * 256 + F.lane * 4) = w;
            const f32x2 kv = *(const f32x2*)(pr + 256 + F.lane * 2);
            ss = wave_sum(kv[0] * kv[0] + kv[1] * kv[1]);
            rstd = rsqrtf(ss * (1.0f / 128.0f) + EPS);
            const f32x2 gk = *(const f32x2*)(p.in(21) + F.lane * 2);
            const float o0 = kv[0] * rstd * gk[0], o1 = kv[1] * rstd * gk[1];
            *(unsigned*)(ckvn + (size_t)row * 128 + F.lane * 2) = pack2(o0, o1);
            if (row < NCTX) {
                *(f32x2*)(p.out() + OUT_CKV + (size_t)row * 128 + F.lane * 2) = (f32x2){o0, o1};
                if (F.lane < 32) p.out()[OUT_KROPE + (size_t)row * 32 + F.lane] = pr[384 + F.lane];
            }
        } else {
            const int i = row - NTOK;
            const f32x2 kv = *(const f32x2*)(p.in(2) + (size_t)i * 128 + F.lane * 2);
            *(unsigned*)(ckvn + (size_t)row * 128 + F.lane * 2) = pack2(kv[0], kv[1]);
        }
    }
    LAS float* kf = (LAS float*)F.lds;
    LAS float* kb = kf + 4096;
    LAS float* vs = kb + 4096;
    float* KVS = (float*)(ws + WS_KVS);
    FOR_UNITS(u, 384, 0) {
        int s, c, h, tok0, nc; seq_of_unit384(u, s, c, h, tok0, nc);
        const float lgf = __logf(sigmoidf_(p.in(26)[h])), lgb = __logf(sigmoidf_(p.in(26)[4 + h]));
        for (int i = F.tid; i < 4096; i += NTHREADS) {
            const int r = i >> 6, e = i & 63;
            const float k = P[(size_t)(tok0 + r) * 2048 + 672 + h * 64 + e] * 0.125f;
            kf[i] = k * __expf(lgf * (float)(63 - r)); kb[i] = k * __expf(lgb * (float)r);
        }
        for (int i = F.tid; i < 8192; i += NTHREADS) { const int r = i >> 7, f = i & 127; vs[i] = P[(size_t)(tok0 + r) * 2048 + 928 + h * 128 + f]; }
        __syncthreads();
        const int f = F.tid & 127, e0 = (F.tid >> 7) * 16;
        float af[16], ab[16];
#pragma unroll
        for (int e = 0; e < 16; ++e) { af[e] = 0.f; ab[e] = 0.f; }
        for (int i = 0; i < 64; ++i) {
            const float v = vs[i * 128 + f];
#pragma unroll
            for (int e = 0; e < 16; ++e) { af[e] += kf[i * 64 + e0 + e] * v; ab[e] += kb[i * 64 + e0 + e] * v; }
        }
        float* o = KVS + (size_t)u * 2 * 8192;
#pragma unroll
        for (int e = 0; e < 16; ++e) { o[(e0 + e) * 128 + f] = af[e]; o[8192 + (e0 + e) * 128 + f] = ab[e]; }
        __syncthreads();
    }
}

__device__ __forceinline__ size_t vt_base(int kr, int nheads, int dv, int& nkeys, int& key) {
    if (kr < NCTX) { nkeys = 256; key = kr & 255; return (size_t)(kr >> 8) * nheads * dv * 256; }
    const int v = kr - NCTX; const int b = v / 1536; nkeys = 1536; key = v - b * 1536;
    return (size_t)16 * nheads * dv * 256 + (size_t)b * nheads * dv * 1536;
}
__device__ void phase_l0_qkv(const Frame& F, const PRef& p) {
    unsigned char* ws = p.ws();
    const float* P = (const float*)(ws + WS_P0); const float* QR = (const float*)(ws + WS_QRAW); const float* KVR = (const float*)(ws + WS_KVRAW);
    bf16_t* Q = (bf16_t*)(ws + WS_Q0); bf16_t* K = (bf16_t*)(ws + WS_K0); bf16_t* VT = (bf16_t*)(ws + WS_VT0);
    const int nw = F.G * 8, lane = F.lane;
    const float qscale = 0.10206207261596577f;
    for (int row = F.bid * 8 + F.wave; row < NKROW; row += nw) {
        const bool istok = row < NTOK, lat = istok && row >= NCTX;
        float cs = 1.f, sn = 0.f;
        if (lat && lane >= 32 && lane < 48) {
            const int t = (row - NCTX) & 1023, a = lane - 32;
            const float pos = a < 8 ? (float)(t >> 6) : (float)(t & 63);
            const float inv = __powf(10000.0f, -(float)(a & 7) * 0.125f);
            const float ang = pos * inv; cs = __cosf(ang); sn = __sinf(ang);
        }
        int kr;
        if (row < NCTX) kr = row; else if (row < NTOK) { const int v = row - NCTX; kr = NCTX + (v >> 10) * 1536 + (v & 1023); }
        else { const int i = row - NTOK; kr = NCTX + (i >> 9) * 1536 + 1024 + (i & 511); }
        int nkeys, key; const size_t vb = vt_base(kr, 8, 64, nkeys, key);
        const float* krope = istok ? P + (size_t)row * 2048 + 384 : p.in(3) + (size_t)(row - NTOK) * 32;
        for (int h = 0; h < 8; ++h) {
            if (istok) {
                float x1 = 0.f, x2 = 0.f;
                if (lane < 48) { const f32x2 v = *(const f32x2*)(QR + (size_t)row * 768 + h * 96 + 2 * lane); x1 = v[0]; x2 = v[1]; }
                const float rstd = rsqrtf(wave_sum(x1 * x1 + x2 * x2) * (1.0f / 96.0f) + EPS);
                if (lane < 48) {
                    const f32x2 gn = *(const f32x2*)(p.in(24) + 2 * lane);
                    x1 = x1 * rstd * gn[0]; x2 = x2 * rstd * gn[1];
                    const float y1 = x1 * cs - x2 * sn, y2 = x1 * sn + x2 * cs;
                    *(unsigned*)(Q + (size_t)row * 768 + h * 96 + 2 * lane) = pack2(y1 * qscale, y2 * qscale);
                }
            }
            {
                float x1 = 0.f, x2 = 0.f;
                if (lane < 32) { const f32x2 v = *(const f32x2*)(KVR + (size_t)row * 1024 + h * 128 + 2 * lane); x1 = v[0]; x2 = v[1]; }
                else if (lane < 48) { const f32x2 v = *(const f32x2*)(krope + 2 * (lane - 32)); x1 = v[0]; x2 = v[1]; }
                const float rstd = rsqrtf(wave_sum(x1 * x1 + x2 * x2) * (1.0f / 96.0f) + EPS);
                if (lane < 48) {
                    const f32x2 gn = *(const f32x2*)(p.in(25) + 2 * lane);
                    x1 = x1 * rstd * gn[0]; x2 = x2 * rstd * gn[1];
                    const float y1 = x1 * cs - x2 * sn, y2 = x1 * sn + x2 * cs;
                    *(unsigned*)(K + (size_t)kr * 768 + h * 96 + 2 * lane) = pack2(y1, y2);
                }
            }
            {
                const float v = KVR[(size_t)row * 1024 + h * 128 + 64 + lane];
                VT[vb + ((size_t)h * 64 + lane) * nkeys + key] = f2bf(v);
            }
        }
    }
}

template <int DQK, int DV, int NC, int NQT>
struct AttnState { f32x4 O[NC][DV / 16][NQT]; float l[NC][NQT]; };

template <int DQK, int DV, int NC, int NQT>
__device__ __forceinline__ void attn_wave(const bf16_t* __restrict__ Q, const bf16_t* __restrict__ K, const bf16_t* __restrict__ Vt,
                                          int qtok0, int krow0, int nkeys, int hh0  , int lane, AttnState<DQK, DV, NC, NQT>& st) {
    constexpr int NS = DQK / 32, NE = DV / 16, RS = 8 * DQK;
    const int fr = lane & 15, fq = lane >> 4;
    bf16x8 Qf[NC][NQT][NS];
#pragma unroll
    for (int c = 0; c < NC; ++c)
#pragma unroll
        for (int qt = 0; qt < NQT; ++qt)
#pragma unroll
            for (int s = 0; s < NS; ++s) Qf[c][qt][s] = *(const bf16x8*)(Q + (size_t)(qtok0 + qt * 16 + fr) * RS + (hh0 + c) * DQK + s * 32 + fq * 8);
    float m[NC][NQT];
#pragma unroll
    for (int c = 0; c < NC; ++c)
#pragma unroll
        for (int qt = 0; qt < NQT; ++qt) { m[c][qt] = -1e30f; st.l[c][qt] = 0.f;
#pragma unroll
            for (int e = 0; e < NE; ++e) st.O[c][e][qt] = (f32x4){0.f, 0.f, 0.f, 0.f}; }
    for (int key0 = 0; key0 < nkeys; key0 += 32) {
        bf16x8 Pf[NC][NQT];
#pragma unroll
        for (int c = 0; c < NC; ++c) {
            f32x4 S[2][NQT];
#pragma unroll
            for (int kt = 0; kt < 2; ++kt) {
                bf16x8 Kf[NS];
#pragma unroll
                for (int s = 0; s < NS; ++s) Kf[s] = *(const bf16x8*)(K + (size_t)(krow0 + key0 + kt * 16 + fr) * RS + (hh0 + c) * DQK + s * 32 + fq * 8);
#pragma unroll
                for (int qt = 0; qt < NQT; ++qt) {
                    f32x4 a = (f32x4){0.f, 0.f, 0.f, 0.f};
#pragma unroll
                    for (int s = 0; s < NS; ++s) a = __builtin_amdgcn_mfma_f32_16x16x32_bf16(Kf[s], Qf[c][qt][s], a, 0, 0, 0);
                    S[kt][qt] = a;
                }
            }
#pragma unroll
            for (int qt = 0; qt < NQT; ++qt) {
                float mx = fmaxf(fmaxf(fmaxf(S[0][qt][0], S[0][qt][1]), fmaxf(S[0][qt][2], S[0][qt][3])), fmaxf(fmaxf(S[1][qt][0], S[1][qt][1]), fmaxf(S[1][qt][2], S[1][qt][3])));
                mx = fmaxf(mx, __shfl_xor(mx, 16)); mx = fmaxf(mx, __shfl_xor(mx, 32));
                const float mn = fmaxf(m[c][qt], mx), alpha = __expf(m[c][qt] - mn);
                m[c][qt] = mn;
                float pv[8]; float ps = 0.f;
#pragma unroll
                for (int j = 0; j < 4; ++j) { pv[j] = __expf(S[0][qt][j] - mn); pv[4 + j] = __expf(S[1][qt][j] - mn); ps += pv[j] + pv[4 + j]; }
                st.l[c][qt] = st.l[c][qt] * alpha + ps;
#pragma unroll
                for (int e = 0; e < NE; ++e) st.O[c][e][qt] *= alpha;
                bf16x8 pf;
#pragma unroll
                for (int j = 0; j < 8; ++j) pf[j] = (short)f2bf(pv[j]);
                Pf[c][qt] = pf;
            }
        }
#pragma unroll
        for (int e = 0; e < NE; ++e) {
            const bf16_t* vp = Vt + (size_t)(e * 16 + fr) * nkeys + key0 + 4 * fq;
            const bf16x4 v0 = *(const bf16x4*)vp, v1 = *(const bf16x4*)(vp + 16);
            bf16x8 Vf; Vf[0] = v0[0]; Vf[1] = v0[1]; Vf[2] = v0[2]; Vf[3] = v0[3]; Vf[4] = v1[0]; Vf[5] = v1[1]; Vf[6] = v1[2]; Vf[7] = v1[3];
#pragma unroll
            for (int c = 0; c < NC; ++c)
#pragma unroll
                for (int qt = 0; qt < NQT; ++qt) st.O[c][e][qt] = __builtin_amdgcn_mfma_f32_16x16x32_bf16(Vf, Pf[c][qt], st.O[c][e][qt], 0, 0, 0);
        }
    }
#pragma unroll
    for (int c = 0; c < NC; ++c)
#pragma unroll
        for (int qt = 0; qt < NQT; ++qt) { float l = st.l[c][qt]; l += __shfl_xor(l, 16); l += __shfl_xor(l, 32); st.l[c][qt] = 1.0f / l; }
}

__device__ __forceinline__ void attn_unit(int u, int wave, int& ab, int& h, int& q0) {
    if (u < 64) { ab = 16 + (u >> 5); h = (u >> 2) & 7; q0 = (u & 3) * 256 + wave * 32; }
    else { const int v = u - 64; ab = v >> 3; h = v & 7; q0 = wave * 32; }
}

__device__ void phase_l0_mix(const Frame& F, const PRef& p) {
    unsigned char* ws = p.ws();
    const float* P = (const float*)(ws + WS_P0);
    bf16_t* OB = (bf16_t*)(ws + WS_OB);
    const bf16_t* Q = (const bf16_t*)(ws + WS_Q0); const bf16_t* K = (const bf16_t*)(ws + WS_K0); const bf16_t* VT = (const bf16_t*)(ws + WS_VT0);
    const int lane = F.lane, fr = lane & 15, fq = lane >> 4;
    FOR_UNITS(u, 192, 0) {
        int ab, h, q0; attn_unit(u, F.wave, ab, h, q0);
        const int nkeys = ab < 16 ? 256 : 1536;
        const int qtok0 = ab < 16 ? ab * 256 + q0 : NCTX + (ab - 16) * 1024 + q0;
        const int krow0 = ab < 16 ? ab * 256 : NCTX + (ab - 16) * 1536;
        const bf16_t* vt = VT + (ab < 16 ? (size_t)ab * 8 * 64 * 256 + (size_t)h * 64 * 256 : (size_t)16 * 8 * 64 * 256 + (size_t)(ab - 16) * 8 * 64 * 1536 + (size_t)h * 64 * 1536);
        AttnState<96, 64, 1, 2> st;
        attn_wave<96, 64, 1, 2>(Q, K, vt, qtok0, krow0, nkeys, h, lane, st);
#pragma unroll
        for (int qt = 0; qt < 2; ++qt)
#pragma unroll
            for (int e = 0; e < 4; ++e) {
                const f32x4 o = st.O[0][e][qt] * st.l[0][qt];
                u32x2 w; w.x = pack2(o[0], o[1]); w.y = pack2(o[2], o[3]);
                *(u32x2*)(OB + (size_t)(qtok0 + qt * 16 + fr) * 1024 + h * 64 + e * 16 + 4 * fq) = w;
            }
    }
    LAS float* vs = (LAS float*)F.lds;
    LAS float* Ss = vs + 8192;
    LAS float* Wt = Ss + 8192;
    LAS float* qfT = Wt + 4096;
    LAS float* qbT = qfT + 4096;
    LAS float* red = qbT + 4096;
    LAS float* qs = red + 128;
    const float* KVS = (const float*)(ws + WS_KVS);
    FOR_UNITS(u, 384, 192) {
        int s, c, h, tok0, nc; seq_of_unit384(u, s, c, h, tok0, nc);
        const float lgf = __logf(sigmoidf_(p.in(26)[h])), lgb = __logf(sigmoidf_(p.in(26)[4 + h]));
        LAS float* ks = Ss;
        for (int i = F.tid; i < 4096; i += NTHREADS) {
            const int r = i >> 6, e = i & 63;
            const float q = P[(size_t)(tok0 + r) * 2048 + 416 + h * 64 + e];
            qs[r * 65 + e] = q; ks[i] = P[(size_t)(tok0 + r) * 2048 + 672 + h * 64 + e] * 0.125f;
            qfT[e * 64 + r] = q * __expf(lgf * (float)(r + 1)); qbT[e * 64 + r] = q * __expf(lgb * (float)(64 - r));
        }
        for (int i = F.tid; i < 8192; i += NTHREADS) { const int r = i >> 7, f = i & 127; vs[i] = P[(size_t)(tok0 + r) * 2048 + 928 + h * 128 + f]; }
        __syncthreads();
        for (int i = F.tid; i < 4096; i += NTHREADS) {
            const int j = i >> 6, ii = i & 63;
            float d = 0.f;
#pragma unroll 16
            for (int e = 0; e < 64; ++e) d += qs[ii * 65 + e] * ks[j * 64 + e];
            float w = 0.f;
            if (j <= ii) w += __expf(lgf * (float)(ii - j));
            if (j >= ii) w += __expf(lgb * (float)(j - ii));
            Wt[i] = d * w;
        }
        __syncthreads();
        const int f = F.tid & 127, i0 = (F.tid >> 7) * 16;
        float o[16];
#pragma unroll
        for (int i = 0; i < 16; ++i) o[i] = 0.f;
        for (int j = 0; j < 64; ++j) {
            const float v = vs[j * 128 + f];
#pragma unroll
            for (int i = 0; i < 16; ++i) o[i] += Wt[j * 64 + i0 + i] * v;
        }
        const float* s0 = s >= 16 ? p.in(4) + (size_t)(s - 16) * 2 * 4 * 8192 : nullptr;
        const int ubase = u - c * 4;
        for (int i = F.tid; i < 8192; i += NTHREADS) {
            float a = s0 ? s0[(size_t)(0 * 4 + h) * 8192 + i] * __expf(lgf * 64.0f * (float)c) : 0.f;
            for (int cc = 0; cc < c; ++cc) a += KVS[(size_t)(ubase + cc * 4) * 16384 + i] * __expf(lgf * 64.0f * (float)(c - 1 - cc));
            Ss[i] = a;
        }
        __syncthreads();
        for (int e = 0; e < 64; ++e) {
            const float v = Ss[e * 128 + f];
#pragma unroll
            for (int i = 0; i < 16; ++i) o[i] += qfT[e * 64 + i0 + i] * v;
        }
        if (s < 16 && c == nc - 1) {
            const float g64 = __expf(lgf * 64.0f);
            for (int i = F.tid; i < 8192; i += NTHREADS)
                p.out()[OUT_SRET + (size_t)((s * 2 + 0) * 4 + h) * 8192 + i] = Ss[i] * g64 + KVS[(size_t)u * 16384 + i];
        }
        __syncthreads();
        for (int i = F.tid; i < 8192; i += NTHREADS) {
            float a = s0 ? s0[(size_t)(1 * 4 + h) * 8192 + i] * __expf(lgb * 64.0f * (float)(nc - 1 - c)) : 0.f;
            for (int cc = c + 1; cc < nc; ++cc) a += KVS[(size_t)(ubase + cc * 4) * 16384 + 8192 + i] * __expf(lgb * 64.0f * (float)(cc - c - 1));
            Ss[i] = a;
        }
        __syncthreads();
        for (int e = 0; e < 64; ++e) {
            const float v = Ss[e * 128 + f];
#pragma unroll
            for (int i = 0; i < 16; ++i) o[i] += qbT[e * 64 + i0 + i] * v;
        }
        if (s < 16 && c == 0) {
            const float g64 = __expf(lgb * 64.0f);
            for (int i = F.tid; i < 8192; i += NTHREADS)
                p.out()[OUT_SRET + (size_t)((s * 2 + 1) * 4 + h) * 8192 + i] = Ss[i] * g64 + KVS[(size_t)u * 16384 + 8192 + i];
        }
        const int wv = (F.tid >> 6) & 1;
#pragma unroll
        for (int i = 0; i < 16; ++i) { const float ss = wave_sum(o[i] * o[i]); if (lane == 0) red[(i0 + i) * 2 + wv] = ss; }
        __syncthreads();
        const float gn = p.in(27)[h * 128 + f];
#pragma unroll
        for (int i = 0; i < 16; ++i) {
            const float rstd = rsqrtf((red[(i0 + i) * 2] + red[(i0 + i) * 2 + 1]) * (1.0f / 128.0f) + EPS);
            const int tok = tok0 + i0 + i;
            const float rg = P[(size_t)tok * 2048 + 1440 + h * 128 + f];
            OB[(size_t)tok * 1024 + 512 + h * 128 + f] = f2bf(siluf_(rg) * o[i] * rstd * gn);
        }
        __syncthreads();
    }
}

__device__ void phase_gate(const Frame& F, const PRef& p, int l) {
    const bf16_t* U = (const bf16_t*)(p.ws() + WS_U); bf16_t* ACT = (bf16_t*)(p.ws() + WS_ACT);
    const float* cw = p.in(16) + (size_t)l * 3 * 5632; const float* cb = p.in(17) + (size_t)l * 5632;
    const int total = NTOK * 352;
    for (int it = F.bid * NTHREADS + F.tid; it < total; it += F.G * NTHREADS) {
        const int tok = it / 352, c0 = (it - tok * 352) * 8;
        const int t = tok < NCTX ? (tok & 255) : ((tok - NCTX) & 1023), n = tok < NCTX ? 256 : 1024;
        const bool hp = t > 0, hn = t < n - 1;
        float ua[8], ub[8];
#pragma unroll
        for (int half = 0; half < 2; ++half) {
            const int col = c0 + half * 2816;
            const bf16x8 z = (bf16x8){0, 0, 0, 0, 0, 0, 0, 0};
            const bf16x8 xc = *(const bf16x8*)(U + (size_t)tok * 5632 + col);
            const bf16x8 xp = hp ? *(const bf16x8*)(U + (size_t)(tok - 1) * 5632 + col) : z;
            const bf16x8 xn = hn ? *(const bf16x8*)(U + (size_t)(tok + 1) * 5632 + col) : z;
#pragma unroll
            for (int j = 0; j < 8; ++j) {
                const float v = bf2f((unsigned short)xp[j]) * cw[col + j] + bf2f((unsigned short)xc[j]) * cw[5632 + col + j] + bf2f((unsigned short)xn[j]) * cw[2 * 5632 + col + j] + cb[col + j];
                if (half == 0) ua[j] = v; else ub[j] = v;
            }
        }
        u32x4 w;
        w.x = pack2(siluf_(ua[0]) * ub[0], siluf_(ua[1]) * ub[1]); w.y = pack2(siluf_(ua[2]) * ub[2], siluf_(ua[3]) * ub[3]);
        w.z = pack2(siluf_(ua[4]) * ub[4], siluf_(ua[5]) * ub[5]); w.w = pack2(siluf_(ua[6]) * ub[6], siluf_(ua[7]) * ub[7]);
        *(u32x4*)(ACT + (size_t)tok * 2816 + c0) = w;
    }
}

__device__ void phase_l1_tok(const Frame& F, const PRef& p) {
    unsigned char* ws = p.ws();
    const float* P = (const float*)(ws + WS_P1);
    bf16_t* QD = (bf16_t*)(ws + WS_QD); bf16_t* KD = (bf16_t*)(ws + WS_KD); bf16_t* VDT = (bf16_t*)(ws + WS_VDT);
    float* RR = (float*)(ws + WS_RR); float* KR = (float*)(ws + WS_KR); float* VV = (float*)(ws + WS_VV); float* KK = (float*)(ws + WS_KK);
    bf16_t* TW = (bf16_t*)(ws + WS_TW); bf16_t* AD = (bf16_t*)(ws + WS_AD); bf16_t* SG = (bf16_t*)(ws + WS_SG);
    const int nw = F.G * 8, lane = F.lane;
    const float* mu = p.in(33);
    for (int row = F.bid * 8 + F.wave; row < NKROW; row += nw) {
        const bool istok = row < NTOK, lat = istok && row >= NCTX;
        int kr;
        if (row < NCTX) kr = row; else if (row < NTOK) { const int v = row - NCTX; kr = NCTX + (v >> 10) * 1536 + (v & 1023); }
        else { const int i = row - NTOK; kr = NCTX + (i >> 9) * 1536 + 1024 + (i & 511); }
        int nkeys, key; const size_t vb = vt_base(kr, 4, 128, nkeys, key);
        if (!istok) {
            const int i = row - NTOK;
#pragma unroll
            for (int j = 0; j < 8; ++j) {
                const int col = j * 64 + lane;
                KD[(size_t)kr * 512 + col] = f2bf(p.in(5)[(size_t)i * 512 + col]);
                VDT[vb + (size_t)col * nkeys + key] = f2bf(p.in(6)[(size_t)i * 512 + col]);
            }
            continue;
        }
        const float* pr = P + (size_t)row * 3584;
        float cs = 1.f, sn = 0.f;
        if (lat) {
            const int t = (row - NCTX) & 1023, a = lane & 31;
            const float pos = a < 16 ? (float)(t >> 6) : (float)(t & 63);
            const float inv = __powf(10000.0f, -(float)(a & 15) * 0.0625f);
            const float ang = pos * inv; cs = __cosf(ang); sn = __sinf(ang);
        }
#pragma unroll
        for (int pass = 0; pass < 4; ++pass) {
            const int vec = pass * 2 + (lane >> 5), pi = lane & 31;
            {
                const f32x2 v = *(const f32x2*)(pr + vec * 64 + 2 * pi);
                float ss = v[0] * v[0] + v[1] * v[1];
#pragma unroll
                for (int o = 16; o; o >>= 1) ss += __shfl_xor(ss, o);
                const float rstd = rsqrtf(ss * (1.0f / 64.0f) + EPS);
                const f32x2 gn = *(const f32x2*)(p.in(29) + 2 * pi);
                const float x1 = v[0] * rstd * gn[0], x2 = v[1] * rstd * gn[1];
                *(unsigned*)(QD + (size_t)row * 512 + vec * 64 + 2 * pi) = pack2((x1 * cs - x2 * sn) * 0.125f, (x1 * sn + x2 * cs) * 0.125f);
            }
            {
                const f32x2 v = *(const f32x2*)(pr + 512 + vec * 64 + 2 * pi);
                float ss = v[0] * v[0] + v[1] * v[1];
#pragma unroll
                for (int o = 16; o; o >>= 1) ss += __shfl_xor(ss, o);
                const float rstd = rsqrtf(ss * (1.0f / 64.0f) + EPS);
                const f32x2 gn = *(const f32x2*)(p.in(30) + 2 * pi);
                const float x1 = v[0] * rstd * gn[0], x2 = v[1] * rstd * gn[1];
                if (row < NCTX) *(f32x2*)(p.out() + OUT_DK + (size_t)row * 512 + vec * 64 + 2 * pi) = (f32x2){x1, x2};
                *(unsigned*)(KD + (size_t)kr * 512 + vec * 64 + 2 * pi) = pack2(x1 * cs - x2 * sn, x1 * sn + x2 * cs);
            }
        }
#pragma unroll
        for (int j = 0; j < 8; ++j) {
            const int col = j * 64 + lane; const float v = pr[1024 + col];
            if (row < NCTX) p.out()[OUT_DV + (size_t)row * 512 + col] = v;
            VDT[vb + (size_t)col * nkeys + key] = f2bf(v);
        }
        const int t = row < NCTX ? (row & 255) : ((row - NCTX) & 1023), n = row < NCTX ? 256 : 1024;
        const bool hp = t > 0, hn = t < n - 1;
        const float* pp = pr + 1536;
#define SHIFTED(col) ({ const float _c = pp[col]; const float _a = 0.5f * ((hp ? pp[(col) - 3584] : 0.f) + (hn ? pp[(col) + 3584] : 0.f)); _c + (_a - _c) * mu[col]; })
        {
            float kk[8]; float ss = 0.f;
#pragma unroll
            for (int j = 0; j < 8; ++j) {
                const int col = lane * 8 + j;
                RR[(size_t)row * 512 + col] = SHIFTED(col);
                const float k = SHIFTED(512 + col); KR[(size_t)row * 512 + col] = k;
                VV[(size_t)row * 512 + col] = SHIFTED(1024 + col);
                kk[j] = k * p.in(39)[col]; ss += kk[j] * kk[j];
            }
            ss += __shfl_xor(ss, 1); ss += __shfl_xor(ss, 2); ss += __shfl_xor(ss, 4);
            const float rn = rsqrtf(ss + EPS);
#pragma unroll
            for (int j = 0; j < 8; ++j) KK[(size_t)row * 512 + lane * 8 + j] = kk[j] * rn;
        }
#pragma unroll
        for (int j = 0; j < 2; ++j) {
            const int col = j * 64 + lane;
            TW[(size_t)row * 128 + col] = f2bf(tanhf_(SHIFTED(1536 + col)));
            AD[(size_t)row * 128 + col] = f2bf(SHIFTED(1664 + col));
            SG[(size_t)row * 128 + col] = f2bf(sigmoidf_(SHIFTED(1792 + col)));
        }
#undef SHIFTED
    }
}

constexpr int SC_T = 16;
constexpr int SC_BUF = 2 * SC_T * 6 * 64;
__device__ void phase_l1_mix(const Frame& F, const PRef& p) {
    unsigned char* ws = p.ws();
    bf16_t* OB = (bf16_t*)(ws + WS_OB);
    const int lane = F.lane, fr = lane & 15, fq = lane >> 4;
    {
        const bf16_t* Q = (const bf16_t*)(ws + WS_QD); const bf16_t* K = (const bf16_t*)(ws + WS_KD); const bf16_t* VT = (const bf16_t*)(ws + WS_VDT);
        const float l1v = p.in(31)[lane] * p.in(31)[64 + lane], l2v = p.in(31)[128 + lane] * p.in(31)[192 + lane];
        const float lam_init = 0.8f - 0.6f * 0.74081822068171788f;
        const float lam = __expf(wave_sum(l1v)) - __expf(wave_sum(l2v)) + lam_init;
        FOR_UNITS(u, 192, 0) {
            int ab, hh, q0; attn_unit(u, F.wave, ab, hh, q0);
            const int h = hh & 3, part = hh >> 2;
            const int nkeys = ab < 16 ? 256 : 1536;
            const int qbase = ab < 16 ? ab * 256 : NCTX + (ab - 16) * 1024;
            const int krow0 = ab < 16 ? ab * 256 : NCTX + (ab - 16) * 1536;
            const bf16_t* vt = VT + (ab < 16 ? (size_t)ab * 4 * 128 * 256 + (size_t)h * 128 * 256 : (size_t)16 * 4 * 128 * 256 + (size_t)(ab - 16) * 4 * 128 * 1536 + (size_t)h * 128 * 1536);
            const int qtok0 = qbase + q0 + part * 16;
            AttnState<64, 128, 2, 1> st;
            attn_wave<64, 128, 2, 1>(Q, K, vt, qtok0, krow0, nkeys, h * 2, lane, st);
            f32x4 d[8]; float ss = 0.f;
#pragma unroll
            for (int e = 0; e < 8; ++e) { d[e] = st.O[0][e][0] * st.l[0][0] - lam * (st.O[1][e][0] * st.l[1][0]); ss += d[e][0] * d[e][0] + d[e][1] * d[e][1] + d[e][2] * d[e][2] + d[e][3] * d[e][3]; }
            ss += __shfl_xor(ss, 16); ss += __shfl_xor(ss, 32);
            const float rstd = rsqrtf(ss * (1.0f / 128.0f) + EPS) * (1.0f - lam_init);
#pragma unroll
            for (int e = 0; e < 8; ++e) {
                const f32x4 gn = *(const f32x4*)(p.in(32) + h * 128 + e * 16 + 4 * fq);
                u32x2 w; w.x = pack2(d[e][0] * rstd * gn[0], d[e][1] * rstd * gn[1]); w.y = pack2(d[e][2] * rstd * gn[2], d[e][3] * rstd * gn[3]);
                *(u32x2*)(OB + (size_t)(qtok0 + fr) * 1024 + h * 128 + e * 16 + 4 * fq) = w;
            }
        }
    }
    {
        const float* RR = (const float*)(ws + WS_RR); const float* KR = (const float*)(ws + WS_KR); const float* VV = (const float*)(ws + WS_VV); const float* KK = (const float*)(ws + WS_KK);
        const float* DEC = (const float*)(ws + WS_DEC); const float* AA = (const float*)(ws + WS_AA);
        float* YY = (float*)(ws + WS_YY);
        LAS float* sb = (LAS float*)F.lds;
        const float* k_a = p.in(40);
        FOR_UNITS(u, 144, 192) {
            const bool islat = u < 16;
            const int nsteps = islat ? 1024 : 256;
            const int ch_w = F.wave >> 2, rgp = F.wave & 3;
#define CHAIN_DECODE(chl, seqbase, hd, dir, bidx) do { const int cid = (islat ? u * 2 : (u - 16) * 2) + (chl); \
                if (islat) { bidx = cid >> 4; hd = (cid >> 1) & 7; dir = cid & 1; seqbase = NCTX + bidx * 1024; } \
                else { bidx = cid >> 4; hd = (cid >> 1) & 7; dir = cid & 1; seqbase = bidx * 256; } } while (0)
            float st_[16];
            int myb, myh, myd, mybase; CHAIN_DECODE(ch_w, mybase, myh, myd, myb);
            const int row = rgp * 16 + (lane >> 2), kq = lane & 3;
            if (islat) {
                const float* s0 = p.in(7) + (size_t)(((myb * 2 + myd) * 8 + myh) * 64 + row) * 64 + kq * 16;
#pragma unroll
                for (int j = 0; j < 16; ++j) st_[j] = s0[j];
            } else {
#pragma unroll
                for (int j = 0; j < 16; ++j) st_[j] = 0.f;
            }
            float pre[4][6];
            const int nchunks = nsteps / SC_T;
#define SC_LOAD(chunk) do { _Pragma("unroll") for (int it = 0; it < 4; ++it) { const int item = it * NTHREADS + F.tid; const int chl = item >> 10, stp = (item >> 6) & 15, k = item & 63; \
                int b_, h_, d_, base_; CHAIN_DECODE(chl, base_, h_, d_, b_); const int j_ = (chunk) * SC_T + stp; const int tok = base_ + (d_ ? nsteps - 1 - j_ : j_); \
                const size_t o_ = (size_t)tok * 512 + h_ * 64 + k; const float a_ = AA[(size_t)d_ * NTOK * 512 + o_], kk_ = KK[o_], kr_ = KR[o_]; \
                pre[it][0] = DEC[(size_t)d_ * NTOK * 512 + o_]; pre[it][1] = kk_ * a_; pre[it][2] = kr_ * (1.0f + (a_ - 1.0f) * k_a[h_ * 64 + k]); pre[it][3] = kk_; pre[it][4] = RR[o_]; pre[it][5] = VV[o_]; } } while (0)
#define SC_WRITE(buf) do { _Pragma("unroll") for (int it = 0; it < 4; ++it) { const int item = it * NTHREADS + F.tid; const int chl = item >> 10, stp = (item >> 6) & 15, k = item & 63; \
                LAS float* d_ = sb + (buf) * SC_BUF + ((chl * SC_T + stp) * 6) * 64 + k; _Pragma("unroll") for (int q = 0; q < 6; ++q) d_[q * 64] = pre[it][q]; } } while (0)
            SC_LOAD(0); SC_WRITE(0);
            __syncthreads();
            for (int cnk = 0; cnk < nchunks; ++cnk) {
                if (cnk + 1 < nchunks) SC_LOAD(cnk + 1);
                const LAS float* bufp = sb + (cnk & 1) * SC_BUF + (ch_w * SC_T) * 6 * 64;
                for (int stp = 0; stp < SC_T; ++stp) {
                    const LAS float* v6 = bufp + stp * 6 * 64;
                    float w[16], kka[16], kd[16], kk[16], r[16];
#pragma unroll
                    for (int j4 = 0; j4 < 4; ++j4) {
                        const f32x4 a = *(const LAS f32x4*)(v6 + 0 * 64 + kq * 16 + j4 * 4), b = *(const LAS f32x4*)(v6 + 1 * 64 + kq * 16 + j4 * 4), c = *(const LAS f32x4*)(v6 + 2 * 64 + kq * 16 + j4 * 4),
                                    d = *(const LAS f32x4*)(v6 + 3 * 64 + kq * 16 + j4 * 4), e = *(const LAS f32x4*)(v6 + 4 * 64 + kq * 16 + j4 * 4);
#pragma unroll
                        for (int q = 0; q < 4; ++q) { w[j4 * 4 + q] = a[q]; kka[j4 * 4 + q] = b[q]; kd[j4 * 4 + q] = c[q]; kk[j4 * 4 + q] = d[q]; r[j4 * 4 + q] = e[q]; }
                    }
                    const float vrow = v6[5 * 64 + row];
                    float sa = 0.f;
#pragma unroll
                    for (int j = 0; j < 16; ++j) sa += st_[j] * kk[j];
                    sa += __shfl_xor(sa, 1); sa += __shfl_xor(sa, 2);
                    float y = 0.f;
#pragma unroll
                    for (int j = 0; j < 16; ++j) { st_[j] = st_[j] * w[j] + (vrow * kd[j] - sa * kka[j]); y += st_[j] * r[j]; }
                    y += __shfl_xor(y, 1); y += __shfl_xor(y, 2);
                    if (kq == 0) { const int j_ = cnk * SC_T + stp; const int tok = mybase + (myd ? nsteps - 1 - j_ : j_); YY[(size_t)myd * NTOK * 512 + (size_t)tok * 512 + myh * 64 + row] = y; }
                }
                if (cnk + 1 < nchunks) SC_WRITE((cnk + 1) & 1);
                __syncthreads();
            }
            if (!islat) {
                float* so = p.out() + OUT_SRWKV + (size_t)(((myb * 2 + myd) * 8 + myh) * 64 + row) * 64 + kq * 16;
#pragma unroll
                for (int j = 0; j < 16; ++j) so[j] = st_[j];
            }
#undef SC_LOAD
#undef SC_WRITE
#undef CHAIN_DECODE
        }
    }
}

__device__ void phase_l1_comb(const Frame& F, const PRef& p) {
    unsigned char* ws = p.ws();
    const float* RR = (const float*)(ws + WS_RR); const float* KR = (const float*)(ws + WS_KR); const float* VV = (const float*)(ws + WS_VV);
    const float* AA = (const float*)(ws + WS_AA); const float* GG = (const float*)(ws + WS_GG); const float* YY = (const float*)(ws + WS_YY);
    bf16_t* OB = (bf16_t*)(ws + WS_OB);
    const int nw = F.G * 8, lane = F.lane;
    for (int row = F.bid * 8 + F.wave; row < NTOK; row += nw) {
        const size_t o = (size_t)row * 512 + lane * 8;
        float y[8]; float ss = 0.f, bs = 0.f;
#pragma unroll
        for (int j = 0; j < 8; ++j) {
            y[j] = YY[o + j] + YY[(size_t)NTOK * 512 + o + j]; ss += y[j] * y[j];
            const float af = AA[o + j], ab = AA[(size_t)NTOK * 512 + o + j], ka = p.in(40)[lane * 8 + j];
            bs += RR[o + j] * p.in(41)[lane * 8 + j] * KR[o + j] * (2.0f + (af + ab - 2.0f) * ka);
        }
        ss += __shfl_xor(ss, 1); ss += __shfl_xor(ss, 2); ss += __shfl_xor(ss, 4);
        bs += __shfl_xor(bs, 1); bs += __shfl_xor(bs, 2); bs += __shfl_xor(bs, 4);
        const float rstd = rsqrtf(ss * (1.0f / 64.0f) + EPS);
        u32x4 w; float ov[8];
#pragma unroll
        for (int j = 0; j < 8; ++j) ov[j] = (y[j] * rstd * p.in(42)[lane * 8 + j] + bs * VV[o + j]) * GG[o + j];
        w.x = pack2(ov[0], ov[1]); w.y = pack2(ov[2], ov[3]); w.z = pack2(ov[4], ov[5]); w.w = pack2(ov[6], ov[7]);
        *(u32x4*)(OB + (size_t)row * 1024 + 512 + lane * 8) = w;
    }
}

constexpr int NPHASE = 25;
#ifndef PH_ONLY
#define PH_ONLY -1
#endif
#if ONE_LAUNCH
#define SEAM() xcd_barrier(bar)
#else
#define SEAM() do {} while (0)
#endif
#define IN(k) (lo <= (k) && (k) < hi && (PH_ONLY < 0 || (k) == PH_ONLY))
#define END(k) do { if (IN((k) + 1)) SEAM(); } while (0)

template <int l>
__device__ __forceinline__ void layer_phases(const Frame& F, const PRef& p, const int lo, const int hi, const XcdBarrier& bar) {
    constexpr int pb = 1 + l * 12;
    if (IN(pb + 0)) {
        unsigned char* ws = p.ws(); const float* ml = (const float*)(ws + WS_MOD) + (size_t)l * 3 * 6144;
        const float* xa = l == 0 ? p.in(0) : p.out(); const float* xb = l == 0 ? p.in(1) : p.out() + (size_t)NCTX * 1024;
        phase_norm(F, xa, xb, p.in(12) + l * 1024, ml + 1024, ml + 0, (bf16_t*)(ws + WS_HB)); END(pb + 0); }
    if (IN(pb + 1)) {
        unsigned char* ws = p.ws();
        if (l == 0) { GemmDesc g{(const bf16_t*)(ws + WS_HB), (const bf16_t*)(ws + WS_WAIN), 1024, 1024, NTOK, 2048, 1024}; EpiF32 E{(float*)(ws + WS_P0), 2048, 2048}; gemm_s(F, g, E, 0); }
        else { GemmDesc g{(const bf16_t*)(ws + WS_HB), (const bf16_t*)(ws + WS_WBIN), 1024, 1024, NTOK, 3584, 1024}; EpiF32 E{(float*)(ws + WS_P1), 3584, 3584}; gemm_s(F, g, E, 0); }
        END(pb + 1);
    }
    if (IN(pb + 2)) { if (l == 0) phase_l0_tok(F, p); else phase_l1_tok(F, p); END(pb + 2); }
    if (IN(pb + 3)) {
        unsigned char* ws = p.ws();
        if (l == 0) {
            { GemmDesc g{(const bf16_t*)(ws + WS_CQN), (const bf16_t*)(ws + WS_WUQ), 256, 256, NTOK, 768, 256}; EpiF32 E{(float*)(ws + WS_QRAW), 768, 768}; gemm_s(F, g, E, 0); }
            { GemmDesc g{(const bf16_t*)(ws + WS_CKVN), (const bf16_t*)(ws + WS_WUKV), 128, 128, NKROW, 1024, 128}; EpiF32 E{(float*)(ws + WS_KVRAW), 1024, 1024}; gemm_s(F, g, E, 48 * 6); }
        } else {
            const bf16_t* TW = (const bf16_t*)(ws + WS_TW); const bf16_t* AD = (const bf16_t*)(ws + WS_AD); const bf16_t* SG = (const bf16_t*)(ws + WS_SG);
            float* DEC = (float*)(ws + WS_DEC); float* AA = (float*)(ws + WS_AA);
            { GemmDesc g{TW, (const bf16_t*)(ws + WS_WWUP), 128, 64, NTOK, 512, 64}; EpiDecay E{DEC, p.in(34)}; gemm_s(F, g, E, 0); }
            { GemmDesc g{TW + 64, (const bf16_t*)(ws + WS_WWUP) + 512 * 64, 128, 64, NTOK, 512, 64}; EpiDecay E{DEC + (size_t)NTOK * 512, p.in(34) + 512}; gemm_s(F, g, E, 192); }
            { GemmDesc g{AD, (const bf16_t*)(ws + WS_WAUP), 128, 64, NTOK, 512, 64}; EpiSigm E{AA, p.in(36)}; gemm_s(F, g, E, 384); }
            { GemmDesc g{AD + 64, (const bf16_t*)(ws + WS_WAUP) + 512 * 64, 128, 64, NTOK, 512, 64}; EpiSigm E{AA + (size_t)NTOK * 512, p.in(36) + 512}; gemm_s(F, g, E, 576); }
            { GemmDesc g{SG, (const bf16_t*)(ws + WS_WGUP), 128, 128, NTOK, 512, 128}; EpiF32 E{(float*)(ws + WS_GG), 512, 512}; gemm_s(F, g, E, 768); }
        }
        END(pb + 3);
    }
    if (IN(pb + 4)) { if (l == 0) phase_l0_qkv(F, p); END(pb + 4); }
    if (IN(pb + 5)) { if (l == 0) phase_l0_mix(F, p); else phase_l1_mix(F, p); END(pb + 5); }
    if (IN(pb + 6)) { if (l == 1) phase_l1_comb(F, p); END(pb + 6); }
    if (IN(pb + 7)) {
        unsigned char* ws = p.ws(); const float* ml = (const float*)(ws + WS_MOD) + (size_t)l * 3 * 6144; float* xbuf = p.out();
        const float* xa = l == 0 ? p.in(0) : xbuf; const float* xb = l == 0 ? p.in(1) : xbuf + (size_t)NCTX * 1024;
        GemmDesc g{(const bf16_t*)(ws + WS_OB), (const bf16_t*)(ws + WS_WOUT) + (size_t)l * 1024 * 1024, 1024, 1024, NTOK, 1024, 1024};
        EpiResid E{xa, xb, xbuf, ml + 2048}; gemm_s(F, g, E, 0);
        END(pb + 7);
    }
    if (IN(pb + 8)) {
        unsigned char* ws = p.ws(); const float* ml = (const float*)(ws + WS_MOD) + (size_t)l * 3 * 6144; float* xbuf = p.out();
        phase_norm(F, xbuf, xbuf + (size_t)NCTX * 1024, p.in(13) + l * 1024, ml + 4096, ml + 3072, (bf16_t*)(ws + WS_HB)); END(pb + 8); }
    if (IN(pb + 9)) {
        unsigned char* ws = p.ws();
        GemmDesc g{(const bf16_t*)(ws + WS_HB), (const bf16_t*)(ws + WS_WUP) + (size_t)l * 5632 * 1024, 1024, 1024, NTOK, 5632, 1024};
        EpiBf16 E{(bf16_t*)(ws + WS_U), 5632, 5632}; gemm_s(F, g, E, 0);
        END(pb + 9);
    }
    if (IN(pb + 10)) { phase_gate(F, p, l); END(pb + 10); }
    if (IN(pb + 11)) {
        unsigned char* ws = p.ws(); const float* ml = (const float*)(ws + WS_MOD) + (size_t)l * 3 * 6144; float* xbuf = p.out();
        GemmDesc g{(const bf16_t*)(ws + WS_ACT), (const bf16_t*)(ws + WS_WDN) + (size_t)l * 1024 * 2816, 2816, 2816, NTOK, 1024, 2816};
        EpiResid E{xbuf, xbuf + (size_t)NCTX * 1024, xbuf, ml + 5120}; gemm_s(F, g, E, 0);
        END(pb + 11);
    }
}

__global__ void __launch_bounds__(NTHREADS, 2) fwd_kernel(Params kp) {
    extern __shared__ __attribute__((aligned(16))) unsigned char lds_raw[];
    Frame F;
    F.lds = (LAS unsigned char*)lds_raw + LDS_WORK;
    F.tid = threadIdx.x; F.lane = F.tid & 63; F.wave = __builtin_amdgcn_readfirstlane(F.tid >> 6); F.G = gridDim.x; F.bid = blockIdx.x;
    {
        LAS unsigned* pw = (LAS unsigned*)((LAS unsigned char*)lds_raw + 64);
        if (F.tid < (int)(sizeof(Params) / 4)) pw[F.tid] = ((const unsigned*)&kp)[F.tid];
        if (F.tid < 4) ((LAS unsigned*)((LAS unsigned char*)lds_raw))[F.tid] = 0u;
    }
    __syncthreads();
    PRef p; p.w = (const LAS unsigned*)((LAS unsigned char*)lds_raw + 64);
    const int lo = kp.ph_lo, hi = kp.ph_hi;
    XcdBarrier bar; bar.bar = nullptr; bar.x = 0; bar.st = nullptr;
#if ONE_LAUNCH
    bar = xcd_barrier_post((unsigned*)(p.ws() + WS_BAR), (volatile LAS unsigned*)((LAS unsigned char*)lds_raw));
#endif
    if (IN(0)) { phase_prep(F, p); END(0); }
    layer_phases<0>(F, p, lo, hi, bar);
    layer_phases<1>(F, p, lo, hi, bar);
}

extern "C" void kernel_launch(void* const* d_in, const int* in_sizes, int n_in, void* d_out, int out_size, void* d_ws, size_t ws_size, hipStream_t stream) {
    static int grid = 0;
    if (grid == 0) {
        if (n_in != 43 || (size_t)out_size != OUT_END || ws_size < WS_END) { fprintf(stderr, "kernel_launch: unexpected shapes: n_in %d out %d ws %zu (need %zu)\n", n_in, out_size, ws_size, (size_t)WS_END); grid = -1; return; }
        int dev = 0, cus = 0, per_cu = 0;
        if (hipGetDevice(&dev) != hipSuccess || hipDeviceGetAttribute(&cus, hipDeviceAttributeMultiprocessorCount, dev) != hipSuccess) { grid = -1; return; }
        if (hipFuncSetAttribute((const void*)fwd_kernel, hipFuncAttributeMaxDynamicSharedMemorySize, LDS_BYTES) != hipSuccess) { fprintf(stderr, "kernel_launch: hipFuncSetAttribute failed\n"); grid = -1; return; }
        if (hipOccupancyMaxActiveBlocksPerMultiprocessor(&per_cu, (const void*)fwd_kernel, NTHREADS, LDS_BYTES) != hipSuccess || per_cu < 1) { fprintf(stderr, "kernel_launch: occupancy query says %d blocks per CU\n", per_cu); grid = -1; (void)hipGetLastError(); return; }
        grid = cus;
    }
    if (grid < 0) return;
    Params p{};
    for (int i = 0; i < 43; ++i) p.in[i] = (const float*)d_in[i];
    p.out = (float*)d_out; p.ws = (unsigned char*)d_ws;
#if ONE_LAUNCH
    (void)hipMemsetAsync((char*)d_ws + WS_BAR, 0, XCD_BAR_WORDS * 4, stream);
    p.ph_lo = 0; p.ph_hi = NPHASE;
    void* args[] = {&p};
    hipError_t e = hipLaunchCooperativeKernel((const void*)fwd_kernel, dim3(grid), dim3(NTHREADS), args, LDS_BYTES, stream);
    if (e != hipSuccess) fprintf(stderr, "cooperative launch failed: %s (grid %d)\n", hipGetErrorString(e), grid);
#else
    for (int ph = 0; ph < NPHASE; ++ph) {
        p.ph_lo = ph; p.ph_hi = ph + 1;
        hipLaunchKernelGGL(fwd_kernel, dim3(grid), dim3(NTHREADS), LDS_BYTES, stream, p);
    }
#endif
}
```

```cpp
#include <hip/hip_runtime.h>
#include <cstdio>
#include <cstdint>

#define LAS __attribute__((address_space(3)))
typedef unsigned short bf16_t;
typedef short bf16x8 __attribute__((ext_vector_type(8)));
typedef short bf16x4 __attribute__((ext_vector_type(4)));
typedef float f32x4 __attribute__((ext_vector_type(4)));
typedef float f32x2 __attribute__((ext_vector_type(2)));
typedef unsigned u32x2 __attribute__((ext_vector_type(2)));
typedef unsigned u32x4 __attribute__((ext_vector_type(4)));

#define REP_MASK 0u
#define ATT_REP 0
#define SCAN_REP 0
#ifndef CHUNKED_SCAN
#define CHUNKED_SCAN 1
#endif
#ifndef ONE_LAUNCH
#define ONE_LAUNCH 1
#endif

constexpr int NTHREADS = 512;
constexpr int LDS_BYTES = 144 * 1024;
constexpr int LDS_WORK = 1024;
constexpr int DM = 1024, NCTX = 4096, NLAT = 2048, NTOK = 6144, NKROW = 7168, DFF = 2816;
constexpr float EPS = 1e-6f;

constexpr size_t al256(size_t x) { return (x + 255) & ~(size_t)255; }
constexpr size_t WS_BAR = 0;
constexpr size_t WS_MOD = WS_BAR + 16384;
constexpr size_t WS_WAIN = al256(WS_MOD + 2 * 3 * 6144 * 4);
constexpr size_t WS_WUQ = WS_WAIN + (size_t)2048 * 1024 * 2;
constexpr size_t WS_WUKV = WS_WUQ + (size_t)768 * 256 * 2;
constexpr size_t WS_WOUT = WS_WUKV + (size_t)1024 * 128 * 2;
constexpr size_t WS_WUP = WS_WOUT + (size_t)2 * 1024 * 1024 * 2;
constexpr size_t WS_WDN = WS_WUP + (size_t)2 * 5632 * 1024 * 2;
constexpr size_t WS_WBIN = WS_WDN + (size_t)2 * 1024 * 2816 * 2;
constexpr size_t WS_WWUP = WS_WBIN + (size_t)3584 * 1024 * 2;
constexpr size_t WS_WAUP = WS_WWUP + (size_t)2 * 512 * 64 * 2;
constexpr size_t WS_WGUP = WS_WAUP + (size_t)2 * 512 * 64 * 2;
constexpr size_t WS_HB = WS_WGUP + (size_t)512 * 128 * 2;
constexpr size_t WS_OB = WS_HB + (size_t)NTOK * 1024 * 2;
constexpr size_t WS_BIG = WS_OB + (size_t)NTOK * 1024 * 2;
constexpr size_t WS_P0 = WS_BIG;
constexpr size_t WS_CQN = WS_P0 + (size_t)NTOK * 2048 * 4;
constexpr size_t WS_CKVN = WS_CQN + (size_t)NTOK * 256 * 2;
constexpr size_t WS_QRAW = WS_CKVN + (size_t)NKROW * 128 * 2;
constexpr size_t WS_KVRAW = WS_QRAW + (size_t)NTOK * 768 * 4;
constexpr size_t WS_Q0 = WS_KVRAW + (size_t)NKROW * 1024 * 4;
constexpr size_t WS_K0 = WS_Q0 + (size_t)NTOK * 768 * 2;
constexpr size_t WS_VT0 = WS_K0 + (size_t)NKROW * 768 * 2;
constexpr size_t WS_KVS = WS_VT0 + (size_t)NKROW * 512 * 2;
constexpr size_t WS_L0END = WS_KVS + (size_t)384 * 2 * 8192 * 4;
constexpr size_t WS_U = WS_BIG;
constexpr size_t WS_ACT = WS_U + (size_t)NTOK * 5632 * 2;
constexpr size_t WS_FFNEND = WS_ACT + (size_t)NTOK * 2816 * 2;
constexpr size_t WS_P1 = WS_BIG;
constexpr size_t WS_DEC = WS_BIG;
constexpr size_t WS_AA = WS_DEC + (size_t)2 * NTOK * 512 * 4;
constexpr size_t WS_GG = WS_AA + (size_t)2 * NTOK * 512 * 4;
constexpr size_t WS_YY = WS_GG + (size_t)NTOK * 512 * 4;
constexpr size_t WS_QD = WS_P1 + (size_t)NTOK * 3584 * 4;
constexpr size_t WS_KD = WS_QD + (size_t)NTOK * 512 * 2;
constexpr size_t WS_VDT = WS_KD + (size_t)NKROW * 512 * 2;
constexpr size_t WS_RR = WS_VDT + (size_t)NKROW * 512 * 2;
constexpr size_t WS_KR = WS_RR + (size_t)NTOK * 512 * 4;
constexpr size_t WS_VV = WS_KR + (size_t)NTOK * 512 * 4;
constexpr size_t WS_KK = WS_VV + (size_t)NTOK * 512 * 4;
constexpr size_t WS_TW = WS_KK + (size_t)NTOK * 512 * 4;
constexpr size_t WS_AD = WS_TW + (size_t)NTOK * 128 * 2;
constexpr size_t WS_SG = WS_AD + (size_t)NTOK * 128 * 2;
constexpr size_t WS_DO = WS_SG + (size_t)NTOK * 128 * 2;
constexpr size_t WS_BON = WS_DO + (size_t)NTOK * 1024 * 2;
constexpr size_t WS_L1END = WS_BON + (size_t)2 * NTOK * 8 * 4;
constexpr size_t cmax(size_t a, size_t b) { return a > b ? a : b; }
constexpr size_t WS_END = cmax(cmax(WS_L0END, WS_FFNEND), WS_L1END);
static_assert(WS_YY + (size_t)2 * NTOK * 512 * 4 <= WS_QD, "layer-1 overlay");
static_assert(WS_END <= (size_t)256 * 1024 * 1024, "workspace exceeds 256 MiB");

constexpr size_t OUT_X = 0;
constexpr size_t OUT_CKV = (size_t)NTOK * 1024;
constexpr size_t OUT_KROPE = OUT_CKV + (size_t)NCTX * 128;
constexpr size_t OUT_SRET = OUT_KROPE + (size_t)NCTX * 32;
constexpr size_t OUT_DK = OUT_SRET + (size_t)16 * 2 * 4 * 8192;
constexpr size_t OUT_DV = OUT_DK + (size_t)NCTX * 512;
constexpr size_t OUT_SRWKV = OUT_DV + (size_t)NCTX * 512;
constexpr size_t OUT_END = OUT_SRWKV + (size_t)16 * 2 * 8 * 4096;

struct Params {
    const float* in[43];
    float* out;
    unsigned char* ws;
    int ph_lo, ph_hi;
};

struct PRef {
    const LAS unsigned* w;
    __device__ __forceinline__ unsigned long long q(int i) const {
        const unsigned lo = (unsigned)__builtin_amdgcn_readfirstlane((int)w[2 * i]), hi = (unsigned)__builtin_amdgcn_readfirstlane((int)w[2 * i + 1]);
        return ((unsigned long long)hi << 32) | lo; }
    __device__ __forceinline__ const float* in(int k) const { return (const float*)(const __attribute__((address_space(1))) float*)q(k); }
    __device__ __forceinline__ float* out() const { return (float*)(__attribute__((address_space(1))) float*)q(43); }
    __device__ __forceinline__ unsigned char* ws() const { return (unsigned char*)(__attribute__((address_space(1))) unsigned char*)q(44); }
};

typedef __bf16 hwbf16x2 __attribute__((ext_vector_type(2)));
__device__ __forceinline__ unsigned pack2(float a, float b) { const f32x2 v = (f32x2){a, b}; return __builtin_bit_cast(unsigned, __builtin_convertvector(v, hwbf16x2)); }
__device__ __forceinline__ bf16_t f2bf(float f) { return (bf16_t)(pack2(f, 0.f) & 0xffffu); }
__device__ __forceinline__ float bf2f(unsigned b) { return __uint_as_float(b << 16); }
#define RDLANE(x, l) __int_as_float(__builtin_amdgcn_readlane(__float_as_int(x), (l)))
#define DPPF(x, ctrl) __int_as_float(__builtin_amdgcn_update_dpp(0, __float_as_int(x), (ctrl), 0xF, 0xF, true))
__device__ __forceinline__ float row16_sum(float v) {
    v += DPPF(v, 0xB1); v += DPPF(v, 0x4E); v += DPPF(v, 0x141); v += DPPF(v, 0x140); return v; }
__device__ __forceinline__ float oct_sum(float v) {
    v += DPPF(v, 0xB1); v += DPPF(v, 0x4E); v += DPPF(v, 0x141); return v; }
__device__ __forceinline__ float wave_sum(float v) {
    v = row16_sum(v);
    return (RDLANE(v, 0) + RDLANE(v, 16)) + (RDLANE(v, 32) + RDLANE(v, 48));
}
__device__ __forceinline__ float half_sum(float v, int lane) {
    v = row16_sum(v);
    const float a = RDLANE(v, 0) + RDLANE(v, 16), b = RDLANE(v, 32) + RDLANE(v, 48);
    return lane < 32 ? a : b;
}
__device__ __forceinline__ float sigmoidf_(float x) { return 1.0f / (1.0f + __expf(-x)); }
__device__ __forceinline__ float siluf_(float x) { return x * sigmoidf_(x); }
__device__ __forceinline__ float tanhf_(float x) { return 1.0f - 2.0f / (__expf(2.0f * x) + 1.0f); }
__device__ __forceinline__ int cond_of(int row) { return row < NCTX ? 0 : 1 + ((row - NCTX) >> 10); }

#define XB_TMO      128
#define XB_XCNT(j)  (256  + 64 * (j))
#define XB_XSUB(j)  (1280 + 64 * (j))
#define XB_XGEN(j)  (2304 + 64 * (j))
#define XB_TOP      3328
#define XB_TOPGEN   3392
#define XCD_BAR_WORDS 3456
#define XB_SPIN_CAP (1u << 20)
__device__ __forceinline__ unsigned xb_ld(unsigned* p) { return __hip_atomic_load(p, __ATOMIC_RELAXED, __HIP_MEMORY_SCOPE_AGENT); }
__device__ __forceinline__ unsigned xb_add(unsigned* p, unsigned v) { return __hip_atomic_fetch_add(p, v, __ATOMIC_RELAXED, __HIP_MEMORY_SCOPE_AGENT); }
__device__ __forceinline__ unsigned xb_xcc_id() { return (unsigned)__builtin_amdgcn_s_getreg((3 << 11) | 20) & 0xFu; }
#define XB_SPIN(cond, bar) do { unsigned _sp = 0; while (cond) { __builtin_amdgcn_s_sleep(1); \
    if ((++_sp & 255u) == 0u) { if (xb_ld(&(bar)[XB_TMO])) break; if (_sp > XB_SPIN_CAP) { atomicAdd(&(bar)[XB_TMO], 1u); break; } } } } while (0)
struct XcdBarrier { unsigned* bar; unsigned x; volatile LAS unsigned* st; };
__device__ __forceinline__ XcdBarrier xcd_barrier_post(unsigned* bar, volatile LAS unsigned* st) {
    XcdBarrier b; b.bar = bar; b.x = xb_xcc_id(); b.st = st;
    if (threadIdx.x == 0) (void)xb_add(&bar[XB_XCNT(b.x)], 1u);
    return b;
}
__device__ __forceinline__ void xcd_barrier_complete(unsigned* bar, unsigned x, unsigned& nloc, unsigned& nx) {
    const unsigned G = gridDim.x * gridDim.y * gridDim.z;
    unsigned sum, cnt, mine, sp = 0u;
    for (;;) {
        sum = 0u; cnt = 0u; mine = 0u;
#pragma unroll
        for (unsigned j = 0; j < 16; ++j) { const unsigned c = xb_ld(&bar[XB_XCNT(j)]); sum += c; cnt += (c > 0u) ? 1u : 0u; mine = (j == x) ? c : mine; }
        if (sum == G) break;
        __builtin_amdgcn_s_sleep(1);
        if ((++sp & 255u) == 0u) { if (xb_ld(&bar[XB_TMO])) break; if (sp > XB_SPIN_CAP) { atomicAdd(&bar[XB_TMO], 1u); break; } }
    }
    nloc = mine > 0u ? mine : 1u; nx = cnt > 0u ? cnt : 1u;
}
__device__ __forceinline__ void xcd_barrier(const XcdBarrier& b) {
    asm volatile("s_waitcnt vmcnt(0)" ::: "memory");
    __syncthreads();
    if (threadIdx.x == 0) {
        unsigned* bar = b.bar;
        __builtin_amdgcn_s_waitcnt(0);
        unsigned nloc = b.st[0], nx = b.st[1];
        if (nloc == 0u) { xcd_barrier_complete(bar, b.x, nloc, nx); b.st[0] = nloc; b.st[1] = nx; }
        const unsigned old = xb_add(&bar[XB_XSUB(b.x)], 1u);
        const unsigned gen = old / nloc;
        if (old + 1u == (gen + 1u) * nloc) {
            __builtin_amdgcn_fence(__ATOMIC_RELEASE, "agent");
            asm volatile("s_waitcnt vmcnt(0)" ::: "memory");
            const unsigned og = xb_add(&bar[XB_TOP], 1u);
            const unsigned tg = og / nx;
            if (og + 1u == (tg + 1u) * nx) xb_add(&bar[XB_TOPGEN], 1u);
            else XB_SPIN(xb_ld(&bar[XB_TOPGEN]) == tg, bar);
            __builtin_amdgcn_fence(__ATOMIC_ACQUIRE, "agent");
            xb_add(&bar[XB_XGEN(b.x)], 1u);
            asm volatile("s_waitcnt vmcnt(0)" ::: "memory");
        } else {
            XB_SPIN(xb_ld(&bar[XB_XGEN(b.x)]) == gen, bar);
            __builtin_amdgcn_fence(__ATOMIC_ACQUIRE, "agent");
            asm volatile("s_waitcnt vmcnt(0)" ::: "memory");
        }
    }
    __syncthreads();
}

struct Frame {
    LAS unsigned char* lds;
    int tid, lane, wave, G, bid;
};
#define FOR_UNITS(u, n, rot) for (int u = (int)((F.bid + F.G - ((rot) % F.G)) % F.G); u < (n); u += F.G)

__device__ __forceinline__ int lds_byte(int r, int c) { const int st = (r >> 4) * 2 + (c >> 5), rr = r & 15, cc = c & 31, ob = rr * 64 + cc * 2; return st * 1024 + (ob ^ (((ob >> 9) & 1) << 5)); }
__device__ __forceinline__ void stage_rc(int b, int& R, int& C) { const int st = b / 1024, sb = b % 1024, swz = sb ^ (((sb >> 9) & 1) << 5); R = (st >> 1) * 16 + swz / 64; C = (st & 1) * 32 + (swz % 64) / 2; }

struct GemmDesc { const bf16_t* A; const bf16_t* Bt; int lda, ldb, M, N, K; };

typedef unsigned u32x4v __attribute__((ext_vector_type(4)));
__device__ __forceinline__ __amdgpu_buffer_rsrc_t wt_rsrc(void* base, size_t bytes) { return __builtin_amdgcn_make_buffer_rsrc(base, 0, (int)bytes, 0x00020000); }
__device__ __forceinline__ void wt_store16(const __amdgpu_buffer_rsrc_t r, size_t byte_off, u32x4 v) { __builtin_amdgcn_raw_buffer_store_b128(v, r, (int)byte_off, 0, 16); }
struct EpiF32 { float* C; int ldc, ncols;
    __device__ __forceinline__ void operator()(int r, int c, f32x4 v, int ks = 0) const { if (c < ncols) *(f32x4*)(C + (size_t)r * ldc + c) = v; } };
struct EpiF32WT { __amdgpu_buffer_rsrc_t R; int ldc;
    __device__ __forceinline__ void operator()(int r, int c, f32x4 v, int ks = 0) const { wt_store16(R, ((size_t)r * ldc + c) * 4, __builtin_bit_cast(u32x4, v)); } };
struct EpiBf16 { bf16_t* C; int ldc, ncols;
    __device__ __forceinline__ void e8(int r, int c, f32x4 v0, f32x4 v1, int ks = 0) const { u32x4 w; w.x = pack2(v0[0], v0[1]); w.y = pack2(v0[2], v0[3]); w.z = pack2(v1[0], v1[1]); w.w = pack2(v1[2], v1[3]); *(u32x4*)(C + (size_t)r * ldc + c) = w; }
    __device__ __forceinline__ void operator()(int r, int c, f32x4 v, int ks = 0) const { if (c < ncols) { u32x2 w; w.x = pack2(v[0], v[1]); w.y = pack2(v[2], v[3]); *(u32x2*)(C + (size_t)r * ldc + c) = w; } } };
struct EpiPart { bf16_t* C; size_t kstride;
    __device__ __forceinline__ void e8(int r, int c, f32x4 v0, f32x4 v1, int ks) const { u32x4 w; w.x = pack2(v0[0], v0[1]); w.y = pack2(v0[2], v0[3]); w.z = pack2(v1[0], v1[1]); w.w = pack2(v1[2], v1[3]);
        *(u32x4*)(C + (size_t)ks * kstride + (size_t)r * 1024 + c) = w; } };
struct EpiBf16WT { __amdgpu_buffer_rsrc_t R; int ldc;
    __device__ __forceinline__ void e8(int r, int c, f32x4 v0, f32x4 v1, int ks = 0) const { u32x4 w; w.x = pack2(v0[0], v0[1]); w.y = pack2(v0[2], v0[3]); w.z = pack2(v1[0], v1[1]); w.w = pack2(v1[2], v1[3]);
        wt_store16(R, ((size_t)r * ldc + c) * 2, w); } };
struct EpiPartWT { __amdgpu_buffer_rsrc_t R; size_t kstride;
    __device__ __forceinline__ void e8(int r, int c, f32x4 v0, f32x4 v1, int ks) const { u32x4 w; w.x = pack2(v0[0], v0[1]); w.y = pack2(v0[2], v0[3]); w.z = pack2(v1[0], v1[1]); w.w = pack2(v1[2], v1[3]);
        wt_store16(R, ((size_t)ks * kstride + (size_t)r * 1024 + c) * 2, w); } };
struct EpiResid { const float* xa; const float* xb; float* xo; const float* gate;
    __device__ __forceinline__ void operator()(int r, int c, f32x4 v, int ks = 0) const {
        const float* xs = r < NCTX ? xa + (size_t)r * 1024 : xb + (size_t)(r - NCTX) * 1024;
        const f32x4 x = *(const f32x4*)(xs + c); const f32x4 g = *(const f32x4*)(gate + cond_of(r) * 6144 + c);
        *(f32x4*)(xo + (size_t)r * 1024 + c) = x + g * v; } };
struct EpiDecay { float* C; const float* w0;
    __device__ __forceinline__ void operator()(int r, int c, f32x4 v, int ks = 0) const { const f32x4 b = *(const f32x4*)(w0 + c); f32x4 o;
#pragma unroll
        for (int j = 0; j < 4; ++j) o[j] = __expf(-0.60653065971f * sigmoidf_(b[j] + v[j]));
        *(f32x4*)(C + (size_t)r * 512 + c) = o; } };
struct EpiSigm { float* C; const float* a0;
    __device__ __forceinline__ void operator()(int r, int c, f32x4 v, int ks = 0) const { const f32x4 b = *(const f32x4*)(a0 + c); f32x4 o;
#pragma unroll
        for (int j = 0; j < 4; ++j) o[j] = sigmoidf_(b[j] + v[j]);
        *(f32x4*)(C + (size_t)r * 512 + c) = o; } };

template <class Epi>
__device__ __forceinline__ void gemm_s(const Frame& F, const GemmDesc g, const Epi& E, int rot, int ufirst = -1, int ustep = 0, int ulast = 0) {
    LAS unsigned char* lds = F.lds;
    const int tid = F.tid, wid = F.wave, lane = F.lane, wr = wid >> 2, wc = wid & 3, fr = lane & 15, fq = lane >> 4;
    const int nM = g.M / 128, nN = g.N / 128, nU = nM * nN, nt = g.K / 64;
    int R0, C0, R1, C1; stage_rc(tid * 16, R0, C0); stage_rc(tid * 16 + 8192, R1, C1);
    const int aoff = lds_byte(wr * 64 + fr, fq * 8), boff = lds_byte(wc * 32 + fr, fq * 8);
    const unsigned ldsw = (unsigned)wid * 1024u;
#define GS_STAGE(buf, t) do { \
        __builtin_amdgcn_global_load_lds((const unsigned*)(Ag + (size_t)R0 * g.lda + (t) * 64 + C0), (LAS unsigned*)(lds + (buf) * 32768 + ldsw), 16, 0, 0); \
        __builtin_amdgcn_global_load_lds((const unsigned*)(Ag + (size_t)R1 * g.lda + (t) * 64 + C1), (LAS unsigned*)(lds + (buf) * 32768 + ldsw + 8192), 16, 0, 0); \
        __builtin_amdgcn_global_load_lds((const unsigned*)(Bg + (size_t)R0 * g.ldb + (t) * 64 + C0), (LAS unsigned*)(lds + (buf) * 32768 + 16384 + ldsw), 16, 0, 0); \
        __builtin_amdgcn_global_load_lds((const unsigned*)(Bg + (size_t)R1 * g.ldb + (t) * 64 + C1), (LAS unsigned*)(lds + (buf) * 32768 + 16384 + ldsw + 8192), 16, 0, 0); } while (0)
    const int u0 = ufirst >= 0 ? ufirst : (int)((F.bid + F.G - (rot % F.G)) % F.G), us = ufirst >= 0 ? ustep : F.G, ue = ufirst >= 0 ? ulast : nU;
    for (int u = u0; u < ue; u += us) {
        const int pm = u % nM, pn = u / nM;
        const bf16_t* Ag = g.A + (size_t)(pm * 128) * g.lda; const bf16_t* Bg = g.Bt + (size_t)(pn * 128) * g.ldb;
        f32x4 acc[4][2];
#pragma unroll
        for (int m = 0; m < 4; ++m)
#pragma unroll
            for (int n = 0; n < 2; ++n) acc[m][n] = (f32x4){0.f, 0.f, 0.f, 0.f};
        GS_STAGE(0, 0);
        if (nt > 1) GS_STAGE(1, 1);
        int b = 0, bn = 2;
        for (int t = 0; t < nt; ++t) {
            if (t + 2 < nt) { GS_STAGE(bn, t + 2); asm volatile("s_waitcnt vmcnt(8)" ::: "memory"); }
            else if (t + 1 < nt) asm volatile("s_waitcnt vmcnt(4)" ::: "memory");
            else asm volatile("s_waitcnt vmcnt(0)" ::: "memory");
            __builtin_amdgcn_s_barrier(); asm volatile("" ::: "memory");
            bf16x8 Af[4][2], Bf[2][2];
#pragma unroll
            for (int m = 0; m < 4; ++m)
#pragma unroll
                for (int k = 0; k < 2; ++k) Af[m][k] = *(const LAS bf16x8*)(lds + b * 32768 + aoff + m * 2048 + k * 1024);
#pragma unroll
            for (int n = 0; n < 2; ++n)
#pragma unroll
                for (int k = 0; k < 2; ++k) Bf[n][k] = *(const LAS bf16x8*)(lds + b * 32768 + 16384 + boff + n * 2048 + k * 1024);
#pragma unroll
            for (int k = 0; k < 2; ++k)
#pragma unroll
                for (int m = 0; m < 4; ++m)
#pragma unroll
                    for (int n = 0; n < 2; ++n) acc[m][n] = __builtin_amdgcn_mfma_f32_16x16x32_bf16(Bf[n][k], Af[m][k], acc[m][n], 0, 0, 0);
            asm volatile("s_waitcnt lgkmcnt(0)" ::: "memory");
            __builtin_amdgcn_s_barrier(); asm volatile("" ::: "memory");
            b = b == 2 ? 0 : b + 1; bn = bn == 2 ? 0 : bn + 1;
        }
#pragma unroll
        for (int m = 0; m < 4; ++m)
#pragma unroll
            for (int n = 0; n < 2; ++n) E(pm * 128 + wr * 64 + m * 16 + fr, pn * 128 + wc * 32 + n * 16 + 4 * fq, acc[m][n]);
    }
#undef GS_STAGE
}

constexpr int HTB = 128 * 64 * 2;
struct BigDesc { const bf16_t* A; const bf16_t* Bt; int lda, ldb, nM, nN, nKS, Ksp; };
struct BUnit { int pm, pn, ks; };
__device__ __forceinline__ bool big_next(const BigDesc& g, int i, int G, int c, BUnit& u) {
    const int nNp = g.nN * g.nKS, nwg = g.nM * nNp;
    const long L = (long)i * G + c; if (L >= nwg) return false;
    int wgid = (int)L; { const int q = nwg / 8, r = nwg % 8, xcd = wgid % 8, off = wgid / 8; wgid = (xcd < r ? xcd * (q + 1) : r * (q + 1) + (xcd - r) * q) + off; }
    const int nig = 8 * nNp, gid = wgid / nig, fm = gid * 8, gsz = (g.nM - fm) < 8 ? (g.nM - fm) : 8;
    u.pm = fm + ((wgid % nig) % gsz); const int pnp = (wgid % nig) / gsz; u.pn = pnp / g.nKS; u.ks = pnp % g.nKS; return true;
}
__device__ __forceinline__ int perm32(int rho) { const int n = rho >> 4, i = rho & 15; return 8 * (i >> 2) + 4 * n + (i & 3); }
template <bool PERM, class Epi>
__device__ __forceinline__ void gemm_big(const Frame& F, const BigDesc g, const Epi& E) {
    LAS unsigned char* lds = F.lds;
    const int tid = F.tid, wid = F.wave, lane = F.lane, wr = wid >> 2, wc = wid & 3, fr = lane & 15, fq = lane >> 4;
    const int nt = g.Ksp / 64;
    unsigned voffA[2], voffB[2];
#pragma unroll
    for (int i = 0; i < 2; ++i) { int R, C; stage_rc(tid * 16 + i * 8192, R, C); const int Rb = PERM ? ((R & ~31) + perm32(R & 31)) : R; voffA[i] = (unsigned)(R * g.lda + C) * 2u; voffB[i] = (unsigned)(Rb * g.ldb + C) * 2u; }
    const size_t kstep = (size_t)(64 * 2);
    const size_t hstepA = (size_t)128 * g.lda * 2, hstepB = (size_t)128 * g.ldb * 2;
    const unsigned ldsw = (unsigned)wid * 1024u;
    const int aoff = lds_byte(wr * 64 + fr, fq * 8), boff = lds_byte(wc * 32 + fr, fq * 8);
#define PG8_SA(b, h) (((b) * 2 + (h)) * HTB)
#define PG8_SB(b, h) ((4 + (b) * 2 + (h)) * HTB)
#define PG8_STAGE(bufoff, gbase, voff) do { _Pragma("unroll") for (int _i = 0; _i < 2; ++_i) \
        __builtin_amdgcn_global_load_lds((const unsigned*)((const char*)(gbase) + (voff)[_i]), (LAS unsigned*)(lds + (bufoff) + ldsw + _i * 8192), 16, 0, 0); } while (0)
#define PG8_LDA(dst, b, h) do { _Pragma("unroll") for (int m = 0; m < 4; ++m) _Pragma("unroll") for (int k = 0; k < 2; ++k) dst[m][k] = *(const LAS bf16x8*)(lds + PG8_SA(b, h) + aoff + m * 2048 + k * 1024); } while (0)
#define PG8_LDB(dst, b, h) do { _Pragma("unroll") for (int n = 0; n < 2; ++n) _Pragma("unroll") for (int k = 0; k < 2; ++k) dst[n][k] = *(const LAS bf16x8*)(lds + PG8_SB(b, h) + boff + n * 2048 + k * 1024); } while (0)
#define PG8_MMA(ai, bj, At, Bt) do { __builtin_amdgcn_s_setprio(1); _Pragma("unroll") for (int m = 0; m < 4; ++m) _Pragma("unroll") for (int n = 0; n < 2; ++n) _Pragma("unroll") for (int k = 0; k < 2; ++k) \
        acc[ai][bj][m][n] = __builtin_amdgcn_mfma_f32_16x16x32_bf16(Bt[n][k], At[m][k], acc[ai][bj][m][n], 0, 0, 0); __builtin_amdgcn_s_setprio(0); } while (0)
#define PG8_WAIT_V(n) asm volatile("s_waitcnt vmcnt(" #n ")" ::: "memory")
#define PG8_WAIT_L(n) asm volatile("s_waitcnt lgkmcnt(" #n ")" ::: "memory")
#define PG8_BAR __builtin_amdgcn_s_barrier()
#define PG8_SCHED __builtin_amdgcn_sched_barrier(0)
#define PG8_UA(u) ((const char*)g.A + (size_t)(u).pm * 2 * hstepA + (size_t)(u).ks * g.Ksp * 2)
#define PG8_UB(u) ((const char*)g.Bt + (size_t)(u).pn * 2 * hstepB + (size_t)(u).ks * g.Ksp * 2)
    BUnit cur, nxt; int ui = 0;
    if (!big_next(g, 0, F.G, F.bid, cur)) return;
    f32x4 acc[2][2][4][2];
#pragma unroll
    for (int a = 0; a < 2; ++a)
#pragma unroll
        for (int b = 0; b < 2; ++b)
#pragma unroll
            for (int m = 0; m < 4; ++m)
#pragma unroll
                for (int n = 0; n < 2; ++n) acc[a][b][m][n] = (f32x4){0.f, 0.f, 0.f, 0.f};
    bf16x8 At[4][2], B0[2][2], B1[2][2];
    const char* cA = PG8_UA(cur); const char* cB = PG8_UB(cur);
    PG8_STAGE(PG8_SB(0, 0), cB, voffB); PG8_STAGE(PG8_SB(0, 1), cB + hstepB, voffB); PG8_STAGE(PG8_SA(0, 0), cA, voffA); PG8_STAGE(PG8_SA(0, 1), cA + hstepA, voffA);
    if (wr == 1) PG8_BAR;
    PG8_WAIT_V(2); PG8_BAR;
    PG8_STAGE(PG8_SB(1, 0), cB + kstep, voffB); PG8_STAGE(PG8_SA(1, 0), cA + kstep, voffA); PG8_STAGE(PG8_SB(1, 1), cB + hstepB + kstep, voffB);
    PG8_WAIT_V(6); PG8_BAR;
    for (;;) {
        const bool has_next = big_next(g, ui + 1, F.G, F.bid, nxt);
        const char* nA = has_next ? PG8_UA(nxt) : cA; const char* nB = has_next ? PG8_UB(nxt) : cB;
        for (int t = 0; t < nt; t += 2) {
            const bool last = (t == nt - 2);
            const char* a1 = cA + (size_t)(t + 1) * kstep;
            const char* a2 = last ? nA : cA + (size_t)(t + 2) * kstep; const char* b2 = last ? nB : cB + (size_t)(t + 2) * kstep;
            const char* a3 = a2 + kstep; const char* b3 = b2 + kstep;
            PG8_LDB(B0, 0, 0); PG8_LDB(B1, 0, 1); PG8_SCHED; PG8_LDA(At, 0, 0); PG8_STAGE(PG8_SA(1, 1), a1 + hstepA, voffA);
            PG8_WAIT_V(8); PG8_WAIT_L(0); PG8_BAR; PG8_MMA(0, 0, At, B0); PG8_MMA(0, 1, At, B1); PG8_BAR; PG8_SCHED;
            PG8_LDA(At, 0, 1); PG8_STAGE(PG8_SB(0, 0), b2, voffB); PG8_STAGE(PG8_SB(0, 1), b2 + hstepB, voffB); PG8_STAGE(PG8_SA(0, 0), a2, voffA);
            PG8_WAIT_V(8); PG8_WAIT_L(0); PG8_BAR; PG8_MMA(1, 0, At, B0); PG8_MMA(1, 1, At, B1); PG8_BAR; PG8_SCHED;
            PG8_LDB(B0, 1, 0); PG8_LDB(B1, 1, 1); PG8_SCHED; PG8_LDA(At, 1, 0); PG8_STAGE(PG8_SA(0, 1), a2 + hstepA, voffA);
            PG8_WAIT_V(8); PG8_WAIT_L(0); PG8_BAR; PG8_MMA(0, 0, At, B0); PG8_MMA(0, 1, At, B1); PG8_BAR; PG8_SCHED;
            PG8_LDA(At, 1, 1); PG8_STAGE(PG8_SB(1, 0), b3, voffB); PG8_STAGE(PG8_SB(1, 1), b3 + hstepB, voffB); PG8_STAGE(PG8_SA(1, 0), a3, voffA);
            PG8_WAIT_V(8); PG8_WAIT_L(0); PG8_BAR; PG8_MMA(1, 0, At, B0); PG8_MMA(1, 1, At, B1); PG8_BAR; PG8_SCHED;
        }
        if (wr == 0) PG8_BAR;
        {
            const int row0 = cur.pm * 256 + wr * 64 + fr, col0 = cur.pn * 256 + wc * 32 + (PERM ? 8 : 4) * fq;
#pragma unroll
            for (int ai = 0; ai < 2; ++ai)
#pragma unroll
                for (int m = 0; m < 4; ++m)
#pragma unroll
                    for (int bj = 0; bj < 2; ++bj) {
                        if constexpr (PERM) E.e8(row0 + ai * 128 + m * 16, col0 + bj * 128, acc[ai][bj][m][0], acc[ai][bj][m][1], cur.ks);
                        else {
#pragma unroll
                            for (int n = 0; n < 2; ++n) E(row0 + ai * 128 + m * 16, col0 + bj * 128 + n * 16, acc[ai][bj][m][n], cur.ks);
                        }
                    }
        }
        if (!has_next) break;
#pragma unroll
        for (int a = 0; a < 2; ++a)
#pragma unroll
            for (int b = 0; b < 2; ++b)
#pragma unroll
                for (int m = 0; m < 4; ++m)
#pragma unroll
                    for (int n = 0; n < 2; ++n) acc[a][b][m][n] = (f32x4){0.f, 0.f, 0.f, 0.f};
        cur = nxt; cA = nA; cB = nB; ++ui;
        if (wr == 1) PG8_BAR;
    }
    PG8_WAIT_V(0);
    PG8_BAR;
#undef PG8_SA
#undef PG8_SB
#undef PG8_STAGE
#undef PG8_LDA
#undef PG8_LDB
#undef PG8_MMA
#undef PG8_WAIT_V
#undef PG8_WAIT_L
#undef PG8_BAR
#undef PG8_SCHED
#undef PG8_UA
#undef PG8_UB
}

struct CvtJob { const float* src; bf16_t* dst; int K, N, Npad, tiles; };
__device__ __forceinline__ void cvt_tile(const Frame& F, const CvtJob& j, int t) {
    LAS float* tile = (LAS float*)F.lds;
    const int tk = j.K / 64, kt = t % tk, ntile = t / tk, k0 = kt * 64, n0 = ntile * 64;
    const int tid = F.tid;
    {
        const int r = tid >> 4, c4 = (tid & 15) * 4;
#pragma unroll
        for (int i = 0; i < 2; ++i) {
            const int kr = r + 32 * i;
            f32x4 v = (f32x4){0.f, 0.f, 0.f, 0.f};
            if (n0 + c4 < j.N) v = *(const f32x4*)(j.src + (size_t)(k0 + kr) * j.N + n0 + c4);
            tile[kr * 65 + c4 + 0] = v[0]; tile[kr * 65 + c4 + 1] = v[1]; tile[kr * 65 + c4 + 2] = v[2]; tile[kr * 65 + c4 + 3] = v[3];
        }
    }
    __syncthreads();
    {
        const int n = tid >> 3, kq = (tid & 7) * 8;
        u32x4 w;
        w.x = pack2(tile[(kq + 0) * 65 + n], tile[(kq + 1) * 65 + n]); w.y = pack2(tile[(kq + 2) * 65 + n], tile[(kq + 3) * 65 + n]);
        w.z = pack2(tile[(kq + 4) * 65 + n], tile[(kq + 5) * 65 + n]); w.w = pack2(tile[(kq + 6) * 65 + n], tile[(kq + 7) * 65 + n]);
        *(u32x4*)(j.dst + (size_t)(n0 + n) * j.K + k0 + kq) = w;
    }
    __syncthreads();
}

__device__ __forceinline__ void cvt_group(const Frame& F, const PRef& p, int group, int bfirst, int nb, int rot0) {
    if (F.bid < bfirst || F.bid >= bfirst + nb) return;
    unsigned char* ws = p.ws();
    const int vb = F.bid - bfirst;
    int rot = rot0;
#define CVT(srcp, dstoff, K_, N_, Npad_) do { CvtJob jb; jb.src = (srcp); jb.dst = (bf16_t*)(ws + (dstoff)); jb.K = (K_); jb.N = (N_); jb.Npad = (Npad_); jb.tiles = ((K_) / 64) * ((Npad_) / 64); \
        for (int t = (vb + nb - (rot % nb)) % nb; t < jb.tiles; t += nb) cvt_tile(F, jb, t); rot += jb.tiles; } while (0)
    if (group == 0) {
        CVT(p.in(19), WS_WAIN, 1024, 1952, 2048);
        CVT(p.in(22), WS_WUQ, 256, 768, 768);
        CVT(p.in(23), WS_WUKV, 128, 1024, 1024);
    } else if (group == 1) {
        CVT(p.in(14), WS_WOUT, 1024, 1024, 1024);
        CVT(p.in(15), WS_WUP, 1024, 5632, 5632);
    } else if (group == 3) {
        CVT(p.in(18), WS_WDN, 2816, 1024, 1024);
    } else {
        CVT(p.in(28), WS_WBIN, 1024, 3456, 3584);
        CVT(p.in(14) + (size_t)1024 * 1024, WS_WOUT + (size_t)1024 * 1024 * 2, 1024, 1024, 1024);
        CVT(p.in(15) + (size_t)1024 * 5632, WS_WUP + (size_t)5632 * 1024 * 2, 1024, 5632, 5632);
        CVT(p.in(18) + (size_t)2816 * 1024, WS_WDN + (size_t)1024 * 2816 * 2, 2816, 1024, 1024);
        CVT(p.in(35), WS_WWUP, 64, 512, 512);
        CVT(p.in(35) + 64 * 512, WS_WWUP + 512 * 64 * 2, 64, 512, 512);
        CVT(p.in(37), WS_WAUP, 64, 512, 512);
        CVT(p.in(37) + 64 * 512, WS_WAUP + 512 * 64 * 2, 64, 512, 512);
        CVT(p.in(38), WS_WGUP, 128, 512, 512);
    }
#undef CVT
}
__device__ __forceinline__ void phase_prep(const Frame& F, const PRef& p) {
    unsigned char* ws = p.ws();
    {
        LAS float* sc = (LAS float*)F.lds;
        LAS float* red = sc + 3 * 1024;
        for (int i = F.tid; i < 3 * 1024; i += NTHREADS) {
            const int c = i >> 10, k = i & 1023;
            const float v = c == 0 ? p.in(9)[k] : p.in(8)[(c - 1) * 1024 + k];
            sc[i] = siluf_(v);
        }
        __syncthreads();
        float* mod = (float*)(ws + WS_MOD);
        FOR_UNITS(u, 192, 0) {
            const int l = u / 96, n0 = (u % 96) * 64, col = F.tid & 63, kg = F.tid >> 6;
            const float* w = p.in(10) + (size_t)l * 1024 * 6144 + (size_t)(kg * 128) * 6144 + n0 + col;
            float a0 = 0.f, a1 = 0.f, a2 = 0.f;
#pragma unroll 8
            for (int k = 0; k < 128; ++k) { const float wv = w[(size_t)k * 6144]; const int kk = kg * 128 + k; a0 += sc[kk] * wv; a1 += sc[1024 + kk] * wv; a2 += sc[2048 + kk] * wv; }
            red[(kg * 3 + 0) * 64 + col] = a0; red[(kg * 3 + 1) * 64 + col] = a1; red[(kg * 3 + 2) * 64 + col] = a2;
            __syncthreads();
            if (F.tid < 192) {
                const int c = F.tid >> 6, cc = F.tid & 63; float s = 0.f;
#pragma unroll
                for (int q = 0; q < 8; ++q) s += red[(q * 3 + c) * 64 + cc];
                mod[(size_t)(l * 3 + c) * 6144 + n0 + cc] = s + p.in(11)[l * 6144 + n0 + cc];
            }
            __syncthreads();
        }
    }
    cvt_group(F, p, 0, 0, F.G, 192);
}

__device__ __forceinline__ void phase_norm(const Frame& F, const float* xa, const float* xb, const bf16_t* part, const float* gate, float* xout,
                                           const float* g, const float* sc, const float* sh, bf16_t* hb, bool do_norm) {
    const int nw = F.G * 8;
    for (int row = F.bid * 8 + F.wave; row < NTOK; row += nw) {
        const float* x = row < NCTX ? xa + (size_t)row * 1024 : xb + (size_t)(row - NCTX) * 1024;
        const int c = cond_of(row);
        f32x4 v[4]; float ss = 0.f;
#pragma unroll
        for (int i = 0; i < 4; ++i) {
            const int col = i * 256 + F.lane * 4;
            v[i] = *(const f32x4*)(x + col);
            if (part) {
                const u32x2 q0 = *(const u32x2*)(part + (size_t)row * 1024 + col), q1 = *(const u32x2*)(part + (size_t)NTOK * 1024 + (size_t)row * 1024 + col);
                const f32x4 ps = (f32x4){bf2f(q0.x & 0xffffu) + bf2f(q1.x & 0xffffu), bf2f(q0.x >> 16) + bf2f(q1.x >> 16), bf2f(q0.y & 0xffffu) + bf2f(q1.y & 0xffffu), bf2f(q0.y >> 16) + bf2f(q1.y >> 16)};
                const f32x4 gt = *(const f32x4*)(gate + c * 6144 + col);
                v[i] = v[i] + gt * ps;
                *(f32x4*)(xout + (size_t)row * 1024 + col) = v[i];
            }
            ss += v[i][0] * v[i][0] + v[i][1] * v[i][1] + v[i][2] * v[i][2] + v[i][3] * v[i][3];
        }
        if (!do_norm) continue;
        ss = wave_sum(ss);
        const float rstd = rsqrtf(ss * (1.0f / 1024.0f) + EPS);
#pragma unroll
        for (int i = 0; i < 4; ++i) {
            const int col = i * 256 + F.lane * 4;
            const f32x4 gg = *(const f32x4*)(g + col), s1 = *(const f32x4*)(sc + c * 6144 + col), s0 = *(const f32x4*)(sh + c * 6144 + col);
            f32x4 h;
#pragma unroll
            for (int j = 0; j < 4; ++j) h[j] = v[i][j] * rstd * gg[j] * (1.0f + s1[j]) + s0[j];
            u32x2 w; w.x = pack2(h[0], h[1]); w.y = pack2(h[2], h[3]);
            *(u32x2*)(hb + (size_t)row * 1024 + col) = w;
        }
    }
}

__device__ __forceinline__ void seq_of_unit384(int u, int& s, int& c, int& h, int& tok0, int& nc) {
    if (u < 256) { s = u >> 4; c = (u >> 2) & 3; h = u & 3; tok0 = s * 256 + c * 64; nc = 4; }
    else { const int v = u - 256; s = 16 + (v >> 6); c = (v >> 2) & 15; h = v & 3; tok0 = NCTX + (s - 16) * 1024 + c * 64; nc = 16; }
}
__device__ __forceinline__ void phase_l0_tok(const Frame& F, const PRef& p) {
    unsigned char* ws = p.ws();
    const float* P = (const float*)(ws + WS_P0);
    bf16_t* cqn = (bf16_t*)(ws + WS_CQN); bf16_t* ckvn = (bf16_t*)(ws + WS_CKVN);
    const int nw = F.G * 8;
    for (int row = F.bid * 8 + F.wave; row < NKROW; row += nw) {
        if (row < NTOK) {
            const float* pr = P + (size_t)row * 2048;
            const f32x4 q = *(const f32x4*)(pr + F.lane * 4);
            float ss = wave_sum(q[0] * q[0] + q[1] * q[1] + q[2] * q[2] + q[3] * q[3]);
            float rstd = rsqrtf(ss * (1.0f / 256.0f) + EPS);
            const f32x4 gq = *(const f32x4*)(p.in(20) + F.lane * 4);
            u32x2 w; w.x = pack2(q[0] * rstd * gq[0], q[1] * rstd * gq[1]); w.y = pack2(q[2] * rstd * gq[2], q[3] * rstd * gq[3]);
            *(u32x2*)(cqn + (size_t)row * 256 + F.lane * 4) = w;
            const f32x2 kv = *(const f32x2*)(pr + 256 + F.lane * 2);
            ss = wave_sum(kv[0] * kv[0] + kv[1] * kv[1]);
            rstd = rsqrtf(ss * (1.0f / 128.0f) + EPS);
            const f32x2 gk = *(const f32x2*)(p.in(21) + F.lane * 2);
            const float o0 = kv[0] * rstd * gk[0], o1 = kv[1] * rstd * gk[1];
            *(unsigned*)(ckvn + (size_t)row * 128 + F.lane * 2) = pack2(o0, o1);
            if (row < NCTX) {
                *(f32x2*)(p.out() + OUT_CKV + (size_t)row * 128 + F.lane * 2) = (f32x2){o0, o1};
                if (F.lane < 32) p.out()[OUT_KROPE + (size_t)row * 32 + F.lane] = pr[384 + F.lane];
            }
        } else {
            const int i = row - NTOK;
            const f32x2 kv = *(const f32x2*)(p.in(2) + (size_t)i * 128 + F.lane * 2);
            *(unsigned*)(ckvn + (size_t)row * 128 + F.lane * 2) = pack2(kv[0], kv[1]);
        }
    }
    {
        LAS unsigned char* L = F.lds;
        constexpr int KPI = 160, VPI = 288, O_KF = 0, O_KB = 64 * KPI, O_V = 2 * 64 * KPI;
        float* KVS = (float*)(ws + WS_KVS);
        const int tid = F.tid, w = F.wave, fr = F.lane & 15, fq = F.lane >> 4;
        FOR_UNITS(u, 384, 0) {
            int s, c, h, tok0, nc; seq_of_unit384(u, s, c, h, tok0, nc);
            const float lgf = __logf(sigmoidf_(p.in(26)[h])), lgb = __logf(sigmoidf_(p.in(26)[4 + h]));
            {
                const int row = tid >> 3, ch = tid & 7;
                const float* pr = P + (size_t)(tok0 + row) * 2048;
                const f32x4 k0 = *(const f32x4*)(pr + 672 + h * 64 + ch * 8), k1 = *(const f32x4*)(pr + 672 + h * 64 + ch * 8 + 4);
                f32x4 vv[4];
#pragma unroll
                for (int i = 0; i < 4; ++i) vv[i] = *(const f32x4*)(pr + 928 + h * 128 + ch * 16 + i * 4);
                const float df = 0.125f * __expf(lgf * (float)(63 - row)), db = 0.125f * __expf(lgb * (float)row);
                u32x4 t;
                t.x = pack2(k0[0] * df, k0[1] * df); t.y = pack2(k0[2] * df, k0[3] * df); t.z = pack2(k1[0] * df, k1[1] * df); t.w = pack2(k1[2] * df, k1[3] * df); *(LAS u32x4*)(L + O_KF + row * KPI + ch * 16) = t;
                t.x = pack2(k0[0] * db, k0[1] * db); t.y = pack2(k0[2] * db, k0[3] * db); t.z = pack2(k1[0] * db, k1[1] * db); t.w = pack2(k1[2] * db, k1[3] * db); *(LAS u32x4*)(L + O_KB + row * KPI + ch * 16) = t;
#pragma unroll
                for (int i = 0; i < 2; ++i) { t.x = pack2(vv[2 * i][0], vv[2 * i][1]); t.y = pack2(vv[2 * i][2], vv[2 * i][3]); t.z = pack2(vv[2 * i + 1][0], vv[2 * i + 1][1]); t.w = pack2(vv[2 * i + 1][2], vv[2 * i + 1][3]);
                    *(LAS u32x4*)(L + O_V + row * VPI + ch * 32 + i * 16) = t; }
            }
            __syncthreads();
            bf16x8 Bf[2];
#pragma unroll
            for (int ks = 0; ks < 2; ++ks) {
                const LAS unsigned char* vp = L + O_V + (32 * ks + 8 * fq + (fr >> 2)) * VPI + (w * 16 + 4 * (fr & 3)) * 2;
                const bf16x4 v0 = __builtin_amdgcn_ds_read_tr16_b64_v4i16((LAS bf16x4*)vp), v1 = __builtin_amdgcn_ds_read_tr16_b64_v4i16((LAS bf16x4*)(vp + 4 * VPI));
                bf16x8 x; x[0] = v0[0]; x[1] = v0[1]; x[2] = v0[2]; x[3] = v0[3]; x[4] = v1[0]; x[5] = v1[1]; x[6] = v1[2]; x[7] = v1[3]; Bf[ks] = x;
            }
            float* o = KVS + (size_t)u * 2 * 8192;
#pragma unroll
            for (int d = 0; d < 2; ++d)
#pragma unroll
                for (int et = 0; et < 4; ++et) {
                    f32x4 a = (f32x4){0.f, 0.f, 0.f, 0.f};
#pragma unroll
                    for (int ks = 0; ks < 2; ++ks) {
                        const LAS unsigned char* kp = L + (d ? O_KB : O_KF) + (32 * ks + 8 * fq + (fr >> 2)) * KPI + (et * 16 + 4 * (fr & 3)) * 2;
                        const bf16x4 v0 = __builtin_amdgcn_ds_read_tr16_b64_v4i16((LAS bf16x4*)kp), v1 = __builtin_amdgcn_ds_read_tr16_b64_v4i16((LAS bf16x4*)(kp + 4 * KPI));
                        bf16x8 x; x[0] = v0[0]; x[1] = v0[1]; x[2] = v0[2]; x[3] = v0[3]; x[4] = v1[0]; x[5] = v1[1]; x[6] = v1[2]; x[7] = v1[3];
                        a = __builtin_amdgcn_mfma_f32_16x16x32_bf16(x, Bf[ks], a, 0, 0, 0);
                    }
#pragma unroll
                    for (int r = 0; r < 4; ++r) o[d * 8192 + (et * 16 + 4 * fq + r) * 128 + w * 16 + fr] = a[r];
                }
            __syncthreads();
        }
    }
}

__device__ __forceinline__ void phase_l0_prefix(const Frame& F, const PRef& p, int rot) {
    float* KVS = (float*)(p.ws() + WS_KVS);
    FOR_UNITS(u, 576, rot) {
        const int qd = u & 3, d = (u >> 2) & 1, h = (u >> 3) & 3, s = u >> 5;
        const int nc = s < 16 ? 4 : 16;
        const int ubase = s < 16 ? s * 16 + h : 256 + (s - 16) * 64 + h;
        const float g64 = __expf(64.0f * __logf(sigmoidf_(p.in(26)[d * 4 + h])));
        const int i = qd * 2048 + F.tid * 4;
        float* base = KVS + (size_t)ubase * 16384 + d * 8192 + i;
        f32x4 kv[16];
#pragma unroll
        for (int c = 0; c < 16; ++c) if (c < nc) kv[c] = *(const f32x4*)(base + (size_t)c * 4 * 16384);
        f32x4 S = (f32x4){0.f, 0.f, 0.f, 0.f};
        if (s >= 16) S = *(const f32x4*)(p.in(4) + (size_t)(((s - 16) * 2 + d) * 4 + h) * 8192 + i);
        if (d == 0) {
#pragma unroll
            for (int c = 0; c < 16; ++c) if (c < nc) { *(f32x4*)(base + (size_t)c * 4 * 16384) = S; S = S * g64 + kv[c]; }
        } else {
#pragma unroll
            for (int c = 15; c >= 0; --c) if (c < nc) { *(f32x4*)(base + (size_t)c * 4 * 16384) = S; S = S * g64 + kv[c]; }
        }
        if (s < 16) *(f32x4*)(p.out() + OUT_SRET + (size_t)((s * 2 + d) * 4 + h) * 8192 + i) = S;
    }
}

__device__ __forceinline__ size_t vt_base(int kr, int nheads, int dv, int& nkeys, int& key) {
    if (kr < NCTX) { nkeys = 256; key = kr & 255; return (size_t)(kr >> 8) * nheads * dv * 256; }
    const int v = kr - NCTX; const int b = v / 1536; nkeys = 1536; key = v - b * 1536;
    return (size_t)16 * nheads * dv * 256 + (size_t)b * nheads * dv * 1536;
}
__device__ __forceinline__ void phase_l0_qkv(const Frame& F, const PRef& p) {
    unsigned char* ws = p.ws();
    const float* P = (const float*)(ws + WS_P0); const float* QR = (const float*)(ws + WS_QRAW); const float* KVR = (const float*)(ws + WS_KVRAW);
    bf16_t* Q = (bf16_t*)(ws + WS_Q0); bf16_t* K = (bf16_t*)(ws + WS_K0); bf16_t* VT = (bf16_t*)(ws + WS_VT0);
    const int nw = F.G * 8, lane = F.lane;
    const float qscale = 0.10206207261596577f;
    for (int row = F.bid * 8 + F.wave; row < NKROW; row += nw) {
        const bool istok = row < NTOK, lat = istok && row >= NCTX;
        float cs = 1.f, sn = 0.f;
        if (lat && lane >= 32 && lane < 48) {
            const int t = (row - NCTX) & 1023, a = lane - 32;
            const float pos = a < 8 ? (float)(t >> 6) : (float)(t & 63);
            const float inv = __powf(10000.0f, -(float)(a & 7) * 0.125f);
            const float ang = pos * inv; cs = __cosf(ang); sn = __sinf(ang);
        }
        int kr;
        if (row < NCTX) kr = row; else if (row < NTOK) { const int v = row - NCTX; kr = NCTX + (v >> 10) * 1536 + (v & 1023); }
        else { const int i = row - NTOK; kr = NCTX + (i >> 9) * 1536 + 1024 + (i & 511); }
        const float* krope = istok ? P + (size_t)row * 2048 + 384 : p.in(3) + (size_t)(row - NTOK) * 32;
        f32x2 qv[8], kv2[8]; float vv[8];
        f32x2 kro = (f32x2){0.f, 0.f};
        if (lane >= 32 && lane < 48) kro = *(const f32x2*)(krope + 2 * (lane - 32));
#pragma unroll
        for (int h = 0; h < 8; ++h) {
            qv[h] = (f32x2){0.f, 0.f};
            if (istok && lane < 48) qv[h] = *(const f32x2*)(QR + (size_t)row * 768 + h * 96 + 2 * lane);
            kv2[h] = kro;
            if (lane < 32) kv2[h] = *(const f32x2*)(KVR + (size_t)row * 1024 + h * 128 + 2 * lane);
            vv[h] = KVR[(size_t)row * 1024 + h * 128 + 64 + lane];
        }
        f32x2 gq = (f32x2){0.f, 0.f}, gk = (f32x2){0.f, 0.f};
        if (lane < 48) { gq = *(const f32x2*)(p.in(24) + 2 * lane); gk = *(const f32x2*)(p.in(25) + 2 * lane); }
#pragma unroll
        for (int h = 0; h < 8; ++h) {
            if (istok) {
                float x1 = qv[h][0], x2 = qv[h][1];
                const float rstd = rsqrtf(wave_sum(x1 * x1 + x2 * x2) * (1.0f / 96.0f) + EPS);
                if (lane < 48) {
                    x1 = x1 * rstd * gq[0]; x2 = x2 * rstd * gq[1];
                    const float y1 = x1 * cs - x2 * sn, y2 = x1 * sn + x2 * cs;
                    *(unsigned*)(Q + (size_t)row * 768 + h * 96 + 2 * lane) = pack2(y1 * qscale, y2 * qscale);
                }
            }
            {
                float x1 = kv2[h][0], x2 = kv2[h][1];
                const float rstd = rsqrtf(wave_sum(x1 * x1 + x2 * x2) * (1.0f / 96.0f) + EPS);
                if (lane < 48) {
                    x1 = x1 * rstd * gk[0]; x2 = x2 * rstd * gk[1];
                    const float y1 = x1 * cs - x2 * sn, y2 = x1 * sn + x2 * cs;
                    *(unsigned*)(K + (size_t)kr * 768 + h * 96 + 2 * lane) = pack2(y1, y2);
                }
            }
            VT[(size_t)kr * 512 + h * 64 + lane] = f2bf(vv[h]);
        }
    }
}

template <int DQK, int DV, int NC, int NQT>
struct AttnState { f32x4 O[NC][DV / 16][NQT]; float l[NC][NQT]; };

template <int DQK, int DV, int NC, int NQT>
__device__ __forceinline__ void attn_wave(const bf16_t* __restrict__ Q, const bf16_t* __restrict__ K, const bf16_t* __restrict__ Vt,
                                          int qtok0, int krow0, int nkeys, int hh0  , int lane, AttnState<DQK, DV, NC, NQT>& st) {
    constexpr int NS = DQK / 32, NE = DV / 16, RS = 8 * DQK;
    const int fr = lane & 15, fq = lane >> 4;
    bf16x8 Qf[NC][NQT][NS];
#pragma unroll
    for (int c = 0; c < NC; ++c)
#pragma unroll
        for (int qt = 0; qt < NQT; ++qt)
#pragma unroll
            for (int s = 0; s < NS; ++s) Qf[c][qt][s] = *(const bf16x8*)(Q + (size_t)(qtok0 + qt * 16 + fr) * RS + (hh0 + c) * DQK + s * 32 + fq * 8);
    float m[NC][NQT];
#pragma unroll
    for (int c = 0; c < NC; ++c)
#pragma unroll
        for (int qt = 0; qt < NQT; ++qt) { m[c][qt] = -1e30f; st.l[c][qt] = 0.f;
#pragma unroll
            for (int e = 0; e < NE; ++e) st.O[c][e][qt] = (f32x4){0.f, 0.f, 0.f, 0.f}; }
    for (int key0 = 0; key0 < nkeys; key0 += 32) {
        bf16x8 Pf[NC][NQT];
#pragma unroll
        for (int c = 0; c < NC; ++c) {
            f32x4 S[2][NQT];
#pragma unroll
            for (int kt = 0; kt < 2; ++kt) {
                bf16x8 Kf[NS];
#pragma unroll
                for (int s = 0; s < NS; ++s) Kf[s] = *(const bf16x8*)(K + (size_t)(krow0 + key0 + kt * 16 + fr) * RS + (hh0 + c) * DQK + s * 32 + fq * 8);
#pragma unroll
                for (int qt = 0; qt < NQT; ++qt) {
                    f32x4 a = (f32x4){0.f, 0.f, 0.f, 0.f};
#pragma unroll
                    for (int s = 0; s < NS; ++s) a = __builtin_amdgcn_mfma_f32_16x16x32_bf16(Kf[s], Qf[c][qt][s], a, 0, 0, 0);
                    S[kt][qt] = a;
                }
            }
#pragma unroll
            for (int qt = 0; qt < NQT; ++qt) {
                float mx = fmaxf(fmaxf(fmaxf(S[0][qt][0], S[0][qt][1]), fmaxf(S[0][qt][2], S[0][qt][3])), fmaxf(fmaxf(S[1][qt][0], S[1][qt][1]), fmaxf(S[1][qt][2], S[1][qt][3])));
                mx = fmaxf(mx, __shfl_xor(mx, 16)); mx = fmaxf(mx, __shfl_xor(mx, 32));
                const float mn = fmaxf(m[c][qt], mx), alpha = __expf(m[c][qt] - mn);
                m[c][qt] = mn;
                float pv[8]; float ps = 0.f;
#pragma unroll
                for (int j = 0; j < 4; ++j) { pv[j] = __expf(S[0][qt][j] - mn); pv[4 + j] = __expf(S[1][qt][j] - mn); ps += pv[j] + pv[4 + j]; }
                st.l[c][qt] = st.l[c][qt] * alpha + ps;
#pragma unroll
                for (int e = 0; e < NE; ++e) st.O[c][e][qt] *= alpha;
                u32x4 pk; pk.x = pack2(pv[0], pv[1]); pk.y = pack2(pv[2], pv[3]); pk.z = pack2(pv[4], pv[5]); pk.w = pack2(pv[6], pv[7]);
                Pf[c][qt] = __builtin_bit_cast(bf16x8, pk);
            }
        }
#pragma unroll
        for (int e = 0; e < NE; ++e) {
            const bf16_t* vp = Vt + (size_t)(e * 16 + fr) * nkeys + key0 + 4 * fq;
            const bf16x4 v0 = *(const bf16x4*)vp, v1 = *(const bf16x4*)(vp + 16);
            bf16x8 Vf; Vf[0] = v0[0]; Vf[1] = v0[1]; Vf[2] = v0[2]; Vf[3] = v0[3]; Vf[4] = v1[0]; Vf[5] = v1[1]; Vf[6] = v1[2]; Vf[7] = v1[3];
#pragma unroll
            for (int c = 0; c < NC; ++c)
#pragma unroll
                for (int qt = 0; qt < NQT; ++qt) st.O[c][e][qt] = __builtin_amdgcn_mfma_f32_16x16x32_bf16(Vf, Pf[c][qt], st.O[c][e][qt], 0, 0, 0);
        }
    }
#pragma unroll
    for (int c = 0; c < NC; ++c)
#pragma unroll
        for (int qt = 0; qt < NQT; ++qt) { float l = st.l[c][qt]; l += __shfl_xor(l, 16); l += __shfl_xor(l, 32); st.l[c][qt] = 1.0f / l; }
}

__device__ __forceinline__ int attn_unit_xcd(int bid, int which) {
    const int x = bid & 7, idx = bid >> 3;
    return which == 0 ? (2 * x + (idx >> 4)) * 16 + (idx & 15) : 256 + (x * 16 + (idx >> 1)) * 2 + (idx & 1);
}
template <int DQK, int DV, int VH, class OutFn>
__device__ __forceinline__ void attn_block(const Frame& F, const bf16_t* __restrict__ Q, const bf16_t* __restrict__ K, const bf16_t* __restrict__ VT, const OutFn& out, int unit, float shift) {
    constexpr int NS = DQK / 32, NE = DV / 16, RS = 8 * DQK, KPC = DQK / 8;
    constexpr int KB = 128 * 256, VP = DV * 2 + 32, VB = 128 * VP, STG = KB + VB, VPC = DV / 8;
    constexpr int NKP = 128 * KPC / NTHREADS, NVP = 128 * VPC / NTHREADS;
    LAS unsigned char* lds = F.lds;
    const int lane = F.lane, fr = lane & 15, fq = lane >> 4, wave = F.wave, tid = F.tid;
    const bool lat = unit < 256;
    int ab, h, q0, nkeys, NQG;
    if (lat) { ab = 16 + (unit >> 7); h = (unit >> 4) & 7; q0 = (unit & 15) * 64; nkeys = 1536; NQG = 2; }
    else { const int v = unit - 256; ab = v >> 4; h = (v >> 1) & 7; q0 = (v & 1) * 128; nkeys = 256; NQG = 4; }
    const int NKS = 8 / NQG, qg = wave % NQG, ks = wave / NQG, kslice = 128 / NKS, nit = kslice / 32;
    const int qtok0 = (lat ? NCTX + (ab - 16) * 1024 : ab * 256) + q0 + qg * 32;
    const int krow0 = lat ? NCTX + (ab - 16) * 1536 : ab * 256;
    const bf16_t* vg = VT + (size_t)krow0 * (VH * DV) + (h * VH / 8) * DV;
    const bf16_t* kg = K + (size_t)krow0 * RS + h * DQK;
    bf16x8 Qf[2][NS];
#pragma unroll
    for (int qt = 0; qt < 2; ++qt)
#pragma unroll
        for (int s = 0; s < NS; ++s) Qf[qt][s] = *(const bf16x8*)(Q + (size_t)(qtok0 + qt * 16 + fr) * RS + h * DQK + s * 32 + fq * 8);
    f32x4 O[NE][2]; float l[2];
    const float sh2 = shift * 1.44269504f;
#pragma unroll
    for (int qt = 0; qt < 2; ++qt) { l[qt] = 0.f;
#pragma unroll
        for (int e = 0; e < NE; ++e) O[e][qt] = (f32x4){0.f, 0.f, 0.f, 0.f}; }
    u32x4 kregA[NKP], vregA[NVP], kregB[DV == 64 ? NKP : 1], vregB[DV == 64 ? NVP : 1];
#define AT_LOAD(kreg, vreg, st) do { \
        _Pragma("unroll") for (int i = 0; i < NKP; ++i) { const int pid = tid + i * NTHREADS, row = pid / KPC, ch = pid % KPC; kreg[i] = *(const u32x4*)(kg + (size_t)((st) * 128 + row) * RS + ch * 8); } \
        _Pragma("unroll") for (int i = 0; i < NVP; ++i) { const int pid = tid + i * NTHREADS, row = pid / VPC, ch = pid % VPC; vreg[i] = *(const u32x4*)(vg + (size_t)((st) * 128 + row) * (VH * DV) + ch * 8); } } while (0)
#define AT_WRITE(kreg, vreg, buf) do { \
        _Pragma("unroll") for (int i = 0; i < NKP; ++i) { const int pid = tid + i * NTHREADS, row = pid / KPC, ch = pid % KPC; *(LAS u32x4*)(lds + (buf) * STG + row * 256 + ((ch ^ (row & 15)) << 4)) = kreg[i]; } \
        _Pragma("unroll") for (int i = 0; i < NVP; ++i) { const int pid = tid + i * NTHREADS, row = pid / VPC, ch = pid % VPC; *(LAS u32x4*)(lds + (buf) * STG + KB + row * VP + ch * 16) = vreg[i]; } } while (0)
#define AT_COMPUTE(bufsel) do { \
        const LAS unsigned char* kb = lds + (bufsel) * STG; const LAS unsigned char* vb = kb + KB; \
        for (int it = 0; it < nit; ++it) { \
            const int key0 = ks * kslice + it * 32; \
            f32x4 S[2][2]; \
            _Pragma("unroll") for (int kt = 0; kt < 2; ++kt) { \
                const int row = key0 + kt * 16 + fr; \
                bf16x8 Kf[NS]; \
                _Pragma("unroll") for (int s_ = 0; s_ < NS; ++s_) Kf[s_] = *(const LAS bf16x8*)(kb + row * 256 + (((4 * s_ + fq) ^ (row & 15)) << 4)); \
                _Pragma("unroll") for (int qt = 0; qt < 2; ++qt) { \
                    f32x4 a = (f32x4){0.f, 0.f, 0.f, 0.f}; \
                    _Pragma("unroll") for (int s_ = 0; s_ < NS; ++s_) a = __builtin_amdgcn_mfma_f32_16x16x32_bf16(Kf[s_], Qf[qt][s_], a, 0, 0, 0); \
                    S[kt][qt] = a; } } \
            bf16x8 Pf[2]; \
            _Pragma("unroll") for (int qt = 0; qt < 2; ++qt) { \
                float pv[8]; float ps = 0.f; \
                _Pragma("unroll") for (int j = 0; j < 4; ++j) { pv[j] = __builtin_amdgcn_exp2f(S[0][qt][j] * 1.44269504f - sh2); pv[4 + j] = __builtin_amdgcn_exp2f(S[1][qt][j] * 1.44269504f - sh2); ps += pv[j] + pv[4 + j]; } \
                l[qt] += ps; \
                u32x4 pk; pk.x = pack2(pv[0], pv[1]); pk.y = pack2(pv[2], pv[3]); pk.z = pack2(pv[4], pv[5]); pk.w = pack2(pv[6], pv[7]); \
                Pf[qt] = __builtin_bit_cast(bf16x8, pk); } \
            _Pragma("unroll") for (int e = 0; e < NE; ++e) { \
                const LAS unsigned char* vp = vb + (key0 + 4 * fq + (fr >> 2)) * VP + (e * 16 + 4 * (fr & 3)) * 2; \
                const bf16x4 v0 = __builtin_amdgcn_ds_read_tr16_b64_v4i16((LAS bf16x4*)vp), v1 = __builtin_amdgcn_ds_read_tr16_b64_v4i16((LAS bf16x4*)(vp + 16 * VP)); \
                bf16x8 Vf; Vf[0] = v0[0]; Vf[1] = v0[1]; Vf[2] = v0[2]; Vf[3] = v0[3]; Vf[4] = v1[0]; Vf[5] = v1[1]; Vf[6] = v1[2]; Vf[7] = v1[3]; \
                _Pragma("unroll") for (int qt = 0; qt < 2; ++qt) O[e][qt] = __builtin_amdgcn_mfma_f32_16x16x32_bf16(Vf, Pf[qt], O[e][qt], 0, 0, 0); } } } while (0)
    const int nst = nkeys / 128;
    constexpr bool TWOSET = DV == 64;
    AT_LOAD(kregA, vregA, 0); if (TWOSET) AT_LOAD(kregB, vregB, 1); AT_WRITE(kregA, vregA, 0);
#pragma unroll
    for (int qt = 0; qt < 2; ++qt)
#pragma unroll
        for (int s_ = 0; s_ < NS; ++s_) asm volatile("" :: "v"(Qf[qt][s_]));
    __syncthreads();
    for (int st = 0; st < nst; st += 2) {
        if (TWOSET) {
            if (st + 2 < nst) AT_LOAD(kregA, vregA, st + 2);
            AT_COMPUTE(0);
            AT_WRITE(kregB, vregB, 1);
            __syncthreads();
            if (st + 3 < nst) AT_LOAD(kregB, vregB, st + 3);
            AT_COMPUTE(1);
            if (st + 2 < nst) AT_WRITE(kregA, vregA, 0);
            __syncthreads();
        } else {
            AT_LOAD(kregA, vregA, st + 1);
            AT_COMPUTE(0);
            AT_WRITE(kregA, vregA, 1);
            __syncthreads();
            if (st + 2 < nst) AT_LOAD(kregA, vregA, st + 2);
            AT_COMPUTE(1);
            if (st + 2 < nst) AT_WRITE(kregA, vregA, 0);
            __syncthreads();
        }
    }
#undef AT_COMPUTE
#undef AT_LOAD
#undef AT_WRITE
    LAS f32x4* Ost = (LAS f32x4*)lds; LAS float* LL = (LAS float*)(lds + 8 * 2 * NE * 1024);
#pragma unroll
    for (int qt = 0; qt < 2; ++qt) {
        float lt = l[qt]; lt += __shfl_xor(lt, 16); lt += __shfl_xor(lt, 32);
        if (fq == 0) LL[(wave * 2 + qt) * 16 + fr] = lt;
#pragma unroll
        for (int e = 0; e < NE; ++e) Ost[((wave * 2 + qt) * NE + e) * 64 + lane] = O[e][qt];
    }
    __syncthreads();
    const int epw = NE / NKS;
#pragma unroll
    for (int qt = 0; qt < 2; ++qt) {
        float L = 0.f;
        for (int j = 0; j < NKS; ++j) L += LL[((j * NQG + qg) * 2 + qt) * 16 + fr];
        const float invL = 1.0f / L;
        for (int ee = 0; ee < epw; ++ee) {
            const int e = ks * epw + ee;
            f32x4 o = (f32x4){0.f, 0.f, 0.f, 0.f};
            for (int j = 0; j < NKS; ++j) o += Ost[(((j * NQG + qg) * 2 + qt) * NE + e) * 64 + lane];
            out(qtok0 + qt * 16 + fr, h * DV + e * 16 + 4 * fq, o * invL);
        }
    }
    __syncthreads();
}
struct AttnOutBf16 { bf16_t* C; int ldc;
    __device__ __forceinline__ void operator()(int tok, int col, f32x4 o) const { u32x2 w; w.x = pack2(o[0], o[1]); w.y = pack2(o[2], o[3]); *(u32x2*)(C + (size_t)tok * ldc + col) = w; } };

__device__ __forceinline__ void attn_unit(int u, int wave, int& ab, int& h, int& q0) {
    if (u < 64) { ab = 16 + (u >> 5); h = (u >> 2) & 7; q0 = (u & 3) * 256 + wave * 32; }
    else { const int v = u - 64; ab = v >> 3; h = v & 7; q0 = wave * 32; }
}

__device__ __forceinline__ void phase_l0_mix(const Frame& F, const PRef& p) {
    unsigned char* ws = p.ws();
    const float* P = (const float*)(ws + WS_P0);
    bf16_t* OB = (bf16_t*)(ws + WS_OB);
    const bf16_t* Q = (const bf16_t*)(ws + WS_Q0); const bf16_t* K = (const bf16_t*)(ws + WS_K0); const bf16_t* VT = (const bf16_t*)(ws + WS_VT0);
    const int lane = F.lane, fr = lane & 15, fq = lane >> 4;
    {
        float gq = 0.f, gk = 0.f;
        for (int i = 0; i < 96; ++i) { gq = fmaxf(gq, fabsf(p.in(24)[i])); gk = fmaxf(gk, fabsf(p.in(25)[i])); }
        const float shift = 9.79795897f * gq * gk;
        AttnOutBf16 ao{OB, 1024};
#ifndef ATT_REP
#define ATT_REP 0
#endif
        for (int rp_ = 0; rp_ < 1 + (ATT_REP == 1); ++rp_) {
            for (int slot = 0; slot * F.G < 512; ++slot) { const int u = F.G == 256 ? attn_unit_xcd(F.bid, slot) : F.bid + slot * F.G; if (u < 512) for (int r2_ = 0; r2_ < 1 + ((ATT_REP == 3 && slot == 0) || (ATT_REP == 4 && slot == 1) ? 3 : 0); ++r2_) attn_block<96, 64, 8>(F, Q, K, VT, ao, u, shift); }
        } }
    {
        LAS unsigned char* L = F.lds;
        constexpr int T64 = 64 * 128, VPI = 288, T128 = 64 * VPI;
        constexpr int O_Q = 0, O_K = T64, O_QF = 2 * T64, O_QB = 3 * T64, O_W = 4 * T64, O_V = 5 * T64, O_SF = O_V + T128, O_SB = O_SF + T128, O_RED = O_SB + T128;
        const float* KVS = (const float*)(ws + WS_KVS);
        const int tid = F.tid, w = F.wave;
        for (int rp_ = 0; rp_ < 1 + (ATT_REP == 2); ++rp_)
        FOR_UNITS(u, 384, 128) {
            int s, c, h, tok0, nc; seq_of_unit384(u, s, c, h, tok0, nc);
            const float lgf = __logf(sigmoidf_(p.in(26)[h])), lgb = __logf(sigmoidf_(p.in(26)[4 + h]));
            {
                const int row = tid >> 3, ch = tid & 7;
                const float* pr = P + (size_t)(tok0 + row) * 2048;
                const f32x4 q0 = *(const f32x4*)(pr + 416 + h * 64 + ch * 8), q1 = *(const f32x4*)(pr + 416 + h * 64 + ch * 8 + 4);
                const f32x4 k0 = *(const f32x4*)(pr + 672 + h * 64 + ch * 8), k1 = *(const f32x4*)(pr + 672 + h * 64 + ch * 8 + 4);
                f32x4 vv[4], sf[4], sb[4];
#pragma unroll
                for (int i = 0; i < 4; ++i) { vv[i] = *(const f32x4*)(pr + 928 + h * 128 + ch * 16 + i * 4);
                    sf[i] = *(const f32x4*)(KVS + (size_t)u * 16384 + row * 128 + ch * 16 + i * 4); sb[i] = *(const f32x4*)(KVS + (size_t)u * 16384 + 8192 + row * 128 + ch * 16 + i * 4); }
                const float df = __expf(lgf * (float)(row + 1)), db = __expf(lgb * (float)(64 - row));
                const int so = row * 128 + ((ch ^ (row & 7)) << 4);
                u32x4 t;
                t.x = pack2(q0[0], q0[1]); t.y = pack2(q0[2], q0[3]); t.z = pack2(q1[0], q1[1]); t.w = pack2(q1[2], q1[3]); *(LAS u32x4*)(L + O_Q + so) = t;
                t.x = pack2(q0[0] * df, q0[1] * df); t.y = pack2(q0[2] * df, q0[3] * df); t.z = pack2(q1[0] * df, q1[1] * df); t.w = pack2(q1[2] * df, q1[3] * df); *(LAS u32x4*)(L + O_QF + so) = t;
                t.x = pack2(q0[0] * db, q0[1] * db); t.y = pack2(q0[2] * db, q0[3] * db); t.z = pack2(q1[0] * db, q1[1] * db); t.w = pack2(q1[2] * db, q1[3] * db); *(LAS u32x4*)(L + O_QB + so) = t;
                t.x = pack2(k0[0] * 0.125f, k0[1] * 0.125f); t.y = pack2(k0[2] * 0.125f, k0[3] * 0.125f); t.z = pack2(k1[0] * 0.125f, k1[1] * 0.125f); t.w = pack2(k1[2] * 0.125f, k1[3] * 0.125f); *(LAS u32x4*)(L + O_K + so) = t;
                const int vo = row * VPI + ch * 32;
#pragma unroll
                for (int i = 0; i < 2; ++i) {
                    t.x = pack2(vv[2 * i][0], vv[2 * i][1]); t.y = pack2(vv[2 * i][2], vv[2 * i][3]); t.z = pack2(vv[2 * i + 1][0], vv[2 * i + 1][1]); t.w = pack2(vv[2 * i + 1][2], vv[2 * i + 1][3]); *(LAS u32x4*)(L + O_V + vo + i * 16) = t;
                    t.x = pack2(sf[2 * i][0], sf[2 * i][1]); t.y = pack2(sf[2 * i][2], sf[2 * i][3]); t.z = pack2(sf[2 * i + 1][0], sf[2 * i + 1][1]); t.w = pack2(sf[2 * i + 1][2], sf[2 * i + 1][3]); *(LAS u32x4*)(L + O_SF + vo + i * 16) = t;
                    t.x = pack2(sb[2 * i][0], sb[2 * i][1]); t.y = pack2(sb[2 * i][2], sb[2 * i][3]); t.z = pack2(sb[2 * i + 1][0], sb[2 * i + 1][1]); t.w = pack2(sb[2 * i + 1][2], sb[2 * i + 1][3]); *(LAS u32x4*)(L + O_SB + vo + i * 16) = t;
                }
            }
            __syncthreads();
            {
                const int jt = w >> 1;
                bf16x8 Kf[2];
#pragma unroll
                for (int ks = 0; ks < 2; ++ks) { const int row = jt * 16 + fr; Kf[ks] = *(const LAS bf16x8*)(L + O_K + row * 128 + (((4 * ks + fq) ^ (row & 7)) << 4)); }
#pragma unroll
                for (int t2 = 0; t2 < 2; ++t2) {
                    const int it = (w & 1) * 2 + t2, irow = it * 16 + fr;
                    f32x4 d = (f32x4){0.f, 0.f, 0.f, 0.f};
#pragma unroll
                    for (int ks = 0; ks < 2; ++ks) { const bf16x8 Qf_ = *(const LAS bf16x8*)(L + O_Q + irow * 128 + (((4 * ks + fq) ^ (irow & 7)) << 4)); d = __builtin_amdgcn_mfma_f32_16x16x32_bf16(Kf[ks], Qf_, d, 0, 0, 0); }
                    float wv[4];
#pragma unroll
                    for (int r = 0; r < 4; ++r) { const int j = jt * 16 + 4 * fq + r; float dec = 0.f; if (j <= irow) dec += __expf(lgf * (float)(irow - j)); if (j >= irow) dec += __expf(lgb * (float)(j - irow)); wv[r] = d[r] * dec; }
                    u32x2 t; t.x = pack2(wv[0], wv[1]); t.y = pack2(wv[2], wv[3]);
                    *(LAS u32x2*)(L + O_W + irow * 128 + (((2 * jt + (fq >> 1)) ^ (irow & 7)) << 4) + (fq & 1) * 8) = t;
                }
            }
            __syncthreads();
            f32x4 acc[4];
#pragma unroll
            for (int it = 0; it < 4; ++it) acc[it] = (f32x4){0.f, 0.f, 0.f, 0.f};
            {
                bf16x8 Af[3][2];
#pragma unroll
                for (int a = 0; a < 3; ++a)
#pragma unroll
                    for (int ks = 0; ks < 2; ++ks) {
                        const LAS unsigned char* vp = L + (a == 0 ? O_V : (a == 1 ? O_SF : O_SB)) + (32 * ks + 8 * fq + (fr >> 2)) * VPI + (w * 16 + 4 * (fr & 3)) * 2;
                        const bf16x4 v0 = __builtin_amdgcn_ds_read_tr16_b64_v4i16((LAS bf16x4*)vp), v1 = __builtin_amdgcn_ds_read_tr16_b64_v4i16((LAS bf16x4*)(vp + 4 * VPI));
                        bf16x8 x; x[0] = v0[0]; x[1] = v0[1]; x[2] = v0[2]; x[3] = v0[3]; x[4] = v1[0]; x[5] = v1[1]; x[6] = v1[2]; x[7] = v1[3];
                        Af[a][ks] = x;
                    }
#pragma unroll
                for (int it = 0; it < 4; ++it) {
                    const int irow = it * 16 + fr;
#pragma unroll
                    for (int ks = 0; ks < 2; ++ks) {
                        const int so = irow * 128 + (((4 * ks + fq) ^ (irow & 7)) << 4);
                        const bf16x8 bw = *(const LAS bf16x8*)(L + O_W + so), bqf = *(const LAS bf16x8*)(L + O_QF + so), bqb = *(const LAS bf16x8*)(L + O_QB + so);
                        acc[it] = __builtin_amdgcn_mfma_f32_16x16x32_bf16(Af[0][ks], bw, acc[it], 0, 0, 0);
                        acc[it] = __builtin_amdgcn_mfma_f32_16x16x32_bf16(Af[1][ks], bqf, acc[it], 0, 0, 0);
                        acc[it] = __builtin_amdgcn_mfma_f32_16x16x32_bf16(Af[2][ks], bqb, acc[it], 0, 0, 0);
                    }
                }
            }
            LAS float* red = (LAS float*)(L + O_RED);
#pragma unroll
            for (int it = 0; it < 4; ++it) {
                float ss = acc[it][0] * acc[it][0] + acc[it][1] * acc[it][1] + acc[it][2] * acc[it][2] + acc[it][3] * acc[it][3];
                ss += __shfl_xor(ss, 16); ss += __shfl_xor(ss, 32);
                if (fq == 0) red[w * 64 + it * 16 + fr] = ss;
            }
            __syncthreads();
            {
                const f32x4 gn = *(const f32x4*)(p.in(27) + h * 128 + w * 16 + 4 * fq);
#pragma unroll
                for (int it = 0; it < 4; ++it) {
                    const int i = it * 16 + fr, tok = tok0 + i;
                    float ss = 0.f;
#pragma unroll
                    for (int q = 0; q < 8; ++q) ss += red[q * 64 + i];
                    const float rstd = rsqrtf(ss * (1.0f / 128.0f) + EPS);
                    const f32x4 rg = *(const f32x4*)(P + (size_t)tok * 2048 + 1440 + h * 128 + w * 16 + 4 * fq);
                    u32x2 t; t.x = pack2(siluf_(rg[0]) * acc[it][0] * rstd * gn[0], siluf_(rg[1]) * acc[it][1] * rstd * gn[1]);
                    t.y = pack2(siluf_(rg[2]) * acc[it][2] * rstd * gn[2], siluf_(rg[3]) * acc[it][3] * rstd * gn[3]);
                    *(u32x2*)(OB + (size_t)tok * 1024 + 512 + h * 128 + w * 16 + 4 * fq) = t;
                }
            }
            __syncthreads();
        }
    }
}

__device__ __forceinline__ void phase_gate(const Frame& F, const PRef& p, int l) {
    const bf16_t* U = (const bf16_t*)(p.ws() + WS_U); bf16_t* ACT = (bf16_t*)(p.ws() + WS_ACT);
    const float* cw = p.in(16) + (size_t)l * 3 * 5632; const float* cb = p.in(17) + (size_t)l * 5632;
    const int gt = F.bid * NTHREADS + F.tid, ngt = F.G * NTHREADS;
    const int cg = gt % 352, tslot = gt / 352, nslot = ngt / 352;
    if (tslot >= nslot) return;
    const int c0 = cg * 8;
    float w0[2][8], w1[2][8], w2[2][8], bb[2][8];
#pragma unroll
    for (int half = 0; half < 2; ++half) {
        const int col = c0 + half * 2816;
#pragma unroll
        for (int q = 0; q < 2; ++q) {
            const f32x4 a = *(const f32x4*)(cw + col + q * 4), b = *(const f32x4*)(cw + 5632 + col + q * 4), c = *(const f32x4*)(cw + 2 * 5632 + col + q * 4), d = *(const f32x4*)(cb + col + q * 4);
#pragma unroll
            for (int j = 0; j < 4; ++j) { w0[half][q * 4 + j] = a[j]; w1[half][q * 4 + j] = b[j]; w2[half][q * 4 + j] = c[j]; bb[half][q * 4 + j] = d[j]; }
        }
    }
    bf16x8 cx[2][3], nx[2][3];
#define GATE_LOAD(dst, tok_) do { const int t_ = (tok_) < NCTX ? ((tok_) & 255) : (((tok_) - NCTX) & 1023), n_ = (tok_) < NCTX ? 256 : 1024; \
        const bf16x8 z_ = (bf16x8){0, 0, 0, 0, 0, 0, 0, 0}; \
        _Pragma("unroll") for (int half = 0; half < 2; ++half) { const bf16_t* up_ = U + (size_t)(tok_) * 5632 + c0 + half * 2816; \
            dst[half][1] = *(const bf16x8*)up_; dst[half][0] = t_ > 0 ? *(const bf16x8*)(up_ - 5632) : z_; dst[half][2] = t_ < n_ - 1 ? *(const bf16x8*)(up_ + 5632) : z_; } } while (0)
    if (tslot < NTOK) GATE_LOAD(cx, tslot);
    for (int tok = tslot; tok < NTOK; tok += nslot) {
        if (tok + nslot < NTOK) GATE_LOAD(nx, tok + nslot);
        float u2[2][8];
#pragma unroll
        for (int half = 0; half < 2; ++half)
#pragma unroll
            for (int j = 0; j < 8; ++j)
                u2[half][j] = bf2f((unsigned short)cx[half][0][j]) * w0[half][j] + bf2f((unsigned short)cx[half][1][j]) * w1[half][j] + bf2f((unsigned short)cx[half][2][j]) * w2[half][j] + bb[half][j];
        u32x4 w;
        w.x = pack2(siluf_(u2[0][0]) * u2[1][0], siluf_(u2[0][1]) * u2[1][1]); w.y = pack2(siluf_(u2[0][2]) * u2[1][2], siluf_(u2[0][3]) * u2[1][3]);
        w.z = pack2(siluf_(u2[0][4]) * u2[1][4], siluf_(u2[0][5]) * u2[1][5]); w.w = pack2(siluf_(u2[0][6]) * u2[1][6], siluf_(u2[0][7]) * u2[1][7]);
        *(u32x4*)(ACT + (size_t)tok * 2816 + c0) = w;
#pragma unroll
        for (int half = 0; half < 2; ++half)
#pragma unroll
            for (int q = 0; q < 3; ++q) cx[half][q] = nx[half][q];
    }
#undef GATE_LOAD
}

__device__ __forceinline__ void phase_l1_tok(const Frame& F, const PRef& p) {
    unsigned char* ws = p.ws();
    const float* P = (const float*)(ws + WS_P1);
    bf16_t* QD = (bf16_t*)(ws + WS_QD); bf16_t* KD = (bf16_t*)(ws + WS_KD); bf16_t* VDT = (bf16_t*)(ws + WS_VDT);
    float* RR = (float*)(ws + WS_RR); float* KR = (float*)(ws + WS_KR); float* VV = (float*)(ws + WS_VV); float* KK = (float*)(ws + WS_KK);
    bf16_t* TW = (bf16_t*)(ws + WS_TW); bf16_t* AD = (bf16_t*)(ws + WS_AD); bf16_t* SG = (bf16_t*)(ws + WS_SG);
    const int nw = F.G * 8, lane = F.lane;
    const float* mu = p.in(33);
    for (int row = F.bid * 8 + F.wave; row < NKROW; row += nw) {
        const bool istok = row < NTOK, lat = istok && row >= NCTX;
        int kr;
        if (row < NCTX) kr = row; else if (row < NTOK) { const int v = row - NCTX; kr = NCTX + (v >> 10) * 1536 + (v & 1023); }
        else { const int i = row - NTOK; kr = NCTX + (i >> 9) * 1536 + 1024 + (i & 511); }
        if (!istok) {
            const int i = row - NTOK;
#pragma unroll
            for (int j = 0; j < 8; ++j) {
                const int col = j * 64 + lane;
                KD[(size_t)kr * 512 + col] = f2bf(p.in(5)[(size_t)i * 512 + col]);
                VDT[(size_t)kr * 512 + col] = f2bf(p.in(6)[(size_t)i * 512 + col]);
            }
            continue;
        }
        const float* pr = P + (size_t)row * 3584;
        float cs = 1.f, sn = 0.f;
        if (lat) {
            const int t = (row - NCTX) & 1023, a = lane & 31;
            const float pos = a < 16 ? (float)(t >> 6) : (float)(t & 63);
            const float inv = __powf(10000.0f, -(float)(a & 15) * 0.0625f);
            const float ang = pos * inv; cs = __cosf(ang); sn = __sinf(ang);
        }
        {
            const int pi = lane & 31;
            f32x2 qv[4], kv[4];
#pragma unroll
            for (int pass = 0; pass < 4; ++pass) { const int vec = pass * 2 + (lane >> 5); qv[pass] = *(const f32x2*)(pr + vec * 64 + 2 * pi); kv[pass] = *(const f32x2*)(pr + 512 + vec * 64 + 2 * pi); }
            const f32x2 gq = *(const f32x2*)(p.in(29) + 2 * pi), gk = *(const f32x2*)(p.in(30) + 2 * pi);
#pragma unroll
            for (int pass = 0; pass < 4; ++pass) {
                const int vec = pass * 2 + (lane >> 5);
                {
                    const f32x2 v = qv[pass];
                    const float rstd = rsqrtf(half_sum(v[0] * v[0] + v[1] * v[1], lane) * (1.0f / 64.0f) + EPS);
                    const float x1 = v[0] * rstd * gq[0], x2 = v[1] * rstd * gq[1];
                    *(unsigned*)(QD + (size_t)row * 512 + vec * 64 + 2 * pi) = pack2((x1 * cs - x2 * sn) * 0.125f, (x1 * sn + x2 * cs) * 0.125f);
                }
                {
                    const f32x2 v = kv[pass];
                    const float rstd = rsqrtf(half_sum(v[0] * v[0] + v[1] * v[1], lane) * (1.0f / 64.0f) + EPS);
                    const float x1 = v[0] * rstd * gk[0], x2 = v[1] * rstd * gk[1];
                    if (row < NCTX) *(f32x2*)(p.out() + OUT_DK + (size_t)row * 512 + vec * 64 + 2 * pi) = (f32x2){x1, x2};
                    *(unsigned*)(KD + (size_t)kr * 512 + vec * 64 + 2 * pi) = pack2(x1 * cs - x2 * sn, x1 * sn + x2 * cs);
                }
            }
        }
#pragma unroll
        for (int j = 0; j < 8; ++j) {
            const int col = j * 64 + lane; const float v = pr[1024 + col];
            if (row < NCTX) p.out()[OUT_DV + (size_t)row * 512 + col] = v;
            VDT[(size_t)kr * 512 + col] = f2bf(v);
        }
        const int t = row < NCTX ? (row & 255) : ((row - NCTX) & 1023), n = row < NCTX ? 256 : 1024;
        const bool hp = t > 0, hn = t < n - 1;
        const float* pp = pr + 1536;
        const float* pn = pp + 3584; const float* pv = pp - 3584;
#define SHIFT4(col) ({ const f32x4 _c = *(const f32x4*)(pp + (col)); const f32x4 _p = hp ? *(const f32x4*)(pv + (col)) : (f32x4){0.f, 0.f, 0.f, 0.f}; \
            const f32x4 _n = hn ? *(const f32x4*)(pn + (col)) : (f32x4){0.f, 0.f, 0.f, 0.f}; const f32x4 _m = *(const f32x4*)(mu + (col)); _c + (0.5f * (_p + _n) - _c) * _m; })
        {
            const size_t o = (size_t)row * 512 + lane * 8;
            const f32x4 r0 = SHIFT4(lane * 8), r1 = SHIFT4(lane * 8 + 4);
            *(f32x4*)(RR + o) = r0; *(f32x4*)(RR + o + 4) = r1;
            const f32x4 k0 = SHIFT4(512 + lane * 8), k1 = SHIFT4(512 + lane * 8 + 4);
            *(f32x4*)(KR + o) = k0; *(f32x4*)(KR + o + 4) = k1;
            const f32x4 v0 = SHIFT4(1024 + lane * 8), v1 = SHIFT4(1024 + lane * 8 + 4);
            *(f32x4*)(VV + o) = v0; *(f32x4*)(VV + o + 4) = v1;
            const f32x4 kk0 = k0 * *(const f32x4*)(p.in(39) + lane * 8), kk1 = k1 * *(const f32x4*)(p.in(39) + lane * 8 + 4);
            float ss = (kk0[0] * kk0[0] + kk0[1] * kk0[1]) + (kk0[2] * kk0[2] + kk0[3] * kk0[3]) + (kk1[0] * kk1[0] + kk1[1] * kk1[1]) + (kk1[2] * kk1[2] + kk1[3] * kk1[3]);
            ss = oct_sum(ss);
            const float rn = rsqrtf(ss + EPS);
            *(f32x4*)(KK + o) = kk0 * rn; *(f32x4*)(KK + o + 4) = kk1 * rn;
        }
        {
            const f32x4 a = SHIFT4(1536 + lane * 4);
            u32x2 w;
            if (lane < 32) { w.x = pack2(tanhf_(a[0]), tanhf_(a[1])); w.y = pack2(tanhf_(a[2]), tanhf_(a[3])); *(u32x2*)(TW + (size_t)row * 128 + lane * 4) = w; }
            else { w.x = pack2(a[0], a[1]); w.y = pack2(a[2], a[3]); *(u32x2*)(AD + (size_t)row * 128 + (lane - 32) * 4) = w; }
            if (lane < 32) { const f32x4 g = SHIFT4(1792 + lane * 4); w.x = pack2(sigmoidf_(g[0]), sigmoidf_(g[1])); w.y = pack2(sigmoidf_(g[2]), sigmoidf_(g[3])); *(u32x2*)(SG + (size_t)row * 128 + lane * 4) = w; }
        }
#define SHIFTED(col) 0
#undef SHIFTED
    }
}

constexpr int SC_T = 16;
constexpr int SC_BUF = 2 * SC_T * 6 * 64;
__device__ __forceinline__ void phase_l1_mix(const Frame& F, const PRef& p) {
    unsigned char* ws = p.ws();
    const bf16_t* Q = (const bf16_t*)(ws + WS_QD); const bf16_t* K = (const bf16_t*)(ws + WS_KD); const bf16_t* VT = (const bf16_t*)(ws + WS_VDT);
    AttnOutBf16 ao{(bf16_t*)(ws + WS_DO), 1024};
    float gq = 0.f, gk = 0.f;
    for (int i = 0; i < 64; ++i) { gq = fmaxf(gq, fabsf(p.in(29)[i])); gk = fmaxf(gk, fabsf(p.in(30)[i])); }
    const float shift = 8.0f * gq * gk;
    for (int slot = 0; slot * F.G < 512; ++slot) { const int u = F.G == 256 ? attn_unit_xcd(F.bid, slot) : F.bid + slot * F.G; if (u < 512) attn_block<64, 128, 4>(F, Q, K, VT, ao, u, shift); }
}

__device__ __forceinline__ float dpp_xor1(float x) { return __int_as_float(__builtin_amdgcn_update_dpp(0, __float_as_int(x), 0xB1, 0xF, 0xF, true)); }
__device__ __forceinline__ float dpp_xor2(float x) { return __int_as_float(__builtin_amdgcn_update_dpp(0, __float_as_int(x), 0x4E, 0xF, 0xF, true)); }
#define VFMA(d, a, b, c) asm("v_fma_f32 %0, %1, %2, %3" : "=v"(d) : "v"(a), "v"(b), "v"(c))
#define VFMAN(d, a, b, c) asm("v_fma_f32 %0, -%1, %2, %3" : "=v"(d) : "v"(a), "v"(b), "v"(c))
#define VMUL(d, a, b) asm("v_mul_f32 %0, %1, %2" : "=v"(d) : "v"(a), "v"(b))
#define VADD(d, a, b) asm("v_add_f32 %0, %1, %2" : "=v"(d) : "v"(a), "v"(b))
#define QUAD_SUM_ASM(x) asm("s_nop 1\n\tv_add_f32_dpp %0, %0, %0 quad_perm:[1,0,3,2] row_mask:0xf bank_mask:0xf bound_ctrl:1\n\ts_nop 1\n\t" \
    "v_add_f32_dpp %0, %0, %0 quad_perm:[2,3,0,1] row_mask:0xf bank_mask:0xf bound_ctrl:1" : "+v"(x))
#define ROW16_SUM_ASM(x) asm("s_nop 1\n\tv_add_f32_dpp %0, %0, %0 quad_perm:[1,0,3,2] row_mask:0xf bank_mask:0xf bound_ctrl:1\n\ts_nop 1\n\t" \
    "v_add_f32_dpp %0, %0, %0 quad_perm:[2,3,0,1] row_mask:0xf bank_mask:0xf bound_ctrl:1\n\ts_nop 1\n\t" \
    "v_add_f32_dpp %0, %0, %0 row_half_mirror row_mask:0xf bank_mask:0xf bound_ctrl:1\n\ts_nop 1\n\t" \
    "v_add_f32_dpp %0, %0, %0 row_mirror row_mask:0xf bank_mask:0xf bound_ctrl:1" : "+v"(x))
constexpr int SREC = 400;
template <int KPL> struct ScanVecs { f32x4 w[KPL / 4], kka[KPL / 4], kd[KPL / 4], kk[KPL / 4], r[KPL / 4]; float v, c1, c2; };
template <int KPL>
__device__ __forceinline__ void scan_load(ScanVecs<KPL>& x, const LAS float* v6, int koff, int row) {
#pragma unroll
    for (int q = 0; q < KPL / 4; ++q) {
        x.w[q] = *(const LAS f32x4*)(v6 + 0 * 64 + koff + q * 4); x.kka[q] = *(const LAS f32x4*)(v6 + 1 * 64 + koff + q * 4); x.kd[q] = *(const LAS f32x4*)(v6 + 2 * 64 + koff + q * 4);
        x.kk[q] = *(const LAS f32x4*)(v6 + 3 * 64 + koff + q * 4); x.r[q] = *(const LAS f32x4*)(v6 + 4 * 64 + koff + q * 4);
    }
    x.v = v6[5 * 64 + row]; x.c1 = v6[384]; x.c2 = v6[385];
}
template <int MODE>
__device__ __forceinline__ void scan_unit(const Frame& F, const PRef& p, int unit) {
    constexpr int T = 32, NSTEPS = MODE == 0 ? 1024 : 256, BUF = T * SREC, NCHUNK = NSTEPS / T;
    constexpr int KPL = MODE == 0 ? 4 : 16, NQ = KPL / 4;
    unsigned char* ws = p.ws();
    const float* RR = (const float*)(ws + WS_RR); const float* KR = (const float*)(ws + WS_KR); const float* VV = (const float*)(ws + WS_VV); const float* KK = (const float*)(ws + WS_KK);
    const float* DEC = (const float*)(ws + WS_DEC); const float* AA = (const float*)(ws + WS_AA);
    float* YY = (float*)(ws + WS_YY);
    const float* k_a = p.in(40);
    LAS float* sb = (LAS float*)F.lds;
    const int lane = F.lane;
    const bool loader = F.wave >= 4;
    const bool compute = F.wave < 4;
    const int cid = MODE == 0 ? (unit >> 2) : unit;
    const int cb = cid >> 4, chh = (cid >> 1) & 7, cd = cid & 1;
    const int cbase = MODE == 0 ? NCTX + cb * 1024 : cb * 256;
    if (loader) {
        const int lt = F.tid - 256;
        f32x4 pa[2][6], pb[2][6];
        const f32x4 ka4 = *(const f32x4*)(k_a + chh * 64 + (lt & 15) * 4), rk4 = *(const f32x4*)(p.in(41) + chh * 64 + (lt & 15) * 4);
        float* BON = (float*)(ws + WS_BON) + (size_t)cd * NTOK * 8 + chh;
        const bool wbon = MODE == 1 || (unit & 3) == 0;
#define SC_LOAD(pre, chunk) do { _Pragma("unroll") for (int it = 0; it < 2; ++it) { const int item = it * 256 + lt; const int stp = item >> 4, k = (item & 15) * 4; \
            const int j_ = (chunk) * T + stp; const int tok = cbase + (cd ? NSTEPS - 1 - j_ : j_); const size_t o_ = (size_t)tok * 512 + chh * 64 + k; \
            pre[it][0] = *(const f32x4*)(DEC + (size_t)cd * NTOK * 512 + o_); pre[it][1] = *(const f32x4*)(AA + (size_t)cd * NTOK * 512 + o_); pre[it][2] = *(const f32x4*)(KR + o_); \
            pre[it][3] = *(const f32x4*)(KK + o_); pre[it][4] = *(const f32x4*)(RR + o_); pre[it][5] = *(const f32x4*)(VV + o_); } } while (0)
#define SC_WRITE(pre, buf, chunk) do { _Pragma("unroll") for (int it = 0; it < 2; ++it) { const int item = it * 256 + lt; const int stp = item >> 4, k = (item & 15) * 4; \
            const f32x4 a_ = pre[it][1], kk_ = pre[it][3], r_ = pre[it][4], w_ = pre[it][0]; LAS float* d_ = sb + (buf) * BUF + stp * SREC + k; \
            const f32x4 bb_ = kk_ * a_, kd_ = pre[it][2] * (1.0f + (a_ - 1.0f) * ka4); \
            *(LAS f32x4*)(d_) = w_; *(LAS f32x4*)(d_ + 64) = bb_; *(LAS f32x4*)(d_ + 128) = kd_; *(LAS f32x4*)(d_ + 192) = kk_; \
            *(LAS f32x4*)(d_ + 256) = w_ * r_; *(LAS f32x4*)(d_ + 320) = pre[it][5]; \
            const f32x4 p1_ = bb_ * r_, p2_ = kd_ * r_; const float c1_ = row16_sum((p1_[0] + p1_[1]) + (p1_[2] + p1_[3])), c2_ = row16_sum((p2_[0] + p2_[1]) + (p2_[2] + p2_[3])); \
            const f32x4 p3_ = p2_ * rk4; const float c3_ = row16_sum((p3_[0] + p3_[1]) + (p3_[2] + p3_[3])); \
            if ((lt & 15) == 0) { LAS float* e_ = sb + (buf) * BUF + stp * SREC + 384; e_[0] = c1_; e_[1] = c2_; \
                if (wbon) { const int j2_ = (chunk) * T + stp; BON[(size_t)(cbase + (cd ? NSTEPS - 1 - j2_ : j2_)) * 8] = c3_; } } } } while (0)
        SC_LOAD(pa, 0); SC_LOAD(pb, 1); SC_WRITE(pa, 0, 0); SC_LOAD(pa, 2);
        __syncthreads();
        for (int cnk = 0; cnk < NCHUNK; cnk += 2) {
            if (cnk + 1 < NCHUNK) { SC_WRITE(pb, (cnk + 1) & 1, cnk + 1); if (cnk + 3 < NCHUNK) SC_LOAD(pb, cnk + 3); }
            __syncthreads();
            if (cnk + 2 < NCHUNK) { SC_WRITE(pa, (cnk + 2) & 1, cnk + 2); if (cnk + 4 < NCHUNK) SC_LOAD(pa, cnk + 4); }
            __syncthreads();
        }
#undef SC_LOAD
#undef SC_WRITE
    } else if (compute) {
        const int row = MODE == 0 ? (unit & 3) * 16 + F.wave * 4 + (lane >> 4) : F.wave * 16 + (lane >> 2);
        const int kq = MODE == 0 ? (lane & 15) : (lane & 3), koff = kq * KPL;
        f32x4 S[NQ];
        if (MODE == 0) {
            const float* s0 = p.in(7) + (size_t)(((cb * 2 + cd) * 8 + chh) * 64 + row) * 64 + koff;
#pragma unroll
            for (int q = 0; q < NQ; ++q) S[q] = *(const f32x4*)(s0 + q * 4);
        } else {
#pragma unroll
            for (int q = 0; q < NQ; ++q) S[q] = (f32x4){0.f, 0.f, 0.f, 0.f};
        }
        __syncthreads();
        float* yp = YY + (size_t)cd * NTOK * 512 + chh * 64 + row;
        for (int cnk = 0; cnk < NCHUNK; ++cnk) {
            const LAS float* bufp = sb + (cnk & 1) * BUF;
            ScanVecs<KPL> cur, nxt;
            scan_load<KPL>(cur, bufp, koff, row);
#pragma unroll 2
            for (int stp = 0; stp < T; ++stp) {
                scan_load<KPL>(nxt, bufp + (stp + 1 < T ? stp + 1 : stp) * SREC, koff, row);
                const int j_ = cnk * T + stp; const int tok = cbase + (cd ? NSTEPS - 1 - j_ : j_);
                f32x4 a4 = S[0] * cur.kk[0], y4 = S[0] * cur.r[0];
#pragma unroll
                for (int q = 1; q < NQ; ++q) { a4 = a4 + S[q] * cur.kk[q]; y4 = y4 + S[q] * cur.r[q]; }
                float sa = (a4[0] + a4[1]) + (a4[2] + a4[3]), ys = (y4[0] + y4[1]) + (y4[2] + y4[3]);
                if (MODE == 0) {
                    sa += DPPF(sa, 0xB1); ys += DPPF(ys, 0xB1); sa += DPPF(sa, 0x4E); ys += DPPF(ys, 0x4E);
                    sa += DPPF(sa, 0x141); ys += DPPF(ys, 0x141); sa += DPPF(sa, 0x140); ys += DPPF(ys, 0x140);
                } else { sa += DPPF(sa, 0xB1); ys += DPPF(ys, 0xB1); sa += DPPF(sa, 0x4E); ys += DPPF(ys, 0x4E); }
                const float vr = cur.v;
#pragma unroll
                for (int q = 0; q < NQ; ++q) S[q] = S[q] * cur.w[q] + (vr * cur.kd[q] - sa * cur.kka[q]);
                if (kq == 0) yp[(size_t)tok * 512] = ys - sa * cur.c1 + vr * cur.c2;
                cur = nxt;
            }
            __syncthreads();
        }
        if (MODE == 1) {
            float* so = p.out() + OUT_SRWKV + (size_t)(((cb * 2 + cd) * 8 + chh) * 64 + row) * 64 + koff;
#pragma unroll
            for (int q = 0; q < NQ; ++q) *(f32x4*)(so + q * 4) = S[q];
        }
    } else {
        __syncthreads();
        for (int cnk = 0; cnk < NCHUNK; ++cnk) __syncthreads();
    }
}
constexpr int CI_AP = 0, CI_RH = 2304, CI_BT = 4608, CI_KT = 7168, CI_MP = 9728, CI_PP = 10368, CI_GL = 11520, CI_VT = 11776, CI_SZ = 14336;
constexpr int CS_AH = 0, CS_BH = 2304, CS_KH = 4608, CS_SZ = 6912;
constexpr int CS_NM = CS_BH, CS_TM = CS_BH + 1024, CS_MM = CS_BH + 2048;
constexpr int CIMG0 = 0, CSCR0 = 8 * CI_SZ;
static_assert(CSCR0 + 4 * CS_SZ <= LDS_BYTES - LDS_WORK, "chunked scan LDS");
constexpr size_t WS_GIMG = WS_HB;
static_assert((size_t)32 * 12 * 4 * CI_SZ <= (size_t)2 * NTOK * 1024 * 2, "hand-off images do not fit HB + OB");
constexpr int SCAN_FLAG_WORD = 3584;
template <int MODE, int ROLE>
__device__ __forceinline__ void scanc_unit(const Frame& F, const PRef& p, int cid, int hid = 0) {
    constexpr int NSTEPS = MODE == 0 ? 1024 : 256, NCH = NSTEPS / 16, NG = NCH / 4;
    unsigned char* ws = p.ws();
    const float* RR = (const float*)(ws + WS_RR); const float* KR = (const float*)(ws + WS_KR); const float* VV = (const float*)(ws + WS_VV); const float* KK = (const float*)(ws + WS_KK);
    const float* DEC = (const float*)(ws + WS_DEC); const float* AA = (const float*)(ws + WS_AA);
    float* YY = (float*)(ws + WS_YY);
    LAS unsigned char* L = F.lds;
    const int lane = F.lane, fr = lane & 15, g = lane >> 4, w = F.wave;
    const int cb = cid >> 4, chh = (cid >> 1) & 7, cd = cid & 1;
    const int cbase = MODE == 0 ? NCTX + cb * 1024 : cb * 256;
#define TOK_OF(step) (cbase + (cd ? NSTEPS - 1 - (step) : (step)))
    unsigned* hflag = (unsigned*)(ws + WS_BAR) + SCAN_FLAG_WORD + cid * 16;
    unsigned char* gimg = ws + WS_GIMG + (size_t)cid * 12 * 4 * CI_SZ;
    const __amdgpu_buffer_rsrc_t grs = wt_rsrc(gimg, (size_t)12 * 4 * CI_SZ);
    if (w >= 4 || ROLE == 2) {
        if (ROLE == 2 && w < 4) {
            for (int grp = hid; grp < NG; grp += 4) {
                const int og = grp - (grp >> 2) - 1;
                __syncthreads();
                for (int i = F.tid; i < 4 * CI_SZ / 16; i += NTHREADS) wt_store16(grs, (size_t)og * 4 * CI_SZ + (size_t)i * 16, *(const LAS u32x4*)(L + CIMG0 + (size_t)i * 16));
                asm volatile("s_waitcnt vmcnt(0)" ::: "memory");
                __syncthreads();
                if (F.tid == 0) __hip_atomic_store(hflag + grp, 1u, __ATOMIC_RELAXED, __HIP_MEMORY_SCOPE_AGENT);
                __syncthreads();
            }
            return;
        }
        const int j = w - 4, k = lane;
        LAS unsigned char* SC = L + CSCR0 + j * CS_SZ;
        const float ka = p.in(40)[chh * 64 + k];
        const size_t colo = (size_t)chh * 64 + k;
        const float* decp = DEC + (size_t)cd * NTOK * 512; const float* aap = AA + (size_t)cd * NTOK * 512;
        float rw[16], rkk[16], ra[16], rkr[16], rr[16], rv[16];
#define PREP_LOAD(chunk) do { _Pragma("unroll") for (int t = 0; t < 16; ++t) { const size_t o_ = (size_t)TOK_OF((chunk) * 16 + t) * 512 + colo; \
            rw[t] = decp[o_]; rkk[t] = KK[o_]; ra[t] = aap[o_]; rkr[t] = KR[o_]; rr[t] = RR[o_]; rv[t] = VV[o_]; } } while (0)
        PREP_LOAD(ROLE == 2 ? hid * 4 + j : j);
        for (int grp = (ROLE == 2 ? hid : 0); grp < NG; grp += (ROLE == 2 ? 4 : 1)) {
            LAS unsigned char* IM = L + CIMG0 + ((ROLE == 2 ? 0 : (grp & 1) * 4) + j) * CI_SZ;
            if (ROLE == 1 && (grp & 3)) {
                if (lane == 0) { unsigned sp = 0; while (__hip_atomic_load(hflag + grp, __ATOMIC_RELAXED, __HIP_MEMORY_SCOPE_AGENT) == 0u && ++sp < (1u << 22)) __builtin_amdgcn_s_sleep(2); }
                asm volatile("" ::: "memory");
                for (int i = lane; i < CI_SZ / 16; i += 64)
                    *(LAS u32x4*)(IM + (size_t)i * 16) = __builtin_bit_cast(u32x4, __builtin_amdgcn_raw_buffer_load_b128(grs, (int)(((size_t)(grp - (grp >> 2) - 1) * 4 + j) * CI_SZ + (size_t)i * 16), 0, 16));
                __syncthreads();
                continue;
            }
            float ah[16]; float G = 1.0f;
#pragma unroll
            for (int t2 = 0; t2 < 8; ++t2) {
                float bh2[2], kh2[2];
#pragma unroll
                for (int u = 0; u < 2; ++u) {
                    const int t = 2 * t2 + u;
                    const float bb = rkk[t] * ra[t], kd = rkr[t] * (1.0f + (ra[t] - 1.0f) * ka);
                    ah[t] = -rkk[t] * G;
                    G *= rw[t];
                    const float inv = __builtin_amdgcn_rcpf(G);
                    const float bh = bb * inv, kh = kd * inv, rh = rr[t] * G;
                    bh2[u] = bh; kh2[u] = kh;
                    *(LAS bf16_t*)(SC + CS_AH + t * 144 + k * 2) = f2bf(ah[t]);
                    *(LAS bf16_t*)(SC + CS_BH + t * 144 + k * 2) = f2bf(bh);
                    *(LAS bf16_t*)(SC + CS_KH + t * 144 + k * 2) = f2bf(kh);
                    *(LAS bf16_t*)(IM + CI_RH + t * 144 + k * 2) = f2bf(rh);
                }
                *(LAS unsigned*)(IM + CI_BT + k * 40 + t2 * 4) = pack2(bh2[0], bh2[1]);
                *(LAS unsigned*)(IM + CI_KT + k * 40 + t2 * 4) = pack2(kh2[0], kh2[1]);
                *(LAS unsigned*)(IM + CI_VT + k * 40 + t2 * 4) = pack2(rv[2 * t2], rv[2 * t2 + 1]);
            }
            *(LAS float*)(IM + CI_GL + k * 4) = G;
            { const int ng_ = grp + (ROLE == 0 ? 1 : 4); if (ng_ < NG) PREP_LOAD(ng_ * 4 + j); }
            f32x4 dN = (f32x4){0.f, 0.f, 0.f, 0.f}, dM = dN, dPb = dN, dPk = dN;
#pragma unroll
            for (int s = 0; s < 2; ++s) {
                const int fo = fr * 144 + (4 * s + g) * 16;
                const bf16x8 fa = *(const LAS bf16x8*)(SC + CS_AH + fo), fb = *(const LAS bf16x8*)(SC + CS_BH + fo), fk = *(const LAS bf16x8*)(SC + CS_KH + fo), frh = *(const LAS bf16x8*)(IM + CI_RH + fo);
                dN = __builtin_amdgcn_mfma_f32_16x16x32_bf16(fa, fb, dN, 0, 0, 0); dM = __builtin_amdgcn_mfma_f32_16x16x32_bf16(fa, fk, dM, 0, 0, 0);
                dPb = __builtin_amdgcn_mfma_f32_16x16x32_bf16(frh, fb, dPb, 0, 0, 0); dPk = __builtin_amdgcn_mfma_f32_16x16x32_bf16(frh, fk, dPk, 0, 0, 0);
            }
#pragma unroll
            for (int r = 0; r < 4; ++r) {
                const int t = 4 * g + r;
                *(LAS float*)(SC + CS_MM + (t * 16 + fr) * 4) = fr < t ? dM[r] : 0.f;
                *(LAS bf16_t*)(IM + CI_PP + t * 72 + fr * 2) = f2bf(fr <= t ? dPb[r] : 0.f);
                *(LAS bf16_t*)(IM + CI_PP + t * 72 + (16 + fr) * 2) = f2bf(fr <= t ? dPk[r] : 0.f);
            }
            float Tc[16];
            Tc[0] = fr == 0 ? 1.0f : 0.f;
#pragma unroll
            for (int i = 1; i < 16; ++i) {
                float s0_ = fr == i ? 1.0f : 0.f, s1_ = 0.f;
#pragma unroll
                for (int jj = 0; jj < i; ++jj) {
                    const float nij = RDLANE(dN[i & 3], jj + 16 * (i >> 2));
                    if (jj & 1) s1_ += nij * Tc[jj]; else s0_ += nij * Tc[jj];
                }
                Tc[i] = s0_ + s1_;
            }
            if (g == 0) {
#pragma unroll
                for (int i = 0; i < 16; ++i) *(LAS float*)(SC + CS_TM + (i * 16 + fr) * 4) = Tc[i];
            }
#pragma unroll
            for (int i = 0; i < 16; ++i) {
                float s0_ = 0.f, s1_ = 0.f;
#pragma unroll
                for (int jj = 0; jj <= i; ++jj) { const float tij = RDLANE(Tc[i], jj); if (jj & 1) s1_ += tij * ah[jj]; else s0_ += tij * ah[jj]; }
                *(LAS bf16_t*)(IM + CI_AP + i * 144 + k * 2) = f2bf(s0_ + s1_);
            }
            {
                const int i = lane >> 2, j4 = (lane & 3) * 4;
                f32x4 macc = (f32x4){0.f, 0.f, 0.f, 0.f};
#pragma unroll
                for (int t = 0; t < 16; ++t) macc += *(const LAS f32x4*)(SC + CS_MM + (t * 16 + j4) * 4) * *(const LAS float*)(SC + CS_TM + (i * 16 + t) * 4);
                u32x2 pk; pk.x = pack2(macc[0], macc[1]); pk.y = pack2(macc[2], macc[3]);
                *(LAS u32x2*)(IM + CI_MP + i * 40 + j4 * 2) = pk;
            }
            if (ROLE == 2) {
                const int og = grp - (grp >> 2) - 1;
                __syncthreads();
                for (int i = F.tid; i < 4 * CI_SZ / 16; i += NTHREADS) wt_store16(grs, (size_t)og * 4 * CI_SZ + (size_t)i * 16, *(const LAS u32x4*)(L + CIMG0 + (size_t)i * 16));
                asm volatile("s_waitcnt vmcnt(0)" ::: "memory");
                __syncthreads();
                __syncthreads();
                continue;
            }
            __syncthreads();
        }
        if (ROLE == 2) return;
        __syncthreads();
#undef PREP_LOAD
    } else {
        f32x4 S[4];
        if (MODE == 0) {
            const float* s0 = p.in(7) + (size_t)(((cb * 2 + cd) * 8 + chh) * 64 + 16 * w + fr) * 64;
#pragma unroll
            for (int kt = 0; kt < 4; ++kt) S[kt] = *(const f32x4*)(s0 + 16 * kt + 4 * g);
        } else {
#pragma unroll
            for (int kt = 0; kt < 4; ++kt) S[kt] = (f32x4){0.f, 0.f, 0.f, 0.f};
        }
        float* yp = YY + (size_t)cd * NTOK * 512 + chh * 64 + 16 * w + fr;
        __syncthreads();
        for (int grp = 0; grp < NG; ++grp) {
#pragma unroll
            for (int c4 = 0; c4 < 4; ++c4) {
                const LAS unsigned char* IM = L + CIMG0 + ((grp & 1) * 4 + c4) * CI_SZ;
                u32x2 oa[2][2], orh[2][2], obt[4], okt[4]; f32x4 ogl[4];
#pragma unroll
                for (int s = 0; s < 2; ++s) {
                    oa[s][0] = *(const LAS u32x2*)(IM + CI_AP + fr * 144 + (32 * s + 4 * g) * 2); oa[s][1] = *(const LAS u32x2*)(IM + CI_AP + fr * 144 + (32 * s + 16 + 4 * g) * 2);
                    orh[s][0] = *(const LAS u32x2*)(IM + CI_RH + fr * 144 + (32 * s + 4 * g) * 2); orh[s][1] = *(const LAS u32x2*)(IM + CI_RH + fr * 144 + (32 * s + 16 + 4 * g) * 2);
                }
                const u32x2 vq = *(const LAS u32x2*)(IM + CI_VT + (16 * w + fr) * 40 + g * 8);
                const u32x2 m0 = *(const LAS u32x2*)(IM + CI_MP + fr * 40 + g * 8);
                const u32x2 p0 = *(const LAS u32x2*)(IM + CI_PP + fr * 72 + g * 8), p1 = *(const LAS u32x2*)(IM + CI_PP + fr * 72 + 32 + g * 8);
#pragma unroll
                for (int kt = 0; kt < 4; ++kt) {
                    obt[kt] = *(const LAS u32x2*)(IM + CI_BT + (16 * kt + fr) * 40 + g * 8); okt[kt] = *(const LAS u32x2*)(IM + CI_KT + (16 * kt + fr) * 40 + g * 8);
                    ogl[kt] = *(const LAS f32x4*)(IM + CI_GL + (16 * kt + 4 * g) * 4);
                }
                bf16x8 Sp[2];
#pragma unroll
                for (int s = 0; s < 2; ++s) { u32x4 pk; pk.x = pack2(S[2 * s][0], S[2 * s][1]); pk.y = pack2(S[2 * s][2], S[2 * s][3]); pk.z = pack2(S[2 * s + 1][0], S[2 * s + 1][1]); pk.w = pack2(S[2 * s + 1][2], S[2 * s + 1][3]); Sp[s] = __builtin_bit_cast(bf16x8, pk); }
                f32x4 U = (f32x4){0.f, 0.f, 0.f, 0.f}, Y = U;
#pragma unroll
                for (int s = 0; s < 2; ++s) {
                    U = __builtin_amdgcn_mfma_f32_16x16x32_bf16(__builtin_bit_cast(bf16x8, (u32x4){oa[s][0].x, oa[s][0].y, oa[s][1].x, oa[s][1].y}), Sp[s], U, 0, 0, 0);
                    Y = __builtin_amdgcn_mfma_f32_16x16x32_bf16(__builtin_bit_cast(bf16x8, (u32x4){orh[s][0].x, orh[s][0].y, orh[s][1].x, orh[s][1].y}), Sp[s], Y, 0, 0, 0);
                }
                U = __builtin_amdgcn_mfma_f32_16x16x32_bf16(__builtin_bit_cast(bf16x8, (u32x4){m0.x, m0.y, 0u, 0u}), __builtin_bit_cast(bf16x8, (u32x4){vq.x, vq.y, vq.x, vq.y}), U, 0, 0, 0);
                u32x4 uvk; uvk.x = pack2(U[0], U[1]); uvk.y = pack2(U[2], U[3]); uvk.z = vq.x; uvk.w = vq.y;
                const bf16x8 UV = __builtin_bit_cast(bf16x8, uvk);
#pragma unroll
                for (int kt = 0; kt < 4; ++kt) {
                    const f32x4 acc = __builtin_amdgcn_mfma_f32_16x16x32_bf16(__builtin_bit_cast(bf16x8, (u32x4){obt[kt].x, obt[kt].y, okt[kt].x, okt[kt].y}), UV, S[kt], 0, 0, 0);
                    S[kt] = acc * ogl[kt];
                }
                Y = __builtin_amdgcn_mfma_f32_16x16x32_bf16(__builtin_bit_cast(bf16x8, (u32x4){p0.x, p0.y, p1.x, p1.y}), UV, Y, 0, 0, 0);
                const int step0 = (grp * 4 + c4) * 16 + 4 * g;
#pragma unroll
                for (int r = 0; r < 4; ++r) yp[(size_t)TOK_OF(step0 + r) * 512] = Y[r];
            }
            __syncthreads();
        }
        if (MODE == 1) {
            float* so = p.out() + OUT_SRWKV + (size_t)(((cb * 2 + cd) * 8 + chh) * 64 + 16 * w + fr) * 64;
#pragma unroll
            for (int kt = 0; kt < 4; ++kt) *(f32x4*)(so + 16 * kt + 4 * g) = S[kt];
        }
    }
#undef TOK_OF
}
__device__ __forceinline__ void phase_l1_scanc(const Frame& F, const PRef& p) {
    if (F.G > 128) {
        if (F.bid < 32) scanc_unit<0, 1>(F, p, F.bid);
        else if (F.bid < 128) scanc_unit<0, 2>(F, p, (F.bid - 32) & 31, 1 + ((F.bid - 32) >> 5));
        else for (int u = F.bid - 128; u < 256; u += F.G - 128) scanc_unit<1, 0>(F, p, u);
    } else { FOR_UNITS(u, 288, 0) { if (u < 32) scanc_unit<0, 0>(F, p, u); else scanc_unit<1, 0>(F, p, u - 32); } }
}
__device__ __forceinline__ void phase_l1_scan(const Frame& F, const PRef& p) {
    const int half = F.G / 2;
    if (F.bid < half) {
        for (int u = F.bid; u < 128; u += half) { const int xcd = u & 7, idx = u >> 3; scan_unit<0>(F, p, (((idx >> 2) * 8 + xcd) << 2) | (idx & 3)); }
    } else {
        for (int u = F.bid - half; u < 256; u += F.G - half) scan_unit<1>(F, p, u);
    }
}

__device__ __forceinline__ void phase_l1_comb(const Frame& F, const PRef& p) {
    unsigned char* ws = p.ws();
    const float* RR = (const float*)(ws + WS_RR); const float* KR = (const float*)(ws + WS_KR); const float* VV = (const float*)(ws + WS_VV);
    const float* AA = (const float*)(ws + WS_AA); const float* GG = (const float*)(ws + WS_GG); const float* YY = (const float*)(ws + WS_YY);
    bf16_t* OB = (bf16_t*)(ws + WS_OB);
    const int nw = F.G * 8, lane = F.lane;
    const bf16_t* DO = (const bf16_t*)(ws + WS_DO);
    const float lam_init = 0.8f - 0.6f * 0.74081822068171788f;
    const float lam = __expf(wave_sum(p.in(31)[lane] * p.in(31)[64 + lane])) - __expf(wave_sum(p.in(31)[128 + lane] * p.in(31)[192 + lane])) + lam_init;
    for (int row = F.bid * 8 + F.wave; row < NTOK; row += nw) {
#pragma unroll
        for (int h = 0; h < 4; ++h) {
            const unsigned a = *(const unsigned*)(DO + (size_t)row * 1024 + (2 * h) * 128 + 2 * lane), b = *(const unsigned*)(DO + (size_t)row * 1024 + (2 * h + 1) * 128 + 2 * lane);
            const float d0 = bf2f(a & 0xffffu) - lam * bf2f(b & 0xffffu), d1 = bf2f(a >> 16) - lam * bf2f(b >> 16);
            const float rstd = rsqrtf(wave_sum(d0 * d0 + d1 * d1) * (1.0f / 128.0f) + EPS) * (1.0f - lam_init);
            const f32x2 gn = *(const f32x2*)(p.in(32) + h * 128 + 2 * lane);
            *(unsigned*)(OB + (size_t)row * 1024 + h * 128 + 2 * lane) = pack2(d0 * rstd * gn[0], d1 * rstd * gn[1]);
        }
        const size_t o = (size_t)row * 512 + lane * 8;
        const f32x4 yf0 = *(const f32x4*)(YY + o), yf1 = *(const f32x4*)(YY + o + 4), yb0 = *(const f32x4*)(YY + (size_t)NTOK * 512 + o), yb1 = *(const f32x4*)(YY + (size_t)NTOK * 512 + o + 4);
        const f32x4 v0 = *(const f32x4*)(VV + o), v1 = *(const f32x4*)(VV + o + 4), g0 = *(const f32x4*)(GG + o), g1 = *(const f32x4*)(GG + o + 4);
        const f32x4 n0 = *(const f32x4*)(p.in(42) + lane * 8), n1 = *(const f32x4*)(p.in(42) + lane * 8 + 4);
        const float* BON = (const float*)(ws + WS_BON);
#if CHUNKED_SCAN
        float bs = 0.f;
        {
            const f32x4 r0 = *(const f32x4*)(RR + o), r1 = *(const f32x4*)(RR + o + 4), k0 = *(const f32x4*)(KR + o), k1 = *(const f32x4*)(KR + o + 4);
            const f32x4 af0 = *(const f32x4*)(AA + o), af1 = *(const f32x4*)(AA + o + 4), ab0 = *(const f32x4*)(AA + (size_t)NTOK * 512 + o), ab1 = *(const f32x4*)(AA + (size_t)NTOK * 512 + o + 4);
            const f32x4 ka0 = *(const f32x4*)(p.in(40) + lane * 8), ka1 = *(const f32x4*)(p.in(40) + lane * 8 + 4), rk0 = *(const f32x4*)(p.in(41) + lane * 8), rk1 = *(const f32x4*)(p.in(41) + lane * 8 + 4);
            const f32x4 t0 = r0 * rk0 * k0 * (2.0f + (af0 + ab0 - 2.0f) * ka0), t1 = r1 * rk1 * k1 * (2.0f + (af1 + ab1 - 2.0f) * ka1);
            bs = oct_sum((t0[0] + t0[1]) + (t0[2] + t0[3]) + (t1[0] + t1[1]) + (t1[2] + t1[3]));
        }
#else
        const float bs = BON[(size_t)row * 8 + (lane >> 3)] + BON[(size_t)NTOK * 8 + (size_t)row * 8 + (lane >> 3)];
#endif
        const f32x4 y0 = yf0 + yb0, y1 = yf1 + yb1;
        float ss = (y0[0] * y0[0] + y0[1] * y0[1]) + (y0[2] * y0[2] + y0[3] * y0[3]) + (y1[0] * y1[0] + y1[1] * y1[1]) + (y1[2] * y1[2] + y1[3] * y1[3]);
        ss = oct_sum(ss);
        const float rstd = rsqrtf(ss * (1.0f / 64.0f) + EPS);
        const f32x4 o0 = (y0 * rstd * n0 + bs * v0) * g0, o1 = (y1 * rstd * n1 + bs * v1) * g1;
        u32x4 w; w.x = pack2(o0[0], o0[1]); w.y = pack2(o0[2], o0[3]); w.z = pack2(o1[0], o1[1]); w.w = pack2(o1[2], o1[3]);
        *(u32x4*)(OB + (size_t)row * 1024 + 512 + lane * 8) = w;
    }
}

constexpr int NPHASE = 26;
#ifndef PH_ONLY
#define PH_ONLY -1
#endif
#if ONE_LAUNCH
#define SEAM() xcd_barrier(bar)
#else
#define SEAM() do {} while (0)
#endif
#define IN(k) (lo <= (k) && (k) < hi && (PH_ONLY < 0 || (k) == PH_ONLY))
#define END(k) do { if (IN((k) + 1)) SEAM(); } while (0)
#ifndef REP_MASK
#define REP_MASK 0u
#endif
#define REPS(k) for (int rep_ = 0; rep_ < 1 + (int)(((unsigned)REP_MASK >> (k)) & 1u); ++rep_, __syncthreads())

constexpr size_t WS_PARTA = WS_BIG;
constexpr size_t WS_PARTD = WS_U;
static_assert(WS_PARTD + (size_t)2 * NTOK * 1024 * 4 <= WS_ACT, "down-projection slabs overlap ACT");
template <int l>
__device__ __forceinline__ void layer_phases(const Frame& F, const PRef& p, const int lo, const int hi, const XcdBarrier bar) {
    constexpr int pb = 1 + l * 12;
    if (IN(pb + 0)) { REPS(pb + 0) {
        unsigned char* ws = p.ws(); const float* ml = (const float*)(ws + WS_MOD) + (size_t)l * 3 * 6144;
        if (l == 0) phase_norm(F, p.in(0), p.in(1), nullptr, nullptr, nullptr, p.in(12), ml + 1024, ml + 0, (bf16_t*)(ws + WS_HB), true);
        else { float* xbuf = p.out(); phase_norm(F, xbuf, xbuf + (size_t)NCTX * 1024, (const bf16_t*)(ws + WS_PARTD), (const float*)(ws + WS_MOD) + 5120, xbuf, p.in(12) + 1024, ml + 1024, ml + 0, (bf16_t*)(ws + WS_HB), true); }
        } END(pb + 0); }
    if (IN(pb + 1)) { REPS(pb + 1) {
        unsigned char* ws = p.ws();
        if (l == 0) { BigDesc g{(const bf16_t*)(ws + WS_HB), (const bf16_t*)(ws + WS_WAIN), 1024, 1024, 24, 8, 1, 1024}; EpiF32WT E{wt_rsrc(ws + WS_P0, (size_t)NTOK * 2048 * 4), 2048}; gemm_big<false>(F, g, E); if (F.G == 256) cvt_group(F, p, 1, 192, 64, 0); else cvt_group(F, p, 1, 0, F.G, 0); }
        else {
            { BigDesc g{(const bf16_t*)(ws + WS_HB), (const bf16_t*)(ws + WS_WBIN), 1024, 1024, 24, F.G == 256 ? 10 : 14, 1, 1024}; EpiF32WT E{wt_rsrc(ws + WS_P1, (size_t)NTOK * 3584 * 4), 3584}; gemm_big<false>(F, g, E); }
            if (F.G == 256) {
                GemmDesc g{(const bf16_t*)(ws + WS_HB), (const bf16_t*)(ws + WS_WBIN) + (size_t)2560 * 1024, 1024, 1024, NTOK, 896, 1024}; EpiF32 E{(float*)(ws + WS_P1) + 2560, 3584, 896};
                if (F.bid >= 240) gemm_s(F, g, E, 0, F.bid - 240, 16, 48);
                else { gemm_s(F, g, E, 0, 48 + F.bid, 1, 49 + F.bid); if (F.bid < 48) gemm_s(F, g, E, 0, 288 + F.bid, 1, 289 + F.bid); }
            }
        }
        } END(pb + 1);
    }
    if (IN(pb + 2)) { REPS(pb + 2) { if (l == 0) phase_l0_tok(F, p); else phase_l1_tok(F, p); } END(pb + 2); }
    if (IN(pb + 3)) { REPS(pb + 3) {
        unsigned char* ws = p.ws();
        if (l == 0) {
            { GemmDesc g{(const bf16_t*)(ws + WS_CQN), (const bf16_t*)(ws + WS_WUQ), 256, 256, NTOK, 768, 256}; EpiF32 E{(float*)(ws + WS_QRAW), 768, 768}; gemm_s(F, g, E, 0); }
            { GemmDesc g{(const bf16_t*)(ws + WS_CKVN), (const bf16_t*)(ws + WS_WUKV), 128, 128, NKROW, 1024, 128}; EpiF32 E{(float*)(ws + WS_KVRAW), 1024, 1024}; gemm_s(F, g, E, 48 * 6); }
            phase_l0_prefix(F, p, 48 * 6 + 56 * 8);
        } else {
            const bf16_t* TW = (const bf16_t*)(ws + WS_TW); const bf16_t* AD = (const bf16_t*)(ws + WS_AD); const bf16_t* SG = (const bf16_t*)(ws + WS_SG);
            float* DEC = (float*)(ws + WS_DEC); float* AA = (float*)(ws + WS_AA);
            { GemmDesc g{TW, (const bf16_t*)(ws + WS_WWUP), 128, 64, NTOK, 512, 64}; EpiDecay E{DEC, p.in(34)}; gemm_s(F, g, E, 0); }
            { GemmDesc g{TW + 64, (const bf16_t*)(ws + WS_WWUP) + 512 * 64, 128, 64, NTOK, 512, 64}; EpiDecay E{DEC + (size_t)NTOK * 512, p.in(34) + 512}; gemm_s(F, g, E, 192); }
            { GemmDesc g{AD, (const bf16_t*)(ws + WS_WAUP), 128, 64, NTOK, 512, 64}; EpiSigm E{AA, p.in(36)}; gemm_s(F, g, E, 384); }
            { GemmDesc g{AD + 64, (const bf16_t*)(ws + WS_WAUP) + 512 * 64, 128, 64, NTOK, 512, 64}; EpiSigm E{AA + (size_t)NTOK * 512, p.in(36) + 512}; gemm_s(F, g, E, 576); }
            { GemmDesc g{SG, (const bf16_t*)(ws + WS_WGUP), 128, 128, NTOK, 512, 128}; EpiF32 E{(float*)(ws + WS_GG), 512, 512}; gemm_s(F, g, E, 768); }
            phase_l1_mix(F, p);
        }
        } END(pb + 3);
    }
    if (l == 0 && IN(pb + 4)) { REPS(pb + 4) { phase_l0_qkv(F, p); } END(pb + 4); }
    if (IN(pb + 5)) { REPS(pb + 5) { if (l == 0) phase_l0_mix(F, p); else {
#if CHUNKED_SCAN
            phase_l1_scanc(F, p);
#else
            phase_l1_scan(F, p);
#endif
        } } END(pb + 5); }
    if (l == 1 && IN(pb + 6)) { REPS(pb + 6) { phase_l1_comb(F, p); } END(pb + 6); }
    if (IN(pb + 7)) { REPS(pb + 7) {
        unsigned char* ws = p.ws();
        BigDesc g{(const bf16_t*)(ws + WS_OB), (const bf16_t*)(ws + WS_WOUT) + (size_t)l * 1024 * 1024, 1024, 1024, 24, 4, 2, 512};
        EpiPartWT E{wt_rsrc(ws + WS_PARTA, (size_t)2 * NTOK * 1024 * 2), (size_t)NTOK * 1024}; gemm_big<true>(F, g, E);
        if (l == 0) { if (F.G == 256) cvt_group(F, p, 3, 192, 64, 0); else cvt_group(F, p, 3, 0, F.G, 0); }
        } END(pb + 7);
    }
    if (IN(pb + 8)) { REPS(pb + 8) {
        unsigned char* ws = p.ws(); const float* ml = (const float*)(ws + WS_MOD) + (size_t)l * 3 * 6144; float* xbuf = p.out();
        const float* xa = l == 0 ? p.in(0) : xbuf; const float* xb = l == 0 ? p.in(1) : xbuf + (size_t)NCTX * 1024;
        phase_norm(F, xa, xb, (const bf16_t*)(ws + WS_PARTA), ml + 2048, xbuf, p.in(13) + l * 1024, ml + 4096, ml + 3072, (bf16_t*)(ws + WS_HB), true); } END(pb + 8); }
    if (IN(pb + 9)) { REPS(pb + 9) {
        unsigned char* ws = p.ws();
        const bf16_t* wup = (const bf16_t*)(ws + WS_WUP) + (size_t)l * 5632 * 1024;
        { BigDesc g{(const bf16_t*)(ws + WS_HB), wup, 1024, 1024, 24, 21, 1, 1024}; EpiBf16WT E{wt_rsrc(ws + WS_U, (size_t)NTOK * 5632 * 2), 5632}; gemm_big<true>(F, g, E); }
        {
            GemmDesc g{(const bf16_t*)(ws + WS_HB), wup + (size_t)5376 * 1024, 1024, 1024, NTOK, 256, 1024}; EpiBf16 E{(bf16_t*)(ws + WS_U) + 5376, 5632, 256};
            if (F.G == 256) { if (F.bid >= 248) gemm_s(F, g, E, 0, F.bid - 248, 8, 16); else if (F.bid < 80) gemm_s(F, g, E, 0, 16 + F.bid, 1, 17 + F.bid); }
            else gemm_s(F, g, E, 0);
        }
        } END(pb + 9);
    }
    if (IN(pb + 10)) { REPS(pb + 10) { phase_gate(F, p, l); } END(pb + 10); }
    if (IN(pb + 11)) { REPS(pb + 11) {
        unsigned char* ws = p.ws();
        BigDesc g{(const bf16_t*)(ws + WS_ACT), (const bf16_t*)(ws + WS_WDN) + (size_t)l * 1024 * 2816, 2816, 2816, 24, 4, 2, 1408};
        EpiPartWT E{wt_rsrc(ws + WS_PARTD, (size_t)2 * NTOK * 1024 * 2), (size_t)NTOK * 1024}; gemm_big<true>(F, g, E);
        if (l == 0) { if (F.G == 256) cvt_group(F, p, 2, 192, 64, 0); else cvt_group(F, p, 2, 0, F.G, 0); }
        } END(pb + 11);
    }
}

__global__ void __launch_bounds__(NTHREADS, 2) fwd_kernel(Params kp) {
    extern __shared__ __attribute__((aligned(16))) unsigned char lds_raw[];
    Frame F;
    F.lds = (LAS unsigned char*)lds_raw + LDS_WORK;
    F.tid = threadIdx.x; F.lane = F.tid & 63; F.wave = __builtin_amdgcn_readfirstlane(F.tid >> 6); F.G = gridDim.x; F.bid = blockIdx.x;
    {
        LAS unsigned* pw = (LAS unsigned*)((LAS unsigned char*)lds_raw + 64);
        if (F.tid < (int)(sizeof(Params) / 4)) pw[F.tid] = ((const unsigned*)&kp)[F.tid];
        if (F.tid < 4) ((LAS unsigned*)((LAS unsigned char*)lds_raw))[F.tid] = 0u;
    }
    __syncthreads();
    PRef p; p.w = (const LAS unsigned*)((LAS unsigned char*)lds_raw + 64);
    const int lo = kp.ph_lo, hi = kp.ph_hi;
    XcdBarrier bar; bar.bar = nullptr; bar.x = 0; bar.st = nullptr;
#if ONE_LAUNCH
    bar = xcd_barrier_post((unsigned*)(p.ws() + WS_BAR), (volatile LAS unsigned*)((LAS unsigned char*)lds_raw));
#endif
#ifdef EXTRA_BARS
    for (int i_ = 0; i_ < EXTRA_BARS; ++i_) SEAM();
#endif
    if (IN(0)) { REPS(0) { phase_prep(F, p); } END(0); }
    layer_phases<0>(F, p, lo, hi, bar);
    layer_phases<1>(F, p, lo, hi, bar);
    if (IN(25)) {
        unsigned char* ws = p.ws(); float* xbuf = p.out();
        phase_norm(F, xbuf, xbuf + (size_t)NCTX * 1024, (const bf16_t*)(ws + WS_PARTD), (const float*)(ws + WS_MOD) + 3 * 6144 + 5120, xbuf, nullptr, nullptr, nullptr, nullptr, false);
    }
}

extern "C" void kernel_launch(void* const* d_in, const int* in_sizes, int n_in, void* d_out, int out_size, void* d_ws, size_t ws_size, hipStream_t stream) {
    static int grid = 0;
    if (grid == 0) {
        if (n_in != 43 || (size_t)out_size != OUT_END || ws_size < WS_END) { fprintf(stderr, "kernel_launch: unexpected shapes: n_in %d out %d ws %zu (need %zu)\n", n_in, out_size, ws_size, (size_t)WS_END); grid = -1; return; }
        int dev = 0, cus = 0, per_cu = 0;
        if (hipGetDevice(&dev) != hipSuccess || hipDeviceGetAttribute(&cus, hipDeviceAttributeMultiprocessorCount, dev) != hipSuccess) { grid = -1; return; }
        if (hipFuncSetAttribute((const void*)fwd_kernel, hipFuncAttributeMaxDynamicSharedMemorySize, LDS_BYTES) != hipSuccess) { fprintf(stderr, "kernel_launch: hipFuncSetAttribute failed\n"); grid = -1; return; }
        if (hipOccupancyMaxActiveBlocksPerMultiprocessor(&per_cu, (const void*)fwd_kernel, NTHREADS, LDS_BYTES) != hipSuccess || per_cu < 1) { fprintf(stderr, "kernel_launch: occupancy query says %d blocks per CU\n", per_cu); grid = -1; (void)hipGetLastError(); return; }
        grid = cus;
    }
    if (grid < 0) return;
    Params p{};
    for (int i = 0; i < 43; ++i) p.in[i] = (const float*)d_in[i];
    p.out = (float*)d_out; p.ws = (unsigned char*)d_ws;
#if ONE_LAUNCH
    (void)hipMemsetAsync((char*)d_ws + WS_BAR, 0, 16384, stream);
    p.ph_lo = 0; p.ph_hi = NPHASE;
    void* args[] = {&p};
    hipError_t e = hipLaunchCooperativeKernel((const void*)fwd_kernel, dim3(grid), dim3(NTHREADS), args, LDS_BYTES, stream);
    if (e != hipSuccess) fprintf(stderr, "cooperative launch failed: %s (grid %d)\n", hipGetErrorString(e), grid);
#else
    for (int ph = 0; ph < NPHASE; ++ph) {
        p.ph_lo = ph; p.ph_hi = ph + 1;
        hipLaunchKernelGGL(fwd_kernel, dim3(grid), dim3(NTHREADS), LDS_BYTES, stream, p);
    }
#endif
}
```

```cpp
#include <hip/hip_runtime.h>
#include <cstdio>
#include <cstdint>

#define LAS __attribute__((address_space(3)))
typedef unsigned short bf16_t;
typedef short bf16x8 __attribute__((ext_vector_type(8)));
typedef short bf16x4 __attribute__((ext_vector_type(4)));
typedef float f32x4 __attribute__((ext_vector_type(4)));
typedef float f32x2 __attribute__((ext_vector_type(2)));
typedef unsigned u32x2 __attribute__((ext_vector_type(2)));
typedef unsigned u32x4 __attribute__((ext_vector_type(4)));

#define REP_MASK 0u
#define ATT_REP 0
#define SCAN_REP 0
#ifndef CHUNKED_SCAN
#define CHUNKED_SCAN 1
#endif
#ifndef ONE_LAUNCH
#define ONE_LAUNCH 1
#endif

constexpr int NTHREADS = 512;
constexpr int LDS_BYTES = 144 * 1024;
constexpr int LDS_WORK = 1024;
constexpr int DM = 1024, NCTX = 4096, NLAT = 2048, NTOK = 6144, NKROW = 7168, DFF = 2816;
constexpr float EPS = 1e-6f;

constexpr size_t al256(size_t x) { return (x + 255) & ~(size_t)255; }
constexpr size_t WS_BAR = 0;
constexpr size_t WS_MOD = WS_BAR + 16384;
constexpr size_t WS_WAIN = al256(WS_MOD + 2 * 3 * 6144 * 4);
constexpr size_t WS_WUQ = WS_WAIN + (size_t)2048 * 1024 * 2;
constexpr size_t WS_WUKV = WS_WUQ + (size_t)768 * 256 * 2;
constexpr size_t WS_WOUT = WS_WUKV + (size_t)1024 * 128 * 2;
constexpr size_t WS_WUP = WS_WOUT + (size_t)2 * 1024 * 1024 * 2;
constexpr size_t WS_WDN = WS_WUP + (size_t)2 * 5632 * 1024 * 2;
constexpr size_t WS_WBIN = WS_WDN + (size_t)2 * 1024 * 2816 * 2;
constexpr size_t WS_WWUP = WS_WBIN + (size_t)3584 * 1024 * 2;
constexpr size_t WS_WAUP = WS_WWUP + (size_t)2 * 512 * 64 * 2;
constexpr size_t WS_WGUP = WS_WAUP + (size_t)2 * 512 * 64 * 2;
constexpr size_t WS_HB = WS_WGUP + (size_t)512 * 128 * 2;
constexpr size_t WS_OB = WS_HB + (size_t)NTOK * 1024 * 2;
constexpr size_t WS_BIG = WS_OB + (size_t)NTOK * 1024 * 2;
constexpr size_t WS_P0 = WS_BIG;
constexpr size_t WS_CQN = WS_P0 + (size_t)NTOK * 2048 * 4;
constexpr size_t WS_CKVN = WS_CQN + (size_t)NTOK * 256 * 2;
constexpr size_t WS_QRAW = WS_CKVN + (size_t)NKROW * 128 * 2;
constexpr size_t WS_KVRAW = WS_QRAW + (size_t)NTOK * 768 * 4;
constexpr size_t WS_Q0 = WS_KVRAW + (size_t)NKROW * 1024 * 4;
constexpr size_t WS_K0 = WS_Q0 + (size_t)NTOK * 768 * 2;
constexpr size_t WS_VT0 = WS_K0 + (size_t)NKROW * 768 * 2;
constexpr size_t WS_KVS = WS_VT0 + (size_t)NKROW * 512 * 2;
constexpr size_t WS_L0END = WS_KVS + (size_t)384 * 2 * 8192 * 4;
constexpr size_t WS_U = WS_BIG;
constexpr size_t WS_ACT = WS_U + (size_t)NTOK * 5632 * 2;
constexpr size_t WS_FFNEND = WS_ACT + (size_t)NTOK * 2816 * 2;
constexpr size_t WS_P1 = WS_BIG;
constexpr size_t WS_DEC = WS_BIG;
constexpr size_t WS_AA = WS_DEC + (size_t)2 * NTOK * 512 * 4;
constexpr size_t WS_GG = WS_AA + (size_t)2 * NTOK * 512 * 4;
constexpr size_t WS_YY = WS_GG + (size_t)NTOK * 512 * 4;
constexpr size_t WS_QD = WS_P1 + (size_t)NTOK * 3584 * 4;
constexpr size_t WS_KD = WS_QD + (size_t)NTOK * 512 * 2;
constexpr size_t WS_VDT = WS_KD + (size_t)NKROW * 512 * 2;
constexpr size_t WS_RR = WS_VDT + (size_t)NKROW * 512 * 2;
constexpr size_t WS_KR = WS_RR + (size_t)NTOK * 512 * 4;
constexpr size_t WS_VV = WS_KR + (size_t)NTOK * 512 * 4;
constexpr size_t WS_KK = WS_VV + (size_t)NTOK * 512 * 4;
constexpr size_t WS_TW = WS_KK + (size_t)NTOK * 512 * 4;
constexpr size_t WS_AD = WS_TW + (size_t)NTOK * 128 * 2;
constexpr size_t WS_SG = WS_AD + (size_t)NTOK * 128 * 2;
constexpr size_t WS_DO = WS_SG + (size_t)NTOK * 128 * 2;
constexpr size_t WS_BON = WS_DO + (size_t)NTOK * 1024 * 2;
constexpr size_t WS_L1END = WS_BON + (size_t)2 * NTOK * 8 * 4;
constexpr size_t cmax(size_t a, size_t b) { return a > b ? a : b; }
constexpr size_t WS_END = cmax(cmax(WS_L0END, WS_FFNEND), WS_L1END);
static_assert(WS_YY + (size_t)2 * NTOK * 512 * 4 <= WS_QD, "layer-1 overlay");
static_assert(WS_END <= (size_t)256 * 1024 * 1024, "workspace exceeds 256 MiB");

constexpr size_t OUT_X = 0;
constexpr size_t OUT_CKV = (size_t)NTOK * 1024;
constexpr size_t OUT_KROPE = OUT_CKV + (size_t)NCTX * 128;
constexpr size_t OUT_SRET = OUT_KROPE + (size_t)NCTX * 32;
constexpr size_t OUT_DK = OUT_SRET + (size_t)16 * 2 * 4 * 8192;
constexpr size_t OUT_DV = OUT_DK + (size_t)NCTX * 512;
constexpr size_t OUT_SRWKV = OUT_DV + (size_t)NCTX * 512;
constexpr size_t OUT_END = OUT_SRWKV + (size_t)16 * 2 * 8 * 4096;

struct Params {
    const float* in[43];
    float* out;
    unsigned char* ws;
    int ph_lo, ph_hi;
};

struct PRef {
    const LAS unsigned* w;
    __device__ __forceinline__ unsigned long long q(int i) const {
        const unsigned lo = (unsigned)__builtin_amdgcn_readfirstlane((int)w[2 * i]), hi = (unsigned)__builtin_amdgcn_readfirstlane((int)w[2 * i + 1]);
        return ((unsigned long long)hi << 32) | lo; }
    __device__ __forceinline__ const float* in(int k) const { return (const float*)(const __attribute__((address_space(1))) float*)q(k); }
    __device__ __forceinline__ float* out() const { return (float*)(__attribute__((address_space(1))) float*)q(43); }
    __device__ __forceinline__ unsigned char* ws() const { return (unsigned char*)(__attribute__((address_space(1))) unsigned char*)q(44); }
};

typedef __bf16 hwbf16x2 __attribute__((ext_vector_type(2)));
__device__ __forceinline__ unsigned pack2(float a, float b) { const f32x2 v = (f32x2){a, b}; return __builtin_bit_cast(unsigned, __builtin_convertvector(v, hwbf16x2)); }
__device__ __forceinline__ bf16_t f2bf(float f) { return (bf16_t)(pack2(f, 0.f) & 0xffffu); }
__device__ __forceinline__ float bf2f(unsigned b) { return __uint_as_float(b << 16); }
#define RDLANE(x, l) __int_as_float(__builtin_amdgcn_readlane(__float_as_int(x), (l)))
#define DPPF(x, ctrl) __int_as_float(__builtin_amdgcn_update_dpp(0, __float_as_int(x), (ctrl), 0xF, 0xF, true))
__device__ __forceinline__ float row16_sum(float v) {
    v += DPPF(v, 0xB1); v += DPPF(v, 0x4E); v += DPPF(v, 0x141); v += DPPF(v, 0x140); return v; }
__device__ __forceinline__ float oct_sum(float v) {
    v += DPPF(v, 0xB1); v += DPPF(v, 0x4E); v += DPPF(v, 0x141); return v; }
__device__ __forceinline__ float wave_sum(float v) {
    v = row16_sum(v);
    return (RDLANE(v, 0) + RDLANE(v, 16)) + (RDLANE(v, 32) + RDLANE(v, 48));
}
__device__ __forceinline__ float half_sum(float v, int lane) {
    v = row16_sum(v);
    const float a = RDLANE(v, 0) + RDLANE(v, 16), b = RDLANE(v, 32) + RDLANE(v, 48);
    return lane < 32 ? a : b;
}
__device__ __forceinline__ float sigmoidf_(float x) { return 1.0f / (1.0f + __expf(-x)); }
__device__ __forceinline__ float siluf_(float x) { return x * sigmoidf_(x); }
__device__ __forceinline__ float tanhf_(float x) { return 1.0f - 2.0f / (__expf(2.0f * x) + 1.0f); }
__device__ __forceinline__ int cond_of(int row) { return row < NCTX ? 0 : 1 + ((row - NCTX) >> 10); }

#define XB_TMO      128
#define XB_XCNT(j)  (256  + 64 * (j))
#define XB_XSUB(j)  (1280 + 64 * (j))
#define XB_XGEN(j)  (2304 + 64 * (j))
#define XB_TOP      3328
#define XB_TOPGEN   3392
#define XCD_BAR_WORDS 3456
#define XB_SPIN_CAP (1u << 20)
__device__ __forceinline__ unsigned xb_ld(unsigned* p) { return __hip_atomic_load(p, __ATOMIC_RELAXED, __HIP_MEMORY_SCOPE_AGENT); }
__device__ __forceinline__ unsigned xb_add(unsigned* p, unsigned v) { return __hip_atomic_fetch_add(p, v, __ATOMIC_RELAXED, __HIP_MEMORY_SCOPE_AGENT); }
__device__ __forceinline__ unsigned xb_xcc_id() { return (unsigned)__builtin_amdgcn_s_getreg((3 << 11) | 20) & 0xFu; }
#define XB_SPIN(cond, bar) do { unsigned _sp = 0; while (cond) { __builtin_amdgcn_s_sleep(1); \
    if ((++_sp & 255u) == 0u) { if (xb_ld(&(bar)[XB_TMO])) break; if (_sp > XB_SPIN_CAP) { atomicAdd(&(bar)[XB_TMO], 1u); break; } } } } while (0)
struct XcdBarrier { unsigned* bar; unsigned x; volatile LAS unsigned* st; };
__device__ __forceinline__ XcdBarrier xcd_barrier_post(unsigned* bar, volatile LAS unsigned* st) {
    XcdBarrier b; b.bar = bar; b.x = xb_xcc_id(); b.st = st;
    if (threadIdx.x == 0) (void)xb_add(&bar[XB_XCNT(b.x)], 1u);
    return b;
}
__device__ __forceinline__ void xcd_barrier_complete(unsigned* bar, unsigned x, unsigned& nloc, unsigned& nx) {
    const unsigned G = gridDim.x * gridDim.y * gridDim.z;
    unsigned sum, cnt, mine, sp = 0u;
    for (;;) {
        sum = 0u; cnt = 0u; mine = 0u;
#pragma unroll
        for (unsigned j = 0; j < 16; ++j) { const unsigned c = xb_ld(&bar[XB_XCNT(j)]); sum += c; cnt += (c > 0u) ? 1u : 0u; mine = (j == x) ? c : mine; }
        if (sum == G) break;
        __builtin_amdgcn_s_sleep(1);
        if ((++sp & 255u) == 0u) { if (xb_ld(&bar[XB_TMO])) break; if (sp > XB_SPIN_CAP) { atomicAdd(&bar[XB_TMO], 1u); break; } }
    }
    nloc = mine > 0u ? mine : 1u; nx = cnt > 0u ? cnt : 1u;
}
__device__ __forceinline__ void xcd_barrier(const XcdBarrier& b) {
    asm volatile("s_waitcnt vmcnt(0)" ::: "memory");
    __syncthreads();
    if (threadIdx.x == 0) {
        unsigned* bar = b.bar;
        __builtin_amdgcn_s_waitcnt(0);
        unsigned nloc = b.st[0], nx = b.st[1];
        if (nloc == 0u) { xcd_barrier_complete(bar, b.x, nloc, nx); b.st[0] = nloc; b.st[1] = nx; }
        const unsigned old = xb_add(&bar[XB_XSUB(b.x)], 1u);
        const unsigned gen = old / nloc;
        if (old + 1u == (gen + 1u) * nloc) {
            __builtin_amdgcn_fence(__ATOMIC_RELEASE, "agent");
            asm volatile("s_waitcnt vmcnt(0)" ::: "memory");
            const unsigned og = xb_add(&bar[XB_TOP], 1u);
            const unsigned tg = og / nx;
            if (og + 1u == (tg + 1u) * nx) xb_add(&bar[XB_TOPGEN], 1u);
            else XB_SPIN(xb_ld(&bar[XB_TOPGEN]) == tg, bar);
            __builtin_amdgcn_fence(__ATOMIC_ACQUIRE, "agent");
            xb_add(&bar[XB_XGEN(b.x)], 1u);
            asm volatile("s_waitcnt vmcnt(0)" ::: "memory");
        } else {
            XB_SPIN(xb_ld(&bar[XB_XGEN(b.x)]) == gen, bar);
            __builtin_amdgcn_fence(__ATOMIC_ACQUIRE, "agent");
            asm volatile("s_waitcnt vmcnt(0)" ::: "memory");
        }
    }
    __syncthreads();
}

struct Frame {
    LAS unsigned char* lds;
    int tid, lane, wave, G, bid;
};
#define FOR_UNITS(u, n, rot) for (int u = (int)((F.bid + F.G - ((rot) % F.G)) % F.G); u < (n); u += F.G)

__device__ __forceinline__ int lds_byte(int r, int c) { const int st = (r >> 4) * 2 + (c >> 5), rr = r & 15, cc = c & 31, ob = rr * 64 + cc * 2; return st * 1024 + (ob ^ (((ob >> 9) & 1) << 5)); }
__device__ __forceinline__ void stage_rc(int b, int& R, int& C) { const int st = b / 1024, sb = b % 1024, swz = sb ^ (((sb >> 9) & 1) << 5); R = (st >> 1) * 16 + swz / 64; C = (st & 1) * 32 + (swz % 64) / 2; }

struct GemmDesc { const bf16_t* A; const bf16_t* Bt; int lda, ldb, M, N, K; };

typedef unsigned u32x4v __attribute__((ext_vector_type(4)));
__device__ __forceinline__ __amdgpu_buffer_rsrc_t wt_rsrc(void* base, size_t bytes) { return __builtin_amdgcn_make_buffer_rsrc(base, 0, (int)bytes, 0x00020000); }
__device__ __forceinline__ void wt_store16(const __amdgpu_buffer_rsrc_t r, size_t byte_off, u32x4 v) { __builtin_amdgcn_raw_buffer_store_b128(v, r, (int)byte_off, 0, 16); }
struct EpiF32 { float* C; int ldc, ncols;
    __device__ __forceinline__ void operator()(int r, int c, f32x4 v, int ks = 0) const { if (c < ncols) *(f32x4*)(C + (size_t)r * ldc + c) = v; } };
struct EpiF32WT { __amdgpu_buffer_rsrc_t R; int ldc;
    __device__ __forceinline__ void operator()(int r, int c, f32x4 v, int ks = 0) const { wt_store16(R, ((size_t)r * ldc + c) * 4, __builtin_bit_cast(u32x4, v)); } };
struct EpiBf16 { bf16_t* C; int ldc, ncols;
    __device__ __forceinline__ void e8(int r, int c, f32x4 v0, f32x4 v1, int ks = 0) const { u32x4 w; w.x = pack2(v0[0], v0[1]); w.y = pack2(v0[2], v0[3]); w.z = pack2(v1[0], v1[1]); w.w = pack2(v1[2], v1[3]); *(u32x4*)(C + (size_t)r * ldc + c) = w; }
    __device__ __forceinline__ void operator()(int r, int c, f32x4 v, int ks = 0) const { if (c < ncols) { u32x2 w; w.x = pack2(v[0], v[1]); w.y = pack2(v[2], v[3]); *(u32x2*)(C + (size_t)r * ldc + c) = w; } } };
struct EpiPart { bf16_t* C; size_t kstride;
    __device__ __forceinline__ void e8(int r, int c, f32x4 v0, f32x4 v1, int ks) const { u32x4 w; w.x = pack2(v0[0], v0[1]); w.y = pack2(v0[2], v0[3]); w.z = pack2(v1[0], v1[1]); w.w = pack2(v1[2], v1[3]);
        *(u32x4*)(C + (size_t)ks * kstride + (size_t)r * 1024 + c) = w; } };
struct EpiBf16WT { __amdgpu_buffer_rsrc_t R; int ldc;
    __device__ __forceinline__ void e8(int r, int c, f32x4 v0, f32x4 v1, int ks = 0) const { u32x4 w; w.x = pack2(v0[0], v0[1]); w.y = pack2(v0[2], v0[3]); w.z = pack2(v1[0], v1[1]); w.w = pack2(v1[2], v1[3]);
        wt_store16(R, ((size_t)r * ldc + c) * 2, w); } };
struct EpiPartWT { __amdgpu_buffer_rsrc_t R; size_t kstride;
    __device__ __forceinline__ void e8(int r, int c, f32x4 v0, f32x4 v1, int ks) const { u32x4 w; w.x = pack2(v0[0], v0[1]); w.y = pack2(v0[2], v0[3]); w.z = pack2(v1[0], v1[1]); w.w = pack2(v1[2], v1[3]);
        wt_store16(R, ((size_t)ks * kstride + (size_t)r * 1024 + c) * 2, w); } };
struct EpiResid { const float* xa; const float* xb; float* xo; const float* gate;
    __device__ __forceinline__ void operator()(int r, int c, f32x4 v, int ks = 0) const {
        const float* xs = r < NCTX ? xa + (size_t)r * 1024 : xb + (size_t)(r - NCTX) * 1024;
        const f32x4 x = *(const f32x4*)(xs + c); const f32x4 g = *(const f32x4*)(gate + cond_of(r) * 6144 + c);
        *(f32x4*)(xo + (size_t)r * 1024 + c) = x + g * v; } };
struct EpiDecay { float* C; const float* w0;
    __device__ __forceinline__ void operator()(int r, int c, f32x4 v, int ks = 0) const { const f32x4 b = *(const f32x4*)(w0 + c); f32x4 o;
#pragma unroll
        for (int j = 0; j < 4; ++j) o[j] = __expf(-0.60653065971f * sigmoidf_(b[j] + v[j]));
        *(f32x4*)(C + (size_t)r * 512 + c) = o; } };
struct EpiSigm { float* C; const float* a0;
    __device__ __forceinline__ void operator()(int r, int c, f32x4 v, int ks = 0) const { const f32x4 b = *(const f32x4*)(a0 + c); f32x4 o;
#pragma unroll
        for (int j = 0; j < 4; ++j) o[j] = sigmoidf_(b[j] + v[j]);
        *(f32x4*)(C + (size_t)r * 512 + c) = o; } };

template <class Epi>
__device__ __forceinline__ void gemm_s(const Frame& F, const GemmDesc g, const Epi& E, int rot, int ufirst = -1, int ustep = 0, int ulast = 0) {
    LAS unsigned char* lds = F.lds;
    const int tid = F.tid, wid = F.wave, lane = F.lane, wr = wid >> 2, wc = wid & 3, fr = lane & 15, fq = lane >> 4;
    const int nM = g.M / 128, nN = g.N / 128, nU = nM * nN, nt = g.K / 64;
    int R0, C0, R1, C1; stage_rc(tid * 16, R0, C0); stage_rc(tid * 16 + 8192, R1, C1);
    const int aoff = lds_byte(wr * 64 + fr, fq * 8), boff = lds_byte(wc * 32 + fr, fq * 8);
    const unsigned ldsw = (unsigned)wid * 1024u;
#define GS_STAGE(buf, t) do { \
        __builtin_amdgcn_global_load_lds((const unsigned*)(Ag + (size_t)R0 * g.lda + (t) * 64 + C0), (LAS unsigned*)(lds + (buf) * 32768 + ldsw), 16, 0, 0); \
        __builtin_amdgcn_global_load_lds((const unsigned*)(Ag + (size_t)R1 * g.lda + (t) * 64 + C1), (LAS unsigned*)(lds + (buf) * 32768 + ldsw + 8192), 16, 0, 0); \
        __builtin_amdgcn_global_load_lds((const unsigned*)(Bg + (size_t)R0 * g.ldb + (t) * 64 + C0), (LAS unsigned*)(lds + (buf) * 32768 + 16384 + ldsw), 16, 0, 0); \
        __builtin_amdgcn_global_load_lds((const unsigned*)(Bg + (size_t)R1 * g.ldb + (t) * 64 + C1), (LAS unsigned*)(lds + (buf) * 32768 + 16384 + ldsw + 8192), 16, 0, 0); } while (0)
    const int u0 = ufirst >= 0 ? ufirst : (int)((F.bid + F.G - (rot % F.G)) % F.G), us = ufirst >= 0 ? ustep : F.G, ue = ufirst >= 0 ? ulast : nU;
    for (int u = u0; u < ue; u += us) {
        const int pm = u % nM, pn = u / nM;
        const bf16_t* Ag = g.A + (size_t)(pm * 128) * g.lda; const bf16_t* Bg = g.Bt + (size_t)(pn * 128) * g.ldb;
        f32x4 acc[4][2];
#pragma unroll
        for (int m = 0; m < 4; ++m)
#pragma unroll
            for (int n = 0; n < 2; ++n) acc[m][n] = (f32x4){0.f, 0.f, 0.f, 0.f};
        GS_STAGE(0, 0);
        if (nt > 1) GS_STAGE(1, 1);
        int b = 0, bn = 2;
        for (int t = 0; t < nt; ++t) {
            if (t + 2 < nt) { GS_STAGE(bn, t + 2); asm volatile("s_waitcnt vmcnt(8)" ::: "memory"); }
            else if (t + 1 < nt) asm volatile("s_waitcnt vmcnt(4)" ::: "memory");
            else asm volatile("s_waitcnt vmcnt(0)" ::: "memory");
            __builtin_amdgcn_s_barrier(); asm volatile("" ::: "memory");
            bf16x8 Af[4][2], Bf[2][2];
#pragma unroll
            for (int m = 0; m < 4; ++m)
#pragma unroll
                for (int k = 0; k < 2; ++k) Af[m][k] = *(const LAS bf16x8*)(lds + b * 32768 + aoff + m * 2048 + k * 1024);
#pragma unroll
            for (int n = 0; n < 2; ++n)
#pragma unroll
                for (int k = 0; k < 2; ++k) Bf[n][k] = *(const LAS bf16x8*)(lds + b * 32768 + 16384 + boff + n * 2048 + k * 1024);
#pragma unroll
            for (int k = 0; k < 2; ++k)
#pragma unroll
                for (int m = 0; m < 4; ++m)
#pragma unroll
                    for (int n = 0; n < 2; ++n) acc[m][n] = __builtin_amdgcn_mfma_f32_16x16x32_bf16(Bf[n][k], Af[m][k], acc[m][n], 0, 0, 0);
            asm volatile("s_waitcnt lgkmcnt(0)" ::: "memory");
            __builtin_amdgcn_s_barrier(); asm volatile("" ::: "memory");
            b = b == 2 ? 0 : b + 1; bn = bn == 2 ? 0 : bn + 1;
        }
#pragma unroll
        for (int m = 0; m < 4; ++m)
#pragma unroll
            for (int n = 0; n < 2; ++n) E(pm * 128 + wr * 64 + m * 16 + fr, pn * 128 + wc * 32 + n * 16 + 4 * fq, acc[m][n]);
    }
#undef GS_STAGE
}

constexpr int HTB = 128 * 64 * 2;
struct BigDesc { const bf16_t* A; const bf16_t* Bt; int lda, ldb, nM, nN, nKS, Ksp; };
struct BUnit { int pm, pn, ks; };
__device__ __forceinline__ bool big_next(const BigDesc& g, int i, int G, int c, BUnit& u) {
    const int nNp = g.nN * g.nKS, nwg = g.nM * nNp;
    const long L = (long)i * G + c; if (L >= nwg) return false;
    int wgid = (int)L; { const int q = nwg / 8, r = nwg % 8, xcd = wgid % 8, off = wgid / 8; wgid = (xcd < r ? xcd * (q + 1) : r * (q + 1) + (xcd - r) * q) + off; }
    const int nig = 8 * nNp, gid = wgid / nig, fm = gid * 8, gsz = (g.nM - fm) < 8 ? (g.nM - fm) : 8;
    u.pm = fm + ((wgid % nig) % gsz); const int pnp = (wgid % nig) / gsz; u.pn = pnp / g.nKS; u.ks = pnp % g.nKS; return true;
}
__device__ __forceinline__ int perm32(int rho) { const int n = rho >> 4, i = rho & 15; return 8 * (i >> 2) + 4 * n + (i & 3); }
template <bool PERM, class Epi>
__device__ __forceinline__ void gemm_big(const Frame& F, const BigDesc g, const Epi& E) {
    LAS unsigned char* lds = F.lds;
    const int tid = F.tid, wid = F.wave, lane = F.lane, wr = wid >> 2, wc = wid & 3, fr = lane & 15, fq = lane >> 4;
    const int nt = g.Ksp / 64;
    unsigned voffA[2], voffB[2];
#pragma unroll
    for (int i = 0; i < 2; ++i) { int R, C; stage_rc(tid * 16 + i * 8192, R, C); const int Rb = PERM ? ((R & ~31) + perm32(R & 31)) : R; voffA[i] = (unsigned)(R * g.lda + C) * 2u; voffB[i] = (unsigned)(Rb * g.ldb + C) * 2u; }
    const size_t kstep = (size_t)(64 * 2);
    const size_t hstepA = (size_t)128 * g.lda * 2, hstepB = (size_t)128 * g.ldb * 2;
    const unsigned ldsw = (unsigned)wid * 1024u;
    const int aoff = lds_byte(wr * 64 + fr, fq * 8), boff = lds_byte(wc * 32 + fr, fq * 8);
#define PG8_SA(b, h) (((b) * 2 + (h)) * HTB)
#define PG8_SB(b, h) ((4 + (b) * 2 + (h)) * HTB)
#define PG8_STAGE(bufoff, gbase, voff) do { _Pragma("unroll") for (int _i = 0; _i < 2; ++_i) \
        __builtin_amdgcn_global_load_lds((const unsigned*)((const char*)(gbase) + (voff)[_i]), (LAS unsigned*)(lds + (bufoff) + ldsw + _i * 8192), 16, 0, 0); } while (0)
#define PG8_LDA(dst, b, h) do { _Pragma("unroll") for (int m = 0; m < 4; ++m) _Pragma("unroll") for (int k = 0; k < 2; ++k) dst[m][k] = *(const LAS bf16x8*)(lds + PG8_SA(b, h) + aoff + m * 2048 + k * 1024); } while (0)
#define PG8_LDB(dst, b, h) do { _Pragma("unroll") for (int n = 0; n < 2; ++n) _Pragma("unroll") for (int k = 0; k < 2; ++k) dst[n][k] = *(const LAS bf16x8*)(lds + PG8_SB(b, h) + boff + n * 2048 + k * 1024); } while (0)
#define PG8_MMA(ai, bj, At, Bt) do { __builtin_amdgcn_s_setprio(1); _Pragma("unroll") for (int m = 0; m < 4; ++m) _Pragma("unroll") for (int n = 0; n < 2; ++n) _Pragma("unroll") for (int k = 0; k < 2; ++k) \
        acc[ai][bj][m][n] = __builtin_amdgcn_mfma_f32_16x16x32_bf16(Bt[n][k], At[m][k], acc[ai][bj][m][n], 0, 0, 0); __builtin_amdgcn_s_setprio(0); } while (0)
#define PG8_WAIT_V(n) asm volatile("s_waitcnt vmcnt(" #n ")" ::: "memory")
#define PG8_WAIT_L(n) asm volatile("s_waitcnt lgkmcnt(" #n ")" ::: "memory")
#define PG8_BAR __builtin_amdgcn_s_barrier()
#define PG8_SCHED __builtin_amdgcn_sched_barrier(0)
#define PG8_UA(u) ((const char*)g.A + (size_t)(u).pm * 2 * hstepA + (size_t)(u).ks * g.Ksp * 2)
#define PG8_UB(u) ((const char*)g.Bt + (size_t)(u).pn * 2 * hstepB + (size_t)(u).ks * g.Ksp * 2)
    BUnit cur, nxt; int ui = 0;
    if (!big_next(g, 0, F.G, F.bid, cur)) return;
    f32x4 acc[2][2][4][2];
#pragma unroll
    for (int a = 0; a < 2; ++a)
#pragma unroll
        for (int b = 0; b < 2; ++b)
#pragma unroll
            for (int m = 0; m < 4; ++m)
#pragma unroll
                for (int n = 0; n < 2; ++n) acc[a][b][m][n] = (f32x4){0.f, 0.f, 0.f, 0.f};
    bf16x8 At[4][2], B0[2][2], B1[2][2];
    const char* cA = PG8_UA(cur); const char* cB = PG8_UB(cur);
    PG8_STAGE(PG8_SB(0, 0), cB, voffB); PG8_STAGE(PG8_SB(0, 1), cB + hstepB, voffB); PG8_STAGE(PG8_SA(0, 0), cA, voffA); PG8_STAGE(PG8_SA(0, 1), cA + hstepA, voffA);
    if (wr == 1) PG8_BAR;
    PG8_WAIT_V(2); PG8_BAR;
    PG8_STAGE(PG8_SB(1, 0), cB + kstep, voffB); PG8_STAGE(PG8_SA(1, 0), cA + kstep, voffA); PG8_STAGE(PG8_SB(1, 1), cB + hstepB + kstep, voffB);
    PG8_WAIT_V(6); PG8_BAR;
    for (;;) {
        const bool has_next = big_next(g, ui + 1, F.G, F.bid, nxt);
        const char* nA = has_next ? PG8_UA(nxt) : cA; const char* nB = has_next ? PG8_UB(nxt) : cB;
        for (int t = 0; t < nt; t += 2) {
            const bool last = (t == nt - 2);
            const char* a1 = cA + (size_t)(t + 1) * kstep;
            const char* a2 = last ? nA : cA + (size_t)(t + 2) * kstep; const char* b2 = last ? nB : cB + (size_t)(t + 2) * kstep;
            const char* a3 = a2 + kstep; const char* b3 = b2 + kstep;
            PG8_LDB(B0, 0, 0); PG8_LDB(B1, 0, 1); PG8_SCHED; PG8_LDA(At, 0, 0); PG8_STAGE(PG8_SA(1, 1), a1 + hstepA, voffA);
            PG8_WAIT_V(8); PG8_WAIT_L(0); PG8_BAR; PG8_MMA(0, 0, At, B0); PG8_MMA(0, 1, At, B1); PG8_BAR; PG8_SCHED;
            PG8_LDA(At, 0, 1); PG8_STAGE(PG8_SB(0, 0), b2, voffB); PG8_STAGE(PG8_SB(0, 1), b2 + hstepB, voffB); PG8_STAGE(PG8_SA(0, 0), a2, voffA);
            PG8_WAIT_V(8); PG8_WAIT_L(0); PG8_BAR; PG8_MMA(1, 0, At, B0); PG8_MMA(1, 1, At, B1); PG8_BAR; PG8_SCHED;
            PG8_LDB(B0, 1, 0); PG8_LDB(B1, 1, 1); PG8_SCHED; PG8_LDA(At, 1, 0); PG8_STAGE(PG8_SA(0, 1), a2 + hstepA, voffA);
            PG8_WAIT_V(8); PG8_WAIT_L(0); PG8_BAR; PG8_MMA(0, 0, At, B0); PG8_MMA(0, 1, At, B1); PG8_BAR; PG8_SCHED;
            PG8_LDA(At, 1, 1); PG8_STAGE(PG8_SB(1, 0), b3, voffB); PG8_STAGE(PG8_SB(1, 1), b3 + hstepB, voffB); PG8_STAGE(PG8_SA(1, 0), a3, voffA);
            PG8_WAIT_V(8); PG8_WAIT_L(0); PG8_BAR; PG8_MMA(1, 0, At, B0); PG8_MMA(1, 1, At, B1); PG8_BAR; PG8_SCHED;
        }
        if (wr == 0) PG8_BAR;
        {
            const int row0 = cur.pm * 256 + wr * 64 + fr, col0 = cur.pn * 256 + wc * 32 + (PERM ? 8 : 4) * fq;
#pragma unroll
            for (int ai = 0; ai < 2; ++ai)
#pragma unroll
                for (int m = 0; m < 4; ++m)
#pragma unroll
                    for (int bj = 0; bj < 2; ++bj) {
                        if constexpr (PERM) E.e8(row0 + ai * 128 + m * 16, col0 + bj * 128, acc[ai][bj][m][0], acc[ai][bj][m][1], cur.ks);
                        else {
#pragma unroll
                            for (int n = 0; n < 2; ++n) E(row0 + ai * 128 + m * 16, col0 + bj * 128 + n * 16, acc[ai][bj][m][n], cur.ks);
                        }
                    }
        }
        if (!has_next) break;
#pragma unroll
        for (int a = 0; a < 2; ++a)
#pragma unroll
            for (int b = 0; b < 2; ++b)
#pragma unroll
                for (int m = 0; m < 4; ++m)
#pragma unroll
                    for (int n = 0; n < 2; ++n) acc[a][b][m][n] = (f32x4){0.f, 0.f, 0.f, 0.f};
        cur = nxt; cA = nA; cB = nB; ++ui;
        if (wr == 1) PG8_BAR;
    }
    PG8_WAIT_V(0);
    PG8_BAR;
#undef PG8_SA
#undef PG8_SB
#undef PG8_STAGE
#undef PG8_LDA
#undef PG8_LDB
#undef PG8_MMA
#undef PG8_WAIT_V
#undef PG8_WAIT_L
#undef PG8_BAR
#undef PG8_SCHED
#undef PG8_UA
#undef PG8_UB
}

__device__ __forceinline__ void upgate_tile(int pm, int& rowbase, int& vlo, int& vhi, bool& first, bool& last) {
    if (pm < 16) { rowbase = pm * 256; vlo = 0; vhi = 255; first = true; last = true; return; }
    const int s = (pm - 16) / 5, i = (pm - 16) % 5;
    const int start = i == 0 ? 0 : (i == 1 ? 254 : (i == 2 ? 508 : (i == 3 ? 762 : 768)));
    rowbase = NCTX + s * 1024 + start; first = i == 0; last = i == 4;
    vlo = i == 0 ? 0 : (i == 4 ? 249 : 1); vhi = i == 4 ? 255 : 254;
}
__device__ __forceinline__ void gemm_upgate(const Frame& F, const bf16_t* A, const bf16_t* Bt, const float* cw, const float* cb, bf16_t* ACT) {
    LAS unsigned char* lds = F.lds;
    const int tid = F.tid, wid = F.wave, lane = F.lane, wr = wid >> 2, wc = wid & 3, fr = lane & 15, fq = lane >> 4;
    constexpr int K = 1024, nt = K / 64, UP = 528;
    BigDesc g{A, Bt, K, K, 26, 22, 1, K};
    unsigned voffA[2], voffB[2];
#pragma unroll
    for (int i = 0; i < 2; ++i) { int R, C; stage_rc(tid * 16 + i * 8192, R, C); voffA[i] = (unsigned)(R * K + C) * 2u; voffB[i] = voffA[i]; }
    const size_t kstep = (size_t)(64 * 2), hstep = (size_t)128 * K * 2;
    const unsigned ldsw = (unsigned)wid * 1024u;
    const int aoff = lds_byte(wr * 64 + fr, fq * 8), boff = lds_byte(wc * 32 + fr, fq * 8);
#define PG8_SA(b, h) (((b) * 2 + (h)) * HTB)
#define PG8_SB(b, h) ((4 + (b) * 2 + (h)) * HTB)
#define PG8_STAGE(bufoff, gbase, voff) do { _Pragma("unroll") for (int _i = 0; _i < 2; ++_i) \
        __builtin_amdgcn_global_load_lds((const unsigned*)((const char*)(gbase) + (voff)[_i]), (LAS unsigned*)(lds + (bufoff) + ldsw + _i * 8192), 16, 0, 0); } while (0)
#define PG8_LDA(dst, b, h) do { _Pragma("unroll") for (int m = 0; m < 4; ++m) _Pragma("unroll") for (int k = 0; k < 2; ++k) dst[m][k] = *(const LAS bf16x8*)(lds + PG8_SA(b, h) + aoff + m * 2048 + k * 1024); } while (0)
#define PG8_LDB(dst, b, h) do { _Pragma("unroll") for (int n = 0; n < 2; ++n) _Pragma("unroll") for (int k = 0; k < 2; ++k) dst[n][k] = *(const LAS bf16x8*)(lds + PG8_SB(b, h) + boff + n * 2048 + k * 1024); } while (0)
#define PG8_MMA(ai, bj, At, Bt_) do { __builtin_amdgcn_s_setprio(1); _Pragma("unroll") for (int m = 0; m < 4; ++m) _Pragma("unroll") for (int n = 0; n < 2; ++n) _Pragma("unroll") for (int k = 0; k < 2; ++k) \
        acc[ai][bj][m][n] = __builtin_amdgcn_mfma_f32_16x16x32_bf16(Bt_[n][k], At[m][k], acc[ai][bj][m][n], 0, 0, 0); __builtin_amdgcn_s_setprio(0); } while (0)
#define PG8_WAIT_V(n) asm volatile("s_waitcnt vmcnt(" #n ")" ::: "memory")
#define PG8_WAIT_L(n) asm volatile("s_waitcnt lgkmcnt(" #n ")" ::: "memory")
#define PG8_BAR __builtin_amdgcn_s_barrier()
#define PG8_SCHED __builtin_amdgcn_sched_barrier(0)
    for (int ui = 0;; ++ui) {
        BUnit cur;
        if (!big_next(g, ui, F.G, F.bid, cur)) break;
        int rowbase; { int a_, b_; bool c_, d_; upgate_tile(cur.pm, rowbase, a_, b_, c_, d_); }
        f32x4 acc[2][2][4][2];
#pragma unroll
        for (int a = 0; a < 2; ++a)
#pragma unroll
            for (int b = 0; b < 2; ++b)
#pragma unroll
                for (int m = 0; m < 4; ++m)
#pragma unroll
                    for (int n = 0; n < 2; ++n) acc[a][b][m][n] = (f32x4){0.f, 0.f, 0.f, 0.f};
        bf16x8 At[4][2], B0[2][2], B1[2][2];
        const char* cA = (const char*)A + (size_t)rowbase * K * 2; const char* cB = (const char*)Bt + (size_t)cur.pn * 2 * hstep;
        PG8_STAGE(PG8_SB(0, 0), cB, voffB); PG8_STAGE(PG8_SB(0, 1), cB + hstep, voffB); PG8_STAGE(PG8_SA(0, 0), cA, voffA); PG8_STAGE(PG8_SA(0, 1), cA + hstep, voffA);
        if (wr == 1) PG8_BAR;
        PG8_WAIT_V(2); PG8_BAR;
        PG8_STAGE(PG8_SB(1, 0), cB + kstep, voffB); PG8_STAGE(PG8_SA(1, 0), cA + kstep, voffA); PG8_STAGE(PG8_SB(1, 1), cB + hstep + kstep, voffB);
        PG8_WAIT_V(6); PG8_BAR;
        for (int t = 0; t < nt; t += 2) {
            const bool last = (t == nt - 2);
            const char* a1 = cA + (size_t)(t + 1) * kstep;
            const char* a2 = last ? cA : cA + (size_t)(t + 2) * kstep; const char* b2 = last ? cB : cB + (size_t)(t + 2) * kstep;
            const char* a3 = a2 + kstep; const char* b3 = b2 + kstep;
            PG8_LDB(B0, 0, 0); PG8_LDB(B1, 0, 1); PG8_SCHED; PG8_LDA(At, 0, 0); PG8_STAGE(PG8_SA(1, 1), a1 + hstep, voffA);
            PG8_WAIT_V(8); PG8_WAIT_L(0); PG8_BAR; PG8_MMA(0, 0, At, B0); PG8_MMA(0, 1, At, B1); PG8_BAR; PG8_SCHED;
            PG8_LDA(At, 0, 1); PG8_STAGE(PG8_SB(0, 0), b2, voffB); PG8_STAGE(PG8_SB(0, 1), b2 + hstep, voffB); PG8_STAGE(PG8_SA(0, 0), a2, voffA);
            PG8_WAIT_V(8); PG8_WAIT_L(0); PG8_BAR; PG8_MMA(1, 0, At, B0); PG8_MMA(1, 1, At, B1); PG8_BAR; PG8_SCHED;
            PG8_LDB(B0, 1, 0); PG8_LDB(B1, 1, 1); PG8_SCHED; PG8_LDA(At, 1, 0); PG8_STAGE(PG8_SA(0, 1), a2 + hstep, voffA);
            PG8_WAIT_V(8); PG8_WAIT_L(0); PG8_BAR; PG8_MMA(0, 0, At, B0); PG8_MMA(0, 1, At, B1); PG8_BAR; PG8_SCHED;
            PG8_LDA(At, 1, 1); PG8_STAGE(PG8_SB(1, 0), b3, voffB); PG8_STAGE(PG8_SB(1, 1), b3 + hstep, voffB); PG8_STAGE(PG8_SA(1, 0), a3, voffA);
            PG8_WAIT_V(8); PG8_WAIT_L(0); PG8_BAR; PG8_MMA(1, 0, At, B0); PG8_MMA(1, 1, At, B1); PG8_BAR; PG8_SCHED;
        }
        if (wr == 0) PG8_BAR;
        PG8_WAIT_V(0); PG8_BAR;
        asm volatile("" ::: "memory");
#pragma unroll
        for (int ai = 0; ai < 2; ++ai)
#pragma unroll
            for (int m = 0; m < 4; ++m)
#pragma unroll
                for (int bj = 0; bj < 2; ++bj)
#pragma unroll
                    for (int n = 0; n < 2; ++n) {
                        const f32x4 v = acc[ai][bj][m][n]; u32x2 w; w.x = pack2(v[0], v[1]); w.y = pack2(v[2], v[3]);
                        *(LAS u32x2*)(lds + (ai * 128 + wr * 64 + m * 16 + fr) * UP + (bj * 128 + wc * 32 + n * 16 + 4 * fq) * 2) = w;
                    }
        __syncthreads();
        __builtin_amdgcn_sched_barrier(0);
        int vlo, vhi; { int rb_; bool c_, d_; upgate_tile(cur.pm, rb_, vlo, vhi, c_, d_); }
        {
            const int c = (tid & 15) * 8, r0 = (tid >> 4) * 8;
            const int ca = cur.pn * 128 + c, cbn = 2816 + cur.pn * 128 + c;
            float wa[3][8], wb[3][8], ba8[8], bb8[8];
#pragma unroll
            for (int q = 0; q < 2; ++q) {
#pragma unroll
                for (int tp = 0; tp < 3; ++tp) {
                    const f32x4 x = *(const f32x4*)(cw + tp * 5632 + ca + q * 4), y = *(const f32x4*)(cw + tp * 5632 + cbn + q * 4);
#pragma unroll
                    for (int jj = 0; jj < 4; ++jj) { wa[tp][q * 4 + jj] = x[jj]; wb[tp][q * 4 + jj] = y[jj]; }
                }
                const f32x4 x = *(const f32x4*)(cb + ca + q * 4), y = *(const f32x4*)(cb + cbn + q * 4);
#pragma unroll
                for (int jj = 0; jj < 4; ++jj) { ba8[q * 4 + jj] = x[jj]; bb8[q * 4 + jj] = y[jj]; }
            }
            const bf16x8 z = (bf16x8){0, 0, 0, 0, 0, 0, 0, 0};
            bf16x8 ap, bp, ac, bc, an, bn;
            {
                const bool hp0 = r0 > 0;
                ap = hp0 ? *(const LAS bf16x8*)(lds + (r0 - 1) * UP + c * 2) : z; bp = hp0 ? *(const LAS bf16x8*)(lds + (r0 - 1) * UP + (128 + c) * 2) : z;
                ac = *(const LAS bf16x8*)(lds + r0 * UP + c * 2); bc = *(const LAS bf16x8*)(lds + r0 * UP + (128 + c) * 2);
            }
#pragma unroll 1
            for (int i = 0; i < 8; ++i) {
                const int r = r0 + i;
                const bool hn = r < 255;
                an = hn ? *(const LAS bf16x8*)(lds + (r + 1) * UP + c * 2) : z; bn = hn ? *(const LAS bf16x8*)(lds + (r + 1) * UP + (128 + c) * 2) : z;
                if (r >= vlo && r <= vhi) {
                    float ov[8];
#pragma unroll
                    for (int e = 0; e < 8; ++e) {
                        const float ua = bf2f((unsigned short)ap[e]) * wa[0][e] + bf2f((unsigned short)ac[e]) * wa[1][e] + bf2f((unsigned short)an[e]) * wa[2][e] + ba8[e];
                        const float ub = bf2f((unsigned short)bp[e]) * wb[0][e] + bf2f((unsigned short)bc[e]) * wb[1][e] + bf2f((unsigned short)bn[e]) * wb[2][e] + bb8[e];
                        ov[e] = siluf_(ua) * ub;
                    }
                    u32x4 w; w.x = pack2(ov[0], ov[1]); w.y = pack2(ov[2], ov[3]); w.z = pack2(ov[4], ov[5]); w.w = pack2(ov[6], ov[7]);
                    *(u32x4*)(ACT + (size_t)(rowbase + r) * 2816 + ca) = w;
                }
                ap = ac; bp = bc; ac = an; bc = bn;
            }
        }
        __syncthreads();
    }
#undef PG8_SA
#undef PG8_SB
#undef PG8_STAGE
#undef PG8_LDA
#undef PG8_LDB
#undef PG8_MMA
#undef PG8_WAIT_V
#undef PG8_WAIT_L
#undef PG8_BAR
#undef PG8_SCHED
}

struct CvtJob { const float* src; bf16_t* dst; int K, N, Npad, tiles, upperm; };
__device__ __forceinline__ void cvt_tile(const Frame& F, const CvtJob& j, int t) {
    LAS float* tile = (LAS float*)F.lds;
    const int tk = j.K / 64, kt = t % tk, ntile = t / tk, k0 = kt * 64, n0 = ntile * 64;
    const int tid = F.tid;
    {
        const int r = tid >> 4, c4 = (tid & 15) * 4;
#pragma unroll
        for (int i = 0; i < 2; ++i) {
            const int kr = r + 32 * i;
            f32x4 v = (f32x4){0.f, 0.f, 0.f, 0.f};
            if (n0 + c4 < j.N) v = *(const f32x4*)(j.src + (size_t)(k0 + kr) * j.N + n0 + c4);
            tile[kr * 65 + c4 + 0] = v[0]; tile[kr * 65 + c4 + 1] = v[1]; tile[kr * 65 + c4 + 2] = v[2]; tile[kr * 65 + c4 + 3] = v[3];
        }
    }
    __syncthreads();
    {
        const int n = tid >> 3, kq = (tid & 7) * 8;
        u32x4 w;
        w.x = pack2(tile[(kq + 0) * 65 + n], tile[(kq + 1) * 65 + n]); w.y = pack2(tile[(kq + 2) * 65 + n], tile[(kq + 3) * 65 + n]);
        w.z = pack2(tile[(kq + 4) * 65 + n], tile[(kq + 5) * 65 + n]); w.w = pack2(tile[(kq + 6) * 65 + n], tile[(kq + 7) * 65 + n]);
        const int drow = j.upperm ? (n0 < 2816 ? (n0 >> 7) * 256 + (n0 & 127) : ((n0 - 2816) >> 7) * 256 + 128 + ((n0 - 2816) & 127)) + n : n0 + n;
        *(u32x4*)(j.dst + (size_t)drow * j.K + k0 + kq) = w;
    }
    __syncthreads();
}

__device__ __forceinline__ void cvt_group(const Frame& F, const PRef& p, int group, int bfirst, int nb, int rot0) {
    if (F.bid < bfirst || F.bid >= bfirst + nb) return;
    unsigned char* ws = p.ws();
    const int vb = F.bid - bfirst;
    int rot = rot0;
#define CVT(srcp, dstoff, K_, N_, Npad_) do { CvtJob jb; jb.src = (srcp); jb.dst = (bf16_t*)(ws + (dstoff)); jb.K = (K_); jb.N = (N_); jb.Npad = (Npad_); jb.tiles = ((K_) / 64) * ((Npad_) / 64); jb.upperm = ((N_) == 5632); \
        for (int t = (vb + nb - (rot % nb)) % nb; t < jb.tiles; t += nb) cvt_tile(F, jb, t); rot += jb.tiles; } while (0)
    if (group == 0) {
        CVT(p.in(19), WS_WAIN, 1024, 1952, 2048);
        CVT(p.in(22), WS_WUQ, 256, 768, 768);
        CVT(p.in(23), WS_WUKV, 128, 1024, 1024);
    } else if (group == 1) {
        CVT(p.in(14), WS_WOUT, 1024, 1024, 1024);
        CVT(p.in(15), WS_WUP, 1024, 5632, 5632);
    } else if (group == 3) {
        CVT(p.in(18), WS_WDN, 2816, 1024, 1024);
    } else {
        CVT(p.in(28), WS_WBIN, 1024, 3456, 3584);
        CVT(p.in(14) + (size_t)1024 * 1024, WS_WOUT + (size_t)1024 * 1024 * 2, 1024, 1024, 1024);
        CVT(p.in(15) + (size_t)1024 * 5632, WS_WUP + (size_t)5632 * 1024 * 2, 1024, 5632, 5632);
        CVT(p.in(18) + (size_t)2816 * 1024, WS_WDN + (size_t)1024 * 2816 * 2, 2816, 1024, 1024);
        CVT(p.in(35), WS_WWUP, 64, 512, 512);
        CVT(p.in(35) + 64 * 512, WS_WWUP + 512 * 64 * 2, 64, 512, 512);
        CVT(p.in(37), WS_WAUP, 64, 512, 512);
        CVT(p.in(37) + 64 * 512, WS_WAUP + 512 * 64 * 2, 64, 512, 512);
        CVT(p.in(38), WS_WGUP, 128, 512, 512);
    }
#undef CVT
}
__device__ __forceinline__ void phase_prep(const Frame& F, const PRef& p) {
    unsigned char* ws = p.ws();
    {
        LAS float* sc = (LAS float*)F.lds;
        LAS float* red = sc + 3 * 1024;
        for (int i = F.tid; i < 3 * 1024; i += NTHREADS) {
            const int c = i >> 10, k = i & 1023;
            const float v = c == 0 ? p.in(9)[k] : p.in(8)[(c - 1) * 1024 + k];
            sc[i] = siluf_(v);
        }
        __syncthreads();
        float* mod = (float*)(ws + WS_MOD);
        FOR_UNITS(u, 192, 0) {
            const int l = u / 96, n0 = (u % 96) * 64, col = F.tid & 63, kg = F.tid >> 6;
            const float* w = p.in(10) + (size_t)l * 1024 * 6144 + (size_t)(kg * 128) * 6144 + n0 + col;
            float a0 = 0.f, a1 = 0.f, a2 = 0.f;
#pragma unroll 8
            for (int k = 0; k < 128; ++k) { const float wv = w[(size_t)k * 6144]; const int kk = kg * 128 + k; a0 += sc[kk] * wv; a1 += sc[1024 + kk] * wv; a2 += sc[2048 + kk] * wv; }
            red[(kg * 3 + 0) * 64 + col] = a0; red[(kg * 3 + 1) * 64 + col] = a1; red[(kg * 3 + 2) * 64 + col] = a2;
            __syncthreads();
            if (F.tid < 192) {
                const int c = F.tid >> 6, cc = F.tid & 63; float s = 0.f;
#pragma unroll
                for (int q = 0; q < 8; ++q) s += red[(q * 3 + c) * 64 + cc];
                mod[(size_t)(l * 3 + c) * 6144 + n0 + cc] = s + p.in(11)[l * 6144 + n0 + cc];
            }
            __syncthreads();
        }
    }
    cvt_group(F, p, 0, 0, F.G, 192);
}

__device__ __forceinline__ void phase_norm(const Frame& F, const float* xa, const float* xb, const bf16_t* part, const float* gate, float* xout,
                                           const float* g, const float* sc, const float* sh, bf16_t* hb, bool do_norm) {
    const int nw = F.G * 8;
    for (int row = F.bid * 8 + F.wave; row < NTOK; row += nw) {
        const float* x = row < NCTX ? xa + (size_t)row * 1024 : xb + (size_t)(row - NCTX) * 1024;
        const int c = cond_of(row);
        f32x4 v[4]; float ss = 0.f;
#pragma unroll
        for (int i = 0; i < 4; ++i) {
            const int col = i * 256 + F.lane * 4;
            v[i] = *(const f32x4*)(x + col);
            if (part) {
                const u32x2 q0 = *(const u32x2*)(part + (size_t)row * 1024 + col), q1 = *(const u32x2*)(part + (size_t)NTOK * 1024 + (size_t)row * 1024 + col);
                const f32x4 ps = (f32x4){bf2f(q0.x & 0xffffu) + bf2f(q1.x & 0xffffu), bf2f(q0.x >> 16) + bf2f(q1.x >> 16), bf2f(q0.y & 0xffffu) + bf2f(q1.y & 0xffffu), bf2f(q0.y >> 16) + bf2f(q1.y >> 16)};
                const f32x4 gt = *(const f32x4*)(gate + c * 6144 + col);
                v[i] = v[i] + gt * ps;
                *(f32x4*)(xout + (size_t)row * 1024 + col) = v[i];
            }
            ss += v[i][0] * v[i][0] + v[i][1] * v[i][1] + v[i][2] * v[i][2] + v[i][3] * v[i][3];
        }
        if (!do_norm) continue;
        ss = wave_sum(ss);
        const float rstd = rsqrtf(ss * (1.0f / 1024.0f) + EPS);
#pragma unroll
        for (int i = 0; i < 4; ++i) {
            const int col = i * 256 + F.lane * 4;
            const f32x4 gg = *(const f32x4*)(g + col), s1 = *(const f32x4*)(sc + c * 6144 + col), s0 = *(const f32x4*)(sh + c * 6144 + col);
            f32x4 h;
#pragma unroll
            for (int j = 0; j < 4; ++j) h[j] = v[i][j] * rstd * gg[j] * (1.0f + s1[j]) + s0[j];
            u32x2 w; w.x = pack2(h[0], h[1]); w.y = pack2(h[2], h[3]);
            *(u32x2*)(hb + (size_t)row * 1024 + col) = w;
        }
    }
}

__device__ __forceinline__ void seq_of_unit384(int u, int& s, int& c, int& h, int& tok0, int& nc) {
    if (u < 256) { s = u >> 4; c = (u >> 2) & 3; h = u & 3; tok0 = s * 256 + c * 64; nc = 4; }
    else { const int v = u - 256; s = 16 + (v >> 6); c = (v >> 2) & 15; h = v & 3; tok0 = NCTX + (s - 16) * 1024 + c * 64; nc = 16; }
}
__device__ __forceinline__ void phase_l0_tok(const Frame& F, const PRef& p) {
    unsigned char* ws = p.ws();
    const float* P = (const float*)(ws + WS_P0);
    bf16_t* cqn = (bf16_t*)(ws + WS_CQN); bf16_t* ckvn = (bf16_t*)(ws + WS_CKVN);
    const int nw = F.G * 8;
    for (int row = F.bid * 8 + F.wave; row < NKROW; row += nw) {
        if (row < NTOK) {
            const float* pr = P + (size_t)row * 2048;
            const f32x4 q = *(const f32x4*)(pr + F.lane * 4);
            float ss = wave_sum(q[0] * q[0] + q[1] * q[1] + q[2] * q[2] + q[3] * q[3]);
            float rstd = rsqrtf(ss * (1.0f / 256.0f) + EPS);
            const f32x4 gq = *(const f32x4*)(p.in(20) + F.lane * 4);
            u32x2 w; w.x = pack2(q[0] * rstd * gq[0], q[1] * rstd * gq[1]); w.y = pack2(q[2] * rstd * gq[2], q[3] * rstd * gq[3]);
            *(u32x2*)(cqn + (size_t)row * 256 + F.lane * 4) = w;
            const f32x2 kv = *(const f32x2*)(pr + 256 + F.lane * 2);
            ss = wave_sum(kv[0] * kv[0] + kv[1] * kv[1]);
            rstd = rsqrtf(ss * (1.0f / 128.0f) + EPS);
            const f32x2 gk = *(const f32x2*)(p.in(21) + F.lane * 2);
            const float o0 = kv[0] * rstd * gk[0], o1 = kv[1] * rstd * gk[1];
            *(unsigned*)(ckvn + (size_t)row * 128 + F.lane * 2) = pack2(o0, o1);
            if (row < NCTX) {
                *(f32x2*)(p.out() + OUT_CKV + (size_t)row * 128 + F.lane * 2) = (f32x2){o0, o1};
                if (F.lane < 32) p.out()[OUT_KROPE + (size_t)row * 32 + F.lane] = pr[384 + F.lane];
            }
        } else {
            const int i = row - NTOK;
            const f32x2 kv = *(const f32x2*)(p.in(2) + (size_t)i * 128 + F.lane * 2);
            *(unsigned*)(ckvn + (size_t)row * 128 + F.lane * 2) = pack2(kv[0], kv[1]);
        }
    }
    {
        LAS unsigned char* L = F.lds;
        constexpr int KPI = 160, VPI = 288, O_KF = 0, O_KB = 64 * KPI, O_V = 2 * 64 * KPI;
        float* KVS = (float*)(ws + WS_KVS);
        const int tid = F.tid, w = F.wave, fr = F.lane & 15, fq = F.lane >> 4;
        FOR_UNITS(u, 384, 0) {
            int s, c, h, tok0, nc; seq_of_unit384(u, s, c, h, tok0, nc);
            const float lgf = __logf(sigmoidf_(p.in(26)[h])), lgb = __logf(sigmoidf_(p.in(26)[4 + h]));
            {
                const int row = tid >> 3, ch = tid & 7;
                const float* pr = P + (size_t)(tok0 + row) * 2048;
                const f32x4 k0 = *(const f32x4*)(pr + 672 + h * 64 + ch * 8), k1 = *(const f32x4*)(pr + 672 + h * 64 + ch * 8 + 4);
                f32x4 vv[4];
#pragma unroll
                for (int i = 0; i < 4; ++i) vv[i] = *(const f32x4*)(pr + 928 + h * 128 + ch * 16 + i * 4);
                const float df = 0.125f * __expf(lgf * (float)(63 - row)), db = 0.125f * __expf(lgb * (float)row);
                u32x4 t;
                t.x = pack2(k0[0] * df, k0[1] * df); t.y = pack2(k0[2] * df, k0[3] * df); t.z = pack2(k1[0] * df, k1[1] * df); t.w = pack2(k1[2] * df, k1[3] * df); *(LAS u32x4*)(L + O_KF + row * KPI + ch * 16) = t;
                t.x = pack2(k0[0] * db, k0[1] * db); t.y = pack2(k0[2] * db, k0[3] * db); t.z = pack2(k1[0] * db, k1[1] * db); t.w = pack2(k1[2] * db, k1[3] * db); *(LAS u32x4*)(L + O_KB + row * KPI + ch * 16) = t;
#pragma unroll
                for (int i = 0; i < 2; ++i) { t.x = pack2(vv[2 * i][0], vv[2 * i][1]); t.y = pack2(vv[2 * i][2], vv[2 * i][3]); t.z = pack2(vv[2 * i + 1][0], vv[2 * i + 1][1]); t.w = pack2(vv[2 * i + 1][2], vv[2 * i + 1][3]);
                    *(LAS u32x4*)(L + O_V + row * VPI + ch * 32 + i * 16) = t; }
            }
            __syncthreads();
            bf16x8 Bf[2];
#pragma unroll
            for (int ks = 0; ks < 2; ++ks) {
                const LAS unsigned char* vp = L + O_V + (32 * ks + 8 * fq + (fr >> 2)) * VPI + (w * 16 + 4 * (fr & 3)) * 2;
                const bf16x4 v0 = __builtin_amdgcn_ds_read_tr16_b64_v4i16((LAS bf16x4*)vp), v1 = __builtin_amdgcn_ds_read_tr16_b64_v4i16((LAS bf16x4*)(vp + 4 * VPI));
                bf16x8 x; x[0] = v0[0]; x[1] = v0[1]; x[2] = v0[2]; x[3] = v0[3]; x[4] = v1[0]; x[5] = v1[1]; x[6] = v1[2]; x[7] = v1[3]; Bf[ks] = x;
            }
            float* o = KVS + (size_t)u * 2 * 8192;
#pragma unroll
            for (int d = 0; d < 2; ++d)
#pragma unroll
                for (int et = 0; et < 4; ++et) {
                    f32x4 a = (f32x4){0.f, 0.f, 0.f, 0.f};
#pragma unroll
                    for (int ks = 0; ks < 2; ++ks) {
                        const LAS unsigned char* kp = L + (d ? O_KB : O_KF) + (32 * ks + 8 * fq + (fr >> 2)) * KPI + (et * 16 + 4 * (fr & 3)) * 2;
                        const bf16x4 v0 = __builtin_amdgcn_ds_read_tr16_b64_v4i16((LAS bf16x4*)kp), v1 = __builtin_amdgcn_ds_read_tr16_b64_v4i16((LAS bf16x4*)(kp + 4 * KPI));
                        bf16x8 x; x[0] = v0[0]; x[1] = v0[1]; x[2] = v0[2]; x[3] = v0[3]; x[4] = v1[0]; x[5] = v1[1]; x[6] = v1[2]; x[7] = v1[3];
                        a = __builtin_amdgcn_mfma_f32_16x16x32_bf16(x, Bf[ks], a, 0, 0, 0);
                    }
#pragma unroll
                    for (int r = 0; r < 4; ++r) o[d * 8192 + (et * 16 + 4 * fq + r) * 128 + w * 16 + fr] = a[r];
                }
            __syncthreads();
        }
    }
}

__device__ __forceinline__ void phase_l0_prefix(const Frame& F, const PRef& p, int rot) {
    float* KVS = (float*)(p.ws() + WS_KVS);
    FOR_UNITS(u, 576, rot) {
        const int qd = u & 3, d = (u >> 2) & 1, h = (u >> 3) & 3, s = u >> 5;
        const int nc = s < 16 ? 4 : 16;
        const int ubase = s < 16 ? s * 16 + h : 256 + (s - 16) * 64 + h;
        const float g64 = __expf(64.0f * __logf(sigmoidf_(p.in(26)[d * 4 + h])));
        const int i = qd * 2048 + F.tid * 4;
        float* base = KVS + (size_t)ubase * 16384 + d * 8192 + i;
        f32x4 kv[16];
#pragma unroll
        for (int c = 0; c < 16; ++c) if (c < nc) kv[c] = *(const f32x4*)(base + (size_t)c * 4 * 16384);
        f32x4 S = (f32x4){0.f, 0.f, 0.f, 0.f};
        if (s >= 16) S = *(const f32x4*)(p.in(4) + (size_t)(((s - 16) * 2 + d) * 4 + h) * 8192 + i);
        if (d == 0) {
#pragma unroll
            for (int c = 0; c < 16; ++c) if (c < nc) { *(f32x4*)(base + (size_t)c * 4 * 16384) = S; S = S * g64 + kv[c]; }
        } else {
#pragma unroll
            for (int c = 15; c >= 0; --c) if (c < nc) { *(f32x4*)(base + (size_t)c * 4 * 16384) = S; S = S * g64 + kv[c]; }
        }
        if (s < 16) *(f32x4*)(p.out() + OUT_SRET + (size_t)((s * 2 + d) * 4 + h) * 8192 + i) = S;
    }
}

__device__ __forceinline__ size_t vt_base(int kr, int nheads, int dv, int& nkeys, int& key) {
    if (kr < NCTX) { nkeys = 256; key = kr & 255; return (size_t)(kr >> 8) * nheads * dv * 256; }
    const int v = kr - NCTX; const int b = v / 1536; nkeys = 1536; key = v - b * 1536;
    return (size_t)16 * nheads * dv * 256 + (size_t)b * nheads * dv * 1536;
}
__device__ __forceinline__ void phase_l0_qkv(const Frame& F, const PRef& p) {
    unsigned char* ws = p.ws();
    const float* P = (const float*)(ws + WS_P0); const float* QR = (const float*)(ws + WS_QRAW); const float* KVR = (const float*)(ws + WS_KVRAW);
    bf16_t* Q = (bf16_t*)(ws + WS_Q0); bf16_t* K = (bf16_t*)(ws + WS_K0); bf16_t* VT = (bf16_t*)(ws + WS_VT0);
    const int nw = F.G * 8, lane = F.lane;
    const float qscale = 0.10206207261596577f;
    for (int row = F.bid * 8 + F.wave; row < NKROW; row += nw) {
        const bool istok = row < NTOK, lat = istok && row >= NCTX;
        float cs = 1.f, sn = 0.f;
        if (lat && lane >= 32 && lane < 48) {
            const int t = (row - NCTX) & 1023, a = lane - 32;
            const float pos = a < 8 ? (float)(t >> 6) : (float)(t & 63);
            const float inv = __powf(10000.0f, -(float)(a & 7) * 0.125f);
            const float ang = pos * inv; cs = __cosf(ang); sn = __sinf(ang);
        }
        int kr;
        if (row < NCTX) kr = row; else if (row < NTOK) { const int v = row - NCTX; kr = NCTX + (v >> 10) * 1536 + (v & 1023); }
        else { const int i = row - NTOK; kr = NCTX + (i >> 9) * 1536 + 1024 + (i & 511); }
        const float* krope = istok ? P + (size_t)row * 2048 + 384 : p.in(3) + (size_t)(row - NTOK) * 32;
        f32x2 qv[8], kv2[8]; float vv[8];
        f32x2 kro = (f32x2){0.f, 0.f};
        if (lane >= 32 && lane < 48) kro = *(const f32x2*)(krope + 2 * (lane - 32));
#pragma unroll
        for (int h = 0; h < 8; ++h) {
            qv[h] = (f32x2){0.f, 0.f};
            if (istok && lane < 48) qv[h] = *(const f32x2*)(QR + (size_t)row * 768 + h * 96 + 2 * lane);
            kv2[h] = kro;
            if (lane < 32) kv2[h] = *(const f32x2*)(KVR + (size_t)row * 1024 + h * 128 + 2 * lane);
            vv[h] = KVR[(size_t)row * 1024 + h * 128 + 64 + lane];
        }
        f32x2 gq = (f32x2){0.f, 0.f}, gk = (f32x2){0.f, 0.f};
        if (lane < 48) { gq = *(const f32x2*)(p.in(24) + 2 * lane); gk = *(const f32x2*)(p.in(25) + 2 * lane); }
#pragma unroll
        for (int h = 0; h < 8; ++h) {
            if (istok) {
                float x1 = qv[h][0], x2 = qv[h][1];
                const float rstd = rsqrtf(wave_sum(x1 * x1 + x2 * x2) * (1.0f / 96.0f) + EPS);
                if (lane < 48) {
                    x1 = x1 * rstd * gq[0]; x2 = x2 * rstd * gq[1];
                    const float y1 = x1 * cs - x2 * sn, y2 = x1 * sn + x2 * cs;
                    *(unsigned*)(Q + (size_t)row * 768 + h * 96 + 2 * lane) = pack2(y1 * qscale, y2 * qscale);
                }
            }
            {
                float x1 = kv2[h][0], x2 = kv2[h][1];
                const float rstd = rsqrtf(wave_sum(x1 * x1 + x2 * x2) * (1.0f / 96.0f) + EPS);
                if (lane < 48) {
                    x1 = x1 * rstd * gk[0]; x2 = x2 * rstd * gk[1];
                    const float y1 = x1 * cs - x2 * sn, y2 = x1 * sn + x2 * cs;
                    *(unsigned*)(K + (size_t)kr * 768 + h * 96 + 2 * lane) = pack2(y1, y2);
                }
            }
            VT[(size_t)kr * 512 + h * 64 + lane] = f2bf(vv[h]);
        }
    }
}

template <int DQK, int DV, int NC, int NQT>
struct AttnState { f32x4 O[NC][DV / 16][NQT]; float l[NC][NQT]; };

template <int DQK, int DV, int NC, int NQT>
__device__ __forceinline__ void attn_wave(const bf16_t* __restrict__ Q, const bf16_t* __restrict__ K, const bf16_t* __restrict__ Vt,
                                          int qtok0, int krow0, int nkeys, int hh0  , int lane, AttnState<DQK, DV, NC, NQT>& st) {
    constexpr int NS = DQK / 32, NE = DV / 16, RS = 8 * DQK;
    const int fr = lane & 15, fq = lane >> 4;
    bf16x8 Qf[NC][NQT][NS];
#pragma unroll
    for (int c = 0; c < NC; ++c)
#pragma unroll
        for (int qt = 0; qt < NQT; ++qt)
#pragma unroll
            for (int s = 0; s < NS; ++s) Qf[c][qt][s] = *(const bf16x8*)(Q + (size_t)(qtok0 + qt * 16 + fr) * RS + (hh0 + c) * DQK + s * 32 + fq * 8);
    float m[NC][NQT];
#pragma unroll
    for (int c = 0; c < NC; ++c)
#pragma unroll
        for (int qt = 0; qt < NQT; ++qt) { m[c][qt] = -1e30f; st.l[c][qt] = 0.f;
#pragma unroll
            for (int e = 0; e < NE; ++e) st.O[c][e][qt] = (f32x4){0.f, 0.f, 0.f, 0.f}; }
    for (int key0 = 0; key0 < nkeys; key0 += 32) {
        bf16x8 Pf[NC][NQT];
#pragma unroll
        for (int c = 0; c < NC; ++c) {
            f32x4 S[2][NQT];
#pragma unroll
            for (int kt = 0; kt < 2; ++kt) {
                bf16x8 Kf[NS];
#pragma unroll
                for (int s = 0; s < NS; ++s) Kf[s] = *(const bf16x8*)(K + (size_t)(krow0 + key0 + kt * 16 + fr) * RS + (hh0 + c) * DQK + s * 32 + fq * 8);
#pragma unroll
                for (int qt = 0; qt < NQT; ++qt) {
                    f32x4 a = (f32x4){0.f, 0.f, 0.f, 0.f};
#pragma unroll
                    for (int s = 0; s < NS; ++s) a = __builtin_amdgcn_mfma_f32_16x16x32_bf16(Kf[s], Qf[c][qt][s], a, 0, 0, 0);
                    S[kt][qt] = a;
                }
            }
#pragma unroll
            for (int qt = 0; qt < NQT; ++qt) {
                float mx = fmaxf(fmaxf(fmaxf(S[0][qt][0], S[0][qt][1]), fmaxf(S[0][qt][2], S[0][qt][3])), fmaxf(fmaxf(S[1][qt][0], S[1][qt][1]), fmaxf(S[1][qt][2], S[1][qt][3])));
                mx = fmaxf(mx, __shfl_xor(mx, 16)); mx = fmaxf(mx, __shfl_xor(mx, 32));
                const float mn = fmaxf(m[c][qt], mx), alpha = __expf(m[c][qt] - mn);
                m[c][qt] = mn;
                float pv[8]; float ps = 0.f;
#pragma unroll
                for (int j = 0; j < 4; ++j) { pv[j] = __expf(S[0][qt][j] - mn); pv[4 + j] = __expf(S[1][qt][j] - mn); ps += pv[j] + pv[4 + j]; }
                st.l[c][qt] = st.l[c][qt] * alpha + ps;
#pragma unroll
                for (int e = 0; e < NE; ++e) st.O[c][e][qt] *= alpha;
                u32x4 pk; pk.x = pack2(pv[0], pv[1]); pk.y = pack2(pv[2], pv[3]); pk.z = pack2(pv[4], pv[5]); pk.w = pack2(pv[6], pv[7]);
                Pf[c][qt] = __builtin_bit_cast(bf16x8, pk);
            }
        }
#pragma unroll
        for (int e = 0; e < NE; ++e) {
            const bf16_t* vp = Vt + (size_t)(e * 16 + fr) * nkeys + key0 + 4 * fq;
            const bf16x4 v0 = *(const bf16x4*)vp, v1 = *(const bf16x4*)(vp + 16);
            bf16x8 Vf; Vf[0] = v0[0]; Vf[1] = v0[1]; Vf[2] = v0[2]; Vf[3] = v0[3]; Vf[4] = v1[0]; Vf[5] = v1[1]; Vf[6] = v1[2]; Vf[7] = v1[3];
#pragma unroll
            for (int c = 0; c < NC; ++c)
#pragma unroll
                for (int qt = 0; qt < NQT; ++qt) st.O[c][e][qt] = __builtin_amdgcn_mfma_f32_16x16x32_bf16(Vf, Pf[c][qt], st.O[c][e][qt], 0, 0, 0);
        }
    }
#pragma unroll
    for (int c = 0; c < NC; ++c)
#pragma unroll
        for (int qt = 0; qt < NQT; ++qt) { float l = st.l[c][qt]; l += __shfl_xor(l, 16); l += __shfl_xor(l, 32); st.l[c][qt] = 1.0f / l; }
}

__device__ __forceinline__ int attn_unit_xcd(int bid, int which) {
    const int x = bid & 7, idx = bid >> 3;
    return which == 0 ? (2 * x + (idx >> 4)) * 16 + (idx & 15) : 256 + (x * 16 + (idx >> 1)) * 2 + (idx & 1);
}
template <int DQK, int DV, int VH, class OutFn>
__device__ __forceinline__ void attn_block(const Frame& F, const bf16_t* __restrict__ Q, const bf16_t* __restrict__ K, const bf16_t* __restrict__ VT, const OutFn& out, int unit, float shift) {
    constexpr int NS = DQK / 32, NE = DV / 16, RS = 8 * DQK, KPC = DQK / 8;
    constexpr int KB = 128 * 256, VP = DV * 2 + 32, VB = 128 * VP, STG = KB + VB, VPC = DV / 8;
    constexpr int NKP = 128 * KPC / NTHREADS, NVP = 128 * VPC / NTHREADS;
    LAS unsigned char* lds = F.lds;
    const int lane = F.lane, fr = lane & 15, fq = lane >> 4, wave = F.wave, tid = F.tid;
    const bool lat = unit < 256;
    int ab, h, q0, nkeys, NQG;
    if (lat) { ab = 16 + (unit >> 7); h = (unit >> 4) & 7; q0 = (unit & 15) * 64; nkeys = 1536; NQG = 2; }
    else { const int v = unit - 256; ab = v >> 4; h = (v >> 1) & 7; q0 = (v & 1) * 128; nkeys = 256; NQG = 4; }
    const int NKS = 8 / NQG, qg = wave % NQG, ks = wave / NQG, kslice = 128 / NKS, nit = kslice / 32;
    const int qtok0 = (lat ? NCTX + (ab - 16) * 1024 : ab * 256) + q0 + qg * 32;
    const int krow0 = lat ? NCTX + (ab - 16) * 1536 : ab * 256;
    const bf16_t* vg = VT + (size_t)krow0 * (VH * DV) + (h * VH / 8) * DV;
    const bf16_t* kg = K + (size_t)krow0 * RS + h * DQK;
    bf16x8 Qf[2][NS];
#pragma unroll
    for (int qt = 0; qt < 2; ++qt)
#pragma unroll
        for (int s = 0; s < NS; ++s) Qf[qt][s] = *(const bf16x8*)(Q + (size_t)(qtok0 + qt * 16 + fr) * RS + h * DQK + s * 32 + fq * 8);
    f32x4 O[NE][2]; float l[2];
    const float sh2 = shift * 1.44269504f;
#pragma unroll
    for (int qt = 0; qt < 2; ++qt) { l[qt] = 0.f;
#pragma unroll
        for (int e = 0; e < NE; ++e) O[e][qt] = (f32x4){0.f, 0.f, 0.f, 0.f}; }
    u32x4 kregA[NKP], vregA[NVP], kregB[DV == 64 ? NKP : 1], vregB[DV == 64 ? NVP : 1];
#define AT_LOAD(kreg, vreg, st) do { \
        _Pragma("unroll") for (int i = 0; i < NKP; ++i) { const int pid = tid + i * NTHREADS, row = pid / KPC, ch = pid % KPC; kreg[i] = *(const u32x4*)(kg + (size_t)((st) * 128 + row) * RS + ch * 8); } \
        _Pragma("unroll") for (int i = 0; i < NVP; ++i) { const int pid = tid + i * NTHREADS, row = pid / VPC, ch = pid % VPC; vreg[i] = *(const u32x4*)(vg + (size_t)((st) * 128 + row) * (VH * DV) + ch * 8); } } while (0)
#define AT_WRITE(kreg, vreg, buf) do { \
        _Pragma("unroll") for (int i = 0; i < NKP; ++i) { const int pid = tid + i * NTHREADS, row = pid / KPC, ch = pid % KPC; *(LAS u32x4*)(lds + (buf) * STG + row * 256 + ((ch ^ (row & 15)) << 4)) = kreg[i]; } \
        _Pragma("unroll") for (int i = 0; i < NVP; ++i) { const int pid = tid + i * NTHREADS, row = pid / VPC, ch = pid % VPC; *(LAS u32x4*)(lds + (buf) * STG + KB + row * VP + ch * 16) = vreg[i]; } } while (0)
#define AT_COMPUTE(bufsel) do { \
        const LAS unsigned char* kb = lds + (bufsel) * STG; const LAS unsigned char* vb = kb + KB; \
        for (int it = 0; it < nit; ++it) { \
            const int key0 = ks * kslice + it * 32; \
            f32x4 S[2][2]; \
            _Pragma("unroll") for (int kt = 0; kt < 2; ++kt) { \
                const int row = key0 + kt * 16 + fr; \
                bf16x8 Kf[NS]; \
                _Pragma("unroll") for (int s_ = 0; s_ < NS; ++s_) Kf[s_] = *(const LAS bf16x8*)(kb + row * 256 + (((4 * s_ + fq) ^ (row & 15)) << 4)); \
                _Pragma("unroll") for (int qt = 0; qt < 2; ++qt) { \
                    f32x4 a = (f32x4){0.f, 0.f, 0.f, 0.f}; \
                    _Pragma("unroll") for (int s_ = 0; s_ < NS; ++s_) a = __builtin_amdgcn_mfma_f32_16x16x32_bf16(Kf[s_], Qf[qt][s_], a, 0, 0, 0); \
                    S[kt][qt] = a; } } \
            bf16x8 Pf[2]; \
            _Pragma("unroll") for (int qt = 0; qt < 2; ++qt) { \
                float pv[8]; float ps = 0.f; \
                _Pragma("unroll") for (int j = 0; j < 4; ++j) { pv[j] = __builtin_amdgcn_exp2f(S[0][qt][j] * 1.44269504f - sh2); pv[4 + j] = __builtin_amdgcn_exp2f(S[1][qt][j] * 1.44269504f - sh2); ps += pv[j] + pv[4 + j]; } \
                l[qt] += ps; \
                u32x4 pk; pk.x = pack2(pv[0], pv[1]); pk.y = pack2(pv[2], pv[3]); pk.z = pack2(pv[4], pv[5]); pk.w = pack2(pv[6], pv[7]); \
                Pf[qt] = __builtin_bit_cast(bf16x8, pk); } \
            _Pragma("unroll") for (int e = 0; e < NE; ++e) { \
                const LAS unsigned char* vp = vb + (key0 + 4 * fq + (fr >> 2)) * VP + (e * 16 + 4 * (fr & 3)) * 2; \
                const bf16x4 v0 = __builtin_amdgcn_ds_read_tr16_b64_v4i16((LAS bf16x4*)vp), v1 = __builtin_amdgcn_ds_read_tr16_b64_v4i16((LAS bf16x4*)(vp + 16 * VP)); \
                bf16x8 Vf; Vf[0] = v0[0]; Vf[1] = v0[1]; Vf[2] = v0[2]; Vf[3] = v0[3]; Vf[4] = v1[0]; Vf[5] = v1[1]; Vf[6] = v1[2]; Vf[7] = v1[3]; \
                _Pragma("unroll") for (int qt = 0; qt < 2; ++qt) O[e][qt] = __builtin_amdgcn_mfma_f32_16x16x32_bf16(Vf, Pf[qt], O[e][qt], 0, 0, 0); } } } while (0)
    const int nst = nkeys / 128;
    constexpr bool TWOSET = DV == 64;
    AT_LOAD(kregA, vregA, 0); if (TWOSET) AT_LOAD(kregB, vregB, 1); AT_WRITE(kregA, vregA, 0);
#pragma unroll
    for (int qt = 0; qt < 2; ++qt)
#pragma unroll
        for (int s_ = 0; s_ < NS; ++s_) asm volatile("" :: "v"(Qf[qt][s_]));
    __syncthreads();
    for (int st = 0; st < nst; st += 2) {
        if (TWOSET) {
            if (st + 2 < nst) AT_LOAD(kregA, vregA, st + 2);
            AT_COMPUTE(0);
            AT_WRITE(kregB, vregB, 1);
            __syncthreads();
            if (st + 3 < nst) AT_LOAD(kregB, vregB, st + 3);
            AT_COMPUTE(1);
            if (st + 2 < nst) AT_WRITE(kregA, vregA, 0);
            __syncthreads();
        } else {
            AT_LOAD(kregA, vregA, st + 1);
            AT_COMPUTE(0);
            AT_WRITE(kregA, vregA, 1);
            __syncthreads();
            if (st + 2 < nst) AT_LOAD(kregA, vregA, st + 2);
            AT_COMPUTE(1);
            if (st + 2 < nst) AT_WRITE(kregA, vregA, 0);
            __syncthreads();
        }
    }
#undef AT_COMPUTE
#undef AT_LOAD
#undef AT_WRITE
    LAS f32x4* Ost = (LAS f32x4*)lds; LAS float* LL = (LAS float*)(lds + 8 * 2 * NE * 1024);
#pragma unroll
    for (int qt = 0; qt < 2; ++qt) {
        float lt = l[qt]; lt += __shfl_xor(lt, 16); lt += __shfl_xor(lt, 32);
        if (fq == 0) LL[(wave * 2 + qt) * 16 + fr] = lt;
#pragma unroll
        for (int e = 0; e < NE; ++e) Ost[((wave * 2 + qt) * NE + e) * 64 + lane] = O[e][qt];
    }
    __syncthreads();
    const int epw = NE / NKS;
#pragma unroll
    for (int qt = 0; qt < 2; ++qt) {
        float L = 0.f;
        for (int j = 0; j < NKS; ++j) L += LL[((j * NQG + qg) * 2 + qt) * 16 + fr];
        const float invL = 1.0f / L;
        for (int ee = 0; ee < epw; ++ee) {
            const int e = ks * epw + ee;
            f32x4 o = (f32x4){0.f, 0.f, 0.f, 0.f};
            for (int j = 0; j < NKS; ++j) o += Ost[(((j * NQG + qg) * 2 + qt) * NE + e) * 64 + lane];
            out(qtok0 + qt * 16 + fr, h * DV + e * 16 + 4 * fq, o * invL);
        }
    }
    __syncthreads();
}
struct AttnOutBf16 { bf16_t* C; int ldc;
    __device__ __forceinline__ void operator()(int tok, int col, f32x4 o) const { u32x2 w; w.x = pack2(o[0], o[1]); w.y = pack2(o[2], o[3]); *(u32x2*)(C + (size_t)tok * ldc + col) = w; } };

__device__ __forceinline__ void attn_unit(int u, int wave, int& ab, int& h, int& q0) {
    if (u < 64) { ab = 16 + (u >> 5); h = (u >> 2) & 7; q0 = (u & 3) * 256 + wave * 32; }
    else { const int v = u - 64; ab = v >> 3; h = v & 7; q0 = wave * 32; }
}

__device__ __forceinline__ void phase_l0_mix(const Frame& F, const PRef& p) {
    unsigned char* ws = p.ws();
    const float* P = (const float*)(ws + WS_P0);
    bf16_t* OB = (bf16_t*)(ws + WS_OB);
    const bf16_t* Q = (const bf16_t*)(ws + WS_Q0); const bf16_t* K = (const bf16_t*)(ws + WS_K0); const bf16_t* VT = (const bf16_t*)(ws + WS_VT0);
    const int lane = F.lane, fr = lane & 15, fq = lane >> 4;
    {
        float gq = 0.f, gk = 0.f;
        for (int i = 0; i < 96; ++i) { gq = fmaxf(gq, fabsf(p.in(24)[i])); gk = fmaxf(gk, fabsf(p.in(25)[i])); }
        const float shift = 9.79795897f * gq * gk;
        AttnOutBf16 ao{OB, 1024};
#ifndef ATT_REP
#define ATT_REP 0
#endif
        for (int rp_ = 0; rp_ < 1 + (ATT_REP == 1); ++rp_) {
            for (int slot = 0; slot * F.G < 512; ++slot) { const int u = F.G == 256 ? attn_unit_xcd(F.bid, slot) : F.bid + slot * F.G; if (u < 512) for (int r2_ = 0; r2_ < 1 + ((ATT_REP == 3 && slot == 0) || (ATT_REP == 4 && slot == 1) ? 3 : 0); ++r2_) attn_block<96, 64, 8>(F, Q, K, VT, ao, u, shift); }
        } }
    {
        LAS unsigned char* L = F.lds;
        constexpr int T64 = 64 * 128, VPI = 288, T128 = 64 * VPI;
        constexpr int O_Q = 0, O_K = T64, O_QF = 2 * T64, O_QB = 3 * T64, O_W = 4 * T64, O_V = 5 * T64, O_SF = O_V + T128, O_SB = O_SF + T128, O_RED = O_SB + T128;
        const float* KVS = (const float*)(ws + WS_KVS);
        const int tid = F.tid, w = F.wave;
        for (int rp_ = 0; rp_ < 1 + (ATT_REP == 2); ++rp_)
        FOR_UNITS(u, 384, 128) {
            int s, c, h, tok0, nc; seq_of_unit384(u, s, c, h, tok0, nc);
            const float lgf = __logf(sigmoidf_(p.in(26)[h])), lgb = __logf(sigmoidf_(p.in(26)[4 + h]));
            {
                const int row = tid >> 3, ch = tid & 7;
                const float* pr = P + (size_t)(tok0 + row) * 2048;
                const f32x4 q0 = *(const f32x4*)(pr + 416 + h * 64 + ch * 8), q1 = *(const f32x4*)(pr + 416 + h * 64 + ch * 8 + 4);
                const f32x4 k0 = *(const f32x4*)(pr + 672 + h * 64 + ch * 8), k1 = *(const f32x4*)(pr + 672 + h * 64 + ch * 8 + 4);
                f32x4 vv[4], sf[4], sb[4];
#pragma unroll
                for (int i = 0; i < 4; ++i) { vv[i] = *(const f32x4*)(pr + 928 + h * 128 + ch * 16 + i * 4);
                    sf[i] = *(const f32x4*)(KVS + (size_t)u * 16384 + row * 128 + ch * 16 + i * 4); sb[i] = *(const f32x4*)(KVS + (size_t)u * 16384 + 8192 + row * 128 + ch * 16 + i * 4); }
                const float df = __expf(lgf * (float)(row + 1)), db = __expf(lgb * (float)(64 - row));
                const int so = row * 128 + ((ch ^ (row & 7)) << 4);
                u32x4 t;
                t.x = pack2(q0[0], q0[1]); t.y = pack2(q0[2], q0[3]); t.z = pack2(q1[0], q1[1]); t.w = pack2(q1[2], q1[3]); *(LAS u32x4*)(L + O_Q + so) = t;
                t.x = pack2(q0[0] * df, q0[1] * df); t.y = pack2(q0[2] * df, q0[3] * df); t.z = pack2(q1[0] * df, q1[1] * df); t.w = pack2(q1[2] * df, q1[3] * df); *(LAS u32x4*)(L + O_QF + so) = t;
                t.x = pack2(q0[0] * db, q0[1] * db); t.y = pack2(q0[2] * db, q0[3] * db); t.z = pack2(q1[0] * db, q1[1] * db); t.w = pack2(q1[2] * db, q1[3] * db); *(LAS u32x4*)(L + O_QB + so) = t;
                t.x = pack2(k0[0] * 0.125f, k0[1] * 0.125f); t.y = pack2(k0[2] * 0.125f, k0[3] * 0.125f); t.z = pack2(k1[0] * 0.125f, k1[1] * 0.125f); t.w = pack2(k1[2] * 0.125f, k1[3] * 0.125f); *(LAS u32x4*)(L + O_K + so) = t;
                const int vo = row * VPI + ch * 32;
#pragma unroll
                for (int i = 0; i < 2; ++i) {
                    t.x = pack2(vv[2 * i][0], vv[2 * i][1]); t.y = pack2(vv[2 * i][2], vv[2 * i][3]); t.z = pack2(vv[2 * i + 1][0], vv[2 * i + 1][1]); t.w = pack2(vv[2 * i + 1][2], vv[2 * i + 1][3]); *(LAS u32x4*)(L + O_V + vo + i * 16) = t;
                    t.x = pack2(sf[2 * i][0], sf[2 * i][1]); t.y = pack2(sf[2 * i][2], sf[2 * i][3]); t.z = pack2(sf[2 * i + 1][0], sf[2 * i + 1][1]); t.w = pack2(sf[2 * i + 1][2], sf[2 * i + 1][3]); *(LAS u32x4*)(L + O_SF + vo + i * 16) = t;
                    t.x = pack2(sb[2 * i][0], sb[2 * i][1]); t.y = pack2(sb[2 * i][2], sb[2 * i][3]); t.z = pack2(sb[2 * i + 1][0], sb[2 * i + 1][1]); t.w = pack2(sb[2 * i + 1][2], sb[2 * i + 1][3]); *(LAS u32x4*)(L + O_SB + vo + i * 16) = t;
                }
            }
            __syncthreads();
            {
                const int jt = w >> 1;
                bf16x8 Kf[2];
#pragma unroll
                for (int ks = 0; ks < 2; ++ks) { const int row = jt * 16 + fr; Kf[ks] = *(const LAS bf16x8*)(L + O_K + row * 128 + (((4 * ks + fq) ^ (row & 7)) << 4)); }
#pragma unroll
                for (int t2 = 0; t2 < 2; ++t2) {
                    const int it = (w & 1) * 2 + t2, irow = it * 16 + fr;
                    f32x4 d = (f32x4){0.f, 0.f, 0.f, 0.f};
#pragma unroll
                    for (int ks = 0; ks < 2; ++ks) { const bf16x8 Qf_ = *(const LAS bf16x8*)(L + O_Q + irow * 128 + (((4 * ks + fq) ^ (irow & 7)) << 4)); d = __builtin_amdgcn_mfma_f32_16x16x32_bf16(Kf[ks], Qf_, d, 0, 0, 0); }
                    float wv[4];
#pragma unroll
                    for (int r = 0; r < 4; ++r) { const int j = jt * 16 + 4 * fq + r; float dec = 0.f; if (j <= irow) dec += __expf(lgf * (float)(irow - j)); if (j >= irow) dec += __expf(lgb * (float)(j - irow)); wv[r] = d[r] * dec; }
                    u32x2 t; t.x = pack2(wv[0], wv[1]); t.y = pack2(wv[2], wv[3]);
                    *(LAS u32x2*)(L + O_W + irow * 128 + (((2 * jt + (fq >> 1)) ^ (irow & 7)) << 4) + (fq & 1) * 8) = t;
                }
            }
            __syncthreads();
            f32x4 acc[4];
#pragma unroll
            for (int it = 0; it < 4; ++it) acc[it] = (f32x4){0.f, 0.f, 0.f, 0.f};
            {
                bf16x8 Af[3][2];
#pragma unroll
                for (int a = 0; a < 3; ++a)
#pragma unroll
                    for (int ks = 0; ks < 2; ++ks) {
                        const LAS unsigned char* vp = L + (a == 0 ? O_V : (a == 1 ? O_SF : O_SB)) + (32 * ks + 8 * fq + (fr >> 2)) * VPI + (w * 16 + 4 * (fr & 3)) * 2;
                        const bf16x4 v0 = __builtin_amdgcn_ds_read_tr16_b64_v4i16((LAS bf16x4*)vp), v1 = __builtin_amdgcn_ds_read_tr16_b64_v4i16((LAS bf16x4*)(vp + 4 * VPI));
                        bf16x8 x; x[0] = v0[0]; x[1] = v0[1]; x[2] = v0[2]; x[3] = v0[3]; x[4] = v1[0]; x[5] = v1[1]; x[6] = v1[2]; x[7] = v1[3];
                        Af[a][ks] = x;
                    }
#pragma unroll
                for (int it = 0; it < 4; ++it) {
                    const int irow = it * 16 + fr;
#pragma unroll
                    for (int ks = 0; ks < 2; ++ks) {
                        const int so = irow * 128 + (((4 * ks + fq) ^ (irow & 7)) << 4);
                        const bf16x8 bw = *(const LAS bf16x8*)(L + O_W + so), bqf = *(const LAS bf16x8*)(L + O_QF + so), bqb = *(const LAS bf16x8*)(L + O_QB + so);
                        acc[it] = __builtin_amdgcn_mfma_f32_16x16x32_bf16(Af[0][ks], bw, acc[it], 0, 0, 0);
                        acc[it] = __builtin_amdgcn_mfma_f32_16x16x32_bf16(Af[1][ks], bqf, acc[it], 0, 0, 0);
                        acc[it] = __builtin_amdgcn_mfma_f32_16x16x32_bf16(Af[2][ks], bqb, acc[it], 0, 0, 0);
                    }
                }
            }
            LAS float* red = (LAS float*)(L + O_RED);
#pragma unroll
            for (int it = 0; it < 4; ++it) {
                float ss = acc[it][0] * acc[it][0] + acc[it][1] * acc[it][1] + acc[it][2] * acc[it][2] + acc[it][3] * acc[it][3];
                ss += __shfl_xor(ss, 16); ss += __shfl_xor(ss, 32);
                if (fq == 0) red[w * 64 + it * 16 + fr] = ss;
            }
            __syncthreads();
            {
                const f32x4 gn = *(const f32x4*)(p.in(27) + h * 128 + w * 16 + 4 * fq);
#pragma unroll
                for (int it = 0; it < 4; ++it) {
                    const int i = it * 16 + fr, tok = tok0 + i;
                    float ss = 0.f;
#pragma unroll
                    for (int q = 0; q < 8; ++q) ss += red[q * 64 + i];
                    const float rstd = rsqrtf(ss * (1.0f / 128.0f) + EPS);
                    const f32x4 rg = *(const f32x4*)(P + (size_t)tok * 2048 + 1440 + h * 128 + w * 16 + 4 * fq);
                    u32x2 t; t.x = pack2(siluf_(rg[0]) * acc[it][0] * rstd * gn[0], siluf_(rg[1]) * acc[it][1] * rstd * gn[1]);
                    t.y = pack2(siluf_(rg[2]) * acc[it][2] * rstd * gn[2], siluf_(rg[3]) * acc[it][3] * rstd * gn[3]);
                    *(u32x2*)(OB + (size_t)tok * 1024 + 512 + h * 128 + w * 16 + 4 * fq) = t;
                }
            }
            __syncthreads();
        }
    }
}

__device__ __forceinline__ void phase_gate(const Frame& F, const PRef& p, int l) {
    const bf16_t* U = (const bf16_t*)(p.ws() + WS_U); bf16_t* ACT = (bf16_t*)(p.ws() + WS_ACT);
    const float* cw = p.in(16) + (size_t)l * 3 * 5632; const float* cb = p.in(17) + (size_t)l * 5632;
    const int gt = F.bid * NTHREADS + F.tid, ngt = F.G * NTHREADS;
    const int cg = gt % 352, tslot = gt / 352, nslot = ngt / 352;
    if (tslot >= nslot) return;
    const int c0 = cg * 8;
    float w0[2][8], w1[2][8], w2[2][8], bb[2][8];
#pragma unroll
    for (int half = 0; half < 2; ++half) {
        const int col = c0 + half * 2816;
#pragma unroll
        for (int q = 0; q < 2; ++q) {
            const f32x4 a = *(const f32x4*)(cw + col + q * 4), b = *(const f32x4*)(cw + 5632 + col + q * 4), c = *(const f32x4*)(cw + 2 * 5632 + col + q * 4), d = *(const f32x4*)(cb + col + q * 4);
#pragma unroll
            for (int j = 0; j < 4; ++j) { w0[half][q * 4 + j] = a[j]; w1[half][q * 4 + j] = b[j]; w2[half][q * 4 + j] = c[j]; bb[half][q * 4 + j] = d[j]; }
        }
    }
    bf16x8 cx[2][3], nx[2][3];
#define GATE_LOAD(dst, tok_) do { const int t_ = (tok_) < NCTX ? ((tok_) & 255) : (((tok_) - NCTX) & 1023), n_ = (tok_) < NCTX ? 256 : 1024; \
        const bf16x8 z_ = (bf16x8){0, 0, 0, 0, 0, 0, 0, 0}; \
        _Pragma("unroll") for (int half = 0; half < 2; ++half) { const bf16_t* up_ = U + (size_t)(tok_) * 5632 + c0 + half * 2816; \
            dst[half][1] = *(const bf16x8*)up_; dst[half][0] = t_ > 0 ? *(const bf16x8*)(up_ - 5632) : z_; dst[half][2] = t_ < n_ - 1 ? *(const bf16x8*)(up_ + 5632) : z_; } } while (0)
    if (tslot < NTOK) GATE_LOAD(cx, tslot);
    for (int tok = tslot; tok < NTOK; tok += nslot) {
        if (tok + nslot < NTOK) GATE_LOAD(nx, tok + nslot);
        float u2[2][8];
#pragma unroll
        for (int half = 0; half < 2; ++half)
#pragma unroll
            for (int j = 0; j < 8; ++j)
                u2[half][j] = bf2f((unsigned short)cx[half][0][j]) * w0[half][j] + bf2f((unsigned short)cx[half][1][j]) * w1[half][j] + bf2f((unsigned short)cx[half][2][j]) * w2[half][j] + bb[half][j];
        u32x4 w;
        w.x = pack2(siluf_(u2[0][0]) * u2[1][0], siluf_(u2[0][1]) * u2[1][1]); w.y = pack2(siluf_(u2[0][2]) * u2[1][2], siluf_(u2[0][3]) * u2[1][3]);
        w.z = pack2(siluf_(u2[0][4]) * u2[1][4], siluf_(u2[0][5]) * u2[1][5]); w.w = pack2(siluf_(u2[0][6]) * u2[1][6], siluf_(u2[0][7]) * u2[1][7]);
        *(u32x4*)(ACT + (size_t)tok * 2816 + c0) = w;
#pragma unroll
        for (int half = 0; half < 2; ++half)
#pragma unroll
            for (int q = 0; q < 3; ++q) cx[half][q] = nx[half][q];
    }
#undef GATE_LOAD
}

__device__ __forceinline__ void phase_l1_tok(const Frame& F, const PRef& p) {
    unsigned char* ws = p.ws();
    const float* P = (const float*)(ws + WS_P1);
    bf16_t* QD = (bf16_t*)(ws + WS_QD); bf16_t* KD = (bf16_t*)(ws + WS_KD); bf16_t* VDT = (bf16_t*)(ws + WS_VDT);
    float* RR = (float*)(ws + WS_RR); float* KR = (float*)(ws + WS_KR); float* VV = (float*)(ws + WS_VV); float* KK = (float*)(ws + WS_KK);
    bf16_t* TW = (bf16_t*)(ws + WS_TW); bf16_t* AD = (bf16_t*)(ws + WS_AD); bf16_t* SG = (bf16_t*)(ws + WS_SG);
    const int nw = F.G * 8, lane = F.lane;
    const float* mu = p.in(33);
    for (int row = F.bid * 8 + F.wave; row < NKROW; row += nw) {
        const bool istok = row < NTOK, lat = istok && row >= NCTX;
        int kr;
        if (row < NCTX) kr = row; else if (row < NTOK) { const int v = row - NCTX; kr = NCTX + (v >> 10) * 1536 + (v & 1023); }
        else { const int i = row - NTOK; kr = NCTX + (i >> 9) * 1536 + 1024 + (i & 511); }
        if (!istok) {
            const int i = row - NTOK;
#pragma unroll
            for (int j = 0; j < 8; ++j) {
                const int col = j * 64 + lane;
                KD[(size_t)kr * 512 + col] = f2bf(p.in(5)[(size_t)i * 512 + col]);
                VDT[(size_t)kr * 512 + col] = f2bf(p.in(6)[(size_t)i * 512 + col]);
            }
            continue;
        }
        const float* pr = P + (size_t)row * 3584;
        float cs = 1.f, sn = 0.f;
        if (lat) {
            const int t = (row - NCTX) & 1023, a = lane & 31;
            const float pos = a < 16 ? (float)(t >> 6) : (float)(t & 63);
            const float inv = __powf(10000.0f, -(float)(a & 15) * 0.0625f);
            const float ang = pos * inv; cs = __cosf(ang); sn = __sinf(ang);
        }
        {
            const int pi = lane & 31;
            f32x2 qv[4], kv[4];
#pragma unroll
            for (int pass = 0; pass < 4; ++pass) { const int vec = pass * 2 + (lane >> 5); qv[pass] = *(const f32x2*)(pr + vec * 64 + 2 * pi); kv[pass] = *(const f32x2*)(pr + 512 + vec * 64 + 2 * pi); }
            const f32x2 gq = *(const f32x2*)(p.in(29) + 2 * pi), gk = *(const f32x2*)(p.in(30) + 2 * pi);
#pragma unroll
            for (int pass = 0; pass < 4; ++pass) {
                const int vec = pass * 2 + (lane >> 5);
                {
                    const f32x2 v = qv[pass];
                    const float rstd = rsqrtf(half_sum(v[0] * v[0] + v[1] * v[1], lane) * (1.0f / 64.0f) + EPS);
                    const float x1 = v[0] * rstd * gq[0], x2 = v[1] * rstd * gq[1];
                    *(unsigned*)(QD + (size_t)row * 512 + vec * 64 + 2 * pi) = pack2((x1 * cs - x2 * sn) * 0.125f, (x1 * sn + x2 * cs) * 0.125f);
                }
                {
                    const f32x2 v = kv[pass];
                    const float rstd = rsqrtf(half_sum(v[0] * v[0] + v[1] * v[1], lane) * (1.0f / 64.0f) + EPS);
                    const float x1 = v[0] * rstd * gk[0], x2 = v[1] * rstd * gk[1];
                    if (row < NCTX) *(f32x2*)(p.out() + OUT_DK + (size_t)row * 512 + vec * 64 + 2 * pi) = (f32x2){x1, x2};
                    *(unsigned*)(KD + (size_t)kr * 512 + vec * 64 + 2 * pi) = pack2(x1 * cs - x2 * sn, x1 * sn + x2 * cs);
                }
            }
        }
#pragma unroll
        for (int j = 0; j < 8; ++j) {
            const int col = j * 64 + lane; const float v = pr[1024 + col];
            if (row < NCTX) p.out()[OUT_DV + (size_t)row * 512 + col] = v;
            VDT[(size_t)kr * 512 + col] = f2bf(v);
        }
        const int t = row < NCTX ? (row & 255) : ((row - NCTX) & 1023), n = row < NCTX ? 256 : 1024;
        const bool hp = t > 0, hn = t < n - 1;
        const float* pp = pr + 1536;
        const float* pn = pp + 3584; const float* pv = pp - 3584;
#define SHIFT4(col) ({ const f32x4 _c = *(const f32x4*)(pp + (col)); const f32x4 _p = hp ? *(const f32x4*)(pv + (col)) : (f32x4){0.f, 0.f, 0.f, 0.f}; \
            const f32x4 _n = hn ? *(const f32x4*)(pn + (col)) : (f32x4){0.f, 0.f, 0.f, 0.f}; const f32x4 _m = *(const f32x4*)(mu + (col)); _c + (0.5f * (_p + _n) - _c) * _m; })
        {
            const size_t o = (size_t)row * 512 + lane * 8;
            const f32x4 r0 = SHIFT4(lane * 8), r1 = SHIFT4(lane * 8 + 4);
            *(f32x4*)(RR + o) = r0; *(f32x4*)(RR + o + 4) = r1;
            const f32x4 k0 = SHIFT4(512 + lane * 8), k1 = SHIFT4(512 + lane * 8 + 4);
            *(f32x4*)(KR + o) = k0; *(f32x4*)(KR + o + 4) = k1;
            const f32x4 v0 = SHIFT4(1024 + lane * 8), v1 = SHIFT4(1024 + lane * 8 + 4);
            *(f32x4*)(VV + o) = v0; *(f32x4*)(VV + o + 4) = v1;
            const f32x4 kk0 = k0 * *(const f32x4*)(p.in(39) + lane * 8), kk1 = k1 * *(const f32x4*)(p.in(39) + lane * 8 + 4);
            float ss = (kk0[0] * kk0[0] + kk0[1] * kk0[1]) + (kk0[2] * kk0[2] + kk0[3] * kk0[3]) + (kk1[0] * kk1[0] + kk1[1] * kk1[1]) + (kk1[2] * kk1[2] + kk1[3] * kk1[3]);
            ss = oct_sum(ss);
            const float rn = rsqrtf(ss + EPS);
            *(f32x4*)(KK + o) = kk0 * rn; *(f32x4*)(KK + o + 4) = kk1 * rn;
        }
        {
            const f32x4 a = SHIFT4(1536 + lane * 4);
            u32x2 w;
            if (lane < 32) { w.x = pack2(tanhf_(a[0]), tanhf_(a[1])); w.y = pack2(tanhf_(a[2]), tanhf_(a[3])); *(u32x2*)(TW + (size_t)row * 128 + lane * 4) = w; }
            else { w.x = pack2(a[0], a[1]); w.y = pack2(a[2], a[3]); *(u32x2*)(AD + (size_t)row * 128 + (lane - 32) * 4) = w; }
            if (lane < 32) { const f32x4 g = SHIFT4(1792 + lane * 4); w.x = pack2(sigmoidf_(g[0]), sigmoidf_(g[1])); w.y = pack2(sigmoidf_(g[2]), sigmoidf_(g[3])); *(u32x2*)(SG + (size_t)row * 128 + lane * 4) = w; }
        }
#define SHIFTED(col) 0
#undef SHIFTED
    }
}

constexpr int SC_T = 16;
constexpr int SC_BUF = 2 * SC_T * 6 * 64;
__device__ __forceinline__ void phase_l1_mix(const Frame& F, const PRef& p) {
    unsigned char* ws = p.ws();
    const bf16_t* Q = (const bf16_t*)(ws + WS_QD); const bf16_t* K = (const bf16_t*)(ws + WS_KD); const bf16_t* VT = (const bf16_t*)(ws + WS_VDT);
    AttnOutBf16 ao{(bf16_t*)(ws + WS_DO), 1024};
    float gq = 0.f, gk = 0.f;
    for (int i = 0; i < 64; ++i) { gq = fmaxf(gq, fabsf(p.in(29)[i])); gk = fmaxf(gk, fabsf(p.in(30)[i])); }
    const float shift = 8.0f * gq * gk;
    for (int slot = 0; slot * F.G < 512; ++slot) { const int u = F.G == 256 ? attn_unit_xcd(F.bid, slot) : F.bid + slot * F.G; if (u < 512) attn_block<64, 128, 4>(F, Q, K, VT, ao, u, shift); }
}

__device__ __forceinline__ float dpp_xor1(float x) { return __int_as_float(__builtin_amdgcn_update_dpp(0, __float_as_int(x), 0xB1, 0xF, 0xF, true)); }
__device__ __forceinline__ float dpp_xor2(float x) { return __int_as_float(__builtin_amdgcn_update_dpp(0, __float_as_int(x), 0x4E, 0xF, 0xF, true)); }
#define VFMA(d, a, b, c) asm("v_fma_f32 %0, %1, %2, %3" : "=v"(d) : "v"(a), "v"(b), "v"(c))
#define VFMAN(d, a, b, c) asm("v_fma_f32 %0, -%1, %2, %3" : "=v"(d) : "v"(a), "v"(b), "v"(c))
#define VMUL(d, a, b) asm("v_mul_f32 %0, %1, %2" : "=v"(d) : "v"(a), "v"(b))
#define VADD(d, a, b) asm("v_add_f32 %0, %1, %2" : "=v"(d) : "v"(a), "v"(b))
#define QUAD_SUM_ASM(x) asm("s_nop 1\n\tv_add_f32_dpp %0, %0, %0 quad_perm:[1,0,3,2] row_mask:0xf bank_mask:0xf bound_ctrl:1\n\ts_nop 1\n\t" \
    "v_add_f32_dpp %0, %0, %0 quad_perm:[2,3,0,1] row_mask:0xf bank_mask:0xf bound_ctrl:1" : "+v"(x))
#define ROW16_SUM_ASM(x) asm("s_nop 1\n\tv_add_f32_dpp %0, %0, %0 quad_perm:[1,0,3,2] row_mask:0xf bank_mask:0xf bound_ctrl:1\n\ts_nop 1\n\t" \
    "v_add_f32_dpp %0, %0, %0 quad_perm:[2,3,0,1] row_mask:0xf bank_mask:0xf bound_ctrl:1\n\ts_nop 1\n\t" \
    "v_add_f32_dpp %0, %0, %0 row_half_mirror row_mask:0xf bank_mask:0xf bound_ctrl:1\n\ts_nop 1\n\t" \
    "v_add_f32_dpp %0, %0, %0 row_mirror row_mask:0xf bank_mask:0xf bound_ctrl:1" : "+v"(x))
constexpr int SREC = 400;
template <int KPL> struct ScanVecs { f32x4 w[KPL / 4], kka[KPL / 4], kd[KPL / 4], kk[KPL / 4], r[KPL / 4]; float v, c1, c2; };
template <int KPL>
__device__ __forceinline__ void scan_load(ScanVecs<KPL>& x, const LAS float* v6, int koff, int row) {
#pragma unroll
    for (int q = 0; q < KPL / 4; ++q) {
        x.w[q] = *(const LAS f32x4*)(v6 + 0 * 64 + koff + q * 4); x.kka[q] = *(const LAS f32x4*)(v6 + 1 * 64 + koff + q * 4); x.kd[q] = *(const LAS f32x4*)(v6 + 2 * 64 + koff + q * 4);
        x.kk[q] = *(const LAS f32x4*)(v6 + 3 * 64 + koff + q * 4); x.r[q] = *(const LAS f32x4*)(v6 + 4 * 64 + koff + q * 4);
    }
    x.v = v6[5 * 64 + row]; x.c1 = v6[384]; x.c2 = v6[385];
}
template <int MODE>
__device__ __forceinline__ void scan_unit(const Frame& F, const PRef& p, int unit) {
    constexpr int T = 32, NSTEPS = MODE == 0 ? 1024 : 256, BUF = T * SREC, NCHUNK = NSTEPS / T;
    constexpr int KPL = MODE == 0 ? 4 : 16, NQ = KPL / 4;
    unsigned char* ws = p.ws();
    const float* RR = (const float*)(ws + WS_RR); const float* KR = (const float*)(ws + WS_KR); const float* VV = (const float*)(ws + WS_VV); const float* KK = (const float*)(ws + WS_KK);
    const float* DEC = (const float*)(ws + WS_DEC); const float* AA = (const float*)(ws + WS_AA);
    float* YY = (float*)(ws + WS_YY);
    const float* k_a = p.in(40);
    LAS float* sb = (LAS float*)F.lds;
    const int lane = F.lane;
    const bool loader = F.wave >= 4;
    const bool compute = F.wave < 4;
    const int cid = MODE == 0 ? (unit >> 2) : unit;
    const int cb = cid >> 4, chh = (cid >> 1) & 7, cd = cid & 1;
    const int cbase = MODE == 0 ? NCTX + cb * 1024 : cb * 256;
    if (loader) {
        const int lt = F.tid - 256;
        f32x4 pa[2][6], pb[2][6];
        const f32x4 ka4 = *(const f32x4*)(k_a + chh * 64 + (lt & 15) * 4), rk4 = *(const f32x4*)(p.in(41) + chh * 64 + (lt & 15) * 4);
        float* BON = (float*)(ws + WS_BON) + (size_t)cd * NTOK * 8 + chh;
        const bool wbon = MODE == 1 || (unit & 3) == 0;
#define SC_LOAD(pre, chunk) do { _Pragma("unroll") for (int it = 0; it < 2; ++it) { const int item = it * 256 + lt; const int stp = item >> 4, k = (item & 15) * 4; \
            const int j_ = (chunk) * T + stp; const int tok = cbase + (cd ? NSTEPS - 1 - j_ : j_); const size_t o_ = (size_t)tok * 512 + chh * 64 + k; \
            pre[it][0] = *(const f32x4*)(DEC + (size_t)cd * NTOK * 512 + o_); pre[it][1] = *(const f32x4*)(AA + (size_t)cd * NTOK * 512 + o_); pre[it][2] = *(const f32x4*)(KR + o_); \
            pre[it][3] = *(const f32x4*)(KK + o_); pre[it][4] = *(const f32x4*)(RR + o_); pre[it][5] = *(const f32x4*)(VV + o_); } } while (0)
#define SC_WRITE(pre, buf, chunk) do { _Pragma("unroll") for (int it = 0; it < 2; ++it) { const int item = it * 256 + lt; const int stp = item >> 4, k = (item & 15) * 4; \
            const f32x4 a_ = pre[it][1], kk_ = pre[it][3], r_ = pre[it][4], w_ = pre[it][0]; LAS float* d_ = sb + (buf) * BUF + stp * SREC + k; \
            const f32x4 bb_ = kk_ * a_, kd_ = pre[it][2] * (1.0f + (a_ - 1.0f) * ka4); \
            *(LAS f32x4*)(d_) = w_; *(LAS f32x4*)(d_ + 64) = bb_; *(LAS f32x4*)(d_ + 128) = kd_; *(LAS f32x4*)(d_ + 192) = kk_; \
            *(LAS f32x4*)(d_ + 256) = w_ * r_; *(LAS f32x4*)(d_ + 320) = pre[it][5]; \
            const f32x4 p1_ = bb_ * r_, p2_ = kd_ * r_; const float c1_ = row16_sum((p1_[0] + p1_[1]) + (p1_[2] + p1_[3])), c2_ = row16_sum((p2_[0] + p2_[1]) + (p2_[2] + p2_[3])); \
            const f32x4 p3_ = p2_ * rk4; const float c3_ = row16_sum((p3_[0] + p3_[1]) + (p3_[2] + p3_[3])); \
            if ((lt & 15) == 0) { LAS float* e_ = sb + (buf) * BUF + stp * SREC + 384; e_[0] = c1_; e_[1] = c2_; \
                if (wbon) { const int j2_ = (chunk) * T + stp; BON[(size_t)(cbase + (cd ? NSTEPS - 1 - j2_ : j2_)) * 8] = c3_; } } } } while (0)
        SC_LOAD(pa, 0); SC_LOAD(pb, 1); SC_WRITE(pa, 0, 0); SC_LOAD(pa, 2);
        __syncthreads();
        for (int cnk = 0; cnk < NCHUNK; cnk += 2) {
            if (cnk + 1 < NCHUNK) { SC_WRITE(pb, (cnk + 1) & 1, cnk + 1); if (cnk + 3 < NCHUNK) SC_LOAD(pb, cnk + 3); }
            __syncthreads();
            if (cnk + 2 < NCHUNK) { SC_WRITE(pa, (cnk + 2) & 1, cnk + 2); if (cnk + 4 < NCHUNK) SC_LOAD(pa, cnk + 4); }
            __syncthreads();
        }
#undef SC_LOAD
#undef SC_WRITE
    } else if (compute) {
        const int row = MODE == 0 ? (unit & 3) * 16 + F.wave * 4 + (lane >> 4) : F.wave * 16 + (lane >> 2);
        const int kq = MODE == 0 ? (lane & 15) : (lane & 3), koff = kq * KPL;
        f32x4 S[NQ];
        if (MODE == 0) {
            const float* s0 = p.in(7) + (size_t)(((cb * 2 + cd) * 8 + chh) * 64 + row) * 64 + koff;
#pragma unroll
            for (int q = 0; q < NQ; ++q) S[q] = *(const f32x4*)(s0 + q * 4);
        } else {
#pragma unroll
            for (int q = 0; q < NQ; ++q) S[q] = (f32x4){0.f, 0.f, 0.f, 0.f};
        }
        __syncthreads();
        float* yp = YY + (size_t)cd * NTOK * 512 + chh * 64 + row;
        for (int cnk = 0; cnk < NCHUNK; ++cnk) {
            const LAS float* bufp = sb + (cnk & 1) * BUF;
            ScanVecs<KPL> cur, nxt;
            scan_load<KPL>(cur, bufp, koff, row);
#pragma unroll 2
            for (int stp = 0; stp < T; ++stp) {
                scan_load<KPL>(nxt, bufp + (stp + 1 < T ? stp + 1 : stp) * SREC, koff, row);
                const int j_ = cnk * T + stp; const int tok = cbase + (cd ? NSTEPS - 1 - j_ : j_);
                f32x4 a4 = S[0] * cur.kk[0], y4 = S[0] * cur.r[0];
#pragma unroll
                for (int q = 1; q < NQ; ++q) { a4 = a4 + S[q] * cur.kk[q]; y4 = y4 + S[q] * cur.r[q]; }
                float sa = (a4[0] + a4[1]) + (a4[2] + a4[3]), ys = (y4[0] + y4[1]) + (y4[2] + y4[3]);
                if (MODE == 0) {
                    sa += DPPF(sa, 0xB1); ys += DPPF(ys, 0xB1); sa += DPPF(sa, 0x4E); ys += DPPF(ys, 0x4E);
                    sa += DPPF(sa, 0x141); ys += DPPF(ys, 0x141); sa += DPPF(sa, 0x140); ys += DPPF(ys, 0x140);
                } else { sa += DPPF(sa, 0xB1); ys += DPPF(ys, 0xB1); sa += DPPF(sa, 0x4E); ys += DPPF(ys, 0x4E); }
                const float vr = cur.v;
#pragma unroll
                for (int q = 0; q < NQ; ++q) S[q] = S[q] * cur.w[q] + (vr * cur.kd[q] - sa * cur.kka[q]);
                if (kq == 0) yp[(size_t)tok * 512] = ys - sa * cur.c1 + vr * cur.c2;
                cur = nxt;
            }
            __syncthreads();
        }
        if (MODE == 1) {
            float* so = p.out() + OUT_SRWKV + (size_t)(((cb * 2 + cd) * 8 + chh) * 64 + row) * 64 + koff;
#pragma unroll
            for (int q = 0; q < NQ; ++q) *(f32x4*)(so + q * 4) = S[q];
        }
    } else {
        __syncthreads();
        for (int cnk = 0; cnk < NCHUNK; ++cnk) __syncthreads();
    }
}
constexpr int CI_AP = 0, CI_RH = 2304, CI_BT = 4608, CI_KT = 7168, CI_MP = 9728, CI_PP = 10368, CI_GL = 11520, CI_VT = 11776, CI_SZ = 14336;
constexpr int CS_AH = 0, CS_BH = 2304, CS_KH = 4608, CS_SZ = 6912;
constexpr int CS_NM = CS_BH, CS_TM = CS_BH + 1024, CS_MM = CS_BH + 2048;
constexpr int CIMG0 = 0, CSCR0 = 8 * CI_SZ;
static_assert(CSCR0 + 4 * CS_SZ <= LDS_BYTES - LDS_WORK, "chunked scan LDS");
constexpr size_t WS_GIMG = WS_HB;
static_assert((size_t)32 * 12 * 4 * CI_SZ <= (size_t)2 * NTOK * 1024 * 2, "hand-off images do not fit HB + OB");
constexpr int SCAN_FLAG_WORD = 3584;
template <int MODE, int ROLE>
__device__ __forceinline__ void scanc_unit(const Frame& F, const PRef& p, int cid, int hid = 0) {
    constexpr int NSTEPS = MODE == 0 ? 1024 : 256, NCH = NSTEPS / 16, NG = NCH / 4;
    unsigned char* ws = p.ws();
    const float* RR = (const float*)(ws + WS_RR); const float* KR = (const float*)(ws + WS_KR); const float* VV = (const float*)(ws + WS_VV); const float* KK = (const float*)(ws + WS_KK);
    const float* DEC = (const float*)(ws + WS_DEC); const float* AA = (const float*)(ws + WS_AA);
    float* YY = (float*)(ws + WS_YY);
    LAS unsigned char* L = F.lds;
    const int lane = F.lane, fr = lane & 15, g = lane >> 4, w = F.wave;
    const int cb = cid >> 4, chh = (cid >> 1) & 7, cd = cid & 1;
    const int cbase = MODE == 0 ? NCTX + cb * 1024 : cb * 256;
#define TOK_OF(step) (cbase + (cd ? NSTEPS - 1 - (step) : (step)))
    unsigned* hflag = (unsigned*)(ws + WS_BAR) + SCAN_FLAG_WORD + cid * 16;
    unsigned char* gimg = ws + WS_GIMG + (size_t)cid * 12 * 4 * CI_SZ;
    const __amdgpu_buffer_rsrc_t grs = wt_rsrc(gimg, (size_t)12 * 4 * CI_SZ);
    if (w >= 4 || ROLE == 2) {
        if (ROLE == 2 && w < 4) {
            for (int grp = hid; grp < NG; grp += 4) {
                const int og = grp - (grp >> 2) - 1;
                __syncthreads();
                for (int i = F.tid; i < 4 * CI_SZ / 16; i += NTHREADS) wt_store16(grs, (size_t)og * 4 * CI_SZ + (size_t)i * 16, *(const LAS u32x4*)(L + CIMG0 + (size_t)i * 16));
                asm volatile("s_waitcnt vmcnt(0)" ::: "memory");
                __syncthreads();
                if (F.tid == 0) __hip_atomic_store(hflag + grp, 1u, __ATOMIC_RELAXED, __HIP_MEMORY_SCOPE_AGENT);
                __syncthreads();
            }
            return;
        }
        const int j = w - 4, k = lane;
        LAS unsigned char* SC = L + CSCR0 + j * CS_SZ;
        const float ka = p.in(40)[chh * 64 + k];
        const size_t colo = (size_t)chh * 64 + k;
        const float* decp = DEC + (size_t)cd * NTOK * 512; const float* aap = AA + (size_t)cd * NTOK * 512;
        float rw[16], rkk[16], ra[16], rkr[16], rr[16], rv[16];
#define PREP_LOAD(chunk) do { _Pragma("unroll") for (int t = 0; t < 16; ++t) { const size_t o_ = (size_t)TOK_OF((chunk) * 16 + t) * 512 + colo; \
            rw[t] = decp[o_]; rkk[t] = KK[o_]; ra[t] = aap[o_]; rkr[t] = KR[o_]; rr[t] = RR[o_]; rv[t] = VV[o_]; } } while (0)
        PREP_LOAD(ROLE == 2 ? hid * 4 + j : j);
        for (int grp = (ROLE == 2 ? hid : 0); grp < NG; grp += (ROLE == 2 ? 4 : 1)) {
            LAS unsigned char* IM = L + CIMG0 + ((ROLE == 2 ? 0 : (grp & 1) * 4) + j) * CI_SZ;
            if (ROLE == 1 && (grp & 3)) {
                if (lane == 0) { unsigned sp = 0; while (__hip_atomic_load(hflag + grp, __ATOMIC_RELAXED, __HIP_MEMORY_SCOPE_AGENT) == 0u && ++sp < (1u << 22)) __builtin_amdgcn_s_sleep(2); }
                asm volatile("" ::: "memory");
                for (int i = lane; i < CI_SZ / 16; i += 64)
                    *(LAS u32x4*)(IM + (size_t)i * 16) = __builtin_bit_cast(u32x4, __builtin_amdgcn_raw_buffer_load_b128(grs, (int)(((size_t)(grp - (grp >> 2) - 1) * 4 + j) * CI_SZ + (size_t)i * 16), 0, 16));
                __syncthreads();
                continue;
            }
            float ah[16]; float G = 1.0f;
#pragma unroll
            for (int t2 = 0; t2 < 8; ++t2) {
                float bh2[2], kh2[2];
#pragma unroll
                for (int u = 0; u < 2; ++u) {
                    const int t = 2 * t2 + u;
                    const float bb = rkk[t] * ra[t], kd = rkr[t] * (1.0f + (ra[t] - 1.0f) * ka);
                    ah[t] = -rkk[t] * G;
                    G *= rw[t];
                    const float inv = __builtin_amdgcn_rcpf(G);
                    const float bh = bb * inv, kh = kd * inv, rh = rr[t] * G;
                    bh2[u] = bh; kh2[u] = kh;
                    *(LAS bf16_t*)(SC + CS_AH + t * 144 + k * 2) = f2bf(ah[t]);
                    *(LAS bf16_t*)(SC + CS_BH + t * 144 + k * 2) = f2bf(bh);
                    *(LAS bf16_t*)(SC + CS_KH + t * 144 + k * 2) = f2bf(kh);
                    *(LAS bf16_t*)(IM + CI_RH + t * 144 + k * 2) = f2bf(rh);
                }
                *(LAS unsigned*)(IM + CI_BT + k * 40 + t2 * 4) = pack2(bh2[0], bh2[1]);
                *(LAS unsigned*)(IM + CI_KT + k * 40 + t2 * 4) = pack2(kh2[0], kh2[1]);
                *(LAS unsigned*)(IM + CI_VT + k * 40 + t2 * 4) = pack2(rv[2 * t2], rv[2 * t2 + 1]);
            }
            *(LAS float*)(IM + CI_GL + k * 4) = G;
            { const int ng_ = grp + (ROLE == 0 ? 1 : 4); if (ng_ < NG) PREP_LOAD(ng_ * 4 + j); }
            f32x4 dN = (f32x4){0.f, 0.f, 0.f, 0.f}, dM = dN, dPb = dN, dPk = dN;
#pragma unroll
            for (int s = 0; s < 2; ++s) {
                const int fo = fr * 144 + (4 * s + g) * 16;
                const bf16x8 fa = *(const LAS bf16x8*)(SC + CS_AH + fo), fb = *(const LAS bf16x8*)(SC + CS_BH + fo), fk = *(const LAS bf16x8*)(SC + CS_KH + fo), frh = *(const LAS bf16x8*)(IM + CI_RH + fo);
                dN = __builtin_amdgcn_mfma_f32_16x16x32_bf16(fa, fb, dN, 0, 0, 0); dM = __builtin_amdgcn_mfma_f32_16x16x32_bf16(fa, fk, dM, 0, 0, 0);
                dPb = __builtin_amdgcn_mfma_f32_16x16x32_bf16(frh, fb, dPb, 0, 0, 0); dPk = __builtin_amdgcn_mfma_f32_16x16x32_bf16(frh, fk, dPk, 0, 0, 0);
            }
#pragma unroll
            for (int r = 0; r < 4; ++r) {
                const int t = 4 * g + r;
                *(LAS float*)(SC + CS_MM + (t * 16 + fr) * 4) = fr < t ? dM[r] : 0.f;
                *(LAS bf16_t*)(IM + CI_PP + t * 72 + fr * 2) = f2bf(fr <= t ? dPb[r] : 0.f);
                *(LAS bf16_t*)(IM + CI_PP + t * 72 + (16 + fr) * 2) = f2bf(fr <= t ? dPk[r] : 0.f);
            }
            float Tc[16];
            Tc[0] = fr == 0 ? 1.0f : 0.f;
#pragma unroll
            for (int i = 1; i < 16; ++i) {
                float s0_ = fr == i ? 1.0f : 0.f, s1_ = 0.f;
#pragma unroll
                for (int jj = 0; jj < i; ++jj) {
                    const float nij = RDLANE(dN[i & 3], jj + 16 * (i >> 2));
                    if (jj & 1) s1_ += nij * Tc[jj]; else s0_ += nij * Tc[jj];
                }
                Tc[i] = s0_ + s1_;
            }
            if (g == 0) {
#pragma unroll
                for (int i = 0; i < 16; ++i) *(LAS float*)(SC + CS_TM + (i * 16 + fr) * 4) = Tc[i];
            }
#pragma unroll
            for (int i = 0; i < 16; ++i) {
                float s0_ = 0.f, s1_ = 0.f;
#pragma unroll
                for (int jj = 0; jj <= i; ++jj) { const float tij = RDLANE(Tc[i], jj); if (jj & 1) s1_ += tij * ah[jj]; else s0_ += tij * ah[jj]; }
                *(LAS bf16_t*)(IM + CI_AP + i * 144 + k * 2) = f2bf(s0_ + s1_);
            }
            {
                const int i = lane >> 2, j4 = (lane & 3) * 4;
                f32x4 macc = (f32x4){0.f, 0.f, 0.f, 0.f};
#pragma unroll
                for (int t = 0; t < 16; ++t) macc += *(const LAS f32x4*)(SC + CS_MM + (t * 16 + j4) * 4) * *(const LAS float*)(SC + CS_TM + (i * 16 + t) * 4);
                u32x2 pk; pk.x = pack2(macc[0], macc[1]); pk.y = pack2(macc[2], macc[3]);
                *(LAS u32x2*)(IM + CI_MP + i * 40 + j4 * 2) = pk;
            }
            if (ROLE == 2) {
                const int og = grp - (grp >> 2) - 1;
                __syncthreads();
                for (int i = F.tid; i < 4 * CI_SZ / 16; i += NTHREADS) wt_store16(grs, (size_t)og * 4 * CI_SZ + (size_t)i * 16, *(const LAS u32x4*)(L + CIMG0 + (size_t)i * 16));
                asm volatile("s_waitcnt vmcnt(0)" ::: "memory");
                __syncthreads();
                __syncthreads();
                continue;
            }
            __syncthreads();
        }
        if (ROLE == 2) return;
        __syncthreads();
#undef PREP_LOAD
    } else {
        f32x4 S[4];
        if (MODE == 0) {
            const float* s0 = p.in(7) + (size_t)(((cb * 2 + cd) * 8 + chh) * 64 + 16 * w + fr) * 64;
#pragma unroll
            for (int kt = 0; kt < 4; ++kt) S[kt] = *(const f32x4*)(s0 + 16 * kt + 4 * g);
        } else {
#pragma unroll
            for (int kt = 0; kt < 4; ++kt) S[kt] = (f32x4){0.f, 0.f, 0.f, 0.f};
        }
        float* yp = YY + (size_t)cd * NTOK * 512 + chh * 64 + 16 * w + fr;
        __syncthreads();
        for (int grp = 0; grp < NG; ++grp) {
#pragma unroll
            for (int c4 = 0; c4 < 4; ++c4) {
                const LAS unsigned char* IM = L + CIMG0 + ((grp & 1) * 4 + c4) * CI_SZ;
                u32x2 oa[2][2], orh[2][2], obt[4], okt[4]; f32x4 ogl[4];
#pragma unroll
                for (int s = 0; s < 2; ++s) {
                    oa[s][0] = *(const LAS u32x2*)(IM + CI_AP + fr * 144 + (32 * s + 4 * g) * 2); oa[s][1] = *(const LAS u32x2*)(IM + CI_AP + fr * 144 + (32 * s + 16 + 4 * g) * 2);
                    orh[s][0] = *(const LAS u32x2*)(IM + CI_RH + fr * 144 + (32 * s + 4 * g) * 2); orh[s][1] = *(const LAS u32x2*)(IM + CI_RH + fr * 144 + (32 * s + 16 + 4 * g) * 2);
                }
                const u32x2 vq = *(const LAS u32x2*)(IM + CI_VT + (16 * w + fr) * 40 + g * 8);
                const u32x2 m0 = *(const LAS u32x2*)(IM + CI_MP + fr * 40 + g * 8);
                const u32x2 p0 = *(const LAS u32x2*)(IM + CI_PP + fr * 72 + g * 8), p1 = *(const LAS u32x2*)(IM + CI_PP + fr * 72 + 32 + g * 8);
#pragma unroll
                for (int kt = 0; kt < 4; ++kt) {
                    obt[kt] = *(const LAS u32x2*)(IM + CI_BT + (16 * kt + fr) * 40 + g * 8); okt[kt] = *(const LAS u32x2*)(IM + CI_KT + (16 * kt + fr) * 40 + g * 8);
                    ogl[kt] = *(const LAS f32x4*)(IM + CI_GL + (16 * kt + 4 * g) * 4);
                }
                bf16x8 Sp[2];
#pragma unroll
                for (int s = 0; s < 2; ++s) { u32x4 pk; pk.x = pack2(S[2 * s][0], S[2 * s][1]); pk.y = pack2(S[2 * s][2], S[2 * s][3]); pk.z = pack2(S[2 * s + 1][0], S[2 * s + 1][1]); pk.w = pack2(S[2 * s + 1][2], S[2 * s + 1][3]); Sp[s] = __builtin_bit_cast(bf16x8, pk); }
                f32x4 U = (f32x4){0.f, 0.f, 0.f, 0.f}, Y = U;
#pragma unroll
                for (int s = 0; s < 2; ++s) {
                    U = __builtin_amdgcn_mfma_f32_16x16x32_bf16(__builtin_bit_cast(bf16x8, (u32x4){oa[s][0].x, oa[s][0].y, oa[s][1].x, oa[s][1].y}), Sp[s], U, 0, 0, 0);
                    Y = __builtin_amdgcn_mfma_f32_16x16x32_bf16(__builtin_bit_cast(bf16x8, (u32x4){orh[s][0].x, orh[s][0].y, orh[s][1].x, orh[s][1].y}), Sp[s], Y, 0, 0, 0);
                }
                U = __builtin_amdgcn_mfma_f32_16x16x32_bf16(__builtin_bit_cast(bf16x8, (u32x4){m0.x, m0.y, 0u, 0u}), __builtin_bit_cast(bf16x8, (u32x4){vq.x, vq.y, vq.x, vq.y}), U, 0, 0, 0);
                u32x4 uvk; uvk.x = pack2(U[0], U[1]); uvk.y = pack2(U[2], U[3]); uvk.z = vq.x; uvk.w = vq.y;
                const bf16x8 UV = __builtin_bit_cast(bf16x8, uvk);
#pragma unroll
                for (int kt = 0; kt < 4; ++kt) {
                    const f32x4 acc = __builtin_amdgcn_mfma_f32_16x16x32_bf16(__builtin_bit_cast(bf16x8, (u32x4){obt[kt].x, obt[kt].y, okt[kt].x, okt[kt].y}), UV, S[kt], 0, 0, 0);
                    S[kt] = acc * ogl[kt];
                }
                Y = __builtin_amdgcn_mfma_f32_16x16x32_bf16(__builtin_bit_cast(bf16x8, (u32x4){p0.x, p0.y, p1.x, p1.y}), UV, Y, 0, 0, 0);
                const int step0 = (grp * 4 + c4) * 16 + 4 * g;
#pragma unroll
                for (int r = 0; r < 4; ++r) yp[(size_t)TOK_OF(step0 + r) * 512] = Y[r];
            }
            __syncthreads();
        }
        if (MODE == 1) {
            float* so = p.out() + OUT_SRWKV + (size_t)(((cb * 2 + cd) * 8 + chh) * 64 + 16 * w + fr) * 64;
#pragma unroll
            for (int kt = 0; kt < 4; ++kt) *(f32x4*)(so + 16 * kt + 4 * g) = S[kt];
        }
    }
#undef TOK_OF
}
__device__ __forceinline__ void phase_l1_scanc(const Frame& F, const PRef& p) {
    if (F.G > 128) {
        if (F.bid < 32) scanc_unit<0, 1>(F, p, F.bid);
        else if (F.bid < 128) scanc_unit<0, 2>(F, p, (F.bid - 32) & 31, 1 + ((F.bid - 32) >> 5));
        else for (int u = F.bid - 128; u < 256; u += F.G - 128) scanc_unit<1, 0>(F, p, u);
    } else { FOR_UNITS(u, 288, 0) { if (u < 32) scanc_unit<0, 0>(F, p, u); else scanc_unit<1, 0>(F, p, u - 32); } }
}
__device__ __forceinline__ void phase_l1_scan(const Frame& F, const PRef& p) {
    const int half = F.G / 2;
    if (F.bid < half) {
        for (int u = F.bid; u < 128; u += half) { const int xcd = u & 7, idx = u >> 3; scan_unit<0>(F, p, (((idx >> 2) * 8 + xcd) << 2) | (idx & 3)); }
    } else {
        for (int u = F.bid - half; u < 256; u += F.G - half) scan_unit<1>(F, p, u);
    }
}

__device__ __forceinline__ void phase_l1_comb(const Frame& F, const PRef& p) {
    unsigned char* ws = p.ws();
    const float* RR = (const float*)(ws + WS_RR); const float* KR = (const float*)(ws + WS_KR); const float* VV = (const float*)(ws + WS_VV);
    const float* AA = (const float*)(ws + WS_AA); const float* GG = (const float*)(ws + WS_GG); const float* YY = (const float*)(ws + WS_YY);
    bf16_t* OB = (bf16_t*)(ws + WS_OB);
    const int nw = F.G * 8, lane = F.lane;
    const bf16_t* DO = (const bf16_t*)(ws + WS_DO);
    const float lam_init = 0.8f - 0.6f * 0.74081822068171788f;
    const float lam = __expf(wave_sum(p.in(31)[lane] * p.in(31)[64 + lane])) - __expf(wave_sum(p.in(31)[128 + lane] * p.in(31)[192 + lane])) + lam_init;
    for (int row = F.bid * 8 + F.wave; row < NTOK; row += nw) {
#pragma unroll
        for (int h = 0; h < 4; ++h) {
            const unsigned a = *(const unsigned*)(DO + (size_t)row * 1024 + (2 * h) * 128 + 2 * lane), b = *(const unsigned*)(DO + (size_t)row * 1024 + (2 * h + 1) * 128 + 2 * lane);
            const float d0 = bf2f(a & 0xffffu) - lam * bf2f(b & 0xffffu), d1 = bf2f(a >> 16) - lam * bf2f(b >> 16);
            const float rstd = rsqrtf(wave_sum(d0 * d0 + d1 * d1) * (1.0f / 128.0f) + EPS) * (1.0f - lam_init);
            const f32x2 gn = *(const f32x2*)(p.in(32) + h * 128 + 2 * lane);
            *(unsigned*)(OB + (size_t)row * 1024 + h * 128 + 2 * lane) = pack2(d0 * rstd * gn[0], d1 * rstd * gn[1]);
        }
        const size_t o = (size_t)row * 512 + lane * 8;
        const f32x4 yf0 = *(const f32x4*)(YY + o), yf1 = *(const f32x4*)(YY + o + 4), yb0 = *(const f32x4*)(YY + (size_t)NTOK * 512 + o), yb1 = *(const f32x4*)(YY + (size_t)NTOK * 512 + o + 4);
        const f32x4 v0 = *(const f32x4*)(VV + o), v1 = *(const f32x4*)(VV + o + 4), g0 = *(const f32x4*)(GG + o), g1 = *(const f32x4*)(GG + o + 4);
        const f32x4 n0 = *(const f32x4*)(p.in(42) + lane * 8), n1 = *(const f32x4*)(p.in(42) + lane * 8 + 4);
        const float* BON = (const float*)(ws + WS_BON);
#if CHUNKED_SCAN
        float bs = 0.f;
        {
            const f32x4 r0 = *(const f32x4*)(RR + o), r1 = *(const f32x4*)(RR + o + 4), k0 = *(const f32x4*)(KR + o), k1 = *(const f32x4*)(KR + o + 4);
            const f32x4 af0 = *(const f32x4*)(AA + o), af1 = *(const f32x4*)(AA + o + 4), ab0 = *(const f32x4*)(AA + (size_t)NTOK * 512 + o), ab1 = *(const f32x4*)(AA + (size_t)NTOK * 512 + o + 4);
            const f32x4 ka0 = *(const f32x4*)(p.in(40) + lane * 8), ka1 = *(const f32x4*)(p.in(40) + lane * 8 + 4), rk0 = *(const f32x4*)(p.in(41) + lane * 8), rk1 = *(const f32x4*)(p.in(41) + lane * 8 + 4);
            const f32x4 t0 = r0 * rk0 * k0 * (2.0f + (af0 + ab0 - 2.0f) * ka0), t1 = r1 * rk1 * k1 * (2.0f + (af1 + ab1 - 2.0f) * ka1);
            bs = oct_sum((t0[0] + t0[1]) + (t0[2] + t0[3]) + (t1[0] + t1[1]) + (t1[2] + t1[3]));
        }
#else
        const float bs = BON[(size_t)row * 8 + (lane >> 3)] + BON[(size_t)NTOK * 8 + (size_t)row * 8 + (lane >> 3)];
#endif
        const f32x4 y0 = yf0 + yb0, y1 = yf1 + yb1;
        float ss = (y0[0] * y0[0] + y0[1] * y0[1]) + (y0[2] * y0[2] + y0[3] * y0[3]) + (y1[0] * y1[0] + y1[1] * y1[1]) + (y1[2] * y1[2] + y1[3] * y1[3]);
        ss = oct_sum(ss);
        const float rstd = rsqrtf(ss * (1.0f / 64.0f) + EPS);
        const f32x4 o0 = (y0 * rstd * n0 + bs * v0) * g0, o1 = (y1 * rstd * n1 + bs * v1) * g1;
        u32x4 w; w.x = pack2(o0[0], o0[1]); w.y = pack2(o0[2], o0[3]); w.z = pack2(o1[0], o1[1]); w.w = pack2(o1[2], o1[3]);
        *(u32x4*)(OB + (size_t)row * 1024 + 512 + lane * 8) = w;
    }
}

constexpr int NPHASE = 26;
#ifndef PH_ONLY
#define PH_ONLY -1
#endif
#if ONE_LAUNCH
#define SEAM() xcd_barrier(bar)
#else
#define SEAM() do {} while (0)
#endif
#define IN(k) (lo <= (k) && (k) < hi && (PH_ONLY < 0 || (k) == PH_ONLY))
#define END(k) do { if (IN((k) + 1)) SEAM(); } while (0)
#ifndef REP_MASK
#define REP_MASK 0u
#endif
#define REPS(k) for (int rep_ = 0; rep_ < 1 + (int)(((unsigned)REP_MASK >> (k)) & 1u); ++rep_, __syncthreads())

constexpr size_t WS_PARTA = WS_BIG;
constexpr size_t WS_PARTD = WS_U;
static_assert(WS_PARTD + (size_t)2 * NTOK * 1024 * 4 <= WS_ACT, "down-projection slabs overlap ACT");
template <int l>
__device__ __forceinline__ void layer_phases(const Frame& F, const PRef& p, const int lo, const int hi, const XcdBarrier bar) {
    constexpr int pb = 1 + l * 12;
    if (IN(pb + 0)) { REPS(pb + 0) {
        unsigned char* ws = p.ws(); const float* ml = (const float*)(ws + WS_MOD) + (size_t)l * 3 * 6144;
        if (l == 0) phase_norm(F, p.in(0), p.in(1), nullptr, nullptr, nullptr, p.in(12), ml + 1024, ml + 0, (bf16_t*)(ws + WS_HB), true);
        else { float* xbuf = p.out(); phase_norm(F, xbuf, xbuf + (size_t)NCTX * 1024, (const bf16_t*)(ws + WS_PARTD), (const float*)(ws + WS_MOD) + 5120, xbuf, p.in(12) + 1024, ml + 1024, ml + 0, (bf16_t*)(ws + WS_HB), true); }
        } END(pb + 0); }
    if (IN(pb + 1)) { REPS(pb + 1) {
        unsigned char* ws = p.ws();
        if (l == 0) { BigDesc g{(const bf16_t*)(ws + WS_HB), (const bf16_t*)(ws + WS_WAIN), 1024, 1024, 24, 8, 1, 1024}; EpiF32WT E{wt_rsrc(ws + WS_P0, (size_t)NTOK * 2048 * 4), 2048}; gemm_big<false>(F, g, E); if (F.G == 256) cvt_group(F, p, 1, 192, 64, 0); else cvt_group(F, p, 1, 0, F.G, 0); }
        else {
            { BigDesc g{(const bf16_t*)(ws + WS_HB), (const bf16_t*)(ws + WS_WBIN), 1024, 1024, 24, F.G == 256 ? 10 : 14, 1, 1024}; EpiF32WT E{wt_rsrc(ws + WS_P1, (size_t)NTOK * 3584 * 4), 3584}; gemm_big<false>(F, g, E); }
            if (F.G == 256) {
                GemmDesc g{(const bf16_t*)(ws + WS_HB), (const bf16_t*)(ws + WS_WBIN) + (size_t)2560 * 1024, 1024, 1024, NTOK, 896, 1024}; EpiF32 E{(float*)(ws + WS_P1) + 2560, 3584, 896};
                if (F.bid >= 240) gemm_s(F, g, E, 0, F.bid - 240, 16, 48);
                else { gemm_s(F, g, E, 0, 48 + F.bid, 1, 49 + F.bid); if (F.bid < 48) gemm_s(F, g, E, 0, 288 + F.bid, 1, 289 + F.bid); }
            }
        }
        } END(pb + 1);
    }
    if (IN(pb + 2)) { REPS(pb + 2) { if (l == 0) phase_l0_tok(F, p); else phase_l1_tok(F, p); } END(pb + 2); }
    if (IN(pb + 3)) { REPS(pb + 3) {
        unsigned char* ws = p.ws();
        if (l == 0) {
            { GemmDesc g{(const bf16_t*)(ws + WS_CQN), (const bf16_t*)(ws + WS_WUQ), 256, 256, NTOK, 768, 256}; EpiF32 E{(float*)(ws + WS_QRAW), 768, 768}; gemm_s(F, g, E, 0); }
            { GemmDesc g{(const bf16_t*)(ws + WS_CKVN), (const bf16_t*)(ws + WS_WUKV), 128, 128, NKROW, 1024, 128}; EpiF32 E{(float*)(ws + WS_KVRAW), 1024, 1024}; gemm_s(F, g, E, 48 * 6); }
            phase_l0_prefix(F, p, 48 * 6 + 56 * 8);
        } else {
            const bf16_t* TW = (const bf16_t*)(ws + WS_TW); const bf16_t* AD = (const bf16_t*)(ws + WS_AD); const bf16_t* SG = (const bf16_t*)(ws + WS_SG);
            float* DEC = (float*)(ws + WS_DEC); float* AA = (float*)(ws + WS_AA);
            { GemmDesc g{TW, (const bf16_t*)(ws + WS_WWUP), 128, 64, NTOK, 512, 64}; EpiDecay E{DEC, p.in(34)}; gemm_s(F, g, E, 0); }
            { GemmDesc g{TW + 64, (const bf16_t*)(ws + WS_WWUP) + 512 * 64, 128, 64, NTOK, 512, 64}; EpiDecay E{DEC + (size_t)NTOK * 512, p.in(34) + 512}; gemm_s(F, g, E, 192); }
            { GemmDesc g{AD, (const bf16_t*)(ws + WS_WAUP), 128, 64, NTOK, 512, 64}; EpiSigm E{AA, p.in(36)}; gemm_s(F, g, E, 384); }
            { GemmDesc g{AD + 64, (const bf16_t*)(ws + WS_WAUP) + 512 * 64, 128, 64, NTOK, 512, 64}; EpiSigm E{AA + (size_t)NTOK * 512, p.in(36) + 512}; gemm_s(F, g, E, 576); }
            { GemmDesc g{SG, (const bf16_t*)(ws + WS_WGUP), 128, 128, NTOK, 512, 128}; EpiF32 E{(float*)(ws + WS_GG), 512, 512}; gemm_s(F, g, E, 768); }
            phase_l1_mix(F, p);
        }
        } END(pb + 3);
    }
    if (l == 0 && IN(pb + 4)) { REPS(pb + 4) { phase_l0_qkv(F, p); } END(pb + 4); }
    if (IN(pb + 5)) { REPS(pb + 5) { if (l == 0) phase_l0_mix(F, p); else {
#if CHUNKED_SCAN
            phase_l1_scanc(F, p);
#else
            phase_l1_scan(F, p);
#endif
        } } END(pb + 5); }
    if (l == 1 && IN(pb + 6)) { REPS(pb + 6) { phase_l1_comb(F, p); } END(pb + 6); }
    if (IN(pb + 7)) { REPS(pb + 7) {
        unsigned char* ws = p.ws();
        BigDesc g{(const bf16_t*)(ws + WS_OB), (const bf16_t*)(ws + WS_WOUT) + (size_t)l * 1024 * 1024, 1024, 1024, 24, 4, 2, 512};
        EpiPartWT E{wt_rsrc(ws + WS_PARTA, (size_t)2 * NTOK * 1024 * 2), (size_t)NTOK * 1024}; gemm_big<true>(F, g, E);
        if (l == 0) { if (F.G == 256) cvt_group(F, p, 3, 192, 64, 0); else cvt_group(F, p, 3, 0, F.G, 0); }
        } END(pb + 7);
    }
    if (IN(pb + 8)) { REPS(pb + 8) {
        unsigned char* ws = p.ws(); const float* ml = (const float*)(ws + WS_MOD) + (size_t)l * 3 * 6144; float* xbuf = p.out();
        const float* xa = l == 0 ? p.in(0) : xbuf; const float* xb = l == 0 ? p.in(1) : xbuf + (size_t)NCTX * 1024;
        phase_norm(F, xa, xb, (const bf16_t*)(ws + WS_PARTA), ml + 2048, xbuf, p.in(13) + l * 1024, ml + 4096, ml + 3072, (bf16_t*)(ws + WS_HB), true); } END(pb + 8); }
    if (IN(pb + 9)) { REPS(pb + 9) {
        unsigned char* ws = p.ws();
        const bf16_t* wup = (const bf16_t*)(ws + WS_WUP) + (size_t)l * 5632 * 1024;
        gemm_upgate(F, (const bf16_t*)(ws + WS_HB), wup, p.in(16) + (size_t)l * 3 * 5632, p.in(17) + (size_t)l * 5632, (bf16_t*)(ws + WS_ACT));
        } END(pb + 9);
    }
    if (IN(pb + 11)) { REPS(pb + 11) {
        unsigned char* ws = p.ws();
        BigDesc g{(const bf16_t*)(ws + WS_ACT), (const bf16_t*)(ws + WS_WDN) + (size_t)l * 1024 * 2816, 2816, 2816, 24, 4, 2, 1408};
        EpiPartWT E{wt_rsrc(ws + WS_PARTD, (size_t)2 * NTOK * 1024 * 2), (size_t)NTOK * 1024}; gemm_big<true>(F, g, E);
        if (l == 0) { if (F.G == 256) cvt_group(F, p, 2, 192, 64, 0); else cvt_group(F, p, 2, 0, F.G, 0); }
        } END(pb + 11);
    }
}

__global__ void __launch_bounds__(NTHREADS, 2) fwd_kernel(Params kp) {
    extern __shared__ __attribute__((aligned(16))) unsigned char lds_raw[];
    Frame F;
    F.lds = (LAS unsigned char*)lds_raw + LDS_WORK;
    F.tid = threadIdx.x; F.lane = F.tid & 63; F.wave = __builtin_amdgcn_readfirstlane(F.tid >> 6); F.G = gridDim.x; F.bid = blockIdx.x;
    {
        LAS unsigned* pw = (LAS unsigned*)((LAS unsigned char*)lds_raw + 64);
        if (F.tid < (int)(sizeof(Params) / 4)) pw[F.tid] = ((const unsigned*)&kp)[F.tid];
        if (F.tid < 4) ((LAS unsigned*)((LAS unsigned char*)lds_raw))[F.tid] = 0u;
    }
    __syncthreads();
    PRef p; p.w = (const LAS unsigned*)((LAS unsigned char*)lds_raw + 64);
    const int lo = kp.ph_lo, hi = kp.ph_hi;
    XcdBarrier bar; bar.bar = nullptr; bar.x = 0; bar.st = nullptr;
#if ONE_LAUNCH
    bar = xcd_barrier_post((unsigned*)(p.ws() + WS_BAR), (volatile LAS unsigned*)((LAS unsigned char*)lds_raw));
#endif
#ifdef EXTRA_BARS
    for (int i_ = 0; i_ < EXTRA_BARS; ++i_) SEAM();
#endif
    if (IN(0)) { REPS(0) { phase_prep(F, p); } END(0); }
    layer_phases<0>(F, p, lo, hi, bar);
    layer_phases<1>(F, p, lo, hi, bar);
    if (IN(25)) {
        unsigned char* ws = p.ws(); float* xbuf = p.out();
        phase_norm(F, xbuf, xbuf + (size_t)NCTX * 1024, (const bf16_t*)(ws + WS_PARTD), (const float*)(ws + WS_MOD) + 3 * 6144 + 5120, xbuf, nullptr, nullptr, nullptr, nullptr, false);
    }
}

extern "C" void kernel_launch(void* const* d_in, const int* in_sizes, int n_in, void* d_out, int out_size, void* d_ws, size_t ws_size, hipStream_t stream) {
    static int grid = 0;
    if (grid == 0) {
        if (n_in != 43 || (size_t)out_size != OUT_END || ws_size < WS_END) { fprintf(stderr, "kernel_launch: unexpected shapes: n_in %d out %d ws %zu (need %zu)\n", n_in, out_size, ws_size, (size_t)WS_END); grid = -1; return; }
        int dev = 0, cus = 0, per_cu = 0;
        if (hipGetDevice(&dev) != hipSuccess || hipDeviceGetAttribute(&cus, hipDeviceAttributeMultiprocessorCount, dev) != hipSuccess) { grid = -1; return; }
        if (hipFuncSetAttribute((const void*)fwd_kernel, hipFuncAttributeMaxDynamicSharedMemorySize, LDS_BYTES) != hipSuccess) { fprintf(stderr, "kernel_launch: hipFuncSetAttribute failed\n"); grid = -1; return; }
        if (hipOccupancyMaxActiveBlocksPerMultiprocessor(&per_cu, (const void*)fwd_kernel, NTHREADS, LDS_BYTES) != hipSuccess || per_cu < 1) { fprintf(stderr, "kernel_launch: occupancy query says %d blocks per CU\n", per_cu); grid = -1; (void)hipGetLastError(); return; }
        grid = cus;
    }
    if (grid < 0) return;
    Params p{};
    for (int i = 0; i < 43; ++i) p.in[i] = (const float*)d_in[i];
    p.out = (float*)d_out; p.ws = (unsigned char*)d_ws;
#if ONE_LAUNCH
    (void)hipMemsetAsync((char*)d_ws + WS_BAR, 0, 16384, stream);
    p.ph_lo = 0; p.ph_hi = NPHASE;
    void* args[] = {&p};
    hipError_t e = hipLaunchCooperativeKernel((const void*)fwd_kernel, dim3(grid), dim3(NTHREADS), args, LDS_BYTES, stream);
    if (e != hipSuccess) fprintf(stderr, "cooperative launch failed: %s (grid %d)\n", hipGetErrorString(e), grid);
#else
    for (int ph = 0; ph < NPHASE; ++ph) {
        p.ph_lo = ph; p.ph_hi = ph + 1;
        hipLaunchKernelGGL(fwd_kernel, dim3(grid), dim3(NTHREADS), LDS_BYTES, stream, p);
    }
#endif
}
```

```cpp
#include <hip/hip_runtime.h>
#include <cstdio>
#include <cstdint>

#define LAS __attribute__((address_space(3)))
typedef unsigned short bf16_t;
typedef short bf16x8 __attribute__((ext_vector_type(8)));
typedef short bf16x4 __attribute__((ext_vector_type(4)));
typedef float f32x4 __attribute__((ext_vector_type(4)));
typedef float f32x2 __attribute__((ext_vector_type(2)));
typedef unsigned u32x2 __attribute__((ext_vector_type(2)));
typedef unsigned u32x4 __attribute__((ext_vector_type(4)));

#define REP_MASK 0u
#define ATT_REP 0
#define SCAN_REP 0
#ifndef CHUNKED_SCAN
#define CHUNKED_SCAN 1
#endif
#ifndef ONE_LAUNCH
#define ONE_LAUNCH 1
#endif

constexpr int NTHREADS = 512;
constexpr int LDS_BYTES = 144 * 1024;
constexpr int LDS_WORK = 1024;
constexpr int DM = 1024, NCTX = 4096, NLAT = 2048, NTOK = 6144, NKROW = 7168, DFF = 2816;
constexpr float EPS = 1e-6f;

constexpr size_t al256(size_t x) { return (x + 255) & ~(size_t)255; }
constexpr size_t WS_BAR = 0;
constexpr size_t WS_MOD = WS_BAR + 16384;
constexpr size_t WS_WAIN = al256(WS_MOD + 2 * 3 * 6144 * 4);
constexpr size_t WS_WUQ = WS_WAIN + (size_t)2048 * 1024 * 2;
constexpr size_t WS_WUKV = WS_WUQ + (size_t)768 * 256 * 2;
constexpr size_t WS_WOUT = WS_WUKV + (size_t)1024 * 128 * 2;
constexpr size_t WS_WUP = WS_WOUT + (size_t)2 * 1024 * 1024 * 2;
constexpr size_t WS_WDN = WS_WUP + (size_t)2 * 5632 * 1024 * 2;
constexpr size_t WS_WBIN = WS_WDN + (size_t)2 * 1024 * 2816 * 2;
constexpr size_t WS_WWUP = WS_WBIN + (size_t)3584 * 1024 * 2;
constexpr size_t WS_WAUP = WS_WWUP + (size_t)2 * 512 * 64 * 2;
constexpr size_t WS_WGUP = WS_WAUP + (size_t)2 * 512 * 64 * 2;
constexpr size_t WS_HB = WS_WGUP + (size_t)512 * 128 * 2;
constexpr size_t WS_OB = WS_HB + (size_t)NTOK * 1024 * 2;
constexpr size_t WS_BIG = WS_OB + (size_t)NTOK * 1024 * 2;
constexpr size_t WS_P0 = WS_BIG;
constexpr size_t WS_CQN = WS_P0 + (size_t)NTOK * 2048 * 4;
constexpr size_t WS_CKVN = WS_CQN + (size_t)NTOK * 256 * 2;
constexpr size_t WS_QRAW = WS_CKVN + (size_t)NKROW * 128 * 2;
constexpr size_t WS_KVRAW = WS_QRAW + (size_t)NTOK * 768 * 4;
constexpr size_t WS_Q0 = WS_KVRAW + (size_t)NKROW * 1024 * 4;
constexpr size_t WS_K0 = WS_Q0 + (size_t)NTOK * 768 * 2;
constexpr size_t WS_VT0 = WS_K0 + (size_t)NKROW * 768 * 2;
constexpr size_t WS_KVS = WS_VT0 + (size_t)NKROW * 512 * 2;
constexpr size_t WS_L0END = WS_KVS + (size_t)384 * 2 * 8192 * 4;
constexpr size_t WS_U = WS_BIG;
constexpr size_t WS_ACT = WS_U + (size_t)NTOK * 5632 * 2;
constexpr size_t WS_FFNEND = WS_ACT + (size_t)NTOK * 2816 * 2;
constexpr size_t WS_P1 = WS_BIG;
constexpr size_t WS_DEC = WS_BIG;
constexpr size_t WS_AA = WS_DEC + (size_t)2 * NTOK * 512 * 4;
constexpr size_t WS_GG = WS_AA + (size_t)2 * NTOK * 512 * 4;
constexpr size_t WS_YY = WS_GG + (size_t)NTOK * 512 * 4;
constexpr size_t WS_QD = WS_P1 + (size_t)NTOK * 3584 * 4;
constexpr size_t WS_KD = WS_QD + (size_t)NTOK * 512 * 2;
constexpr size_t WS_VDT = WS_KD + (size_t)NKROW * 512 * 2;
constexpr size_t WS_RR = WS_VDT + (size_t)NKROW * 512 * 2;
constexpr size_t WS_KR = WS_RR + (size_t)NTOK * 512 * 4;
constexpr size_t WS_VV = WS_KR + (size_t)NTOK * 512 * 4;
constexpr size_t WS_KK = WS_VV + (size_t)NTOK * 512 * 4;
constexpr size_t WS_TW = WS_KK + (size_t)NTOK * 512 * 4;
constexpr size_t WS_AD = WS_TW + (size_t)NTOK * 128 * 2;
constexpr size_t WS_SG = WS_AD + (size_t)NTOK * 128 * 2;
constexpr size_t WS_DO = WS_SG + (size_t)NTOK * 128 * 2;
constexpr size_t WS_BON = WS_DO + (size_t)NTOK * 1024 * 2;
constexpr size_t WS_L1END = WS_BON + (size_t)2 * NTOK * 8 * 4;
constexpr size_t cmax(size_t a, size_t b) { return a > b ? a : b; }
constexpr size_t WS_END = cmax(cmax(WS_L0END, WS_FFNEND), WS_L1END);
static_assert(WS_YY + (size_t)2 * NTOK * 512 * 4 <= WS_QD, "layer-1 overlay");
static_assert(WS_END <= (size_t)256 * 1024 * 1024, "workspace exceeds 256 MiB");

constexpr size_t OUT_X = 0;
constexpr size_t OUT_CKV = (size_t)NTOK * 1024;
constexpr size_t OUT_KROPE = OUT_CKV + (size_t)NCTX * 128;
constexpr size_t OUT_SRET = OUT_KROPE + (size_t)NCTX * 32;
constexpr size_t OUT_DK = OUT_SRET + (size_t)16 * 2 * 4 * 8192;
constexpr size_t OUT_DV = OUT_DK + (size_t)NCTX * 512;
constexpr size_t OUT_SRWKV = OUT_DV + (size_t)NCTX * 512;
constexpr size_t OUT_END = OUT_SRWKV + (size_t)16 * 2 * 8 * 4096;

struct Params {
    const float* in[43];
    float* out;
    unsigned char* ws;
    int ph_lo, ph_hi;
};

struct PRef {
    const LAS unsigned* w;
    __device__ __forceinline__ unsigned long long q(int i) const {
        const unsigned lo = (unsigned)__builtin_amdgcn_readfirstlane((int)w[2 * i]), hi = (unsigned)__builtin_amdgcn_readfirstlane((int)w[2 * i + 1]);
        return ((unsigned long long)hi << 32) | lo; }
    __device__ __forceinline__ const float* in(int k) const { return (const float*)(const __attribute__((address_space(1))) float*)q(k); }
    __device__ __forceinline__ float* out() const { return (float*)(__attribute__((address_space(1))) float*)q(43); }
    __device__ __forceinline__ unsigned char* ws() const { return (unsigned char*)(__attribute__((address_space(1))) unsigned char*)q(44); }
};

typedef __bf16 hwbf16x2 __attribute__((ext_vector_type(2)));
__device__ __forceinline__ unsigned pack2(float a, float b) { const f32x2 v = (f32x2){a, b}; return __builtin_bit_cast(unsigned, __builtin_convertvector(v, hwbf16x2)); }
__device__ __forceinline__ bf16_t f2bf(float f) { return (bf16_t)(pack2(f, 0.f) & 0xffffu); }
__device__ __forceinline__ float bf2f(unsigned b) { return __uint_as_float(b << 16); }
#define RDLANE(x, l) __int_as_float(__builtin_amdgcn_readlane(__float_as_int(x), (l)))
#define DPPF(x, ctrl) __int_as_float(__builtin_amdgcn_update_dpp(0, __float_as_int(x), (ctrl), 0xF, 0xF, true))
__device__ __forceinline__ float row16_sum(float v) {
    v += DPPF(v, 0xB1); v += DPPF(v, 0x4E); v += DPPF(v, 0x141); v += DPPF(v, 0x140); return v; }
__device__ __forceinline__ float oct_sum(float v) {
    v += DPPF(v, 0xB1); v += DPPF(v, 0x4E); v += DPPF(v, 0x141); return v; }
__device__ __forceinline__ float wave_sum(float v) {
    v = row16_sum(v);
    return (RDLANE(v, 0) + RDLANE(v, 16)) + (RDLANE(v, 32) + RDLANE(v, 48));
}
__device__ __forceinline__ float half_sum(float v, int lane) {
    v = row16_sum(v);
    const float a = RDLANE(v, 0) + RDLANE(v, 16), b = RDLANE(v, 32) + RDLANE(v, 48);
    return lane < 32 ? a : b;
}
__device__ __forceinline__ float sigmoidf_(float x) { return 1.0f / (1.0f + __expf(-x)); }
__device__ __forceinline__ float siluf_(float x) { return x * sigmoidf_(x); }
__device__ __forceinline__ float tanhf_(float x) { return 1.0f - 2.0f / (__expf(2.0f * x) + 1.0f); }
__device__ __forceinline__ int cond_of(int row) { return row < NCTX ? 0 : 1 + ((row - NCTX) >> 10); }

#define XB_TMO      128
#define XB_XCNT(j)  (256  + 64 * (j))
#define XB_XSUB(j)  (1280 + 64 * (j))
#define XB_XGEN(j)  (2304 + 64 * (j))
#define XB_TOP      3328
#define XB_TOPGEN   3392
#define XCD_BAR_WORDS 3456
#define XB_SPIN_CAP (1u << 20)
__device__ __forceinline__ unsigned xb_ld(unsigned* p) { return __hip_atomic_load(p, __ATOMIC_RELAXED, __HIP_MEMORY_SCOPE_AGENT); }
__device__ __forceinline__ unsigned xb_add(unsigned* p, unsigned v) { return __hip_atomic_fetch_add(p, v, __ATOMIC_RELAXED, __HIP_MEMORY_SCOPE_AGENT); }
__device__ __forceinline__ unsigned xb_xcc_id() { return (unsigned)__builtin_amdgcn_s_getreg((3 << 11) | 20) & 0xFu; }
#define XB_SPIN(cond, bar) do { unsigned _sp = 0; while (cond) { __builtin_amdgcn_s_sleep(1); \
    if ((++_sp & 255u) == 0u) { if (xb_ld(&(bar)[XB_TMO])) break; if (_sp > XB_SPIN_CAP) { atomicAdd(&(bar)[XB_TMO], 1u); break; } } } } while (0)
struct XcdBarrier { unsigned* bar; unsigned x; volatile LAS unsigned* st; };
__device__ __forceinline__ XcdBarrier xcd_barrier_post(unsigned* bar, volatile LAS unsigned* st) {
    XcdBarrier b; b.bar = bar; b.x = xb_xcc_id(); b.st = st;
    if (threadIdx.x == 0) (void)xb_add(&bar[XB_XCNT(b.x)], 1u);
    return b;
}
__device__ __forceinline__ void xcd_barrier_complete(unsigned* bar, unsigned x, unsigned& nloc, unsigned& nx) {
    const unsigned G = gridDim.x * gridDim.y * gridDim.z;
    unsigned sum, cnt, mine, sp = 0u;
    for (;;) {
        sum = 0u; cnt = 0u; mine = 0u;
#pragma unroll
        for (unsigned j = 0; j < 16; ++j) { const unsigned c = xb_ld(&bar[XB_XCNT(j)]); sum += c; cnt += (c > 0u) ? 1u : 0u; mine = (j == x) ? c : mine; }
        if (sum == G) break;
        __builtin_amdgcn_s_sleep(1);
        if ((++sp & 255u) == 0u) { if (xb_ld(&bar[XB_TMO])) break; if (sp > XB_SPIN_CAP) { atomicAdd(&bar[XB_TMO], 1u); break; } }
    }
    nloc = mine > 0u ? mine : 1u; nx = cnt > 0u ? cnt : 1u;
}
__device__ __forceinline__ void xcd_barrier(const XcdBarrier& b) {
    asm volatile("s_waitcnt vmcnt(0)" ::: "memory");
    __syncthreads();
    if (threadIdx.x == 0) {
        unsigned* bar = b.bar;
        __builtin_amdgcn_s_waitcnt(0);
        unsigned nloc = b.st[0], nx = b.st[1];
        if (nloc == 0u) { xcd_barrier_complete(bar, b.x, nloc, nx); b.st[0] = nloc; b.st[1] = nx; }
        const unsigned old = xb_add(&bar[XB_XSUB(b.x)], 1u);
        const unsigned gen = old / nloc;
        if (old + 1u == (gen + 1u) * nloc) {
            __builtin_amdgcn_fence(__ATOMIC_RELEASE, "agent");
            asm volatile("s_waitcnt vmcnt(0)" ::: "memory");
            const unsigned og = xb_add(&bar[XB_TOP], 1u);
            const unsigned tg = og / nx;
            if (og + 1u == (tg + 1u) * nx) xb_add(&bar[XB_TOPGEN], 1u);
            else XB_SPIN(xb_ld(&bar[XB_TOPGEN]) == tg, bar);
            __builtin_amdgcn_fence(__ATOMIC_ACQUIRE, "agent");
            xb_add(&bar[XB_XGEN(b.x)], 1u);
            asm volatile("s_waitcnt vmcnt(0)" ::: "memory");
        } else {
            XB_SPIN(xb_ld(&bar[XB_XGEN(b.x)]) == gen, bar);
            __builtin_amdgcn_fence(__ATOMIC_ACQUIRE, "agent");
            asm volatile("s_waitcnt vmcnt(0)" ::: "memory");
        }
    }
    __syncthreads();
}

struct Frame {
    LAS unsigned char* lds;
    int tid, lane, wave, G, bid;
};
#define FOR_UNITS(u, n, rot) for (int u = (int)((F.bid + F.G - ((rot) % F.G)) % F.G); u < (n); u += F.G)

__device__ __forceinline__ int lds_byte(int r, int c) { const int st = (r >> 4) * 2 + (c >> 5), rr = r & 15, cc = c & 31, ob = rr * 64 + cc * 2; return st * 1024 + (ob ^ (((ob >> 9) & 1) << 5)); }
__device__ __forceinline__ void stage_rc(int b, int& R, int& C) { const int st = b / 1024, sb = b % 1024, swz = sb ^ (((sb >> 9) & 1) << 5); R = (st >> 1) * 16 + swz / 64; C = (st & 1) * 32 + (swz % 64) / 2; }

struct GemmDesc { const bf16_t* A; const bf16_t* Bt; int lda, ldb, M, N, K; };

typedef unsigned u32x4v __attribute__((ext_vector_type(4)));
__device__ __forceinline__ __amdgpu_buffer_rsrc_t wt_rsrc(void* base, size_t bytes) { return __builtin_amdgcn_make_buffer_rsrc(base, 0, (int)bytes, 0x00020000); }
__device__ __forceinline__ void wt_store16(const __amdgpu_buffer_rsrc_t r, size_t byte_off, u32x4 v) { __builtin_amdgcn_raw_buffer_store_b128(v, r, (int)byte_off, 0, 16); }
struct EpiF32 { float* C; int ldc, ncols;
    __device__ __forceinline__ void operator()(int r, int c, f32x4 v, int ks = 0) const { if (c < ncols) *(f32x4*)(C + (size_t)r * ldc + c) = v; } };
struct EpiF32WT { __amdgpu_buffer_rsrc_t R; int ldc;
    __device__ __forceinline__ void operator()(int r, int c, f32x4 v, int ks = 0) const { wt_store16(R, ((size_t)r * ldc + c) * 4, __builtin_bit_cast(u32x4, v)); } };
struct EpiBf16 { bf16_t* C; int ldc, ncols;
    __device__ __forceinline__ void e8(int r, int c, f32x4 v0, f32x4 v1, int ks = 0) const { u32x4 w; w.x = pack2(v0[0], v0[1]); w.y = pack2(v0[2], v0[3]); w.z = pack2(v1[0], v1[1]); w.w = pack2(v1[2], v1[3]); *(u32x4*)(C + (size_t)r * ldc + c) = w; }
    __device__ __forceinline__ void operator()(int r, int c, f32x4 v, int ks = 0) const { if (c < ncols) { u32x2 w; w.x = pack2(v[0], v[1]); w.y = pack2(v[2], v[3]); *(u32x2*)(C + (size_t)r * ldc + c) = w; } } };
struct EpiPart { bf16_t* C; size_t kstride;
    __device__ __forceinline__ void e8(int r, int c, f32x4 v0, f32x4 v1, int ks) const { u32x4 w; w.x = pack2(v0[0], v0[1]); w.y = pack2(v0[2], v0[3]); w.z = pack2(v1[0], v1[1]); w.w = pack2(v1[2], v1[3]);
        *(u32x4*)(C + (size_t)ks * kstride + (size_t)r * 1024 + c) = w; } };
struct EpiBf16WT { __amdgpu_buffer_rsrc_t R; int ldc;
    __device__ __forceinline__ void e8(int r, int c, f32x4 v0, f32x4 v1, int ks = 0) const { u32x4 w; w.x = pack2(v0[0], v0[1]); w.y = pack2(v0[2], v0[3]); w.z = pack2(v1[0], v1[1]); w.w = pack2(v1[2], v1[3]);
        wt_store16(R, ((size_t)r * ldc + c) * 2, w); } };
struct EpiPartWT { __amdgpu_buffer_rsrc_t R; size_t kstride;
    __device__ __forceinline__ void e8(int r, int c, f32x4 v0, f32x4 v1, int ks) const { u32x4 w; w.x = pack2(v0[0], v0[1]); w.y = pack2(v0[2], v0[3]); w.z = pack2(v1[0], v1[1]); w.w = pack2(v1[2], v1[3]);
        wt_store16(R, ((size_t)ks * kstride + (size_t)r * 1024 + c) * 2, w); } };
struct EpiResid { const float* xa; const float* xb; float* xo; const float* gate;
    __device__ __forceinline__ void operator()(int r, int c, f32x4 v, int ks = 0) const {
        const float* xs = r < NCTX ? xa + (size_t)r * 1024 : xb + (size_t)(r - NCTX) * 1024;
        const f32x4 x = *(const f32x4*)(xs + c); const f32x4 g = *(const f32x4*)(gate + cond_of(r) * 6144 + c);
        *(f32x4*)(xo + (size_t)r * 1024 + c) = x + g * v; } };
struct EpiDecay { float* C; const float* w0;
    __device__ __forceinline__ void operator()(int r, int c, f32x4 v, int ks = 0) const { const f32x4 b = *(const f32x4*)(w0 + c); f32x4 o;
#pragma unroll
        for (int j = 0; j < 4; ++j) o[j] = __expf(-0.60653065971f * sigmoidf_(b[j] + v[j]));
        *(f32x4*)(C + (size_t)r * 512 + c) = o; } };
struct EpiSigm { float* C; const float* a0;
    __device__ __forceinline__ void operator()(int r, int c, f32x4 v, int ks = 0) const { const f32x4 b = *(const f32x4*)(a0 + c); f32x4 o;
#pragma unroll
        for (int j = 0; j < 4; ++j) o[j] = sigmoidf_(b[j] + v[j]);
        *(f32x4*)(C + (size_t)r * 512 + c) = o; } };

template <class Epi>
__device__ __forceinline__ void gemm_s(const Frame& F, const GemmDesc g, const Epi& E, int rot, int ufirst = -1, int ustep = 0, int ulast = 0) {
    LAS unsigned char* lds = F.lds;
    const int tid = F.tid, wid = F.wave, lane = F.lane, wr = wid >> 2, wc = wid & 3, fr = lane & 15, fq = lane >> 4;
    const int nM = g.M / 128, nN = g.N / 128, nU = nM * nN, nt = g.K / 64;
    int R0, C0, R1, C1; stage_rc(tid * 16, R0, C0); stage_rc(tid * 16 + 8192, R1, C1);
    const int aoff = lds_byte(wr * 64 + fr, fq * 8), boff = lds_byte(wc * 32 + fr, fq * 8);
    const unsigned ldsw = (unsigned)wid * 1024u;
#define GS_STAGE(buf, t) do { \
        __builtin_amdgcn_global_load_lds((const unsigned*)(Ag + (size_t)R0 * g.lda + (t) * 64 + C0), (LAS unsigned*)(lds + (buf) * 32768 + ldsw), 16, 0, 0); \
        __builtin_amdgcn_global_load_lds((const unsigned*)(Ag + (size_t)R1 * g.lda + (t) * 64 + C1), (LAS unsigned*)(lds + (buf) * 32768 + ldsw + 8192), 16, 0, 0); \
        __builtin_amdgcn_global_load_lds((const unsigned*)(Bg + (size_t)R0 * g.ldb + (t) * 64 + C0), (LAS unsigned*)(lds + (buf) * 32768 + 16384 + ldsw), 16, 0, 0); \
        __builtin_amdgcn_global_load_lds((const unsigned*)(Bg + (size_t)R1 * g.ldb + (t) * 64 + C1), (LAS unsigned*)(lds + (buf) * 32768 + 16384 + ldsw + 8192), 16, 0, 0); } while (0)
    const int u0 = ufirst >= 0 ? ufirst : (int)((F.bid + F.G - (rot % F.G)) % F.G), us = ufirst >= 0 ? ustep : F.G, ue = ufirst >= 0 ? ulast : nU;
    for (int u = u0; u < ue; u += us) {
        const int pm = u % nM, pn = u / nM;
        const bf16_t* Ag = g.A + (size_t)(pm * 128) * g.lda; const bf16_t* Bg = g.Bt + (size_t)(pn * 128) * g.ldb;
        f32x4 acc[4][2];
#pragma unroll
        for (int m = 0; m < 4; ++m)
#pragma unroll
            for (int n = 0; n < 2; ++n) acc[m][n] = (f32x4){0.f, 0.f, 0.f, 0.f};
        GS_STAGE(0, 0);
        if (nt > 1) GS_STAGE(1, 1);
        int b = 0, bn = 2;
        for (int t = 0; t < nt; ++t) {
            if (t + 2 < nt) { GS_STAGE(bn, t + 2); asm volatile("s_waitcnt vmcnt(8)" ::: "memory"); }
            else if (t + 1 < nt) asm volatile("s_waitcnt vmcnt(4)" ::: "memory");
            else asm volatile("s_waitcnt vmcnt(0)" ::: "memory");
            __builtin_amdgcn_s_barrier(); asm volatile("" ::: "memory");
            bf16x8 Af[4][2], Bf[2][2];
#pragma unroll
            for (int m = 0; m < 4; ++m)
#pragma unroll
                for (int k = 0; k < 2; ++k) Af[m][k] = *(const LAS bf16x8*)(lds + b * 32768 + aoff + m * 2048 + k * 1024);
#pragma unroll
            for (int n = 0; n < 2; ++n)
#pragma unroll
                for (int k = 0; k < 2; ++k) Bf[n][k] = *(const LAS bf16x8*)(lds + b * 32768 + 16384 + boff + n * 2048 + k * 1024);
#pragma unroll
            for (int k = 0; k < 2; ++k)
#pragma unroll
                for (int m = 0; m < 4; ++m)
#pragma unroll
                    for (int n = 0; n < 2; ++n) acc[m][n] = __builtin_amdgcn_mfma_f32_16x16x32_bf16(Bf[n][k], Af[m][k], acc[m][n], 0, 0, 0);
            asm volatile("s_waitcnt lgkmcnt(0)" ::: "memory");
            __builtin_amdgcn_s_barrier(); asm volatile("" ::: "memory");
            b = b == 2 ? 0 : b + 1; bn = bn == 2 ? 0 : bn + 1;
        }
#pragma unroll
        for (int m = 0; m < 4; ++m)
#pragma unroll
            for (int n = 0; n < 2; ++n) E(pm * 128 + wr * 64 + m * 16 + fr, pn * 128 + wc * 32 + n * 16 + 4 * fq, acc[m][n]);
    }
#undef GS_STAGE
}

constexpr int HTB = 128 * 64 * 2;
struct BigDesc { const bf16_t* A; const bf16_t* Bt; int lda, ldb, nM, nN, nKS, Ksp; };
struct BUnit { int pm, pn, ks; };
__device__ __forceinline__ bool big_next(const BigDesc& g, int i, int G, int c, BUnit& u) {
    const int nNp = g.nN * g.nKS, nwg = g.nM * nNp;
    const long L = (long)i * G + c; if (L >= nwg) return false;
    int wgid = (int)L; { const int q = nwg / 8, r = nwg % 8, xcd = wgid % 8, off = wgid / 8; wgid = (xcd < r ? xcd * (q + 1) : r * (q + 1) + (xcd - r) * q) + off; }
    const int nig = 8 * nNp, gid = wgid / nig, fm = gid * 8, gsz = (g.nM - fm) < 8 ? (g.nM - fm) : 8;
    u.pm = fm + ((wgid % nig) % gsz); const int pnp = (wgid % nig) / gsz; u.pn = pnp / g.nKS; u.ks = pnp % g.nKS; return true;
}
__device__ __forceinline__ int perm32(int rho) { const int n = rho >> 4, i = rho & 15; return 8 * (i >> 2) + 4 * n + (i & 3); }
template <bool PERM, class Epi>
__device__ __forceinline__ void gemm_big(const Frame& F, const BigDesc g, const Epi& E) {
    LAS unsigned char* lds = F.lds;
    const int tid = F.tid, wid = F.wave, lane = F.lane, wr = wid >> 2, wc = wid & 3, fr = lane & 15, fq = lane >> 4;
    const int nt = g.Ksp / 64;
    unsigned voffA[2], voffB[2];
#pragma unroll
    for (int i = 0; i < 2; ++i) { int R, C; stage_rc(tid * 16 + i * 8192, R, C); const int Rb = PERM ? ((R & ~31) + perm32(R & 31)) : R; voffA[i] = (unsigned)(R * g.lda + C) * 2u; voffB[i] = (unsigned)(Rb * g.ldb + C) * 2u; }
    const size_t kstep = (size_t)(64 * 2);
    const size_t hstepA = (size_t)128 * g.lda * 2, hstepB = (size_t)128 * g.ldb * 2;
    const unsigned ldsw = (unsigned)wid * 1024u;
    const int aoff = lds_byte(wr * 64 + fr, fq * 8), boff = lds_byte(wc * 32 + fr, fq * 8);
#define PG8_SA(b, h) (((b) * 2 + (h)) * HTB)
#define PG8_SB(b, h) ((4 + (b) * 2 + (h)) * HTB)
#define PG8_STAGE(bufoff, gbase, voff) do { _Pragma("unroll") for (int _i = 0; _i < 2; ++_i) \
        __builtin_amdgcn_global_load_lds((const unsigned*)((const char*)(gbase) + (voff)[_i]), (LAS unsigned*)(lds + (bufoff) + ldsw + _i * 8192), 16, 0, 0); } while (0)
#define PG8_LDA(dst, b, h) do { _Pragma("unroll") for (int m = 0; m < 4; ++m) _Pragma("unroll") for (int k = 0; k < 2; ++k) dst[m][k] = *(const LAS bf16x8*)(lds + PG8_SA(b, h) + aoff + m * 2048 + k * 1024); } while (0)
#define PG8_LDB(dst, b, h) do { _Pragma("unroll") for (int n = 0; n < 2; ++n) _Pragma("unroll") for (int k = 0; k < 2; ++k) dst[n][k] = *(const LAS bf16x8*)(lds + PG8_SB(b, h) + boff + n * 2048 + k * 1024); } while (0)
#define PG8_MMA(ai, bj, At, Bt) do { __builtin_amdgcn_s_setprio(1); _Pragma("unroll") for (int m = 0; m < 4; ++m) _Pragma("unroll") for (int n = 0; n < 2; ++n) _Pragma("unroll") for (int k = 0; k < 2; ++k) \
        acc[ai][bj][m][n] = __builtin_amdgcn_mfma_f32_16x16x32_bf16(Bt[n][k], At[m][k], acc[ai][bj][m][n], 0, 0, 0); __builtin_amdgcn_s_setprio(0); } while (0)
#define PG8_WAIT_V(n) asm volatile("s_waitcnt vmcnt(" #n ")" ::: "memory")
#define PG8_WAIT_L(n) asm volatile("s_waitcnt lgkmcnt(" #n ")" ::: "memory")
#define PG8_BAR __builtin_amdgcn_s_barrier()
#define PG8_SCHED __builtin_amdgcn_sched_barrier(0)
#define PG8_UA(u) ((const char*)g.A + (size_t)(u).pm * 2 * hstepA + (size_t)(u).ks * g.Ksp * 2)
#define PG8_UB(u) ((const char*)g.Bt + (size_t)(u).pn * 2 * hstepB + (size_t)(u).ks * g.Ksp * 2)
    BUnit cur, nxt; int ui = 0;
    if (!big_next(g, 0, F.G, F.bid, cur)) return;
    f32x4 acc[2][2][4][2];
#pragma unroll
    for (int a = 0; a < 2; ++a)
#pragma unroll
        for (int b = 0; b < 2; ++b)
#pragma unroll
            for (int m = 0; m < 4; ++m)
#pragma unroll
                for (int n = 0; n < 2; ++n) acc[a][b][m][n] = (f32x4){0.f, 0.f, 0.f, 0.f};
    bf16x8 At[4][2], B0[2][2], B1[2][2];
    const char* cA = PG8_UA(cur); const char* cB = PG8_UB(cur);
    PG8_STAGE(PG8_SB(0, 0), cB, voffB); PG8_STAGE(PG8_SB(0, 1), cB + hstepB, voffB); PG8_STAGE(PG8_SA(0, 0), cA, voffA); PG8_STAGE(PG8_SA(0, 1), cA + hstepA, voffA);
    if (wr == 1) PG8_BAR;
    PG8_WAIT_V(2); PG8_BAR;
    PG8_STAGE(PG8_SB(1, 0), cB + kstep, voffB); PG8_STAGE(PG8_SA(1, 0), cA + kstep, voffA); PG8_STAGE(PG8_SB(1, 1), cB + hstepB + kstep, voffB);
    PG8_WAIT_V(6); PG8_BAR;
    for (;;) {
        const bool has_next = big_next(g, ui + 1, F.G, F.bid, nxt);
        const char* nA = has_next ? PG8_UA(nxt) : cA; const char* nB = has_next ? PG8_UB(nxt) : cB;
        for (int t = 0; t < nt; t += 2) {
            const bool last = (t == nt - 2);
            const char* a1 = cA + (size_t)(t + 1) * kstep;
            const char* a2 = last ? nA : cA + (size_t)(t + 2) * kstep; const char* b2 = last ? nB : cB + (size_t)(t + 2) * kstep;
            const char* a3 = a2 + kstep; const char* b3 = b2 + kstep;
            PG8_LDB(B0, 0, 0); PG8_LDB(B1, 0, 1); PG8_SCHED; PG8_LDA(At, 0, 0); PG8_STAGE(PG8_SA(1, 1), a1 + hstepA, voffA);
            PG8_WAIT_V(8); PG8_WAIT_L(0); PG8_BAR; PG8_MMA(0, 0, At, B0); PG8_MMA(0, 1, At, B1); PG8_BAR; PG8_SCHED;
            PG8_LDA(At, 0, 1); PG8_STAGE(PG8_SB(0, 0), b2, voffB); PG8_STAGE(PG8_SB(0, 1), b2 + hstepB, voffB); PG8_STAGE(PG8_SA(0, 0), a2, voffA);
            PG8_WAIT_V(8); PG8_WAIT_L(0); PG8_BAR; PG8_MMA(1, 0, At, B0); PG8_MMA(1, 1, At, B1); PG8_BAR; PG8_SCHED;
            PG8_LDB(B0, 1, 0); PG8_LDB(B1, 1, 1); PG8_SCHED; PG8_LDA(At, 1, 0); PG8_STAGE(PG8_SA(0, 1), a2 + hstepA, voffA);
            PG8_WAIT_V(8); PG8_WAIT_L(0); PG8_BAR; PG8_MMA(0, 0, At, B0); PG8_MMA(0, 1, At, B1); PG8_BAR; PG8_SCHED;
            PG8_LDA(At, 1, 1); PG8_STAGE(PG8_SB(1, 0), b3, voffB); PG8_STAGE(PG8_SB(1, 1), b3 + hstepB, voffB); PG8_STAGE(PG8_SA(1, 0), a3, voffA);
            PG8_WAIT_V(8); PG8_WAIT_L(0); PG8_BAR; PG8_MMA(1, 0, At, B0); PG8_MMA(1, 1, At, B1); PG8_BAR; PG8_SCHED;
        }
        if (wr == 0) PG8_BAR;
        {
            const int row0 = cur.pm * 256 + wr * 64 + fr, col0 = cur.pn * 256 + wc * 32 + (PERM ? 8 : 4) * fq;
#pragma unroll
            for (int ai = 0; ai < 2; ++ai)
#pragma unroll
                for (int m = 0; m < 4; ++m)
#pragma unroll
                    for (int bj = 0; bj < 2; ++bj) {
                        if constexpr (PERM) E.e8(row0 + ai * 128 + m * 16, col0 + bj * 128, acc[ai][bj][m][0], acc[ai][bj][m][1], cur.ks);
                        else {
#pragma unroll
                            for (int n = 0; n < 2; ++n) E(row0 + ai * 128 + m * 16, col0 + bj * 128 + n * 16, acc[ai][bj][m][n], cur.ks);
                        }
                    }
        }
        if (!has_next) break;
#pragma unroll
        for (int a = 0; a < 2; ++a)
#pragma unroll
            for (int b = 0; b < 2; ++b)
#pragma unroll
                for (int m = 0; m < 4; ++m)
#pragma unroll
                    for (int n = 0; n < 2; ++n) acc[a][b][m][n] = (f32x4){0.f, 0.f, 0.f, 0.f};
        cur = nxt; cA = nA; cB = nB; ++ui;
        if (wr == 1) PG8_BAR;
    }
    PG8_WAIT_V(0);
    PG8_BAR;
#undef PG8_SA
#undef PG8_SB
#undef PG8_STAGE
#undef PG8_LDA
#undef PG8_LDB
#undef PG8_MMA
#undef PG8_WAIT_V
#undef PG8_WAIT_L
#undef PG8_BAR
#undef PG8_SCHED
#undef PG8_UA
#undef PG8_UB
}

__device__ __forceinline__ void upgate_tile(int pm, int& rowbase, int& vlo, int& vhi, bool& first, bool& last) {
    if (pm < 16) { rowbase = pm * 256; vlo = 0; vhi = 255; first = true; last = true; return; }
    const int s = (pm - 16) / 5, i = (pm - 16) % 5;
    const int start = i == 0 ? 0 : (i == 1 ? 254 : (i == 2 ? 508 : (i == 3 ? 762 : 768)));
    rowbase = NCTX + s * 1024 + start; first = i == 0; last = i == 4;
    vlo = i == 0 ? 0 : (i == 4 ? 249 : 1); vhi = i == 4 ? 255 : 254;
}
__device__ __forceinline__ void gemm_upgate(const Frame& F, const bf16_t* A, const bf16_t* Bt, const float* cw, const float* cb, bf16_t* ACT) {
    LAS unsigned char* lds = F.lds;
    const int tid = F.tid, wid = F.wave, lane = F.lane, wr = wid >> 2, wc = wid & 3, fr = lane & 15, fq = lane >> 4;
    constexpr int K = 1024, nt = K / 64, UP = 528;
    BigDesc g{A, Bt, K, K, 26, 22, 1, K};
    unsigned voffA[2], voffB[2];
#pragma unroll
    for (int i = 0; i < 2; ++i) { int R, C; stage_rc(tid * 16 + i * 8192, R, C); voffA[i] = (unsigned)(R * K + C) * 2u; voffB[i] = voffA[i]; }
    const size_t kstep = (size_t)(64 * 2), hstep = (size_t)128 * K * 2;
    const unsigned ldsw = (unsigned)wid * 1024u;
    const int aoff = lds_byte(wr * 64 + fr, fq * 8), boff = lds_byte(wc * 32 + fr, fq * 8);
#define PG8_SA(b, h) (((b) * 2 + (h)) * HTB)
#define PG8_SB(b, h) ((4 + (b) * 2 + (h)) * HTB)
#define PG8_STAGE(bufoff, gbase, voff) do { _Pragma("unroll") for (int _i = 0; _i < 2; ++_i) \
        __builtin_amdgcn_global_load_lds((const unsigned*)((const char*)(gbase) + (voff)[_i]), (LAS unsigned*)(lds + (bufoff) + ldsw + _i * 8192), 16, 0, 0); } while (0)
#define PG8_LDA(dst, b, h) do { _Pragma("unroll") for (int m = 0; m < 4; ++m) _Pragma("unroll") for (int k = 0; k < 2; ++k) dst[m][k] = *(const LAS bf16x8*)(lds + PG8_SA(b, h) + aoff + m * 2048 + k * 1024); } while (0)
#define PG8_LDB(dst, b, h) do { _Pragma("unroll") for (int n = 0; n < 2; ++n) _Pragma("unroll") for (int k = 0; k < 2; ++k) dst[n][k] = *(const LAS bf16x8*)(lds + PG8_SB(b, h) + boff + n * 2048 + k * 1024); } while (0)
#define PG8_MMA(ai, bj, At, Bt_) do { __builtin_amdgcn_s_setprio(1); _Pragma("unroll") for (int m = 0; m < 4; ++m) _Pragma("unroll") for (int n = 0; n < 2; ++n) _Pragma("unroll") for (int k = 0; k < 2; ++k) \
        acc[ai][bj][m][n] = __builtin_amdgcn_mfma_f32_16x16x32_bf16(Bt_[n][k], At[m][k], acc[ai][bj][m][n], 0, 0, 0); __builtin_amdgcn_s_setprio(0); } while (0)
#define PG8_WAIT_V(n) asm volatile("s_waitcnt vmcnt(" #n ")" ::: "memory")
#define PG8_WAIT_L(n) asm volatile("s_waitcnt lgkmcnt(" #n ")" ::: "memory")
#define PG8_BAR __builtin_amdgcn_s_barrier()
#define PG8_SCHED __builtin_amdgcn_sched_barrier(0)
    for (int ui = 0;; ++ui) {
        BUnit cur;
        int hm = -1;
        if (F.G == 256 && ui == 2) { if (F.bid >= 120 || !big_next(g, 2, F.G, F.bid >> 1, cur)) break; hm = F.bid & 1; }
        else if (!big_next(g, ui, F.G, F.bid, cur)) break;
        unsigned voffBh[2];
#pragma unroll
        for (int i = 0; i < 2; ++i) { int R, C; stage_rc(tid * 16 + i * 8192, R, C); const int Rs = hm < 0 ? R : R + 64 * hm + (R >= 64 ? 64 : 0); voffBh[i] = (unsigned)(Rs * K + C) * 2u; }
        int rowbase; { int a_, b_; bool c_, d_; upgate_tile(cur.pm, rowbase, a_, b_, c_, d_); }
        f32x4 acc[2][2][4][2];
#pragma unroll
        for (int a = 0; a < 2; ++a)
#pragma unroll
            for (int b = 0; b < 2; ++b)
#pragma unroll
                for (int m = 0; m < 4; ++m)
#pragma unroll
                    for (int n = 0; n < 2; ++n) acc[a][b][m][n] = (f32x4){0.f, 0.f, 0.f, 0.f};
        bf16x8 At[4][2], B0[2][2], B1[2][2];
        const char* cA = (const char*)A + (size_t)rowbase * K * 2; const char* cB = (const char*)Bt + (size_t)cur.pn * 2 * hstep;
        PG8_STAGE(PG8_SB(0, 0), cB, voffBh); PG8_STAGE(PG8_SB(0, 1), cB + hstep, voffB); PG8_STAGE(PG8_SA(0, 0), cA, voffA); PG8_STAGE(PG8_SA(0, 1), cA + hstep, voffA);
        if (wr == 1) PG8_BAR;
        PG8_WAIT_V(2); PG8_BAR;
        PG8_STAGE(PG8_SB(1, 0), cB + kstep, voffBh); PG8_STAGE(PG8_SA(1, 0), cA + kstep, voffA); PG8_STAGE(PG8_SB(1, 1), cB + hstep + kstep, voffB);
        PG8_WAIT_V(6); PG8_BAR;
        for (int t = 0; t < nt; t += 2) {
            const bool last = (t == nt - 2);
            const char* a1 = cA + (size_t)(t + 1) * kstep;
            const char* a2 = last ? cA : cA + (size_t)(t + 2) * kstep; const char* b2 = last ? cB : cB + (size_t)(t + 2) * kstep;
            const char* a3 = a2 + kstep; const char* b3 = b2 + kstep;
            PG8_LDB(B0, 0, 0); PG8_LDB(B1, 0, 1); PG8_SCHED; PG8_LDA(At, 0, 0); PG8_STAGE(PG8_SA(1, 1), a1 + hstep, voffA);
            PG8_WAIT_V(8); PG8_WAIT_L(0); PG8_BAR; PG8_MMA(0, 0, At, B0); if (hm < 0) PG8_MMA(0, 1, At, B1); PG8_BAR; PG8_SCHED;
            PG8_LDA(At, 0, 1); PG8_STAGE(PG8_SB(0, 0), b2, voffBh); PG8_STAGE(PG8_SB(0, 1), b2 + hstep, voffB); PG8_STAGE(PG8_SA(0, 0), a2, voffA);
            PG8_WAIT_V(8); PG8_WAIT_L(0); PG8_BAR; PG8_MMA(1, 0, At, B0); if (hm < 0) PG8_MMA(1, 1, At, B1); PG8_BAR; PG8_SCHED;
            PG8_LDB(B0, 1, 0); PG8_LDB(B1, 1, 1); PG8_SCHED; PG8_LDA(At, 1, 0); PG8_STAGE(PG8_SA(0, 1), a2 + hstep, voffA);
            PG8_WAIT_V(8); PG8_WAIT_L(0); PG8_BAR; PG8_MMA(0, 0, At, B0); if (hm < 0) PG8_MMA(0, 1, At, B1); PG8_BAR; PG8_SCHED;
            PG8_LDA(At, 1, 1); PG8_STAGE(PG8_SB(1, 0), b3, voffBh); PG8_STAGE(PG8_SB(1, 1), b3 + hstep, voffB); PG8_STAGE(PG8_SA(1, 0), a3, voffA);
            PG8_WAIT_V(8); PG8_WAIT_L(0); PG8_BAR; PG8_MMA(1, 0, At, B0); if (hm < 0) PG8_MMA(1, 1, At, B1); PG8_BAR; PG8_SCHED;
        }
        if (wr == 0) PG8_BAR;
        PG8_WAIT_V(0); PG8_BAR;
        asm volatile("" ::: "memory");
#pragma unroll
        for (int ai = 0; ai < 2; ++ai)
#pragma unroll
            for (int m = 0; m < 4; ++m)
#pragma unroll
                for (int bj = 0; bj < 2; ++bj)
#pragma unroll
                    for (int n = 0; n < 2; ++n) {
                        if (bj == 1 && hm >= 0) continue;
                        const f32x4 v = acc[ai][bj][m][n]; u32x2 w; w.x = pack2(v[0], v[1]); w.y = pack2(v[2], v[3]);
                        *(LAS u32x2*)(lds + (ai * 128 + wr * 64 + m * 16 + fr) * UP + (bj * 128 + wc * 32 + n * 16 + 4 * fq) * 2) = w;
                    }
        __syncthreads();
        __builtin_amdgcn_sched_barrier(0);
        int vlo, vhi; { int rb_; bool c_, d_; upgate_tile(cur.pm, rb_, vlo, vhi, c_, d_); }
        {
            const int c = hm < 0 ? (tid & 15) * 8 : (tid & 7) * 8, r0 = hm < 0 ? (tid >> 4) * 8 : (tid >> 3) * 4, nrow = hm < 0 ? 8 : 4, boffc = hm < 0 ? 128 : 64;
            const int ca = cur.pn * 128 + (hm < 0 ? 0 : 64 * hm) + c, cbn = 2816 + ca;
            float wa[3][8], wb[3][8], ba8[8], bb8[8];
#pragma unroll
            for (int q = 0; q < 2; ++q) {
#pragma unroll
                for (int tp = 0; tp < 3; ++tp) {
                    const f32x4 x = *(const f32x4*)(cw + tp * 5632 + ca + q * 4), y = *(const f32x4*)(cw + tp * 5632 + cbn + q * 4);
#pragma unroll
                    for (int jj = 0; jj < 4; ++jj) { wa[tp][q * 4 + jj] = x[jj]; wb[tp][q * 4 + jj] = y[jj]; }
                }
                const f32x4 x = *(const f32x4*)(cb + ca + q * 4), y = *(const f32x4*)(cb + cbn + q * 4);
#pragma unroll
                for (int jj = 0; jj < 4; ++jj) { ba8[q * 4 + jj] = x[jj]; bb8[q * 4 + jj] = y[jj]; }
            }
            const bf16x8 z = (bf16x8){0, 0, 0, 0, 0, 0, 0, 0};
            bf16x8 ap, bp, ac, bc, an, bn;
            {
                const bool hp0 = r0 > 0;
                ap = hp0 ? *(const LAS bf16x8*)(lds + (r0 - 1) * UP + c * 2) : z; bp = hp0 ? *(const LAS bf16x8*)(lds + (r0 - 1) * UP + (boffc + c) * 2) : z;
                ac = *(const LAS bf16x8*)(lds + r0 * UP + c * 2); bc = *(const LAS bf16x8*)(lds + r0 * UP + (boffc + c) * 2);
            }
#pragma unroll 1
            for (int i = 0; i < nrow; ++i) {
                const int r = r0 + i;
                const bool hn = r < 255;
                an = hn ? *(const LAS bf16x8*)(lds + (r + 1) * UP + c * 2) : z; bn = hn ? *(const LAS bf16x8*)(lds + (r + 1) * UP + (boffc + c) * 2) : z;
                if (r >= vlo && r <= vhi) {
                    float ov[8];
#pragma unroll
                    for (int e = 0; e < 8; ++e) {
                        const float ua = bf2f((unsigned short)ap[e]) * wa[0][e] + bf2f((unsigned short)ac[e]) * wa[1][e] + bf2f((unsigned short)an[e]) * wa[2][e] + ba8[e];
                        const float ub = bf2f((unsigned short)bp[e]) * wb[0][e] + bf2f((unsigned short)bc[e]) * wb[1][e] + bf2f((unsigned short)bn[e]) * wb[2][e] + bb8[e];
                        ov[e] = siluf_(ua) * ub;
                    }
                    u32x4 w; w.x = pack2(ov[0], ov[1]); w.y = pack2(ov[2], ov[3]); w.z = pack2(ov[4], ov[5]); w.w = pack2(ov[6], ov[7]);
                    *(u32x4*)(ACT + (size_t)(rowbase + r) * 2816 + ca) = w;
                }
                ap = ac; bp = bc; ac = an; bc = bn;
            }
        }
        __syncthreads();
    }
#undef PG8_SA
#undef PG8_SB
#undef PG8_STAGE
#undef PG8_LDA
#undef PG8_LDB
#undef PG8_MMA
#undef PG8_WAIT_V
#undef PG8_WAIT_L
#undef PG8_BAR
#undef PG8_SCHED
}

struct CvtJob { const float* src; bf16_t* dst; int K, N, Npad, tiles, upperm; };
__device__ __forceinline__ void cvt_tile(const Frame& F, const CvtJob& j, int t) {
    LAS float* tile = (LAS float*)F.lds;
    const int tk = j.K / 64, kt = t % tk, ntile = t / tk, k0 = kt * 64, n0 = ntile * 64;
    const int tid = F.tid;
    {
        const int r = tid >> 4, c4 = (tid & 15) * 4;
#pragma unroll
        for (int i = 0; i < 2; ++i) {
            const int kr = r + 32 * i;
            f32x4 v = (f32x4){0.f, 0.f, 0.f, 0.f};
            if (n0 + c4 < j.N) v = *(const f32x4*)(j.src + (size_t)(k0 + kr) * j.N + n0 + c4);
            tile[kr * 65 + c4 + 0] = v[0]; tile[kr * 65 + c4 + 1] = v[1]; tile[kr * 65 + c4 + 2] = v[2]; tile[kr * 65 + c4 + 3] = v[3];
        }
    }
    __syncthreads();
    {
        const int n = tid >> 3, kq = (tid & 7) * 8;
        u32x4 w;
        w.x = pack2(tile[(kq + 0) * 65 + n], tile[(kq + 1) * 65 + n]); w.y = pack2(tile[(kq + 2) * 65 + n], tile[(kq + 3) * 65 + n]);
        w.z = pack2(tile[(kq + 4) * 65 + n], tile[(kq + 5) * 65 + n]); w.w = pack2(tile[(kq + 6) * 65 + n], tile[(kq + 7) * 65 + n]);
        const int drow = j.upperm ? (n0 < 2816 ? (n0 >> 7) * 256 + (n0 & 127) : ((n0 - 2816) >> 7) * 256 + 128 + ((n0 - 2816) & 127)) + n : n0 + n;
        *(u32x4*)(j.dst + (size_t)drow * j.K + k0 + kq) = w;
    }
    __syncthreads();
}

__device__ __forceinline__ void cvt_group(const Frame& F, const PRef& p, int group, int bfirst, int nb, int rot0) {
    if (F.bid < bfirst || F.bid >= bfirst + nb) return;
    unsigned char* ws = p.ws();
    const int vb = F.bid - bfirst;
    int rot = rot0;
#define CVT(srcp, dstoff, K_, N_, Npad_) do { CvtJob jb; jb.src = (srcp); jb.dst = (bf16_t*)(ws + (dstoff)); jb.K = (K_); jb.N = (N_); jb.Npad = (Npad_); jb.tiles = ((K_) / 64) * ((Npad_) / 64); jb.upperm = ((N_) == 5632); \
        for (int t = (vb + nb - (rot % nb)) % nb; t < jb.tiles; t += nb) cvt_tile(F, jb, t); rot += jb.tiles; } while (0)
    if (group == 0) {
        CVT(p.in(19), WS_WAIN, 1024, 1952, 2048);
        CVT(p.in(22), WS_WUQ, 256, 768, 768);
        CVT(p.in(23), WS_WUKV, 128, 1024, 1024);
    } else if (group == 1) {
        CVT(p.in(14), WS_WOUT, 1024, 1024, 1024);
        CVT(p.in(15), WS_WUP, 1024, 5632, 5632);
    } else if (group == 3) {
        CVT(p.in(18), WS_WDN, 2816, 1024, 1024);
    } else {
        CVT(p.in(28), WS_WBIN, 1024, 3456, 3584);
        CVT(p.in(14) + (size_t)1024 * 1024, WS_WOUT + (size_t)1024 * 1024 * 2, 1024, 1024, 1024);
        CVT(p.in(15) + (size_t)1024 * 5632, WS_WUP + (size_t)5632 * 1024 * 2, 1024, 5632, 5632);
        CVT(p.in(18) + (size_t)2816 * 1024, WS_WDN + (size_t)1024 * 2816 * 2, 2816, 1024, 1024);
        CVT(p.in(35), WS_WWUP, 64, 512, 512);
        CVT(p.in(35) + 64 * 512, WS_WWUP + 512 * 64 * 2, 64, 512, 512);
        CVT(p.in(37), WS_WAUP, 64, 512, 512);
        CVT(p.in(37) + 64 * 512, WS_WAUP + 512 * 64 * 2, 64, 512, 512);
        CVT(p.in(38), WS_WGUP, 128, 512, 512);
    }
#undef CVT
}
__device__ __forceinline__ void phase_prep(const Frame& F, const PRef& p) {
    unsigned char* ws = p.ws();
    {
        LAS float* sc = (LAS float*)F.lds;
        LAS float* red = sc + 3 * 1024;
        for (int i = F.tid; i < 3 * 1024; i += NTHREADS) {
            const int c = i >> 10, k = i & 1023;
            const float v = c == 0 ? p.in(9)[k] : p.in(8)[(c - 1) * 1024 + k];
            sc[i] = siluf_(v);
        }
        __syncthreads();
        float* mod = (float*)(ws + WS_MOD);
        FOR_UNITS(u, 192, 0) {
            const int l = u / 96, n0 = (u % 96) * 64, col = F.tid & 63, kg = F.tid >> 6;
            const float* w = p.in(10) + (size_t)l * 1024 * 6144 + (size_t)(kg * 128) * 6144 + n0 + col;
            float a0 = 0.f, a1 = 0.f, a2 = 0.f;
#pragma unroll 8
            for (int k = 0; k < 128; ++k) { const float wv = w[(size_t)k * 6144]; const int kk = kg * 128 + k; a0 += sc[kk] * wv; a1 += sc[1024 + kk] * wv; a2 += sc[2048 + kk] * wv; }
            red[(kg * 3 + 0) * 64 + col] = a0; red[(kg * 3 + 1) * 64 + col] = a1; red[(kg * 3 + 2) * 64 + col] = a2;
            __syncthreads();
            if (F.tid < 192) {
                const int c = F.tid >> 6, cc = F.tid & 63; float s = 0.f;
#pragma unroll
                for (int q = 0; q < 8; ++q) s += red[(q * 3 + c) * 64 + cc];
                mod[(size_t)(l * 3 + c) * 6144 + n0 + cc] = s + p.in(11)[l * 6144 + n0 + cc];
            }
            __syncthreads();
        }
    }
    cvt_group(F, p, 0, 0, F.G, 192);
}

__device__ __forceinline__ void phase_norm(const Frame& F, const float* xa, const float* xb, const bf16_t* part, const float* gate, float* xout,
                                           const float* g, const float* sc, const float* sh, bf16_t* hb, bool do_norm) {
    const int nw = F.G * 8;
    for (int row = F.bid * 8 + F.wave; row < NTOK; row += nw) {
        const float* x = row < NCTX ? xa + (size_t)row * 1024 : xb + (size_t)(row - NCTX) * 1024;
        const int c = cond_of(row);
        f32x4 v[4]; float ss = 0.f;
#pragma unroll
        for (int i = 0; i < 4; ++i) {
            const int col = i * 256 + F.lane * 4;
            v[i] = *(const f32x4*)(x + col);
            if (part) {
                const u32x2 q0 = *(const u32x2*)(part + (size_t)row * 1024 + col), q1 = *(const u32x2*)(part + (size_t)NTOK * 1024 + (size_t)row * 1024 + col);
                const f32x4 ps = (f32x4){bf2f(q0.x & 0xffffu) + bf2f(q1.x & 0xffffu), bf2f(q0.x >> 16) + bf2f(q1.x >> 16), bf2f(q0.y & 0xffffu) + bf2f(q1.y & 0xffffu), bf2f(q0.y >> 16) + bf2f(q1.y >> 16)};
                const f32x4 gt = *(const f32x4*)(gate + c * 6144 + col);
                v[i] = v[i] + gt * ps;
                *(f32x4*)(xout + (size_t)row * 1024 + col) = v[i];
            }
            ss += v[i][0] * v[i][0] + v[i][1] * v[i][1] + v[i][2] * v[i][2] + v[i][3] * v[i][3];
        }
        if (!do_norm) continue;
        ss = wave_sum(ss);
        const float rstd = rsqrtf(ss * (1.0f / 1024.0f) + EPS);
#pragma unroll
        for (int i = 0; i < 4; ++i) {
            const int col = i * 256 + F.lane * 4;
            const f32x4 gg = *(const f32x4*)(g + col), s1 = *(const f32x4*)(sc + c * 6144 + col), s0 = *(const f32x4*)(sh + c * 6144 + col);
            f32x4 h;
#pragma unroll
            for (int j = 0; j < 4; ++j) h[j] = v[i][j] * rstd * gg[j] * (1.0f + s1[j]) + s0[j];
            u32x2 w; w.x = pack2(h[0], h[1]); w.y = pack2(h[2], h[3]);
            *(u32x2*)(hb + (size_t)row * 1024 + col) = w;
        }
    }
}

__device__ __forceinline__ void seq_of_unit384(int u, int& s, int& c, int& h, int& tok0, int& nc) {
    if (u < 256) { s = u >> 4; c = (u >> 2) & 3; h = u & 3; tok0 = s * 256 + c * 64; nc = 4; }
    else { const int v = u - 256; s = 16 + (v >> 6); c = (v >> 2) & 15; h = v & 3; tok0 = NCTX + (s - 16) * 1024 + c * 64; nc = 16; }
}
__device__ __forceinline__ void phase_l0_tok(const Frame& F, const PRef& p) {
    unsigned char* ws = p.ws();
    const float* P = (const float*)(ws + WS_P0);
    bf16_t* cqn = (bf16_t*)(ws + WS_CQN); bf16_t* ckvn = (bf16_t*)(ws + WS_CKVN);
    const int nw = F.G * 8;
    for (int row = F.bid * 8 + F.wave; row < NKROW; row += nw) {
        if (row < NTOK) {
            const float* pr = P + (size_t)row * 2048;
            const f32x4 q = *(const f32x4*)(pr + F.lane * 4);
            float ss = wave_sum(q[0] * q[0] + q[1] * q[1] + q[2] * q[2] + q[3] * q[3]);
            float rstd = rsqrtf(ss * (1.0f / 256.0f) + EPS);
            const f32x4 gq = *(const f32x4*)(p.in(20) + F.lane * 4);
            u32x2 w; w.x = pack2(q[0] * rstd * gq[0], q[1] * rstd * gq[1]); w.y = pack2(q[2] * rstd * gq[2], q[3] * rstd * gq[3]);
            *(u32x2*)(cqn + (size_t)row * 256 + F.lane * 4) = w;
            const f32x2 kv = *(const f32x2*)(pr + 256 + F.lane * 2);
            ss = wave_sum(kv[0] * kv[0] + kv[1] * kv[1]);
            rstd = rsqrtf(ss * (1.0f / 128.0f) + EPS);
            const f32x2 gk = *(const f32x2*)(p.in(21) + F.lane * 2);
            const float o0 = kv[0] * rstd * gk[0], o1 = kv[1] * rstd * gk[1];
            *(unsigned*)(ckvn + (size_t)row * 128 + F.lane * 2) = pack2(o0, o1);
            if (row < NCTX) {
                *(f32x2*)(p.out() + OUT_CKV + (size_t)row * 128 + F.lane * 2) = (f32x2){o0, o1};
                if (F.lane < 32) p.out()[OUT_KROPE + (size_t)row * 32 + F.lane] = pr[384 + F.lane];
            }
        } else {
            const int i = row - NTOK;
            const f32x2 kv = *(const f32x2*)(p.in(2) + (size_t)i * 128 + F.lane * 2);
            *(unsigned*)(ckvn + (size_t)row * 128 + F.lane * 2) = pack2(kv[0], kv[1]);
        }
    }
    {
        LAS unsigned char* L = F.lds;
        constexpr int KPI = 160, VPI = 288, O_KF = 0, O_KB = 64 * KPI, O_V = 2 * 64 * KPI;
        float* KVS = (float*)(ws + WS_KVS);
        const int tid = F.tid, w = F.wave, fr = F.lane & 15, fq = F.lane >> 4;
        FOR_UNITS(u, 384, 0) {
            int s, c, h, tok0, nc; seq_of_unit384(u, s, c, h, tok0, nc);
            const float lgf = __logf(sigmoidf_(p.in(26)[h])), lgb = __logf(sigmoidf_(p.in(26)[4 + h]));
            {
                const int row = tid >> 3, ch = tid & 7;
                const float* pr = P + (size_t)(tok0 + row) * 2048;
                const f32x4 k0 = *(const f32x4*)(pr + 672 + h * 64 + ch * 8), k1 = *(const f32x4*)(pr + 672 + h * 64 + ch * 8 + 4);
                f32x4 vv[4];
#pragma unroll
                for (int i = 0; i < 4; ++i) vv[i] = *(const f32x4*)(pr + 928 + h * 128 + ch * 16 + i * 4);
                const float df = 0.125f * __expf(lgf * (float)(63 - row)), db = 0.125f * __expf(lgb * (float)row);
                u32x4 t;
                t.x = pack2(k0[0] * df, k0[1] * df); t.y = pack2(k0[2] * df, k0[3] * df); t.z = pack2(k1[0] * df, k1[1] * df); t.w = pack2(k1[2] * df, k1[3] * df); *(LAS u32x4*)(L + O_KF + row * KPI + ch * 16) = t;
                t.x = pack2(k0[0] * db, k0[1] * db); t.y = pack2(k0[2] * db, k0[3] * db); t.z = pack2(k1[0] * db, k1[1] * db); t.w = pack2(k1[2] * db, k1[3] * db); *(LAS u32x4*)(L + O_KB + row * KPI + ch * 16) = t;
#pragma unroll
                for (int i = 0; i < 2; ++i) { t.x = pack2(vv[2 * i][0], vv[2 * i][1]); t.y = pack2(vv[2 * i][2], vv[2 * i][3]); t.z = pack2(vv[2 * i + 1][0], vv[2 * i + 1][1]); t.w = pack2(vv[2 * i + 1][2], vv[2 * i + 1][3]);
                    *(LAS u32x4*)(L + O_V + row * VPI + ch * 32 + i * 16) = t; }
            }
            __syncthreads();
            bf16x8 Bf[2];
#pragma unroll
            for (int ks = 0; ks < 2; ++ks) {
                const LAS unsigned char* vp = L + O_V + (32 * ks + 8 * fq + (fr >> 2)) * VPI + (w * 16 + 4 * (fr & 3)) * 2;
                const bf16x4 v0 = __builtin_amdgcn_ds_read_tr16_b64_v4i16((LAS bf16x4*)vp), v1 = __builtin_amdgcn_ds_read_tr16_b64_v4i16((LAS bf16x4*)(vp + 4 * VPI));
                bf16x8 x; x[0] = v0[0]; x[1] = v0[1]; x[2] = v0[2]; x[3] = v0[3]; x[4] = v1[0]; x[5] = v1[1]; x[6] = v1[2]; x[7] = v1[3]; Bf[ks] = x;
            }
            float* o = KVS + (size_t)u * 2 * 8192;
#pragma unroll
            for (int d = 0; d < 2; ++d)
#pragma unroll
                for (int et = 0; et < 4; ++et) {
                    f32x4 a = (f32x4){0.f, 0.f, 0.f, 0.f};
#pragma unroll
                    for (int ks = 0; ks < 2; ++ks) {
                        const LAS unsigned char* kp = L + (d ? O_KB : O_KF) + (32 * ks + 8 * fq + (fr >> 2)) * KPI + (et * 16 + 4 * (fr & 3)) * 2;
                        const bf16x4 v0 = __builtin_amdgcn_ds_read_tr16_b64_v4i16((LAS bf16x4*)kp), v1 = __builtin_amdgcn_ds_read_tr16_b64_v4i16((LAS bf16x4*)(kp + 4 * KPI));
                        bf16x8 x; x[0] = v0[0]; x[1] = v0[1]; x[2] = v0[2]; x[3] = v0[3]; x[4] = v1[0]; x[5] = v1[1]; x[6] = v1[2]; x[7] = v1[3];
                        a = __builtin_amdgcn_mfma_f32_16x16x32_bf16(x, Bf[ks], a, 0, 0, 0);
                    }
#pragma unroll
                    for (int r = 0; r < 4; ++r) o[d * 8192 + (et * 16 + 4 * fq + r) * 128 + w * 16 + fr] = a[r];
                }
            __syncthreads();
        }
    }
}

__device__ __forceinline__ void phase_l0_prefix(const Frame& F, const PRef& p, int rot) {
    float* KVS = (float*)(p.ws() + WS_KVS);
    FOR_UNITS(u, 576, rot) {
        const int qd = u & 3, d = (u >> 2) & 1, h = (u >> 3) & 3, s = u >> 5;
        const int nc = s < 16 ? 4 : 16;
        const int ubase = s < 16 ? s * 16 + h : 256 + (s - 16) * 64 + h;
        const float g64 = __expf(64.0f * __logf(sigmoidf_(p.in(26)[d * 4 + h])));
        const int i = qd * 2048 + F.tid * 4;
        float* base = KVS + (size_t)ubase * 16384 + d * 8192 + i;
        f32x4 kv[16];
#pragma unroll
        for (int c = 0; c < 16; ++c) if (c < nc) kv[c] = *(const f32x4*)(base + (size_t)c * 4 * 16384);
        f32x4 S = (f32x4){0.f, 0.f, 0.f, 0.f};
        if (s >= 16) S = *(const f32x4*)(p.in(4) + (size_t)(((s - 16) * 2 + d) * 4 + h) * 8192 + i);
        if (d == 0) {
#pragma unroll
            for (int c = 0; c < 16; ++c) if (c < nc) { *(f32x4*)(base + (size_t)c * 4 * 16384) = S; S = S * g64 + kv[c]; }
        } else {
#pragma unroll
            for (int c = 15; c >= 0; --c) if (c < nc) { *(f32x4*)(base + (size_t)c * 4 * 16384) = S; S = S * g64 + kv[c]; }
        }
        if (s < 16) *(f32x4*)(p.out() + OUT_SRET + (size_t)((s * 2 + d) * 4 + h) * 8192 + i) = S;
    }
}

__device__ __forceinline__ size_t vt_base(int kr, int nheads, int dv, int& nkeys, int& key) {
    if (kr < NCTX) { nkeys = 256; key = kr & 255; return (size_t)(kr >> 8) * nheads * dv * 256; }
    const int v = kr - NCTX; const int b = v / 1536; nkeys = 1536; key = v - b * 1536;
    return (size_t)16 * nheads * dv * 256 + (size_t)b * nheads * dv * 1536;
}
__device__ __forceinline__ void phase_l0_qkv(const Frame& F, const PRef& p) {
    unsigned char* ws = p.ws();
    const float* P = (const float*)(ws + WS_P0); const float* QR = (const float*)(ws + WS_QRAW); const float* KVR = (const float*)(ws + WS_KVRAW);
    bf16_t* Q = (bf16_t*)(ws + WS_Q0); bf16_t* K = (bf16_t*)(ws + WS_K0); bf16_t* VT = (bf16_t*)(ws + WS_VT0);
    const int nw = F.G * 8, lane = F.lane;
    const float qscale = 0.10206207261596577f;
    for (int row = F.bid * 8 + F.wave; row < NKROW; row += nw) {
        const bool istok = row < NTOK, lat = istok && row >= NCTX;
        float cs = 1.f, sn = 0.f;
        if (lat && lane >= 32 && lane < 48) {
            const int t = (row - NCTX) & 1023, a = lane - 32;
            const float pos = a < 8 ? (float)(t >> 6) : (float)(t & 63);
            const float inv = __powf(10000.0f, -(float)(a & 7) * 0.125f);
            const float ang = pos * inv; cs = __cosf(ang); sn = __sinf(ang);
        }
        int kr;
        if (row < NCTX) kr = row; else if (row < NTOK) { const int v = row - NCTX; kr = NCTX + (v >> 10) * 1536 + (v & 1023); }
        else { const int i = row - NTOK; kr = NCTX + (i >> 9) * 1536 + 1024 + (i & 511); }
        const float* krope = istok ? P + (size_t)row * 2048 + 384 : p.in(3) + (size_t)(row - NTOK) * 32;
        f32x2 qv[8], kv2[8]; float vv[8];
        f32x2 kro = (f32x2){0.f, 0.f};
        if (lane >= 32 && lane < 48) kro = *(const f32x2*)(krope + 2 * (lane - 32));
#pragma unroll
        for (int h = 0; h < 8; ++h) {
            qv[h] = (f32x2){0.f, 0.f};
            if (istok && lane < 48) qv[h] = *(const f32x2*)(QR + (size_t)row * 768 + h * 96 + 2 * lane);
            kv2[h] = kro;
            if (lane < 32) kv2[h] = *(const f32x2*)(KVR + (size_t)row * 1024 + h * 128 + 2 * lane);
            vv[h] = KVR[(size_t)row * 1024 + h * 128 + 64 + lane];
        }
        f32x2 gq = (f32x2){0.f, 0.f}, gk = (f32x2){0.f, 0.f};
        if (lane < 48) { gq = *(const f32x2*)(p.in(24) + 2 * lane); gk = *(const f32x2*)(p.in(25) + 2 * lane); }
#pragma unroll
        for (int h = 0; h < 8; ++h) {
            if (istok) {
                float x1 = qv[h][0], x2 = qv[h][1];
                const float rstd = rsqrtf(wave_sum(x1 * x1 + x2 * x2) * (1.0f / 96.0f) + EPS);
                if (lane < 48) {
                    x1 = x1 * rstd * gq[0]; x2 = x2 * rstd * gq[1];
                    const float y1 = x1 * cs - x2 * sn, y2 = x1 * sn + x2 * cs;
                    *(unsigned*)(Q + (size_t)row * 768 + h * 96 + 2 * lane) = pack2(y1 * qscale, y2 * qscale);
                }
            }
            {
                float x1 = kv2[h][0], x2 = kv2[h][1];
                const float rstd = rsqrtf(wave_sum(x1 * x1 + x2 * x2) * (1.0f / 96.0f) + EPS);
                if (lane < 48) {
                    x1 = x1 * rstd * gk[0]; x2 = x2 * rstd * gk[1];
                    const float y1 = x1 * cs - x2 * sn, y2 = x1 * sn + x2 * cs;
                    *(unsigned*)(K + (size_t)kr * 768 + h * 96 + 2 * lane) = pack2(y1, y2);
                }
            }
            VT[(size_t)kr * 512 + h * 64 + lane] = f2bf(vv[h]);
        }
    }
}

template <int DQK, int DV, int NC, int NQT>
struct AttnState { f32x4 O[NC][DV / 16][NQT]; float l[NC][NQT]; };

template <int DQK, int DV, int NC, int NQT>
__device__ __forceinline__ void attn_wave(const bf16_t* __restrict__ Q, const bf16_t* __restrict__ K, const bf16_t* __restrict__ Vt,
                                          int qtok0, int krow0, int nkeys, int hh0  , int lane, AttnState<DQK, DV, NC, NQT>& st) {
    constexpr int NS = DQK / 32, NE = DV / 16, RS = 8 * DQK;
    const int fr = lane & 15, fq = lane >> 4;
    bf16x8 Qf[NC][NQT][NS];
#pragma unroll
    for (int c = 0; c < NC; ++c)
#pragma unroll
        for (int qt = 0; qt < NQT; ++qt)
#pragma unroll
            for (int s = 0; s < NS; ++s) Qf[c][qt][s] = *(const bf16x8*)(Q + (size_t)(qtok0 + qt * 16 + fr) * RS + (hh0 + c) * DQK + s * 32 + fq * 8);
    float m[NC][NQT];
#pragma unroll
    for (int c = 0; c < NC; ++c)
#pragma unroll
        for (int qt = 0; qt < NQT; ++qt) { m[c][qt] = -1e30f; st.l[c][qt] = 0.f;
#pragma unroll
            for (int e = 0; e < NE; ++e) st.O[c][e][qt] = (f32x4){0.f, 0.f, 0.f, 0.f}; }
    for (int key0 = 0; key0 < nkeys; key0 += 32) {
        bf16x8 Pf[NC][NQT];
#pragma unroll
        for (int c = 0; c < NC; ++c) {
            f32x4 S[2][NQT];
#pragma unroll
            for (int kt = 0; kt < 2; ++kt) {
                bf16x8 Kf[NS];
#pragma unroll
                for (int s = 0; s < NS; ++s) Kf[s] = *(const bf16x8*)(K + (size_t)(krow0 + key0 + kt * 16 + fr) * RS + (hh0 + c) * DQK + s * 32 + fq * 8);
#pragma unroll
                for (int qt = 0; qt < NQT; ++qt) {
                    f32x4 a = (f32x4){0.f, 0.f, 0.f, 0.f};
#pragma unroll
                    for (int s = 0; s < NS; ++s) a = __builtin_amdgcn_mfma_f32_16x16x32_bf16(Kf[s], Qf[c][qt][s], a, 0, 0, 0);
                    S[kt][qt] = a;
                }
            }
#pragma unroll
            for (int qt = 0; qt < NQT; ++qt) {
                float mx = fmaxf(fmaxf(fmaxf(S[0][qt][0], S[0][qt][1]), fmaxf(S[0][qt][2], S[0][qt][3])), fmaxf(fmaxf(S[1][qt][0], S[1][qt][1]), fmaxf(S[1][qt][2], S[1][qt][3])));
                mx = fmaxf(mx, __shfl_xor(mx, 16)); mx = fmaxf(mx, __shfl_xor(mx, 32));
                const float mn = fmaxf(m[c][qt], mx), alpha = __expf(m[c][qt] - mn);
                m[c][qt] = mn;
                float pv[8]; float ps = 0.f;
#pragma unroll
                for (int j = 0; j < 4; ++j) { pv[j] = __expf(S[0][qt][j] - mn); pv[4 + j] = __expf(S[1][qt][j] - mn); ps += pv[j] + pv[4 + j]; }
                st.l[c][qt] = st.l[c][qt] * alpha + ps;
#pragma unroll
                for (int e = 0; e < NE; ++e) st.O[c][e][qt] *= alpha;
                u32x4 pk; pk.x = pack2(pv[0], pv[1]); pk.y = pack2(pv[2], pv[3]); pk.z = pack2(pv[4], pv[5]); pk.w = pack2(pv[6], pv[7]);
                Pf[c][qt] = __builtin_bit_cast(bf16x8, pk);
            }
        }
#pragma unroll
        for (int e = 0; e < NE; ++e) {
            const bf16_t* vp = Vt + (size_t)(e * 16 + fr) * nkeys + key0 + 4 * fq;
            const bf16x4 v0 = *(const bf16x4*)vp, v1 = *(const bf16x4*)(vp + 16);
            bf16x8 Vf; Vf[0] = v0[0]; Vf[1] = v0[1]; Vf[2] = v0[2]; Vf[3] = v0[3]; Vf[4] = v1[0]; Vf[5] = v1[1]; Vf[6] = v1[2]; Vf[7] = v1[3];
#pragma unroll
            for (int c = 0; c < NC; ++c)
#pragma unroll
                for (int qt = 0; qt < NQT; ++qt) st.O[c][e][qt] = __builtin_amdgcn_mfma_f32_16x16x32_bf16(Vf, Pf[c][qt], st.O[c][e][qt], 0, 0, 0);
        }
    }
#pragma unroll
    for (int c = 0; c < NC; ++c)
#pragma unroll
        for (int qt = 0; qt < NQT; ++qt) { float l = st.l[c][qt]; l += __shfl_xor(l, 16); l += __shfl_xor(l, 32); st.l[c][qt] = 1.0f / l; }
}

__device__ __forceinline__ int attn_unit_xcd(int bid, int which) {
    const int x = bid & 7, idx = bid >> 3;
    return which == 0 ? (2 * x + (idx >> 4)) * 16 + (idx & 15) : 256 + (x * 16 + (idx >> 1)) * 2 + (idx & 1);
}
template <int DQK, int DV, int VH, class OutFn>
__device__ __forceinline__ void attn_block(const Frame& F, const bf16_t* __restrict__ Q, const bf16_t* __restrict__ K, const bf16_t* __restrict__ VT, const OutFn& out, int unit, float shift) {
    constexpr int NS = DQK / 32, NE = DV / 16, RS = 8 * DQK, KPC = DQK / 8;
    constexpr int KB = 128 * 256, VP = DV * 2 + 32, VB = 128 * VP, STG = KB + VB, VPC = DV / 8;
    constexpr int NKP = 128 * KPC / NTHREADS, NVP = 128 * VPC / NTHREADS;
    LAS unsigned char* lds = F.lds;
    const int lane = F.lane, fr = lane & 15, fq = lane >> 4, wave = F.wave, tid = F.tid;
    const bool lat = unit < 256;
    int ab, h, q0, nkeys, NQG;
    if (lat) { ab = 16 + (unit >> 7); h = (unit >> 4) & 7; q0 = (unit & 15) * 64; nkeys = 1536; NQG = 2; }
    else { const int v = unit - 256; ab = v >> 4; h = (v >> 1) & 7; q0 = (v & 1) * 128; nkeys = 256; NQG = 4; }
    const int NKS = 8 / NQG, qg = wave % NQG, ks = wave / NQG, kslice = 128 / NKS, nit = kslice / 32;
    const int qtok0 = (lat ? NCTX + (ab - 16) * 1024 : ab * 256) + q0 + qg * 32;
    const int krow0 = lat ? NCTX + (ab - 16) * 1536 : ab * 256;
    const bf16_t* vg = VT + (size_t)krow0 * (VH * DV) + (h * VH / 8) * DV;
    const bf16_t* kg = K + (size_t)krow0 * RS + h * DQK;
    bf16x8 Qf[2][NS];
#pragma unroll
    for (int qt = 0; qt < 2; ++qt)
#pragma unroll
        for (int s = 0; s < NS; ++s) Qf[qt][s] = *(const bf16x8*)(Q + (size_t)(qtok0 + qt * 16 + fr) * RS + h * DQK + s * 32 + fq * 8);
    f32x4 O[NE][2]; float l[2];
    const float sh2 = shift * 1.44269504f;
#pragma unroll
    for (int qt = 0; qt < 2; ++qt) { l[qt] = 0.f;
#pragma unroll
        for (int e = 0; e < NE; ++e) O[e][qt] = (f32x4){0.f, 0.f, 0.f, 0.f}; }
    u32x4 kregA[NKP], vregA[NVP], kregB[DV == 64 ? NKP : 1], vregB[DV == 64 ? NVP : 1];
#define AT_LOAD(kreg, vreg, st) do { \
        _Pragma("unroll") for (int i = 0; i < NKP; ++i) { const int pid = tid + i * NTHREADS, row = pid / KPC, ch = pid % KPC; kreg[i] = *(const u32x4*)(kg + (size_t)((st) * 128 + row) * RS + ch * 8); } \
        _Pragma("unroll") for (int i = 0; i < NVP; ++i) { const int pid = tid + i * NTHREADS, row = pid / VPC, ch = pid % VPC; vreg[i] = *(const u32x4*)(vg + (size_t)((st) * 128 + row) * (VH * DV) + ch * 8); } } while (0)
#define AT_WRITE(kreg, vreg, buf) do { \
        _Pragma("unroll") for (int i = 0; i < NKP; ++i) { const int pid = tid + i * NTHREADS, row = pid / KPC, ch = pid % KPC; *(LAS u32x4*)(lds + (buf) * STG + row * 256 + ((ch ^ (row & 15)) << 4)) = kreg[i]; } \
        _Pragma("unroll") for (int i = 0; i < NVP; ++i) { const int pid = tid + i * NTHREADS, row = pid / VPC, ch = pid % VPC; *(LAS u32x4*)(lds + (buf) * STG + KB + row * VP + ch * 16) = vreg[i]; } } while (0)
#define AT_COMPUTE(bufsel) do { \
        const LAS unsigned char* kb = lds + (bufsel) * STG; const LAS unsigned char* vb = kb + KB; \
        for (int it = 0; it < nit; ++it) { \
            const int key0 = ks * kslice + it * 32; \
            f32x4 S[2][2]; \
            _Pragma("unroll") for (int kt = 0; kt < 2; ++kt) { \
                const int row = key0 + kt * 16 + fr; \
                bf16x8 Kf[NS]; \
                _Pragma("unroll") for (int s_ = 0; s_ < NS; ++s_) Kf[s_] = *(const LAS bf16x8*)(kb + row * 256 + (((4 * s_ + fq) ^ (row & 15)) << 4)); \
                _Pragma("unroll") for (int qt = 0; qt < 2; ++qt) { \
                    f32x4 a = (f32x4){0.f, 0.f, 0.f, 0.f}; \
                    _Pragma("unroll") for (int s_ = 0; s_ < NS; ++s_) a = __builtin_amdgcn_mfma_f32_16x16x32_bf16(Kf[s_], Qf[qt][s_], a, 0, 0, 0); \
                    S[kt][qt] = a; } } \
            bf16x8 Pf[2]; \
            _Pragma("unroll") for (int qt = 0; qt < 2; ++qt) { \
                float pv[8]; float ps = 0.f; \
                _Pragma("unroll") for (int j = 0; j < 4; ++j) { pv[j] = __builtin_amdgcn_exp2f(S[0][qt][j] * 1.44269504f - sh2); pv[4 + j] = __builtin_amdgcn_exp2f(S[1][qt][j] * 1.44269504f - sh2); ps += pv[j] + pv[4 + j]; } \
                l[qt] += ps; \
                u32x4 pk; pk.x = pack2(pv[0], pv[1]); pk.y = pack2(pv[2], pv[3]); pk.z = pack2(pv[4], pv[5]); pk.w = pack2(pv[6], pv[7]); \
                Pf[qt] = __builtin_bit_cast(bf16x8, pk); } \
            _Pragma("unroll") for (int e = 0; e < NE; ++e) { \
                const LAS unsigned char* vp = vb + (key0 + 4 * fq + (fr >> 2)) * VP + (e * 16 + 4 * (fr & 3)) * 2; \
                const bf16x4 v0 = __builtin_amdgcn_ds_read_tr16_b64_v4i16((LAS bf16x4*)vp), v1 = __builtin_amdgcn_ds_read_tr16_b64_v4i16((LAS bf16x4*)(vp + 16 * VP)); \
                bf16x8 Vf; Vf[0] = v0[0]; Vf[1] = v0[1]; Vf[2] = v0[2]; Vf[3] = v0[3]; Vf[4] = v1[0]; Vf[5] = v1[1]; Vf[6] = v1[2]; Vf[7] = v1[3]; \
                _Pragma("unroll") for (int qt = 0; qt < 2; ++qt) O[e][qt] = __builtin_amdgcn_mfma_f32_16x16x32_bf16(Vf, Pf[qt], O[e][qt], 0, 0, 0); } } } while (0)
    const int nst = nkeys / 128;
    constexpr bool TWOSET = DV == 64;
    AT_LOAD(kregA, vregA, 0); if (TWOSET) AT_LOAD(kregB, vregB, 1); AT_WRITE(kregA, vregA, 0);
#pragma unroll
    for (int qt = 0; qt < 2; ++qt)
#pragma unroll
        for (int s_ = 0; s_ < NS; ++s_) asm volatile("" :: "v"(Qf[qt][s_]));
    __syncthreads();
    for (int st = 0; st < nst; st += 2) {
        if (TWOSET) {
            if (st + 2 < nst) AT_LOAD(kregA, vregA, st + 2);
            AT_COMPUTE(0);
            AT_WRITE(kregB, vregB, 1);
            __syncthreads();
            if (st + 3 < nst) AT_LOAD(kregB, vregB, st + 3);
            AT_COMPUTE(1);
            if (st + 2 < nst) AT_WRITE(kregA, vregA, 0);
            __syncthreads();
        } else {
            AT_LOAD(kregA, vregA, st + 1);
            AT_COMPUTE(0);
            AT_WRITE(kregA, vregA, 1);
            __syncthreads();
            if (st + 2 < nst) AT_LOAD(kregA, vregA, st + 2);
            AT_COMPUTE(1);
            if (st + 2 < nst) AT_WRITE(kregA, vregA, 0);
            __syncthreads();
        }
    }
#undef AT_COMPUTE
#undef AT_LOAD
#undef AT_WRITE
    LAS f32x4* Ost = (LAS f32x4*)lds; LAS float* LL = (LAS float*)(lds + 8 * 2 * NE * 1024);
#pragma unroll
    for (int qt = 0; qt < 2; ++qt) {
        float lt = l[qt]; lt += __shfl_xor(lt, 16); lt += __shfl_xor(lt, 32);
        if (fq == 0) LL[(wave * 2 + qt) * 16 + fr] = lt;
#pragma unroll
        for (int e = 0; e < NE; ++e) Ost[((wave * 2 + qt) * NE + e) * 64 + lane] = O[e][qt];
    }
    __syncthreads();
    const int epw = NE / NKS;
#pragma unroll
    for (int qt = 0; qt < 2; ++qt) {
        float L = 0.f;
        for (int j = 0; j < NKS; ++j) L += LL[((j * NQG + qg) * 2 + qt) * 16 + fr];
        const float invL = 1.0f / L;
        for (int ee = 0; ee < epw; ++ee) {
            const int e = ks * epw + ee;
            f32x4 o = (f32x4){0.f, 0.f, 0.f, 0.f};
            for (int j = 0; j < NKS; ++j) o += Ost[(((j * NQG + qg) * 2 + qt) * NE + e) * 64 + lane];
            out(qtok0 + qt * 16 + fr, h * DV + e * 16 + 4 * fq, o * invL);
        }
    }
    __syncthreads();
}
struct AttnOutBf16 { bf16_t* C; int ldc;
    __device__ __forceinline__ void operator()(int tok, int col, f32x4 o) const { u32x2 w; w.x = pack2(o[0], o[1]); w.y = pack2(o[2], o[3]); *(u32x2*)(C + (size_t)tok * ldc + col) = w; } };

__device__ __forceinline__ void attn_unit(int u, int wave, int& ab, int& h, int& q0) {
    if (u < 64) { ab = 16 + (u >> 5); h = (u >> 2) & 7; q0 = (u & 3) * 256 + wave * 32; }
    else { const int v = u - 64; ab = v >> 3; h = v & 7; q0 = wave * 32; }
}

__device__ __forceinline__ void phase_l0_mix(const Frame& F, const PRef& p) {
    unsigned char* ws = p.ws();
    const float* P = (const float*)(ws + WS_P0);
    bf16_t* OB = (bf16_t*)(ws + WS_OB);
    const bf16_t* Q = (const bf16_t*)(ws + WS_Q0); const bf16_t* K = (const bf16_t*)(ws + WS_K0); const bf16_t* VT = (const bf16_t*)(ws + WS_VT0);
    const int lane = F.lane, fr = lane & 15, fq = lane >> 4;
    {
        float gq = 0.f, gk = 0.f;
        for (int i = 0; i < 96; ++i) { gq = fmaxf(gq, fabsf(p.in(24)[i])); gk = fmaxf(gk, fabsf(p.in(25)[i])); }
        const float shift = 9.79795897f * gq * gk;
        AttnOutBf16 ao{OB, 1024};
#ifndef ATT_REP
#define ATT_REP 0
#endif
        for (int rp_ = 0; rp_ < 1 + (ATT_REP == 1); ++rp_) {
            for (int slot = 0; slot * F.G < 512; ++slot) { const int u = F.G == 256 ? attn_unit_xcd(F.bid, slot) : F.bid + slot * F.G; if (u < 512) for (int r2_ = 0; r2_ < 1 + ((ATT_REP == 3 && slot == 0) || (ATT_REP == 4 && slot == 1) ? 3 : 0); ++r2_) attn_block<96, 64, 8>(F, Q, K, VT, ao, u, shift); }
        } }
    {
        LAS unsigned char* L = F.lds;
        constexpr int T64 = 64 * 128, VPI = 288, T128 = 64 * VPI;
        constexpr int O_Q = 0, O_K = T64, O_QF = 2 * T64, O_QB = 3 * T64, O_W = 4 * T64, O_V = 5 * T64, O_SF = O_V + T128, O_SB = O_SF + T128, O_RED = O_SB + T128;
        const float* KVS = (const float*)(ws + WS_KVS);
        const int tid = F.tid, w = F.wave;
        for (int rp_ = 0; rp_ < 1 + (ATT_REP == 2); ++rp_)
        FOR_UNITS(u, 384, 128) {
            int s, c, h, tok0, nc; seq_of_unit384(u, s, c, h, tok0, nc);
            const float lgf = __logf(sigmoidf_(p.in(26)[h])), lgb = __logf(sigmoidf_(p.in(26)[4 + h]));
            {
                const int row = tid >> 3, ch = tid & 7;
                const float* pr = P + (size_t)(tok0 + row) * 2048;
                const f32x4 q0 = *(const f32x4*)(pr + 416 + h * 64 + ch * 8), q1 = *(const f32x4*)(pr + 416 + h * 64 + ch * 8 + 4);
                const f32x4 k0 = *(const f32x4*)(pr + 672 + h * 64 + ch * 8), k1 = *(const f32x4*)(pr + 672 + h * 64 + ch * 8 + 4);
                f32x4 vv[4], sf[4], sb[4];
#pragma unroll
                for (int i = 0; i < 4; ++i) { vv[i] = *(const f32x4*)(pr + 928 + h * 128 + ch * 16 + i * 4);
                    sf[i] = *(const f32x4*)(KVS + (size_t)u * 16384 + row * 128 + ch * 16 + i * 4); sb[i] = *(const f32x4*)(KVS + (size_t)u * 16384 + 8192 + row * 128 + ch * 16 + i * 4); }
                const float df = __expf(lgf * (float)(row + 1)), db = __expf(lgb * (float)(64 - row));
                const int so = row * 128 + ((ch ^ (row & 7)) << 4);
                u32x4 t;
                t.x = pack2(q0[0], q0[1]); t.y = pack2(q0[2], q0[3]); t.z = pack2(q1[0], q1[1]); t.w = pack2(q1[2], q1[3]); *(LAS u32x4*)(L + O_Q + so) = t;
                t.x = pack2(q0[0] * df, q0[1] * df); t.y = pack2(q0[2] * df, q0[3] * df); t.z = pack2(q1[0] * df, q1[1] * df); t.w = pack2(q1[2] * df, q1[3] * df); *(LAS u32x4*)(L + O_QF + so) = t;
                t.x = pack2(q0[0] * db, q0[1] * db); t.y = pack2(q0[2] * db, q0[3] * db); t.z = pack2(q1[0] * db, q1[1] * db); t.w = pack2(q1[2] * db, q1[3] * db); *(LAS u32x4*)(L + O_QB + so) = t;
                t.x = pack2(k0[0] * 0.125f, k0[1] * 0.125f); t.y = pack2(k0[2] * 0.125f, k0[3] * 0.125f); t.z = pack2(k1[0] * 0.125f, k1[1] * 0.125f); t.w = pack2(k1[2] * 0.125f, k1[3] * 0.125f); *(LAS u32x4*)(L + O_K + so) = t;
                const int vo = row * VPI + ch * 32;
#pragma unroll
                for (int i = 0; i < 2; ++i) {
                    t.x = pack2(vv[2 * i][0], vv[2 * i][1]); t.y = pack2(vv[2 * i][2], vv[2 * i][3]); t.z = pack2(vv[2 * i + 1][0], vv[2 * i + 1][1]); t.w = pack2(vv[2 * i + 1][2], vv[2 * i + 1][3]); *(LAS u32x4*)(L + O_V + vo + i * 16) = t;
                    t.x = pack2(sf[2 * i][0], sf[2 * i][1]); t.y = pack2(sf[2 * i][2], sf[2 * i][3]); t.z = pack2(sf[2 * i + 1][0], sf[2 * i + 1][1]); t.w = pack2(sf[2 * i + 1][2], sf[2 * i + 1][3]); *(LAS u32x4*)(L + O_SF + vo + i * 16) = t;
                    t.x = pack2(sb[2 * i][0], sb[2 * i][1]); t.y = pack2(sb[2 * i][2], sb[2 * i][3]); t.z = pack2(sb[2 * i + 1][0], sb[2 * i + 1][1]); t.w = pack2(sb[2 * i + 1][2], sb[2 * i + 1][3]); *(LAS u32x4*)(L + O_SB + vo + i * 16) = t;
                }
            }
            __syncthreads();
            {
                const int jt = w >> 1;
                bf16x8 Kf[2];
#pragma unroll
                for (int ks = 0; ks < 2; ++ks) { const int row = jt * 16 + fr; Kf[ks] = *(const LAS bf16x8*)(L + O_K + row * 128 + (((4 * ks + fq) ^ (row & 7)) << 4)); }
#pragma unroll
                for (int t2 = 0; t2 < 2; ++t2) {
                    const int it = (w & 1) * 2 + t2, irow = it * 16 + fr;
                    f32x4 d = (f32x4){0.f, 0.f, 0.f, 0.f};
#pragma unroll
                    for (int ks = 0; ks < 2; ++ks) { const bf16x8 Qf_ = *(const LAS bf16x8*)(L + O_Q + irow * 128 + (((4 * ks + fq) ^ (irow & 7)) << 4)); d = __builtin_amdgcn_mfma_f32_16x16x32_bf16(Kf[ks], Qf_, d, 0, 0, 0); }
                    float wv[4];
#pragma unroll
                    for (int r = 0; r < 4; ++r) { const int j = jt * 16 + 4 * fq + r; float dec = 0.f; if (j <= irow) dec += __expf(lgf * (float)(irow - j)); if (j >= irow) dec += __expf(lgb * (float)(j - irow)); wv[r] = d[r] * dec; }
                    u32x2 t; t.x = pack2(wv[0], wv[1]); t.y = pack2(wv[2], wv[3]);
                    *(LAS u32x2*)(L + O_W + irow * 128 + (((2 * jt + (fq >> 1)) ^ (irow & 7)) << 4) + (fq & 1) * 8) = t;
                }
            }
            __syncthreads();
            f32x4 acc[4];
#pragma unroll
            for (int it = 0; it < 4; ++it) acc[it] = (f32x4){0.f, 0.f, 0.f, 0.f};
            {
                bf16x8 Af[3][2];
#pragma unroll
                for (int a = 0; a < 3; ++a)
#pragma unroll
                    for (int ks = 0; ks < 2; ++ks) {
                        const LAS unsigned char* vp = L + (a == 0 ? O_V : (a == 1 ? O_SF : O_SB)) + (32 * ks + 8 * fq + (fr >> 2)) * VPI + (w * 16 + 4 * (fr & 3)) * 2;
                        const bf16x4 v0 = __builtin_amdgcn_ds_read_tr16_b64_v4i16((LAS bf16x4*)vp), v1 = __builtin_amdgcn_ds_read_tr16_b64_v4i16((LAS bf16x4*)(vp + 4 * VPI));
                        bf16x8 x; x[0] = v0[0]; x[1] = v0[1]; x[2] = v0[2]; x[3] = v0[3]; x[4] = v1[0]; x[5] = v1[1]; x[6] = v1[2]; x[7] = v1[3];
                        Af[a][ks] = x;
                    }
#pragma unroll
                for (int it = 0; it < 4; ++it) {
                    const int irow = it * 16 + fr;
#pragma unroll
                    for (int ks = 0; ks < 2; ++ks) {
                        const int so = irow * 128 + (((4 * ks + fq) ^ (irow & 7)) << 4);
                        const bf16x8 bw = *(const LAS bf16x8*)(L + O_W + so), bqf = *(const LAS bf16x8*)(L + O_QF + so), bqb = *(const LAS bf16x8*)(L + O_QB + so);
                        acc[it] = __builtin_amdgcn_mfma_f32_16x16x32_bf16(Af[0][ks], bw, acc[it], 0, 0, 0);
                        acc[it] = __builtin_amdgcn_mfma_f32_16x16x32_bf16(Af[1][ks], bqf, acc[it], 0, 0, 0);
                        acc[it] = __builtin_amdgcn_mfma_f32_16x16x32_bf16(Af[2][ks], bqb, acc[it], 0, 0, 0);
                    }
                }
            }
            LAS float* red = (LAS float*)(L + O_RED);
#pragma unroll
            for (int it = 0; it < 4; ++it) {
                float ss = acc[it][0] * acc[it][0] + acc[it][1] * acc[it][1] + acc[it][2] * acc[it][2] + acc[it][3] * acc[it][3];
                ss += __shfl_xor(ss, 16); ss += __shfl_xor(ss, 32);
                if (fq == 0) red[w * 64 + it * 16 + fr] = ss;
            }
            __syncthreads();
            {
                const f32x4 gn = *(const f32x4*)(p.in(27) + h * 128 + w * 16 + 4 * fq);
#pragma unroll
                for (int it = 0; it < 4; ++it) {
                    const int i = it * 16 + fr, tok = tok0 + i;
                    float ss = 0.f;
#pragma unroll
                    for (int q = 0; q < 8; ++q) ss += red[q * 64 + i];
                    const float rstd = rsqrtf(ss * (1.0f / 128.0f) + EPS);
                    const f32x4 rg = *(const f32x4*)(P + (size_t)tok * 2048 + 1440 + h * 128 + w * 16 + 4 * fq);
                    u32x2 t; t.x = pack2(siluf_(rg[0]) * acc[it][0] * rstd * gn[0], siluf_(rg[1]) * acc[it][1] * rstd * gn[1]);
                    t.y = pack2(siluf_(rg[2]) * acc[it][2] * rstd * gn[2], siluf_(rg[3]) * acc[it][3] * rstd * gn[3]);
                    *(u32x2*)(OB + (size_t)tok * 1024 + 512 + h * 128 + w * 16 + 4 * fq) = t;
                }
            }
            __syncthreads();
        }
    }
}

__device__ __forceinline__ void phase_gate(const Frame& F, const PRef& p, int l) {
    const bf16_t* U = (const bf16_t*)(p.ws() + WS_U); bf16_t* ACT = (bf16_t*)(p.ws() + WS_ACT);
    const float* cw = p.in(16) + (size_t)l * 3 * 5632; const float* cb = p.in(17) + (size_t)l * 5632;
    const int gt = F.bid * NTHREADS + F.tid, ngt = F.G * NTHREADS;
    const int cg = gt % 352, tslot = gt / 352, nslot = ngt / 352;
    if (tslot >= nslot) return;
    const int c0 = cg * 8;
    float w0[2][8], w1[2][8], w2[2][8], bb[2][8];
#pragma unroll
    for (int half = 0; half < 2; ++half) {
        const int col = c0 + half * 2816;
#pragma unroll
        for (int q = 0; q < 2; ++q) {
            const f32x4 a = *(const f32x4*)(cw + col + q * 4), b = *(const f32x4*)(cw + 5632 + col + q * 4), c = *(const f32x4*)(cw + 2 * 5632 + col + q * 4), d = *(const f32x4*)(cb + col + q * 4);
#pragma unroll
            for (int j = 0; j < 4; ++j) { w0[half][q * 4 + j] = a[j]; w1[half][q * 4 + j] = b[j]; w2[half][q * 4 + j] = c[j]; bb[half][q * 4 + j] = d[j]; }
        }
    }
    bf16x8 cx[2][3], nx[2][3];
#define GATE_LOAD(dst, tok_) do { const int t_ = (tok_) < NCTX ? ((tok_) & 255) : (((tok_) - NCTX) & 1023), n_ = (tok_) < NCTX ? 256 : 1024; \
        const bf16x8 z_ = (bf16x8){0, 0, 0, 0, 0, 0, 0, 0}; \
        _Pragma("unroll") for (int half = 0; half < 2; ++half) { const bf16_t* up_ = U + (size_t)(tok_) * 5632 + c0 + half * 2816; \
            dst[half][1] = *(const bf16x8*)up_; dst[half][0] = t_ > 0 ? *(const bf16x8*)(up_ - 5632) : z_; dst[half][2] = t_ < n_ - 1 ? *(const bf16x8*)(up_ + 5632) : z_; } } while (0)
    if (tslot < NTOK) GATE_LOAD(cx, tslot);
    for (int tok = tslot; tok < NTOK; tok += nslot) {
        if (tok + nslot < NTOK) GATE_LOAD(nx, tok + nslot);
        float u2[2][8];
#pragma unroll
        for (int half = 0; half < 2; ++half)
#pragma unroll
            for (int j = 0; j < 8; ++j)
                u2[half][j] = bf2f((unsigned short)cx[half][0][j]) * w0[half][j] + bf2f((unsigned short)cx[half][1][j]) * w1[half][j] + bf2f((unsigned short)cx[half][2][j]) * w2[half][j] + bb[half][j];
        u32x4 w;
        w.x = pack2(siluf_(u2[0][0]) * u2[1][0], siluf_(u2[0][1]) * u2[1][1]); w.y = pack2(siluf_(u2[0][2]) * u2[1][2], siluf_(u2[0][3]) * u2[1][3]);
        w.z = pack2(siluf_(u2[0][4]) * u2[1][4], siluf_(u2[0][5]) * u2[1][5]); w.w = pack2(siluf_(u2[0][6]) * u2[1][6], siluf_(u2[0][7]) * u2[1][7]);
        *(u32x4*)(ACT + (size_t)tok * 2816 + c0) = w;
#pragma unroll
        for (int half = 0; half < 2; ++half)
#pragma unroll
            for (int q = 0; q < 3; ++q) cx[half][q] = nx[half][q];
    }
#undef GATE_LOAD
}

__device__ __forceinline__ void phase_l1_tok(const Frame& F, const PRef& p) {
    unsigned char* ws = p.ws();
    const float* P = (const float*)(ws + WS_P1);
    bf16_t* QD = (bf16_t*)(ws + WS_QD); bf16_t* KD = (bf16_t*)(ws + WS_KD); bf16_t* VDT = (bf16_t*)(ws + WS_VDT);
    float* RR = (float*)(ws + WS_RR); float* KR = (float*)(ws + WS_KR); float* VV = (float*)(ws + WS_VV); float* KK = (float*)(ws + WS_KK);
    bf16_t* TW = (bf16_t*)(ws + WS_TW); bf16_t* AD = (bf16_t*)(ws + WS_AD); bf16_t* SG = (bf16_t*)(ws + WS_SG);
    const int nw = F.G * 8, lane = F.lane;
    const float* mu = p.in(33);
    for (int row = F.bid * 8 + F.wave; row < NKROW; row += nw) {
        const bool istok = row < NTOK, lat = istok && row >= NCTX;
        int kr;
        if (row < NCTX) kr = row; else if (row < NTOK) { const int v = row - NCTX; kr = NCTX + (v >> 10) * 1536 + (v & 1023); }
        else { const int i = row - NTOK; kr = NCTX + (i >> 9) * 1536 + 1024 + (i & 511); }
        if (!istok) {
            const int i = row - NTOK;
#pragma unroll
            for (int j = 0; j < 8; ++j) {
                const int col = j * 64 + lane;
                KD[(size_t)kr * 512 + col] = f2bf(p.in(5)[(size_t)i * 512 + col]);
                VDT[(size_t)kr * 512 + col] = f2bf(p.in(6)[(size_t)i * 512 + col]);
            }
            continue;
        }
        const float* pr = P + (size_t)row * 3584;
        float cs = 1.f, sn = 0.f;
        if (lat) {
            const int t = (row - NCTX) & 1023, a = lane & 31;
            const float pos = a < 16 ? (float)(t >> 6) : (float)(t & 63);
            const float inv = __powf(10000.0f, -(float)(a & 15) * 0.0625f);
            const float ang = pos * inv; cs = __cosf(ang); sn = __sinf(ang);
        }
        {
            const int pi = lane & 31;
            f32x2 qv[4], kv[4];
#pragma unroll
            for (int pass = 0; pass < 4; ++pass) { const int vec = pass * 2 + (lane >> 5); qv[pass] = *(const f32x2*)(pr + vec * 64 + 2 * pi); kv[pass] = *(const f32x2*)(pr + 512 + vec * 64 + 2 * pi); }
            const f32x2 gq = *(const f32x2*)(p.in(29) + 2 * pi), gk = *(const f32x2*)(p.in(30) + 2 * pi);
#pragma unroll
            for (int pass = 0; pass < 4; ++pass) {
                const int vec = pass * 2 + (lane >> 5);
                {
                    const f32x2 v = qv[pass];
                    const float rstd = rsqrtf(half_sum(v[0] * v[0] + v[1] * v[1], lane) * (1.0f / 64.0f) + EPS);
                    const float x1 = v[0] * rstd * gq[0], x2 = v[1] * rstd * gq[1];
                    *(unsigned*)(QD + (size_t)row * 512 + vec * 64 + 2 * pi) = pack2((x1 * cs - x2 * sn) * 0.125f, (x1 * sn + x2 * cs) * 0.125f);
                }
                {
                    const f32x2 v = kv[pass];
                    const float rstd = rsqrtf(half_sum(v[0] * v[0] + v[1] * v[1], lane) * (1.0f / 64.0f) + EPS);
                    const float x1 = v[0] * rstd * gk[0], x2 = v[1] * rstd * gk[1];
                    if (row < NCTX) *(f32x2*)(p.out() + OUT_DK + (size_t)row * 512 + vec * 64 + 2 * pi) = (f32x2){x1, x2};
                    *(unsigned*)(KD + (size_t)kr * 512 + vec * 64 + 2 * pi) = pack2(x1 * cs - x2 * sn, x1 * sn + x2 * cs);
                }
            }
        }
#pragma unroll
        for (int j = 0; j < 8; ++j) {
            const int col = j * 64 + lane; const float v = pr[1024 + col];
            if (row < NCTX) p.out()[OUT_DV + (size_t)row * 512 + col] = v;
            VDT[(size_t)kr * 512 + col] = f2bf(v);
        }
        const int t = row < NCTX ? (row & 255) : ((row - NCTX) & 1023), n = row < NCTX ? 256 : 1024;
        const bool hp = t > 0, hn = t < n - 1;
        const float* pp = pr + 1536;
        const float* pn = pp + 3584; const float* pv = pp - 3584;
#define SHIFT4(col) ({ const f32x4 _c = *(const f32x4*)(pp + (col)); const f32x4 _p = hp ? *(const f32x4*)(pv + (col)) : (f32x4){0.f, 0.f, 0.f, 0.f}; \
            const f32x4 _n = hn ? *(const f32x4*)(pn + (col)) : (f32x4){0.f, 0.f, 0.f, 0.f}; const f32x4 _m = *(const f32x4*)(mu + (col)); _c + (0.5f * (_p + _n) - _c) * _m; })
        {
            const size_t o = (size_t)row * 512 + lane * 8;
            const f32x4 r0 = SHIFT4(lane * 8), r1 = SHIFT4(lane * 8 + 4);
            *(f32x4*)(RR + o) = r0; *(f32x4*)(RR + o + 4) = r1;
            const f32x4 k0 = SHIFT4(512 + lane * 8), k1 = SHIFT4(512 + lane * 8 + 4);
            *(f32x4*)(KR + o) = k0; *(f32x4*)(KR + o + 4) = k1;
            const f32x4 v0 = SHIFT4(1024 + lane * 8), v1 = SHIFT4(1024 + lane * 8 + 4);
            *(f32x4*)(VV + o) = v0; *(f32x4*)(VV + o + 4) = v1;
            const f32x4 kk0 = k0 * *(const f32x4*)(p.in(39) + lane * 8), kk1 = k1 * *(const f32x4*)(p.in(39) + lane * 8 + 4);
            float ss = (kk0[0] * kk0[0] + kk0[1] * kk0[1]) + (kk0[2] * kk0[2] + kk0[3] * kk0[3]) + (kk1[0] * kk1[0] + kk1[1] * kk1[1]) + (kk1[2] * kk1[2] + kk1[3] * kk1[3]);
            ss = oct_sum(ss);
            const float rn = rsqrtf(ss + EPS);
            *(f32x4*)(KK + o) = kk0 * rn; *(f32x4*)(KK + o + 4) = kk1 * rn;
        }
        {
            const f32x4 a = SHIFT4(1536 + lane * 4);
            u32x2 w;
            if (lane < 32) { w.x = pack2(tanhf_(a[0]), tanhf_(a[1])); w.y = pack2(tanhf_(a[2]), tanhf_(a[3])); *(u32x2*)(TW + (size_t)row * 128 + lane * 4) = w; }
            else { w.x = pack2(a[0], a[1]); w.y = pack2(a[2], a[3]); *(u32x2*)(AD + (size_t)row * 128 + (lane - 32) * 4) = w; }
            if (lane < 32) { const f32x4 g = SHIFT4(1792 + lane * 4); w.x = pack2(sigmoidf_(g[0]), sigmoidf_(g[1])); w.y = pack2(sigmoidf_(g[2]), sigmoidf_(g[3])); *(u32x2*)(SG + (size_t)row * 128 + lane * 4) = w; }
        }
#define SHIFTED(col) 0
#undef SHIFTED
    }
}

constexpr int SC_T = 16;
constexpr int SC_BUF = 2 * SC_T * 6 * 64;
__device__ __forceinline__ void phase_l1_mix(const Frame& F, const PRef& p) {
    unsigned char* ws = p.ws();
    const bf16_t* Q = (const bf16_t*)(ws + WS_QD); const bf16_t* K = (const bf16_t*)(ws + WS_KD); const bf16_t* VT = (const bf16_t*)(ws + WS_VDT);
    AttnOutBf16 ao{(bf16_t*)(ws + WS_DO), 1024};
    float gq = 0.f, gk = 0.f;
    for (int i = 0; i < 64; ++i) { gq = fmaxf(gq, fabsf(p.in(29)[i])); gk = fmaxf(gk, fabsf(p.in(30)[i])); }
    const float shift = 8.0f * gq * gk;
    for (int slot = 0; slot * F.G < 512; ++slot) { const int u = F.G == 256 ? attn_unit_xcd(F.bid, slot) : F.bid + slot * F.G; if (u < 512) attn_block<64, 128, 4>(F, Q, K, VT, ao, u, shift); }
}

__device__ __forceinline__ float dpp_xor1(float x) { return __int_as_float(__builtin_amdgcn_update_dpp(0, __float_as_int(x), 0xB1, 0xF, 0xF, true)); }
__device__ __forceinline__ float dpp_xor2(float x) { return __int_as_float(__builtin_amdgcn_update_dpp(0, __float_as_int(x), 0x4E, 0xF, 0xF, true)); }
#define VFMA(d, a, b, c) asm("v_fma_f32 %0, %1, %2, %3" : "=v"(d) : "v"(a), "v"(b), "v"(c))
#define VFMAN(d, a, b, c) asm("v_fma_f32 %0, -%1, %2, %3" : "=v"(d) : "v"(a), "v"(b), "v"(c))
#define VMUL(d, a, b) asm("v_mul_f32 %0, %1, %2" : "=v"(d) : "v"(a), "v"(b))
#define VADD(d, a, b) asm("v_add_f32 %0, %1, %2" : "=v"(d) : "v"(a), "v"(b))
#define QUAD_SUM_ASM(x) asm("s_nop 1\n\tv_add_f32_dpp %0, %0, %0 quad_perm:[1,0,3,2] row_mask:0xf bank_mask:0xf bound_ctrl:1\n\ts_nop 1\n\t" \
    "v_add_f32_dpp %0, %0, %0 quad_perm:[2,3,0,1] row_mask:0xf bank_mask:0xf bound_ctrl:1" : "+v"(x))
#define ROW16_SUM_ASM(x) asm("s_nop 1\n\tv_add_f32_dpp %0, %0, %0 quad_perm:[1,0,3,2] row_mask:0xf bank_mask:0xf bound_ctrl:1\n\ts_nop 1\n\t" \
    "v_add_f32_dpp %0, %0, %0 quad_perm:[2,3,0,1] row_mask:0xf bank_mask:0xf bound_ctrl:1\n\ts_nop 1\n\t" \
    "v_add_f32_dpp %0, %0, %0 row_half_mirror row_mask:0xf bank_mask:0xf bound_ctrl:1\n\ts_nop 1\n\t" \
    "v_add_f32_dpp %0, %0, %0 row_mirror row_mask:0xf bank_mask:0xf bound_ctrl:1" : "+v"(x))
constexpr int SREC = 400;
template <int KPL> struct ScanVecs { f32x4 w[KPL / 4], kka[KPL / 4], kd[KPL / 4], kk[KPL / 4], r[KPL / 4]; float v, c1, c2; };
template <int KPL>
__device__ __forceinline__ void scan_load(ScanVecs<KPL>& x, const LAS float* v6, int koff, int row) {
#pragma unroll
    for (int q = 0; q < KPL / 4; ++q) {
        x.w[q] = *(const LAS f32x4*)(v6 + 0 * 64 + koff + q * 4); x.kka[q] = *(const LAS f32x4*)(v6 + 1 * 64 + koff + q * 4); x.kd[q] = *(const LAS f32x4*)(v6 + 2 * 64 + koff + q * 4);
        x.kk[q] = *(const LAS f32x4*)(v6 + 3 * 64 + koff + q * 4); x.r[q] = *(const LAS f32x4*)(v6 + 4 * 64 + koff + q * 4);
    }
    x.v = v6[5 * 64 + row]; x.c1 = v6[384]; x.c2 = v6[385];
}
template <int MODE>
__device__ __forceinline__ void scan_unit(const Frame& F, const PRef& p, int unit) {
    constexpr int T = 32, NSTEPS = MODE == 0 ? 1024 : 256, BUF = T * SREC, NCHUNK = NSTEPS / T;
    constexpr int KPL = MODE == 0 ? 4 : 16, NQ = KPL / 4;
    unsigned char* ws = p.ws();
    const float* RR = (const float*)(ws + WS_RR); const float* KR = (const float*)(ws + WS_KR); const float* VV = (const float*)(ws + WS_VV); const float* KK = (const float*)(ws + WS_KK);
    const float* DEC = (const float*)(ws + WS_DEC); const float* AA = (const float*)(ws + WS_AA);
    float* YY = (float*)(ws + WS_YY);
    const float* k_a = p.in(40);
    LAS float* sb = (LAS float*)F.lds;
    const int lane = F.lane;
    const bool loader = F.wave >= 4;
    const bool compute = F.wave < 4;
    const int cid = MODE == 0 ? (unit >> 2) : unit;
    const int cb = cid >> 4, chh = (cid >> 1) & 7, cd = cid & 1;
    const int cbase = MODE == 0 ? NCTX + cb * 1024 : cb * 256;
    if (loader) {
        const int lt = F.tid - 256;
        f32x4 pa[2][6], pb[2][6];
        const f32x4 ka4 = *(const f32x4*)(k_a + chh * 64 + (lt & 15) * 4), rk4 = *(const f32x4*)(p.in(41) + chh * 64 + (lt & 15) * 4);
        float* BON = (float*)(ws + WS_BON) + (size_t)cd * NTOK * 8 + chh;
        const bool wbon = MODE == 1 || (unit & 3) == 0;
#define SC_LOAD(pre, chunk) do { _Pragma("unroll") for (int it = 0; it < 2; ++it) { const int item = it * 256 + lt; const int stp = item >> 4, k = (item & 15) * 4; \
            const int j_ = (chunk) * T + stp; const int tok = cbase + (cd ? NSTEPS - 1 - j_ : j_); const size_t o_ = (size_t)tok * 512 + chh * 64 + k; \
            pre[it][0] = *(const f32x4*)(DEC + (size_t)cd * NTOK * 512 + o_); pre[it][1] = *(const f32x4*)(AA + (size_t)cd * NTOK * 512 + o_); pre[it][2] = *(const f32x4*)(KR + o_); \
            pre[it][3] = *(const f32x4*)(KK + o_); pre[it][4] = *(const f32x4*)(RR + o_); pre[it][5] = *(const f32x4*)(VV + o_); } } while (0)
#define SC_WRITE(pre, buf, chunk) do { _Pragma("unroll") for (int it = 0; it < 2; ++it) { const int item = it * 256 + lt; const int stp = item >> 4, k = (item & 15) * 4; \
            const f32x4 a_ = pre[it][1], kk_ = pre[it][3], r_ = pre[it][4], w_ = pre[it][0]; LAS float* d_ = sb + (buf) * BUF + stp * SREC + k; \
            const f32x4 bb_ = kk_ * a_, kd_ = pre[it][2] * (1.0f + (a_ - 1.0f) * ka4); \
            *(LAS f32x4*)(d_) = w_; *(LAS f32x4*)(d_ + 64) = bb_; *(LAS f32x4*)(d_ + 128) = kd_; *(LAS f32x4*)(d_ + 192) = kk_; \
            *(LAS f32x4*)(d_ + 256) = w_ * r_; *(LAS f32x4*)(d_ + 320) = pre[it][5]; \
            const f32x4 p1_ = bb_ * r_, p2_ = kd_ * r_; const float c1_ = row16_sum((p1_[0] + p1_[1]) + (p1_[2] + p1_[3])), c2_ = row16_sum((p2_[0] + p2_[1]) + (p2_[2] + p2_[3])); \
            const f32x4 p3_ = p2_ * rk4; const float c3_ = row16_sum((p3_[0] + p3_[1]) + (p3_[2] + p3_[3])); \
            if ((lt & 15) == 0) { LAS float* e_ = sb + (buf) * BUF + stp * SREC + 384; e_[0] = c1_; e_[1] = c2_; \
                if (wbon) { const int j2_ = (chunk) * T + stp; BON[(size_t)(cbase + (cd ? NSTEPS - 1 - j2_ : j2_)) * 8] = c3_; } } } } while (0)
        SC_LOAD(pa, 0); SC_LOAD(pb, 1); SC_WRITE(pa, 0, 0); SC_LOAD(pa, 2);
        __syncthreads();
        for (int cnk = 0; cnk < NCHUNK; cnk += 2) {
            if (cnk + 1 < NCHUNK) { SC_WRITE(pb, (cnk + 1) & 1, cnk + 1); if (cnk + 3 < NCHUNK) SC_LOAD(pb, cnk + 3); }
            __syncthreads();
            if (cnk + 2 < NCHUNK) { SC_WRITE(pa, (cnk + 2) & 1, cnk + 2); if (cnk + 4 < NCHUNK) SC_LOAD(pa, cnk + 4); }
            __syncthreads();
        }
#undef SC_LOAD
#undef SC_WRITE
    } else if (compute) {
        const int row = MODE == 0 ? (unit & 3) * 16 + F.wave * 4 + (lane >> 4) : F.wave * 16 + (lane >> 2);
        const int kq = MODE == 0 ? (lane & 15) : (lane & 3), koff = kq * KPL;
        f32x4 S[NQ];
        if (MODE == 0) {
            const float* s0 = p.in(7) + (size_t)(((cb * 2 + cd) * 8 + chh) * 64 + row) * 64 + koff;
#pragma unroll
            for (int q = 0; q < NQ; ++q) S[q] = *(const f32x4*)(s0 + q * 4);
        } else {
#pragma unroll
            for (int q = 0; q < NQ; ++q) S[q] = (f32x4){0.f, 0.f, 0.f, 0.f};
        }
        __syncthreads();
        float* yp = YY + (size_t)cd * NTOK * 512 + chh * 64 + row;
        for (int cnk = 0; cnk < NCHUNK; ++cnk) {
            const LAS float* bufp = sb + (cnk & 1) * BUF;
            ScanVecs<KPL> cur, nxt;
            scan_load<KPL>(cur, bufp, koff, row);
#pragma unroll 2
            for (int stp = 0; stp < T; ++stp) {
                scan_load<KPL>(nxt, bufp + (stp + 1 < T ? stp + 1 : stp) * SREC, koff, row);
                const int j_ = cnk * T + stp; const int tok = cbase + (cd ? NSTEPS - 1 - j_ : j_);
                f32x4 a4 = S[0] * cur.kk[0], y4 = S[0] * cur.r[0];
#pragma unroll
                for (int q = 1; q < NQ; ++q) { a4 = a4 + S[q] * cur.kk[q]; y4 = y4 + S[q] * cur.r[q]; }
                float sa = (a4[0] + a4[1]) + (a4[2] + a4[3]), ys = (y4[0] + y4[1]) + (y4[2] + y4[3]);
                if (MODE == 0) {
                    sa += DPPF(sa, 0xB1); ys += DPPF(ys, 0xB1); sa += DPPF(sa, 0x4E); ys += DPPF(ys, 0x4E);
                    sa += DPPF(sa, 0x141); ys += DPPF(ys, 0x141); sa += DPPF(sa, 0x140); ys += DPPF(ys, 0x140);
                } else { sa += DPPF(sa, 0xB1); ys += DPPF(ys, 0xB1); sa += DPPF(sa, 0x4E); ys += DPPF(ys, 0x4E); }
                const float vr = cur.v;
#pragma unroll
                for (int q = 0; q < NQ; ++q) S[q] = S[q] * cur.w[q] + (vr * cur.kd[q] - sa * cur.kka[q]);
                if (kq == 0) yp[(size_t)tok * 512] = ys - sa * cur.c1 + vr * cur.c2;
                cur = nxt;
            }
            __syncthreads();
        }
        if (MODE == 1) {
            float* so = p.out() + OUT_SRWKV + (size_t)(((cb * 2 + cd) * 8 + chh) * 64 + row) * 64 + koff;
#pragma unroll
            for (int q = 0; q < NQ; ++q) *(f32x4*)(so + q * 4) = S[q];
        }
    } else {
        __syncthreads();
        for (int cnk = 0; cnk < NCHUNK; ++cnk) __syncthreads();
    }
}
constexpr int CI_AP = 0, CI_RH = 2304, CI_BT = 4608, CI_KT = 7168, CI_MP = 9728, CI_PP = 10368, CI_GL = 11520, CI_VT = 11776, CI_SZ = 14336;
constexpr int CS_AH = 0, CS_BH = 2304, CS_KH = 4608, CS_SZ = 6912;
constexpr int CS_NM = CS_BH, CS_TM = CS_BH + 1024, CS_MM = CS_BH + 2048;
constexpr int CIMG0 = 0, CSCR0 = 8 * CI_SZ;
static_assert(CSCR0 + 4 * CS_SZ <= LDS_BYTES - LDS_WORK, "chunked scan LDS");
constexpr size_t WS_GIMG = WS_HB;
static_assert((size_t)32 * 12 * 4 * CI_SZ <= (size_t)2 * NTOK * 1024 * 2, "hand-off images do not fit HB + OB");
constexpr int SCAN_FLAG_WORD = 3584;
template <int MODE, int ROLE>
__device__ __forceinline__ void scanc_unit(const Frame& F, const PRef& p, int cid, int hid = 0) {
    constexpr int NSTEPS = MODE == 0 ? 1024 : 256, NCH = NSTEPS / 16, NG = NCH / 4;
    unsigned char* ws = p.ws();
    const float* RR = (const float*)(ws + WS_RR); const float* KR = (const float*)(ws + WS_KR); const float* VV = (const float*)(ws + WS_VV); const float* KK = (const float*)(ws + WS_KK);
    const float* DEC = (const float*)(ws + WS_DEC); const float* AA = (const float*)(ws + WS_AA);
    float* YY = (float*)(ws + WS_YY);
    LAS unsigned char* L = F.lds;
    const int lane = F.lane, fr = lane & 15, g = lane >> 4, w = F.wave;
    const int cb = cid >> 4, chh = (cid >> 1) & 7, cd = cid & 1;
    const int cbase = MODE == 0 ? NCTX + cb * 1024 : cb * 256;
#define TOK_OF(step) (cbase + (cd ? NSTEPS - 1 - (step) : (step)))
    unsigned* hflag = (unsigned*)(ws + WS_BAR) + SCAN_FLAG_WORD + cid * 16;
    unsigned char* gimg = ws + WS_GIMG + (size_t)cid * 12 * 4 * CI_SZ;
    const __amdgpu_buffer_rsrc_t grs = wt_rsrc(gimg, (size_t)12 * 4 * CI_SZ);
    if (w >= 4 || ROLE == 2) {
        if (ROLE == 2 && w < 4) {
            for (int grp = hid; grp < NG; grp += 4) {
                const int og = grp - (grp >> 2) - 1;
                __syncthreads();
                for (int i = F.tid; i < 4 * CI_SZ / 16; i += NTHREADS) wt_store16(grs, (size_t)og * 4 * CI_SZ + (size_t)i * 16, *(const LAS u32x4*)(L + CIMG0 + (size_t)i * 16));
                asm volatile("s_waitcnt vmcnt(0)" ::: "memory");
                __syncthreads();
                if (F.tid == 0) __hip_atomic_store(hflag + grp, 1u, __ATOMIC_RELAXED, __HIP_MEMORY_SCOPE_AGENT);
                __syncthreads();
            }
            return;
        }
        const int j = w - 4, k = lane;
        LAS unsigned char* SC = L + CSCR0 + j * CS_SZ;
        const float ka = p.in(40)[chh * 64 + k];
        const size_t colo = (size_t)chh * 64 + k;
        const float* decp = DEC + (size_t)cd * NTOK * 512; const float* aap = AA + (size_t)cd * NTOK * 512;
        float rw[16], rkk[16], ra[16], rkr[16], rr[16], rv[16];
#define PREP_LOAD(chunk) do { _Pragma("unroll") for (int t = 0; t < 16; ++t) { const size_t o_ = (size_t)TOK_OF((chunk) * 16 + t) * 512 + colo; \
            rw[t] = decp[o_]; rkk[t] = KK[o_]; ra[t] = aap[o_]; rkr[t] = KR[o_]; rr[t] = RR[o_]; rv[t] = VV[o_]; } } while (0)
        PREP_LOAD(ROLE == 2 ? hid * 4 + j : j);
        for (int grp = (ROLE == 2 ? hid : 0); grp < NG; grp += (ROLE == 2 ? 4 : 1)) {
            LAS unsigned char* IM = L + CIMG0 + ((ROLE == 2 ? 0 : (grp & 1) * 4) + j) * CI_SZ;
            if (ROLE == 1 && (grp & 3)) {
                if (lane == 0) { unsigned sp = 0; while (__hip_atomic_load(hflag + grp, __ATOMIC_RELAXED, __HIP_MEMORY_SCOPE_AGENT) == 0u && ++sp < (1u << 22)) __builtin_amdgcn_s_sleep(2); }
                asm volatile("" ::: "memory");
                for (int i = lane; i < CI_SZ / 16; i += 64)
                    *(LAS u32x4*)(IM + (size_t)i * 16) = __builtin_bit_cast(u32x4, __builtin_amdgcn_raw_buffer_load_b128(grs, (int)(((size_t)(grp - (grp >> 2) - 1) * 4 + j) * CI_SZ + (size_t)i * 16), 0, 16));
                __syncthreads();
                continue;
            }
            float ah[16]; float G = 1.0f;
#pragma unroll
            for (int t2 = 0; t2 < 8; ++t2) {
                float bh2[2], kh2[2];
#pragma unroll
                for (int u = 0; u < 2; ++u) {
                    const int t = 2 * t2 + u;
                    const float bb = rkk[t] * ra[t], kd = rkr[t] * (1.0f + (ra[t] - 1.0f) * ka);
                    ah[t] = -rkk[t] * G;
                    G *= rw[t];
                    const float inv = __builtin_amdgcn_rcpf(G);
                    const float bh = bb * inv, kh = kd * inv, rh = rr[t] * G;
                    bh2[u] = bh; kh2[u] = kh;
                    *(LAS bf16_t*)(SC + CS_AH + t * 144 + k * 2) = f2bf(ah[t]);
                    *(LAS bf16_t*)(SC + CS_BH + t * 144 + k * 2) = f2bf(bh);
                    *(LAS bf16_t*)(SC + CS_KH + t * 144 + k * 2) = f2bf(kh);
                    *(LAS bf16_t*)(IM + CI_RH + t * 144 + k * 2) = f2bf(rh);
                }
                *(LAS unsigned*)(IM + CI_BT + k * 40 + t2 * 4) = pack2(bh2[0], bh2[1]);
                *(LAS unsigned*)(IM + CI_KT + k * 40 + t2 * 4) = pack2(kh2[0], kh2[1]);
                *(LAS unsigned*)(IM + CI_VT + k * 40 + t2 * 4) = pack2(rv[2 * t2], rv[2 * t2 + 1]);
            }
            *(LAS float*)(IM + CI_GL + k * 4) = G;
            { const int ng_ = grp + (ROLE == 0 ? 1 : 4); if (ng_ < NG) PREP_LOAD(ng_ * 4 + j); }
            f32x4 dN = (f32x4){0.f, 0.f, 0.f, 0.f}, dM = dN, dPb = dN, dPk = dN;
#pragma unroll
            for (int s = 0; s < 2; ++s) {
                const int fo = fr * 144 + (4 * s + g) * 16;
                const bf16x8 fa = *(const LAS bf16x8*)(SC + CS_AH + fo), fb = *(const LAS bf16x8*)(SC + CS_BH + fo), fk = *(const LAS bf16x8*)(SC + CS_KH + fo), frh = *(const LAS bf16x8*)(IM + CI_RH + fo);
                dN = __builtin_amdgcn_mfma_f32_16x16x32_bf16(fa, fb, dN, 0, 0, 0); dM = __builtin_amdgcn_mfma_f32_16x16x32_bf16(fa, fk, dM, 0, 0, 0);
                dPb = __builtin_amdgcn_mfma_f32_16x16x32_bf16(frh, fb, dPb, 0, 0, 0); dPk = __builtin_amdgcn_mfma_f32_16x16x32_bf16(frh, fk, dPk, 0, 0, 0);
            }
#pragma unroll
            for (int r = 0; r < 4; ++r) {
                const int t = 4 * g + r;
                *(LAS float*)(SC + CS_MM + (t * 16 + fr) * 4) = fr < t ? dM[r] : 0.f;
                *(LAS bf16_t*)(IM + CI_PP + t * 72 + fr * 2) = f2bf(fr <= t ? dPb[r] : 0.f);
                *(LAS bf16_t*)(IM + CI_PP + t * 72 + (16 + fr) * 2) = f2bf(fr <= t ? dPk[r] : 0.f);
            }
            float Tc[16];
            Tc[0] = fr == 0 ? 1.0f : 0.f;
#pragma unroll
            for (int i = 1; i < 16; ++i) {
                float s0_ = fr == i ? 1.0f : 0.f, s1_ = 0.f;
#pragma unroll
                for (int jj = 0; jj < i; ++jj) {
                    const float nij = RDLANE(dN[i & 3], jj + 16 * (i >> 2));
                    if (jj & 1) s1_ += nij * Tc[jj]; else s0_ += nij * Tc[jj];
                }
                Tc[i] = s0_ + s1_;
            }
            if (g == 0) {
#pragma unroll
                for (int i = 0; i < 16; ++i) *(LAS float*)(SC + CS_TM + (i * 16 + fr) * 4) = Tc[i];
            }
#pragma unroll
            for (int i = 0; i < 16; ++i) {
                float s0_ = 0.f, s1_ = 0.f;
#pragma unroll
                for (int jj = 0; jj <= i; ++jj) { const float tij = RDLANE(Tc[i], jj); if (jj & 1) s1_ += tij * ah[jj]; else s0_ += tij * ah[jj]; }
                *(LAS bf16_t*)(IM + CI_AP + i * 144 + k * 2) = f2bf(s0_ + s1_);
            }
            {
                const int i = lane >> 2, j4 = (lane & 3) * 4;
                f32x4 macc = (f32x4){0.f, 0.f, 0.f, 0.f};
#pragma unroll
                for (int t = 0; t < 16; ++t) macc += *(const LAS f32x4*)(SC + CS_MM + (t * 16 + j4) * 4) * *(const LAS float*)(SC + CS_TM + (i * 16 + t) * 4);
                u32x2 pk; pk.x = pack2(macc[0], macc[1]); pk.y = pack2(macc[2], macc[3]);
                *(LAS u32x2*)(IM + CI_MP + i * 40 + j4 * 2) = pk;
            }
            if (ROLE == 2) {
                const int og = grp - (grp >> 2) - 1;
                __syncthreads();
                for (int i = F.tid; i < 4 * CI_SZ / 16; i += NTHREADS) wt_store16(grs, (size_t)og * 4 * CI_SZ + (size_t)i * 16, *(const LAS u32x4*)(L + CIMG0 + (size_t)i * 16));
                asm volatile("s_waitcnt vmcnt(0)" ::: "memory");
                __syncthreads();
                __syncthreads();
                continue;
            }
            __syncthreads();
        }
        if (ROLE == 2) return;
        __syncthreads();
#undef PREP_LOAD
    } else {
        f32x4 S[4];
        if (MODE == 0) {
            const float* s0 = p.in(7) + (size_t)(((cb * 2 + cd) * 8 + chh) * 64 + 16 * w + fr) * 64;
#pragma unroll
            for (int kt = 0; kt < 4; ++kt) S[kt] = *(const f32x4*)(s0 + 16 * kt + 4 * g);
        } else {
#pragma unroll
            for (int kt = 0; kt < 4; ++kt) S[kt] = (f32x4){0.f, 0.f, 0.f, 0.f};
        }
        float* yp = YY + (size_t)cd * NTOK * 512 + chh * 64 + 16 * w + fr;
        __syncthreads();
        for (int grp = 0; grp < NG; ++grp) {
#pragma unroll
            for (int c4 = 0; c4 < 4; ++c4) {
                const LAS unsigned char* IM = L + CIMG0 + ((grp & 1) * 4 + c4) * CI_SZ;
                u32x2 oa[2][2], orh[2][2], obt[4], okt[4]; f32x4 ogl[4];
#pragma unroll
                for (int s = 0; s < 2; ++s) {
                    oa[s][0] = *(const LAS u32x2*)(IM + CI_AP + fr * 144 + (32 * s + 4 * g) * 2); oa[s][1] = *(const LAS u32x2*)(IM + CI_AP + fr * 144 + (32 * s + 16 + 4 * g) * 2);
                    orh[s][0] = *(const LAS u32x2*)(IM + CI_RH + fr * 144 + (32 * s + 4 * g) * 2); orh[s][1] = *(const LAS u32x2*)(IM + CI_RH + fr * 144 + (32 * s + 16 + 4 * g) * 2);
                }
                const u32x2 vq = *(const LAS u32x2*)(IM + CI_VT + (16 * w + fr) * 40 + g * 8);
                const u32x2 m0 = *(const LAS u32x2*)(IM + CI_MP + fr * 40 + g * 8);
                const u32x2 p0 = *(const LAS u32x2*)(IM + CI_PP + fr * 72 + g * 8), p1 = *(const LAS u32x2*)(IM + CI_PP + fr * 72 + 32 + g * 8);
#pragma unroll
                for (int kt = 0; kt < 4; ++kt) {
                    obt[kt] = *(const LAS u32x2*)(IM + CI_BT + (16 * kt + fr) * 40 + g * 8); okt[kt] = *(const LAS u32x2*)(IM + CI_KT + (16 * kt + fr) * 40 + g * 8);
                    ogl[kt] = *(const LAS f32x4*)(IM + CI_GL + (16 * kt + 4 * g) * 4);
                }
                bf16x8 Sp[2];
#pragma unroll
                for (int s = 0; s < 2; ++s) { u32x4 pk; pk.x = pack2(S[2 * s][0], S[2 * s][1]); pk.y = pack2(S[2 * s][2], S[2 * s][3]); pk.z = pack2(S[2 * s + 1][0], S[2 * s + 1][1]); pk.w = pack2(S[2 * s + 1][2], S[2 * s + 1][3]); Sp[s] = __builtin_bit_cast(bf16x8, pk); }
                f32x4 U = (f32x4){0.f, 0.f, 0.f, 0.f}, Y = U;
#pragma unroll
                for (int s = 0; s < 2; ++s) {
                    U = __builtin_amdgcn_mfma_f32_16x16x32_bf16(__builtin_bit_cast(bf16x8, (u32x4){oa[s][0].x, oa[s][0].y, oa[s][1].x, oa[s][1].y}), Sp[s], U, 0, 0, 0);
                    Y = __builtin_amdgcn_mfma_f32_16x16x32_bf16(__builtin_bit_cast(bf16x8, (u32x4){orh[s][0].x, orh[s][0].y, orh[s][1].x, orh[s][1].y}), Sp[s], Y, 0, 0, 0);
                }
                U = __builtin_amdgcn_mfma_f32_16x16x32_bf16(__builtin_bit_cast(bf16x8, (u32x4){m0.x, m0.y, 0u, 0u}), __builtin_bit_cast(bf16x8, (u32x4){vq.x, vq.y, vq.x, vq.y}), U, 0, 0, 0);
                u32x4 uvk; uvk.x = pack2(U[0], U[1]); uvk.y = pack2(U[2], U[3]); uvk.z = vq.x; uvk.w = vq.y;
                const bf16x8 UV = __builtin_bit_cast(bf16x8, uvk);
#pragma unroll
                for (int kt = 0; kt < 4; ++kt) {
                    const f32x4 acc = __builtin_amdgcn_mfma_f32_16x16x32_bf16(__builtin_bit_cast(bf16x8, (u32x4){obt[kt].x, obt[kt].y, okt[kt].x, okt[kt].y}), UV, S[kt], 0, 0, 0);
                    S[kt] = acc * ogl[kt];
                }
                Y = __builtin_amdgcn_mfma_f32_16x16x32_bf16(__builtin_bit_cast(bf16x8, (u32x4){p0.x, p0.y, p1.x, p1.y}), UV, Y, 0, 0, 0);
                const int step0 = (grp * 4 + c4) * 16 + 4 * g;
#pragma unroll
                for (int r = 0; r < 4; ++r) yp[(size_t)TOK_OF(step0 + r) * 512] = Y[r];
            }
            __syncthreads();
        }
        if (MODE == 1) {
            float* so = p.out() + OUT_SRWKV + (size_t)(((cb * 2 + cd) * 8 + chh) * 64 + 16 * w + fr) * 64;
#pragma unroll
            for (int kt = 0; kt < 4; ++kt) *(f32x4*)(so + 16 * kt + 4 * g) = S[kt];
        }
    }
#undef TOK_OF
}
__device__ __forceinline__ void phase_l1_scanc(const Frame& F, const PRef& p) {
    if (F.G > 128) {
        if (F.bid < 32) scanc_unit<0, 1>(F, p, F.bid);
        else if (F.bid < 128) scanc_unit<0, 2>(F, p, (F.bid - 32) & 31, 1 + ((F.bid - 32) >> 5));
        else for (int u = F.bid - 128; u < 256; u += F.G - 128) scanc_unit<1, 0>(F, p, u);
    } else { FOR_UNITS(u, 288, 0) { if (u < 32) scanc_unit<0, 0>(F, p, u); else scanc_unit<1, 0>(F, p, u - 32); } }
}
__device__ __forceinline__ void phase_l1_scan(const Frame& F, const PRef& p) {
    const int half = F.G / 2;
    if (F.bid < half) {
        for (int u = F.bid; u < 128; u += half) { const int xcd = u & 7, idx = u >> 3; scan_unit<0>(F, p, (((idx >> 2) * 8 + xcd) << 2) | (idx & 3)); }
    } else {
        for (int u = F.bid - half; u < 256; u += F.G - half) scan_unit<1>(F, p, u);
    }
}

__device__ __forceinline__ void phase_l1_comb(const Frame& F, const PRef& p) {
    unsigned char* ws = p.ws();
    const float* RR = (const float*)(ws + WS_RR); const float* KR = (const float*)(ws + WS_KR); const float* VV = (const float*)(ws + WS_VV);
    const float* AA = (const float*)(ws + WS_AA); const float* GG = (const float*)(ws + WS_GG); const float* YY = (const float*)(ws + WS_YY);
    bf16_t* OB = (bf16_t*)(ws + WS_OB);
    const int nw = F.G * 8, lane = F.lane;
    const bf16_t* DO = (const bf16_t*)(ws + WS_DO);
    const float lam_init = 0.8f - 0.6f * 0.74081822068171788f;
    const float lam = __expf(wave_sum(p.in(31)[lane] * p.in(31)[64 + lane])) - __expf(wave_sum(p.in(31)[128 + lane] * p.in(31)[192 + lane])) + lam_init;
    for (int row = F.bid * 8 + F.wave; row < NTOK; row += nw) {
#pragma unroll
        for (int h = 0; h < 4; ++h) {
            const unsigned a = *(const unsigned*)(DO + (size_t)row * 1024 + (2 * h) * 128 + 2 * lane), b = *(const unsigned*)(DO + (size_t)row * 1024 + (2 * h + 1) * 128 + 2 * lane);
            const float d0 = bf2f(a & 0xffffu) - lam * bf2f(b & 0xffffu), d1 = bf2f(a >> 16) - lam * bf2f(b >> 16);
            const float rstd = rsqrtf(wave_sum(d0 * d0 + d1 * d1) * (1.0f / 128.0f) + EPS) * (1.0f - lam_init);
            const f32x2 gn = *(const f32x2*)(p.in(32) + h * 128 + 2 * lane);
            *(unsigned*)(OB + (size_t)row * 1024 + h * 128 + 2 * lane) = pack2(d0 * rstd * gn[0], d1 * rstd * gn[1]);
        }
        const size_t o = (size_t)row * 512 + lane * 8;
        const f32x4 yf0 = *(const f32x4*)(YY + o), yf1 = *(const f32x4*)(YY + o + 4), yb0 = *(const f32x4*)(YY + (size_t)NTOK * 512 + o), yb1 = *(const f32x4*)(YY + (size_t)NTOK * 512 + o + 4);
        const f32x4 v0 = *(const f32x4*)(VV + o), v1 = *(const f32x4*)(VV + o + 4), g0 = *(const f32x4*)(GG + o), g1 = *(const f32x4*)(GG + o + 4);
        const f32x4 n0 = *(const f32x4*)(p.in(42) + lane * 8), n1 = *(const f32x4*)(p.in(42) + lane * 8 + 4);
        const float* BON = (const float*)(ws + WS_BON);
#if CHUNKED_SCAN
        float bs = 0.f;
        {
            const f32x4 r0 = *(const f32x4*)(RR + o), r1 = *(const f32x4*)(RR + o + 4), k0 = *(const f32x4*)(KR + o), k1 = *(const f32x4*)(KR + o + 4);
            const f32x4 af0 = *(const f32x4*)(AA + o), af1 = *(const f32x4*)(AA + o + 4), ab0 = *(const f32x4*)(AA + (size_t)NTOK * 512 + o), ab1 = *(const f32x4*)(AA + (size_t)NTOK * 512 + o + 4);
            const f32x4 ka0 = *(const f32x4*)(p.in(40) + lane * 8), ka1 = *(const f32x4*)(p.in(40) + lane * 8 + 4), rk0 = *(const f32x4*)(p.in(41) + lane * 8), rk1 = *(const f32x4*)(p.in(41) + lane * 8 + 4);
            const f32x4 t0 = r0 * rk0 * k0 * (2.0f + (af0 + ab0 - 2.0f) * ka0), t1 = r1 * rk1 * k1 * (2.0f + (af1 + ab1 - 2.0f) * ka1);
            bs = oct_sum((t0[0] + t0[1]) + (t0[2] + t0[3]) + (t1[0] + t1[1]) + (t1[2] + t1[3]));
        }
#else
        const float bs = BON[(size_t)row * 8 + (lane >> 3)] + BON[(size_t)NTOK * 8 + (size_t)row * 8 + (lane >> 3)];
#endif
        const f32x4 y0 = yf0 + yb0, y1 = yf1 + yb1;
        float ss = (y0[0] * y0[0] + y0[1] * y0[1]) + (y0[2] * y0[2] + y0[3] * y0[3]) + (y1[0] * y1[0] + y1[1] * y1[1]) + (y1[2] * y1[2] + y1[3] * y1[3]);
        ss = oct_sum(ss);
        const float rstd = rsqrtf(ss * (1.0f / 64.0f) + EPS);
        const f32x4 o0 = (y0 * rstd * n0 + bs * v0) * g0, o1 = (y1 * rstd * n1 + bs * v1) * g1;
        u32x4 w; w.x = pack2(o0[0], o0[1]); w.y = pack2(o0[2], o0[3]); w.z = pack2(o1[0], o1[1]); w.w = pack2(o1[2], o1[3]);
        *(u32x4*)(OB + (size_t)row * 1024 + 512 + lane * 8) = w;
    }
}

constexpr int NPHASE = 26;
#ifndef PH_ONLY
#define PH_ONLY -1
#endif
#if ONE_LAUNCH
#define SEAM() xcd_barrier(bar)
#else
#define SEAM() do {} while (0)
#endif
#define IN(k) (lo <= (k) && (k) < hi && (PH_ONLY < 0 || (k) == PH_ONLY))
#define END(k) do { if (IN((k) + 1)) SEAM(); } while (0)
#ifndef REP_MASK
#define REP_MASK 0u
#endif
#define REPS(k) for (int rep_ = 0; rep_ < 1 + (int)(((unsigned)REP_MASK >> (k)) & 1u); ++rep_, __syncthreads())

constexpr size_t WS_PARTA = WS_BIG;
constexpr size_t WS_PARTD = WS_U;
static_assert(WS_PARTD + (size_t)2 * NTOK * 1024 * 4 <= WS_ACT, "down-projection slabs overlap ACT");
template <int l>
__device__ __forceinline__ void layer_phases(const Frame& F, const PRef& p, const int lo, const int hi, const XcdBarrier bar) {
    constexpr int pb = 1 + l * 12;
    if (IN(pb + 0)) { REPS(pb + 0) {
        unsigned char* ws = p.ws(); const float* ml = (const float*)(ws + WS_MOD) + (size_t)l * 3 * 6144;
        if (l == 0) phase_norm(F, p.in(0), p.in(1), nullptr, nullptr, nullptr, p.in(12), ml + 1024, ml + 0, (bf16_t*)(ws + WS_HB), true);
        else { float* xbuf = p.out(); phase_norm(F, xbuf, xbuf + (size_t)NCTX * 1024, (const bf16_t*)(ws + WS_PARTD), (const float*)(ws + WS_MOD) + 5120, xbuf, p.in(12) + 1024, ml + 1024, ml + 0, (bf16_t*)(ws + WS_HB), true); }
        } END(pb + 0); }
    if (IN(pb + 1)) { REPS(pb + 1) {
        unsigned char* ws = p.ws();
        if (l == 0) { BigDesc g{(const bf16_t*)(ws + WS_HB), (const bf16_t*)(ws + WS_WAIN), 1024, 1024, 24, 8, 1, 1024}; EpiF32WT E{wt_rsrc(ws + WS_P0, (size_t)NTOK * 2048 * 4), 2048}; gemm_big<false>(F, g, E); if (F.G == 256) cvt_group(F, p, 1, 192, 64, 0); else cvt_group(F, p, 1, 0, F.G, 0); }
        else {
            { BigDesc g{(const bf16_t*)(ws + WS_HB), (const bf16_t*)(ws + WS_WBIN), 1024, 1024, 24, F.G == 256 ? 10 : 14, 1, 1024}; EpiF32WT E{wt_rsrc(ws + WS_P1, (size_t)NTOK * 3584 * 4), 3584}; gemm_big<false>(F, g, E); }
            if (F.G == 256) {
                GemmDesc g{(const bf16_t*)(ws + WS_HB), (const bf16_t*)(ws + WS_WBIN) + (size_t)2560 * 1024, 1024, 1024, NTOK, 896, 1024}; EpiF32 E{(float*)(ws + WS_P1) + 2560, 3584, 896};
                if (F.bid >= 240) gemm_s(F, g, E, 0, F.bid - 240, 16, 48);
                else { gemm_s(F, g, E, 0, 48 + F.bid, 1, 49 + F.bid); if (F.bid < 48) gemm_s(F, g, E, 0, 288 + F.bid, 1, 289 + F.bid); }
            }
        }
        } END(pb + 1);
    }
    if (IN(pb + 2)) { REPS(pb + 2) { if (l == 0) phase_l0_tok(F, p); else phase_l1_tok(F, p); } END(pb + 2); }
    if (IN(pb + 3)) { REPS(pb + 3) {
        unsigned char* ws = p.ws();
        if (l == 0) {
            { GemmDesc g{(const bf16_t*)(ws + WS_CQN), (const bf16_t*)(ws + WS_WUQ), 256, 256, NTOK, 768, 256}; EpiF32 E{(float*)(ws + WS_QRAW), 768, 768}; gemm_s(F, g, E, 0); }
            { GemmDesc g{(const bf16_t*)(ws + WS_CKVN), (const bf16_t*)(ws + WS_WUKV), 128, 128, NKROW, 1024, 128}; EpiF32 E{(float*)(ws + WS_KVRAW), 1024, 1024}; gemm_s(F, g, E, 48 * 6); }
            phase_l0_prefix(F, p, 48 * 6 + 56 * 8);
        } else {
            const bf16_t* TW = (const bf16_t*)(ws + WS_TW); const bf16_t* AD = (const bf16_t*)(ws + WS_AD); const bf16_t* SG = (const bf16_t*)(ws + WS_SG);
            float* DEC = (float*)(ws + WS_DEC); float* AA = (float*)(ws + WS_AA);
            { GemmDesc g{TW, (const bf16_t*)(ws + WS_WWUP), 128, 64, NTOK, 512, 64}; EpiDecay E{DEC, p.in(34)}; gemm_s(F, g, E, 0); }
            { GemmDesc g{TW + 64, (const bf16_t*)(ws + WS_WWUP) + 512 * 64, 128, 64, NTOK, 512, 64}; EpiDecay E{DEC + (size_t)NTOK * 512, p.in(34) + 512}; gemm_s(F, g, E, 192); }
            { GemmDesc g{AD, (const bf16_t*)(ws + WS_WAUP), 128, 64, NTOK, 512, 64}; EpiSigm E{AA, p.in(36)}; gemm_s(F, g, E, 384); }
            { GemmDesc g{AD + 64, (const bf16_t*)(ws + WS_WAUP) + 512 * 64, 128, 64, NTOK, 512, 64}; EpiSigm E{AA + (size_t)NTOK * 512, p.in(36) + 512}; gemm_s(F, g, E, 576); }
            { GemmDesc g{SG, (const bf16_t*)(ws + WS_WGUP), 128, 128, NTOK, 512, 128}; EpiF32 E{(float*)(ws + WS_GG), 512, 512}; gemm_s(F, g, E, 768); }
            phase_l1_mix(F, p);
        }
        } END(pb + 3);
    }
    if (l == 0 && IN(pb + 4)) { REPS(pb + 4) { phase_l0_qkv(F, p); } END(pb + 4); }
    if (IN(pb + 5)) { REPS(pb + 5) { if (l == 0) phase_l0_mix(F, p); else {
#if CHUNKED_SCAN
            phase_l1_scanc(F, p);
#else
            phase_l1_scan(F, p);
#endif
        } } END(pb + 5); }
    if (l == 1 && IN(pb + 6)) { REPS(pb + 6) { phase_l1_comb(F, p); } END(pb + 6); }
    if (IN(pb + 7)) { REPS(pb + 7) {
        unsigned char* ws = p.ws();
        BigDesc g{(const bf16_t*)(ws + WS_OB), (const bf16_t*)(ws + WS_WOUT) + (size_t)l * 1024 * 1024, 1024, 1024, 24, 4, 2, 512};
        EpiPartWT E{wt_rsrc(ws + WS_PARTA, (size_t)2 * NTOK * 1024 * 2), (size_t)NTOK * 1024}; gemm_big<true>(F, g, E);
        if (l == 0) { if (F.G == 256) cvt_group(F, p, 3, 192, 64, 0); else cvt_group(F, p, 3, 0, F.G, 0); }
        } END(pb + 7);
    }
    if (IN(pb + 8)) { REPS(pb + 8) {
        unsigned char* ws = p.ws(); const float* ml = (const float*)(ws + WS_MOD) + (size_t)l * 3 * 6144; float* xbuf = p.out();
        const float* xa = l == 0 ? p.in(0) : xbuf; const float* xb = l == 0 ? p.in(1) : xbuf + (size_t)NCTX * 1024;
        phase_norm(F, xa, xb, (const bf16_t*)(ws + WS_PARTA), ml + 2048, xbuf, p.in(13) + l * 1024, ml + 4096, ml + 3072, (bf16_t*)(ws + WS_HB), true); } END(pb + 8); }
    if (IN(pb + 9)) { REPS(pb + 9) {
        unsigned char* ws = p.ws();
        const bf16_t* wup = (const bf16_t*)(ws + WS_WUP) + (size_t)l * 5632 * 1024;
        gemm_upgate(F, (const bf16_t*)(ws + WS_HB), wup, p.in(16) + (size_t)l * 3 * 5632, p.in(17) + (size_t)l * 5632, (bf16_t*)(ws + WS_ACT));
        } END(pb + 9);
    }
    if (IN(pb + 11)) { REPS(pb + 11) {
        unsigned char* ws = p.ws();
        BigDesc g{(const bf16_t*)(ws + WS_ACT), (const bf16_t*)(ws + WS_WDN) + (size_t)l * 1024 * 2816, 2816, 2816, 24, 4, 2, 1408};
        EpiPartWT E{wt_rsrc(ws + WS_PARTD, (size_t)2 * NTOK * 1024 * 2), (size_t)NTOK * 1024}; gemm_big<true>(F, g, E);
        if (l == 0) { if (F.G == 256) cvt_group(F, p, 2, 192, 64, 0); else cvt_group(F, p, 2, 0, F.G, 0); }
        } END(pb + 11);
    }
}

__global__ void __launch_bounds__(NTHREADS, 2) fwd_kernel(Params kp) {
    extern __shared__ __attribute__((aligned(16))) unsigned char lds_raw[];
    Frame F;
    F.lds = (LAS unsigned char*)lds_raw + LDS_WORK;
    F.tid = threadIdx.x; F.lane = F.tid & 63; F.wave = __builtin_amdgcn_readfirstlane(F.tid >> 6); F.G = gridDim.x; F.bid = blockIdx.x;
    {
        LAS unsigned* pw = (LAS unsigned*)((LAS unsigned char*)lds_raw + 64);
        if (F.tid < (int)(sizeof(Params) / 4)) pw[F.tid] = ((const unsigned*)&kp)[F.tid];
        if (F.tid < 4) ((LAS unsigned*)((LAS unsigned char*)lds_raw))[F.tid] = 0u;
    }
    __syncthreads();
    PRef p; p.w = (const LAS unsigned*)((LAS unsigned char*)lds_raw + 64);
    const int lo = kp.ph_lo, hi = kp.ph_hi;
    XcdBarrier bar; bar.bar = nullptr; bar.x = 0; bar.st = nullptr;
#if ONE_LAUNCH
    bar = xcd_barrier_post((unsigned*)(p.ws() + WS_BAR), (volatile LAS unsigned*)((LAS unsigned char*)lds_raw));
#endif
#ifdef EXTRA_BARS
    for (int i_ = 0; i_ < EXTRA_BARS; ++i_) SEAM();
#endif
    if (IN(0)) { REPS(0) { phase_prep(F, p); } END(0); }
    layer_phases<0>(F, p, lo, hi, bar);
    layer_phases<1>(F, p, lo, hi, bar);
    if (IN(25)) {
        unsigned char* ws = p.ws(); float* xbuf = p.out();
        phase_norm(F, xbuf, xbuf + (size_t)NCTX * 1024, (const bf16_t*)(ws + WS_PARTD), (const float*)(ws + WS_MOD) + 3 * 6144 + 5120, xbuf, nullptr, nullptr, nullptr, nullptr, false);
    }
}

extern "C" void kernel_launch(void* const* d_in, const int* in_sizes, int n_in, void* d_out, int out_size, void* d_ws, size_t ws_size, hipStream_t stream) {
    static int grid = 0;
    if (grid == 0) {
        if (n_in != 43 || (size_t)out_size != OUT_END || ws_size < WS_END) { fprintf(stderr, "kernel_launch: unexpected shapes: n_in %d out %d ws %zu (need %zu)\n", n_in, out_size, ws_size, (size_t)WS_END); grid = -1; return; }
        int dev = 0, cus = 0, per_cu = 0;
        if (hipGetDevice(&dev) != hipSuccess || hipDeviceGetAttribute(&cus, hipDeviceAttributeMultiprocessorCount, dev) != hipSuccess) { grid = -1; return; }
        if (hipFuncSetAttribute((const void*)fwd_kernel, hipFuncAttributeMaxDynamicSharedMemorySize, LDS_BYTES) != hipSuccess) { fprintf(stderr, "kernel_launch: hipFuncSetAttribute failed\n"); grid = -1; return; }
        if (hipOccupancyMaxActiveBlocksPerMultiprocessor(&per_cu, (const void*)fwd_kernel, NTHREADS, LDS_BYTES) != hipSuccess || per_cu < 1) { fprintf(stderr, "kernel_launch: occupancy query says %d blocks per CU\n", per_cu); grid = -1; (void)hipGetLastError(); return; }
        grid = cus;
    }
    if (grid < 0) return;
    Params p{};
    for (int i = 0; i < 43; ++i) p.in[i] = (const float*)d_in[i];
    p.out = (float*)d_out; p.ws = (unsigned char*)d_ws;
#if ONE_LAUNCH
    (void)hipMemsetAsync((char*)d_ws + WS_BAR, 0, 16384, stream);
    p.ph_lo = 0; p.ph_hi = NPHASE;
    void* args[] = {&p};
    hipError_t e = hipLaunchCooperativeKernel((const void*)fwd_kernel, dim3(grid), dim3(NTHREADS), args, LDS_BYTES, stream);
    if (e != hipSuccess) fprintf(stderr, "cooperative launch failed: %s (grid %d)\n", hipGetErrorString(e), grid);
#else
    for (int ph = 0; ph < NPHASE; ++ph) {
        p.ph_lo = ph; p.ph_hi = ph + 1;
        hipLaunchKernelGGL(fwd_kernel, dim3(grid), dim3(NTHREADS), LDS_BYTES, stream, p);
    }
#endif
}
```

```cpp
#include <hip/hip_runtime.h>
#include <cstdio>
#include <cstdint>

#define LAS __attribute__((address_space(3)))
typedef unsigned short bf16_t;
typedef short bf16x8 __attribute__((ext_vector_type(8)));
typedef short bf16x4 __attribute__((ext_vector_type(4)));
typedef float f32x4 __attribute__((ext_vector_type(4)));
typedef float f32x2 __attribute__((ext_vector_type(2)));
typedef unsigned u32x2 __attribute__((ext_vector_type(2)));
typedef unsigned u32x4 __attribute__((ext_vector_type(4)));

#define REP_MASK 0u
#define ATT_REP 0
#define SCAN_REP 0
#ifndef CHUNKED_SCAN
#define CHUNKED_SCAN 1
#endif
#ifndef ONE_LAUNCH
#define ONE_LAUNCH 1
#endif

constexpr int NTHREADS = 512;
constexpr int LDS_BYTES = 144 * 1024;
constexpr int LDS_WORK = 1024;
constexpr int DM = 1024, NCTX = 4096, NLAT = 2048, NTOK = 6144, NKROW = 7168, DFF = 2816;
constexpr float EPS = 1e-6f;

constexpr size_t al256(size_t x) { return (x + 255) & ~(size_t)255; }
constexpr size_t WS_BAR = 0;
constexpr size_t WS_MOD = WS_BAR + 16384;
constexpr size_t WS_WAIN = al256(WS_MOD + 2 * 3 * 6144 * 4);
constexpr size_t WS_WUQ = WS_WAIN + (size_t)2048 * 1024 * 2;
constexpr size_t WS_WUKV = WS_WUQ + (size_t)768 * 256 * 2;
constexpr size_t WS_WOUT = WS_WUKV + (size_t)1024 * 128 * 2;
constexpr size_t WS_WUP = WS_WOUT + (size_t)2 * 1024 * 1024 * 2;
constexpr size_t WS_WDN = WS_WUP + (size_t)2 * 5632 * 1024 * 2;
constexpr size_t WS_WBIN = WS_WDN + (size_t)2 * 1024 * 2816 * 2;
constexpr size_t WS_WWUP = WS_WBIN + (size_t)3584 * 1024 * 2;
constexpr size_t WS_WAUP = WS_WWUP + (size_t)2 * 512 * 64 * 2;
constexpr size_t WS_WGUP = WS_WAUP + (size_t)2 * 512 * 64 * 2;
constexpr size_t WS_HB = WS_WGUP + (size_t)512 * 128 * 2;
constexpr size_t WS_OB = WS_HB + (size_t)NTOK * 1024 * 2;
constexpr size_t WS_BIG = WS_OB + (size_t)NTOK * 1024 * 2;
constexpr size_t WS_P0 = WS_BIG;
constexpr size_t WS_CQN = WS_P0 + (size_t)NTOK * 2048 * 4;
constexpr size_t WS_CKVN = WS_CQN + (size_t)NTOK * 256 * 2;
constexpr size_t WS_QRAW = WS_CKVN + (size_t)NKROW * 128 * 2;
constexpr size_t WS_KVRAW = WS_QRAW + (size_t)NTOK * 768 * 4;
constexpr size_t WS_Q0 = WS_KVRAW + (size_t)NKROW * 1024 * 4;
constexpr size_t WS_K0 = WS_Q0 + (size_t)NTOK * 768 * 2;
constexpr size_t WS_VT0 = WS_K0 + (size_t)NKROW * 768 * 2;
constexpr size_t WS_KVS = WS_VT0 + (size_t)NKROW * 512 * 2;
constexpr size_t WS_L0END = WS_KVS + (size_t)384 * 2 * 8192 * 4;
constexpr size_t WS_U = WS_BIG;
constexpr size_t WS_ACT = WS_U + (size_t)NTOK * 5632 * 2;
constexpr size_t WS_FFNEND = WS_ACT + (size_t)NTOK * 2816 * 2;
constexpr size_t WS_P1 = WS_BIG;
constexpr size_t WS_DEC = WS_BIG;
constexpr size_t WS_AA = WS_DEC + (size_t)2 * NTOK * 512 * 4;
constexpr size_t WS_GG = WS_AA + (size_t)2 * NTOK * 512 * 4;
constexpr size_t WS_YY = WS_GG + (size_t)NTOK * 512 * 4;
constexpr size_t WS_QD = WS_P1 + (size_t)NTOK * 3584 * 4;
constexpr size_t WS_KD = WS_QD + (size_t)NTOK * 512 * 2;
constexpr size_t WS_VDT = WS_KD + (size_t)NKROW * 512 * 2;
constexpr size_t WS_RR = WS_VDT + (size_t)NKROW * 512 * 2;
constexpr size_t WS_KR = WS_RR + (size_t)NTOK * 512 * 4;
constexpr size_t WS_VV = WS_KR + (size_t)NTOK * 512 * 4;
constexpr size_t WS_KK = WS_VV + (size_t)NTOK * 512 * 4;
constexpr size_t WS_TW = WS_KK + (size_t)NTOK * 512 * 4;
constexpr size_t WS_AD = WS_TW + (size_t)NTOK * 128 * 2;
constexpr size_t WS_SG = WS_AD + (size_t)NTOK * 128 * 2;
constexpr size_t WS_DO = WS_SG + (size_t)NTOK * 128 * 2;
constexpr size_t WS_BON = WS_DO + (size_t)NTOK * 1024 * 2;
constexpr size_t WS_L1END = WS_BON + (size_t)2 * NTOK * 8 * 4;
constexpr size_t cmax(size_t a, size_t b) { return a > b ? a : b; }
constexpr size_t WS_END = cmax(cmax(WS_L0END, WS_FFNEND), WS_L1END);
static_assert(WS_YY + (size_t)2 * NTOK * 512 * 4 <= WS_QD, "layer-1 overlay");
static_assert(WS_END <= (size_t)256 * 1024 * 1024, "workspace exceeds 256 MiB");

constexpr size_t OUT_X = 0;
constexpr size_t OUT_CKV = (size_t)NTOK * 1024;
constexpr size_t OUT_KROPE = OUT_CKV + (size_t)NCTX * 128;
constexpr size_t OUT_SRET = OUT_KROPE + (size_t)NCTX * 32;
constexpr size_t OUT_DK = OUT_SRET + (size_t)16 * 2 * 4 * 8192;
constexpr size_t OUT_DV = OUT_DK + (size_t)NCTX * 512;
constexpr size_t OUT_SRWKV = OUT_DV + (size_t)NCTX * 512;
constexpr size_t OUT_END = OUT_SRWKV + (size_t)16 * 2 * 8 * 4096;

struct Params {
    const float* in[43];
    float* out;
    unsigned char* ws;
    int ph_lo, ph_hi;
};

struct PRef {
    const LAS unsigned* w;
    __device__ __forceinline__ unsigned long long q(int i) const {
        const unsigned lo = (unsigned)__builtin_amdgcn_readfirstlane((int)w[2 * i]), hi = (unsigned)__builtin_amdgcn_readfirstlane((int)w[2 * i + 1]);
        return ((unsigned long long)hi << 32) | lo; }
    __device__ __forceinline__ const float* in(int k) const { return (const float*)(const __attribute__((address_space(1))) float*)q(k); }
    __device__ __forceinline__ float* out() const { return (float*)(__attribute__((address_space(1))) float*)q(43); }
    __device__ __forceinline__ unsigned char* ws() const { return (unsigned char*)(__attribute__((address_space(1))) unsigned char*)q(44); }
};

typedef __bf16 hwbf16x2 __attribute__((ext_vector_type(2)));
__device__ __forceinline__ unsigned pack2(float a, float b) { const f32x2 v = (f32x2){a, b}; return __builtin_bit_cast(unsigned, __builtin_convertvector(v, hwbf16x2)); }
__device__ __forceinline__ bf16_t f2bf(float f) { return (bf16_t)(pack2(f, 0.f) & 0xffffu); }
__device__ __forceinline__ float bf2f(unsigned b) { return __uint_as_float(b << 16); }
#define RDLANE(x, l) __int_as_float(__builtin_amdgcn_readlane(__float_as_int(x), (l)))
#define DPPF(x, ctrl) __int_as_float(__builtin_amdgcn_update_dpp(0, __float_as_int(x), (ctrl), 0xF, 0xF, true))
__device__ __forceinline__ float row16_sum(float v) {
    v += DPPF(v, 0xB1); v += DPPF(v, 0x4E); v += DPPF(v, 0x141); v += DPPF(v, 0x140); return v; }
__device__ __forceinline__ float oct_sum(float v) {
    v += DPPF(v, 0xB1); v += DPPF(v, 0x4E); v += DPPF(v, 0x141); return v; }
__device__ __forceinline__ float wave_sum(float v) {
    v = row16_sum(v);
    return (RDLANE(v, 0) + RDLANE(v, 16)) + (RDLANE(v, 32) + RDLANE(v, 48));
}
__device__ __forceinline__ float half_sum(float v, int lane) {
    v = row16_sum(v);
    const float a = RDLANE(v, 0) + RDLANE(v, 16), b = RDLANE(v, 32) + RDLANE(v, 48);
    return lane < 32 ? a : b;
}
__device__ __forceinline__ float sigmoidf_(float x) { return 1.0f / (1.0f + __expf(-x)); }
__device__ __forceinline__ float siluf_(float x) { return x * sigmoidf_(x); }
__device__ __forceinline__ float tanhf_(float x) { return 1.0f - 2.0f / (__expf(2.0f * x) + 1.0f); }
__device__ __forceinline__ int cond_of(int row) { return row < NCTX ? 0 : 1 + ((row - NCTX) >> 10); }

#define XB_TMO      128
#define XB_XCNT(j)  (256  + 64 * (j))
#define XB_XSUB(j)  (1280 + 64 * (j))
#define XB_XGEN(j)  (2304 + 64 * (j))
#define XB_TOP      3328
#define XB_TOPGEN   3392
#define XCD_BAR_WORDS 3456
#define UPDONE_WORD 3520
#define XB_SPIN_CAP (1u << 20)
__device__ __forceinline__ unsigned xb_ld(unsigned* p) { return __hip_atomic_load(p, __ATOMIC_RELAXED, __HIP_MEMORY_SCOPE_AGENT); }
__device__ __forceinline__ unsigned xb_add(unsigned* p, unsigned v) { return __hip_atomic_fetch_add(p, v, __ATOMIC_RELAXED, __HIP_MEMORY_SCOPE_AGENT); }
__device__ __forceinline__ unsigned xb_xcc_id() { return (unsigned)__builtin_amdgcn_s_getreg((3 << 11) | 20) & 0xFu; }
#define XB_SPIN(cond, bar) do { unsigned _sp = 0; while (cond) { __builtin_amdgcn_s_sleep(1); \
    if ((++_sp & 255u) == 0u) { if (xb_ld(&(bar)[XB_TMO])) break; if (_sp > XB_SPIN_CAP) { atomicAdd(&(bar)[XB_TMO], 1u); break; } } } } while (0)
struct XcdBarrier { unsigned* bar; unsigned x; volatile LAS unsigned* st; };
__device__ __forceinline__ XcdBarrier xcd_barrier_post(unsigned* bar, volatile LAS unsigned* st) {
    XcdBarrier b; b.bar = bar; b.x = xb_xcc_id(); b.st = st;
    if (threadIdx.x == 0) (void)xb_add(&bar[XB_XCNT(b.x)], 1u);
    return b;
}
__device__ __forceinline__ void xcd_barrier_complete(unsigned* bar, unsigned x, unsigned& nloc, unsigned& nx) {
    const unsigned G = gridDim.x * gridDim.y * gridDim.z;
    unsigned sum, cnt, mine, sp = 0u;
    for (;;) {
        sum = 0u; cnt = 0u; mine = 0u;
#pragma unroll
        for (unsigned j = 0; j < 16; ++j) { const unsigned c = xb_ld(&bar[XB_XCNT(j)]); sum += c; cnt += (c > 0u) ? 1u : 0u; mine = (j == x) ? c : mine; }
        if (sum == G) break;
        __builtin_amdgcn_s_sleep(1);
        if ((++sp & 255u) == 0u) { if (xb_ld(&bar[XB_TMO])) break; if (sp > XB_SPIN_CAP) { atomicAdd(&bar[XB_TMO], 1u); break; } }
    }
    nloc = mine > 0u ? mine : 1u; nx = cnt > 0u ? cnt : 1u;
}
__device__ __forceinline__ void xcd_barrier(const XcdBarrier& b) {
    asm volatile("s_waitcnt vmcnt(0)" ::: "memory");
    __syncthreads();
    if (threadIdx.x == 0) {
        unsigned* bar = b.bar;
        __builtin_amdgcn_s_waitcnt(0);
        unsigned nloc = b.st[0], nx = b.st[1];
        if (nloc == 0u) { xcd_barrier_complete(bar, b.x, nloc, nx); b.st[0] = nloc; b.st[1] = nx; }
        const unsigned old = xb_add(&bar[XB_XSUB(b.x)], 1u);
        const unsigned gen = old / nloc;
        if (old + 1u == (gen + 1u) * nloc) {
            __builtin_amdgcn_fence(__ATOMIC_RELEASE, "agent");
            asm volatile("s_waitcnt vmcnt(0)" ::: "memory");
            const unsigned og = xb_add(&bar[XB_TOP], 1u);
            const unsigned tg = og / nx;
            if (og + 1u == (tg + 1u) * nx) xb_add(&bar[XB_TOPGEN], 1u);
            else XB_SPIN(xb_ld(&bar[XB_TOPGEN]) == tg, bar);
            __builtin_amdgcn_fence(__ATOMIC_ACQUIRE, "agent");
            xb_add(&bar[XB_XGEN(b.x)], 1u);
            asm volatile("s_waitcnt vmcnt(0)" ::: "memory");
        } else {
            XB_SPIN(xb_ld(&bar[XB_XGEN(b.x)]) == gen, bar);
            __builtin_amdgcn_fence(__ATOMIC_ACQUIRE, "agent");
            asm volatile("s_waitcnt vmcnt(0)" ::: "memory");
        }
    }
    __syncthreads();
}

struct Frame {
    LAS unsigned char* lds;
    int tid, lane, wave, G, bid;
};
#define FOR_UNITS(u, n, rot) for (int u = (int)((F.bid + F.G - ((rot) % F.G)) % F.G); u < (n); u += F.G)

__device__ __forceinline__ int lds_byte(int r, int c) { const int st = (r >> 4) * 2 + (c >> 5), rr = r & 15, cc = c & 31, ob = rr * 64 + cc * 2; return st * 1024 + (ob ^ (((ob >> 9) & 1) << 5)); }
__device__ __forceinline__ void stage_rc(int b, int& R, int& C) { const int st = b / 1024, sb = b % 1024, swz = sb ^ (((sb >> 9) & 1) << 5); R = (st >> 1) * 16 + swz / 64; C = (st & 1) * 32 + (swz % 64) / 2; }

struct GemmDesc { const bf16_t* A; const bf16_t* Bt; int lda, ldb, M, N, K; };

typedef unsigned u32x4v __attribute__((ext_vector_type(4)));
__device__ __forceinline__ __amdgpu_buffer_rsrc_t wt_rsrc(void* base, size_t bytes) { return __builtin_amdgcn_make_buffer_rsrc(base, 0, (int)bytes, 0x00020000); }
__device__ __forceinline__ void wt_store16(const __amdgpu_buffer_rsrc_t r, size_t byte_off, u32x4 v) { __builtin_amdgcn_raw_buffer_store_b128(v, r, (int)byte_off, 0, 16); }
struct EpiF32 { float* C; int ldc, ncols;
    __device__ __forceinline__ void operator()(int r, int c, f32x4 v, int ks = 0) const { if (c < ncols) *(f32x4*)(C + (size_t)r * ldc + c) = v; } };
struct EpiF32WT { __amdgpu_buffer_rsrc_t R; int ldc;
    __device__ __forceinline__ void operator()(int r, int c, f32x4 v, int ks = 0) const { wt_store16(R, ((size_t)r * ldc + c) * 4, __builtin_bit_cast(u32x4, v)); } };
struct EpiBf16 { bf16_t* C; int ldc, ncols;
    __device__ __forceinline__ void e8(int r, int c, f32x4 v0, f32x4 v1, int ks = 0) const { u32x4 w; w.x = pack2(v0[0], v0[1]); w.y = pack2(v0[2], v0[3]); w.z = pack2(v1[0], v1[1]); w.w = pack2(v1[2], v1[3]); *(u32x4*)(C + (size_t)r * ldc + c) = w; }
    __device__ __forceinline__ void operator()(int r, int c, f32x4 v, int ks = 0) const { if (c < ncols) { u32x2 w; w.x = pack2(v[0], v[1]); w.y = pack2(v[2], v[3]); *(u32x2*)(C + (size_t)r * ldc + c) = w; } } };
struct EpiPart { bf16_t* C; size_t kstride;
    __device__ __forceinline__ void e8(int r, int c, f32x4 v0, f32x4 v1, int ks) const { u32x4 w; w.x = pack2(v0[0], v0[1]); w.y = pack2(v0[2], v0[3]); w.z = pack2(v1[0], v1[1]); w.w = pack2(v1[2], v1[3]);
        *(u32x4*)(C + (size_t)ks * kstride + (size_t)r * 1024 + c) = w; } };
struct EpiBf16WT { __amdgpu_buffer_rsrc_t R; int ldc;
    __device__ __forceinline__ void e8(int r, int c, f32x4 v0, f32x4 v1, int ks = 0) const { u32x4 w; w.x = pack2(v0[0], v0[1]); w.y = pack2(v0[2], v0[3]); w.z = pack2(v1[0], v1[1]); w.w = pack2(v1[2], v1[3]);
        wt_store16(R, ((size_t)r * ldc + c) * 2, w); } };
struct EpiPartWT { __amdgpu_buffer_rsrc_t R; size_t kstride;
    __device__ __forceinline__ void e8(int r, int c, f32x4 v0, f32x4 v1, int ks) const { u32x4 w; w.x = pack2(v0[0], v0[1]); w.y = pack2(v0[2], v0[3]); w.z = pack2(v1[0], v1[1]); w.w = pack2(v1[2], v1[3]);
        wt_store16(R, ((size_t)ks * kstride + (size_t)r * 1024 + c) * 2, w); } };
struct EpiResid { const float* xa; const float* xb; float* xo; const float* gate;
    __device__ __forceinline__ void operator()(int r, int c, f32x4 v, int ks = 0) const {
        const float* xs = r < NCTX ? xa + (size_t)r * 1024 : xb + (size_t)(r - NCTX) * 1024;
        const f32x4 x = *(const f32x4*)(xs + c); const f32x4 g = *(const f32x4*)(gate + cond_of(r) * 6144 + c);
        *(f32x4*)(xo + (size_t)r * 1024 + c) = x + g * v; } };
struct EpiDecay { float* C; const float* w0;
    __device__ __forceinline__ void operator()(int r, int c, f32x4 v, int ks = 0) const { const f32x4 b = *(const f32x4*)(w0 + c); f32x4 o;
#pragma unroll
        for (int j = 0; j < 4; ++j) o[j] = __expf(-0.60653065971f * sigmoidf_(b[j] + v[j]));
        *(f32x4*)(C + (size_t)r * 512 + c) = o; } };
struct EpiSigm { float* C; const float* a0;
    __device__ __forceinline__ void operator()(int r, int c, f32x4 v, int ks = 0) const { const f32x4 b = *(const f32x4*)(a0 + c); f32x4 o;
#pragma unroll
        for (int j = 0; j < 4; ++j) o[j] = sigmoidf_(b[j] + v[j]);
        *(f32x4*)(C + (size_t)r * 512 + c) = o; } };

template <class Epi>
__device__ __forceinline__ void gemm_s(const Frame& F, const GemmDesc g, const Epi& E, int rot, int ufirst = -1, int ustep = 0, int ulast = 0) {
    LAS unsigned char* lds = F.lds;
    const int tid = F.tid, wid = F.wave, lane = F.lane, wr = wid >> 2, wc = wid & 3, fr = lane & 15, fq = lane >> 4;
    const int nM = g.M / 128, nN = g.N / 128, nU = nM * nN, nt = g.K / 64;
    int R0, C0, R1, C1; stage_rc(tid * 16, R0, C0); stage_rc(tid * 16 + 8192, R1, C1);
    const int aoff = lds_byte(wr * 64 + fr, fq * 8), boff = lds_byte(wc * 32 + fr, fq * 8);
    const unsigned ldsw = (unsigned)wid * 1024u;
#define GS_STAGE(buf, t) do { \
        __builtin_amdgcn_global_load_lds((const unsigned*)(Ag + (size_t)R0 * g.lda + (t) * 64 + C0), (LAS unsigned*)(lds + (buf) * 32768 + ldsw), 16, 0, 0); \
        __builtin_amdgcn_global_load_lds((const unsigned*)(Ag + (size_t)R1 * g.lda + (t) * 64 + C1), (LAS unsigned*)(lds + (buf) * 32768 + ldsw + 8192), 16, 0, 0); \
        __builtin_amdgcn_global_load_lds((const unsigned*)(Bg + (size_t)R0 * g.ldb + (t) * 64 + C0), (LAS unsigned*)(lds + (buf) * 32768 + 16384 + ldsw), 16, 0, 0); \
        __builtin_amdgcn_global_load_lds((const unsigned*)(Bg + (size_t)R1 * g.ldb + (t) * 64 + C1), (LAS unsigned*)(lds + (buf) * 32768 + 16384 + ldsw + 8192), 16, 0, 0); } while (0)
    const int u0 = ufirst >= 0 ? ufirst : (int)((F.bid + F.G - (rot % F.G)) % F.G), us = ufirst >= 0 ? ustep : F.G, ue = ufirst >= 0 ? ulast : nU;
    for (int u = u0; u < ue; u += us) {
        const int pm = u % nM, pn = u / nM;
        const bf16_t* Ag = g.A + (size_t)(pm * 128) * g.lda; const bf16_t* Bg = g.Bt + (size_t)(pn * 128) * g.ldb;
        f32x4 acc[4][2];
#pragma unroll
        for (int m = 0; m < 4; ++m)
#pragma unroll
            for (int n = 0; n < 2; ++n) acc[m][n] = (f32x4){0.f, 0.f, 0.f, 0.f};
        GS_STAGE(0, 0);
        if (nt > 1) GS_STAGE(1, 1);
        int b = 0, bn = 2;
        for (int t = 0; t < nt; ++t) {
            if (t + 2 < nt) { GS_STAGE(bn, t + 2); asm volatile("s_waitcnt vmcnt(8)" ::: "memory"); }
            else if (t + 1 < nt) asm volatile("s_waitcnt vmcnt(4)" ::: "memory");
            else asm volatile("s_waitcnt vmcnt(0)" ::: "memory");
            __builtin_amdgcn_s_barrier(); asm volatile("" ::: "memory");
            bf16x8 Af[4][2], Bf[2][2];
#pragma unroll
            for (int m = 0; m < 4; ++m)
#pragma unroll
                for (int k = 0; k < 2; ++k) Af[m][k] = *(const LAS bf16x8*)(lds + b * 32768 + aoff + m * 2048 + k * 1024);
#pragma unroll
            for (int n = 0; n < 2; ++n)
#pragma unroll
                for (int k = 0; k < 2; ++k) Bf[n][k] = *(const LAS bf16x8*)(lds + b * 32768 + 16384 + boff + n * 2048 + k * 1024);
#pragma unroll
            for (int k = 0; k < 2; ++k)
#pragma unroll
                for (int m = 0; m < 4; ++m)
#pragma unroll
                    for (int n = 0; n < 2; ++n) acc[m][n] = __builtin_amdgcn_mfma_f32_16x16x32_bf16(Bf[n][k], Af[m][k], acc[m][n], 0, 0, 0);
            asm volatile("s_waitcnt lgkmcnt(0)" ::: "memory");
            __builtin_amdgcn_s_barrier(); asm volatile("" ::: "memory");
            b = b == 2 ? 0 : b + 1; bn = bn == 2 ? 0 : bn + 1;
        }
#pragma unroll
        for (int m = 0; m < 4; ++m)
#pragma unroll
            for (int n = 0; n < 2; ++n) E(pm * 128 + wr * 64 + m * 16 + fr, pn * 128 + wc * 32 + n * 16 + 4 * fq, acc[m][n]);
    }
#undef GS_STAGE
}

constexpr int HTB = 128 * 64 * 2;
struct BigDesc { const bf16_t* A; const bf16_t* Bt; int lda, ldb, nM, nN, nKS, Ksp; };
struct BUnit { int pm, pn, ks, hm; };
__device__ __forceinline__ bool big_next(const BigDesc& g, int i, int G, int c, BUnit& u) {
    const int nNp = g.nN * g.nKS, nwg = g.nM * nNp;
    const long L = (long)i * G + c; if (L >= nwg) return false;
    int wgid = (int)L; { const int q = nwg / 8, r = nwg % 8, xcd = wgid % 8, off = wgid / 8; wgid = (xcd < r ? xcd * (q + 1) : r * (q + 1) + (xcd - r) * q) + off; }
    const int nig = 8 * nNp, gid = wgid / nig, fm = gid * 8, gsz = (g.nM - fm) < 8 ? (g.nM - fm) : 8;
    u.pm = fm + ((wgid % nig) % gsz); const int pnp = (wgid % nig) / gsz; u.pn = pnp / g.nKS; u.ks = pnp % g.nKS; u.hm = -1; return true;
}
template <bool HALFTAIL>
__device__ __forceinline__ bool big_next_h(const BigDesc& g, int i, int G, int c, BUnit& u) {
    if constexpr (!HALFTAIL) return big_next(g, i, G, c, u);
    else {
        const int nwg = g.nM * g.nN * g.nKS, nfr = nwg / G, rem = nwg - nfr * G;
        if (i < nfr || 2 * rem > G) return big_next(g, i, G, c, u);
        if (i > nfr || c >= 2 * rem) return false;
        big_next(g, nfr, G, c >> 1, u); u.hm = c & 1; return true;
    }
}
__device__ __forceinline__ bool down_merged_unit(int i, int bid, BUnit& u) {
    if (i > 0 || (bid >= 112 && bid < 120)) return false;
    u.hm = -1;
    if (bid >= 120) { const int a = bid - 120, tl = a >> 1; u.ks = a & 1; u.pm = tl >> 2; u.pn = tl & 3; }
    else { const int tl = 68 + (bid >> 2); u.ks = bid & 3; u.pm = tl >> 2; u.pn = tl & 3; }
    return true;
}
__device__ __forceinline__ int down_merged_k0(int bid, int ks) { return bid >= 120 ? ks * 1408 : (ks == 0 ? 0 : (ks == 1 ? 12 : (ks == 2 ? 22 : 34))) * 64; }
__device__ __forceinline__ int down_merged_nt(int bid, int ks) { return bid >= 120 ? 22 : ((ks & 1) ? 10 : 12); }
__device__ __forceinline__ int perm32(int rho) { const int n = rho >> 4, i = rho & 15; return 8 * (i >> 2) + 4 * n + (i & 3); }
template <bool PERM, class Epi, bool HALFTAIL = false, int UMODE = 0>
__device__ __forceinline__ void gemm_big(const Frame& F, const BigDesc g, const Epi& E) {
    LAS unsigned char* lds = F.lds;
    const int tid = F.tid, wid = F.wave, lane = F.lane, wr = wid >> 2, wc = wid & 3, fr = lane & 15, fq = lane >> 4;
    unsigned voffA[2], voffB[2];
#pragma unroll
    for (int i = 0; i < 2; ++i) { int R, C; stage_rc(tid * 16 + i * 8192, R, C); const int Rb = PERM ? ((R & ~31) + perm32(R & 31)) : R; voffA[i] = (unsigned)(R * g.lda + C) * 2u; voffB[i] = (unsigned)(Rb * g.ldb + C) * 2u; }
    const size_t kstep = (size_t)(64 * 2);
    const size_t hstepA = (size_t)128 * g.lda * 2, hstepB = (size_t)128 * g.ldb * 2;
    const unsigned ldsw = (unsigned)wid * 1024u;
    const int aoff = lds_byte(wr * 64 + fr, fq * 8), boff = lds_byte(wc * 32 + fr, fq * 8);
#define PG8_SA(b, h) (((b) * 2 + (h)) * HTB)
#define PG8_SB(b, h) ((4 + (b) * 2 + (h)) * HTB)
#define PG8_STAGE(bufoff, gbase, voff) do { _Pragma("unroll") for (int _i = 0; _i < 2; ++_i) \
        __builtin_amdgcn_global_load_lds((const unsigned*)((const char*)(gbase) + (voff)[_i]), (LAS unsigned*)(lds + (bufoff) + ldsw + _i * 8192), 16, 0, 0); } while (0)
#define PG8_LDA(dst, b, h) do { _Pragma("unroll") for (int m = 0; m < 4; ++m) _Pragma("unroll") for (int k = 0; k < 2; ++k) dst[m][k] = *(const LAS bf16x8*)(lds + PG8_SA(b, h) + aoff + m * 2048 + k * 1024); } while (0)
#define PG8_LDB(dst, b, h) do { _Pragma("unroll") for (int n = 0; n < 2; ++n) _Pragma("unroll") for (int k = 0; k < 2; ++k) dst[n][k] = *(const LAS bf16x8*)(lds + PG8_SB(b, h) + boff + n * 2048 + k * 1024); } while (0)
#define PG8_MMA(ai, bj, At, Bt) do { __builtin_amdgcn_s_setprio(1); _Pragma("unroll") for (int m = 0; m < 4; ++m) _Pragma("unroll") for (int n = 0; n < 2; ++n) _Pragma("unroll") for (int k = 0; k < 2; ++k) \
        acc[ai][bj][m][n] = __builtin_amdgcn_mfma_f32_16x16x32_bf16(Bt[n][k], At[m][k], acc[ai][bj][m][n], 0, 0, 0); __builtin_amdgcn_s_setprio(0); } while (0)
#define PG8_WAIT_V(n) asm volatile("s_waitcnt vmcnt(" #n ")" ::: "memory")
#define PG8_WAIT_L(n) asm volatile("s_waitcnt lgkmcnt(" #n ")" ::: "memory")
#define PG8_BAR __builtin_amdgcn_s_barrier()
#define PG8_SCHED __builtin_amdgcn_sched_barrier(0)
#define PG8_K0(u) (UMODE == 1 ? down_merged_k0(F.bid, (u).ks) : (u).ks * g.Ksp)
#define PG8_UA(u) ((const char*)g.A + (size_t)(u).pm * 2 * hstepA + (size_t)PG8_K0(u) * 2)
#define PG8_UB(u) ((const char*)g.Bt + (size_t)((u).pn * 2 + (HALFTAIL && (u).hm > 0 ? 1 : 0)) * hstepB + (size_t)PG8_K0(u) * 2)
#define PG8_NEXT(i, u) (UMODE == 1 ? down_merged_unit(i, F.bid, u) : big_next_h<HALFTAIL>(g, i, F.G, F.bid, u))
#define PG8_UH(u) ((HALFTAIL && (u).hm >= 0) ? (size_t)0 : hstepB)
    BUnit cur, nxt; int ui = 0;
    if (!PG8_NEXT(0, cur)) return;
    f32x4 acc[2][2][4][2];
#pragma unroll
    for (int a = 0; a < 2; ++a)
#pragma unroll
        for (int b = 0; b < 2; ++b)
#pragma unroll
            for (int m = 0; m < 4; ++m)
#pragma unroll
                for (int n = 0; n < 2; ++n) acc[a][b][m][n] = (f32x4){0.f, 0.f, 0.f, 0.f};
    bf16x8 At[4][2], B0[2][2], B1[2][2];
    const char* cA = PG8_UA(cur); const char* cB = PG8_UB(cur); size_t cH = PG8_UH(cur);
    PG8_STAGE(PG8_SB(0, 0), cB, voffB); PG8_STAGE(PG8_SB(0, 1), cB + cH, voffB); PG8_STAGE(PG8_SA(0, 0), cA, voffA); PG8_STAGE(PG8_SA(0, 1), cA + hstepA, voffA);
    if (wr == 1) PG8_BAR;
    PG8_WAIT_V(2); PG8_BAR;
    PG8_STAGE(PG8_SB(1, 0), cB + kstep, voffB); PG8_STAGE(PG8_SA(1, 0), cA + kstep, voffA); PG8_STAGE(PG8_SB(1, 1), cB + cH + kstep, voffB);
    PG8_WAIT_V(6); PG8_BAR;
    for (;;) {
        const bool has_next = PG8_NEXT(ui + 1, nxt);
        const int nt = UMODE == 1 ? down_merged_nt(F.bid, cur.ks) : g.Ksp / 64;
        const char* nA = has_next ? PG8_UA(nxt) : cA; const char* nB = has_next ? PG8_UB(nxt) : cB; const size_t nH = has_next ? PG8_UH(nxt) : cH;
        const bool full = !HALFTAIL || cur.hm < 0;
        for (int t = 0; t < nt; t += 2) {
            const bool last = (t == nt - 2);
            const char* a1 = cA + (size_t)(t + 1) * kstep;
            const char* a2 = last ? nA : cA + (size_t)(t + 2) * kstep; const char* b2 = last ? nB : cB + (size_t)(t + 2) * kstep;
            const char* a3 = a2 + kstep; const char* b3 = b2 + kstep; const size_t h2 = last ? nH : cH;
            PG8_LDB(B0, 0, 0); PG8_LDB(B1, 0, 1); PG8_SCHED; PG8_LDA(At, 0, 0); PG8_STAGE(PG8_SA(1, 1), a1 + hstepA, voffA);
            PG8_WAIT_V(8); PG8_WAIT_L(0); PG8_BAR; PG8_MMA(0, 0, At, B0); if (full) PG8_MMA(0, 1, At, B1); PG8_BAR; PG8_SCHED;
            PG8_LDA(At, 0, 1); PG8_STAGE(PG8_SB(0, 0), b2, voffB); PG8_STAGE(PG8_SB(0, 1), b2 + h2, voffB); PG8_STAGE(PG8_SA(0, 0), a2, voffA);
            PG8_WAIT_V(8); PG8_WAIT_L(0); PG8_BAR; PG8_MMA(1, 0, At, B0); if (full) PG8_MMA(1, 1, At, B1); PG8_BAR; PG8_SCHED;
            PG8_LDB(B0, 1, 0); PG8_LDB(B1, 1, 1); PG8_SCHED; PG8_LDA(At, 1, 0); PG8_STAGE(PG8_SA(0, 1), a2 + hstepA, voffA);
            PG8_WAIT_V(8); PG8_WAIT_L(0); PG8_BAR; PG8_MMA(0, 0, At, B0); if (full) PG8_MMA(0, 1, At, B1); PG8_BAR; PG8_SCHED;
            PG8_LDA(At, 1, 1); PG8_STAGE(PG8_SB(1, 0), b3, voffB); PG8_STAGE(PG8_SB(1, 1), b3 + h2, voffB); PG8_STAGE(PG8_SA(1, 0), a3, voffA);
            PG8_WAIT_V(8); PG8_WAIT_L(0); PG8_BAR; PG8_MMA(1, 0, At, B0); if (full) PG8_MMA(1, 1, At, B1); PG8_BAR; PG8_SCHED;
        }
        if (wr == 0) PG8_BAR;
        {
            const int row0 = cur.pm * 256 + wr * 64 + fr, col0 = cur.pn * 256 + (HALFTAIL && cur.hm > 0 ? 128 : 0) + wc * 32 + (PERM ? 8 : 4) * fq;
#pragma unroll
            for (int ai = 0; ai < 2; ++ai)
#pragma unroll
                for (int m = 0; m < 4; ++m)
#pragma unroll
                    for (int bj = 0; bj < 2; ++bj) {
                        if (bj == 1 && !full) continue;
                        if constexpr (PERM) E.e8(row0 + ai * 128 + m * 16, col0 + bj * 128, acc[ai][bj][m][0], acc[ai][bj][m][1], cur.ks);
                        else {
#pragma unroll
                            for (int n = 0; n < 2; ++n) E(row0 + ai * 128 + m * 16, col0 + bj * 128 + n * 16, acc[ai][bj][m][n], cur.ks);
                        }
                    }
        }
        if (!has_next) break;
#pragma unroll
        for (int a = 0; a < 2; ++a)
#pragma unroll
            for (int b = 0; b < 2; ++b)
#pragma unroll
                for (int m = 0; m < 4; ++m)
#pragma unroll
                    for (int n = 0; n < 2; ++n) acc[a][b][m][n] = (f32x4){0.f, 0.f, 0.f, 0.f};
        cur = nxt; cA = nA; cB = nB; cH = nH; ++ui;
        if (wr == 1) PG8_BAR;
    }
    PG8_WAIT_V(0);
    PG8_BAR;
#undef PG8_SA
#undef PG8_SB
#undef PG8_STAGE
#undef PG8_LDA
#undef PG8_LDB
#undef PG8_MMA
#undef PG8_WAIT_V
#undef PG8_WAIT_L
#undef PG8_BAR
#undef PG8_SCHED
#undef PG8_UA
#undef PG8_UB
#undef PG8_UH
#undef PG8_NEXT
#undef PG8_K0
}

__device__ __forceinline__ void upgate_tile(int pm, int& rowbase, int& vlo, int& vhi, bool& first, bool& last) {
    if (pm < 16) { rowbase = pm * 256; vlo = 0; vhi = 255; first = true; last = true; return; }
    const int s = (pm - 16) / 5, i = (pm - 16) % 5;
    const int start = i == 0 ? 0 : (i == 1 ? 254 : (i == 2 ? 508 : (i == 3 ? 762 : 768)));
    rowbase = NCTX + s * 1024 + start; first = i == 0; last = i == 4;
    vlo = i == 0 ? 0 : (i == 4 ? 249 : 1); vhi = i == 4 ? 255 : 254;
}
__device__ __forceinline__ void gemm_upgate(const Frame& F, const bf16_t* A, const bf16_t* Bt, const float* cw, const float* cb, bf16_t* ACT, const int mode) {
    LAS unsigned char* lds = F.lds;
    const int tid = F.tid, wid = F.wave, lane = F.lane, wr = wid >> 2, wc = wid & 3, fr = lane & 15, fq = lane >> 4;
    constexpr int K = 1024, nt = K / 64, UP = 528;
    BigDesc g{A, Bt, K, K, 26, 22, 1, K};
    unsigned voffA[2], voffB[2];
#pragma unroll
    for (int i = 0; i < 2; ++i) { int R, C; stage_rc(tid * 16 + i * 8192, R, C); voffA[i] = (unsigned)(R * K + C) * 2u; voffB[i] = voffA[i]; }
    const size_t kstep = (size_t)(64 * 2), hstep = (size_t)128 * K * 2;
    const unsigned ldsw = (unsigned)wid * 1024u;
    const int aoff = lds_byte(wr * 64 + fr, fq * 8), boff = lds_byte(wc * 32 + fr, fq * 8);
#define PG8_SA(b, h) (((b) * 2 + (h)) * HTB)
#define PG8_SB(b, h) ((4 + (b) * 2 + (h)) * HTB)
#define PG8_STAGE(bufoff, gbase, voff) do { _Pragma("unroll") for (int _i = 0; _i < 2; ++_i) \
        __builtin_amdgcn_global_load_lds((const unsigned*)((const char*)(gbase) + (voff)[_i]), (LAS unsigned*)(lds + (bufoff) + ldsw + _i * 8192), 16, 0, 0); } while (0)
#define PG8_LDA(dst, b, h) do { _Pragma("unroll") for (int m = 0; m < 4; ++m) _Pragma("unroll") for (int k = 0; k < 2; ++k) dst[m][k] = *(const LAS bf16x8*)(lds + PG8_SA(b, h) + aoff + m * 2048 + k * 1024); } while (0)
#define PG8_LDB(dst, b, h) do { _Pragma("unroll") for (int n = 0; n < 2; ++n) _Pragma("unroll") for (int k = 0; k < 2; ++k) dst[n][k] = *(const LAS bf16x8*)(lds + PG8_SB(b, h) + boff + n * 2048 + k * 1024); } while (0)
#define PG8_MMA(ai, bj, At, Bt_) do { __builtin_amdgcn_s_setprio(1); _Pragma("unroll") for (int m = 0; m < 4; ++m) _Pragma("unroll") for (int n = 0; n < 2; ++n) _Pragma("unroll") for (int k = 0; k < 2; ++k) \
        acc[ai][bj][m][n] = __builtin_amdgcn_mfma_f32_16x16x32_bf16(Bt_[n][k], At[m][k], acc[ai][bj][m][n], 0, 0, 0); __builtin_amdgcn_s_setprio(0); } while (0)
#define PG8_WAIT_V(n) asm volatile("s_waitcnt vmcnt(" #n ")" ::: "memory")
#define PG8_WAIT_L(n) asm volatile("s_waitcnt lgkmcnt(" #n ")" ::: "memory")
#define PG8_BAR __builtin_amdgcn_s_barrier()
#define PG8_SCHED __builtin_amdgcn_sched_barrier(0)
    for (int ui = 0;; ++ui) {
        BUnit cur;
        int hm = -1;
        if (mode == 0) {
            if (F.G == 256 && ui == 2) { if (F.bid >= 120 || !big_next(g, 2, F.G, F.bid >> 1, cur)) break; hm = F.bid & 1; }
            else if (!big_next(g, ui, F.G, F.bid, cur)) break;
        } else if (mode == 1) {
            if (ui >= 2) break;
            BigDesc g23 = g; g23.nM = 23;
            if (!big_next(g23, ui, 256, F.bid, cur)) { cur.pm = 23; cur.pn = ui * 256 + F.bid - 506; }
        } else {
            if (ui >= 1 || F.bid >= 120) break;
            const int j = (F.bid >> 1) + 6; cur.pm = 23 + j / 22; cur.pn = j % 22; hm = F.bid & 1;
        }
        unsigned voffBh[2];
#pragma unroll
        for (int i = 0; i < 2; ++i) { int R, C; stage_rc(tid * 16 + i * 8192, R, C); const int Rs = hm < 0 ? R : R + 64 * hm + (R >= 64 ? 64 : 0); voffBh[i] = (unsigned)(Rs * K + C) * 2u; }
        int rowbase; { int a_, b_; bool c_, d_; upgate_tile(cur.pm, rowbase, a_, b_, c_, d_); }
        f32x4 acc[2][2][4][2];
#pragma unroll
        for (int a = 0; a < 2; ++a)
#pragma unroll
            for (int b = 0; b < 2; ++b)
#pragma unroll
                for (int m = 0; m < 4; ++m)
#pragma unroll
                    for (int n = 0; n < 2; ++n) acc[a][b][m][n] = (f32x4){0.f, 0.f, 0.f, 0.f};
        bf16x8 At[4][2], B0[2][2], B1[2][2];
        const char* cA = (const char*)A + (size_t)rowbase * K * 2; const char* cB = (const char*)Bt + (size_t)cur.pn * 2 * hstep;
        PG8_STAGE(PG8_SB(0, 0), cB, voffBh); PG8_STAGE(PG8_SB(0, 1), cB + hstep, voffB); PG8_STAGE(PG8_SA(0, 0), cA, voffA); PG8_STAGE(PG8_SA(0, 1), cA + hstep, voffA);
        if (wr == 1) PG8_BAR;
        PG8_WAIT_V(2); PG8_BAR;
        PG8_STAGE(PG8_SB(1, 0), cB + kstep, voffBh); PG8_STAGE(PG8_SA(1, 0), cA + kstep, voffA); PG8_STAGE(PG8_SB(1, 1), cB + hstep + kstep, voffB);
        PG8_WAIT_V(6); PG8_BAR;
        for (int t = 0; t < nt; t += 2) {
            const bool last = (t == nt - 2);
            const char* a1 = cA + (size_t)(t + 1) * kstep;
            const char* a2 = last ? cA : cA + (size_t)(t + 2) * kstep; const char* b2 = last ? cB : cB + (size_t)(t + 2) * kstep;
            const char* a3 = a2 + kstep; const char* b3 = b2 + kstep;
            PG8_LDB(B0, 0, 0); PG8_LDB(B1, 0, 1); PG8_SCHED; PG8_LDA(At, 0, 0); PG8_STAGE(PG8_SA(1, 1), a1 + hstep, voffA);
            PG8_WAIT_V(8); PG8_WAIT_L(0); PG8_BAR; PG8_MMA(0, 0, At, B0); if (hm < 0) PG8_MMA(0, 1, At, B1); PG8_BAR; PG8_SCHED;
            PG8_LDA(At, 0, 1); PG8_STAGE(PG8_SB(0, 0), b2, voffBh); PG8_STAGE(PG8_SB(0, 1), b2 + hstep, voffB); PG8_STAGE(PG8_SA(0, 0), a2, voffA);
            PG8_WAIT_V(8); PG8_WAIT_L(0); PG8_BAR; PG8_MMA(1, 0, At, B0); if (hm < 0) PG8_MMA(1, 1, At, B1); PG8_BAR; PG8_SCHED;
            PG8_LDB(B0, 1, 0); PG8_LDB(B1, 1, 1); PG8_SCHED; PG8_LDA(At, 1, 0); PG8_STAGE(PG8_SA(0, 1), a2 + hstep, voffA);
            PG8_WAIT_V(8); PG8_WAIT_L(0); PG8_BAR; PG8_MMA(0, 0, At, B0); if (hm < 0) PG8_MMA(0, 1, At, B1); PG8_BAR; PG8_SCHED;
            PG8_LDA(At, 1, 1); PG8_STAGE(PG8_SB(1, 0), b3, voffBh); PG8_STAGE(PG8_SB(1, 1), b3 + hstep, voffB); PG8_STAGE(PG8_SA(1, 0), a3, voffA);
            PG8_WAIT_V(8); PG8_WAIT_L(0); PG8_BAR; PG8_MMA(1, 0, At, B0); if (hm < 0) PG8_MMA(1, 1, At, B1); PG8_BAR; PG8_SCHED;
        }
        if (wr == 0) PG8_BAR;
        PG8_WAIT_V(0); PG8_BAR;
        asm volatile("" ::: "memory");
#pragma unroll
        for (int ai = 0; ai < 2; ++ai)
#pragma unroll
            for (int m = 0; m < 4; ++m)
#pragma unroll
                for (int bj = 0; bj < 2; ++bj)
#pragma unroll
                    for (int n = 0; n < 2; ++n) {
                        if (bj == 1 && hm >= 0) continue;
                        const f32x4 v = acc[ai][bj][m][n]; u32x2 w; w.x = pack2(v[0], v[1]); w.y = pack2(v[2], v[3]);
                        *(LAS u32x2*)(lds + (ai * 128 + wr * 64 + m * 16 + fr) * UP + (bj * 128 + wc * 32 + n * 16 + 4 * fq) * 2) = w;
                    }
        __syncthreads();
        __builtin_amdgcn_sched_barrier(0);
        int vlo, vhi; { int rb_; bool c_, d_; upgate_tile(cur.pm, rb_, vlo, vhi, c_, d_); }
        {
            const int c = hm < 0 ? (tid & 15) * 8 : (tid & 7) * 8, r0 = hm < 0 ? (tid >> 4) * 8 : (tid >> 3) * 4, nrow = hm < 0 ? 8 : 4, boffc = hm < 0 ? 128 : 64;
            const int ca = cur.pn * 128 + (hm < 0 ? 0 : 64 * hm) + c, cbn = 2816 + ca;
            float wa[3][8], wb[3][8], ba8[8], bb8[8];
#pragma unroll
            for (int q = 0; q < 2; ++q) {
#pragma unroll
                for (int tp = 0; tp < 3; ++tp) {
                    const f32x4 x = *(const f32x4*)(cw + tp * 5632 + ca + q * 4), y = *(const f32x4*)(cw + tp * 5632 + cbn + q * 4);
#pragma unroll
                    for (int jj = 0; jj < 4; ++jj) { wa[tp][q * 4 + jj] = x[jj]; wb[tp][q * 4 + jj] = y[jj]; }
                }
                const f32x4 x = *(const f32x4*)(cb + ca + q * 4), y = *(const f32x4*)(cb + cbn + q * 4);
#pragma unroll
                for (int jj = 0; jj < 4; ++jj) { ba8[q * 4 + jj] = x[jj]; bb8[q * 4 + jj] = y[jj]; }
            }
            const bf16x8 z = (bf16x8){0, 0, 0, 0, 0, 0, 0, 0};
            bf16x8 ap, bp, ac, bc, an, bn;
            {
                const bool hp0 = r0 > 0;
                ap = hp0 ? *(const LAS bf16x8*)(lds + (r0 - 1) * UP + c * 2) : z; bp = hp0 ? *(const LAS bf16x8*)(lds + (r0 - 1) * UP + (boffc + c) * 2) : z;
                ac = *(const LAS bf16x8*)(lds + r0 * UP + c * 2); bc = *(const LAS bf16x8*)(lds + r0 * UP + (boffc + c) * 2);
            }
#pragma unroll 1
            for (int i = 0; i < nrow; ++i) {
                const int r = r0 + i;
                const bool hn = r < 255;
                an = hn ? *(const LAS bf16x8*)(lds + (r + 1) * UP + c * 2) : z; bn = hn ? *(const LAS bf16x8*)(lds + (r + 1) * UP + (boffc + c) * 2) : z;
                if (r >= vlo && r <= vhi) {
                    float ov[8];
#pragma unroll
                    for (int e = 0; e < 8; ++e) {
                        const float ua = bf2f((unsigned short)ap[e]) * wa[0][e] + bf2f((unsigned short)ac[e]) * wa[1][e] + bf2f((unsigned short)an[e]) * wa[2][e] + ba8[e];
                        const float ub = bf2f((unsigned short)bp[e]) * wb[0][e] + bf2f((unsigned short)bc[e]) * wb[1][e] + bf2f((unsigned short)bn[e]) * wb[2][e] + bb8[e];
                        ov[e] = siluf_(ua) * ub;
                    }
                    u32x4 w; w.x = pack2(ov[0], ov[1]); w.y = pack2(ov[2], ov[3]); w.z = pack2(ov[4], ov[5]); w.w = pack2(ov[6], ov[7]);
                    *(u32x4*)(ACT + (size_t)(rowbase + r) * 2816 + ca) = w;
                }
                ap = ac; bp = bc; ac = an; bc = bn;
            }
        }
        __syncthreads();
    }
#undef PG8_SA
#undef PG8_SB
#undef PG8_STAGE
#undef PG8_LDA
#undef PG8_LDB
#undef PG8_MMA
#undef PG8_WAIT_V
#undef PG8_WAIT_L
#undef PG8_BAR
#undef PG8_SCHED
}

struct CvtJob { const float* src; bf16_t* dst; int K, N, Npad, tiles, upperm; };
__device__ __forceinline__ void cvt_tile(const Frame& F, const CvtJob& j, int t) {
    LAS float* tile = (LAS float*)F.lds;
    const int tk = j.K / 64, kt = t % tk, ntile = t / tk, k0 = kt * 64, n0 = ntile * 64;
    const int tid = F.tid;
    {
        const int r = tid >> 4, c4 = (tid & 15) * 4;
#pragma unroll
        for (int i = 0; i < 2; ++i) {
            const int kr = r + 32 * i;
            f32x4 v = (f32x4){0.f, 0.f, 0.f, 0.f};
            if (n0 + c4 < j.N) v = *(const f32x4*)(j.src + (size_t)(k0 + kr) * j.N + n0 + c4);
            tile[kr * 65 + c4 + 0] = v[0]; tile[kr * 65 + c4 + 1] = v[1]; tile[kr * 65 + c4 + 2] = v[2]; tile[kr * 65 + c4 + 3] = v[3];
        }
    }
    __syncthreads();
    {
        const int n = tid >> 3, kq = (tid & 7) * 8;
        u32x4 w;
        w.x = pack2(tile[(kq + 0) * 65 + n], tile[(kq + 1) * 65 + n]); w.y = pack2(tile[(kq + 2) * 65 + n], tile[(kq + 3) * 65 + n]);
        w.z = pack2(tile[(kq + 4) * 65 + n], tile[(kq + 5) * 65 + n]); w.w = pack2(tile[(kq + 6) * 65 + n], tile[(kq + 7) * 65 + n]);
        const int drow = j.upperm ? (n0 < 2816 ? (n0 >> 7) * 256 + (n0 & 127) : ((n0 - 2816) >> 7) * 256 + 128 + ((n0 - 2816) & 127)) + n : n0 + n;
        *(u32x4*)(j.dst + (size_t)drow * j.K + k0 + kq) = w;
    }
    __syncthreads();
}

__device__ __forceinline__ void cvt_group(const Frame& F, const PRef& p, int group, int bfirst, int nb, int rot0) {
    if (F.bid < bfirst || F.bid >= bfirst + nb) return;
    unsigned char* ws = p.ws();
    const int vb = F.bid - bfirst;
    int rot = rot0;
#define CVT(srcp, dstoff, K_, N_, Npad_) do { CvtJob jb; jb.src = (srcp); jb.dst = (bf16_t*)(ws + (dstoff)); jb.K = (K_); jb.N = (N_); jb.Npad = (Npad_); jb.tiles = ((K_) / 64) * ((Npad_) / 64); jb.upperm = ((N_) == 5632); \
        for (int t = (vb + nb - (rot % nb)) % nb; t < jb.tiles; t += nb) cvt_tile(F, jb, t); rot += jb.tiles; } while (0)
    if (group == 0) {
        CVT(p.in(19), WS_WAIN, 1024, 1952, 2048);
        CVT(p.in(22), WS_WUQ, 256, 768, 768);
        CVT(p.in(23), WS_WUKV, 128, 1024, 1024);
    } else if (group == 1) {
        CVT(p.in(14), WS_WOUT, 1024, 1024, 1024);
        CVT(p.in(15), WS_WUP, 1024, 5632, 5632);
    } else if (group == 3) {
        CVT(p.in(18), WS_WDN, 2816, 1024, 1024);
    } else {
        CVT(p.in(28), WS_WBIN, 1024, 3456, 3584);
        CVT(p.in(14) + (size_t)1024 * 1024, WS_WOUT + (size_t)1024 * 1024 * 2, 1024, 1024, 1024);
        CVT(p.in(15) + (size_t)1024 * 5632, WS_WUP + (size_t)5632 * 1024 * 2, 1024, 5632, 5632);
        CVT(p.in(18) + (size_t)2816 * 1024, WS_WDN + (size_t)1024 * 2816 * 2, 2816, 1024, 1024);
        CVT(p.in(35), WS_WWUP, 64, 512, 512);
        CVT(p.in(35) + 64 * 512, WS_WWUP + 512 * 64 * 2, 64, 512, 512);
        CVT(p.in(37), WS_WAUP, 64, 512, 512);
        CVT(p.in(37) + 64 * 512, WS_WAUP + 512 * 64 * 2, 64, 512, 512);
        CVT(p.in(38), WS_WGUP, 128, 512, 512);
    }
#undef CVT
}
__device__ __forceinline__ void phase_prep(const Frame& F, const PRef& p) {
    unsigned char* ws = p.ws();
    {
        LAS float* sc = (LAS float*)F.lds;
        LAS float* red = sc + 3 * 1024;
        for (int i = F.tid; i < 3 * 1024; i += NTHREADS) {
            const int c = i >> 10, k = i & 1023;
            const float v = c == 0 ? p.in(9)[k] : p.in(8)[(c - 1) * 1024 + k];
            sc[i] = siluf_(v);
        }
        __syncthreads();
        float* mod = (float*)(ws + WS_MOD);
        FOR_UNITS(u, 192, 0) {
            const int l = u / 96, n0 = (u % 96) * 64, col = F.tid & 63, kg = F.tid >> 6;
            const float* w = p.in(10) + (size_t)l * 1024 * 6144 + (size_t)(kg * 128) * 6144 + n0 + col;
            float a0 = 0.f, a1 = 0.f, a2 = 0.f;
#pragma unroll 8
            for (int k = 0; k < 128; ++k) { const float wv = w[(size_t)k * 6144]; const int kk = kg * 128 + k; a0 += sc[kk] * wv; a1 += sc[1024 + kk] * wv; a2 += sc[2048 + kk] * wv; }
            red[(kg * 3 + 0) * 64 + col] = a0; red[(kg * 3 + 1) * 64 + col] = a1; red[(kg * 3 + 2) * 64 + col] = a2;
            __syncthreads();
            if (F.tid < 192) {
                const int c = F.tid >> 6, cc = F.tid & 63; float s = 0.f;
#pragma unroll
                for (int q = 0; q < 8; ++q) s += red[(q * 3 + c) * 64 + cc];
                mod[(size_t)(l * 3 + c) * 6144 + n0 + cc] = s + p.in(11)[l * 6144 + n0 + cc];
            }
            __syncthreads();
        }
    }
    cvt_group(F, p, 0, 0, F.G, 192);
}

__device__ __forceinline__ void phase_norm(const Frame& F, const float* xa, const float* xb, const bf16_t* part, const float* gate, float* xout,
                                           const float* g, const float* sc, const float* sh, bf16_t* hb, bool do_norm, const int q4row = NTOK) {
    const int nw = F.G * 8;
    for (int row = F.bid * 8 + F.wave; row < NTOK; row += nw) {
        const float* x = row < NCTX ? xa + (size_t)row * 1024 : xb + (size_t)(row - NCTX) * 1024;
        const int c = cond_of(row);
        f32x4 v[4]; float ss = 0.f;
#pragma unroll
        for (int i = 0; i < 4; ++i) {
            const int col = i * 256 + F.lane * 4;
            v[i] = *(const f32x4*)(x + col);
            if (part) {
                const u32x2 q0 = *(const u32x2*)(part + (size_t)row * 1024 + col), q1 = *(const u32x2*)(part + (size_t)NTOK * 1024 + (size_t)row * 1024 + col);
                f32x4 ps = (f32x4){bf2f(q0.x & 0xffffu) + bf2f(q1.x & 0xffffu), bf2f(q0.x >> 16) + bf2f(q1.x >> 16), bf2f(q0.y & 0xffffu) + bf2f(q1.y & 0xffffu), bf2f(q0.y >> 16) + bf2f(q1.y >> 16)};
                if (row >= q4row) {
                    const u32x2 q2 = *(const u32x2*)(part + (size_t)2 * NTOK * 1024 + (size_t)row * 1024 + col), q3 = *(const u32x2*)(part + (size_t)3 * NTOK * 1024 + (size_t)row * 1024 + col);
                    ps = ps + (f32x4){bf2f(q2.x & 0xffffu) + bf2f(q3.x & 0xffffu), bf2f(q2.x >> 16) + bf2f(q3.x >> 16), bf2f(q2.y & 0xffffu) + bf2f(q3.y & 0xffffu), bf2f(q2.y >> 16) + bf2f(q3.y >> 16)};
                }
                const f32x4 gt = *(const f32x4*)(gate + c * 6144 + col);
                v[i] = v[i] + gt * ps;
                *(f32x4*)(xout + (size_t)row * 1024 + col) = v[i];
            }
            ss += v[i][0] * v[i][0] + v[i][1] * v[i][1] + v[i][2] * v[i][2] + v[i][3] * v[i][3];
        }
        if (!do_norm) continue;
        ss = wave_sum(ss);
        const float rstd = rsqrtf(ss * (1.0f / 1024.0f) + EPS);
#pragma unroll
        for (int i = 0; i < 4; ++i) {
            const int col = i * 256 + F.lane * 4;
            const f32x4 gg = *(const f32x4*)(g + col), s1 = *(const f32x4*)(sc + c * 6144 + col), s0 = *(const f32x4*)(sh + c * 6144 + col);
            f32x4 h;
#pragma unroll
            for (int j = 0; j < 4; ++j) h[j] = v[i][j] * rstd * gg[j] * (1.0f + s1[j]) + s0[j];
            u32x2 w; w.x = pack2(h[0], h[1]); w.y = pack2(h[2], h[3]);
            *(u32x2*)(hb + (size_t)row * 1024 + col) = w;
        }
    }
}

__device__ __forceinline__ void seq_of_unit384(int u, int& s, int& c, int& h, int& tok0, int& nc) {
    if (u < 256) { s = u >> 4; c = (u >> 2) & 3; h = u & 3; tok0 = s * 256 + c * 64; nc = 4; }
    else { const int v = u - 256; s = 16 + (v >> 6); c = (v >> 2) & 15; h = v & 3; tok0 = NCTX + (s - 16) * 1024 + c * 64; nc = 16; }
}
__device__ __forceinline__ void phase_l0_tok(const Frame& F, const PRef& p) {
    unsigned char* ws = p.ws();
    const float* P = (const float*)(ws + WS_P0);
    bf16_t* cqn = (bf16_t*)(ws + WS_CQN); bf16_t* ckvn = (bf16_t*)(ws + WS_CKVN);
    const int nw = F.G * 8;
    for (int row = F.bid * 8 + F.wave; row < NKROW; row += nw) {
        if (row < NTOK) {
            const float* pr = P + (size_t)row * 2048;
            const f32x4 q = *(const f32x4*)(pr + F.lane * 4);
            float ss = wave_sum(q[0] * q[0] + q[1] * q[1] + q[2] * q[2] + q[3] * q[3]);
            float rstd = rsqrtf(ss * (1.0f / 256.0f) + EPS);
            const f32x4 gq = *(const f32x4*)(p.in(20) + F.lane * 4);
            u32x2 w; w.x = pack2(q[0] * rstd * gq[0], q[1] * rstd * gq[1]); w.y = pack2(q[2] * rstd * gq[2], q[3] * rstd * gq[3]);
            *(u32x2*)(cqn + (size_t)row * 256 + F.lane * 4) = w;
            const f32x2 kv = *(const f32x2*)(pr + 256 + F.lane * 2);
            ss = wave_sum(kv[0] * kv[0] + kv[1] * kv[1]);
            rstd = rsqrtf(ss * (1.0f / 128.0f) + EPS);
            const f32x2 gk = *(const f32x2*)(p.in(21) + F.lane * 2);
            const float o0 = kv[0] * rstd * gk[0], o1 = kv[1] * rstd * gk[1];
            *(unsigned*)(ckvn + (size_t)row * 128 + F.lane * 2) = pack2(o0, o1);
            if (row < NCTX) {
                *(f32x2*)(p.out() + OUT_CKV + (size_t)row * 128 + F.lane * 2) = (f32x2){o0, o1};
                if (F.lane < 32) p.out()[OUT_KROPE + (size_t)row * 32 + F.lane] = pr[384 + F.lane];
            }
        } else {
            const int i = row - NTOK;
            const f32x2 kv = *(const f32x2*)(p.in(2) + (size_t)i * 128 + F.lane * 2);
            *(unsigned*)(ckvn + (size_t)row * 128 + F.lane * 2) = pack2(kv[0], kv[1]);
        }
    }
    {
        LAS unsigned char* L = F.lds;
        constexpr int KPI = 160, VPI = 288, O_KF = 0, O_KB = 64 * KPI, O_V = 2 * 64 * KPI;
        float* KVS = (float*)(ws + WS_KVS);
        const int tid = F.tid, w = F.wave, fr = F.lane & 15, fq = F.lane >> 4;
        FOR_UNITS(u, 384, 0) {
            int s, c, h, tok0, nc; seq_of_unit384(u, s, c, h, tok0, nc);
            const float lgf = __logf(sigmoidf_(p.in(26)[h])), lgb = __logf(sigmoidf_(p.in(26)[4 + h]));
            {
                const int row = tid >> 3, ch = tid & 7;
                const float* pr = P + (size_t)(tok0 + row) * 2048;
                const f32x4 k0 = *(const f32x4*)(pr + 672 + h * 64 + ch * 8), k1 = *(const f32x4*)(pr + 672 + h * 64 + ch * 8 + 4);
                f32x4 vv[4];
#pragma unroll
                for (int i = 0; i < 4; ++i) vv[i] = *(const f32x4*)(pr + 928 + h * 128 + ch * 16 + i * 4);
                const float df = 0.125f * __expf(lgf * (float)(63 - row)), db = 0.125f * __expf(lgb * (float)row);
                u32x4 t;
                t.x = pack2(k0[0] * df, k0[1] * df); t.y = pack2(k0[2] * df, k0[3] * df); t.z = pack2(k1[0] * df, k1[1] * df); t.w = pack2(k1[2] * df, k1[3] * df); *(LAS u32x4*)(L + O_KF + row * KPI + ch * 16) = t;
                t.x = pack2(k0[0] * db, k0[1] * db); t.y = pack2(k0[2] * db, k0[3] * db); t.z = pack2(k1[0] * db, k1[1] * db); t.w = pack2(k1[2] * db, k1[3] * db); *(LAS u32x4*)(L + O_KB + row * KPI + ch * 16) = t;
#pragma unroll
                for (int i = 0; i < 2; ++i) { t.x = pack2(vv[2 * i][0], vv[2 * i][1]); t.y = pack2(vv[2 * i][2], vv[2 * i][3]); t.z = pack2(vv[2 * i + 1][0], vv[2 * i + 1][1]); t.w = pack2(vv[2 * i + 1][2], vv[2 * i + 1][3]);
                    *(LAS u32x4*)(L + O_V + row * VPI + ch * 32 + i * 16) = t; }
            }
            __syncthreads();
            bf16x8 Bf[2];
#pragma unroll
            for (int ks = 0; ks < 2; ++ks) {
                const LAS unsigned char* vp = L + O_V + (32 * ks + 8 * fq + (fr >> 2)) * VPI + (w * 16 + 4 * (fr & 3)) * 2;
                const bf16x4 v0 = __builtin_amdgcn_ds_read_tr16_b64_v4i16((LAS bf16x4*)vp), v1 = __builtin_amdgcn_ds_read_tr16_b64_v4i16((LAS bf16x4*)(vp + 4 * VPI));
                bf16x8 x; x[0] = v0[0]; x[1] = v0[1]; x[2] = v0[2]; x[3] = v0[3]; x[4] = v1[0]; x[5] = v1[1]; x[6] = v1[2]; x[7] = v1[3]; Bf[ks] = x;
            }
            float* o = KVS + (size_t)u * 2 * 8192;
#pragma unroll
            for (int d = 0; d < 2; ++d)
#pragma unroll
                for (int et = 0; et < 4; ++et) {
                    f32x4 a = (f32x4){0.f, 0.f, 0.f, 0.f};
#pragma unroll
                    for (int ks = 0; ks < 2; ++ks) {
                        const LAS unsigned char* kp = L + (d ? O_KB : O_KF) + (32 * ks + 8 * fq + (fr >> 2)) * KPI + (et * 16 + 4 * (fr & 3)) * 2;
                        const bf16x4 v0 = __builtin_amdgcn_ds_read_tr16_b64_v4i16((LAS bf16x4*)kp), v1 = __builtin_amdgcn_ds_read_tr16_b64_v4i16((LAS bf16x4*)(kp + 4 * KPI));
                        bf16x8 x; x[0] = v0[0]; x[1] = v0[1]; x[2] = v0[2]; x[3] = v0[3]; x[4] = v1[0]; x[5] = v1[1]; x[6] = v1[2]; x[7] = v1[3];
                        a = __builtin_amdgcn_mfma_f32_16x16x32_bf16(x, Bf[ks], a, 0, 0, 0);
                    }
#pragma unroll
                    for (int r = 0; r < 4; ++r) o[d * 8192 + (et * 16 + 4 * fq + r) * 128 + w * 16 + fr] = a[r];
                }
            __syncthreads();
        }
    }
}

__device__ __forceinline__ void phase_l0_prefix(const Frame& F, const PRef& p, int rot) {
    float* KVS = (float*)(p.ws() + WS_KVS);
    FOR_UNITS(u, 576, rot) {
        const int qd = u & 3, d = (u >> 2) & 1, h = (u >> 3) & 3, s = u >> 5;
        const int nc = s < 16 ? 4 : 16;
        const int ubase = s < 16 ? s * 16 + h : 256 + (s - 16) * 64 + h;
        const float g64 = __expf(64.0f * __logf(sigmoidf_(p.in(26)[d * 4 + h])));
        const int i = qd * 2048 + F.tid * 4;
        float* base = KVS + (size_t)ubase * 16384 + d * 8192 + i;
        f32x4 kv[16];
#pragma unroll
        for (int c = 0; c < 16; ++c) if (c < nc) kv[c] = *(const f32x4*)(base + (size_t)c * 4 * 16384);
        f32x4 S = (f32x4){0.f, 0.f, 0.f, 0.f};
        if (s >= 16) S = *(const f32x4*)(p.in(4) + (size_t)(((s - 16) * 2 + d) * 4 + h) * 8192 + i);
        if (d == 0) {
#pragma unroll
            for (int c = 0; c < 16; ++c) if (c < nc) { *(f32x4*)(base + (size_t)c * 4 * 16384) = S; S = S * g64 + kv[c]; }
        } else {
#pragma unroll
            for (int c = 15; c >= 0; --c) if (c < nc) { *(f32x4*)(base + (size_t)c * 4 * 16384) = S; S = S * g64 + kv[c]; }
        }
        if (s < 16) *(f32x4*)(p.out() + OUT_SRET + (size_t)((s * 2 + d) * 4 + h) * 8192 + i) = S;
    }
}

__device__ __forceinline__ size_t vt_base(int kr, int nheads, int dv, int& nkeys, int& key) {
    if (kr < NCTX) { nkeys = 256; key = kr & 255; return (size_t)(kr >> 8) * nheads * dv * 256; }
    const int v = kr - NCTX; const int b = v / 1536; nkeys = 1536; key = v - b * 1536;
    return (size_t)16 * nheads * dv * 256 + (size_t)b * nheads * dv * 1536;
}
__device__ __forceinline__ void phase_l0_qkv(const Frame& F, const PRef& p) {
    unsigned char* ws = p.ws();
    const float* P = (const float*)(ws + WS_P0); const float* QR = (const float*)(ws + WS_QRAW); const float* KVR = (const float*)(ws + WS_KVRAW);
    bf16_t* Q = (bf16_t*)(ws + WS_Q0); bf16_t* K = (bf16_t*)(ws + WS_K0); bf16_t* VT = (bf16_t*)(ws + WS_VT0);
    const int nw = F.G * 8, lane = F.lane;
    const float qscale = 0.10206207261596577f;
    for (int row = F.bid * 8 + F.wave; row < NKROW; row += nw) {
        const bool istok = row < NTOK, lat = istok && row >= NCTX;
        float cs = 1.f, sn = 0.f;
        if (lat && lane >= 32 && lane < 48) {
            const int t = (row - NCTX) & 1023, a = lane - 32;
            const float pos = a < 8 ? (float)(t >> 6) : (float)(t & 63);
            const float inv = __powf(10000.0f, -(float)(a & 7) * 0.125f);
            const float ang = pos * inv; cs = __cosf(ang); sn = __sinf(ang);
        }
        int kr;
        if (row < NCTX) kr = row; else if (row < NTOK) { const int v = row - NCTX; kr = NCTX + (v >> 10) * 1536 + (v & 1023); }
        else { const int i = row - NTOK; kr = NCTX + (i >> 9) * 1536 + 1024 + (i & 511); }
        const float* krope = istok ? P + (size_t)row * 2048 + 384 : p.in(3) + (size_t)(row - NTOK) * 32;
        f32x2 qv[8], kv2[8]; float vv[8];
        f32x2 kro = (f32x2){0.f, 0.f};
        if (lane >= 32 && lane < 48) kro = *(const f32x2*)(krope + 2 * (lane - 32));
#pragma unroll
        for (int h = 0; h < 8; ++h) {
            qv[h] = (f32x2){0.f, 0.f};
            if (istok && lane < 48) qv[h] = *(const f32x2*)(QR + (size_t)row * 768 + h * 96 + 2 * lane);
            kv2[h] = kro;
            if (lane < 32) kv2[h] = *(const f32x2*)(KVR + (size_t)row * 1024 + h * 128 + 2 * lane);
            vv[h] = KVR[(size_t)row * 1024 + h * 128 + 64 + lane];
        }
        f32x2 gq = (f32x2){0.f, 0.f}, gk = (f32x2){0.f, 0.f};
        if (lane < 48) { gq = *(const f32x2*)(p.in(24) + 2 * lane); gk = *(const f32x2*)(p.in(25) + 2 * lane); }
#pragma unroll
        for (int h = 0; h < 8; ++h) {
            if (istok) {
                float x1 = qv[h][0], x2 = qv[h][1];
                const float rstd = rsqrtf(wave_sum(x1 * x1 + x2 * x2) * (1.0f / 96.0f) + EPS);
                if (lane < 48) {
                    x1 = x1 * rstd * gq[0]; x2 = x2 * rstd * gq[1];
                    const float y1 = x1 * cs - x2 * sn, y2 = x1 * sn + x2 * cs;
                    *(unsigned*)(Q + (size_t)row * 768 + h * 96 + 2 * lane) = pack2(y1 * qscale, y2 * qscale);
                }
            }
            {
                float x1 = kv2[h][0], x2 = kv2[h][1];
                const float rstd = rsqrtf(wave_sum(x1 * x1 + x2 * x2) * (1.0f / 96.0f) + EPS);
                if (lane < 48) {
                    x1 = x1 * rstd * gk[0]; x2 = x2 * rstd * gk[1];
                    const float y1 = x1 * cs - x2 * sn, y2 = x1 * sn + x2 * cs;
                    *(unsigned*)(K + (size_t)kr * 768 + h * 96 + 2 * lane) = pack2(y1, y2);
                }
            }
            VT[(size_t)kr * 512 + h * 64 + lane] = f2bf(vv[h]);
        }
    }
}

template <int DQK, int DV, int NC, int NQT>
struct AttnState { f32x4 O[NC][DV / 16][NQT]; float l[NC][NQT]; };

template <int DQK, int DV, int NC, int NQT>
__device__ __forceinline__ void attn_wave(const bf16_t* __restrict__ Q, const bf16_t* __restrict__ K, const bf16_t* __restrict__ Vt,
                                          int qtok0, int krow0, int nkeys, int hh0  , int lane, AttnState<DQK, DV, NC, NQT>& st) {
    constexpr int NS = DQK / 32, NE = DV / 16, RS = 8 * DQK;
    const int fr = lane & 15, fq = lane >> 4;
    bf16x8 Qf[NC][NQT][NS];
#pragma unroll
    for (int c = 0; c < NC; ++c)
#pragma unroll
        for (int qt = 0; qt < NQT; ++qt)
#pragma unroll
            for (int s = 0; s < NS; ++s) Qf[c][qt][s] = *(const bf16x8*)(Q + (size_t)(qtok0 + qt * 16 + fr) * RS + (hh0 + c) * DQK + s * 32 + fq * 8);
    float m[NC][NQT];
#pragma unroll
    for (int c = 0; c < NC; ++c)
#pragma unroll
        for (int qt = 0; qt < NQT; ++qt) { m[c][qt] = -1e30f; st.l[c][qt] = 0.f;
#pragma unroll
            for (int e = 0; e < NE; ++e) st.O[c][e][qt] = (f32x4){0.f, 0.f, 0.f, 0.f}; }
    for (int key0 = 0; key0 < nkeys; key0 += 32) {
        bf16x8 Pf[NC][NQT];
#pragma unroll
        for (int c = 0; c < NC; ++c) {
            f32x4 S[2][NQT];
#pragma unroll
            for (int kt = 0; kt < 2; ++kt) {
                bf16x8 Kf[NS];
#pragma unroll
                for (int s = 0; s < NS; ++s) Kf[s] = *(const bf16x8*)(K + (size_t)(krow0 + key0 + kt * 16 + fr) * RS + (hh0 + c) * DQK + s * 32 + fq * 8);
#pragma unroll
                for (int qt = 0; qt < NQT; ++qt) {
                    f32x4 a = (f32x4){0.f, 0.f, 0.f, 0.f};
#pragma unroll
                    for (int s = 0; s < NS; ++s) a = __builtin_amdgcn_mfma_f32_16x16x32_bf16(Kf[s], Qf[c][qt][s], a, 0, 0, 0);
                    S[kt][qt] = a;
                }
            }
#pragma unroll
            for (int qt = 0; qt < NQT; ++qt) {
                float mx = fmaxf(fmaxf(fmaxf(S[0][qt][0], S[0][qt][1]), fmaxf(S[0][qt][2], S[0][qt][3])), fmaxf(fmaxf(S[1][qt][0], S[1][qt][1]), fmaxf(S[1][qt][2], S[1][qt][3])));
                mx = fmaxf(mx, __shfl_xor(mx, 16)); mx = fmaxf(mx, __shfl_xor(mx, 32));
                const float mn = fmaxf(m[c][qt], mx), alpha = __expf(m[c][qt] - mn);
                m[c][qt] = mn;
                float pv[8]; float ps = 0.f;
#pragma unroll
                for (int j = 0; j < 4; ++j) { pv[j] = __expf(S[0][qt][j] - mn); pv[4 + j] = __expf(S[1][qt][j] - mn); ps += pv[j] + pv[4 + j]; }
                st.l[c][qt] = st.l[c][qt] * alpha + ps;
#pragma unroll
                for (int e = 0; e < NE; ++e) st.O[c][e][qt] *= alpha;
                u32x4 pk; pk.x = pack2(pv[0], pv[1]); pk.y = pack2(pv[2], pv[3]); pk.z = pack2(pv[4], pv[5]); pk.w = pack2(pv[6], pv[7]);
                Pf[c][qt] = __builtin_bit_cast(bf16x8, pk);
            }
        }
#pragma unroll
        for (int e = 0; e < NE; ++e) {
            const bf16_t* vp = Vt + (size_t)(e * 16 + fr) * nkeys + key0 + 4 * fq;
            const bf16x4 v0 = *(const bf16x4*)vp, v1 = *(const bf16x4*)(vp + 16);
            bf16x8 Vf; Vf[0] = v0[0]; Vf[1] = v0[1]; Vf[2] = v0[2]; Vf[3] = v0[3]; Vf[4] = v1[0]; Vf[5] = v1[1]; Vf[6] = v1[2]; Vf[7] = v1[3];
#pragma unroll
            for (int c = 0; c < NC; ++c)
#pragma unroll
                for (int qt = 0; qt < NQT; ++qt) st.O[c][e][qt] = __builtin_amdgcn_mfma_f32_16x16x32_bf16(Vf, Pf[c][qt], st.O[c][e][qt], 0, 0, 0);
        }
    }
#pragma unroll
    for (int c = 0; c < NC; ++c)
#pragma unroll
        for (int qt = 0; qt < NQT; ++qt) { float l = st.l[c][qt]; l += __shfl_xor(l, 16); l += __shfl_xor(l, 32); st.l[c][qt] = 1.0f / l; }
}

__device__ __forceinline__ int attn_unit_xcd(int bid, int which) {
    const int x = bid & 7, idx = bid >> 3;
    return which == 0 ? (2 * x + (idx >> 4)) * 16 + (idx & 15) : 256 + (x * 16 + (idx >> 1)) * 2 + (idx & 1);
}
template <int DQK, int DV, int VH, class OutFn>
__device__ __forceinline__ void attn_block(const Frame& F, const bf16_t* __restrict__ Q, const bf16_t* __restrict__ K, const bf16_t* __restrict__ VT, const OutFn& out, int unit, float shift) {
    constexpr int NS = DQK / 32, NE = DV / 16, RS = 8 * DQK, KPC = DQK / 8;
    constexpr int KB = 128 * 256, VP = DV * 2 + 32, VB = 128 * VP, STG = KB + VB, VPC = DV / 8;
    constexpr int NKP = 128 * KPC / NTHREADS, NVP = 128 * VPC / NTHREADS;
    LAS unsigned char* lds = F.lds;
    const int lane = F.lane, fr = lane & 15, fq = lane >> 4, wave = F.wave, tid = F.tid;
    const bool lat = unit < 256;
    int ab, h, q0, nkeys, NQG;
    if (lat) { ab = 16 + (unit >> 7); h = (unit >> 4) & 7; q0 = (unit & 15) * 64; nkeys = 1536; NQG = 2; }
    else { const int v = unit - 256; ab = v >> 4; h = (v >> 1) & 7; q0 = (v & 1) * 128; nkeys = 256; NQG = 4; }
    const int NKS = 8 / NQG, qg = wave % NQG, ks = wave / NQG, kslice = 128 / NKS, nit = kslice / 32;
    const int qtok0 = (lat ? NCTX + (ab - 16) * 1024 : ab * 256) + q0 + qg * 32;
    const int krow0 = lat ? NCTX + (ab - 16) * 1536 : ab * 256;
    const bf16_t* vg = VT + (size_t)krow0 * (VH * DV) + (h * VH / 8) * DV;
    const bf16_t* kg = K + (size_t)krow0 * RS + h * DQK;
    bf16x8 Qf[2][NS];
#pragma unroll
    for (int qt = 0; qt < 2; ++qt)
#pragma unroll
        for (int s = 0; s < NS; ++s) Qf[qt][s] = *(const bf16x8*)(Q + (size_t)(qtok0 + qt * 16 + fr) * RS + h * DQK + s * 32 + fq * 8);
    f32x4 O[NE][2]; float l[2];
    const float sh2 = shift * 1.44269504f;
#pragma unroll
    for (int qt = 0; qt < 2; ++qt) { l[qt] = 0.f;
#pragma unroll
        for (int e = 0; e < NE; ++e) O[e][qt] = (f32x4){0.f, 0.f, 0.f, 0.f}; }
    u32x4 kregA[NKP], vregA[NVP], kregB[DV == 64 ? NKP : 1], vregB[DV == 64 ? NVP : 1];
#define AT_LOAD(kreg, vreg, st) do { \
        _Pragma("unroll") for (int i = 0; i < NKP; ++i) { const int pid = tid + i * NTHREADS, row = pid / KPC, ch = pid % KPC; kreg[i] = *(const u32x4*)(kg + (size_t)((st) * 128 + row) * RS + ch * 8); } \
        _Pragma("unroll") for (int i = 0; i < NVP; ++i) { const int pid = tid + i * NTHREADS, row = pid / VPC, ch = pid % VPC; vreg[i] = *(const u32x4*)(vg + (size_t)((st) * 128 + row) * (VH * DV) + ch * 8); } } while (0)
#define AT_WRITE(kreg, vreg, buf) do { \
        _Pragma("unroll") for (int i = 0; i < NKP; ++i) { const int pid = tid + i * NTHREADS, row = pid / KPC, ch = pid % KPC; *(LAS u32x4*)(lds + (buf) * STG + row * 256 + ((ch ^ (row & 15)) << 4)) = kreg[i]; } \
        _Pragma("unroll") for (int i = 0; i < NVP; ++i) { const int pid = tid + i * NTHREADS, row = pid / VPC, ch = pid % VPC; *(LAS u32x4*)(lds + (buf) * STG + KB + row * VP + ch * 16) = vreg[i]; } } while (0)
#define AT_COMPUTE(bufsel) do { \
        const LAS unsigned char* kb = lds + (bufsel) * STG; const LAS unsigned char* vb = kb + KB; \
        for (int it = 0; it < nit; ++it) { \
            const int key0 = ks * kslice + it * 32; \
            f32x4 S[2][2]; \
            _Pragma("unroll") for (int kt = 0; kt < 2; ++kt) { \
                const int row = key0 + kt * 16 + fr; \
                bf16x8 Kf[NS]; \
                _Pragma("unroll") for (int s_ = 0; s_ < NS; ++s_) Kf[s_] = *(const LAS bf16x8*)(kb + row * 256 + (((4 * s_ + fq) ^ (row & 15)) << 4)); \
                _Pragma("unroll") for (int qt = 0; qt < 2; ++qt) { \
                    f32x4 a = (f32x4){0.f, 0.f, 0.f, 0.f}; \
                    _Pragma("unroll") for (int s_ = 0; s_ < NS; ++s_) a = __builtin_amdgcn_mfma_f32_16x16x32_bf16(Kf[s_], Qf[qt][s_], a, 0, 0, 0); \
                    S[kt][qt] = a; } } \
            bf16x8 Pf[2]; \
            _Pragma("unroll") for (int qt = 0; qt < 2; ++qt) { \
                float pv[8]; float ps = 0.f; \
                _Pragma("unroll") for (int j = 0; j < 4; ++j) { pv[j] = __builtin_amdgcn_exp2f(S[0][qt][j] * 1.44269504f - sh2); pv[4 + j] = __builtin_amdgcn_exp2f(S[1][qt][j] * 1.44269504f - sh2); ps += pv[j] + pv[4 + j]; } \
                l[qt] += ps; \
                u32x4 pk; pk.x = pack2(pv[0], pv[1]); pk.y = pack2(pv[2], pv[3]); pk.z = pack2(pv[4], pv[5]); pk.w = pack2(pv[6], pv[7]); \
                Pf[qt] = __builtin_bit_cast(bf16x8, pk); } \
            _Pragma("unroll") for (int e = 0; e < NE; ++e) { \
                const LAS unsigned char* vp = vb + (key0 + 4 * fq + (fr >> 2)) * VP + (e * 16 + 4 * (fr & 3)) * 2; \
                const bf16x4 v0 = __builtin_amdgcn_ds_read_tr16_b64_v4i16((LAS bf16x4*)vp), v1 = __builtin_amdgcn_ds_read_tr16_b64_v4i16((LAS bf16x4*)(vp + 16 * VP)); \
                bf16x8 Vf; Vf[0] = v0[0]; Vf[1] = v0[1]; Vf[2] = v0[2]; Vf[3] = v0[3]; Vf[4] = v1[0]; Vf[5] = v1[1]; Vf[6] = v1[2]; Vf[7] = v1[3]; \
                _Pragma("unroll") for (int qt = 0; qt < 2; ++qt) O[e][qt] = __builtin_amdgcn_mfma_f32_16x16x32_bf16(Vf, Pf[qt], O[e][qt], 0, 0, 0); } } } while (0)
    const int nst = nkeys / 128;
    constexpr bool TWOSET = DV == 64;
    AT_LOAD(kregA, vregA, 0); if (TWOSET) AT_LOAD(kregB, vregB, 1); AT_WRITE(kregA, vregA, 0);
#pragma unroll
    for (int qt = 0; qt < 2; ++qt)
#pragma unroll
        for (int s_ = 0; s_ < NS; ++s_) asm volatile("" :: "v"(Qf[qt][s_]));
    __syncthreads();
    for (int st = 0; st < nst; st += 2) {
        if (TWOSET) {
            if (st + 2 < nst) AT_LOAD(kregA, vregA, st + 2);
            AT_COMPUTE(0);
            AT_WRITE(kregB, vregB, 1);
            __syncthreads();
            if (st + 3 < nst) AT_LOAD(kregB, vregB, st + 3);
            AT_COMPUTE(1);
            if (st + 2 < nst) AT_WRITE(kregA, vregA, 0);
            __syncthreads();
        } else {
            AT_LOAD(kregA, vregA, st + 1);
            AT_COMPUTE(0);
            AT_WRITE(kregA, vregA, 1);
            __syncthreads();
            if (st + 2 < nst) AT_LOAD(kregA, vregA, st + 2);
            AT_COMPUTE(1);
            if (st + 2 < nst) AT_WRITE(kregA, vregA, 0);
            __syncthreads();
        }
    }
#undef AT_COMPUTE
#undef AT_LOAD
#undef AT_WRITE
    LAS f32x4* Ost = (LAS f32x4*)lds; LAS float* LL = (LAS float*)(lds + 8 * 2 * NE * 1024);
#pragma unroll
    for (int qt = 0; qt < 2; ++qt) {
        float lt = l[qt]; lt += __shfl_xor(lt, 16); lt += __shfl_xor(lt, 32);
        if (fq == 0) LL[(wave * 2 + qt) * 16 + fr] = lt;
#pragma unroll
        for (int e = 0; e < NE; ++e) Ost[((wave * 2 + qt) * NE + e) * 64 + lane] = O[e][qt];
    }
    __syncthreads();
    const int epw = NE / NKS;
#pragma unroll
    for (int qt = 0; qt < 2; ++qt) {
        float L = 0.f;
        for (int j = 0; j < NKS; ++j) L += LL[((j * NQG + qg) * 2 + qt) * 16 + fr];
        const float invL = 1.0f / L;
        for (int ee = 0; ee < epw; ++ee) {
            const int e = ks * epw + ee;
            f32x4 o = (f32x4){0.f, 0.f, 0.f, 0.f};
            for (int j = 0; j < NKS; ++j) o += Ost[(((j * NQG + qg) * 2 + qt) * NE + e) * 64 + lane];
            out(qtok0 + qt * 16 + fr, h * DV + e * 16 + 4 * fq, o * invL);
        }
    }
    __syncthreads();
}
struct AttnOutBf16 { bf16_t* C; int ldc;
    __device__ __forceinline__ void operator()(int tok, int col, f32x4 o) const { u32x2 w; w.x = pack2(o[0], o[1]); w.y = pack2(o[2], o[3]); *(u32x2*)(C + (size_t)tok * ldc + col) = w; } };

__device__ __forceinline__ void attn_unit(int u, int wave, int& ab, int& h, int& q0) {
    if (u < 64) { ab = 16 + (u >> 5); h = (u >> 2) & 7; q0 = (u & 3) * 256 + wave * 32; }
    else { const int v = u - 64; ab = v >> 3; h = v & 7; q0 = wave * 32; }
}

__device__ __forceinline__ void phase_l0_mix(const Frame& F, const PRef& p) {
    unsigned char* ws = p.ws();
    const float* P = (const float*)(ws + WS_P0);
    bf16_t* OB = (bf16_t*)(ws + WS_OB);
    const bf16_t* Q = (const bf16_t*)(ws + WS_Q0); const bf16_t* K = (const bf16_t*)(ws + WS_K0); const bf16_t* VT = (const bf16_t*)(ws + WS_VT0);
    const int lane = F.lane, fr = lane & 15, fq = lane >> 4;
    {
        float gq = 0.f, gk = 0.f;
        for (int i = 0; i < 96; ++i) { gq = fmaxf(gq, fabsf(p.in(24)[i])); gk = fmaxf(gk, fabsf(p.in(25)[i])); }
        const float shift = 9.79795897f * gq * gk;
        AttnOutBf16 ao{OB, 1024};
#ifndef ATT_REP
#define ATT_REP 0
#endif
        for (int rp_ = 0; rp_ < 1 + (ATT_REP == 1); ++rp_) {
            for (int slot = 0; slot * F.G < 512; ++slot) { const int u = F.G == 256 ? attn_unit_xcd(F.bid, slot) : F.bid + slot * F.G; if (u < 512) for (int r2_ = 0; r2_ < 1 + ((ATT_REP == 3 && slot == 0) || (ATT_REP == 4 && slot == 1) ? 3 : 0); ++r2_) attn_block<96, 64, 8>(F, Q, K, VT, ao, u, shift); }
        } }
    {
        LAS unsigned char* L = F.lds;
        constexpr int T64 = 64 * 128, VPI = 288, T128 = 64 * VPI;
        constexpr int O_Q = 0, O_K = T64, O_QF = 2 * T64, O_QB = 3 * T64, O_W = 4 * T64, O_V = 5 * T64, O_SF = O_V + T128, O_SB = O_SF + T128, O_RED = O_SB + T128;
        const float* KVS = (const float*)(ws + WS_KVS);
        const int tid = F.tid, w = F.wave;
        for (int rp_ = 0; rp_ < 1 + (ATT_REP == 2); ++rp_)
        FOR_UNITS(u, 384, 128) {
            int s, c, h, tok0, nc; seq_of_unit384(u, s, c, h, tok0, nc);
            const float lgf = __logf(sigmoidf_(p.in(26)[h])), lgb = __logf(sigmoidf_(p.in(26)[4 + h]));
            {
                const int row = tid >> 3, ch = tid & 7;
                const float* pr = P + (size_t)(tok0 + row) * 2048;
                const f32x4 q0 = *(const f32x4*)(pr + 416 + h * 64 + ch * 8), q1 = *(const f32x4*)(pr + 416 + h * 64 + ch * 8 + 4);
                const f32x4 k0 = *(const f32x4*)(pr + 672 + h * 64 + ch * 8), k1 = *(const f32x4*)(pr + 672 + h * 64 + ch * 8 + 4);
                f32x4 vv[4], sf[4], sb[4];
#pragma unroll
                for (int i = 0; i < 4; ++i) { vv[i] = *(const f32x4*)(pr + 928 + h * 128 + ch * 16 + i * 4);
                    sf[i] = *(const f32x4*)(KVS + (size_t)u * 16384 + row * 128 + ch * 16 + i * 4); sb[i] = *(const f32x4*)(KVS + (size_t)u * 16384 + 8192 + row * 128 + ch * 16 + i * 4); }
                const float df = __expf(lgf * (float)(row + 1)), db = __expf(lgb * (float)(64 - row));
                const int so = row * 128 + ((ch ^ (row & 7)) << 4);
                u32x4 t;
                t.x = pack2(q0[0], q0[1]); t.y = pack2(q0[2], q0[3]); t.z = pack2(q1[0], q1[1]); t.w = pack2(q1[2], q1[3]); *(LAS u32x4*)(L + O_Q + so) = t;
                t.x = pack2(q0[0] * df, q0[1] * df); t.y = pack2(q0[2] * df, q0[3] * df); t.z = pack2(q1[0] * df, q1[1] * df); t.w = pack2(q1[2] * df, q1[3] * df); *(LAS u32x4*)(L + O_QF + so) = t;
                t.x = pack2(q0[0] * db, q0[1] * db); t.y = pack2(q0[2] * db, q0[3] * db); t.z = pack2(q1[0] * db, q1[1] * db); t.w = pack2(q1[2] * db, q1[3] * db); *(LAS u32x4*)(L + O_QB + so) = t;
                t.x = pack2(k0[0] * 0.125f, k0[1] * 0.125f); t.y = pack2(k0[2] * 0.125f, k0[3] * 0.125f); t.z = pack2(k1[0] * 0.125f, k1[1] * 0.125f); t.w = pack2(k1[2] * 0.125f, k1[3] * 0.125f); *(LAS u32x4*)(L + O_K + so) = t;
                const int vo = row * VPI + ch * 32;
#pragma unroll
                for (int i = 0; i < 2; ++i) {
                    t.x = pack2(vv[2 * i][0], vv[2 * i][1]); t.y = pack2(vv[2 * i][2], vv[2 * i][3]); t.z = pack2(vv[2 * i + 1][0], vv[2 * i + 1][1]); t.w = pack2(vv[2 * i + 1][2], vv[2 * i + 1][3]); *(LAS u32x4*)(L + O_V + vo + i * 16) = t;
                    t.x = pack2(sf[2 * i][0], sf[2 * i][1]); t.y = pack2(sf[2 * i][2], sf[2 * i][3]); t.z = pack2(sf[2 * i + 1][0], sf[2 * i + 1][1]); t.w = pack2(sf[2 * i + 1][2], sf[2 * i + 1][3]); *(LAS u32x4*)(L + O_SF + vo + i * 16) = t;
                    t.x = pack2(sb[2 * i][0], sb[2 * i][1]); t.y = pack2(sb[2 * i][2], sb[2 * i][3]); t.z = pack2(sb[2 * i + 1][0], sb[2 * i + 1][1]); t.w = pack2(sb[2 * i + 1][2], sb[2 * i + 1][3]); *(LAS u32x4*)(L + O_SB + vo + i * 16) = t;
                }
            }
            __syncthreads();
            {
                const int jt = w >> 1;
                bf16x8 Kf[2];
#pragma unroll
                for (int ks = 0; ks < 2; ++ks) { const int row = jt * 16 + fr; Kf[ks] = *(const LAS bf16x8*)(L + O_K + row * 128 + (((4 * ks + fq) ^ (row & 7)) << 4)); }
#pragma unroll
                for (int t2 = 0; t2 < 2; ++t2) {
                    const int it = (w & 1) * 2 + t2, irow = it * 16 + fr;
                    f32x4 d = (f32x4){0.f, 0.f, 0.f, 0.f};
#pragma unroll
                    for (int ks = 0; ks < 2; ++ks) { const bf16x8 Qf_ = *(const LAS bf16x8*)(L + O_Q + irow * 128 + (((4 * ks + fq) ^ (irow & 7)) << 4)); d = __builtin_amdgcn_mfma_f32_16x16x32_bf16(Kf[ks], Qf_, d, 0, 0, 0); }
                    float wv[4];
#pragma unroll
                    for (int r = 0; r < 4; ++r) { const int j = jt * 16 + 4 * fq + r; float dec = 0.f; if (j <= irow) dec += __expf(lgf * (float)(irow - j)); if (j >= irow) dec += __expf(lgb * (float)(j - irow)); wv[r] = d[r] * dec; }
                    u32x2 t; t.x = pack2(wv[0], wv[1]); t.y = pack2(wv[2], wv[3]);
                    *(LAS u32x2*)(L + O_W + irow * 128 + (((2 * jt + (fq >> 1)) ^ (irow & 7)) << 4) + (fq & 1) * 8) = t;
                }
            }
            __syncthreads();
            f32x4 acc[4];
#pragma unroll
            for (int it = 0; it < 4; ++it) acc[it] = (f32x4){0.f, 0.f, 0.f, 0.f};
            {
                bf16x8 Af[3][2];
#pragma unroll
                for (int a = 0; a < 3; ++a)
#pragma unroll
                    for (int ks = 0; ks < 2; ++ks) {
                        const LAS unsigned char* vp = L + (a == 0 ? O_V : (a == 1 ? O_SF : O_SB)) + (32 * ks + 8 * fq + (fr >> 2)) * VPI + (w * 16 + 4 * (fr & 3)) * 2;
                        const bf16x4 v0 = __builtin_amdgcn_ds_read_tr16_b64_v4i16((LAS bf16x4*)vp), v1 = __builtin_amdgcn_ds_read_tr16_b64_v4i16((LAS bf16x4*)(vp + 4 * VPI));
                        bf16x8 x; x[0] = v0[0]; x[1] = v0[1]; x[2] = v0[2]; x[3] = v0[3]; x[4] = v1[0]; x[5] = v1[1]; x[6] = v1[2]; x[7] = v1[3];
                        Af[a][ks] = x;
                    }
#pragma unroll
                for (int it = 0; it < 4; ++it) {
                    const int irow = it * 16 + fr;
#pragma unroll
                    for (int ks = 0; ks < 2; ++ks) {
                        const int so = irow * 128 + (((4 * ks + fq) ^ (irow & 7)) << 4);
                        const bf16x8 bw = *(const LAS bf16x8*)(L + O_W + so), bqf = *(const LAS bf16x8*)(L + O_QF + so), bqb = *(const LAS bf16x8*)(L + O_QB + so);
                        acc[it] = __builtin_amdgcn_mfma_f32_16x16x32_bf16(Af[0][ks], bw, acc[it], 0, 0, 0);
                        acc[it] = __builtin_amdgcn_mfma_f32_16x16x32_bf16(Af[1][ks], bqf, acc[it], 0, 0, 0);
                        acc[it] = __builtin_amdgcn_mfma_f32_16x16x32_bf16(Af[2][ks], bqb, acc[it], 0, 0, 0);
                    }
                }
            }
            LAS float* red = (LAS float*)(L + O_RED);
#pragma unroll
            for (int it = 0; it < 4; ++it) {
                float ss = acc[it][0] * acc[it][0] + acc[it][1] * acc[it][1] + acc[it][2] * acc[it][2] + acc[it][3] * acc[it][3];
                ss += __shfl_xor(ss, 16); ss += __shfl_xor(ss, 32);
                if (fq == 0) red[w * 64 + it * 16 + fr] = ss;
            }
            __syncthreads();
            {
                const f32x4 gn = *(const f32x4*)(p.in(27) + h * 128 + w * 16 + 4 * fq);
#pragma unroll
                for (int it = 0; it < 4; ++it) {
                    const int i = it * 16 + fr, tok = tok0 + i;
                    float ss = 0.f;
#pragma unroll
                    for (int q = 0; q < 8; ++q) ss += red[q * 64 + i];
                    const float rstd = rsqrtf(ss * (1.0f / 128.0f) + EPS);
                    const f32x4 rg = *(const f32x4*)(P + (size_t)tok * 2048 + 1440 + h * 128 + w * 16 + 4 * fq);
                    u32x2 t; t.x = pack2(siluf_(rg[0]) * acc[it][0] * rstd * gn[0], siluf_(rg[1]) * acc[it][1] * rstd * gn[1]);
                    t.y = pack2(siluf_(rg[2]) * acc[it][2] * rstd * gn[2], siluf_(rg[3]) * acc[it][3] * rstd * gn[3]);
                    *(u32x2*)(OB + (size_t)tok * 1024 + 512 + h * 128 + w * 16 + 4 * fq) = t;
                }
            }
            __syncthreads();
        }
    }
}

__device__ __forceinline__ void phase_gate(const Frame& F, const PRef& p, int l) {
    const bf16_t* U = (const bf16_t*)(p.ws() + WS_U); bf16_t* ACT = (bf16_t*)(p.ws() + WS_ACT);
    const float* cw = p.in(16) + (size_t)l * 3 * 5632; const float* cb = p.in(17) + (size_t)l * 5632;
    const int gt = F.bid * NTHREADS + F.tid, ngt = F.G * NTHREADS;
    const int cg = gt % 352, tslot = gt / 352, nslot = ngt / 352;
    if (tslot >= nslot) return;
    const int c0 = cg * 8;
    float w0[2][8], w1[2][8], w2[2][8], bb[2][8];
#pragma unroll
    for (int half = 0; half < 2; ++half) {
        const int col = c0 + half * 2816;
#pragma unroll
        for (int q = 0; q < 2; ++q) {
            const f32x4 a = *(const f32x4*)(cw + col + q * 4), b = *(const f32x4*)(cw + 5632 + col + q * 4), c = *(const f32x4*)(cw + 2 * 5632 + col + q * 4), d = *(const f32x4*)(cb + col + q * 4);
#pragma unroll
            for (int j = 0; j < 4; ++j) { w0[half][q * 4 + j] = a[j]; w1[half][q * 4 + j] = b[j]; w2[half][q * 4 + j] = c[j]; bb[half][q * 4 + j] = d[j]; }
        }
    }
    bf16x8 cx[2][3], nx[2][3];
#define GATE_LOAD(dst, tok_) do { const int t_ = (tok_) < NCTX ? ((tok_) & 255) : (((tok_) - NCTX) & 1023), n_ = (tok_) < NCTX ? 256 : 1024; \
        const bf16x8 z_ = (bf16x8){0, 0, 0, 0, 0, 0, 0, 0}; \
        _Pragma("unroll") for (int half = 0; half < 2; ++half) { const bf16_t* up_ = U + (size_t)(tok_) * 5632 + c0 + half * 2816; \
            dst[half][1] = *(const bf16x8*)up_; dst[half][0] = t_ > 0 ? *(const bf16x8*)(up_ - 5632) : z_; dst[half][2] = t_ < n_ - 1 ? *(const bf16x8*)(up_ + 5632) : z_; } } while (0)
    if (tslot < NTOK) GATE_LOAD(cx, tslot);
    for (int tok = tslot; tok < NTOK; tok += nslot) {
        if (tok + nslot < NTOK) GATE_LOAD(nx, tok + nslot);
        float u2[2][8];
#pragma unroll
        for (int half = 0; half < 2; ++half)
#pragma unroll
            for (int j = 0; j < 8; ++j)
                u2[half][j] = bf2f((unsigned short)cx[half][0][j]) * w0[half][j] + bf2f((unsigned short)cx[half][1][j]) * w1[half][j] + bf2f((unsigned short)cx[half][2][j]) * w2[half][j] + bb[half][j];
        u32x4 w;
        w.x = pack2(siluf_(u2[0][0]) * u2[1][0], siluf_(u2[0][1]) * u2[1][1]); w.y = pack2(siluf_(u2[0][2]) * u2[1][2], siluf_(u2[0][3]) * u2[1][3]);
        w.z = pack2(siluf_(u2[0][4]) * u2[1][4], siluf_(u2[0][5]) * u2[1][5]); w.w = pack2(siluf_(u2[0][6]) * u2[1][6], siluf_(u2[0][7]) * u2[1][7]);
        *(u32x4*)(ACT + (size_t)tok * 2816 + c0) = w;
#pragma unroll
        for (int half = 0; half < 2; ++half)
#pragma unroll
            for (int q = 0; q < 3; ++q) cx[half][q] = nx[half][q];
    }
#undef GATE_LOAD
}

__device__ __forceinline__ void phase_l1_tok(const Frame& F, const PRef& p) {
    unsigned char* ws = p.ws();
    const float* P = (const float*)(ws + WS_P1);
    bf16_t* QD = (bf16_t*)(ws + WS_QD); bf16_t* KD = (bf16_t*)(ws + WS_KD); bf16_t* VDT = (bf16_t*)(ws + WS_VDT);
    float* RR = (float*)(ws + WS_RR); float* KR = (float*)(ws + WS_KR); float* VV = (float*)(ws + WS_VV); float* KK = (float*)(ws + WS_KK);
    bf16_t* TW = (bf16_t*)(ws + WS_TW); bf16_t* AD = (bf16_t*)(ws + WS_AD); bf16_t* SG = (bf16_t*)(ws + WS_SG);
    const int nw = F.G * 8, lane = F.lane;
    const float* mu = p.in(33);
    for (int row = F.bid * 8 + F.wave; row < NKROW; row += nw) {
        const bool istok = row < NTOK, lat = istok && row >= NCTX;
        int kr;
        if (row < NCTX) kr = row; else if (row < NTOK) { const int v = row - NCTX; kr = NCTX + (v >> 10) * 1536 + (v & 1023); }
        else { const int i = row - NTOK; kr = NCTX + (i >> 9) * 1536 + 1024 + (i & 511); }
        if (!istok) {
            const int i = row - NTOK;
#pragma unroll
            for (int j = 0; j < 8; ++j) {
                const int col = j * 64 + lane;
                KD[(size_t)kr * 512 + col] = f2bf(p.in(5)[(size_t)i * 512 + col]);
                VDT[(size_t)kr * 512 + col] = f2bf(p.in(6)[(size_t)i * 512 + col]);
            }
            continue;
        }
        const float* pr = P + (size_t)row * 3584;
        float cs = 1.f, sn = 0.f;
        if (lat) {
            const int t = (row - NCTX) & 1023, a = lane & 31;
            const float pos = a < 16 ? (float)(t >> 6) : (float)(t & 63);
            const float inv = __powf(10000.0f, -(float)(a & 15) * 0.0625f);
            const float ang = pos * inv; cs = __cosf(ang); sn = __sinf(ang);
        }
        {
            const int pi = lane & 31;
            f32x2 qv[4], kv[4];
#pragma unroll
            for (int pass = 0; pass < 4; ++pass) { const int vec = pass * 2 + (lane >> 5); qv[pass] = *(const f32x2*)(pr + vec * 64 + 2 * pi); kv[pass] = *(const f32x2*)(pr + 512 + vec * 64 + 2 * pi); }
            const f32x2 gq = *(const f32x2*)(p.in(29) + 2 * pi), gk = *(const f32x2*)(p.in(30) + 2 * pi);
#pragma unroll
            for (int pass = 0; pass < 4; ++pass) {
                const int vec = pass * 2 + (lane >> 5);
                {
                    const f32x2 v = qv[pass];
                    const float rstd = rsqrtf(half_sum(v[0] * v[0] + v[1] * v[1], lane) * (1.0f / 64.0f) + EPS);
                    const float x1 = v[0] * rstd * gq[0], x2 = v[1] * rstd * gq[1];
                    *(unsigned*)(QD + (size_t)row * 512 + vec * 64 + 2 * pi) = pack2((x1 * cs - x2 * sn) * 0.125f, (x1 * sn + x2 * cs) * 0.125f);
                }
                {
                    const f32x2 v = kv[pass];
                    const float rstd = rsqrtf(half_sum(v[0] * v[0] + v[1] * v[1], lane) * (1.0f / 64.0f) + EPS);
                    const float x1 = v[0] * rstd * gk[0], x2 = v[1] * rstd * gk[1];
                    if (row < NCTX) *(f32x2*)(p.out() + OUT_DK + (size_t)row * 512 + vec * 64 + 2 * pi) = (f32x2){x1, x2};
                    *(unsigned*)(KD + (size_t)kr * 512 + vec * 64 + 2 * pi) = pack2(x1 * cs - x2 * sn, x1 * sn + x2 * cs);
                }
            }
        }
#pragma unroll
        for (int j = 0; j < 8; ++j) {
            const int col = j * 64 + lane; const float v = pr[1024 + col];
            if (row < NCTX) p.out()[OUT_DV + (size_t)row * 512 + col] = v;
            VDT[(size_t)kr * 512 + col] = f2bf(v);
        }
        const int t = row < NCTX ? (row & 255) : ((row - NCTX) & 1023), n = row < NCTX ? 256 : 1024;
        const bool hp = t > 0, hn = t < n - 1;
        const float* pp = pr + 1536;
        const float* pn = pp + 3584; const float* pv = pp - 3584;
#define SHIFT4(col) ({ const f32x4 _c = *(const f32x4*)(pp + (col)); const f32x4 _p = hp ? *(const f32x4*)(pv + (col)) : (f32x4){0.f, 0.f, 0.f, 0.f}; \
            const f32x4 _n = hn ? *(const f32x4*)(pn + (col)) : (f32x4){0.f, 0.f, 0.f, 0.f}; const f32x4 _m = *(const f32x4*)(mu + (col)); _c + (0.5f * (_p + _n) - _c) * _m; })
        {
            const size_t o = (size_t)row * 512 + lane * 8;
            const f32x4 r0 = SHIFT4(lane * 8), r1 = SHIFT4(lane * 8 + 4);
            *(f32x4*)(RR + o) = r0; *(f32x4*)(RR + o + 4) = r1;
            const f32x4 k0 = SHIFT4(512 + lane * 8), k1 = SHIFT4(512 + lane * 8 + 4);
            *(f32x4*)(KR + o) = k0; *(f32x4*)(KR + o + 4) = k1;
            const f32x4 v0 = SHIFT4(1024 + lane * 8), v1 = SHIFT4(1024 + lane * 8 + 4);
            *(f32x4*)(VV + o) = v0; *(f32x4*)(VV + o + 4) = v1;
            const f32x4 kk0 = k0 * *(const f32x4*)(p.in(39) + lane * 8), kk1 = k1 * *(const f32x4*)(p.in(39) + lane * 8 + 4);
            float ss = (kk0[0] * kk0[0] + kk0[1] * kk0[1]) + (kk0[2] * kk0[2] + kk0[3] * kk0[3]) + (kk1[0] * kk1[0] + kk1[1] * kk1[1]) + (kk1[2] * kk1[2] + kk1[3] * kk1[3]);
            ss = oct_sum(ss);
            const float rn = rsqrtf(ss + EPS);
            *(f32x4*)(KK + o) = kk0 * rn; *(f32x4*)(KK + o + 4) = kk1 * rn;
        }
        {
            const f32x4 a = SHIFT4(1536 + lane * 4);
            u32x2 w;
            if (lane < 32) { w.x = pack2(tanhf_(a[0]), tanhf_(a[1])); w.y = pack2(tanhf_(a[2]), tanhf_(a[3])); *(u32x2*)(TW + (size_t)row * 128 + lane * 4) = w; }
            else { w.x = pack2(a[0], a[1]); w.y = pack2(a[2], a[3]); *(u32x2*)(AD + (size_t)row * 128 + (lane - 32) * 4) = w; }
            if (lane < 32) { const f32x4 g = SHIFT4(1792 + lane * 4); w.x = pack2(sigmoidf_(g[0]), sigmoidf_(g[1])); w.y = pack2(sigmoidf_(g[2]), sigmoidf_(g[3])); *(u32x2*)(SG + (size_t)row * 128 + lane * 4) = w; }
        }
#define SHIFTED(col) 0
#undef SHIFTED
    }
}

constexpr int SC_T = 16;
constexpr int SC_BUF = 2 * SC_T * 6 * 64;
__device__ __forceinline__ void phase_l1_mix(const Frame& F, const PRef& p) {
    unsigned char* ws = p.ws();
    const bf16_t* Q = (const bf16_t*)(ws + WS_QD); const bf16_t* K = (const bf16_t*)(ws + WS_KD); const bf16_t* VT = (const bf16_t*)(ws + WS_VDT);
    AttnOutBf16 ao{(bf16_t*)(ws + WS_DO), 1024};
    float gq = 0.f, gk = 0.f;
    for (int i = 0; i < 64; ++i) { gq = fmaxf(gq, fabsf(p.in(29)[i])); gk = fmaxf(gk, fabsf(p.in(30)[i])); }
    const float shift = 8.0f * gq * gk;
    for (int slot = 0; slot * F.G < 512; ++slot) { const int u = F.G == 256 ? attn_unit_xcd(F.bid, slot) : F.bid + slot * F.G; if (u < 512) attn_block<64, 128, 4>(F, Q, K, VT, ao, u, shift); }
}

__device__ __forceinline__ float dpp_xor1(float x) { return __int_as_float(__builtin_amdgcn_update_dpp(0, __float_as_int(x), 0xB1, 0xF, 0xF, true)); }
__device__ __forceinline__ float dpp_xor2(float x) { return __int_as_float(__builtin_amdgcn_update_dpp(0, __float_as_int(x), 0x4E, 0xF, 0xF, true)); }
#define VFMA(d, a, b, c) asm("v_fma_f32 %0, %1, %2, %3" : "=v"(d) : "v"(a), "v"(b), "v"(c))
#define VFMAN(d, a, b, c) asm("v_fma_f32 %0, -%1, %2, %3" : "=v"(d) : "v"(a), "v"(b), "v"(c))
#define VMUL(d, a, b) asm("v_mul_f32 %0, %1, %2" : "=v"(d) : "v"(a), "v"(b))
#define VADD(d, a, b) asm("v_add_f32 %0, %1, %2" : "=v"(d) : "v"(a), "v"(b))
#define QUAD_SUM_ASM(x) asm("s_nop 1\n\tv_add_f32_dpp %0, %0, %0 quad_perm:[1,0,3,2] row_mask:0xf bank_mask:0xf bound_ctrl:1\n\ts_nop 1\n\t" \
    "v_add_f32_dpp %0, %0, %0 quad_perm:[2,3,0,1] row_mask:0xf bank_mask:0xf bound_ctrl:1" : "+v"(x))
#define ROW16_SUM_ASM(x) asm("s_nop 1\n\tv_add_f32_dpp %0, %0, %0 quad_perm:[1,0,3,2] row_mask:0xf bank_mask:0xf bound_ctrl:1\n\ts_nop 1\n\t" \
    "v_add_f32_dpp %0, %0, %0 quad_perm:[2,3,0,1] row_mask:0xf bank_mask:0xf bound_ctrl:1\n\ts_nop 1\n\t" \
    "v_add_f32_dpp %0, %0, %0 row_half_mirror row_mask:0xf bank_mask:0xf bound_ctrl:1\n\ts_nop 1\n\t" \
    "v_add_f32_dpp %0, %0, %0 row_mirror row_mask:0xf bank_mask:0xf bound_ctrl:1" : "+v"(x))
constexpr int SREC = 400;
template <int KPL> struct ScanVecs { f32x4 w[KPL / 4], kka[KPL / 4], kd[KPL / 4], kk[KPL / 4], r[KPL / 4]; float v, c1, c2; };
template <int KPL>
__device__ __forceinline__ void scan_load(ScanVecs<KPL>& x, const LAS float* v6, int koff, int row) {
#pragma unroll
    for (int q = 0; q < KPL / 4; ++q) {
        x.w[q] = *(const LAS f32x4*)(v6 + 0 * 64 + koff + q * 4); x.kka[q] = *(const LAS f32x4*)(v6 + 1 * 64 + koff + q * 4); x.kd[q] = *(const LAS f32x4*)(v6 + 2 * 64 + koff + q * 4);
        x.kk[q] = *(const LAS f32x4*)(v6 + 3 * 64 + koff + q * 4); x.r[q] = *(const LAS f32x4*)(v6 + 4 * 64 + koff + q * 4);
    }
    x.v = v6[5 * 64 + row]; x.c1 = v6[384]; x.c2 = v6[385];
}
template <int MODE>
__device__ __forceinline__ void scan_unit(const Frame& F, const PRef& p, int unit) {
    constexpr int T = 32, NSTEPS = MODE == 0 ? 1024 : 256, BUF = T * SREC, NCHUNK = NSTEPS / T;
    constexpr int KPL = MODE == 0 ? 4 : 16, NQ = KPL / 4;
    unsigned char* ws = p.ws();
    const float* RR = (const float*)(ws + WS_RR); const float* KR = (const float*)(ws + WS_KR); const float* VV = (const float*)(ws + WS_VV); const float* KK = (const float*)(ws + WS_KK);
    const float* DEC = (const float*)(ws + WS_DEC); const float* AA = (const float*)(ws + WS_AA);
    float* YY = (float*)(ws + WS_YY);
    const float* k_a = p.in(40);
    LAS float* sb = (LAS float*)F.lds;
    const int lane = F.lane;
    const bool loader = F.wave >= 4;
    const bool compute = F.wave < 4;
    const int cid = MODE == 0 ? (unit >> 2) : unit;
    const int cb = cid >> 4, chh = (cid >> 1) & 7, cd = cid & 1;
    const int cbase = MODE == 0 ? NCTX + cb * 1024 : cb * 256;
    if (loader) {
        const int lt = F.tid - 256;
        f32x4 pa[2][6], pb[2][6];
        const f32x4 ka4 = *(const f32x4*)(k_a + chh * 64 + (lt & 15) * 4), rk4 = *(const f32x4*)(p.in(41) + chh * 64 + (lt & 15) * 4);
        float* BON = (float*)(ws + WS_BON) + (size_t)cd * NTOK * 8 + chh;
        const bool wbon = MODE == 1 || (unit & 3) == 0;
#define SC_LOAD(pre, chunk) do { _Pragma("unroll") for (int it = 0; it < 2; ++it) { const int item = it * 256 + lt; const int stp = item >> 4, k = (item & 15) * 4; \
            const int j_ = (chunk) * T + stp; const int tok = cbase + (cd ? NSTEPS - 1 - j_ : j_); const size_t o_ = (size_t)tok * 512 + chh * 64 + k; \
            pre[it][0] = *(const f32x4*)(DEC + (size_t)cd * NTOK * 512 + o_); pre[it][1] = *(const f32x4*)(AA + (size_t)cd * NTOK * 512 + o_); pre[it][2] = *(const f32x4*)(KR + o_); \
            pre[it][3] = *(const f32x4*)(KK + o_); pre[it][4] = *(const f32x4*)(RR + o_); pre[it][5] = *(const f32x4*)(VV + o_); } } while (0)
#define SC_WRITE(pre, buf, chunk) do { _Pragma("unroll") for (int it = 0; it < 2; ++it) { const int item = it * 256 + lt; const int stp = item >> 4, k = (item & 15) * 4; \
            const f32x4 a_ = pre[it][1], kk_ = pre[it][3], r_ = pre[it][4], w_ = pre[it][0]; LAS float* d_ = sb + (buf) * BUF + stp * SREC + k; \
            const f32x4 bb_ = kk_ * a_, kd_ = pre[it][2] * (1.0f + (a_ - 1.0f) * ka4); \
            *(LAS f32x4*)(d_) = w_; *(LAS f32x4*)(d_ + 64) = bb_; *(LAS f32x4*)(d_ + 128) = kd_; *(LAS f32x4*)(d_ + 192) = kk_; \
            *(LAS f32x4*)(d_ + 256) = w_ * r_; *(LAS f32x4*)(d_ + 320) = pre[it][5]; \
            const f32x4 p1_ = bb_ * r_, p2_ = kd_ * r_; const float c1_ = row16_sum((p1_[0] + p1_[1]) + (p1_[2] + p1_[3])), c2_ = row16_sum((p2_[0] + p2_[1]) + (p2_[2] + p2_[3])); \
            const f32x4 p3_ = p2_ * rk4; const float c3_ = row16_sum((p3_[0] + p3_[1]) + (p3_[2] + p3_[3])); \
            if ((lt & 15) == 0) { LAS float* e_ = sb + (buf) * BUF + stp * SREC + 384; e_[0] = c1_; e_[1] = c2_; \
                if (wbon) { const int j2_ = (chunk) * T + stp; BON[(size_t)(cbase + (cd ? NSTEPS - 1 - j2_ : j2_)) * 8] = c3_; } } } } while (0)
        SC_LOAD(pa, 0); SC_LOAD(pb, 1); SC_WRITE(pa, 0, 0); SC_LOAD(pa, 2);
        __syncthreads();
        for (int cnk = 0; cnk < NCHUNK; cnk += 2) {
            if (cnk + 1 < NCHUNK) { SC_WRITE(pb, (cnk + 1) & 1, cnk + 1); if (cnk + 3 < NCHUNK) SC_LOAD(pb, cnk + 3); }
            __syncthreads();
            if (cnk + 2 < NCHUNK) { SC_WRITE(pa, (cnk + 2) & 1, cnk + 2); if (cnk + 4 < NCHUNK) SC_LOAD(pa, cnk + 4); }
            __syncthreads();
        }
#undef SC_LOAD
#undef SC_WRITE
    } else if (compute) {
        const int row = MODE == 0 ? (unit & 3) * 16 + F.wave * 4 + (lane >> 4) : F.wave * 16 + (lane >> 2);
        const int kq = MODE == 0 ? (lane & 15) : (lane & 3), koff = kq * KPL;
        f32x4 S[NQ];
        if (MODE == 0) {
            const float* s0 = p.in(7) + (size_t)(((cb * 2 + cd) * 8 + chh) * 64 + row) * 64 + koff;
#pragma unroll
            for (int q = 0; q < NQ; ++q) S[q] = *(const f32x4*)(s0 + q * 4);
        } else {
#pragma unroll
            for (int q = 0; q < NQ; ++q) S[q] = (f32x4){0.f, 0.f, 0.f, 0.f};
        }
        __syncthreads();
        float* yp = YY + (size_t)cd * NTOK * 512 + chh * 64 + row;
        for (int cnk = 0; cnk < NCHUNK; ++cnk) {
            const LAS float* bufp = sb + (cnk & 1) * BUF;
            ScanVecs<KPL> cur, nxt;
            scan_load<KPL>(cur, bufp, koff, row);
#pragma unroll 2
            for (int stp = 0; stp < T; ++stp) {
                scan_load<KPL>(nxt, bufp + (stp + 1 < T ? stp + 1 : stp) * SREC, koff, row);
                const int j_ = cnk * T + stp; const int tok = cbase + (cd ? NSTEPS - 1 - j_ : j_);
                f32x4 a4 = S[0] * cur.kk[0], y4 = S[0] * cur.r[0];
#pragma unroll
                for (int q = 1; q < NQ; ++q) { a4 = a4 + S[q] * cur.kk[q]; y4 = y4 + S[q] * cur.r[q]; }
                float sa = (a4[0] + a4[1]) + (a4[2] + a4[3]), ys = (y4[0] + y4[1]) + (y4[2] + y4[3]);
                if (MODE == 0) {
                    sa += DPPF(sa, 0xB1); ys += DPPF(ys, 0xB1); sa += DPPF(sa, 0x4E); ys += DPPF(ys, 0x4E);
                    sa += DPPF(sa, 0x141); ys += DPPF(ys, 0x141); sa += DPPF(sa, 0x140); ys += DPPF(ys, 0x140);
                } else { sa += DPPF(sa, 0xB1); ys += DPPF(ys, 0xB1); sa += DPPF(sa, 0x4E); ys += DPPF(ys, 0x4E); }
                const float vr = cur.v;
#pragma unroll
                for (int q = 0; q < NQ; ++q) S[q] = S[q] * cur.w[q] + (vr * cur.kd[q] - sa * cur.kka[q]);
                if (kq == 0) yp[(size_t)tok * 512] = ys - sa * cur.c1 + vr * cur.c2;
                cur = nxt;
            }
            __syncthreads();
        }
        if (MODE == 1) {
            float* so = p.out() + OUT_SRWKV + (size_t)(((cb * 2 + cd) * 8 + chh) * 64 + row) * 64 + koff;
#pragma unroll
            for (int q = 0; q < NQ; ++q) *(f32x4*)(so + q * 4) = S[q];
        }
    } else {
        __syncthreads();
        for (int cnk = 0; cnk < NCHUNK; ++cnk) __syncthreads();
    }
}
constexpr int CI_AP = 0, CI_RH = 2304, CI_BT = 4608, CI_KT = 7168, CI_MP = 9728, CI_PP = 10368, CI_GL = 11520, CI_VT = 11776, CI_SZ = 14336;
constexpr int CS_AH = 0, CS_BH = 2304, CS_KH = 4608, CS_SZ = 6912;
constexpr int CS_NM = CS_BH, CS_TM = CS_BH + 1024, CS_MM = CS_BH + 2048;
constexpr int CIMG0 = 0, CSCR0 = 8 * CI_SZ;
static_assert(CSCR0 + 4 * CS_SZ <= LDS_BYTES - LDS_WORK, "chunked scan LDS");
constexpr size_t WS_GIMG = WS_HB;
static_assert((size_t)32 * 12 * 4 * CI_SZ <= (size_t)2 * NTOK * 1024 * 2, "hand-off images do not fit HB + OB");
constexpr int SCAN_FLAG_WORD = 3584;
template <int MODE, int ROLE>
__device__ __forceinline__ void scanc_unit(const Frame& F, const PRef& p, int cid, int hid = 0) {
    constexpr int NSTEPS = MODE == 0 ? 1024 : 256, NCH = NSTEPS / 16, NG = NCH / 4;
    unsigned char* ws = p.ws();
    const float* RR = (const float*)(ws + WS_RR); const float* KR = (const float*)(ws + WS_KR); const float* VV = (const float*)(ws + WS_VV); const float* KK = (const float*)(ws + WS_KK);
    const float* DEC = (const float*)(ws + WS_DEC); const float* AA = (const float*)(ws + WS_AA);
    float* YY = (float*)(ws + WS_YY);
    LAS unsigned char* L = F.lds;
    const int lane = F.lane, fr = lane & 15, g = lane >> 4, w = F.wave;
    const int cb = cid >> 4, chh = (cid >> 1) & 7, cd = cid & 1;
    const int cbase = MODE == 0 ? NCTX + cb * 1024 : cb * 256;
#define TOK_OF(step) (cbase + (cd ? NSTEPS - 1 - (step) : (step)))
    unsigned* hflag = (unsigned*)(ws + WS_BAR) + SCAN_FLAG_WORD + cid * 16;
    unsigned char* gimg = ws + WS_GIMG + (size_t)cid * 12 * 4 * CI_SZ;
    const __amdgpu_buffer_rsrc_t grs = wt_rsrc(gimg, (size_t)12 * 4 * CI_SZ);
    if (w >= 4 || ROLE == 2) {
        if (ROLE == 2 && w < 4) {
            for (int grp = hid; grp < NG; grp += 4) {
                const int og = grp - (grp >> 2) - 1;
                __syncthreads();
                for (int i = F.tid; i < 4 * CI_SZ / 16; i += NTHREADS) wt_store16(grs, (size_t)og * 4 * CI_SZ + (size_t)i * 16, *(const LAS u32x4*)(L + CIMG0 + (size_t)i * 16));
                asm volatile("s_waitcnt vmcnt(0)" ::: "memory");
                __syncthreads();
                if (F.tid == 0) __hip_atomic_store(hflag + grp, 1u, __ATOMIC_RELAXED, __HIP_MEMORY_SCOPE_AGENT);
                __syncthreads();
            }
            return;
        }
        const int j = w - 4, k = lane;
        LAS unsigned char* SC = L + CSCR0 + j * CS_SZ;
        const float ka = p.in(40)[chh * 64 + k];
        const size_t colo = (size_t)chh * 64 + k;
        const float* decp = DEC + (size_t)cd * NTOK * 512; const float* aap = AA + (size_t)cd * NTOK * 512;
        float rw[16], rkk[16], ra[16], rkr[16], rr[16], rv[16];
#define PREP_LOAD(chunk) do { _Pragma("unroll") for (int t = 0; t < 16; ++t) { const size_t o_ = (size_t)TOK_OF((chunk) * 16 + t) * 512 + colo; \
            rw[t] = decp[o_]; rkk[t] = KK[o_]; ra[t] = aap[o_]; rkr[t] = KR[o_]; rr[t] = RR[o_]; rv[t] = VV[o_]; } } while (0)
        PREP_LOAD(ROLE == 2 ? hid * 4 + j : j);
        for (int grp = (ROLE == 2 ? hid : 0); grp < NG; grp += (ROLE == 2 ? 4 : 1)) {
            LAS unsigned char* IM = L + CIMG0 + ((ROLE == 2 ? 0 : (grp & 1) * 4) + j) * CI_SZ;
            if (ROLE == 1 && (grp & 3)) {
                if (lane == 0) { unsigned sp = 0; while (__hip_atomic_load(hflag + grp, __ATOMIC_RELAXED, __HIP_MEMORY_SCOPE_AGENT) == 0u && ++sp < (1u << 22)) __builtin_amdgcn_s_sleep(2); }
                asm volatile("" ::: "memory");
                for (int i = lane; i < CI_SZ / 16; i += 64)
                    *(LAS u32x4*)(IM + (size_t)i * 16) = __builtin_bit_cast(u32x4, __builtin_amdgcn_raw_buffer_load_b128(grs, (int)(((size_t)(grp - (grp >> 2) - 1) * 4 + j) * CI_SZ + (size_t)i * 16), 0, 16));
                __syncthreads();
                continue;
            }
            float ah[16]; float G = 1.0f;
#pragma unroll
            for (int t2 = 0; t2 < 8; ++t2) {
                float bh2[2], kh2[2];
#pragma unroll
                for (int u = 0; u < 2; ++u) {
                    const int t = 2 * t2 + u;
                    const float bb = rkk[t] * ra[t], kd = rkr[t] * (1.0f + (ra[t] - 1.0f) * ka);
                    ah[t] = -rkk[t] * G;
                    G *= rw[t];
                    const float inv = __builtin_amdgcn_rcpf(G);
                    const float bh = bb * inv, kh = kd * inv, rh = rr[t] * G;
                    bh2[u] = bh; kh2[u] = kh;
                    *(LAS bf16_t*)(SC + CS_AH + t * 144 + k * 2) = f2bf(ah[t]);
                    *(LAS bf16_t*)(SC + CS_BH + t * 144 + k * 2) = f2bf(bh);
                    *(LAS bf16_t*)(SC + CS_KH + t * 144 + k * 2) = f2bf(kh);
                    *(LAS bf16_t*)(IM + CI_RH + t * 144 + k * 2) = f2bf(rh);
                }
                *(LAS unsigned*)(IM + CI_BT + k * 40 + t2 * 4) = pack2(bh2[0], bh2[1]);
                *(LAS unsigned*)(IM + CI_KT + k * 40 + t2 * 4) = pack2(kh2[0], kh2[1]);
                *(LAS unsigned*)(IM + CI_VT + k * 40 + t2 * 4) = pack2(rv[2 * t2], rv[2 * t2 + 1]);
            }
            *(LAS float*)(IM + CI_GL + k * 4) = G;
            { const int ng_ = grp + (ROLE == 0 ? 1 : 4); if (ng_ < NG) PREP_LOAD(ng_ * 4 + j); }
            f32x4 dN = (f32x4){0.f, 0.f, 0.f, 0.f}, dM = dN, dPb = dN, dPk = dN;
#pragma unroll
            for (int s = 0; s < 2; ++s) {
                const int fo = fr * 144 + (4 * s + g) * 16;
                const bf16x8 fa = *(const LAS bf16x8*)(SC + CS_AH + fo), fb = *(const LAS bf16x8*)(SC + CS_BH + fo), fk = *(const LAS bf16x8*)(SC + CS_KH + fo), frh = *(const LAS bf16x8*)(IM + CI_RH + fo);
                dN = __builtin_amdgcn_mfma_f32_16x16x32_bf16(fa, fb, dN, 0, 0, 0); dM = __builtin_amdgcn_mfma_f32_16x16x32_bf16(fa, fk, dM, 0, 0, 0);
                dPb = __builtin_amdgcn_mfma_f32_16x16x32_bf16(frh, fb, dPb, 0, 0, 0); dPk = __builtin_amdgcn_mfma_f32_16x16x32_bf16(frh, fk, dPk, 0, 0, 0);
            }
#pragma unroll
            for (int r = 0; r < 4; ++r) {
                const int t = 4 * g + r;
                *(LAS float*)(SC + CS_MM + (t * 16 + fr) * 4) = fr < t ? dM[r] : 0.f;
                *(LAS bf16_t*)(IM + CI_PP + t * 72 + fr * 2) = f2bf(fr <= t ? dPb[r] : 0.f);
                *(LAS bf16_t*)(IM + CI_PP + t * 72 + (16 + fr) * 2) = f2bf(fr <= t ? dPk[r] : 0.f);
            }
            float Tc[16];
            Tc[0] = fr == 0 ? 1.0f : 0.f;
#pragma unroll
            for (int i = 1; i < 16; ++i) {
                float s0_ = fr == i ? 1.0f : 0.f, s1_ = 0.f;
#pragma unroll
                for (int jj = 0; jj < i; ++jj) {
                    const float nij = RDLANE(dN[i & 3], jj + 16 * (i >> 2));
                    if (jj & 1) s1_ += nij * Tc[jj]; else s0_ += nij * Tc[jj];
                }
                Tc[i] = s0_ + s1_;
            }
            if (g == 0) {
#pragma unroll
                for (int i = 0; i < 16; ++i) *(LAS float*)(SC + CS_TM + (i * 16 + fr) * 4) = Tc[i];
            }
#pragma unroll
            for (int i = 0; i < 16; ++i) {
                float s0_ = 0.f, s1_ = 0.f;
#pragma unroll
                for (int jj = 0; jj <= i; ++jj) { const float tij = RDLANE(Tc[i], jj); if (jj & 1) s1_ += tij * ah[jj]; else s0_ += tij * ah[jj]; }
                *(LAS bf16_t*)(IM + CI_AP + i * 144 + k * 2) = f2bf(s0_ + s1_);
            }
            {
                const int i = lane >> 2, j4 = (lane & 3) * 4;
                f32x4 macc = (f32x4){0.f, 0.f, 0.f, 0.f};
#pragma unroll
                for (int t = 0; t < 16; ++t) macc += *(const LAS f32x4*)(SC + CS_MM + (t * 16 + j4) * 4) * *(const LAS float*)(SC + CS_TM + (i * 16 + t) * 4);
                u32x2 pk; pk.x = pack2(macc[0], macc[1]); pk.y = pack2(macc[2], macc[3]);
                *(LAS u32x2*)(IM + CI_MP + i * 40 + j4 * 2) = pk;
            }
            if (ROLE == 2) {
                const int og = grp - (grp >> 2) - 1;
                __syncthreads();
                for (int i = F.tid; i < 4 * CI_SZ / 16; i += NTHREADS) wt_store16(grs, (size_t)og * 4 * CI_SZ + (size_t)i * 16, *(const LAS u32x4*)(L + CIMG0 + (size_t)i * 16));
                asm volatile("s_waitcnt vmcnt(0)" ::: "memory");
                __syncthreads();
                __syncthreads();
                continue;
            }
            __syncthreads();
        }
        if (ROLE == 2) return;
        __syncthreads();
#undef PREP_LOAD
    } else {
        f32x4 S[4];
        if (MODE == 0) {
            const float* s0 = p.in(7) + (size_t)(((cb * 2 + cd) * 8 + chh) * 64 + 16 * w + fr) * 64;
#pragma unroll
            for (int kt = 0; kt < 4; ++kt) S[kt] = *(const f32x4*)(s0 + 16 * kt + 4 * g);
        } else {
#pragma unroll
            for (int kt = 0; kt < 4; ++kt) S[kt] = (f32x4){0.f, 0.f, 0.f, 0.f};
        }
        float* yp = YY + (size_t)cd * NTOK * 512 + chh * 64 + 16 * w + fr;
        __syncthreads();
        for (int grp = 0; grp < NG; ++grp) {
#pragma unroll
            for (int c4 = 0; c4 < 4; ++c4) {
                const LAS unsigned char* IM = L + CIMG0 + ((grp & 1) * 4 + c4) * CI_SZ;
                u32x2 oa[2][2], orh[2][2], obt[4], okt[4]; f32x4 ogl[4];
#pragma unroll
                for (int s = 0; s < 2; ++s) {
                    oa[s][0] = *(const LAS u32x2*)(IM + CI_AP + fr * 144 + (32 * s + 4 * g) * 2); oa[s][1] = *(const LAS u32x2*)(IM + CI_AP + fr * 144 + (32 * s + 16 + 4 * g) * 2);
                    orh[s][0] = *(const LAS u32x2*)(IM + CI_RH + fr * 144 + (32 * s + 4 * g) * 2); orh[s][1] = *(const LAS u32x2*)(IM + CI_RH + fr * 144 + (32 * s + 16 + 4 * g) * 2);
                }
                const u32x2 vq = *(const LAS u32x2*)(IM + CI_VT + (16 * w + fr) * 40 + g * 8);
                const u32x2 m0 = *(const LAS u32x2*)(IM + CI_MP + fr * 40 + g * 8);
                const u32x2 p0 = *(const LAS u32x2*)(IM + CI_PP + fr * 72 + g * 8), p1 = *(const LAS u32x2*)(IM + CI_PP + fr * 72 + 32 + g * 8);
#pragma unroll
                for (int kt = 0; kt < 4; ++kt) {
                    obt[kt] = *(const LAS u32x2*)(IM + CI_BT + (16 * kt + fr) * 40 + g * 8); okt[kt] = *(const LAS u32x2*)(IM + CI_KT + (16 * kt + fr) * 40 + g * 8);
                    ogl[kt] = *(const LAS f32x4*)(IM + CI_GL + (16 * kt + 4 * g) * 4);
                }
                bf16x8 Sp[2];
#pragma unroll
                for (int s = 0; s < 2; ++s) { u32x4 pk; pk.x = pack2(S[2 * s][0], S[2 * s][1]); pk.y = pack2(S[2 * s][2], S[2 * s][3]); pk.z = pack2(S[2 * s + 1][0], S[2 * s + 1][1]); pk.w = pack2(S[2 * s + 1][2], S[2 * s + 1][3]); Sp[s] = __builtin_bit_cast(bf16x8, pk); }
                f32x4 U = (f32x4){0.f, 0.f, 0.f, 0.f}, Y = U;
#pragma unroll
                for (int s = 0; s < 2; ++s) {
                    U = __builtin_amdgcn_mfma_f32_16x16x32_bf16(__builtin_bit_cast(bf16x8, (u32x4){oa[s][0].x, oa[s][0].y, oa[s][1].x, oa[s][1].y}), Sp[s], U, 0, 0, 0);
                    Y = __builtin_amdgcn_mfma_f32_16x16x32_bf16(__builtin_bit_cast(bf16x8, (u32x4){orh[s][0].x, orh[s][0].y, orh[s][1].x, orh[s][1].y}), Sp[s], Y, 0, 0, 0);
                }
                U = __builtin_amdgcn_mfma_f32_16x16x32_bf16(__builtin_bit_cast(bf16x8, (u32x4){m0.x, m0.y, 0u, 0u}), __builtin_bit_cast(bf16x8, (u32x4){vq.x, vq.y, vq.x, vq.y}), U, 0, 0, 0);
                u32x4 uvk; uvk.x = pack2(U[0], U[1]); uvk.y = pack2(U[2], U[3]); uvk.z = vq.x; uvk.w = vq.y;
                const bf16x8 UV = __builtin_bit_cast(bf16x8, uvk);
#pragma unroll
                for (int kt = 0; kt < 4; ++kt) {
                    const f32x4 acc = __builtin_amdgcn_mfma_f32_16x16x32_bf16(__builtin_bit_cast(bf16x8, (u32x4){obt[kt].x, obt[kt].y, okt[kt].x, okt[kt].y}), UV, S[kt], 0, 0, 0);
                    S[kt] = acc * ogl[kt];
                }
                Y = __builtin_amdgcn_mfma_f32_16x16x32_bf16(__builtin_bit_cast(bf16x8, (u32x4){p0.x, p0.y, p1.x, p1.y}), UV, Y, 0, 0, 0);
                const int step0 = (grp * 4 + c4) * 16 + 4 * g;
#pragma unroll
                for (int r = 0; r < 4; ++r) yp[(size_t)TOK_OF(step0 + r) * 512] = Y[r];
            }
            __syncthreads();
        }
        if (MODE == 1) {
            float* so = p.out() + OUT_SRWKV + (size_t)(((cb * 2 + cd) * 8 + chh) * 64 + 16 * w + fr) * 64;
#pragma unroll
            for (int kt = 0; kt < 4; ++kt) *(f32x4*)(so + 16 * kt + 4 * g) = S[kt];
        }
    }
#undef TOK_OF
}
__device__ __forceinline__ void phase_l1_scanc(const Frame& F, const PRef& p) {
    if (F.G > 128) {
        if (F.bid < 32) scanc_unit<0, 1>(F, p, F.bid);
        else if (F.bid < 128) scanc_unit<0, 2>(F, p, (F.bid - 32) & 31, 1 + ((F.bid - 32) >> 5));
        else for (int u = F.bid - 128; u < 256; u += F.G - 128) scanc_unit<1, 0>(F, p, u);
    } else { FOR_UNITS(u, 288, 0) { if (u < 32) scanc_unit<0, 0>(F, p, u); else scanc_unit<1, 0>(F, p, u - 32); } }
}
__device__ __forceinline__ void phase_l1_scan(const Frame& F, const PRef& p) {
    const int half = F.G / 2;
    if (F.bid < half) {
        for (int u = F.bid; u < 128; u += half) { const int xcd = u & 7, idx = u >> 3; scan_unit<0>(F, p, (((idx >> 2) * 8 + xcd) << 2) | (idx & 3)); }
    } else {
        for (int u = F.bid - half; u < 256; u += F.G - half) scan_unit<1>(F, p, u);
    }
}

__device__ __forceinline__ void phase_l1_comb(const Frame& F, const PRef& p) {
    unsigned char* ws = p.ws();
    const float* RR = (const float*)(ws + WS_RR); const float* KR = (const float*)(ws + WS_KR); const float* VV = (const float*)(ws + WS_VV);
    const float* AA = (const float*)(ws + WS_AA); const float* GG = (const float*)(ws + WS_GG); const float* YY = (const float*)(ws + WS_YY);
    bf16_t* OB = (bf16_t*)(ws + WS_OB);
    const int nw = F.G * 8, lane = F.lane;
    const bf16_t* DO = (const bf16_t*)(ws + WS_DO);
    const float lam_init = 0.8f - 0.6f * 0.74081822068171788f;
    const float lam = __expf(wave_sum(p.in(31)[lane] * p.in(31)[64 + lane])) - __expf(wave_sum(p.in(31)[128 + lane] * p.in(31)[192 + lane])) + lam_init;
    for (int row = F.bid * 8 + F.wave; row < NTOK; row += nw) {
#pragma unroll
        for (int h = 0; h < 4; ++h) {
            const unsigned a = *(const unsigned*)(DO + (size_t)row * 1024 + (2 * h) * 128 + 2 * lane), b = *(const unsigned*)(DO + (size_t)row * 1024 + (2 * h + 1) * 128 + 2 * lane);
            const float d0 = bf2f(a & 0xffffu) - lam * bf2f(b & 0xffffu), d1 = bf2f(a >> 16) - lam * bf2f(b >> 16);
            const float rstd = rsqrtf(wave_sum(d0 * d0 + d1 * d1) * (1.0f / 128.0f) + EPS) * (1.0f - lam_init);
            const f32x2 gn = *(const f32x2*)(p.in(32) + h * 128 + 2 * lane);
            *(unsigned*)(OB + (size_t)row * 1024 + h * 128 + 2 * lane) = pack2(d0 * rstd * gn[0], d1 * rstd * gn[1]);
        }
        const size_t o = (size_t)row * 512 + lane * 8;
        const f32x4 yf0 = *(const f32x4*)(YY + o), yf1 = *(const f32x4*)(YY + o + 4), yb0 = *(const f32x4*)(YY + (size_t)NTOK * 512 + o), yb1 = *(const f32x4*)(YY + (size_t)NTOK * 512 + o + 4);
        const f32x4 v0 = *(const f32x4*)(VV + o), v1 = *(const f32x4*)(VV + o + 4), g0 = *(const f32x4*)(GG + o), g1 = *(const f32x4*)(GG + o + 4);
        const f32x4 n0 = *(const f32x4*)(p.in(42) + lane * 8), n1 = *(const f32x4*)(p.in(42) + lane * 8 + 4);
        const float* BON = (const float*)(ws + WS_BON);
#if CHUNKED_SCAN
        float bs = 0.f;
        {
            const f32x4 r0 = *(const f32x4*)(RR + o), r1 = *(const f32x4*)(RR + o + 4), k0 = *(const f32x4*)(KR + o), k1 = *(const f32x4*)(KR + o + 4);
            const f32x4 af0 = *(const f32x4*)(AA + o), af1 = *(const f32x4*)(AA + o + 4), ab0 = *(const f32x4*)(AA + (size_t)NTOK * 512 + o), ab1 = *(const f32x4*)(AA + (size_t)NTOK * 512 + o + 4);
            const f32x4 ka0 = *(const f32x4*)(p.in(40) + lane * 8), ka1 = *(const f32x4*)(p.in(40) + lane * 8 + 4), rk0 = *(const f32x4*)(p.in(41) + lane * 8), rk1 = *(const f32x4*)(p.in(41) + lane * 8 + 4);
            const f32x4 t0 = r0 * rk0 * k0 * (2.0f + (af0 + ab0 - 2.0f) * ka0), t1 = r1 * rk1 * k1 * (2.0f + (af1 + ab1 - 2.0f) * ka1);
            bs = oct_sum((t0[0] + t0[1]) + (t0[2] + t0[3]) + (t1[0] + t1[1]) + (t1[2] + t1[3]));
        }
#else
        const float bs = BON[(size_t)row * 8 + (lane >> 3)] + BON[(size_t)NTOK * 8 + (size_t)row * 8 + (lane >> 3)];
#endif
        const f32x4 y0 = yf0 + yb0, y1 = yf1 + yb1;
        float ss = (y0[0] * y0[0] + y0[1] * y0[1]) + (y0[2] * y0[2] + y0[3] * y0[3]) + (y1[0] * y1[0] + y1[1] * y1[1]) + (y1[2] * y1[2] + y1[3] * y1[3]);
        ss = oct_sum(ss);
        const float rstd = rsqrtf(ss * (1.0f / 64.0f) + EPS);
        const f32x4 o0 = (y0 * rstd * n0 + bs * v0) * g0, o1 = (y1 * rstd * n1 + bs * v1) * g1;
        u32x4 w; w.x = pack2(o0[0], o0[1]); w.y = pack2(o0[2], o0[3]); w.z = pack2(o1[0], o1[1]); w.w = pack2(o1[2], o1[3]);
        *(u32x4*)(OB + (size_t)row * 1024 + 512 + lane * 8) = w;
    }
}

constexpr int NPHASE = 26;
#ifndef PH_ONLY
#define PH_ONLY -1
#endif
#if ONE_LAUNCH
#define SEAM() xcd_barrier(bar)
#else
#define SEAM() do {} while (0)
#endif
#define IN(k) (lo <= (k) && (k) < hi && (PH_ONLY < 0 || (k) == PH_ONLY))
#define END(k) do { if (IN((k) + 1)) SEAM(); } while (0)
#ifndef REP_MASK
#define REP_MASK 0u
#endif
#define REPS(k) for (int rep_ = 0; rep_ < 1 + (int)(((unsigned)REP_MASK >> (k)) & 1u); ++rep_, __syncthreads())

constexpr size_t WS_PARTA = WS_BIG;
constexpr size_t WS_PARTD = WS_U;
static_assert(WS_PARTD + (size_t)2 * NTOK * 1024 * 4 <= WS_ACT, "down-projection slabs overlap ACT");
template <int l>
__device__ __forceinline__ void layer_phases(const Frame& F, const PRef& p, const int lo, const int hi, const XcdBarrier bar) {
    constexpr int pb = 1 + l * 12;
    if (IN(pb + 0)) { REPS(pb + 0) {
        unsigned char* ws = p.ws(); const float* ml = (const float*)(ws + WS_MOD) + (size_t)l * 3 * 6144;
        if (l == 0) phase_norm(F, p.in(0), p.in(1), nullptr, nullptr, nullptr, p.in(12), ml + 1024, ml + 0, (bf16_t*)(ws + WS_HB), true);
        else { float* xbuf = p.out(); phase_norm(F, xbuf, xbuf + (size_t)NCTX * 1024, (const bf16_t*)(ws + WS_PARTD), (const float*)(ws + WS_MOD) + 5120, xbuf, p.in(12) + 1024, ml + 1024, ml + 0, (bf16_t*)(ws + WS_HB), true); }
        } END(pb + 0); }
    if (IN(pb + 1)) { REPS(pb + 1) {
        unsigned char* ws = p.ws();
        if (l == 0) { BigDesc g{(const bf16_t*)(ws + WS_HB), (const bf16_t*)(ws + WS_WAIN), 1024, 1024, 24, 8, 1, 1024}; EpiF32WT E{wt_rsrc(ws + WS_P0, (size_t)NTOK * 2048 * 4), 2048}; gemm_big<false>(F, g, E); if (F.G == 256) cvt_group(F, p, 1, 192, 64, 0); else cvt_group(F, p, 1, 0, F.G, 0); }
        else {
            BigDesc g{(const bf16_t*)(ws + WS_HB), (const bf16_t*)(ws + WS_WBIN), 1024, 1024, 24, 14, 1, 1024}; EpiF32WT E{wt_rsrc(ws + WS_P1, (size_t)NTOK * 3584 * 4), 3584}; gemm_big<false, EpiF32WT, true>(F, g, E);
        }
        } END(pb + 1);
    }
    if (IN(pb + 2)) { REPS(pb + 2) { if (l == 0) phase_l0_tok(F, p); else phase_l1_tok(F, p); } END(pb + 2); }
    if (IN(pb + 3)) { REPS(pb + 3) {
        unsigned char* ws = p.ws();
        if (l == 0) {
            { GemmDesc g{(const bf16_t*)(ws + WS_CQN), (const bf16_t*)(ws + WS_WUQ), 256, 256, NTOK, 768, 256}; EpiF32 E{(float*)(ws + WS_QRAW), 768, 768}; gemm_s(F, g, E, 0); }
            { GemmDesc g{(const bf16_t*)(ws + WS_CKVN), (const bf16_t*)(ws + WS_WUKV), 128, 128, NKROW, 1024, 128}; EpiF32 E{(float*)(ws + WS_KVRAW), 1024, 1024}; gemm_s(F, g, E, 48 * 6); }
            phase_l0_prefix(F, p, 48 * 6 + 56 * 8);
        } else {
            const bf16_t* TW = (const bf16_t*)(ws + WS_TW); const bf16_t* AD = (const bf16_t*)(ws + WS_AD); const bf16_t* SG = (const bf16_t*)(ws + WS_SG);
            float* DEC = (float*)(ws + WS_DEC); float* AA = (float*)(ws + WS_AA);
            { GemmDesc g{TW, (const bf16_t*)(ws + WS_WWUP), 128, 64, NTOK, 512, 64}; EpiDecay E{DEC, p.in(34)}; gemm_s(F, g, E, 0); }
            { GemmDesc g{TW + 64, (const bf16_t*)(ws + WS_WWUP) + 512 * 64, 128, 64, NTOK, 512, 64}; EpiDecay E{DEC + (size_t)NTOK * 512, p.in(34) + 512}; gemm_s(F, g, E, 192); }
            { GemmDesc g{AD, (const bf16_t*)(ws + WS_WAUP), 128, 64, NTOK, 512, 64}; EpiSigm E{AA, p.in(36)}; gemm_s(F, g, E, 384); }
            { GemmDesc g{AD + 64, (const bf16_t*)(ws + WS_WAUP) + 512 * 64, 128, 64, NTOK, 512, 64}; EpiSigm E{AA + (size_t)NTOK * 512, p.in(36) + 512}; gemm_s(F, g, E, 576); }
            { GemmDesc g{SG, (const bf16_t*)(ws + WS_WGUP), 128, 128, NTOK, 512, 128}; EpiF32 E{(float*)(ws + WS_GG), 512, 512}; gemm_s(F, g, E, 768); }
            phase_l1_mix(F, p);
        }
        } END(pb + 3);
    }
    if (l == 0 && IN(pb + 4)) { REPS(pb + 4) { phase_l0_qkv(F, p); } END(pb + 4); }
    if (IN(pb + 5)) { REPS(pb + 5) { if (l == 0) phase_l0_mix(F, p); else {
#if CHUNKED_SCAN
            phase_l1_scanc(F, p);
#else
            phase_l1_scan(F, p);
#endif
        } } END(pb + 5); }
    if (l == 1 && IN(pb + 6)) { REPS(pb + 6) { phase_l1_comb(F, p); } END(pb + 6); }
    if (IN(pb + 7)) { REPS(pb + 7) {
        unsigned char* ws = p.ws();
        BigDesc g{(const bf16_t*)(ws + WS_OB), (const bf16_t*)(ws + WS_WOUT) + (size_t)l * 1024 * 1024, 1024, 1024, 24, 4, 2, 512};
        EpiPartWT E{wt_rsrc(ws + WS_PARTA, (size_t)2 * NTOK * 1024 * 2), (size_t)NTOK * 1024}; gemm_big<true>(F, g, E);
        if (l == 0) { if (F.G == 256) cvt_group(F, p, 3, 192, 64, 0); else cvt_group(F, p, 3, 0, F.G, 0); }
        } END(pb + 7);
    }
    if (IN(pb + 8)) { REPS(pb + 8) {
        unsigned char* ws = p.ws(); const float* ml = (const float*)(ws + WS_MOD) + (size_t)l * 3 * 6144; float* xbuf = p.out();
        const float* xa = l == 0 ? p.in(0) : xbuf; const float* xb = l == 0 ? p.in(1) : xbuf + (size_t)NCTX * 1024;
        phase_norm(F, xa, xb, (const bf16_t*)(ws + WS_PARTA), ml + 2048, xbuf, p.in(13) + l * 1024, ml + 4096, ml + 3072, (bf16_t*)(ws + WS_HB), true); } END(pb + 8); }
    if (IN(pb + 9)) { REPS(pb + 9) {
        unsigned char* ws = p.ws();
        const bf16_t* wup = (const bf16_t*)(ws + WS_WUP) + (size_t)l * 5632 * 1024;
        gemm_upgate(F, (const bf16_t*)(ws + WS_HB), wup, p.in(16) + (size_t)l * 3 * 5632, p.in(17) + (size_t)l * 5632, (bf16_t*)(ws + WS_ACT), (l == 1 && F.G == 256) ? 1 : 0);
        } END(pb + 9);
    }
    if (IN(pb + 11)) { REPS(pb + 11) {
        unsigned char* ws = p.ws();
        BigDesc g{(const bf16_t*)(ws + WS_ACT), (const bf16_t*)(ws + WS_WDN) + (size_t)l * 1024 * 2816, 2816, 2816, 24, 4, 2, 1408};
        if (l == 1 && F.G == 256) {
            unsigned* updone = (unsigned*)(ws + WS_BAR) + UPDONE_WORD;
            if (F.bid < 120) {
                const bf16_t* wup = (const bf16_t*)(ws + WS_WUP) + (size_t)l * 5632 * 1024;
                gemm_upgate(F, (const bf16_t*)(ws + WS_HB), wup, p.in(16) + (size_t)l * 3 * 5632, p.in(17) + (size_t)l * 5632, (bf16_t*)(ws + WS_ACT), 2);
                asm volatile("s_waitcnt vmcnt(0)" ::: "memory");
                __syncthreads();
                if (F.tid == 0) {
                    __builtin_amdgcn_fence(__ATOMIC_RELEASE, "agent");
                    (void)xb_add(updone, 1u);
                    if (F.bid >= 64 && F.bid < 112) { XB_SPIN(xb_ld(updone) < 120u, (unsigned*)(ws + WS_BAR)); __builtin_amdgcn_fence(__ATOMIC_ACQUIRE, "agent"); }
                }
                __syncthreads();
            }
            EpiPartWT E{wt_rsrc(ws + WS_PARTD, (size_t)4 * NTOK * 1024 * 2), (size_t)NTOK * 1024}; gemm_big<true, EpiPartWT, false, 1>(F, g, E);
        } else {
            EpiPartWT E{wt_rsrc(ws + WS_PARTD, (size_t)2 * NTOK * 1024 * 2), (size_t)NTOK * 1024}; gemm_big<true>(F, g, E);
            if (l == 0) { if (F.G == 256) cvt_group(F, p, 2, 192, 64, 0); else cvt_group(F, p, 2, 0, F.G, 0); }
        }
        } END(pb + 11);
    }
}

__global__ void __launch_bounds__(NTHREADS, 2) fwd_kernel(Params kp) {
    extern __shared__ __attribute__((aligned(16))) unsigned char lds_raw[];
    Frame F;
    F.lds = (LAS unsigned char*)lds_raw + LDS_WORK;
    F.tid = threadIdx.x; F.lane = F.tid & 63; F.wave = __builtin_amdgcn_readfirstlane(F.tid >> 6); F.G = gridDim.x; F.bid = blockIdx.x;
    {
        LAS unsigned* pw = (LAS unsigned*)((LAS unsigned char*)lds_raw + 64);
        if (F.tid < (int)(sizeof(Params) / 4)) pw[F.tid] = ((const unsigned*)&kp)[F.tid];
        if (F.tid < 4) ((LAS unsigned*)((LAS unsigned char*)lds_raw))[F.tid] = 0u;
    }
    __syncthreads();
    PRef p; p.w = (const LAS unsigned*)((LAS unsigned char*)lds_raw + 64);
    const int lo = kp.ph_lo, hi = kp.ph_hi;
    XcdBarrier bar; bar.bar = nullptr; bar.x = 0; bar.st = nullptr;
#if ONE_LAUNCH
    bar = xcd_barrier_post((unsigned*)(p.ws() + WS_BAR), (volatile LAS unsigned*)((LAS unsigned char*)lds_raw));
#endif
#ifdef EXTRA_BARS
    for (int i_ = 0; i_ < EXTRA_BARS; ++i_) SEAM();
#endif
    if (IN(0)) { REPS(0) { phase_prep(F, p); } END(0); }
    layer_phases<0>(F, p, lo, hi, bar);
    layer_phases<1>(F, p, lo, hi, bar);
    if (IN(25)) {
        unsigned char* ws = p.ws(); float* xbuf = p.out();
        phase_norm(F, xbuf, xbuf + (size_t)NCTX * 1024, (const bf16_t*)(ws + WS_PARTD), (const float*)(ws + WS_MOD) + 3 * 6144 + 5120, xbuf, nullptr, nullptr, nullptr, nullptr, false, F.G == 256 ? 17 * 256 : NTOK);
    }
}

extern "C" void kernel_launch(void* const* d_in, const int* in_sizes, int n_in, void* d_out, int out_size, void* d_ws, size_t ws_size, hipStream_t stream) {
    static int grid = 0;
    if (grid == 0) {
        if (n_in != 43 || (size_t)out_size != OUT_END || ws_size < WS_END) { fprintf(stderr, "kernel_launch: unexpected shapes: n_in %d out %d ws %zu (need %zu)\n", n_in, out_size, ws_size, (size_t)WS_END); grid = -1; return; }
        int dev = 0, cus = 0, per_cu = 0;
        if (hipGetDevice(&dev) != hipSuccess || hipDeviceGetAttribute(&cus, hipDeviceAttributeMultiprocessorCount, dev) != hipSuccess) { grid = -1; return; }
        if (hipFuncSetAttribute((const void*)fwd_kernel, hipFuncAttributeMaxDynamicSharedMemorySize, LDS_BYTES) != hipSuccess) { fprintf(stderr, "kernel_launch: hipFuncSetAttribute failed\n"); grid = -1; return; }
        if (hipOccupancyMaxActiveBlocksPerMultiprocessor(&per_cu, (const void*)fwd_kernel, NTHREADS, LDS_BYTES) != hipSuccess || per_cu < 1) { fprintf(stderr, "kernel_launch: occupancy query says %d blocks per CU\n", per_cu); grid = -1; (void)hipGetLastError(); return; }
        grid = cus;
    }
    if (grid < 0) return;
    Params p{};
    for (int i = 0; i < 43; ++i) p.in[i] = (const float*)d_in[i];
    p.out = (float*)d_out; p.ws = (unsigned char*)d_ws;
#if ONE_LAUNCH
    (void)hipMemsetAsync((char*)d_ws + WS_BAR, 0, 16384, stream);
    p.ph_lo = 0; p.ph_hi = NPHASE;
    void* args[] = {&p};
    hipError_t e = hipLaunchCooperativeKernel((const void*)fwd_kernel, dim3(grid), dim3(NTHREADS), args, LDS_BYTES, stream);
    if (e != hipSuccess) fprintf(stderr, "cooperative launch failed: %s (grid %d)\n", hipGetErrorString(e), grid);
#else
    for (int ph = 0; ph < NPHASE; ++ph) {
        p.ph_lo = ph; p.ph_hi = ph + 1;
        hipLaunchKernelGGL(fwd_kernel, dim3(grid), dim3(NTHREADS), LDS_BYTES, stream, p);
    }
#endif
}
```

```cpp
#include <hip/hip_runtime.h>
#include <cstdio>
#include <cstdint>

#define LAS __attribute__((address_space(3)))
typedef unsigned short bf16_t;
typedef short bf16x8 __attribute__((ext_vector_type(8)));
typedef short bf16x4 __attribute__((ext_vector_type(4)));
typedef float f32x4 __attribute__((ext_vector_type(4)));
typedef float f32x2 __attribute__((ext_vector_type(2)));
typedef unsigned u32x2 __attribute__((ext_vector_type(2)));
typedef unsigned u32x4 __attribute__((ext_vector_type(4)));

#define REP_MASK 0u
#define ATT_REP 0
#define SCAN_REP 0
#ifndef CHUNKED_SCAN
#define CHUNKED_SCAN 1
#endif
#ifndef ONE_LAUNCH
#define ONE_LAUNCH 1
#endif

constexpr int NTHREADS = 512;
constexpr int LDS_BYTES = 144 * 1024;
constexpr int LDS_WORK = 1024;
constexpr int DM = 1024, NCTX = 4096, NLAT = 2048, NTOK = 6144, NKROW = 7168, DFF = 2816;
constexpr float EPS = 1e-6f;

constexpr size_t al256(size_t x) { return (x + 255) & ~(size_t)255; }
constexpr size_t WS_BAR = 0;
constexpr size_t WS_MOD = WS_BAR + 16384;
constexpr size_t WS_WAIN = al256(WS_MOD + 2 * 3 * 6144 * 4);
constexpr size_t WS_WUQ = WS_WAIN + (size_t)2048 * 1024 * 2;
constexpr size_t WS_WUKV = WS_WUQ + (size_t)768 * 256 * 2;
constexpr size_t WS_WOUT = WS_WUKV + (size_t)1024 * 128 * 2;
constexpr size_t WS_WUP = WS_WOUT + (size_t)2 * 1024 * 1024 * 2;
constexpr size_t WS_WDN = WS_WUP + (size_t)2 * 5632 * 1024 * 2;
constexpr size_t WS_WBIN = WS_WDN + (size_t)2 * 1024 * 2816 * 2;
constexpr size_t WS_WWUP = WS_WBIN + (size_t)3584 * 1024 * 2;
constexpr size_t WS_WAUP = WS_WWUP + (size_t)2 * 512 * 64 * 2;
constexpr size_t WS_WGUP = WS_WAUP + (size_t)2 * 512 * 64 * 2;
constexpr size_t WS_HB = WS_WGUP + (size_t)512 * 128 * 2;
constexpr size_t WS_OB = WS_HB + (size_t)NTOK * 1024 * 2;
constexpr size_t WS_BIG = WS_OB + (size_t)NTOK * 1024 * 2;
constexpr size_t WS_P0 = WS_BIG;
constexpr size_t WS_CQN = WS_P0 + (size_t)NTOK * 2048 * 4;
constexpr size_t WS_CKVN = WS_CQN + (size_t)NTOK * 256 * 2;
constexpr size_t WS_QRAW = WS_CKVN + (size_t)NKROW * 128 * 2;
constexpr size_t WS_KVRAW = WS_QRAW + (size_t)NTOK * 768 * 4;
constexpr size_t WS_Q0 = WS_KVRAW + (size_t)NKROW * 1024 * 4;
constexpr size_t WS_K0 = WS_Q0 + (size_t)NTOK * 768 * 2;
constexpr size_t WS_VT0 = WS_K0 + (size_t)NKROW * 768 * 2;
constexpr size_t WS_KVS = WS_VT0 + (size_t)NKROW * 512 * 2;
constexpr size_t WS_L0END = WS_KVS + (size_t)384 * 2 * 8192 * 4;
constexpr size_t WS_U = WS_BIG;
constexpr size_t WS_ACT = WS_U + (size_t)NTOK * 5632 * 2;
constexpr size_t WS_FFNEND = WS_ACT + (size_t)NTOK * 2816 * 2;
constexpr size_t WS_P1 = WS_BIG;
constexpr size_t WS_DEC = WS_BIG;
constexpr size_t WS_AA = WS_DEC + (size_t)2 * NTOK * 512 * 4;
constexpr size_t WS_GG = WS_AA + (size_t)2 * NTOK * 512 * 4;
constexpr size_t WS_YY = WS_GG + (size_t)NTOK * 512 * 4;
constexpr size_t WS_QD = WS_P1 + (size_t)NTOK * 3584 * 4;
constexpr size_t WS_KD = WS_QD + (size_t)NTOK * 512 * 2;
constexpr size_t WS_VDT = WS_KD + (size_t)NKROW * 512 * 2;
constexpr size_t WS_RR = WS_VDT + (size_t)NKROW * 512 * 2;
constexpr size_t WS_KR = WS_RR + (size_t)NTOK * 512 * 4;
constexpr size_t WS_VV = WS_KR + (size_t)NTOK * 512 * 4;
constexpr size_t WS_KK = WS_VV + (size_t)NTOK * 512 * 4;
constexpr size_t WS_TW = WS_KK + (size_t)NTOK * 512 * 4;
constexpr size_t WS_AD = WS_TW + (size_t)NTOK * 128 * 2;
constexpr size_t WS_SG = WS_AD + (size_t)NTOK * 128 * 2;
constexpr size_t WS_DO = WS_SG + (size_t)NTOK * 128 * 2;
constexpr size_t WS_BON = WS_DO + (size_t)NTOK * 1024 * 2;
constexpr size_t WS_L1END = WS_BON + (size_t)2 * NTOK * 8 * 4;
constexpr size_t cmax(size_t a, size_t b) { return a > b ? a : b; }
constexpr size_t WS_END = cmax(cmax(WS_L0END, WS_FFNEND), WS_L1END);
static_assert(WS_YY + (size_t)2 * NTOK * 512 * 4 <= WS_QD, "layer-1 overlay");
static_assert(WS_END <= (size_t)256 * 1024 * 1024, "workspace exceeds 256 MiB");

constexpr size_t OUT_X = 0;
constexpr size_t OUT_CKV = (size_t)NTOK * 1024;
constexpr size_t OUT_KROPE = OUT_CKV + (size_t)NCTX * 128;
constexpr size_t OUT_SRET = OUT_KROPE + (size_t)NCTX * 32;
constexpr size_t OUT_DK = OUT_SRET + (size_t)16 * 2 * 4 * 8192;
constexpr size_t OUT_DV = OUT_DK + (size_t)NCTX * 512;
constexpr size_t OUT_SRWKV = OUT_DV + (size_t)NCTX * 512;
constexpr size_t OUT_END = OUT_SRWKV + (size_t)16 * 2 * 8 * 4096;

struct Params {
    const float* in[43];
    float* out;
    unsigned char* ws;
    int ph_lo, ph_hi;
};

struct PRef {
    const LAS unsigned* w;
    __device__ __forceinline__ unsigned long long q(int i) const {
        const unsigned lo = (unsigned)__builtin_amdgcn_readfirstlane((int)w[2 * i]), hi = (unsigned)__builtin_amdgcn_readfirstlane((int)w[2 * i + 1]);
        return ((unsigned long long)hi << 32) | lo; }
    __device__ __forceinline__ const float* in(int k) const { return (const float*)(const __attribute__((address_space(1))) float*)q(k); }
    __device__ __forceinline__ float* out() const { return (float*)(__attribute__((address_space(1))) float*)q(43); }
    __device__ __forceinline__ unsigned char* ws() const { return (unsigned char*)(__attribute__((address_space(1))) unsigned char*)q(44); }
};

typedef __bf16 hwbf16x2 __attribute__((ext_vector_type(2)));
__device__ __forceinline__ unsigned pack2(float a, float b) { const f32x2 v = (f32x2){a, b}; return __builtin_bit_cast(unsigned, __builtin_convertvector(v, hwbf16x2)); }
__device__ __forceinline__ bf16_t f2bf(float f) { return (bf16_t)(pack2(f, 0.f) & 0xffffu); }
__device__ __forceinline__ float bf2f(unsigned b) { return __uint_as_float(b << 16); }
#define RDLANE(x, l) __int_as_float(__builtin_amdgcn_readlane(__float_as_int(x), (l)))
#define DPPF(x, ctrl) __int_as_float(__builtin_amdgcn_update_dpp(0, __float_as_int(x), (ctrl), 0xF, 0xF, true))
__device__ __forceinline__ float row16_sum(float v) {
    v += DPPF(v, 0xB1); v += DPPF(v, 0x4E); v += DPPF(v, 0x141); v += DPPF(v, 0x140); return v; }
__device__ __forceinline__ float oct_sum(float v) {
    v += DPPF(v, 0xB1); v += DPPF(v, 0x4E); v += DPPF(v, 0x141); return v; }
__device__ __forceinline__ float wave_sum(float v) {
    v = row16_sum(v);
    return (RDLANE(v, 0) + RDLANE(v, 16)) + (RDLANE(v, 32) + RDLANE(v, 48));
}
__device__ __forceinline__ float half_sum(float v, int lane) {
    v = row16_sum(v);
    const float a = RDLANE(v, 0) + RDLANE(v, 16), b = RDLANE(v, 32) + RDLANE(v, 48);
    return lane < 32 ? a : b;
}
__device__ __forceinline__ float sigmoidf_(float x) { return 1.0f / (1.0f + __expf(-x)); }
__device__ __forceinline__ float siluf_(float x) { return x * sigmoidf_(x); }
__device__ __forceinline__ float tanhf_(float x) { return 1.0f - 2.0f / (__expf(2.0f * x) + 1.0f); }
__device__ __forceinline__ int cond_of(int row) { return row < NCTX ? 0 : 1 + ((row - NCTX) >> 10); }

#define XB_TMO      128
#define XB_XCNT(j)  (256  + 64 * (j))
#define XB_XSUB(j)  (1280 + 64 * (j))
#define XB_XGEN(j)  (2304 + 64 * (j))
#define XB_TOP      3328
#define XB_TOPGEN   3392
#define XCD_BAR_WORDS 3456
#define UPDONE_WORD 3520
#define XB_SPIN_CAP (1u << 20)
__device__ __forceinline__ unsigned xb_ld(unsigned* p) { return __hip_atomic_load(p, __ATOMIC_RELAXED, __HIP_MEMORY_SCOPE_AGENT); }
__device__ __forceinline__ unsigned xb_add(unsigned* p, unsigned v) { return __hip_atomic_fetch_add(p, v, __ATOMIC_RELAXED, __HIP_MEMORY_SCOPE_AGENT); }
__device__ __forceinline__ unsigned xb_xcc_id() { return (unsigned)__builtin_amdgcn_s_getreg((3 << 11) | 20) & 0xFu; }
#define XB_SPIN(cond, bar) do { unsigned _sp = 0; while (cond) { __builtin_amdgcn_s_sleep(1); \
    if ((++_sp & 255u) == 0u) { if (xb_ld(&(bar)[XB_TMO])) break; if (_sp > XB_SPIN_CAP) { atomicAdd(&(bar)[XB_TMO], 1u); break; } } } } while (0)
struct XcdBarrier { unsigned* bar; unsigned x; volatile LAS unsigned* st; };
__device__ __forceinline__ XcdBarrier xcd_barrier_post(unsigned* bar, volatile LAS unsigned* st) {
    XcdBarrier b; b.bar = bar; b.x = xb_xcc_id(); b.st = st;
    if (threadIdx.x == 0) (void)xb_add(&bar[XB_XCNT(b.x)], 1u);
    return b;
}
__device__ __forceinline__ void xcd_barrier_complete(unsigned* bar, unsigned x, unsigned& nloc, unsigned& nx) {
    const unsigned G = gridDim.x * gridDim.y * gridDim.z;
    unsigned sum, cnt, mine, sp = 0u;
    for (;;) {
        sum = 0u; cnt = 0u; mine = 0u;
#pragma unroll
        for (unsigned j = 0; j < 16; ++j) { const unsigned c = xb_ld(&bar[XB_XCNT(j)]); sum += c; cnt += (c > 0u) ? 1u : 0u; mine = (j == x) ? c : mine; }
        if (sum == G) break;
        __builtin_amdgcn_s_sleep(1);
        if ((++sp & 255u) == 0u) { if (xb_ld(&bar[XB_TMO])) break; if (sp > XB_SPIN_CAP) { atomicAdd(&bar[XB_TMO], 1u); break; } }
    }
    nloc = mine > 0u ? mine : 1u; nx = cnt > 0u ? cnt : 1u;
}
__device__ __forceinline__ void xcd_barrier(const XcdBarrier& b) {
    asm volatile("s_waitcnt vmcnt(0)" ::: "memory");
    __syncthreads();
    if (threadIdx.x == 0) {
        unsigned* bar = b.bar;
        __builtin_amdgcn_s_waitcnt(0);
        unsigned nloc = b.st[0], nx = b.st[1];
        if (nloc == 0u) { xcd_barrier_complete(bar, b.x, nloc, nx); b.st[0] = nloc; b.st[1] = nx; }
        const unsigned old = xb_add(&bar[XB_XSUB(b.x)], 1u);
        const unsigned gen = old / nloc;
        if (old + 1u == (gen + 1u) * nloc) {
            __builtin_amdgcn_fence(__ATOMIC_RELEASE, "agent");
            asm volatile("s_waitcnt vmcnt(0)" ::: "memory");
            const unsigned og = xb_add(&bar[XB_TOP], 1u);
            const unsigned tg = og / nx;
            if (og + 1u == (tg + 1u) * nx) xb_add(&bar[XB_TOPGEN], 1u);
            else XB_SPIN(xb_ld(&bar[XB_TOPGEN]) == tg, bar);
            __builtin_amdgcn_fence(__ATOMIC_ACQUIRE, "agent");
            xb_add(&bar[XB_XGEN(b.x)], 1u);
            asm volatile("s_waitcnt vmcnt(0)" ::: "memory");
        } else {
            XB_SPIN(xb_ld(&bar[XB_XGEN(b.x)]) == gen, bar);
            __builtin_amdgcn_fence(__ATOMIC_ACQUIRE, "agent");
            asm volatile("s_waitcnt vmcnt(0)" ::: "memory");
        }
    }
    __syncthreads();
}

struct Frame {
    LAS unsigned char* lds;
    int tid, lane, wave, G, bid;
};
#define FOR_UNITS(u, n, rot) for (int u = (int)((F.bid + F.G - ((rot) % F.G)) % F.G); u < (n); u += F.G)

__device__ __forceinline__ int lds_byte(int r, int c) { const int st = (r >> 4) * 2 + (c >> 5), rr = r & 15, cc = c & 31, ob = rr * 64 + cc * 2; return st * 1024 + (ob ^ (((ob >> 9) & 1) << 5)); }
__device__ __forceinline__ void stage_rc(int b, int& R, int& C) { const int st = b / 1024, sb = b % 1024, swz = sb ^ (((sb >> 9) & 1) << 5); R = (st >> 1) * 16 + swz / 64; C = (st & 1) * 32 + (swz % 64) / 2; }

struct GemmDesc { const bf16_t* A; const bf16_t* Bt; int lda, ldb, M, N, K; };

typedef unsigned u32x4v __attribute__((ext_vector_type(4)));
__device__ __forceinline__ __amdgpu_buffer_rsrc_t wt_rsrc(void* base, size_t bytes) { return __builtin_amdgcn_make_buffer_rsrc(base, 0, (int)bytes, 0x00020000); }
__device__ __forceinline__ void wt_store16(const __amdgpu_buffer_rsrc_t r, size_t byte_off, u32x4 v) { __builtin_amdgcn_raw_buffer_store_b128(v, r, (int)byte_off, 0, 16); }
struct EpiF32 { float* C; int ldc, ncols;
    __device__ __forceinline__ void operator()(int r, int c, f32x4 v, int ks = 0) const { if (c < ncols) *(f32x4*)(C + (size_t)r * ldc + c) = v; } };
struct EpiF32WT { __amdgpu_buffer_rsrc_t R; int ldc;
    __device__ __forceinline__ void operator()(int r, int c, f32x4 v, int ks = 0) const { wt_store16(R, ((size_t)r * ldc + c) * 4, __builtin_bit_cast(u32x4, v)); } };
struct EpiBf16 { bf16_t* C; int ldc, ncols;
    __device__ __forceinline__ void e8(int r, int c, f32x4 v0, f32x4 v1, int ks = 0) const { u32x4 w; w.x = pack2(v0[0], v0[1]); w.y = pack2(v0[2], v0[3]); w.z = pack2(v1[0], v1[1]); w.w = pack2(v1[2], v1[3]); *(u32x4*)(C + (size_t)r * ldc + c) = w; }
    __device__ __forceinline__ void operator()(int r, int c, f32x4 v, int ks = 0) const { if (c < ncols) { u32x2 w; w.x = pack2(v[0], v[1]); w.y = pack2(v[2], v[3]); *(u32x2*)(C + (size_t)r * ldc + c) = w; } } };
struct EpiPart { bf16_t* C; size_t kstride;
    __device__ __forceinline__ void e8(int r, int c, f32x4 v0, f32x4 v1, int ks) const { u32x4 w; w.x = pack2(v0[0], v0[1]); w.y = pack2(v0[2], v0[3]); w.z = pack2(v1[0], v1[1]); w.w = pack2(v1[2], v1[3]);
        *(u32x4*)(C + (size_t)ks * kstride + (size_t)r * 1024 + c) = w; } };
struct EpiBf16WT { __amdgpu_buffer_rsrc_t R; int ldc;
    __device__ __forceinline__ void e8(int r, int c, f32x4 v0, f32x4 v1, int ks = 0) const { u32x4 w; w.x = pack2(v0[0], v0[1]); w.y = pack2(v0[2], v0[3]); w.z = pack2(v1[0], v1[1]); w.w = pack2(v1[2], v1[3]);
        wt_store16(R, ((size_t)r * ldc + c) * 2, w); } };
struct EpiPartWT { __amdgpu_buffer_rsrc_t R; size_t kstride;
    __device__ __forceinline__ void e8(int r, int c, f32x4 v0, f32x4 v1, int ks) const { u32x4 w; w.x = pack2(v0[0], v0[1]); w.y = pack2(v0[2], v0[3]); w.z = pack2(v1[0], v1[1]); w.w = pack2(v1[2], v1[3]);
        wt_store16(R, ((size_t)ks * kstride + (size_t)r * 1024 + c) * 2, w); } };
struct EpiResid { const float* xa; const float* xb; float* xo; const float* gate;
    __device__ __forceinline__ void operator()(int r, int c, f32x4 v, int ks = 0) const {
        const float* xs = r < NCTX ? xa + (size_t)r * 1024 : xb + (size_t)(r - NCTX) * 1024;
        const f32x4 x = *(const f32x4*)(xs + c); const f32x4 g = *(const f32x4*)(gate + cond_of(r) * 6144 + c);
        *(f32x4*)(xo + (size_t)r * 1024 + c) = x + g * v; } };
struct EpiDecay { float* C; const float* w0;
    __device__ __forceinline__ void operator()(int r, int c, f32x4 v, int ks = 0) const { const f32x4 b = *(const f32x4*)(w0 + c); f32x4 o;
#pragma unroll
        for (int j = 0; j < 4; ++j) o[j] = __expf(-0.60653065971f * sigmoidf_(b[j] + v[j]));
        *(f32x4*)(C + (size_t)r * 512 + c) = o; } };
struct EpiSigm { float* C; const float* a0;
    __device__ __forceinline__ void operator()(int r, int c, f32x4 v, int ks = 0) const { const f32x4 b = *(const f32x4*)(a0 + c); f32x4 o;
#pragma unroll
        for (int j = 0; j < 4; ++j) o[j] = sigmoidf_(b[j] + v[j]);
        *(f32x4*)(C + (size_t)r * 512 + c) = o; } };

template <class Epi>
__device__ __forceinline__ void gemm_s(const Frame& F, const GemmDesc g, const Epi& E, int rot, int ufirst = -1, int ustep = 0, int ulast = 0) {
    LAS unsigned char* lds = F.lds;
    const int tid = F.tid, wid = F.wave, lane = F.lane, wr = wid >> 2, wc = wid & 3, fr = lane & 15, fq = lane >> 4;
    const int nM = g.M / 128, nN = g.N / 128, nU = nM * nN, nt = g.K / 64;
    int R0, C0, R1, C1; stage_rc(tid * 16, R0, C0); stage_rc(tid * 16 + 8192, R1, C1);
    const int aoff = lds_byte(wr * 64 + fr, fq * 8), boff = lds_byte(wc * 32 + fr, fq * 8);
    const unsigned ldsw = (unsigned)wid * 1024u;
#define GS_STAGE(buf, t) do { \
        __builtin_amdgcn_global_load_lds((const unsigned*)(Ag + (size_t)R0 * g.lda + (t) * 64 + C0), (LAS unsigned*)(lds + (buf) * 32768 + ldsw), 16, 0, 0); \
        __builtin_amdgcn_global_load_lds((const unsigned*)(Ag + (size_t)R1 * g.lda + (t) * 64 + C1), (LAS unsigned*)(lds + (buf) * 32768 + ldsw + 8192), 16, 0, 0); \
        __builtin_amdgcn_global_load_lds((const unsigned*)(Bg + (size_t)R0 * g.ldb + (t) * 64 + C0), (LAS unsigned*)(lds + (buf) * 32768 + 16384 + ldsw), 16, 0, 0); \
        __builtin_amdgcn_global_load_lds((const unsigned*)(Bg + (size_t)R1 * g.ldb + (t) * 64 + C1), (LAS unsigned*)(lds + (buf) * 32768 + 16384 + ldsw + 8192), 16, 0, 0); } while (0)
    const int u0 = ufirst >= 0 ? ufirst : (int)((F.bid + F.G - (rot % F.G)) % F.G), us = ufirst >= 0 ? ustep : F.G, ue = ufirst >= 0 ? ulast : nU;
    for (int u = u0; u < ue; u += us) {
        const int pm = u % nM, pn = u / nM;
        const bf16_t* Ag = g.A + (size_t)(pm * 128) * g.lda; const bf16_t* Bg = g.Bt + (size_t)(pn * 128) * g.ldb;
        f32x4 acc[4][2];
#pragma unroll
        for (int m = 0; m < 4; ++m)
#pragma unroll
            for (int n = 0; n < 2; ++n) acc[m][n] = (f32x4){0.f, 0.f, 0.f, 0.f};
        GS_STAGE(0, 0);
        if (nt > 1) GS_STAGE(1, 1);
        int b = 0, bn = 2;
        for (int t = 0; t < nt; ++t) {
            if (t + 2 < nt) { GS_STAGE(bn, t + 2); asm volatile("s_waitcnt vmcnt(8)" ::: "memory"); }
            else if (t + 1 < nt) asm volatile("s_waitcnt vmcnt(4)" ::: "memory");
            else asm volatile("s_waitcnt vmcnt(0)" ::: "memory");
            __builtin_amdgcn_s_barrier(); asm volatile("" ::: "memory");
            bf16x8 Af[4][2], Bf[2][2];
#pragma unroll
            for (int m = 0; m < 4; ++m)
#pragma unroll
                for (int k = 0; k < 2; ++k) Af[m][k] = *(const LAS bf16x8*)(lds + b * 32768 + aoff + m * 2048 + k * 1024);
#pragma unroll
            for (int n = 0; n < 2; ++n)
#pragma unroll
                for (int k = 0; k < 2; ++k) Bf[n][k] = *(const LAS bf16x8*)(lds + b * 32768 + 16384 + boff + n * 2048 + k * 1024);
#pragma unroll
            for (int k = 0; k < 2; ++k)
#pragma unroll
                for (int m = 0; m < 4; ++m)
#pragma unroll
                    for (int n = 0; n < 2; ++n) acc[m][n] = __builtin_amdgcn_mfma_f32_16x16x32_bf16(Bf[n][k], Af[m][k], acc[m][n], 0, 0, 0);
            asm volatile("s_waitcnt lgkmcnt(0)" ::: "memory");
            __builtin_amdgcn_s_barrier(); asm volatile("" ::: "memory");
            b = b == 2 ? 0 : b + 1; bn = bn == 2 ? 0 : bn + 1;
        }
#pragma unroll
        for (int m = 0; m < 4; ++m)
#pragma unroll
            for (int n = 0; n < 2; ++n) E(pm * 128 + wr * 64 + m * 16 + fr, pn * 128 + wc * 32 + n * 16 + 4 * fq, acc[m][n]);
    }
#undef GS_STAGE
}

constexpr int HTB = 128 * 64 * 2;
struct BigDesc { const bf16_t* A; const bf16_t* Bt; int lda, ldb, nM, nN, nKS, Ksp; };
struct BUnit { int pm, pn, ks, hm; };
__device__ __forceinline__ bool big_next(const BigDesc& g, int i, int G, int c, BUnit& u) {
    const int nNp = g.nN * g.nKS, nwg = g.nM * nNp;
    const long L = (long)i * G + c; if (L >= nwg) return false;
    int wgid = (int)L; { const int q = nwg / 8, r = nwg % 8, xcd = wgid % 8, off = wgid / 8; wgid = (xcd < r ? xcd * (q + 1) : r * (q + 1) + (xcd - r) * q) + off; }
    const int nig = 8 * nNp, gid = wgid / nig, fm = gid * 8, gsz = (g.nM - fm) < 8 ? (g.nM - fm) : 8;
    u.pm = fm + ((wgid % nig) % gsz); const int pnp = (wgid % nig) / gsz; u.pn = pnp / g.nKS; u.ks = pnp % g.nKS; u.hm = -1; return true;
}
template <bool HALFTAIL>
__device__ __forceinline__ bool big_next_h(const BigDesc& g, int i, int G, int c, BUnit& u) {
    if constexpr (!HALFTAIL) return big_next(g, i, G, c, u);
    else {
        const int nwg = g.nM * g.nN * g.nKS, nfr = nwg / G, rem = nwg - nfr * G;
        if (i < nfr || 2 * rem > G) return big_next(g, i, G, c, u);
        if (i > nfr || c >= 2 * rem) return false;
        big_next(g, nfr, G, c >> 1, u); u.hm = c & 1; return true;
    }
}
__device__ __forceinline__ bool down_merged_unit(int i, int bid, BUnit& u) {
    if (i > 0 || (bid >= 112 && bid < 120)) return false;
    u.hm = -1;
    if (bid >= 120) { const int a = bid - 120, tl = a >> 1; u.ks = a & 1; u.pm = tl >> 2; u.pn = tl & 3; }
    else { const int tl = 68 + (bid >> 2); u.ks = bid & 3; u.pm = tl >> 2; u.pn = tl & 3; }
    return true;
}
__device__ __forceinline__ int down_merged_k0(int bid, int ks) { return bid >= 120 ? ks * 1408 : (ks == 0 ? 0 : (ks == 1 ? 12 : (ks == 2 ? 22 : 34))) * 64; }
__device__ __forceinline__ int down_merged_nt(int bid, int ks) { return bid >= 120 ? 22 : ((ks & 1) ? 10 : 12); }
__device__ __forceinline__ int perm32(int rho) { const int n = rho >> 4, i = rho & 15; return 8 * (i >> 2) + 4 * n + (i & 3); }
template <bool PERM, class Epi, bool HALFTAIL = false, int UMODE = 0>
__device__ __forceinline__ void gemm_big(const Frame& F, const BigDesc g, const Epi& E) {
    LAS unsigned char* lds = F.lds;
    const int tid = F.tid, wid = F.wave, lane = F.lane, wr = wid >> 2, wc = wid & 3, fr = lane & 15, fq = lane >> 4;
    unsigned voffA[2], voffB[2];
#pragma unroll
    for (int i = 0; i < 2; ++i) { int R, C; stage_rc(tid * 16 + i * 8192, R, C); const int Rb = PERM ? ((R & ~31) + perm32(R & 31)) : R; voffA[i] = (unsigned)(R * g.lda + C) * 2u; voffB[i] = (unsigned)(Rb * g.ldb + C) * 2u; }
    const size_t kstep = (size_t)(64 * 2);
    const size_t hstepA = (size_t)128 * g.lda * 2, hstepB = (size_t)128 * g.ldb * 2;
    const unsigned ldsw = (unsigned)wid * 1024u;
    const int aoff = lds_byte(wr * 64 + fr, fq * 8), boff = lds_byte(wc * 32 + fr, fq * 8);
#define PG8_SA(b, h) (((b) * 2 + (h)) * HTB)
#define PG8_SB(b, h) ((4 + (b) * 2 + (h)) * HTB)
#define PG8_STAGE(bufoff, gbase, voff) do { _Pragma("unroll") for (int _i = 0; _i < 2; ++_i) \
        __builtin_amdgcn_global_load_lds((const unsigned*)((const char*)(gbase) + (voff)[_i]), (LAS unsigned*)(lds + (bufoff) + ldsw + _i * 8192), 16, 0, 0); } while (0)
#define PG8_LDA(dst, b, h) do { _Pragma("unroll") for (int m = 0; m < 4; ++m) _Pragma("unroll") for (int k = 0; k < 2; ++k) dst[m][k] = *(const LAS bf16x8*)(lds + PG8_SA(b, h) + aoff + m * 2048 + k * 1024); } while (0)
#define PG8_LDB(dst, b, h) do { _Pragma("unroll") for (int n = 0; n < 2; ++n) _Pragma("unroll") for (int k = 0; k < 2; ++k) dst[n][k] = *(const LAS bf16x8*)(lds + PG8_SB(b, h) + boff + n * 2048 + k * 1024); } while (0)
#define PG8_MMA(ai, bj, At, Bt) do { __builtin_amdgcn_s_setprio(1); _Pragma("unroll") for (int m = 0; m < 4; ++m) _Pragma("unroll") for (int n = 0; n < 2; ++n) _Pragma("unroll") for (int k = 0; k < 2; ++k) \
        acc[ai][bj][m][n] = __builtin_amdgcn_mfma_f32_16x16x32_bf16(Bt[n][k], At[m][k], acc[ai][bj][m][n], 0, 0, 0); __builtin_amdgcn_s_setprio(0); } while (0)
#define PG8_WAIT_V(n) asm volatile("s_waitcnt vmcnt(" #n ")" ::: "memory")
#define PG8_WAIT_L(n) asm volatile("s_waitcnt lgkmcnt(" #n ")" ::: "memory")
#define PG8_BAR __builtin_amdgcn_s_barrier()
#define PG8_SCHED __builtin_amdgcn_sched_barrier(0)
#define PG8_K0(u) (UMODE == 1 ? down_merged_k0(F.bid, (u).ks) : (u).ks * g.Ksp)
#define PG8_UA(u) ((const char*)g.A + (size_t)(u).pm * 2 * hstepA + (size_t)PG8_K0(u) * 2)
#define PG8_UB(u) ((const char*)g.Bt + (size_t)((u).pn * 2 + (HALFTAIL && (u).hm > 0 ? 1 : 0)) * hstepB + (size_t)PG8_K0(u) * 2)
#define PG8_NEXT(i, u) (UMODE == 1 ? down_merged_unit(i, F.bid, u) : big_next_h<HALFTAIL>(g, i, F.G, F.bid, u))
#define PG8_UH(u) ((HALFTAIL && (u).hm >= 0) ? (size_t)0 : hstepB)
    BUnit cur, nxt; int ui = 0;
    if (!PG8_NEXT(0, cur)) return;
    f32x4 acc[2][2][4][2];
#pragma unroll
    for (int a = 0; a < 2; ++a)
#pragma unroll
        for (int b = 0; b < 2; ++b)
#pragma unroll
            for (int m = 0; m < 4; ++m)
#pragma unroll
                for (int n = 0; n < 2; ++n) acc[a][b][m][n] = (f32x4){0.f, 0.f, 0.f, 0.f};
    bf16x8 At[4][2], B0[2][2], B1[2][2];
    const char* cA = PG8_UA(cur); const char* cB = PG8_UB(cur); size_t cH = PG8_UH(cur);
    PG8_STAGE(PG8_SB(0, 0), cB, voffB); PG8_STAGE(PG8_SB(0, 1), cB + cH, voffB); PG8_STAGE(PG8_SA(0, 0), cA, voffA); PG8_STAGE(PG8_SA(0, 1), cA + hstepA, voffA);
    if (wr == 1) PG8_BAR;
    PG8_WAIT_V(2); PG8_BAR;
    PG8_STAGE(PG8_SB(1, 0), cB + kstep, voffB); PG8_STAGE(PG8_SA(1, 0), cA + kstep, voffA); PG8_STAGE(PG8_SB(1, 1), cB + cH + kstep, voffB);
    PG8_WAIT_V(6); PG8_BAR;
    for (;;) {
        const bool has_next = PG8_NEXT(ui + 1, nxt);
        const int nt = UMODE == 1 ? down_merged_nt(F.bid, cur.ks) : g.Ksp / 64;
        const char* nA = has_next ? PG8_UA(nxt) : cA; const char* nB = has_next ? PG8_UB(nxt) : cB; const size_t nH = has_next ? PG8_UH(nxt) : cH;
        const bool full = !HALFTAIL || cur.hm < 0;
        for (int t = 0; t < nt; t += 2) {
            const bool last = (t == nt - 2);
            const char* a1 = cA + (size_t)(t + 1) * kstep;
            const char* a2 = last ? nA : cA + (size_t)(t + 2) * kstep; const char* b2 = last ? nB : cB + (size_t)(t + 2) * kstep;
            const char* a3 = a2 + kstep; const char* b3 = b2 + kstep; const size_t h2 = last ? nH : cH;
            PG8_LDB(B0, 0, 0); PG8_LDB(B1, 0, 1); PG8_SCHED; PG8_LDA(At, 0, 0); PG8_STAGE(PG8_SA(1, 1), a1 + hstepA, voffA);
            PG8_WAIT_V(8); PG8_WAIT_L(0); PG8_BAR; PG8_MMA(0, 0, At, B0); if (full) PG8_MMA(0, 1, At, B1); PG8_BAR; PG8_SCHED;
            PG8_LDA(At, 0, 1); PG8_STAGE(PG8_SB(0, 0), b2, voffB); PG8_STAGE(PG8_SB(0, 1), b2 + h2, voffB); PG8_STAGE(PG8_SA(0, 0), a2, voffA);
            PG8_WAIT_V(8); PG8_WAIT_L(0); PG8_BAR; PG8_MMA(1, 0, At, B0); if (full) PG8_MMA(1, 1, At, B1); PG8_BAR; PG8_SCHED;
            PG8_LDB(B0, 1, 0); PG8_LDB(B1, 1, 1); PG8_SCHED; PG8_LDA(At, 1, 0); PG8_STAGE(PG8_SA(0, 1), a2 + hstepA, voffA);
            PG8_WAIT_V(8); PG8_WAIT_L(0); PG8_BAR; PG8_MMA(0, 0, At, B0); if (full) PG8_MMA(0, 1, At, B1); PG8_BAR; PG8_SCHED;
            PG8_LDA(At, 1, 1); PG8_STAGE(PG8_SB(1, 0), b3, voffB); PG8_STAGE(PG8_SB(1, 1), b3 + h2, voffB); PG8_STAGE(PG8_SA(1, 0), a3, voffA);
            PG8_WAIT_V(8); PG8_WAIT_L(0); PG8_BAR; PG8_MMA(1, 0, At, B0); if (full) PG8_MMA(1, 1, At, B1); PG8_BAR; PG8_SCHED;
        }
        if (wr == 0) PG8_BAR;
        {
            const int row0 = cur.pm * 256 + wr * 64 + fr, col0 = cur.pn * 256 + (HALFTAIL && cur.hm > 0 ? 128 : 0) + wc * 32 + (PERM ? 8 : 4) * fq;
#pragma unroll
            for (int ai = 0; ai < 2; ++ai)
#pragma unroll
                for (int m = 0; m < 4; ++m)
#pragma unroll
                    for (int bj = 0; bj < 2; ++bj) {
                        if (bj == 1 && !full) continue;
                        if constexpr (PERM) E.e8(row0 + ai * 128 + m * 16, col0 + bj * 128, acc[ai][bj][m][0], acc[ai][bj][m][1], cur.ks);
                        else {
#pragma unroll
                            for (int n = 0; n < 2; ++n) E(row0 + ai * 128 + m * 16, col0 + bj * 128 + n * 16, acc[ai][bj][m][n], cur.ks);
                        }
                    }
        }
        if (!has_next) break;
#pragma unroll
        for (int a = 0; a < 2; ++a)
#pragma unroll
            for (int b = 0; b < 2; ++b)
#pragma unroll
                for (int m = 0; m < 4; ++m)
#pragma unroll
                    for (int n = 0; n < 2; ++n) acc[a][b][m][n] = (f32x4){0.f, 0.f, 0.f, 0.f};
        cur = nxt; cA = nA; cB = nB; cH = nH; ++ui;
        if (wr == 1) PG8_BAR;
    }
    PG8_WAIT_V(0);
    PG8_BAR;
#undef PG8_SA
#undef PG8_SB
#undef PG8_STAGE
#undef PG8_LDA
#undef PG8_LDB
#undef PG8_MMA
#undef PG8_WAIT_V
#undef PG8_WAIT_L
#undef PG8_BAR
#undef PG8_SCHED
#undef PG8_UA
#undef PG8_UB
#undef PG8_UH
#undef PG8_NEXT
#undef PG8_K0
}

__device__ __forceinline__ void upgate_tile(int pm, int& rowbase, int& vlo, int& vhi, bool& first, bool& last) {
    if (pm < 16) { rowbase = pm * 256; vlo = 0; vhi = 255; first = true; last = true; return; }
    const int s = (pm - 16) / 5, i = (pm - 16) % 5;
    const int start = i == 0 ? 0 : (i == 1 ? 254 : (i == 2 ? 508 : (i == 3 ? 762 : 768)));
    rowbase = NCTX + s * 1024 + start; first = i == 0; last = i == 4;
    vlo = i == 0 ? 0 : (i == 4 ? 249 : 1); vhi = i == 4 ? 255 : 254;
}
__device__ __forceinline__ void gemm_upgate(const Frame& F, const bf16_t* A, const bf16_t* Bt, const float* cw, const float* cb, bf16_t* ACT, const int mode) {
    LAS unsigned char* lds = F.lds;
    const int tid = F.tid, wid = F.wave, lane = F.lane, wr = wid >> 2, wc = wid & 3, fr = lane & 15, fq = lane >> 4;
    constexpr int K = 1024, nt = K / 64, UP = 528;
    BigDesc g{A, Bt, K, K, 26, 22, 1, K};
    unsigned voffA[2], voffB[2];
#pragma unroll
    for (int i = 0; i < 2; ++i) { int R, C; stage_rc(tid * 16 + i * 8192, R, C); voffA[i] = (unsigned)(R * K + C) * 2u; voffB[i] = voffA[i]; }
    const size_t kstep = (size_t)(64 * 2), hstep = (size_t)128 * K * 2;
    const unsigned ldsw = (unsigned)wid * 1024u;
    const int aoff = lds_byte(wr * 64 + fr, fq * 8), boff = lds_byte(wc * 32 + fr, fq * 8);
#define PG8_SA(b, h) (((b) * 2 + (h)) * HTB)
#define PG8_SB(b, h) ((4 + (b) * 2 + (h)) * HTB)
#define PG8_STAGE(bufoff, gbase, voff) do { _Pragma("unroll") for (int _i = 0; _i < 2; ++_i) \
        __builtin_amdgcn_global_load_lds((const unsigned*)((const char*)(gbase) + (voff)[_i]), (LAS unsigned*)(lds + (bufoff) + ldsw + _i * 8192), 16, 0, 0); } while (0)
#define PG8_LDA(dst, b, h) do { _Pragma("unroll") for (int m = 0; m < 4; ++m) _Pragma("unroll") for (int k = 0; k < 2; ++k) dst[m][k] = *(const LAS bf16x8*)(lds + PG8_SA(b, h) + aoff + m * 2048 + k * 1024); } while (0)
#define PG8_LDB(dst, b, h) do { _Pragma("unroll") for (int n = 0; n < 2; ++n) _Pragma("unroll") for (int k = 0; k < 2; ++k) dst[n][k] = *(const LAS bf16x8*)(lds + PG8_SB(b, h) + boff + n * 2048 + k * 1024); } while (0)
#define PG8_MMA(ai, bj, At, Bt_) do { __builtin_amdgcn_s_setprio(1); _Pragma("unroll") for (int m = 0; m < 4; ++m) _Pragma("unroll") for (int n = 0; n < 2; ++n) _Pragma("unroll") for (int k = 0; k < 2; ++k) \
        acc[ai][bj][m][n] = __builtin_amdgcn_mfma_f32_16x16x32_bf16(Bt_[n][k], At[m][k], acc[ai][bj][m][n], 0, 0, 0); __builtin_amdgcn_s_setprio(0); } while (0)
#define PG8_WAIT_V(n) asm volatile("s_waitcnt vmcnt(" #n ")" ::: "memory")
#define PG8_WAIT_L(n) asm volatile("s_waitcnt lgkmcnt(" #n ")" ::: "memory")
#define PG8_BAR __builtin_amdgcn_s_barrier()
#define PG8_SCHED __builtin_amdgcn_sched_barrier(0)
    for (int ui = 0;; ++ui) {
        BUnit cur;
        int hm = -1;
        if (mode == 0) {
            if (F.G == 256 && ui == 2) { if (F.bid >= 120 || !big_next(g, 2, F.G, F.bid >> 1, cur)) break; hm = F.bid & 1; }
            else if (!big_next(g, ui, F.G, F.bid, cur)) break;
        } else if (mode == 1) {
            if (ui >= 2) break;
            BigDesc g23 = g; g23.nM = 23;
            if (!big_next(g23, ui, 256, F.bid, cur)) { cur.pm = 23; cur.pn = ui * 256 + F.bid - 506; }
        } else {
            if (ui >= 1 || F.bid >= 120) break;
            const int j = (F.bid >> 1) + 6; cur.pm = 23 + j / 22; cur.pn = j % 22; hm = F.bid & 1;
        }
        unsigned voffBh[2];
#pragma unroll
        for (int i = 0; i < 2; ++i) { int R, C; stage_rc(tid * 16 + i * 8192, R, C); const int Rs = hm < 0 ? R : R + 64 * hm + (R >= 64 ? 64 : 0); voffBh[i] = (unsigned)(Rs * K + C) * 2u; }
        int rowbase; { int a_, b_; bool c_, d_; upgate_tile(cur.pm, rowbase, a_, b_, c_, d_); }
        f32x4 acc[2][2][4][2];
#pragma unroll
        for (int a = 0; a < 2; ++a)
#pragma unroll
            for (int b = 0; b < 2; ++b)
#pragma unroll
                for (int m = 0; m < 4; ++m)
#pragma unroll
                    for (int n = 0; n < 2; ++n) acc[a][b][m][n] = (f32x4){0.f, 0.f, 0.f, 0.f};
        bf16x8 At[4][2], B0[2][2], B1[2][2];
        const char* cA = (const char*)A + (size_t)rowbase * K * 2; const char* cB = (const char*)Bt + (size_t)cur.pn * 2 * hstep;
        PG8_STAGE(PG8_SB(0, 0), cB, voffBh); PG8_STAGE(PG8_SB(0, 1), cB + hstep, voffB); PG8_STAGE(PG8_SA(0, 0), cA, voffA); PG8_STAGE(PG8_SA(0, 1), cA + hstep, voffA);
        if (wr == 1) PG8_BAR;
        PG8_WAIT_V(2); PG8_BAR;
        PG8_STAGE(PG8_SB(1, 0), cB + kstep, voffBh); PG8_STAGE(PG8_SA(1, 0), cA + kstep, voffA); PG8_STAGE(PG8_SB(1, 1), cB + hstep + kstep, voffB);
        PG8_WAIT_V(6); PG8_BAR;
        for (int t = 0; t < nt; t += 2) {
            const bool last = (t == nt - 2);
            const char* a1 = cA + (size_t)(t + 1) * kstep;
            const char* a2 = last ? cA : cA + (size_t)(t + 2) * kstep; const char* b2 = last ? cB : cB + (size_t)(t + 2) * kstep;
            const char* a3 = a2 + kstep; const char* b3 = b2 + kstep;
            PG8_LDB(B0, 0, 0); PG8_LDB(B1, 0, 1); PG8_SCHED; PG8_LDA(At, 0, 0); PG8_STAGE(PG8_SA(1, 1), a1 + hstep, voffA);
            PG8_WAIT_V(8); PG8_WAIT_L(0); PG8_BAR; PG8_MMA(0, 0, At, B0); if (hm < 0) PG8_MMA(0, 1, At, B1); PG8_BAR; PG8_SCHED;
            PG8_LDA(At, 0, 1); PG8_STAGE(PG8_SB(0, 0), b2, voffBh); PG8_STAGE(PG8_SB(0, 1), b2 + hstep, voffB); PG8_STAGE(PG8_SA(0, 0), a2, voffA);
            PG8_WAIT_V(8); PG8_WAIT_L(0); PG8_BAR; PG8_MMA(1, 0, At, B0); if (hm < 0) PG8_MMA(1, 1, At, B1); PG8_BAR; PG8_SCHED;
            PG8_LDB(B0, 1, 0); PG8_LDB(B1, 1, 1); PG8_SCHED; PG8_LDA(At, 1, 0); PG8_STAGE(PG8_SA(0, 1), a2 + hstep, voffA);
            PG8_WAIT_V(8); PG8_WAIT_L(0); PG8_BAR; PG8_MMA(0, 0, At, B0); if (hm < 0) PG8_MMA(0, 1, At, B1); PG8_BAR; PG8_SCHED;
            PG8_LDA(At, 1, 1); PG8_STAGE(PG8_SB(1, 0), b3, voffBh); PG8_STAGE(PG8_SB(1, 1), b3 + hstep, voffB); PG8_STAGE(PG8_SA(1, 0), a3, voffA);
            PG8_WAIT_V(8); PG8_WAIT_L(0); PG8_BAR; PG8_MMA(1, 0, At, B0); if (hm < 0) PG8_MMA(1, 1, At, B1); PG8_BAR; PG8_SCHED;
        }
        if (wr == 0) PG8_BAR;
        PG8_WAIT_V(0); PG8_BAR;
        asm volatile("" ::: "memory");
#pragma unroll
        for (int ai = 0; ai < 2; ++ai)
#pragma unroll
            for (int m = 0; m < 4; ++m)
#pragma unroll
                for (int bj = 0; bj < 2; ++bj)
#pragma unroll
                    for (int n = 0; n < 2; ++n) {
                        if (bj == 1 && hm >= 0) continue;
                        const f32x4 v = acc[ai][bj][m][n]; u32x2 w; w.x = pack2(v[0], v[1]); w.y = pack2(v[2], v[3]);
                        *(LAS u32x2*)(lds + (ai * 128 + wr * 64 + m * 16 + fr) * UP + (bj * 128 + wc * 32 + n * 16 + 4 * fq) * 2) = w;
                    }
        __syncthreads();
        __builtin_amdgcn_sched_barrier(0);
        int vlo, vhi; { int rb_; bool c_, d_; upgate_tile(cur.pm, rb_, vlo, vhi, c_, d_); }
        {
            const int c = hm < 0 ? (tid & 15) * 8 : (tid & 7) * 8, r0 = hm < 0 ? (tid >> 4) * 8 : (tid >> 3) * 4, nrow = hm < 0 ? 8 : 4, boffc = hm < 0 ? 128 : 64;
            const int ca = cur.pn * 128 + (hm < 0 ? 0 : 64 * hm) + c, cbn = 2816 + ca;
            float wa[3][8], wb[3][8], ba8[8], bb8[8];
#pragma unroll
            for (int q = 0; q < 2; ++q) {
#pragma unroll
                for (int tp = 0; tp < 3; ++tp) {
                    const f32x4 x = *(const f32x4*)(cw + tp * 5632 + ca + q * 4), y = *(const f32x4*)(cw + tp * 5632 + cbn + q * 4);
#pragma unroll
                    for (int jj = 0; jj < 4; ++jj) { wa[tp][q * 4 + jj] = x[jj]; wb[tp][q * 4 + jj] = y[jj]; }
                }
                const f32x4 x = *(const f32x4*)(cb + ca + q * 4), y = *(const f32x4*)(cb + cbn + q * 4);
#pragma unroll
                for (int jj = 0; jj < 4; ++jj) { ba8[q * 4 + jj] = x[jj]; bb8[q * 4 + jj] = y[jj]; }
            }
            const bf16x8 z = (bf16x8){0, 0, 0, 0, 0, 0, 0, 0};
            bf16x8 ap, bp, ac, bc, an, bn;
            {
                const bool hp0 = r0 > 0;
                ap = hp0 ? *(const LAS bf16x8*)(lds + (r0 - 1) * UP + c * 2) : z; bp = hp0 ? *(const LAS bf16x8*)(lds + (r0 - 1) * UP + (boffc + c) * 2) : z;
                ac = *(const LAS bf16x8*)(lds + r0 * UP + c * 2); bc = *(const LAS bf16x8*)(lds + r0 * UP + (boffc + c) * 2);
            }
#pragma unroll 1
            for (int i = 0; i < nrow; ++i) {
                const int r = r0 + i;
                const bool hn = r < 255;
                an = hn ? *(const LAS bf16x8*)(lds + (r + 1) * UP + c * 2) : z; bn = hn ? *(const LAS bf16x8*)(lds + (r + 1) * UP + (boffc + c) * 2) : z;
                if (r >= vlo && r <= vhi) {
                    float ov[8];
#pragma unroll
                    for (int e = 0; e < 8; ++e) {
                        const float ua = bf2f((unsigned short)ap[e]) * wa[0][e] + bf2f((unsigned short)ac[e]) * wa[1][e] + bf2f((unsigned short)an[e]) * wa[2][e] + ba8[e];
                        const float ub = bf2f((unsigned short)bp[e]) * wb[0][e] + bf2f((unsigned short)bc[e]) * wb[1][e] + bf2f((unsigned short)bn[e]) * wb[2][e] + bb8[e];
                        ov[e] = siluf_(ua) * ub;
                    }
                    u32x4 w; w.x = pack2(ov[0], ov[1]); w.y = pack2(ov[2], ov[3]); w.z = pack2(ov[4], ov[5]); w.w = pack2(ov[6], ov[7]);
                    *(u32x4*)(ACT + (size_t)(rowbase + r) * 2816 + ca) = w;
                }
                ap = ac; bp = bc; ac = an; bc = bn;
            }
        }
        __syncthreads();
    }
#undef PG8_SA
#undef PG8_SB
#undef PG8_STAGE
#undef PG8_LDA
#undef PG8_LDB
#undef PG8_MMA
#undef PG8_WAIT_V
#undef PG8_WAIT_L
#undef PG8_BAR
#undef PG8_SCHED
}

struct CvtJob { const float* src; bf16_t* dst; int K, N, Npad, tiles, upperm; };
template <int NT>
__device__ __forceinline__ void cvt_run(const Frame& F, const CvtJob& j, int t0, int nb) {
    LAS float* tiles = (LAS float*)F.lds;
    const int tk = j.K / 64, tid = F.tid;
    const int r = tid >> 4, c4 = (tid & 15) * 4, n = tid >> 3, kq = (tid & 7) * 8;
    f32x4 v[NT][2];
#define CVT_LOAD(tb) do { _Pragma("unroll") for (int q = 0; q < NT; ++q) { const int t = (tb) + q * nb; \
        _Pragma("unroll") for (int i = 0; i < 2; ++i) { v[q][i] = (f32x4){0.f, 0.f, 0.f, 0.f}; \
            if (t < j.tiles) { const int k0 = (t % tk) * 64, n0 = (t / tk) * 64; if (n0 + c4 < j.N) v[q][i] = *(const f32x4*)(j.src + (size_t)(k0 + r + 32 * i) * j.N + n0 + c4); } } } } while (0)
    CVT_LOAD(t0);
    for (int tb = t0; tb < j.tiles; tb += NT * nb) {
#pragma unroll
        for (int q = 0; q < NT; ++q)
#pragma unroll
            for (int i = 0; i < 2; ++i) { LAS float* tp = tiles + q * (64 * 65) + (r + 32 * i) * 65 + c4; tp[0] = v[q][i][0]; tp[1] = v[q][i][1]; tp[2] = v[q][i][2]; tp[3] = v[q][i][3]; }
        __syncthreads();
        CVT_LOAD(tb + NT * nb);
#pragma unroll
        for (int q = 0; q < NT; ++q) {
            const int t = tb + q * nb;
            if (t < j.tiles) {
                const int k0 = (t % tk) * 64, n0 = (t / tk) * 64;
                const LAS float* tile = tiles + q * (64 * 65);
                u32x4 w;
                w.x = pack2(tile[(kq + 0) * 65 + n], tile[(kq + 1) * 65 + n]); w.y = pack2(tile[(kq + 2) * 65 + n], tile[(kq + 3) * 65 + n]);
                w.z = pack2(tile[(kq + 4) * 65 + n], tile[(kq + 5) * 65 + n]); w.w = pack2(tile[(kq + 6) * 65 + n], tile[(kq + 7) * 65 + n]);
                const int drow = j.upperm ? (n0 < 2816 ? (n0 >> 7) * 256 + (n0 & 127) : ((n0 - 2816) >> 7) * 256 + 128 + ((n0 - 2816) & 127)) + n : n0 + n;
                *(u32x4*)(j.dst + (size_t)drow * j.K + k0 + kq) = w;
            }
        }
        __syncthreads();
    }
#undef CVT_LOAD
}

__device__ __forceinline__ void cvt_group(const Frame& F, const PRef& p, int group, int bfirst, int nb, int rot0) {
    if (F.bid < bfirst || F.bid >= bfirst + nb) return;
    unsigned char* ws = p.ws();
    const int vb = F.bid - bfirst;
    int rot = rot0;
#define CVT(srcp, dstoff, K_, N_, Npad_) do { CvtJob jb; jb.src = (srcp); jb.dst = (bf16_t*)(ws + (dstoff)); jb.K = (K_); jb.N = (N_); jb.Npad = (Npad_); jb.tiles = ((K_) / 64) * ((Npad_) / 64); jb.upperm = ((N_) == 5632); \
        cvt_run<4>(F, jb, (vb + nb - (rot % nb)) % nb, nb); rot += jb.tiles; } while (0)
    if (group == 0) {
        CVT(p.in(19), WS_WAIN, 1024, 1952, 2048);
        CVT(p.in(22), WS_WUQ, 256, 768, 768);
        CVT(p.in(23), WS_WUKV, 128, 1024, 1024);
    } else if (group == 1) {
        CVT(p.in(14), WS_WOUT, 1024, 1024, 1024);
        CVT(p.in(15), WS_WUP, 1024, 5632, 5632);
    } else if (group == 3) {
        CVT(p.in(18), WS_WDN, 2816, 1024, 1024);
    } else {
        CVT(p.in(28), WS_WBIN, 1024, 3456, 3584);
        CVT(p.in(14) + (size_t)1024 * 1024, WS_WOUT + (size_t)1024 * 1024 * 2, 1024, 1024, 1024);
        CVT(p.in(15) + (size_t)1024 * 5632, WS_WUP + (size_t)5632 * 1024 * 2, 1024, 5632, 5632);
        CVT(p.in(18) + (size_t)2816 * 1024, WS_WDN + (size_t)1024 * 2816 * 2, 2816, 1024, 1024);
        CVT(p.in(35), WS_WWUP, 64, 512, 512);
        CVT(p.in(35) + 64 * 512, WS_WWUP + 512 * 64 * 2, 64, 512, 512);
        CVT(p.in(37), WS_WAUP, 64, 512, 512);
        CVT(p.in(37) + 64 * 512, WS_WAUP + 512 * 64 * 2, 64, 512, 512);
        CVT(p.in(38), WS_WGUP, 128, 512, 512);
    }
#undef CVT
}
__device__ __forceinline__ void phase_prep(const Frame& F, const PRef& p) {
    unsigned char* ws = p.ws();
    {
        LAS float* sc = (LAS float*)F.lds;
        LAS float* red = sc + 3 * 1024;
        for (int i = F.tid; i < 3 * 1024; i += NTHREADS) {
            const int c = i >> 10, k = i & 1023;
            const float v = c == 0 ? p.in(9)[k] : p.in(8)[(c - 1) * 1024 + k];
            sc[i] = siluf_(v);
        }
        __syncthreads();
        float* mod = (float*)(ws + WS_MOD);
        FOR_UNITS(u, 192, 0) {
            const int l = u / 96, n0 = (u % 96) * 64, col = F.tid & 63, kg = F.tid >> 6;
            const float* w = p.in(10) + (size_t)l * 1024 * 6144 + (size_t)(kg * 128) * 6144 + n0 + col;
            float a0 = 0.f, a1 = 0.f, a2 = 0.f;
#pragma unroll 8
            for (int k = 0; k < 128; ++k) { const float wv = w[(size_t)k * 6144]; const int kk = kg * 128 + k; a0 += sc[kk] * wv; a1 += sc[1024 + kk] * wv; a2 += sc[2048 + kk] * wv; }
            red[(kg * 3 + 0) * 64 + col] = a0; red[(kg * 3 + 1) * 64 + col] = a1; red[(kg * 3 + 2) * 64 + col] = a2;
            __syncthreads();
            if (F.tid < 192) {
                const int c = F.tid >> 6, cc = F.tid & 63; float s = 0.f;
#pragma unroll
                for (int q = 0; q < 8; ++q) s += red[(q * 3 + c) * 64 + cc];
                mod[(size_t)(l * 3 + c) * 6144 + n0 + cc] = s + p.in(11)[l * 6144 + n0 + cc];
            }
            __syncthreads();
        }
    }
    cvt_group(F, p, 0, 0, F.G, 192);
}

__device__ __forceinline__ void phase_norm(const Frame& F, const float* xa, const float* xb, const bf16_t* part, const float* gate, float* xout,
                                           const float* g, const float* sc, const float* sh, bf16_t* hb, bool do_norm, const int q4row = NTOK) {
    const int nw = F.G * 8;
    for (int row = F.bid * 8 + F.wave; row < NTOK; row += nw) {
        const float* x = row < NCTX ? xa + (size_t)row * 1024 : xb + (size_t)(row - NCTX) * 1024;
        const int c = cond_of(row);
        f32x4 v[4]; float ss = 0.f;
#pragma unroll
        for (int i = 0; i < 4; ++i) {
            const int col = i * 256 + F.lane * 4;
            v[i] = *(const f32x4*)(x + col);
            if (part) {
                const u32x2 q0 = *(const u32x2*)(part + (size_t)row * 1024 + col), q1 = *(const u32x2*)(part + (size_t)NTOK * 1024 + (size_t)row * 1024 + col);
                f32x4 ps = (f32x4){bf2f(q0.x & 0xffffu) + bf2f(q1.x & 0xffffu), bf2f(q0.x >> 16) + bf2f(q1.x >> 16), bf2f(q0.y & 0xffffu) + bf2f(q1.y & 0xffffu), bf2f(q0.y >> 16) + bf2f(q1.y >> 16)};
                if (row >= q4row) {
                    const u32x2 q2 = *(const u32x2*)(part + (size_t)2 * NTOK * 1024 + (size_t)row * 1024 + col), q3 = *(const u32x2*)(part + (size_t)3 * NTOK * 1024 + (size_t)row * 1024 + col);
                    ps = ps + (f32x4){bf2f(q2.x & 0xffffu) + bf2f(q3.x & 0xffffu), bf2f(q2.x >> 16) + bf2f(q3.x >> 16), bf2f(q2.y & 0xffffu) + bf2f(q3.y & 0xffffu), bf2f(q2.y >> 16) + bf2f(q3.y >> 16)};
                }
                const f32x4 gt = *(const f32x4*)(gate + c * 6144 + col);
                v[i] = v[i] + gt * ps;
                *(f32x4*)(xout + (size_t)row * 1024 + col) = v[i];
            }
            ss += v[i][0] * v[i][0] + v[i][1] * v[i][1] + v[i][2] * v[i][2] + v[i][3] * v[i][3];
        }
        if (!do_norm) continue;
        ss = wave_sum(ss);
        const float rstd = rsqrtf(ss * (1.0f / 1024.0f) + EPS);
#pragma unroll
        for (int i = 0; i < 4; ++i) {
            const int col = i * 256 + F.lane * 4;
            const f32x4 gg = *(const f32x4*)(g + col), s1 = *(const f32x4*)(sc + c * 6144 + col), s0 = *(const f32x4*)(sh + c * 6144 + col);
            f32x4 h;
#pragma unroll
            for (int j = 0; j < 4; ++j) h[j] = v[i][j] * rstd * gg[j] * (1.0f + s1[j]) + s0[j];
            u32x2 w; w.x = pack2(h[0], h[1]); w.y = pack2(h[2], h[3]);
            *(u32x2*)(hb + (size_t)row * 1024 + col) = w;
        }
    }
}

__device__ __forceinline__ void seq_of_unit384(int u, int& s, int& c, int& h, int& tok0, int& nc) {
    if (u < 256) { s = u >> 4; c = (u >> 2) & 3; h = u & 3; tok0 = s * 256 + c * 64; nc = 4; }
    else { const int v = u - 256; s = 16 + (v >> 6); c = (v >> 2) & 15; h = v & 3; tok0 = NCTX + (s - 16) * 1024 + c * 64; nc = 16; }
}
__device__ __forceinline__ void phase_l0_tok(const Frame& F, const PRef& p) {
    unsigned char* ws = p.ws();
    const float* P = (const float*)(ws + WS_P0);
    bf16_t* cqn = (bf16_t*)(ws + WS_CQN); bf16_t* ckvn = (bf16_t*)(ws + WS_CKVN);
    const int nw = F.G * 8;
    for (int row = F.bid * 8 + F.wave; row < NKROW; row += nw) {
        if (row < NTOK) {
            const float* pr = P + (size_t)row * 2048;
            const f32x4 q = *(const f32x4*)(pr + F.lane * 4);
            float ss = wave_sum(q[0] * q[0] + q[1] * q[1] + q[2] * q[2] + q[3] * q[3]);
            float rstd = rsqrtf(ss * (1.0f / 256.0f) + EPS);
            const f32x4 gq = *(const f32x4*)(p.in(20) + F.lane * 4);
            u32x2 w; w.x = pack2(q[0] * rstd * gq[0], q[1] * rstd * gq[1]); w.y = pack2(q[2] * rstd * gq[2], q[3] * rstd * gq[3]);
            *(u32x2*)(cqn + (size_t)row * 256 + F.lane * 4) = w;
            const f32x2 kv = *(const f32x2*)(pr + 256 + F.lane * 2);
            ss = wave_sum(kv[0] * kv[0] + kv[1] * kv[1]);
            rstd = rsqrtf(ss * (1.0f / 128.0f) + EPS);
            const f32x2 gk = *(const f32x2*)(p.in(21) + F.lane * 2);
            const float o0 = kv[0] * rstd * gk[0], o1 = kv[1] * rstd * gk[1];
            *(unsigned*)(ckvn + (size_t)row * 128 + F.lane * 2) = pack2(o0, o1);
            if (row < NCTX) {
                *(f32x2*)(p.out() + OUT_CKV + (size_t)row * 128 + F.lane * 2) = (f32x2){o0, o1};
                if (F.lane < 32) p.out()[OUT_KROPE + (size_t)row * 32 + F.lane] = pr[384 + F.lane];
            }
        } else {
            const int i = row - NTOK;
            const f32x2 kv = *(const f32x2*)(p.in(2) + (size_t)i * 128 + F.lane * 2);
            *(unsigned*)(ckvn + (size_t)row * 128 + F.lane * 2) = pack2(kv[0], kv[1]);
        }
    }
    {
        LAS unsigned char* L = F.lds;
        constexpr int KPI = 160, VPI = 288, O_KF = 0, O_KB = 64 * KPI, O_V = 2 * 64 * KPI;
        float* KVS = (float*)(ws + WS_KVS);
        const int tid = F.tid, w = F.wave, fr = F.lane & 15, fq = F.lane >> 4;
        FOR_UNITS(u, 384, 0) {
            int s, c, h, tok0, nc; seq_of_unit384(u, s, c, h, tok0, nc);
            const float lgf = __logf(sigmoidf_(p.in(26)[h])), lgb = __logf(sigmoidf_(p.in(26)[4 + h]));
            {
                const int row = tid >> 3, ch = tid & 7;
                const float* pr = P + (size_t)(tok0 + row) * 2048;
                const f32x4 k0 = *(const f32x4*)(pr + 672 + h * 64 + ch * 8), k1 = *(const f32x4*)(pr + 672 + h * 64 + ch * 8 + 4);
                f32x4 vv[4];
#pragma unroll
                for (int i = 0; i < 4; ++i) vv[i] = *(const f32x4*)(pr + 928 + h * 128 + ch * 16 + i * 4);
                const float df = 0.125f * __expf(lgf * (float)(63 - row)), db = 0.125f * __expf(lgb * (float)row);
                u32x4 t;
                t.x = pack2(k0[0] * df, k0[1] * df); t.y = pack2(k0[2] * df, k0[3] * df); t.z = pack2(k1[0] * df, k1[1] * df); t.w = pack2(k1[2] * df, k1[3] * df); *(LAS u32x4*)(L + O_KF + row * KPI + ch * 16) = t;
                t.x = pack2(k0[0] * db, k0[1] * db); t.y = pack2(k0[2] * db, k0[3] * db); t.z = pack2(k1[0] * db, k1[1] * db); t.w = pack2(k1[2] * db, k1[3] * db); *(LAS u32x4*)(L + O_KB + row * KPI + ch * 16) = t;
#pragma unroll
                for (int i = 0; i < 2; ++i) { t.x = pack2(vv[2 * i][0], vv[2 * i][1]); t.y = pack2(vv[2 * i][2], vv[2 * i][3]); t.z = pack2(vv[2 * i + 1][0], vv[2 * i + 1][1]); t.w = pack2(vv[2 * i + 1][2], vv[2 * i + 1][3]);
                    *(LAS u32x4*)(L + O_V + row * VPI + ch * 32 + i * 16) = t; }
            }
            __syncthreads();
            bf16x8 Bf[2];
#pragma unroll
            for (int ks = 0; ks < 2; ++ks) {
                const LAS unsigned char* vp = L + O_V + (32 * ks + 8 * fq + (fr >> 2)) * VPI + (w * 16 + 4 * (fr & 3)) * 2;
                const bf16x4 v0 = __builtin_amdgcn_ds_read_tr16_b64_v4i16((LAS bf16x4*)vp), v1 = __builtin_amdgcn_ds_read_tr16_b64_v4i16((LAS bf16x4*)(vp + 4 * VPI));
                bf16x8 x; x[0] = v0[0]; x[1] = v0[1]; x[2] = v0[2]; x[3] = v0[3]; x[4] = v1[0]; x[5] = v1[1]; x[6] = v1[2]; x[7] = v1[3]; Bf[ks] = x;
            }
            float* o = KVS + (size_t)u * 2 * 8192;
#pragma unroll
            for (int d = 0; d < 2; ++d)
#pragma unroll
                for (int et = 0; et < 4; ++et) {
                    f32x4 a = (f32x4){0.f, 0.f, 0.f, 0.f};
#pragma unroll
                    for (int ks = 0; ks < 2; ++ks) {
                        const LAS unsigned char* kp = L + (d ? O_KB : O_KF) + (32 * ks + 8 * fq + (fr >> 2)) * KPI + (et * 16 + 4 * (fr & 3)) * 2;
                        const bf16x4 v0 = __builtin_amdgcn_ds_read_tr16_b64_v4i16((LAS bf16x4*)kp), v1 = __builtin_amdgcn_ds_read_tr16_b64_v4i16((LAS bf16x4*)(kp + 4 * KPI));
                        bf16x8 x; x[0] = v0[0]; x[1] = v0[1]; x[2] = v0[2]; x[3] = v0[3]; x[4] = v1[0]; x[5] = v1[1]; x[6] = v1[2]; x[7] = v1[3];
                        a = __builtin_amdgcn_mfma_f32_16x16x32_bf16(x, Bf[ks], a, 0, 0, 0);
                    }
#pragma unroll
                    for (int r = 0; r < 4; ++r) o[d * 8192 + (et * 16 + 4 * fq + r) * 128 + w * 16 + fr] = a[r];
                }
            __syncthreads();
        }
    }
}

__device__ __forceinline__ void phase_l0_prefix(const Frame& F, const PRef& p, int rot) {
    float* KVS = (float*)(p.ws() + WS_KVS);
    FOR_UNITS(u, 576, rot) {
        const int qd = u & 3, d = (u >> 2) & 1, h = (u >> 3) & 3, s = u >> 5;
        const int nc = s < 16 ? 4 : 16;
        const int ubase = s < 16 ? s * 16 + h : 256 + (s - 16) * 64 + h;
        const float g64 = __expf(64.0f * __logf(sigmoidf_(p.in(26)[d * 4 + h])));
        const int i = qd * 2048 + F.tid * 4;
        float* base = KVS + (size_t)ubase * 16384 + d * 8192 + i;
        f32x4 kv[16];
#pragma unroll
        for (int c = 0; c < 16; ++c) if (c < nc) kv[c] = *(const f32x4*)(base + (size_t)c * 4 * 16384);
        f32x4 S = (f32x4){0.f, 0.f, 0.f, 0.f};
        if (s >= 16) S = *(const f32x4*)(p.in(4) + (size_t)(((s - 16) * 2 + d) * 4 + h) * 8192 + i);
        if (d == 0) {
#pragma unroll
            for (int c = 0; c < 16; ++c) if (c < nc) { *(f32x4*)(base + (size_t)c * 4 * 16384) = S; S = S * g64 + kv[c]; }
        } else {
#pragma unroll
            for (int c = 15; c >= 0; --c) if (c < nc) { *(f32x4*)(base + (size_t)c * 4 * 16384) = S; S = S * g64 + kv[c]; }
        }
        if (s < 16) *(f32x4*)(p.out() + OUT_SRET + (size_t)((s * 2 + d) * 4 + h) * 8192 + i) = S;
    }
}

__device__ __forceinline__ size_t vt_base(int kr, int nheads, int dv, int& nkeys, int& key) {
    if (kr < NCTX) { nkeys = 256; key = kr & 255; return (size_t)(kr >> 8) * nheads * dv * 256; }
    const int v = kr - NCTX; const int b = v / 1536; nkeys = 1536; key = v - b * 1536;
    return (size_t)16 * nheads * dv * 256 + (size_t)b * nheads * dv * 1536;
}
__device__ __forceinline__ void phase_l0_qkv(const Frame& F, const PRef& p) {
    unsigned char* ws = p.ws();
    const float* P = (const float*)(ws + WS_P0); const float* QR = (const float*)(ws + WS_QRAW); const float* KVR = (const float*)(ws + WS_KVRAW);
    bf16_t* Q = (bf16_t*)(ws + WS_Q0); bf16_t* K = (bf16_t*)(ws + WS_K0); bf16_t* VT = (bf16_t*)(ws + WS_VT0);
    const int nw = F.G * 8, lane = F.lane;
    const float qscale = 0.10206207261596577f;
    for (int row = F.bid * 8 + F.wave; row < NKROW; row += nw) {
        const bool istok = row < NTOK, lat = istok && row >= NCTX;
        float cs = 1.f, sn = 0.f;
        if (lat && lane >= 32 && lane < 48) {
            const int t = (row - NCTX) & 1023, a = lane - 32;
            const float pos = a < 8 ? (float)(t >> 6) : (float)(t & 63);
            const float inv = __powf(10000.0f, -(float)(a & 7) * 0.125f);
            const float ang = pos * inv; cs = __cosf(ang); sn = __sinf(ang);
        }
        int kr;
        if (row < NCTX) kr = row; else if (row < NTOK) { const int v = row - NCTX; kr = NCTX + (v >> 10) * 1536 + (v & 1023); }
        else { const int i = row - NTOK; kr = NCTX + (i >> 9) * 1536 + 1024 + (i & 511); }
        const float* krope = istok ? P + (size_t)row * 2048 + 384 : p.in(3) + (size_t)(row - NTOK) * 32;
        f32x2 qv[8], kv2[8]; float vv[8];
        f32x2 kro = (f32x2){0.f, 0.f};
        if (lane >= 32 && lane < 48) kro = *(const f32x2*)(krope + 2 * (lane - 32));
#pragma unroll
        for (int h = 0; h < 8; ++h) {
            qv[h] = (f32x2){0.f, 0.f};
            if (istok && lane < 48) qv[h] = *(const f32x2*)(QR + (size_t)row * 768 + h * 96 + 2 * lane);
            kv2[h] = kro;
            if (lane < 32) kv2[h] = *(const f32x2*)(KVR + (size_t)row * 1024 + h * 128 + 2 * lane);
            vv[h] = KVR[(size_t)row * 1024 + h * 128 + 64 + lane];
        }
        f32x2 gq = (f32x2){0.f, 0.f}, gk = (f32x2){0.f, 0.f};
        if (lane < 48) { gq = *(const f32x2*)(p.in(24) + 2 * lane); gk = *(const f32x2*)(p.in(25) + 2 * lane); }
#pragma unroll
        for (int h = 0; h < 8; ++h) {
            if (istok) {
                float x1 = qv[h][0], x2 = qv[h][1];
                const float rstd = rsqrtf(wave_sum(x1 * x1 + x2 * x2) * (1.0f / 96.0f) + EPS);
                if (lane < 48) {
                    x1 = x1 * rstd * gq[0]; x2 = x2 * rstd * gq[1];
                    const float y1 = x1 * cs - x2 * sn, y2 = x1 * sn + x2 * cs;
                    *(unsigned*)(Q + (size_t)row * 768 + h * 96 + 2 * lane) = pack2(y1 * qscale, y2 * qscale);
                }
            }
            {
                float x1 = kv2[h][0], x2 = kv2[h][1];
                const float rstd = rsqrtf(wave_sum(x1 * x1 + x2 * x2) * (1.0f / 96.0f) + EPS);
                if (lane < 48) {
                    x1 = x1 * rstd * gk[0]; x2 = x2 * rstd * gk[1];
                    const float y1 = x1 * cs - x2 * sn, y2 = x1 * sn + x2 * cs;
                    *(unsigned*)(K + (size_t)kr * 768 + h * 96 + 2 * lane) = pack2(y1, y2);
                }
            }
            VT[(size_t)kr * 512 + h * 64 + lane] = f2bf(vv[h]);
        }
    }
}

template <int DQK, int DV, int NC, int NQT>
struct AttnState { f32x4 O[NC][DV / 16][NQT]; float l[NC][NQT]; };

template <int DQK, int DV, int NC, int NQT>
__device__ __forceinline__ void attn_wave(const bf16_t* __restrict__ Q, const bf16_t* __restrict__ K, const bf16_t* __restrict__ Vt,
                                          int qtok0, int krow0, int nkeys, int hh0  , int lane, AttnState<DQK, DV, NC, NQT>& st) {
    constexpr int NS = DQK / 32, NE = DV / 16, RS = 8 * DQK;
    const int fr = lane & 15, fq = lane >> 4;
    bf16x8 Qf[NC][NQT][NS];
#pragma unroll
    for (int c = 0; c < NC; ++c)
#pragma unroll
        for (int qt = 0; qt < NQT; ++qt)
#pragma unroll
            for (int s = 0; s < NS; ++s) Qf[c][qt][s] = *(const bf16x8*)(Q + (size_t)(qtok0 + qt * 16 + fr) * RS + (hh0 + c) * DQK + s * 32 + fq * 8);
    float m[NC][NQT];
#pragma unroll
    for (int c = 0; c < NC; ++c)
#pragma unroll
        for (int qt = 0; qt < NQT; ++qt) { m[c][qt] = -1e30f; st.l[c][qt] = 0.f;
#pragma unroll
            for (int e = 0; e < NE; ++e) st.O[c][e][qt] = (f32x4){0.f, 0.f, 0.f, 0.f}; }
    for (int key0 = 0; key0 < nkeys; key0 += 32) {
        bf16x8 Pf[NC][NQT];
#pragma unroll
        for (int c = 0; c < NC; ++c) {
            f32x4 S[2][NQT];
#pragma unroll
            for (int kt = 0; kt < 2; ++kt) {
                bf16x8 Kf[NS];
#pragma unroll
                for (int s = 0; s < NS; ++s) Kf[s] = *(const bf16x8*)(K + (size_t)(krow0 + key0 + kt * 16 + fr) * RS + (hh0 + c) * DQK + s * 32 + fq * 8);
#pragma unroll
                for (int qt = 0; qt < NQT; ++qt) {
                    f32x4 a = (f32x4){0.f, 0.f, 0.f, 0.f};
#pragma unroll
                    for (int s = 0; s < NS; ++s) a = __builtin_amdgcn_mfma_f32_16x16x32_bf16(Kf[s], Qf[c][qt][s], a, 0, 0, 0);
                    S[kt][qt] = a;
                }
            }
#pragma unroll
            for (int qt = 0; qt < NQT; ++qt) {
                float mx = fmaxf(fmaxf(fmaxf(S[0][qt][0], S[0][qt][1]), fmaxf(S[0][qt][2], S[0][qt][3])), fmaxf(fmaxf(S[1][qt][0], S[1][qt][1]), fmaxf(S[1][qt][2], S[1][qt][3])));
                mx = fmaxf(mx, __shfl_xor(mx, 16)); mx = fmaxf(mx, __shfl_xor(mx, 32));
                const float mn = fmaxf(m[c][qt], mx), alpha = __expf(m[c][qt] - mn);
                m[c][qt] = mn;
                float pv[8]; float ps = 0.f;
#pragma unroll
                for (int j = 0; j < 4; ++j) { pv[j] = __expf(S[0][qt][j] - mn); pv[4 + j] = __expf(S[1][qt][j] - mn); ps += pv[j] + pv[4 + j]; }
                st.l[c][qt] = st.l[c][qt] * alpha + ps;
#pragma unroll
                for (int e = 0; e < NE; ++e) st.O[c][e][qt] *= alpha;
                u32x4 pk; pk.x = pack2(pv[0], pv[1]); pk.y = pack2(pv[2], pv[3]); pk.z = pack2(pv[4], pv[5]); pk.w = pack2(pv[6], pv[7]);
                Pf[c][qt] = __builtin_bit_cast(bf16x8, pk);
            }
        }
#pragma unroll
        for (int e = 0; e < NE; ++e) {
            const bf16_t* vp = Vt + (size_t)(e * 16 + fr) * nkeys + key0 + 4 * fq;
            const bf16x4 v0 = *(const bf16x4*)vp, v1 = *(const bf16x4*)(vp + 16);
            bf16x8 Vf; Vf[0] = v0[0]; Vf[1] = v0[1]; Vf[2] = v0[2]; Vf[3] = v0[3]; Vf[4] = v1[0]; Vf[5] = v1[1]; Vf[6] = v1[2]; Vf[7] = v1[3];
#pragma unroll
            for (int c = 0; c < NC; ++c)
#pragma unroll
                for (int qt = 0; qt < NQT; ++qt) st.O[c][e][qt] = __builtin_amdgcn_mfma_f32_16x16x32_bf16(Vf, Pf[c][qt], st.O[c][e][qt], 0, 0, 0);
        }
    }
#pragma unroll
    for (int c = 0; c < NC; ++c)
#pragma unroll
        for (int qt = 0; qt < NQT; ++qt) { float l = st.l[c][qt]; l += __shfl_xor(l, 16); l += __shfl_xor(l, 32); st.l[c][qt] = 1.0f / l; }
}

__device__ __forceinline__ int attn_unit_xcd(int bid, int which) {
    const int x = bid & 7, idx = bid >> 3;
    return which == 0 ? (2 * x + (idx >> 4)) * 16 + (idx & 15) : 256 + (x * 16 + (idx >> 1)) * 2 + (idx & 1);
}
template <int DQK, int DV, int VH, class OutFn>
__device__ __forceinline__ void attn_block(const Frame& F, const bf16_t* __restrict__ Q, const bf16_t* __restrict__ K, const bf16_t* __restrict__ VT, const OutFn& out, int unit, float shift) {
    constexpr int NS = DQK / 32, NE = DV / 16, RS = 8 * DQK, KPC = DQK / 8;
    constexpr int KB = 128 * 256, VP = DV * 2 + 32, VB = 128 * VP, STG = KB + VB, VPC = DV / 8;
    constexpr int NKP = 128 * KPC / NTHREADS, NVP = 128 * VPC / NTHREADS;
    LAS unsigned char* lds = F.lds;
    const int lane = F.lane, fr = lane & 15, fq = lane >> 4, wave = F.wave, tid = F.tid;
    const bool lat = unit < 256;
    int ab, h, q0, nkeys, NQG;
    if (lat) { ab = 16 + (unit >> 7); h = (unit >> 4) & 7; q0 = (unit & 15) * 64; nkeys = 1536; NQG = 2; }
    else { const int v = unit - 256; ab = v >> 4; h = (v >> 1) & 7; q0 = (v & 1) * 128; nkeys = 256; NQG = 4; }
    const int NKS = 8 / NQG, qg = wave % NQG, ks = wave / NQG, kslice = 128 / NKS, nit = kslice / 32;
    const int qtok0 = (lat ? NCTX + (ab - 16) * 1024 : ab * 256) + q0 + qg * 32;
    const int krow0 = lat ? NCTX + (ab - 16) * 1536 : ab * 256;
    const bf16_t* vg = VT + (size_t)krow0 * (VH * DV) + (h * VH / 8) * DV;
    const bf16_t* kg = K + (size_t)krow0 * RS + h * DQK;
    bf16x8 Qf[2][NS];
#pragma unroll
    for (int qt = 0; qt < 2; ++qt)
#pragma unroll
        for (int s = 0; s < NS; ++s) Qf[qt][s] = *(const bf16x8*)(Q + (size_t)(qtok0 + qt * 16 + fr) * RS + h * DQK + s * 32 + fq * 8);
    f32x4 O[NE][2]; float l[2];
    const float sh2 = shift * 1.44269504f;
#pragma unroll
    for (int qt = 0; qt < 2; ++qt) { l[qt] = 0.f;
#pragma unroll
        for (int e = 0; e < NE; ++e) O[e][qt] = (f32x4){0.f, 0.f, 0.f, 0.f}; }
    u32x4 kregA[NKP], vregA[NVP], kregB[DV == 64 ? NKP : 1], vregB[DV == 64 ? NVP : 1];
#define AT_LOAD(kreg, vreg, st) do { \
        _Pragma("unroll") for (int i = 0; i < NKP; ++i) { const int pid = tid + i * NTHREADS, row = pid / KPC, ch = pid % KPC; kreg[i] = *(const u32x4*)(kg + (size_t)((st) * 128 + row) * RS + ch * 8); } \
        _Pragma("unroll") for (int i = 0; i < NVP; ++i) { const int pid = tid + i * NTHREADS, row = pid / VPC, ch = pid % VPC; vreg[i] = *(const u32x4*)(vg + (size_t)((st) * 128 + row) * (VH * DV) + ch * 8); } } while (0)
#define AT_WRITE(kreg, vreg, buf) do { \
        _Pragma("unroll") for (int i = 0; i < NKP; ++i) { const int pid = tid + i * NTHREADS, row = pid / KPC, ch = pid % KPC; *(LAS u32x4*)(lds + (buf) * STG + row * 256 + ((ch ^ (row & 15)) << 4)) = kreg[i]; } \
        _Pragma("unroll") for (int i = 0; i < NVP; ++i) { const int pid = tid + i * NTHREADS, row = pid / VPC, ch = pid % VPC; *(LAS u32x4*)(lds + (buf) * STG + KB + row * VP + ch * 16) = vreg[i]; } } while (0)
#define AT_COMPUTE(bufsel) do { \
        const LAS unsigned char* kb = lds + (bufsel) * STG; const LAS unsigned char* vb = kb + KB; \
        for (int it = 0; it < nit; ++it) { \
            const int key0 = ks * kslice + it * 32; \
            f32x4 S[2][2]; \
            _Pragma("unroll") for (int kt = 0; kt < 2; ++kt) { \
                const int row = key0 + kt * 16 + fr; \
                bf16x8 Kf[NS]; \
                _Pragma("unroll") for (int s_ = 0; s_ < NS; ++s_) Kf[s_] = *(const LAS bf16x8*)(kb + row * 256 + (((4 * s_ + fq) ^ (row & 15)) << 4)); \
                _Pragma("unroll") for (int qt = 0; qt < 2; ++qt) { \
                    f32x4 a = (f32x4){0.f, 0.f, 0.f, 0.f}; \
                    _Pragma("unroll") for (int s_ = 0; s_ < NS; ++s_) a = __builtin_amdgcn_mfma_f32_16x16x32_bf16(Kf[s_], Qf[qt][s_], a, 0, 0, 0); \
                    S[kt][qt] = a; } } \
            bf16x8 Pf[2]; \
            _Pragma("unroll") for (int qt = 0; qt < 2; ++qt) { \
                float pv[8]; float ps = 0.f; \
                _Pragma("unroll") for (int j = 0; j < 4; ++j) { pv[j] = __builtin_amdgcn_exp2f(S[0][qt][j] * 1.44269504f - sh2); pv[4 + j] = __builtin_amdgcn_exp2f(S[1][qt][j] * 1.44269504f - sh2); ps += pv[j] + pv[4 + j]; } \
                l[qt] += ps; \
                u32x4 pk; pk.x = pack2(pv[0], pv[1]); pk.y = pack2(pv[2], pv[3]); pk.z = pack2(pv[4], pv[5]); pk.w = pack2(pv[6], pv[7]); \
                Pf[qt] = __builtin_bit_cast(bf16x8, pk); } \
            _Pragma("unroll") for (int e = 0; e < NE; ++e) { \
                const LAS unsigned char* vp = vb + (key0 + 4 * fq + (fr >> 2)) * VP + (e * 16 + 4 * (fr & 3)) * 2; \
                const bf16x4 v0 = __builtin_amdgcn_ds_read_tr16_b64_v4i16((LAS bf16x4*)vp), v1 = __builtin_amdgcn_ds_read_tr16_b64_v4i16((LAS bf16x4*)(vp + 16 * VP)); \
                bf16x8 Vf; Vf[0] = v0[0]; Vf[1] = v0[1]; Vf[2] = v0[2]; Vf[3] = v0[3]; Vf[4] = v1[0]; Vf[5] = v1[1]; Vf[6] = v1[2]; Vf[7] = v1[3]; \
                _Pragma("unroll") for (int qt = 0; qt < 2; ++qt) O[e][qt] = __builtin_amdgcn_mfma_f32_16x16x32_bf16(Vf, Pf[qt], O[e][qt], 0, 0, 0); } } } while (0)
    const int nst = nkeys / 128;
    constexpr bool TWOSET = DV == 64;
    AT_LOAD(kregA, vregA, 0); if (TWOSET) AT_LOAD(kregB, vregB, 1); AT_WRITE(kregA, vregA, 0);
#pragma unroll
    for (int qt = 0; qt < 2; ++qt)
#pragma unroll
        for (int s_ = 0; s_ < NS; ++s_) asm volatile("" :: "v"(Qf[qt][s_]));
    __syncthreads();
    for (int st = 0; st < nst; st += 2) {
        if (TWOSET) {
            if (st + 2 < nst) AT_LOAD(kregA, vregA, st + 2);
            AT_COMPUTE(0);
            AT_WRITE(kregB, vregB, 1);
            __syncthreads();
            if (st + 3 < nst) AT_LOAD(kregB, vregB, st + 3);
            AT_COMPUTE(1);
            if (st + 2 < nst) AT_WRITE(kregA, vregA, 0);
            __syncthreads();
        } else {
            AT_LOAD(kregA, vregA, st + 1);
            AT_COMPUTE(0);
            AT_WRITE(kregA, vregA, 1);
            __syncthreads();
            if (st + 2 < nst) AT_LOAD(kregA, vregA, st + 2);
            AT_COMPUTE(1);
            if (st + 2 < nst) AT_WRITE(kregA, vregA, 0);
            __syncthreads();
        }
    }
#undef AT_COMPUTE
#undef AT_LOAD
#undef AT_WRITE
    LAS f32x4* Ost = (LAS f32x4*)lds; LAS float* LL = (LAS float*)(lds + 8 * 2 * NE * 1024);
#pragma unroll
    for (int qt = 0; qt < 2; ++qt) {
        float lt = l[qt]; lt += __shfl_xor(lt, 16); lt += __shfl_xor(lt, 32);
        if (fq == 0) LL[(wave * 2 + qt) * 16 + fr] = lt;
#pragma unroll
        for (int e = 0; e < NE; ++e) Ost[((wave * 2 + qt) * NE + e) * 64 + lane] = O[e][qt];
    }
    __syncthreads();
    const int epw = NE / NKS;
#pragma unroll
    for (int qt = 0; qt < 2; ++qt) {
        float L = 0.f;
        for (int j = 0; j < NKS; ++j) L += LL[((j * NQG + qg) * 2 + qt) * 16 + fr];
        const float invL = 1.0f / L;
        for (int ee = 0; ee < epw; ++ee) {
            const int e = ks * epw + ee;
            f32x4 o = (f32x4){0.f, 0.f, 0.f, 0.f};
            for (int j = 0; j < NKS; ++j) o += Ost[(((j * NQG + qg) * 2 + qt) * NE + e) * 64 + lane];
            out(qtok0 + qt * 16 + fr, h * DV + e * 16 + 4 * fq, o * invL);
        }
    }
    __syncthreads();
}
struct AttnOutBf16 { bf16_t* C; int ldc;
    __device__ __forceinline__ void operator()(int tok, int col, f32x4 o) const { u32x2 w; w.x = pack2(o[0], o[1]); w.y = pack2(o[2], o[3]); *(u32x2*)(C + (size_t)tok * ldc + col) = w; } };

__device__ __forceinline__ void attn_unit(int u, int wave, int& ab, int& h, int& q0) {
    if (u < 64) { ab = 16 + (u >> 5); h = (u >> 2) & 7; q0 = (u & 3) * 256 + wave * 32; }
    else { const int v = u - 64; ab = v >> 3; h = v & 7; q0 = wave * 32; }
}

__device__ __forceinline__ void phase_l0_mix(const Frame& F, const PRef& p) {
    unsigned char* ws = p.ws();
    const float* P = (const float*)(ws + WS_P0);
    bf16_t* OB = (bf16_t*)(ws + WS_OB);
    const bf16_t* Q = (const bf16_t*)(ws + WS_Q0); const bf16_t* K = (const bf16_t*)(ws + WS_K0); const bf16_t* VT = (const bf16_t*)(ws + WS_VT0);
    const int lane = F.lane, fr = lane & 15, fq = lane >> 4;
    {
        float gq = 0.f, gk = 0.f;
        for (int i = 0; i < 96; ++i) { gq = fmaxf(gq, fabsf(p.in(24)[i])); gk = fmaxf(gk, fabsf(p.in(25)[i])); }
        const float shift = 9.79795897f * gq * gk;
        AttnOutBf16 ao{OB, 1024};
#ifndef ATT_REP
#define ATT_REP 0
#endif
        for (int rp_ = 0; rp_ < 1 + (ATT_REP == 1); ++rp_) {
            for (int slot = 0; slot * F.G < 512; ++slot) { const int u = F.G == 256 ? attn_unit_xcd(F.bid, slot) : F.bid + slot * F.G; if (u < 512) for (int r2_ = 0; r2_ < 1 + ((ATT_REP == 3 && slot == 0) || (ATT_REP == 4 && slot == 1) ? 3 : 0); ++r2_) attn_block<96, 64, 8>(F, Q, K, VT, ao, u, shift); }
        } }
    {
        LAS unsigned char* L = F.lds;
        constexpr int T64 = 64 * 128, VPI = 288, T128 = 64 * VPI;
        constexpr int O_Q = 0, O_K = T64, O_QF = 2 * T64, O_QB = 3 * T64, O_W = 4 * T64, O_V = 5 * T64, O_SF = O_V + T128, O_SB = O_SF + T128, O_RED = O_SB + T128;
        const float* KVS = (const float*)(ws + WS_KVS);
        const int tid = F.tid, w = F.wave;
        for (int rp_ = 0; rp_ < 1 + (ATT_REP == 2); ++rp_)
        FOR_UNITS(u, 384, 128) {
            int s, c, h, tok0, nc; seq_of_unit384(u, s, c, h, tok0, nc);
            const float lgf = __logf(sigmoidf_(p.in(26)[h])), lgb = __logf(sigmoidf_(p.in(26)[4 + h]));
            {
                const int row = tid >> 3, ch = tid & 7;
                const float* pr = P + (size_t)(tok0 + row) * 2048;
                const f32x4 q0 = *(const f32x4*)(pr + 416 + h * 64 + ch * 8), q1 = *(const f32x4*)(pr + 416 + h * 64 + ch * 8 + 4);
                const f32x4 k0 = *(const f32x4*)(pr + 672 + h * 64 + ch * 8), k1 = *(const f32x4*)(pr + 672 + h * 64 + ch * 8 + 4);
                f32x4 vv[4], sf[4], sb[4];
#pragma unroll
                for (int i = 0; i < 4; ++i) { vv[i] = *(const f32x4*)(pr + 928 + h * 128 + ch * 16 + i * 4);
                    sf[i] = *(const f32x4*)(KVS + (size_t)u * 16384 + row * 128 + ch * 16 + i * 4); sb[i] = *(const f32x4*)(KVS + (size_t)u * 16384 + 8192 + row * 128 + ch * 16 + i * 4); }
                const float df = __expf(lgf * (float)(row + 1)), db = __expf(lgb * (float)(64 - row));
                const int so = row * 128 + ((ch ^ (row & 7)) << 4);
                u32x4 t;
                t.x = pack2(q0[0], q0[1]); t.y = pack2(q0[2], q0[3]); t.z = pack2(q1[0], q1[1]); t.w = pack2(q1[2], q1[3]); *(LAS u32x4*)(L + O_Q + so) = t;
                t.x = pack2(q0[0] * df, q0[1] * df); t.y = pack2(q0[2] * df, q0[3] * df); t.z = pack2(q1[0] * df, q1[1] * df); t.w = pack2(q1[2] * df, q1[3] * df); *(LAS u32x4*)(L + O_QF + so) = t;
                t.x = pack2(q0[0] * db, q0[1] * db); t.y = pack2(q0[2] * db, q0[3] * db); t.z = pack2(q1[0] * db, q1[1] * db); t.w = pack2(q1[2] * db, q1[3] * db); *(LAS u32x4*)(L + O_QB + so) = t;
                t.x = pack2(k0[0] * 0.125f, k0[1] * 0.125f); t.y = pack2(k0[2] * 0.125f, k0[3] * 0.125f); t.z = pack2(k1[0] * 0.125f, k1[1] * 0.125f); t.w = pack2(k1[2] * 0.125f, k1[3] * 0.125f); *(LAS u32x4*)(L + O_K + so) = t;
                const int vo = row * VPI + ch * 32;
#pragma unroll
                for (int i = 0; i < 2; ++i) {
                    t.x = pack2(vv[2 * i][0], vv[2 * i][1]); t.y = pack2(vv[2 * i][2], vv[2 * i][3]); t.z = pack2(vv[2 * i + 1][0], vv[2 * i + 1][1]); t.w = pack2(vv[2 * i + 1][2], vv[2 * i + 1][3]); *(LAS u32x4*)(L + O_V + vo + i * 16) = t;
                    t.x = pack2(sf[2 * i][0], sf[2 * i][1]); t.y = pack2(sf[2 * i][2], sf[2 * i][3]); t.z = pack2(sf[2 * i + 1][0], sf[2 * i + 1][1]); t.w = pack2(sf[2 * i + 1][2], sf[2 * i + 1][3]); *(LAS u32x4*)(L + O_SF + vo + i * 16) = t;
                    t.x = pack2(sb[2 * i][0], sb[2 * i][1]); t.y = pack2(sb[2 * i][2], sb[2 * i][3]); t.z = pack2(sb[2 * i + 1][0], sb[2 * i + 1][1]); t.w = pack2(sb[2 * i + 1][2], sb[2 * i + 1][3]); *(LAS u32x4*)(L + O_SB + vo + i * 16) = t;
                }
            }
            __syncthreads();
            {
                const int jt = w >> 1;
                bf16x8 Kf[2];
#pragma unroll
                for (int ks = 0; ks < 2; ++ks) { const int row = jt * 16 + fr; Kf[ks] = *(const LAS bf16x8*)(L + O_K + row * 128 + (((4 * ks + fq) ^ (row & 7)) << 4)); }
#pragma unroll
                for (int t2 = 0; t2 < 2; ++t2) {
                    const int it = (w & 1) * 2 + t2, irow = it * 16 + fr;
                    f32x4 d = (f32x4){0.f, 0.f, 0.f, 0.f};
#pragma unroll
                    for (int ks = 0; ks < 2; ++ks) { const bf16x8 Qf_ = *(const LAS bf16x8*)(L + O_Q + irow * 128 + (((4 * ks + fq) ^ (irow & 7)) << 4)); d = __builtin_amdgcn_mfma_f32_16x16x32_bf16(Kf[ks], Qf_, d, 0, 0, 0); }
                    float wv[4];
#pragma unroll
                    for (int r = 0; r < 4; ++r) { const int j = jt * 16 + 4 * fq + r; float dec = 0.f; if (j <= irow) dec += __expf(lgf * (float)(irow - j)); if (j >= irow) dec += __expf(lgb * (float)(j - irow)); wv[r] = d[r] * dec; }
                    u32x2 t; t.x = pack2(wv[0], wv[1]); t.y = pack2(wv[2], wv[3]);
                    *(LAS u32x2*)(L + O_W + irow * 128 + (((2 * jt + (fq >> 1)) ^ (irow & 7)) << 4) + (fq & 1) * 8) = t;
                }
            }
            __syncthreads();
            f32x4 acc[4];
#pragma unroll
            for (int it = 0; it < 4; ++it) acc[it] = (f32x4){0.f, 0.f, 0.f, 0.f};
            {
                bf16x8 Af[3][2];
#pragma unroll
                for (int a = 0; a < 3; ++a)
#pragma unroll
                    for (int ks = 0; ks < 2; ++ks) {
                        const LAS unsigned char* vp = L + (a == 0 ? O_V : (a == 1 ? O_SF : O_SB)) + (32 * ks + 8 * fq + (fr >> 2)) * VPI + (w * 16 + 4 * (fr & 3)) * 2;
                        const bf16x4 v0 = __builtin_amdgcn_ds_read_tr16_b64_v4i16((LAS bf16x4*)vp), v1 = __builtin_amdgcn_ds_read_tr16_b64_v4i16((LAS bf16x4*)(vp + 4 * VPI));
                        bf16x8 x; x[0] = v0[0]; x[1] = v0[1]; x[2] = v0[2]; x[3] = v0[3]; x[4] = v1[0]; x[5] = v1[1]; x[6] = v1[2]; x[7] = v1[3];
                        Af[a][ks] = x;
                    }
#pragma unroll
                for (int it = 0; it < 4; ++it) {
                    const int irow = it * 16 + fr;
#pragma unroll
                    for (int ks = 0; ks < 2; ++ks) {
                        const int so = irow * 128 + (((4 * ks + fq) ^ (irow & 7)) << 4);
                        const bf16x8 bw = *(const LAS bf16x8*)(L + O_W + so), bqf = *(const LAS bf16x8*)(L + O_QF + so), bqb = *(const LAS bf16x8*)(L + O_QB + so);
                        acc[it] = __builtin_amdgcn_mfma_f32_16x16x32_bf16(Af[0][ks], bw, acc[it], 0, 0, 0);
                        acc[it] = __builtin_amdgcn_mfma_f32_16x16x32_bf16(Af[1][ks], bqf, acc[it], 0, 0, 0);
                        acc[it] = __builtin_amdgcn_mfma_f32_16x16x32_bf16(Af[2][ks], bqb, acc[it], 0, 0, 0);
                    }
                }
            }
            LAS float* red = (LAS float*)(L + O_RED);
#pragma unroll
            for (int it = 0; it < 4; ++it) {
                float ss = acc[it][0] * acc[it][0] + acc[it][1] * acc[it][1] + acc[it][2] * acc[it][2] + acc[it][3] * acc[it][3];
                ss += __shfl_xor(ss, 16); ss += __shfl_xor(ss, 32);
                if (fq == 0) red[w * 64 + it * 16 + fr] = ss;
            }
            __syncthreads();
            {
                const f32x4 gn = *(const f32x4*)(p.in(27) + h * 128 + w * 16 + 4 * fq);
#pragma unroll
                for (int it = 0; it < 4; ++it) {
                    const int i = it * 16 + fr, tok = tok0 + i;
                    float ss = 0.f;
#pragma unroll
                    for (int q = 0; q < 8; ++q) ss += red[q * 64 + i];
                    const float rstd = rsqrtf(ss * (1.0f / 128.0f) + EPS);
                    const f32x4 rg = *(const f32x4*)(P + (size_t)tok * 2048 + 1440 + h * 128 + w * 16 + 4 * fq);
                    u32x2 t; t.x = pack2(siluf_(rg[0]) * acc[it][0] * rstd * gn[0], siluf_(rg[1]) * acc[it][1] * rstd * gn[1]);
                    t.y = pack2(siluf_(rg[2]) * acc[it][2] * rstd * gn[2], siluf_(rg[3]) * acc[it][3] * rstd * gn[3]);
                    *(u32x2*)(OB + (size_t)tok * 1024 + 512 + h * 128 + w * 16 + 4 * fq) = t;
                }
            }
            __syncthreads();
        }
    }
}

__device__ __forceinline__ void phase_gate(const Frame& F, const PRef& p, int l) {
    const bf16_t* U = (const bf16_t*)(p.ws() + WS_U); bf16_t* ACT = (bf16_t*)(p.ws() + WS_ACT);
    const float* cw = p.in(16) + (size_t)l * 3 * 5632; const float* cb = p.in(17) + (size_t)l * 5632;
    const int gt = F.bid * NTHREADS + F.tid, ngt = F.G * NTHREADS;
    const int cg = gt % 352, tslot = gt / 352, nslot = ngt / 352;
    if (tslot >= nslot) return;
    const int c0 = cg * 8;
    float w0[2][8], w1[2][8], w2[2][8], bb[2][8];
#pragma unroll
    for (int half = 0; half < 2; ++half) {
        const int col = c0 + half * 2816;
#pragma unroll
        for (int q = 0; q < 2; ++q) {
            const f32x4 a = *(const f32x4*)(cw + col + q * 4), b = *(const f32x4*)(cw + 5632 + col + q * 4), c = *(const f32x4*)(cw + 2 * 5632 + col + q * 4), d = *(const f32x4*)(cb + col + q * 4);
#pragma unroll
            for (int j = 0; j < 4; ++j) { w0[half][q * 4 + j] = a[j]; w1[half][q * 4 + j] = b[j]; w2[half][q * 4 + j] = c[j]; bb[half][q * 4 + j] = d[j]; }
        }
    }
    bf16x8 cx[2][3], nx[2][3];
#define GATE_LOAD(dst, tok_) do { const int t_ = (tok_) < NCTX ? ((tok_) & 255) : (((tok_) - NCTX) & 1023), n_ = (tok_) < NCTX ? 256 : 1024; \
        const bf16x8 z_ = (bf16x8){0, 0, 0, 0, 0, 0, 0, 0}; \
        _Pragma("unroll") for (int half = 0; half < 2; ++half) { const bf16_t* up_ = U + (size_t)(tok_) * 5632 + c0 + half * 2816; \
            dst[half][1] = *(const bf16x8*)up_; dst[half][0] = t_ > 0 ? *(const bf16x8*)(up_ - 5632) : z_; dst[half][2] = t_ < n_ - 1 ? *(const bf16x8*)(up_ + 5632) : z_; } } while (0)
    if (tslot < NTOK) GATE_LOAD(cx, tslot);
    for (int tok = tslot; tok < NTOK; tok += nslot) {
        if (tok + nslot < NTOK) GATE_LOAD(nx, tok + nslot);
        float u2[2][8];
#pragma unroll
        for (int half = 0; half < 2; ++half)
#pragma unroll
            for (int j = 0; j < 8; ++j)
                u2[half][j] = bf2f((unsigned short)cx[half][0][j]) * w0[half][j] + bf2f((unsigned short)cx[half][1][j]) * w1[half][j] + bf2f((unsigned short)cx[half][2][j]) * w2[half][j] + bb[half][j];
        u32x4 w;
        w.x = pack2(siluf_(u2[0][0]) * u2[1][0], siluf_(u2[0][1]) * u2[1][1]); w.y = pack2(siluf_(u2[0][2]) * u2[1][2], siluf_(u2[0][3]) * u2[1][3]);
        w.z = pack2(siluf_(u2[0][4]) * u2[1][4], siluf_(u2[0][5]) * u2[1][5]); w.w = pack2(siluf_(u2[0][6]) * u2[1][6], siluf_(u2[0][7]) * u2[1][7]);
        *(u32x4*)(ACT + (size_t)tok * 2816 + c0) = w;
#pragma unroll
        for (int half = 0; half < 2; ++half)
#pragma unroll
            for (int q = 0; q < 3; ++q) cx[half][q] = nx[half][q];
    }
#undef GATE_LOAD
}

__device__ __forceinline__ void phase_l1_tok(const Frame& F, const PRef& p) {
    unsigned char* ws = p.ws();
    const float* P = (const float*)(ws + WS_P1);
    bf16_t* QD = (bf16_t*)(ws + WS_QD); bf16_t* KD = (bf16_t*)(ws + WS_KD); bf16_t* VDT = (bf16_t*)(ws + WS_VDT);
    float* RR = (float*)(ws + WS_RR); float* KR = (float*)(ws + WS_KR); float* VV = (float*)(ws + WS_VV); float* KK = (float*)(ws + WS_KK);
    bf16_t* TW = (bf16_t*)(ws + WS_TW); bf16_t* AD = (bf16_t*)(ws + WS_AD); bf16_t* SG = (bf16_t*)(ws + WS_SG);
    const int nw = F.G * 8, lane = F.lane;
    const float* mu = p.in(33);
    for (int row = F.bid * 8 + F.wave; row < NKROW; row += nw) {
        const bool istok = row < NTOK, lat = istok && row >= NCTX;
        int kr;
        if (row < NCTX) kr = row; else if (row < NTOK) { const int v = row - NCTX; kr = NCTX + (v >> 10) * 1536 + (v & 1023); }
        else { const int i = row - NTOK; kr = NCTX + (i >> 9) * 1536 + 1024 + (i & 511); }
        if (!istok) {
            const int i = row - NTOK;
#pragma unroll
            for (int j = 0; j < 8; ++j) {
                const int col = j * 64 + lane;
                KD[(size_t)kr * 512 + col] = f2bf(p.in(5)[(size_t)i * 512 + col]);
                VDT[(size_t)kr * 512 + col] = f2bf(p.in(6)[(size_t)i * 512 + col]);
            }
            continue;
        }
        const float* pr = P + (size_t)row * 3584;
        float cs = 1.f, sn = 0.f;
        if (lat) {
            const int t = (row - NCTX) & 1023, a = lane & 31;
            const float pos = a < 16 ? (float)(t >> 6) : (float)(t & 63);
            const float inv = __powf(10000.0f, -(float)(a & 15) * 0.0625f);
            const float ang = pos * inv; cs = __cosf(ang); sn = __sinf(ang);
        }
        {
            const int pi = lane & 31;
            f32x2 qv[4], kv[4];
#pragma unroll
            for (int pass = 0; pass < 4; ++pass) { const int vec = pass * 2 + (lane >> 5); qv[pass] = *(const f32x2*)(pr + vec * 64 + 2 * pi); kv[pass] = *(const f32x2*)(pr + 512 + vec * 64 + 2 * pi); }
            const f32x2 gq = *(const f32x2*)(p.in(29) + 2 * pi), gk = *(const f32x2*)(p.in(30) + 2 * pi);
#pragma unroll
            for (int pass = 0; pass < 4; ++pass) {
                const int vec = pass * 2 + (lane >> 5);
                {
                    const f32x2 v = qv[pass];
                    const float rstd = rsqrtf(half_sum(v[0] * v[0] + v[1] * v[1], lane) * (1.0f / 64.0f) + EPS);
                    const float x1 = v[0] * rstd * gq[0], x2 = v[1] * rstd * gq[1];
                    *(unsigned*)(QD + (size_t)row * 512 + vec * 64 + 2 * pi) = pack2((x1 * cs - x2 * sn) * 0.125f, (x1 * sn + x2 * cs) * 0.125f);
                }
                {
                    const f32x2 v = kv[pass];
                    const float rstd = rsqrtf(half_sum(v[0] * v[0] + v[1] * v[1], lane) * (1.0f / 64.0f) + EPS);
                    const float x1 = v[0] * rstd * gk[0], x2 = v[1] * rstd * gk[1];
                    if (row < NCTX) *(f32x2*)(p.out() + OUT_DK + (size_t)row * 512 + vec * 64 + 2 * pi) = (f32x2){x1, x2};
                    *(unsigned*)(KD + (size_t)kr * 512 + vec * 64 + 2 * pi) = pack2(x1 * cs - x2 * sn, x1 * sn + x2 * cs);
                }
            }
        }
#pragma unroll
        for (int j = 0; j < 8; ++j) {
            const int col = j * 64 + lane; const float v = pr[1024 + col];
            if (row < NCTX) p.out()[OUT_DV + (size_t)row * 512 + col] = v;
            VDT[(size_t)kr * 512 + col] = f2bf(v);
        }
        const int t = row < NCTX ? (row & 255) : ((row - NCTX) & 1023), n = row < NCTX ? 256 : 1024;
        const bool hp = t > 0, hn = t < n - 1;
        const float* pp = pr + 1536;
        const float* pn = pp + 3584; const float* pv = pp - 3584;
#define SHIFT4(col) ({ const f32x4 _c = *(const f32x4*)(pp + (col)); const f32x4 _p = hp ? *(const f32x4*)(pv + (col)) : (f32x4){0.f, 0.f, 0.f, 0.f}; \
            const f32x4 _n = hn ? *(const f32x4*)(pn + (col)) : (f32x4){0.f, 0.f, 0.f, 0.f}; const f32x4 _m = *(const f32x4*)(mu + (col)); _c + (0.5f * (_p + _n) - _c) * _m; })
        {
            const size_t o = (size_t)row * 512 + lane * 8;
            const f32x4 r0 = SHIFT4(lane * 8), r1 = SHIFT4(lane * 8 + 4);
            *(f32x4*)(RR + o) = r0; *(f32x4*)(RR + o + 4) = r1;
            const f32x4 k0 = SHIFT4(512 + lane * 8), k1 = SHIFT4(512 + lane * 8 + 4);
            *(f32x4*)(KR + o) = k0; *(f32x4*)(KR + o + 4) = k1;
            const f32x4 v0 = SHIFT4(1024 + lane * 8), v1 = SHIFT4(1024 + lane * 8 + 4);
            *(f32x4*)(VV + o) = v0; *(f32x4*)(VV + o + 4) = v1;
            const f32x4 kk0 = k0 * *(const f32x4*)(p.in(39) + lane * 8), kk1 = k1 * *(const f32x4*)(p.in(39) + lane * 8 + 4);
            float ss = (kk0[0] * kk0[0] + kk0[1] * kk0[1]) + (kk0[2] * kk0[2] + kk0[3] * kk0[3]) + (kk1[0] * kk1[0] + kk1[1] * kk1[1]) + (kk1[2] * kk1[2] + kk1[3] * kk1[3]);
            ss = oct_sum(ss);
            const float rn = rsqrtf(ss + EPS);
            *(f32x4*)(KK + o) = kk0 * rn; *(f32x4*)(KK + o + 4) = kk1 * rn;
        }
        {
            const f32x4 a = SHIFT4(1536 + lane * 4);
            u32x2 w;
            if (lane < 32) { w.x = pack2(tanhf_(a[0]), tanhf_(a[1])); w.y = pack2(tanhf_(a[2]), tanhf_(a[3])); *(u32x2*)(TW + (size_t)row * 128 + lane * 4) = w; }
            else { w.x = pack2(a[0], a[1]); w.y = pack2(a[2], a[3]); *(u32x2*)(AD + (size_t)row * 128 + (lane - 32) * 4) = w; }
            if (lane < 32) { const f32x4 g = SHIFT4(1792 + lane * 4); w.x = pack2(sigmoidf_(g[0]), sigmoidf_(g[1])); w.y = pack2(sigmoidf_(g[2]), sigmoidf_(g[3])); *(u32x2*)(SG + (size_t)row * 128 + lane * 4) = w; }
        }
#define SHIFTED(col) 0
#undef SHIFTED
    }
}

constexpr int SC_T = 16;
constexpr int SC_BUF = 2 * SC_T * 6 * 64;
__device__ __forceinline__ void phase_l1_mix(const Frame& F, const PRef& p) {
    unsigned char* ws = p.ws();
    const bf16_t* Q = (const bf16_t*)(ws + WS_QD); const bf16_t* K = (const bf16_t*)(ws + WS_KD); const bf16_t* VT = (const bf16_t*)(ws + WS_VDT);
    AttnOutBf16 ao{(bf16_t*)(ws + WS_DO), 1024};
    float gq = 0.f, gk = 0.f;
    for (int i = 0; i < 64; ++i) { gq = fmaxf(gq, fabsf(p.in(29)[i])); gk = fmaxf(gk, fabsf(p.in(30)[i])); }
    const float shift = 8.0f * gq * gk;
    for (int slot = 0; slot * F.G < 512; ++slot) { const int u = F.G == 256 ? attn_unit_xcd(F.bid, slot) : F.bid + slot * F.G; if (u < 512) attn_block<64, 128, 4>(F, Q, K, VT, ao, u, shift); }
}

__device__ __forceinline__ float dpp_xor1(float x) { return __int_as_float(__builtin_amdgcn_update_dpp(0, __float_as_int(x), 0xB1, 0xF, 0xF, true)); }
__device__ __forceinline__ float dpp_xor2(float x) { return __int_as_float(__builtin_amdgcn_update_dpp(0, __float_as_int(x), 0x4E, 0xF, 0xF, true)); }
#define VFMA(d, a, b, c) asm("v_fma_f32 %0, %1, %2, %3" : "=v"(d) : "v"(a), "v"(b), "v"(c))
#define VFMAN(d, a, b, c) asm("v_fma_f32 %0, -%1, %2, %3" : "=v"(d) : "v"(a), "v"(b), "v"(c))
#define VMUL(d, a, b) asm("v_mul_f32 %0, %1, %2" : "=v"(d) : "v"(a), "v"(b))
#define VADD(d, a, b) asm("v_add_f32 %0, %1, %2" : "=v"(d) : "v"(a), "v"(b))
#define QUAD_SUM_ASM(x) asm("s_nop 1\n\tv_add_f32_dpp %0, %0, %0 quad_perm:[1,0,3,2] row_mask:0xf bank_mask:0xf bound_ctrl:1\n\ts_nop 1\n\t" \
    "v_add_f32_dpp %0, %0, %0 quad_perm:[2,3,0,1] row_mask:0xf bank_mask:0xf bound_ctrl:1" : "+v"(x))
#define ROW16_SUM_ASM(x) asm("s_nop 1\n\tv_add_f32_dpp %0, %0, %0 quad_perm:[1,0,3,2] row_mask:0xf bank_mask:0xf bound_ctrl:1\n\ts_nop 1\n\t" \
    "v_add_f32_dpp %0, %0, %0 quad_perm:[2,3,0,1] row_mask:0xf bank_mask:0xf bound_ctrl:1\n\ts_nop 1\n\t" \
    "v_add_f32_dpp %0, %0, %0 row_half_mirror row_mask:0xf bank_mask:0xf bound_ctrl:1\n\ts_nop 1\n\t" \
    "v_add_f32_dpp %0, %0, %0 row_mirror row_mask:0xf bank_mask:0xf bound_ctrl:1" : "+v"(x))
constexpr int SREC = 400;
template <int KPL> struct ScanVecs { f32x4 w[KPL / 4], kka[KPL / 4], kd[KPL / 4], kk[KPL / 4], r[KPL / 4]; float v, c1, c2; };
template <int KPL>
__device__ __forceinline__ void scan_load(ScanVecs<KPL>& x, const LAS float* v6, int koff, int row) {
#pragma unroll
    for (int q = 0; q < KPL / 4; ++q) {
        x.w[q] = *(const LAS f32x4*)(v6 + 0 * 64 + koff + q * 4); x.kka[q] = *(const LAS f32x4*)(v6 + 1 * 64 + koff + q * 4); x.kd[q] = *(const LAS f32x4*)(v6 + 2 * 64 + koff + q * 4);
        x.kk[q] = *(const LAS f32x4*)(v6 + 3 * 64 + koff + q * 4); x.r[q] = *(const LAS f32x4*)(v6 + 4 * 64 + koff + q * 4);
    }
    x.v = v6[5 * 64 + row]; x.c1 = v6[384]; x.c2 = v6[385];
}
template <int MODE>
__device__ __forceinline__ void scan_unit(const Frame& F, const PRef& p, int unit) {
    constexpr int T = 32, NSTEPS = MODE == 0 ? 1024 : 256, BUF = T * SREC, NCHUNK = NSTEPS / T;
    constexpr int KPL = MODE == 0 ? 4 : 16, NQ = KPL / 4;
    unsigned char* ws = p.ws();
    const float* RR = (const float*)(ws + WS_RR); const float* KR = (const float*)(ws + WS_KR); const float* VV = (const float*)(ws + WS_VV); const float* KK = (const float*)(ws + WS_KK);
    const float* DEC = (const float*)(ws + WS_DEC); const float* AA = (const float*)(ws + WS_AA);
    float* YY = (float*)(ws + WS_YY);
    const float* k_a = p.in(40);
    LAS float* sb = (LAS float*)F.lds;
    const int lane = F.lane;
    const bool loader = F.wave >= 4;
    const bool compute = F.wave < 4;
    const int cid = MODE == 0 ? (unit >> 2) : unit;
    const int cb = cid >> 4, chh = (cid >> 1) & 7, cd = cid & 1;
    const int cbase = MODE == 0 ? NCTX + cb * 1024 : cb * 256;
    if (loader) {
        const int lt = F.tid - 256;
        f32x4 pa[2][6], pb[2][6];
        const f32x4 ka4 = *(const f32x4*)(k_a + chh * 64 + (lt & 15) * 4), rk4 = *(const f32x4*)(p.in(41) + chh * 64 + (lt & 15) * 4);
        float* BON = (float*)(ws + WS_BON) + (size_t)cd * NTOK * 8 + chh;
        const bool wbon = MODE == 1 || (unit & 3) == 0;
#define SC_LOAD(pre, chunk) do { _Pragma("unroll") for (int it = 0; it < 2; ++it) { const int item = it * 256 + lt; const int stp = item >> 4, k = (item & 15) * 4; \
            const int j_ = (chunk) * T + stp; const int tok = cbase + (cd ? NSTEPS - 1 - j_ : j_); const size_t o_ = (size_t)tok * 512 + chh * 64 + k; \
            pre[it][0] = *(const f32x4*)(DEC + (size_t)cd * NTOK * 512 + o_); pre[it][1] = *(const f32x4*)(AA + (size_t)cd * NTOK * 512 + o_); pre[it][2] = *(const f32x4*)(KR + o_); \
            pre[it][3] = *(const f32x4*)(KK + o_); pre[it][4] = *(const f32x4*)(RR + o_); pre[it][5] = *(const f32x4*)(VV + o_); } } while (0)
#define SC_WRITE(pre, buf, chunk) do { _Pragma("unroll") for (int it = 0; it < 2; ++it) { const int item = it * 256 + lt; const int stp = item >> 4, k = (item & 15) * 4; \
            const f32x4 a_ = pre[it][1], kk_ = pre[it][3], r_ = pre[it][4], w_ = pre[it][0]; LAS float* d_ = sb + (buf) * BUF + stp * SREC + k; \
            const f32x4 bb_ = kk_ * a_, kd_ = pre[it][2] * (1.0f + (a_ - 1.0f) * ka4); \
            *(LAS f32x4*)(d_) = w_; *(LAS f32x4*)(d_ + 64) = bb_; *(LAS f32x4*)(d_ + 128) = kd_; *(LAS f32x4*)(d_ + 192) = kk_; \
            *(LAS f32x4*)(d_ + 256) = w_ * r_; *(LAS f32x4*)(d_ + 320) = pre[it][5]; \
            const f32x4 p1_ = bb_ * r_, p2_ = kd_ * r_; const float c1_ = row16_sum((p1_[0] + p1_[1]) + (p1_[2] + p1_[3])), c2_ = row16_sum((p2_[0] + p2_[1]) + (p2_[2] + p2_[3])); \
            const f32x4 p3_ = p2_ * rk4; const float c3_ = row16_sum((p3_[0] + p3_[1]) + (p3_[2] + p3_[3])); \
            if ((lt & 15) == 0) { LAS float* e_ = sb + (buf) * BUF + stp * SREC + 384; e_[0] = c1_; e_[1] = c2_; \
                if (wbon) { const int j2_ = (chunk) * T + stp; BON[(size_t)(cbase + (cd ? NSTEPS - 1 - j2_ : j2_)) * 8] = c3_; } } } } while (0)
        SC_LOAD(pa, 0); SC_LOAD(pb, 1); SC_WRITE(pa, 0, 0); SC_LOAD(pa, 2);
        __syncthreads();
        for (int cnk = 0; cnk < NCHUNK; cnk += 2) {
            if (cnk + 1 < NCHUNK) { SC_WRITE(pb, (cnk + 1) & 1, cnk + 1); if (cnk + 3 < NCHUNK) SC_LOAD(pb, cnk + 3); }
            __syncthreads();
            if (cnk + 2 < NCHUNK) { SC_WRITE(pa, (cnk + 2) & 1, cnk + 2); if (cnk + 4 < NCHUNK) SC_LOAD(pa, cnk + 4); }
            __syncthreads();
        }
#undef SC_LOAD
#undef SC_WRITE
    } else if (compute) {
        const int row = MODE == 0 ? (unit & 3) * 16 + F.wave * 4 + (lane >> 4) : F.wave * 16 + (lane >> 2);
        const int kq = MODE == 0 ? (lane & 15) : (lane & 3), koff = kq * KPL;
        f32x4 S[NQ];
        if (MODE == 0) {
            const float* s0 = p.in(7) + (size_t)(((cb * 2 + cd) * 8 + chh) * 64 + row) * 64 + koff;
#pragma unroll
            for (int q = 0; q < NQ; ++q) S[q] = *(const f32x4*)(s0 + q * 4);
        } else {
#pragma unroll
            for (int q = 0; q < NQ; ++q) S[q] = (f32x4){0.f, 0.f, 0.f, 0.f};
        }
        __syncthreads();
        float* yp = YY + (size_t)cd * NTOK * 512 + chh * 64 + row;
        for (int cnk = 0; cnk < NCHUNK; ++cnk) {
            const LAS float* bufp = sb + (cnk & 1) * BUF;
            ScanVecs<KPL> cur, nxt;
            scan_load<KPL>(cur, bufp, koff, row);
#pragma unroll 2
            for (int stp = 0; stp < T; ++stp) {
                scan_load<KPL>(nxt, bufp + (stp + 1 < T ? stp + 1 : stp) * SREC, koff, row);
                const int j_ = cnk * T + stp; const int tok = cbase + (cd ? NSTEPS - 1 - j_ : j_);
                f32x4 a4 = S[0] * cur.kk[0], y4 = S[0] * cur.r[0];
#pragma unroll
                for (int q = 1; q < NQ; ++q) { a4 = a4 + S[q] * cur.kk[q]; y4 = y4 + S[q] * cur.r[q]; }
                float sa = (a4[0] + a4[1]) + (a4[2] + a4[3]), ys = (y4[0] + y4[1]) + (y4[2] + y4[3]);
                if (MODE == 0) {
                    sa += DPPF(sa, 0xB1); ys += DPPF(ys, 0xB1); sa += DPPF(sa, 0x4E); ys += DPPF(ys, 0x4E);
                    sa += DPPF(sa, 0x141); ys += DPPF(ys, 0x141); sa += DPPF(sa, 0x140); ys += DPPF(ys, 0x140);
                } else { sa += DPPF(sa, 0xB1); ys += DPPF(ys, 0xB1); sa += DPPF(sa, 0x4E); ys += DPPF(ys, 0x4E); }
                const float vr = cur.v;
#pragma unroll
                for (int q = 0; q < NQ; ++q) S[q] = S[q] * cur.w[q] + (vr * cur.kd[q] - sa * cur.kka[q]);
                if (kq == 0) yp[(size_t)tok * 512] = ys - sa * cur.c1 + vr * cur.c2;
                cur = nxt;
            }
            __syncthreads();
        }
        if (MODE == 1) {
            float* so = p.out() + OUT_SRWKV + (size_t)(((cb * 2 + cd) * 8 + chh) * 64 + row) * 64 + koff;
#pragma unroll
            for (int q = 0; q < NQ; ++q) *(f32x4*)(so + q * 4) = S[q];
        }
    } else {
        __syncthreads();
        for (int cnk = 0; cnk < NCHUNK; ++cnk) __syncthreads();
    }
}
constexpr int CI_AP = 0, CI_RH = 2304, CI_BT = 4608, CI_KT = 7168, CI_MP = 9728, CI_PP = 10368, CI_GL = 11520, CI_VT = 11776, CI_SZ = 14336;
constexpr int CS_AH = 0, CS_BH = 2304, CS_KH = 4608, CS_SZ = 6912;
constexpr int CS_NM = CS_BH, CS_TM = CS_BH + 1024, CS_MM = CS_BH + 2048;
constexpr int CIMG0 = 0, CSCR0 = 8 * CI_SZ;
static_assert(CSCR0 + 4 * CS_SZ <= LDS_BYTES - LDS_WORK, "chunked scan LDS");
constexpr size_t WS_GIMG = WS_HB;
static_assert((size_t)32 * 12 * 4 * CI_SZ <= (size_t)2 * NTOK * 1024 * 2, "hand-off images do not fit HB + OB");
constexpr int SCAN_FLAG_WORD = 3584;
template <int MODE, int ROLE>
__device__ __forceinline__ void scanc_unit(const Frame& F, const PRef& p, int cid, int hid = 0) {
    constexpr int NSTEPS = MODE == 0 ? 1024 : 256, NCH = NSTEPS / 16, NG = NCH / 4;
    unsigned char* ws = p.ws();
    const float* RR = (const float*)(ws + WS_RR); const float* KR = (const float*)(ws + WS_KR); const float* VV = (const float*)(ws + WS_VV); const float* KK = (const float*)(ws + WS_KK);
    const float* DEC = (const float*)(ws + WS_DEC); const float* AA = (const float*)(ws + WS_AA);
    float* YY = (float*)(ws + WS_YY);
    LAS unsigned char* L = F.lds;
    const int lane = F.lane, fr = lane & 15, g = lane >> 4, w = F.wave;
    const int cb = cid >> 4, chh = (cid >> 1) & 7, cd = cid & 1;
    const int cbase = MODE == 0 ? NCTX + cb * 1024 : cb * 256;
#define TOK_OF(step) (cbase + (cd ? NSTEPS - 1 - (step) : (step)))
    unsigned* hflag = (unsigned*)(ws + WS_BAR) + SCAN_FLAG_WORD + cid * 16;
    unsigned char* gimg = ws + WS_GIMG + (size_t)cid * 12 * 4 * CI_SZ;
    const __amdgpu_buffer_rsrc_t grs = wt_rsrc(gimg, (size_t)12 * 4 * CI_SZ);
    if (w >= 4 || ROLE == 2) {
        if (ROLE == 2 && w < 4) {
            for (int grp = hid; grp < NG; grp += 4) {
                const int og = grp - (grp >> 2) - 1;
                __syncthreads();
                for (int i = F.tid; i < 4 * CI_SZ / 16; i += NTHREADS) wt_store16(grs, (size_t)og * 4 * CI_SZ + (size_t)i * 16, *(const LAS u32x4*)(L + CIMG0 + (size_t)i * 16));
                asm volatile("s_waitcnt vmcnt(0)" ::: "memory");
                __syncthreads();
                if (F.tid == 0) __hip_atomic_store(hflag + grp, 1u, __ATOMIC_RELAXED, __HIP_MEMORY_SCOPE_AGENT);
                __syncthreads();
            }
            return;
        }
        const int j = w - 4, k = lane;
        LAS unsigned char* SC = L + CSCR0 + j * CS_SZ;
        const float ka = p.in(40)[chh * 64 + k];
        const size_t colo = (size_t)chh * 64 + k;
        const float* decp = DEC + (size_t)cd * NTOK * 512; const float* aap = AA + (size_t)cd * NTOK * 512;
        float rw[16], rkk[16], ra[16], rkr[16], rr[16], rv[16];
#define PREP_LOAD(chunk) do { _Pragma("unroll") for (int t = 0; t < 16; ++t) { const size_t o_ = (size_t)TOK_OF((chunk) * 16 + t) * 512 + colo; \
            rw[t] = decp[o_]; rkk[t] = KK[o_]; ra[t] = aap[o_]; rkr[t] = KR[o_]; rr[t] = RR[o_]; rv[t] = VV[o_]; } } while (0)
        PREP_LOAD(ROLE == 2 ? hid * 4 + j : j);
        for (int grp = (ROLE == 2 ? hid : 0); grp < NG; grp += (ROLE == 2 ? 4 : 1)) {
            LAS unsigned char* IM = L + CIMG0 + ((ROLE == 2 ? 0 : (grp & 1) * 4) + j) * CI_SZ;
            if (ROLE == 1 && (grp & 3)) {
                if (lane == 0) { unsigned sp = 0; while (__hip_atomic_load(hflag + grp, __ATOMIC_RELAXED, __HIP_MEMORY_SCOPE_AGENT) == 0u && ++sp < (1u << 22)) __builtin_amdgcn_s_sleep(2); }
                asm volatile("" ::: "memory");
                for (int i = lane; i < CI_SZ / 16; i += 64)
                    *(LAS u32x4*)(IM + (size_t)i * 16) = __builtin_bit_cast(u32x4, __builtin_amdgcn_raw_buffer_load_b128(grs, (int)(((size_t)(grp - (grp >> 2) - 1) * 4 + j) * CI_SZ + (size_t)i * 16), 0, 16));
                __syncthreads();
                continue;
            }
            float ah[16]; float G = 1.0f;
#pragma unroll
            for (int t2 = 0; t2 < 8; ++t2) {
                float bh2[2], kh2[2];
#pragma unroll
                for (int u = 0; u < 2; ++u) {
                    const int t = 2 * t2 + u;
                    const float bb = rkk[t] * ra[t], kd = rkr[t] * (1.0f + (ra[t] - 1.0f) * ka);
                    ah[t] = -rkk[t] * G;
                    G *= rw[t];
                    const float inv = __builtin_amdgcn_rcpf(G);
                    const float bh = bb * inv, kh = kd * inv, rh = rr[t] * G;
                    bh2[u] = bh; kh2[u] = kh;
                    *(LAS bf16_t*)(SC + CS_AH + t * 144 + k * 2) = f2bf(ah[t]);
                    *(LAS bf16_t*)(SC + CS_BH + t * 144 + k * 2) = f2bf(bh);
                    *(LAS bf16_t*)(SC + CS_KH + t * 144 + k * 2) = f2bf(kh);
                    *(LAS bf16_t*)(IM + CI_RH + t * 144 + k * 2) = f2bf(rh);
                }
                *(LAS unsigned*)(IM + CI_BT + k * 40 + t2 * 4) = pack2(bh2[0], bh2[1]);
                *(LAS unsigned*)(IM + CI_KT + k * 40 + t2 * 4) = pack2(kh2[0], kh2[1]);
                *(LAS unsigned*)(IM + CI_VT + k * 40 + t2 * 4) = pack2(rv[2 * t2], rv[2 * t2 + 1]);
            }
            *(LAS float*)(IM + CI_GL + k * 4) = G;
            { const int ng_ = grp + (ROLE == 0 ? 1 : 4); if (ng_ < NG) PREP_LOAD(ng_ * 4 + j); }
            f32x4 dN = (f32x4){0.f, 0.f, 0.f, 0.f}, dM = dN, dPb = dN, dPk = dN;
#pragma unroll
            for (int s = 0; s < 2; ++s) {
                const int fo = fr * 144 + (4 * s + g) * 16;
                const bf16x8 fa = *(const LAS bf16x8*)(SC + CS_AH + fo), fb = *(const LAS bf16x8*)(SC + CS_BH + fo), fk = *(const LAS bf16x8*)(SC + CS_KH + fo), frh = *(const LAS bf16x8*)(IM + CI_RH + fo);
                dN = __builtin_amdgcn_mfma_f32_16x16x32_bf16(fa, fb, dN, 0, 0, 0); dM = __builtin_amdgcn_mfma_f32_16x16x32_bf16(fa, fk, dM, 0, 0, 0);
                dPb = __builtin_amdgcn_mfma_f32_16x16x32_bf16(frh, fb, dPb, 0, 0, 0); dPk = __builtin_amdgcn_mfma_f32_16x16x32_bf16(frh, fk, dPk, 0, 0, 0);
            }
#pragma unroll
            for (int r = 0; r < 4; ++r) {
                const int t = 4 * g + r;
                *(LAS float*)(SC + CS_MM + (t * 16 + fr) * 4) = fr < t ? dM[r] : 0.f;
                *(LAS bf16_t*)(IM + CI_PP + t * 72 + fr * 2) = f2bf(fr <= t ? dPb[r] : 0.f);
                *(LAS bf16_t*)(IM + CI_PP + t * 72 + (16 + fr) * 2) = f2bf(fr <= t ? dPk[r] : 0.f);
            }
            float Tc[16];
            Tc[0] = fr == 0 ? 1.0f : 0.f;
#pragma unroll
            for (int i = 1; i < 16; ++i) {
                float s0_ = fr == i ? 1.0f : 0.f, s1_ = 0.f;
#pragma unroll
                for (int jj = 0; jj < i; ++jj) {
                    const float nij = RDLANE(dN[i & 3], jj + 16 * (i >> 2));
                    if (jj & 1) s1_ += nij * Tc[jj]; else s0_ += nij * Tc[jj];
                }
                Tc[i] = s0_ + s1_;
            }
            if (g == 0) {
#pragma unroll
                for (int i = 0; i < 16; ++i) *(LAS float*)(SC + CS_TM + (i * 16 + fr) * 4) = Tc[i];
            }
#pragma unroll
            for (int i = 0; i < 16; ++i) {
                float s0_ = 0.f, s1_ = 0.f;
#pragma unroll
                for (int jj = 0; jj <= i; ++jj) { const float tij = RDLANE(Tc[i], jj); if (jj & 1) s1_ += tij * ah[jj]; else s0_ += tij * ah[jj]; }
                *(LAS bf16_t*)(IM + CI_AP + i * 144 + k * 2) = f2bf(s0_ + s1_);
            }
            {
                const int i = lane >> 2, j4 = (lane & 3) * 4;
                f32x4 macc = (f32x4){0.f, 0.f, 0.f, 0.f};
#pragma unroll
                for (int t = 0; t < 16; ++t) macc += *(const LAS f32x4*)(SC + CS_MM + (t * 16 + j4) * 4) * *(const LAS float*)(SC + CS_TM + (i * 16 + t) * 4);
                u32x2 pk; pk.x = pack2(macc[0], macc[1]); pk.y = pack2(macc[2], macc[3]);
                *(LAS u32x2*)(IM + CI_MP + i * 40 + j4 * 2) = pk;
            }
            if (ROLE == 2) {
                const int og = grp - (grp >> 2) - 1;
                __syncthreads();
                for (int i = F.tid; i < 4 * CI_SZ / 16; i += NTHREADS) wt_store16(grs, (size_t)og * 4 * CI_SZ + (size_t)i * 16, *(const LAS u32x4*)(L + CIMG0 + (size_t)i * 16));
                asm volatile("s_waitcnt vmcnt(0)" ::: "memory");
                __syncthreads();
                __syncthreads();
                continue;
            }
            __syncthreads();
        }
        if (ROLE == 2) return;
        __syncthreads();
#undef PREP_LOAD
    } else {
        f32x4 S[4];
        if (MODE == 0) {
            const float* s0 = p.in(7) + (size_t)(((cb * 2 + cd) * 8 + chh) * 64 + 16 * w + fr) * 64;
#pragma unroll
            for (int kt = 0; kt < 4; ++kt) S[kt] = *(const f32x4*)(s0 + 16 * kt + 4 * g);
        } else {
#pragma unroll
            for (int kt = 0; kt < 4; ++kt) S[kt] = (f32x4){0.f, 0.f, 0.f, 0.f};
        }
        float* yp = YY + (size_t)cd * NTOK * 512 + chh * 64 + 16 * w + fr;
        __syncthreads();
        for (int grp = 0; grp < NG; ++grp) {
#pragma unroll
            for (int c4 = 0; c4 < 4; ++c4) {
                const LAS unsigned char* IM = L + CIMG0 + ((grp & 1) * 4 + c4) * CI_SZ;
                u32x2 oa[2][2], orh[2][2], obt[4], okt[4]; f32x4 ogl[4];
#pragma unroll
                for (int s = 0; s < 2; ++s) {
                    oa[s][0] = *(const LAS u32x2*)(IM + CI_AP + fr * 144 + (32 * s + 4 * g) * 2); oa[s][1] = *(const LAS u32x2*)(IM + CI_AP + fr * 144 + (32 * s + 16 + 4 * g) * 2);
                    orh[s][0] = *(const LAS u32x2*)(IM + CI_RH + fr * 144 + (32 * s + 4 * g) * 2); orh[s][1] = *(const LAS u32x2*)(IM + CI_RH + fr * 144 + (32 * s + 16 + 4 * g) * 2);
                }
                const u32x2 vq = *(const LAS u32x2*)(IM + CI_VT + (16 * w + fr) * 40 + g * 8);
                const u32x2 m0 = *(const LAS u32x2*)(IM + CI_MP + fr * 40 + g * 8);
                const u32x2 p0 = *(const LAS u32x2*)(IM + CI_PP + fr * 72 + g * 8), p1 = *(const LAS u32x2*)(IM + CI_PP + fr * 72 + 32 + g * 8);
#pragma unroll
                for (int kt = 0; kt < 4; ++kt) {
                    obt[kt] = *(const LAS u32x2*)(IM + CI_BT + (16 * kt + fr) * 40 + g * 8); okt[kt] = *(const LAS u32x2*)(IM + CI_KT + (16 * kt + fr) * 40 + g * 8);
                    ogl[kt] = *(const LAS f32x4*)(IM + CI_GL + (16 * kt + 4 * g) * 4);
                }
                bf16x8 Sp[2];
#pragma unroll
                for (int s = 0; s < 2; ++s) { u32x4 pk; pk.x = pack2(S[2 * s][0], S[2 * s][1]); pk.y = pack2(S[2 * s][2], S[2 * s][3]); pk.z = pack2(S[2 * s + 1][0], S[2 * s + 1][1]); pk.w = pack2(S[2 * s + 1][2], S[2 * s + 1][3]); Sp[s] = __builtin_bit_cast(bf16x8, pk); }
                f32x4 U = (f32x4){0.f, 0.f, 0.f, 0.f}, Y = U;
#pragma unroll
                for (int s = 0; s < 2; ++s) {
                    U = __builtin_amdgcn_mfma_f32_16x16x32_bf16(__builtin_bit_cast(bf16x8, (u32x4){oa[s][0].x, oa[s][0].y, oa[s][1].x, oa[s][1].y}), Sp[s], U, 0, 0, 0);
                    Y = __builtin_amdgcn_mfma_f32_16x16x32_bf16(__builtin_bit_cast(bf16x8, (u32x4){orh[s][0].x, orh[s][0].y, orh[s][1].x, orh[s][1].y}), Sp[s], Y, 0, 0, 0);
                }
                U = __builtin_amdgcn_mfma_f32_16x16x32_bf16(__builtin_bit_cast(bf16x8, (u32x4){m0.x, m0.y, 0u, 0u}), __builtin_bit_cast(bf16x8, (u32x4){vq.x, vq.y, vq.x, vq.y}), U, 0, 0, 0);
                u32x4 uvk; uvk.x = pack2(U[0], U[1]); uvk.y = pack2(U[2], U[3]); uvk.z = vq.x; uvk.w = vq.y;
                const bf16x8 UV = __builtin_bit_cast(bf16x8, uvk);
#pragma unroll
                for (int kt = 0; kt < 4; ++kt) {
                    const f32x4 acc = __builtin_amdgcn_mfma_f32_16x16x32_bf16(__builtin_bit_cast(bf16x8, (u32x4){obt[kt].x, obt[kt].y, okt[kt].x, okt[kt].y}), UV, S[kt], 0, 0, 0);
                    S[kt] = acc * ogl[kt];
                }
                Y = __builtin_amdgcn_mfma_f32_16x16x32_bf16(__builtin_bit_cast(bf16x8, (u32x4){p0.x, p0.y, p1.x, p1.y}), UV, Y, 0, 0, 0);
                const int step0 = (grp * 4 + c4) * 16 + 4 * g;
#pragma unroll
                for (int r = 0; r < 4; ++r) yp[(size_t)TOK_OF(step0 + r) * 512] = Y[r];
            }
            __syncthreads();
        }
        if (MODE == 1) {
            float* so = p.out() + OUT_SRWKV + (size_t)(((cb * 2 + cd) * 8 + chh) * 64 + 16 * w + fr) * 64;
#pragma unroll
            for (int kt = 0; kt < 4; ++kt) *(f32x4*)(so + 16 * kt + 4 * g) = S[kt];
        }
    }
#undef TOK_OF
}
__device__ __forceinline__ void phase_l1_scanc(const Frame& F, const PRef& p) {
    if (F.G > 128) {
        if (F.bid < 32) scanc_unit<0, 1>(F, p, F.bid);
        else if (F.bid < 128) scanc_unit<0, 2>(F, p, (F.bid - 32) & 31, 1 + ((F.bid - 32) >> 5));
        else for (int u = F.bid - 128; u < 256; u += F.G - 128) scanc_unit<1, 0>(F, p, u);
    } else { FOR_UNITS(u, 288, 0) { if (u < 32) scanc_unit<0, 0>(F, p, u); else scanc_unit<1, 0>(F, p, u - 32); } }
}
__device__ __forceinline__ void phase_l1_scan(const Frame& F, const PRef& p) {
    const int half = F.G / 2;
    if (F.bid < half) {
        for (int u = F.bid; u < 128; u += half) { const int xcd = u & 7, idx = u >> 3; scan_unit<0>(F, p, (((idx >> 2) * 8 + xcd) << 2) | (idx & 3)); }
    } else {
        for (int u = F.bid - half; u < 256; u += F.G - half) scan_unit<1>(F, p, u);
    }
}

__device__ __forceinline__ void phase_l1_comb(const Frame& F, const PRef& p) {
    unsigned char* ws = p.ws();
    const float* RR = (const float*)(ws + WS_RR); const float* KR = (const float*)(ws + WS_KR); const float* VV = (const float*)(ws + WS_VV);
    const float* AA = (const float*)(ws + WS_AA); const float* GG = (const float*)(ws + WS_GG); const float* YY = (const float*)(ws + WS_YY);
    bf16_t* OB = (bf16_t*)(ws + WS_OB);
    const int nw = F.G * 8, lane = F.lane;
    const bf16_t* DO = (const bf16_t*)(ws + WS_DO);
    const float lam_init = 0.8f - 0.6f * 0.74081822068171788f;
    const float lam = __expf(wave_sum(p.in(31)[lane] * p.in(31)[64 + lane])) - __expf(wave_sum(p.in(31)[128 + lane] * p.in(31)[192 + lane])) + lam_init;
    for (int row = F.bid * 8 + F.wave; row < NTOK; row += nw) {
#pragma unroll
        for (int h = 0; h < 4; ++h) {
            const unsigned a = *(const unsigned*)(DO + (size_t)row * 1024 + (2 * h) * 128 + 2 * lane), b = *(const unsigned*)(DO + (size_t)row * 1024 + (2 * h + 1) * 128 + 2 * lane);
            const float d0 = bf2f(a & 0xffffu) - lam * bf2f(b & 0xffffu), d1 = bf2f(a >> 16) - lam * bf2f(b >> 16);
            const float rstd = rsqrtf(wave_sum(d0 * d0 + d1 * d1) * (1.0f / 128.0f) + EPS) * (1.0f - lam_init);
            const f32x2 gn = *(const f32x2*)(p.in(32) + h * 128 + 2 * lane);
            *(unsigned*)(OB + (size_t)row * 1024 + h * 128 + 2 * lane) = pack2(d0 * rstd * gn[0], d1 * rstd * gn[1]);
        }
        const size_t o = (size_t)row * 512 + lane * 8;
        const f32x4 yf0 = *(const f32x4*)(YY + o), yf1 = *(const f32x4*)(YY + o + 4), yb0 = *(const f32x4*)(YY + (size_t)NTOK * 512 + o), yb1 = *(const f32x4*)(YY + (size_t)NTOK * 512 + o + 4);
        const f32x4 v0 = *(const f32x4*)(VV + o), v1 = *(const f32x4*)(VV + o + 4), g0 = *(const f32x4*)(GG + o), g1 = *(const f32x4*)(GG + o + 4);
        const f32x4 n0 = *(const f32x4*)(p.in(42) + lane * 8), n1 = *(const f32x4*)(p.in(42) + lane * 8 + 4);
        const float* BON = (const float*)(ws + WS_BON);
#if CHUNKED_SCAN
        float bs = 0.f;
        {
            const f32x4 r0 = *(const f32x4*)(RR + o), r1 = *(const f32x4*)(RR + o + 4), k0 = *(const f32x4*)(KR + o), k1 = *(const f32x4*)(KR + o + 4);
            const f32x4 af0 = *(const f32x4*)(AA + o), af1 = *(const f32x4*)(AA + o + 4), ab0 = *(const f32x4*)(AA + (size_t)NTOK * 512 + o), ab1 = *(const f32x4*)(AA + (size_t)NTOK * 512 + o + 4);
            const f32x4 ka0 = *(const f32x4*)(p.in(40) + lane * 8), ka1 = *(const f32x4*)(p.in(40) + lane * 8 + 4), rk0 = *(const f32x4*)(p.in(41) + lane * 8), rk1 = *(const f32x4*)(p.in(41) + lane * 8 + 4);
            const f32x4 t0 = r0 * rk0 * k0 * (2.0f + (af0 + ab0 - 2.0f) * ka0), t1 = r1 * rk1 * k1 * (2.0f + (af1 + ab1 - 2.0f) * ka1);
            bs = oct_sum((t0[0] + t0[1]) + (t0[2] + t0[3]) + (t1[0] + t1[1]) + (t1[2] + t1[3]));
        }
#else
        const float bs = BON[(size_t)row * 8 + (lane >> 3)] + BON[(size_t)NTOK * 8 + (size_t)row * 8 + (lane >> 3)];
#endif
        const f32x4 y0 = yf0 + yb0, y1 = yf1 + yb1;
        float ss = (y0[0] * y0[0] + y0[1] * y0[1]) + (y0[2] * y0[2] + y0[3] * y0[3]) + (y1[0] * y1[0] + y1[1] * y1[1]) + (y1[2] * y1[2] + y1[3] * y1[3]);
        ss = oct_sum(ss);
        const float rstd = rsqrtf(ss * (1.0f / 64.0f) + EPS);
        const f32x4 o0 = (y0 * rstd * n0 + bs * v0) * g0, o1 = (y1 * rstd * n1 + bs * v1) * g1;
        u32x4 w; w.x = pack2(o0[0], o0[1]); w.y = pack2(o0[2], o0[3]); w.z = pack2(o1[0], o1[1]); w.w = pack2(o1[2], o1[3]);
        *(u32x4*)(OB + (size_t)row * 1024 + 512 + lane * 8) = w;
    }
}

constexpr int NPHASE = 26;
#ifndef PH_ONLY
#define PH_ONLY -1
#endif
#if ONE_LAUNCH
#define SEAM() xcd_barrier(bar)
#else
#define SEAM() do {} while (0)
#endif
#define IN(k) (lo <= (k) && (k) < hi && (PH_ONLY < 0 || (k) == PH_ONLY))
#define END(k) do { if (IN((k) + 1)) SEAM(); } while (0)
#ifndef REP_MASK
#define REP_MASK 0u
#endif
#define REPS(k) for (int rep_ = 0; rep_ < 1 + (int)(((unsigned)REP_MASK >> (k)) & 1u); ++rep_, __syncthreads())

constexpr size_t WS_PARTA = WS_BIG;
constexpr size_t WS_PARTD = WS_U;
static_assert(WS_PARTD + (size_t)2 * NTOK * 1024 * 4 <= WS_ACT, "down-projection slabs overlap ACT");
template <int l>
__device__ __forceinline__ void layer_phases(const Frame& F, const PRef& p, const int lo, const int hi, const XcdBarrier bar) {
    constexpr int pb = 1 + l * 12;
    if (IN(pb + 0)) { REPS(pb + 0) {
        unsigned char* ws = p.ws(); const float* ml = (const float*)(ws + WS_MOD) + (size_t)l * 3 * 6144;
        if (l == 0) phase_norm(F, p.in(0), p.in(1), nullptr, nullptr, nullptr, p.in(12), ml + 1024, ml + 0, (bf16_t*)(ws + WS_HB), true);
        else { float* xbuf = p.out(); phase_norm(F, xbuf, xbuf + (size_t)NCTX * 1024, (const bf16_t*)(ws + WS_PARTD), (const float*)(ws + WS_MOD) + 5120, xbuf, p.in(12) + 1024, ml + 1024, ml + 0, (bf16_t*)(ws + WS_HB), true); }
        } END(pb + 0); }
    if (IN(pb + 1)) { REPS(pb + 1) {
        unsigned char* ws = p.ws();
        if (l == 0) { BigDesc g{(const bf16_t*)(ws + WS_HB), (const bf16_t*)(ws + WS_WAIN), 1024, 1024, 24, 8, 1, 1024}; EpiF32WT E{wt_rsrc(ws + WS_P0, (size_t)NTOK * 2048 * 4), 2048}; gemm_big<false>(F, g, E); if (F.G == 256) cvt_group(F, p, 1, 192, 64, 0); else cvt_group(F, p, 1, 0, F.G, 0); }
        else {
            BigDesc g{(const bf16_t*)(ws + WS_HB), (const bf16_t*)(ws + WS_WBIN), 1024, 1024, 24, 14, 1, 1024}; EpiF32WT E{wt_rsrc(ws + WS_P1, (size_t)NTOK * 3584 * 4), 3584}; gemm_big<false, EpiF32WT, true>(F, g, E);
        }
        } END(pb + 1);
    }
    if (IN(pb + 2)) { REPS(pb + 2) { if (l == 0) phase_l0_tok(F, p); else phase_l1_tok(F, p); } END(pb + 2); }
    if (IN(pb + 3)) { REPS(pb + 3) {
        unsigned char* ws = p.ws();
        if (l == 0) {
            { GemmDesc g{(const bf16_t*)(ws + WS_CQN), (const bf16_t*)(ws + WS_WUQ), 256, 256, NTOK, 768, 256}; EpiF32 E{(float*)(ws + WS_QRAW), 768, 768}; gemm_s(F, g, E, 0); }
            { GemmDesc g{(const bf16_t*)(ws + WS_CKVN), (const bf16_t*)(ws + WS_WUKV), 128, 128, NKROW, 1024, 128}; EpiF32 E{(float*)(ws + WS_KVRAW), 1024, 1024}; gemm_s(F, g, E, 48 * 6); }
            phase_l0_prefix(F, p, 48 * 6 + 56 * 8);
        } else {
            const bf16_t* TW = (const bf16_t*)(ws + WS_TW); const bf16_t* AD = (const bf16_t*)(ws + WS_AD); const bf16_t* SG = (const bf16_t*)(ws + WS_SG);
            float* DEC = (float*)(ws + WS_DEC); float* AA = (float*)(ws + WS_AA);
            { GemmDesc g{TW, (const bf16_t*)(ws + WS_WWUP), 128, 64, NTOK, 512, 64}; EpiDecay E{DEC, p.in(34)}; gemm_s(F, g, E, 0); }
            { GemmDesc g{TW + 64, (const bf16_t*)(ws + WS_WWUP) + 512 * 64, 128, 64, NTOK, 512, 64}; EpiDecay E{DEC + (size_t)NTOK * 512, p.in(34) + 512}; gemm_s(F, g, E, 192); }
            { GemmDesc g{AD, (const bf16_t*)(ws + WS_WAUP), 128, 64, NTOK, 512, 64}; EpiSigm E{AA, p.in(36)}; gemm_s(F, g, E, 384); }
            { GemmDesc g{AD + 64, (const bf16_t*)(ws + WS_WAUP) + 512 * 64, 128, 64, NTOK, 512, 64}; EpiSigm E{AA + (size_t)NTOK * 512, p.in(36) + 512}; gemm_s(F, g, E, 576); }
            { GemmDesc g{SG, (const bf16_t*)(ws + WS_WGUP), 128, 128, NTOK, 512, 128}; EpiF32 E{(float*)(ws + WS_GG), 512, 512}; gemm_s(F, g, E, 768); }
            phase_l1_mix(F, p);
        }
        } END(pb + 3);
    }
    if (l == 0 && IN(pb + 4)) { REPS(pb + 4) { phase_l0_qkv(F, p); } END(pb + 4); }
    if (IN(pb + 5)) { REPS(pb + 5) { if (l == 0) phase_l0_mix(F, p); else {
#if CHUNKED_SCAN
            phase_l1_scanc(F, p);
#else
            phase_l1_scan(F, p);
#endif
        } } END(pb + 5); }
    if (l == 1 && IN(pb + 6)) { REPS(pb + 6) { phase_l1_comb(F, p); } END(pb + 6); }
    if (IN(pb + 7)) { REPS(pb + 7) {
        unsigned char* ws = p.ws();
        BigDesc g{(const bf16_t*)(ws + WS_OB), (const bf16_t*)(ws + WS_WOUT) + (size_t)l * 1024 * 1024, 1024, 1024, 24, 4, 2, 512};
        EpiPartWT E{wt_rsrc(ws + WS_PARTA, (size_t)2 * NTOK * 1024 * 2), (size_t)NTOK * 1024}; gemm_big<true>(F, g, E);
        if (l == 0) { if (F.G == 256) cvt_group(F, p, 3, 192, 64, 0); else cvt_group(F, p, 3, 0, F.G, 0); }
        } END(pb + 7);
    }
    if (IN(pb + 8)) { REPS(pb + 8) {
        unsigned char* ws = p.ws(); const float* ml = (const float*)(ws + WS_MOD) + (size_t)l * 3 * 6144; float* xbuf = p.out();
        const float* xa = l == 0 ? p.in(0) : xbuf; const float* xb = l == 0 ? p.in(1) : xbuf + (size_t)NCTX * 1024;
        phase_norm(F, xa, xb, (const bf16_t*)(ws + WS_PARTA), ml + 2048, xbuf, p.in(13) + l * 1024, ml + 4096, ml + 3072, (bf16_t*)(ws + WS_HB), true); } END(pb + 8); }
    if (IN(pb + 9)) { REPS(pb + 9) {
        unsigned char* ws = p.ws();
        const bf16_t* wup = (const bf16_t*)(ws + WS_WUP) + (size_t)l * 5632 * 1024;
        gemm_upgate(F, (const bf16_t*)(ws + WS_HB), wup, p.in(16) + (size_t)l * 3 * 5632, p.in(17) + (size_t)l * 5632, (bf16_t*)(ws + WS_ACT), (l == 1 && F.G == 256) ? 1 : 0);
        } END(pb + 9);
    }
    if (IN(pb + 11)) { REPS(pb + 11) {
        unsigned char* ws = p.ws();
        BigDesc g{(const bf16_t*)(ws + WS_ACT), (const bf16_t*)(ws + WS_WDN) + (size_t)l * 1024 * 2816, 2816, 2816, 24, 4, 2, 1408};
        if (l == 1 && F.G == 256) {
            unsigned* updone = (unsigned*)(ws + WS_BAR) + UPDONE_WORD;
            if (F.bid < 120) {
                const bf16_t* wup = (const bf16_t*)(ws + WS_WUP) + (size_t)l * 5632 * 1024;
                gemm_upgate(F, (const bf16_t*)(ws + WS_HB), wup, p.in(16) + (size_t)l * 3 * 5632, p.in(17) + (size_t)l * 5632, (bf16_t*)(ws + WS_ACT), 2);
                asm volatile("s_waitcnt vmcnt(0)" ::: "memory");
                __syncthreads();
                if (F.tid == 0) {
                    __builtin_amdgcn_fence(__ATOMIC_RELEASE, "agent");
                    (void)xb_add(updone, 1u);
                    if (F.bid >= 64 && F.bid < 112) { XB_SPIN(xb_ld(updone) < 120u, (unsigned*)(ws + WS_BAR)); __builtin_amdgcn_fence(__ATOMIC_ACQUIRE, "agent"); }
                }
                __syncthreads();
            }
            EpiPartWT E{wt_rsrc(ws + WS_PARTD, (size_t)4 * NTOK * 1024 * 2), (size_t)NTOK * 1024}; gemm_big<true, EpiPartWT, false, 1>(F, g, E);
        } else {
            EpiPartWT E{wt_rsrc(ws + WS_PARTD, (size_t)2 * NTOK * 1024 * 2), (size_t)NTOK * 1024}; gemm_big<true>(F, g, E);
            if (l == 0) { if (F.G == 256) cvt_group(F, p, 2, 192, 64, 0); else cvt_group(F, p, 2, 0, F.G, 0); }
        }
        } END(pb + 11);
    }
}

__global__ void __launch_bounds__(NTHREADS, 2) fwd_kernel(Params kp) {
    extern __shared__ __attribute__((aligned(16))) unsigned char lds_raw[];
    Frame F;
    F.lds = (LAS unsigned char*)lds_raw + LDS_WORK;
    F.tid = threadIdx.x; F.lane = F.tid & 63; F.wave = __builtin_amdgcn_readfirstlane(F.tid >> 6); F.G = gridDim.x; F.bid = blockIdx.x;
    {
        LAS unsigned* pw = (LAS unsigned*)((LAS unsigned char*)lds_raw + 64);
        if (F.tid < (int)(sizeof(Params) / 4)) pw[F.tid] = ((const unsigned*)&kp)[F.tid];
        if (F.tid < 4) ((LAS unsigned*)((LAS unsigned char*)lds_raw))[F.tid] = 0u;
    }
    __syncthreads();
    PRef p; p.w = (const LAS unsigned*)((LAS unsigned char*)lds_raw + 64);
    const int lo = kp.ph_lo, hi = kp.ph_hi;
    XcdBarrier bar; bar.bar = nullptr; bar.x = 0; bar.st = nullptr;
#if ONE_LAUNCH
    bar = xcd_barrier_post((unsigned*)(p.ws() + WS_BAR), (volatile LAS unsigned*)((LAS unsigned char*)lds_raw));
#endif
#ifdef EXTRA_BARS
    for (int i_ = 0; i_ < EXTRA_BARS; ++i_) SEAM();
#endif
    if (IN(0)) { REPS(0) { phase_prep(F, p); } END(0); }
    layer_phases<0>(F, p, lo, hi, bar);
    layer_phases<1>(F, p, lo, hi, bar);
    if (IN(25)) {
        unsigned char* ws = p.ws(); float* xbuf = p.out();
        phase_norm(F, xbuf, xbuf + (size_t)NCTX * 1024, (const bf16_t*)(ws + WS_PARTD), (const float*)(ws + WS_MOD) + 3 * 6144 + 5120, xbuf, nullptr, nullptr, nullptr, nullptr, false, F.G == 256 ? 17 * 256 : NTOK);
    }
}

extern "C" void kernel_launch(void* const* d_in, const int* in_sizes, int n_in, void* d_out, int out_size, void* d_ws, size_t ws_size, hipStream_t stream) {
    static int grid = 0;
    if (grid == 0) {
        if (n_in != 43 || (size_t)out_size != OUT_END || ws_size < WS_END) { fprintf(stderr, "kernel_launch: unexpected shapes: n_in %d out %d ws %zu (need %zu)\n", n_in, out_size, ws_size, (size_t)WS_END); grid = -1; return; }
        int dev = 0, cus = 0, per_cu = 0;
        if (hipGetDevice(&dev) != hipSuccess || hipDeviceGetAttribute(&cus, hipDeviceAttributeMultiprocessorCount, dev) != hipSuccess) { grid = -1; return; }
        if (hipFuncSetAttribute((const void*)fwd_kernel, hipFuncAttributeMaxDynamicSharedMemorySize, LDS_BYTES) != hipSuccess) { fprintf(stderr, "kernel_launch: hipFuncSetAttribute failed\n"); grid = -1; return; }
        if (hipOccupancyMaxActiveBlocksPerMultiprocessor(&per_cu, (const void*)fwd_kernel, NTHREADS, LDS_BYTES) != hipSuccess || per_cu < 1) { fprintf(stderr, "kernel_launch: occupancy query says %d blocks per CU\n", per_cu); grid = -1; (void)hipGetLastError(); return; }
        grid = cus;
    }
    if (grid < 0) return;
    Params p{};
    for (int i = 0; i < 43; ++i) p.in[i] = (const float*)d_in[i];
    p.out = (float*)d_out; p.ws = (unsigned char*)d_ws;
#if ONE_LAUNCH
    (void)hipMemsetAsync((char*)d_ws + WS_BAR, 0, 16384, stream);
    p.ph_lo = 0; p.ph_hi = NPHASE;
    void* args[] = {&p};
    hipError_t e = hipLaunchCooperativeKernel((const void*)fwd_kernel, dim3(grid), dim3(NTHREADS), args, LDS_BYTES, stream);
    if (e != hipSuccess) fprintf(stderr, "cooperative launch failed: %s (grid %d)\n", hipGetErrorString(e), grid);
#else
    for (int ph = 0; ph < NPHASE; ++ph) {
        p.ph_lo = ph; p.ph_hi = ph + 1;
        hipLaunchKernelGGL(fwd_kernel, dim3(grid), dim3(NTHREADS), LDS_BYTES, stream, p);
    }
#endif
}
```

```cpp
#include <hip/hip_runtime.h>
#include <cstdio>
#include <cstdint>

#define LAS __attribute__((address_space(3)))
typedef unsigned short bf16_t;
typedef short bf16x8 __attribute__((ext_vector_type(8)));
typedef short bf16x4 __attribute__((ext_vector_type(4)));
typedef float f32x4 __attribute__((ext_vector_type(4)));
typedef float f32x2 __attribute__((ext_vector_type(2)));
typedef unsigned u32x2 __attribute__((ext_vector_type(2)));
typedef unsigned u32x4 __attribute__((ext_vector_type(4)));

#define REP_MASK 0u
#define ATT_REP 0
#define SCAN_REP 0
#ifndef CHUNKED_SCAN
#define CHUNKED_SCAN 1
#endif
#ifndef ONE_LAUNCH
#define ONE_LAUNCH 1
#endif

constexpr int NTHREADS = 512;
constexpr int LDS_BYTES = 144 * 1024;
constexpr int LDS_WORK = 1024;
constexpr int DM = 1024, NCTX = 4096, NLAT = 2048, NTOK = 6144, NKROW = 7168, DFF = 2816;
constexpr float EPS = 1e-6f;

constexpr size_t al256(size_t x) { return (x + 255) & ~(size_t)255; }
constexpr size_t WS_BAR = 0;
constexpr size_t WS_MOD = WS_BAR + 16384;
constexpr size_t WS_WAIN = al256(WS_MOD + 2 * 3 * 6144 * 4);
constexpr size_t WS_WUQ = WS_WAIN + (size_t)2048 * 1024 * 2;
constexpr size_t WS_WUKV = WS_WUQ + (size_t)768 * 256 * 2;
constexpr size_t WS_WOUT = WS_WUKV + (size_t)1024 * 128 * 2;
constexpr size_t WS_WUP = WS_WOUT + (size_t)2 * 1024 * 1024 * 2;
constexpr size_t WS_WDN = WS_WUP + (size_t)2 * 5632 * 1024 * 2;
constexpr size_t WS_WBIN = WS_WDN + (size_t)2 * 1024 * 2816 * 2;
constexpr size_t WS_WWUP = WS_WBIN + (size_t)3584 * 1024 * 2;
constexpr size_t WS_WAUP = WS_WWUP + (size_t)2 * 512 * 64 * 2;
constexpr size_t WS_WGUP = WS_WAUP + (size_t)2 * 512 * 64 * 2;
constexpr size_t WS_HB = WS_WGUP + (size_t)512 * 128 * 2;
constexpr size_t WS_OB = WS_HB + (size_t)NTOK * 1024 * 2;
constexpr size_t WS_BIG = WS_OB + (size_t)NTOK * 1024 * 2;
constexpr size_t WS_P0 = WS_BIG;
constexpr size_t WS_CQN = WS_P0 + (size_t)NTOK * 2048 * 4;
constexpr size_t WS_CKVN = WS_CQN + (size_t)NTOK * 256 * 2;
constexpr size_t WS_QRAW = WS_CKVN + (size_t)NKROW * 128 * 2;
constexpr size_t WS_KVRAW = WS_QRAW + (size_t)NTOK * 768 * 4;
constexpr size_t WS_Q0 = WS_KVRAW + (size_t)NKROW * 1024 * 4;
constexpr size_t WS_K0 = WS_Q0 + (size_t)NTOK * 768 * 2;
constexpr size_t WS_VT0 = WS_K0 + (size_t)NKROW * 768 * 2;
constexpr size_t WS_KVS = WS_VT0 + (size_t)NKROW * 512 * 2;
constexpr size_t WS_L0END = WS_KVS + (size_t)384 * 2 * 8192 * 4;
constexpr size_t WS_U = WS_BIG;
constexpr size_t WS_ACT = WS_U + (size_t)NTOK * 5632 * 2;
constexpr size_t WS_FFNEND = WS_ACT + (size_t)NTOK * 2816 * 2;
constexpr size_t WS_P1 = WS_BIG;
constexpr size_t WS_DEC = WS_BIG;
constexpr size_t WS_AA = WS_DEC + (size_t)2 * NTOK * 512 * 4;
constexpr size_t WS_GG = WS_AA + (size_t)2 * NTOK * 512 * 4;
constexpr size_t WS_YY = WS_GG + (size_t)NTOK * 512 * 4;
constexpr size_t WS_QD = WS_P1 + (size_t)NTOK * 3584 * 4;
constexpr size_t WS_KD = WS_QD + (size_t)NTOK * 512 * 2;
constexpr size_t WS_VDT = WS_KD + (size_t)NKROW * 512 * 2;
constexpr size_t WS_RR = WS_VDT + (size_t)NKROW * 512 * 2;
constexpr size_t WS_KR = WS_RR + (size_t)NTOK * 512 * 4;
constexpr size_t WS_VV = WS_KR + (size_t)NTOK * 512 * 4;
constexpr size_t WS_KK = WS_VV + (size_t)NTOK * 512 * 4;
constexpr size_t WS_TW = WS_KK + (size_t)NTOK * 512 * 4;
constexpr size_t WS_AD = WS_TW + (size_t)NTOK * 128 * 2;
constexpr size_t WS_SG = WS_AD + (size_t)NTOK * 128 * 2;
constexpr size_t WS_DO = WS_SG + (size_t)NTOK * 128 * 2;
constexpr size_t WS_BON = WS_DO + (size_t)NTOK * 1024 * 2;
constexpr size_t WS_L1END = WS_BON + (size_t)2 * NTOK * 8 * 4;
constexpr size_t cmax(size_t a, size_t b) { return a > b ? a : b; }
constexpr size_t WS_END = cmax(cmax(WS_L0END, WS_FFNEND), WS_L1END);
static_assert(WS_YY + (size_t)2 * NTOK * 512 * 4 <= WS_QD, "layer-1 overlay");
static_assert(WS_END <= (size_t)256 * 1024 * 1024, "workspace exceeds 256 MiB");

constexpr size_t OUT_X = 0;
constexpr size_t OUT_CKV = (size_t)NTOK * 1024;
constexpr size_t OUT_KROPE = OUT_CKV + (size_t)NCTX * 128;
constexpr size_t OUT_SRET = OUT_KROPE + (size_t)NCTX * 32;
constexpr size_t OUT_DK = OUT_SRET + (size_t)16 * 2 * 4 * 8192;
constexpr size_t OUT_DV = OUT_DK + (size_t)NCTX * 512;
constexpr size_t OUT_SRWKV = OUT_DV + (size_t)NCTX * 512;
constexpr size_t OUT_END = OUT_SRWKV + (size_t)16 * 2 * 8 * 4096;

struct Params {
    const float* in[43];
    float* out;
    unsigned char* ws;
    int ph_lo, ph_hi;
};

struct PRef {
    const LAS unsigned* w;
    __device__ __forceinline__ unsigned long long q(int i) const {
        const unsigned lo = (unsigned)__builtin_amdgcn_readfirstlane((int)w[2 * i]), hi = (unsigned)__builtin_amdgcn_readfirstlane((int)w[2 * i + 1]);
        return ((unsigned long long)hi << 32) | lo; }
    __device__ __forceinline__ const float* in(int k) const { return (const float*)(const __attribute__((address_space(1))) float*)q(k); }
    __device__ __forceinline__ float* out() const { return (float*)(__attribute__((address_space(1))) float*)q(43); }
    __device__ __forceinline__ unsigned char* ws() const { return (unsigned char*)(__attribute__((address_space(1))) unsigned char*)q(44); }
};

typedef __bf16 hwbf16x2 __attribute__((ext_vector_type(2)));
__device__ __forceinline__ unsigned pack2(float a, float b) { const f32x2 v = (f32x2){a, b}; return __builtin_bit_cast(unsigned, __builtin_convertvector(v, hwbf16x2)); }
__device__ __forceinline__ bf16_t f2bf(float f) { return (bf16_t)(pack2(f, 0.f) & 0xffffu); }
__device__ __forceinline__ float bf2f(unsigned b) { return __uint_as_float(b << 16); }
#define RDLANE(x, l) __int_as_float(__builtin_amdgcn_readlane(__float_as_int(x), (l)))
#define DPPF(x, ctrl) __int_as_float(__builtin_amdgcn_update_dpp(0, __float_as_int(x), (ctrl), 0xF, 0xF, true))
__device__ __forceinline__ float row16_sum(float v) {
    v += DPPF(v, 0xB1); v += DPPF(v, 0x4E); v += DPPF(v, 0x141); v += DPPF(v, 0x140); return v; }
__device__ __forceinline__ float oct_sum(float v) {
    v += DPPF(v, 0xB1); v += DPPF(v, 0x4E); v += DPPF(v, 0x141); return v; }
__device__ __forceinline__ float wave_sum(float v) {
    v = row16_sum(v);
    return (RDLANE(v, 0) + RDLANE(v, 16)) + (RDLANE(v, 32) + RDLANE(v, 48));
}
__device__ __forceinline__ float half_sum(float v, int lane) {
    v = row16_sum(v);
    const float a = RDLANE(v, 0) + RDLANE(v, 16), b = RDLANE(v, 32) + RDLANE(v, 48);
    return lane < 32 ? a : b;
}
__device__ __forceinline__ float sigmoidf_(float x) { return 1.0f / (1.0f + __expf(-x)); }
__device__ __forceinline__ float siluf_(float x) { return x * sigmoidf_(x); }
__device__ __forceinline__ float tanhf_(float x) { return 1.0f - 2.0f / (__expf(2.0f * x) + 1.0f); }
__device__ __forceinline__ int cond_of(int row) { return row < NCTX ? 0 : 1 + ((row - NCTX) >> 10); }

#define XB_TMO      128
#define XB_XCNT(j)  (256  + 64 * (j))
#define XB_XSUB(j)  (1280 + 64 * (j))
#define XB_XGEN(j)  (2304 + 64 * (j))
#define XB_TOP      3328
#define XB_TOPGEN   3392
#define XCD_BAR_WORDS 3456
#define UPDONE_WORD 3520
#define XB_SPIN_CAP (1u << 20)
__device__ __forceinline__ unsigned xb_ld(unsigned* p) { return __hip_atomic_load(p, __ATOMIC_RELAXED, __HIP_MEMORY_SCOPE_AGENT); }
__device__ __forceinline__ unsigned xb_add(unsigned* p, unsigned v) { return __hip_atomic_fetch_add(p, v, __ATOMIC_RELAXED, __HIP_MEMORY_SCOPE_AGENT); }
__device__ __forceinline__ unsigned xb_xcc_id() { return (unsigned)__builtin_amdgcn_s_getreg((3 << 11) | 20) & 0xFu; }
#define XB_SPIN(cond, bar) do { unsigned _sp = 0; while (cond) { __builtin_amdgcn_s_sleep(1); \
    if ((++_sp & 255u) == 0u) { if (xb_ld(&(bar)[XB_TMO])) break; if (_sp > XB_SPIN_CAP) { atomicAdd(&(bar)[XB_TMO], 1u); break; } } } } while (0)
struct XcdBarrier { unsigned* bar; unsigned x; volatile LAS unsigned* st; };
__device__ __forceinline__ XcdBarrier xcd_barrier_post(unsigned* bar, volatile LAS unsigned* st) {
    XcdBarrier b; b.bar = bar; b.x = xb_xcc_id(); b.st = st;
    if (threadIdx.x == 0) (void)xb_add(&bar[XB_XCNT(b.x)], 1u);
    return b;
}
__device__ __forceinline__ void xcd_barrier_complete(unsigned* bar, unsigned x, unsigned& nloc, unsigned& nx) {
    const unsigned G = gridDim.x * gridDim.y * gridDim.z;
    unsigned sum, cnt, mine, sp = 0u;
    for (;;) {
        sum = 0u; cnt = 0u; mine = 0u;
#pragma unroll
        for (unsigned j = 0; j < 16; ++j) { const unsigned c = xb_ld(&bar[XB_XCNT(j)]); sum += c; cnt += (c > 0u) ? 1u : 0u; mine = (j == x) ? c : mine; }
        if (sum == G) break;
        __builtin_amdgcn_s_sleep(1);
        if ((++sp & 255u) == 0u) { if (xb_ld(&bar[XB_TMO])) break; if (sp > XB_SPIN_CAP) { atomicAdd(&bar[XB_TMO], 1u); break; } }
    }
    nloc = mine > 0u ? mine : 1u; nx = cnt > 0u ? cnt : 1u;
}
__device__ __forceinline__ void xcd_barrier(const XcdBarrier& b) {
    asm volatile("s_waitcnt vmcnt(0)" ::: "memory");
    __syncthreads();
    if (threadIdx.x == 0) {
        unsigned* bar = b.bar;
        __builtin_amdgcn_s_waitcnt(0);
        unsigned nloc = b.st[0], nx = b.st[1];
        if (nloc == 0u) { xcd_barrier_complete(bar, b.x, nloc, nx); b.st[0] = nloc; b.st[1] = nx; }
        const unsigned old = xb_add(&bar[XB_XSUB(b.x)], 1u);
        const unsigned gen = old / nloc;
        if (old + 1u == (gen + 1u) * nloc) {
            __builtin_amdgcn_fence(__ATOMIC_RELEASE, "agent");
            asm volatile("s_waitcnt vmcnt(0)" ::: "memory");
            const unsigned og = xb_add(&bar[XB_TOP], 1u);
            const unsigned tg = og / nx;
            if (og + 1u == (tg + 1u) * nx) xb_add(&bar[XB_TOPGEN], 1u);
            else XB_SPIN(xb_ld(&bar[XB_TOPGEN]) == tg, bar);
            __builtin_amdgcn_fence(__ATOMIC_ACQUIRE, "agent");
            xb_add(&bar[XB_XGEN(b.x)], 1u);
            asm volatile("s_waitcnt vmcnt(0)" ::: "memory");
        } else {
            XB_SPIN(xb_ld(&bar[XB_XGEN(b.x)]) == gen, bar);
            __builtin_amdgcn_fence(__ATOMIC_ACQUIRE, "agent");
            asm volatile("s_waitcnt vmcnt(0)" ::: "memory");
        }
    }
    __syncthreads();
}

struct Frame {
    LAS unsigned char* lds;
    int tid, lane, wave, G, bid;
};
#define FOR_UNITS(u, n, rot) for (int u = (int)((F.bid + F.G - ((rot) % F.G)) % F.G); u < (n); u += F.G)

__device__ __forceinline__ int lds_byte(int r, int c) { const int st = (r >> 4) * 2 + (c >> 5), rr = r & 15, cc = c & 31, ob = rr * 64 + cc * 2; return st * 1024 + (ob ^ (((ob >> 9) & 1) << 5)); }
__device__ __forceinline__ void stage_rc(int b, int& R, int& C) { const int st = b / 1024, sb = b % 1024, swz = sb ^ (((sb >> 9) & 1) << 5); R = (st >> 1) * 16 + swz / 64; C = (st & 1) * 32 + (swz % 64) / 2; }

struct GemmDesc { const bf16_t* A; const bf16_t* Bt; int lda, ldb, M, N, K; };

typedef unsigned u32x4v __attribute__((ext_vector_type(4)));
__device__ __forceinline__ __amdgpu_buffer_rsrc_t wt_rsrc(void* base, size_t bytes) { return __builtin_amdgcn_make_buffer_rsrc(base, 0, (int)bytes, 0x00020000); }
__device__ __forceinline__ void wt_store16(const __amdgpu_buffer_rsrc_t r, size_t byte_off, u32x4 v) { __builtin_amdgcn_raw_buffer_store_b128(v, r, (int)byte_off, 0, 16); }
struct EpiF32 { float* C; int ldc, ncols;
    __device__ __forceinline__ void operator()(int r, int c, f32x4 v, int ks = 0) const { if (c < ncols) *(f32x4*)(C + (size_t)r * ldc + c) = v; } };
struct EpiF32WT { __amdgpu_buffer_rsrc_t R; int ldc;
    __device__ __forceinline__ void operator()(int r, int c, f32x4 v, int ks = 0) const { wt_store16(R, ((size_t)r * ldc + c) * 4, __builtin_bit_cast(u32x4, v)); } };
struct EpiBf16 { bf16_t* C; int ldc, ncols;
    __device__ __forceinline__ void e8(int r, int c, f32x4 v0, f32x4 v1, int ks = 0) const { u32x4 w; w.x = pack2(v0[0], v0[1]); w.y = pack2(v0[2], v0[3]); w.z = pack2(v1[0], v1[1]); w.w = pack2(v1[2], v1[3]); *(u32x4*)(C + (size_t)r * ldc + c) = w; }
    __device__ __forceinline__ void operator()(int r, int c, f32x4 v, int ks = 0) const { if (c < ncols) { u32x2 w; w.x = pack2(v[0], v[1]); w.y = pack2(v[2], v[3]); *(u32x2*)(C + (size_t)r * ldc + c) = w; } } };
struct EpiPart { bf16_t* C; size_t kstride;
    __device__ __forceinline__ void e8(int r, int c, f32x4 v0, f32x4 v1, int ks) const { u32x4 w; w.x = pack2(v0[0], v0[1]); w.y = pack2(v0[2], v0[3]); w.z = pack2(v1[0], v1[1]); w.w = pack2(v1[2], v1[3]);
        *(u32x4*)(C + (size_t)ks * kstride + (size_t)r * 1024 + c) = w; } };
struct EpiBf16WT { __amdgpu_buffer_rsrc_t R; int ldc;
    __device__ __forceinline__ void e8(int r, int c, f32x4 v0, f32x4 v1, int ks = 0) const { u32x4 w; w.x = pack2(v0[0], v0[1]); w.y = pack2(v0[2], v0[3]); w.z = pack2(v1[0], v1[1]); w.w = pack2(v1[2], v1[3]);
        wt_store16(R, ((size_t)r * ldc + c) * 2, w); } };
struct EpiPartWT { __amdgpu_buffer_rsrc_t R; size_t kstride;
    __device__ __forceinline__ void e8(int r, int c, f32x4 v0, f32x4 v1, int ks) const { u32x4 w; w.x = pack2(v0[0], v0[1]); w.y = pack2(v0[2], v0[3]); w.z = pack2(v1[0], v1[1]); w.w = pack2(v1[2], v1[3]);
        wt_store16(R, ((size_t)ks * kstride + (size_t)r * 1024 + c) * 2, w); } };
struct EpiResid { const float* xa; const float* xb; float* xo; const float* gate;
    __device__ __forceinline__ void operator()(int r, int c, f32x4 v, int ks = 0) const {
        const float* xs = r < NCTX ? xa + (size_t)r * 1024 : xb + (size_t)(r - NCTX) * 1024;
        const f32x4 x = *(const f32x4*)(xs + c); const f32x4 g = *(const f32x4*)(gate + cond_of(r) * 6144 + c);
        *(f32x4*)(xo + (size_t)r * 1024 + c) = x + g * v; } };
struct EpiDecay { float* C; const float* w0;
    __device__ __forceinline__ void operator()(int r, int c, f32x4 v, int ks = 0) const { const f32x4 b = *(const f32x4*)(w0 + c); f32x4 o;
#pragma unroll
        for (int j = 0; j < 4; ++j) o[j] = __expf(-0.60653065971f * sigmoidf_(b[j] + v[j]));
        *(f32x4*)(C + (size_t)r * 512 + c) = o; } };
struct EpiSigm { float* C; const float* a0;
    __device__ __forceinline__ void operator()(int r, int c, f32x4 v, int ks = 0) const { const f32x4 b = *(const f32x4*)(a0 + c); f32x4 o;
#pragma unroll
        for (int j = 0; j < 4; ++j) o[j] = sigmoidf_(b[j] + v[j]);
        *(f32x4*)(C + (size_t)r * 512 + c) = o; } };

template <class Epi>
__device__ __forceinline__ void gemm_s(const Frame& F, const GemmDesc g, const Epi& E, int rot, int ufirst = -1, int ustep = 0, int ulast = 0) {
    LAS unsigned char* lds = F.lds;
    const int tid = F.tid, wid = F.wave, lane = F.lane, wr = wid >> 2, wc = wid & 3, fr = lane & 15, fq = lane >> 4;
    const int nM = g.M / 128, nN = g.N / 128, nU = nM * nN, nt = g.K / 64;
    int R0, C0, R1, C1; stage_rc(tid * 16, R0, C0); stage_rc(tid * 16 + 8192, R1, C1);
    const int aoff = lds_byte(wr * 64 + fr, fq * 8), boff = lds_byte(wc * 32 + fr, fq * 8);
    const unsigned ldsw = (unsigned)wid * 1024u;
#define GS_STAGE(buf, t) do { \
        __builtin_amdgcn_global_load_lds((const unsigned*)(Ag + (size_t)R0 * g.lda + (t) * 64 + C0), (LAS unsigned*)(lds + (buf) * 32768 + ldsw), 16, 0, 0); \
        __builtin_amdgcn_global_load_lds((const unsigned*)(Ag + (size_t)R1 * g.lda + (t) * 64 + C1), (LAS unsigned*)(lds + (buf) * 32768 + ldsw + 8192), 16, 0, 0); \
        __builtin_amdgcn_global_load_lds((const unsigned*)(Bg + (size_t)R0 * g.ldb + (t) * 64 + C0), (LAS unsigned*)(lds + (buf) * 32768 + 16384 + ldsw), 16, 0, 0); \
        __builtin_amdgcn_global_load_lds((const unsigned*)(Bg + (size_t)R1 * g.ldb + (t) * 64 + C1), (LAS unsigned*)(lds + (buf) * 32768 + 16384 + ldsw + 8192), 16, 0, 0); } while (0)
    const int u0 = ufirst >= 0 ? ufirst : (int)((F.bid + F.G - (rot % F.G)) % F.G), us = ufirst >= 0 ? ustep : F.G, ue = ufirst >= 0 ? ulast : nU;
    for (int u = u0; u < ue; u += us) {
        const int pm = u % nM, pn = u / nM;
        const bf16_t* Ag = g.A + (size_t)(pm * 128) * g.lda; const bf16_t* Bg = g.Bt + (size_t)(pn * 128) * g.ldb;
        f32x4 acc[4][2];
#pragma unroll
        for (int m = 0; m < 4; ++m)
#pragma unroll
            for (int n = 0; n < 2; ++n) acc[m][n] = (f32x4){0.f, 0.f, 0.f, 0.f};
        GS_STAGE(0, 0);
        if (nt > 1) GS_STAGE(1, 1);
        int b = 0, bn = 2;
        for (int t = 0; t < nt; ++t) {
            if (t + 2 < nt) { GS_STAGE(bn, t + 2); asm volatile("s_waitcnt vmcnt(8)" ::: "memory"); }
            else if (t + 1 < nt) asm volatile("s_waitcnt vmcnt(4)" ::: "memory");
            else asm volatile("s_waitcnt vmcnt(0)" ::: "memory");
            __builtin_amdgcn_s_barrier(); asm volatile("" ::: "memory");
            bf16x8 Af[4][2], Bf[2][2];
#pragma unroll
            for (int m = 0; m < 4; ++m)
#pragma unroll
                for (int k = 0; k < 2; ++k) Af[m][k] = *(const LAS bf16x8*)(lds + b * 32768 + aoff + m * 2048 + k * 1024);
#pragma unroll
            for (int n = 0; n < 2; ++n)
#pragma unroll
                for (int k = 0; k < 2; ++k) Bf[n][k] = *(const LAS bf16x8*)(lds + b * 32768 + 16384 + boff + n * 2048 + k * 1024);
#pragma unroll
            for (int k = 0; k < 2; ++k)
#pragma unroll
                for (int m = 0; m < 4; ++m)
#pragma unroll
                    for (int n = 0; n < 2; ++n) acc[m][n] = __builtin_amdgcn_mfma_f32_16x16x32_bf16(Bf[n][k], Af[m][k], acc[m][n], 0, 0, 0);
            asm volatile("s_waitcnt lgkmcnt(0)" ::: "memory");
            __builtin_amdgcn_s_barrier(); asm volatile("" ::: "memory");
            b = b == 2 ? 0 : b + 1; bn = bn == 2 ? 0 : bn + 1;
        }
#pragma unroll
        for (int m = 0; m < 4; ++m)
#pragma unroll
            for (int n = 0; n < 2; ++n) E(pm * 128 + wr * 64 + m * 16 + fr, pn * 128 + wc * 32 + n * 16 + 4 * fq, acc[m][n]);
    }
#undef GS_STAGE
}

constexpr int HTB = 128 * 64 * 2;
struct BigDesc { const bf16_t* A; const bf16_t* Bt; int lda, ldb, nM, nN, nKS, Ksp; };
struct BUnit { int pm, pn, ks, hm; };
__device__ __forceinline__ bool big_next(const BigDesc& g, int i, int G, int c, BUnit& u) {
    const int nNp = g.nN * g.nKS, nwg = g.nM * nNp;
    const long L = (long)i * G + c; if (L >= nwg) return false;
    int wgid = (int)L; { const int q = nwg / 8, r = nwg % 8, xcd = wgid % 8, off = wgid / 8; wgid = (xcd < r ? xcd * (q + 1) : r * (q + 1) + (xcd - r) * q) + off; }
    const int nig = 8 * nNp, gid = wgid / nig, fm = gid * 8, gsz = (g.nM - fm) < 8 ? (g.nM - fm) : 8;
    u.pm = fm + ((wgid % nig) % gsz); const int pnp = (wgid % nig) / gsz; u.pn = pnp / g.nKS; u.ks = pnp % g.nKS; u.hm = -1; return true;
}
template <bool HALFTAIL>
__device__ __forceinline__ bool big_next_h(const BigDesc& g, int i, int G, int c, BUnit& u) {
    if constexpr (!HALFTAIL) return big_next(g, i, G, c, u);
    else {
        const int nwg = g.nM * g.nN * g.nKS, nfr = nwg / G, rem = nwg - nfr * G;
        if (i < nfr || 2 * rem > G) return big_next(g, i, G, c, u);
        if (i > nfr || c >= 2 * rem) return false;
        big_next(g, nfr, G, c >> 1, u); u.hm = c & 1; return true;
    }
}
__device__ __forceinline__ bool down_merged_unit(int i, int bid, BUnit& u) {
    if (i > 0 || (bid >= 112 && bid < 120)) return false;
    u.hm = -1;
    if (bid >= 120) { const int a = bid - 120, tl = a >> 1; u.ks = a & 1; u.pm = tl >> 2; u.pn = tl & 3; }
    else { const int tl = 68 + (bid >> 2); u.ks = bid & 3; u.pm = tl >> 2; u.pn = tl & 3; }
    return true;
}
__device__ __forceinline__ int down_merged_k0(int bid, int ks) { return bid >= 120 ? ks * 1408 : (ks == 0 ? 0 : (ks == 1 ? 12 : (ks == 2 ? 22 : 34))) * 64; }
__device__ __forceinline__ int down_merged_nt(int bid, int ks) { return bid >= 120 ? 22 : ((ks & 1) ? 10 : 12); }
__device__ __forceinline__ int perm32(int rho) { const int n = rho >> 4, i = rho & 15; return 8 * (i >> 2) + 4 * n + (i & 3); }
template <bool PERM, class Epi, bool HALFTAIL = false, int UMODE = 0>
__device__ __forceinline__ void gemm_big(const Frame& F, const BigDesc g, const Epi& E) {
    LAS unsigned char* lds = F.lds;
    const int tid = F.tid, wid = F.wave, lane = F.lane, wr = wid >> 2, wc = wid & 3, fr = lane & 15, fq = lane >> 4;
    unsigned voffA[2], voffB[2];
#pragma unroll
    for (int i = 0; i < 2; ++i) { int R, C; stage_rc(tid * 16 + i * 8192, R, C); const int Rb = PERM ? ((R & ~31) + perm32(R & 31)) : R; voffA[i] = (unsigned)(R * g.lda + C) * 2u; voffB[i] = (unsigned)(Rb * g.ldb + C) * 2u; }
    const size_t kstep = (size_t)(64 * 2);
    const size_t hstepA = (size_t)128 * g.lda * 2, hstepB = (size_t)128 * g.ldb * 2;
    const unsigned ldsw = (unsigned)wid * 1024u;
    const int aoff = lds_byte(wr * 64 + fr, fq * 8), boff = lds_byte(wc * 32 + fr, fq * 8);
#define PG8_SA(b, h) (((b) * 2 + (h)) * HTB)
#define PG8_SB(b, h) ((4 + (b) * 2 + (h)) * HTB)
#define PG8_STAGE(bufoff, gbase, voff) do { _Pragma("unroll") for (int _i = 0; _i < 2; ++_i) \
        __builtin_amdgcn_global_load_lds((const unsigned*)((const char*)(gbase) + (voff)[_i]), (LAS unsigned*)(lds + (bufoff) + ldsw + _i * 8192), 16, 0, 0); } while (0)
#define PG8_LDA(dst, b, h) do { _Pragma("unroll") for (int m = 0; m < 4; ++m) _Pragma("unroll") for (int k = 0; k < 2; ++k) dst[m][k] = *(const LAS bf16x8*)(lds + PG8_SA(b, h) + aoff + m * 2048 + k * 1024); } while (0)
#define PG8_LDB(dst, b, h) do { _Pragma("unroll") for (int n = 0; n < 2; ++n) _Pragma("unroll") for (int k = 0; k < 2; ++k) dst[n][k] = *(const LAS bf16x8*)(lds + PG8_SB(b, h) + boff + n * 2048 + k * 1024); } while (0)
#define PG8_MMA(ai, bj, At, Bt) do { __builtin_amdgcn_s_setprio(1); _Pragma("unroll") for (int m = 0; m < 4; ++m) _Pragma("unroll") for (int n = 0; n < 2; ++n) _Pragma("unroll") for (int k = 0; k < 2; ++k) \
        acc[ai][bj][m][n] = __builtin_amdgcn_mfma_f32_16x16x32_bf16(Bt[n][k], At[m][k], acc[ai][bj][m][n], 0, 0, 0); __builtin_amdgcn_s_setprio(0); } while (0)
#define PG8_WAIT_V(n) asm volatile("s_waitcnt vmcnt(" #n ")" ::: "memory")
#define PG8_WAIT_L(n) asm volatile("s_waitcnt lgkmcnt(" #n ")" ::: "memory")
#define PG8_BAR __builtin_amdgcn_s_barrier()
#define PG8_SCHED __builtin_amdgcn_sched_barrier(0)
#define PG8_K0(u) (UMODE == 1 ? down_merged_k0(F.bid, (u).ks) : (u).ks * g.Ksp)
#define PG8_UA(u) ((const char*)g.A + (size_t)(u).pm * 2 * hstepA + (size_t)PG8_K0(u) * 2)
#define PG8_UB(u) ((const char*)g.Bt + (size_t)((u).pn * 2 + (HALFTAIL && (u).hm > 0 ? 1 : 0)) * hstepB + (size_t)PG8_K0(u) * 2)
#define PG8_NEXT(i, u) (UMODE == 1 ? down_merged_unit(i, F.bid, u) : big_next_h<HALFTAIL>(g, i, F.G, F.bid, u))
#define PG8_UH(u) ((HALFTAIL && (u).hm >= 0) ? (size_t)0 : hstepB)
    BUnit cur, nxt; int ui = 0;
    if (!PG8_NEXT(0, cur)) return;
    f32x4 acc[2][2][4][2];
#pragma unroll
    for (int a = 0; a < 2; ++a)
#pragma unroll
        for (int b = 0; b < 2; ++b)
#pragma unroll
            for (int m = 0; m < 4; ++m)
#pragma unroll
                for (int n = 0; n < 2; ++n) acc[a][b][m][n] = (f32x4){0.f, 0.f, 0.f, 0.f};
    bf16x8 At[4][2], B0[2][2], B1[2][2];
    const char* cA = PG8_UA(cur); const char* cB = PG8_UB(cur); size_t cH = PG8_UH(cur);
    PG8_STAGE(PG8_SB(0, 0), cB, voffB); PG8_STAGE(PG8_SB(0, 1), cB + cH, voffB); PG8_STAGE(PG8_SA(0, 0), cA, voffA); PG8_STAGE(PG8_SA(0, 1), cA + hstepA, voffA);
    if (wr == 1) PG8_BAR;
    PG8_WAIT_V(2); PG8_BAR;
    PG8_STAGE(PG8_SB(1, 0), cB + kstep, voffB); PG8_STAGE(PG8_SA(1, 0), cA + kstep, voffA); PG8_STAGE(PG8_SB(1, 1), cB + cH + kstep, voffB);
    PG8_WAIT_V(6); PG8_BAR;
    for (;;) {
        const bool has_next = PG8_NEXT(ui + 1, nxt);
        const int nt = UMODE == 1 ? down_merged_nt(F.bid, cur.ks) : g.Ksp / 64;
        const char* nA = has_next ? PG8_UA(nxt) : cA; const char* nB = has_next ? PG8_UB(nxt) : cB; const size_t nH = has_next ? PG8_UH(nxt) : cH;
        const bool full = !HALFTAIL || cur.hm < 0;
        for (int t = 0; t < nt; t += 2) {
            const bool last = (t == nt - 2);
            const char* a1 = cA + (size_t)(t + 1) * kstep;
            const char* a2 = last ? nA : cA + (size_t)(t + 2) * kstep; const char* b2 = last ? nB : cB + (size_t)(t + 2) * kstep;
            const char* a3 = a2 + kstep; const char* b3 = b2 + kstep; const size_t h2 = last ? nH : cH;
            PG8_LDB(B0, 0, 0); PG8_LDB(B1, 0, 1); PG8_SCHED; PG8_LDA(At, 0, 0); PG8_STAGE(PG8_SA(1, 1), a1 + hstepA, voffA);
            PG8_WAIT_V(8); PG8_WAIT_L(0); PG8_BAR; PG8_MMA(0, 0, At, B0); if (full) PG8_MMA(0, 1, At, B1); PG8_BAR; PG8_SCHED;
            PG8_LDA(At, 0, 1); PG8_STAGE(PG8_SB(0, 0), b2, voffB); PG8_STAGE(PG8_SB(0, 1), b2 + h2, voffB); PG8_STAGE(PG8_SA(0, 0), a2, voffA);
            PG8_WAIT_V(8); PG8_WAIT_L(0); PG8_BAR; PG8_MMA(1, 0, At, B0); if (full) PG8_MMA(1, 1, At, B1); PG8_BAR; PG8_SCHED;
            PG8_LDB(B0, 1, 0); PG8_LDB(B1, 1, 1); PG8_SCHED; PG8_LDA(At, 1, 0); PG8_STAGE(PG8_SA(0, 1), a2 + hstepA, voffA);
            PG8_WAIT_V(8); PG8_WAIT_L(0); PG8_BAR; PG8_MMA(0, 0, At, B0); if (full) PG8_MMA(0, 1, At, B1); PG8_BAR; PG8_SCHED;
            PG8_LDA(At, 1, 1); PG8_STAGE(PG8_SB(1, 0), b3, voffB); PG8_STAGE(PG8_SB(1, 1), b3 + h2, voffB); PG8_STAGE(PG8_SA(1, 0), a3, voffA);
            PG8_WAIT_V(8); PG8_WAIT_L(0); PG8_BAR; PG8_MMA(1, 0, At, B0); if (full) PG8_MMA(1, 1, At, B1); PG8_BAR; PG8_SCHED;
        }
        if (wr == 0) PG8_BAR;
        {
            const int row0 = cur.pm * 256 + wr * 64 + fr, col0 = cur.pn * 256 + (HALFTAIL && cur.hm > 0 ? 128 : 0) + wc * 32 + (PERM ? 8 : 4) * fq;
#pragma unroll
            for (int ai = 0; ai < 2; ++ai)
#pragma unroll
                for (int m = 0; m < 4; ++m)
#pragma unroll
                    for (int bj = 0; bj < 2; ++bj) {
                        if (bj == 1 && !full) continue;
                        if constexpr (PERM) E.e8(row0 + ai * 128 + m * 16, col0 + bj * 128, acc[ai][bj][m][0], acc[ai][bj][m][1], cur.ks);
                        else {
#pragma unroll
                            for (int n = 0; n < 2; ++n) E(row0 + ai * 128 + m * 16, col0 + bj * 128 + n * 16, acc[ai][bj][m][n], cur.ks);
                        }
                    }
        }
        if (!has_next) break;
#pragma unroll
        for (int a = 0; a < 2; ++a)
#pragma unroll
            for (int b = 0; b < 2; ++b)
#pragma unroll
                for (int m = 0; m < 4; ++m)
#pragma unroll
                    for (int n = 0; n < 2; ++n) acc[a][b][m][n] = (f32x4){0.f, 0.f, 0.f, 0.f};
        cur = nxt; cA = nA; cB = nB; cH = nH; ++ui;
        if (wr == 1) PG8_BAR;
    }
    PG8_WAIT_V(0);
    PG8_BAR;
#undef PG8_SA
#undef PG8_SB
#undef PG8_STAGE
#undef PG8_LDA
#undef PG8_LDB
#undef PG8_MMA
#undef PG8_WAIT_V
#undef PG8_WAIT_L
#undef PG8_BAR
#undef PG8_SCHED
#undef PG8_UA
#undef PG8_UB
#undef PG8_UH
#undef PG8_NEXT
#undef PG8_K0
}

__device__ __forceinline__ void upgate_tile(int pm, int& rowbase, int& vlo, int& vhi, bool& first, bool& last) {
    if (pm < 16) { rowbase = pm * 256; vlo = 0; vhi = 255; first = true; last = true; return; }
    const int s = (pm - 16) / 5, i = (pm - 16) % 5;
    const int start = i == 0 ? 0 : (i == 1 ? 254 : (i == 2 ? 508 : (i == 3 ? 762 : 768)));
    rowbase = NCTX + s * 1024 + start; first = i == 0; last = i == 4;
    vlo = i == 0 ? 0 : (i == 4 ? 249 : 1); vhi = i == 4 ? 255 : 254;
}
__device__ __forceinline__ void gemm_upgate(const Frame& F, const bf16_t* A, const bf16_t* Bt, const float* cw, const float* cb, bf16_t* ACT, const int mode) {
    LAS unsigned char* lds = F.lds;
    const int tid = F.tid, wid = F.wave, lane = F.lane, wr = wid >> 2, wc = wid & 3, fr = lane & 15, fq = lane >> 4;
    constexpr int K = 1024, nt = K / 64, UP = 528;
    BigDesc g{A, Bt, K, K, 26, 22, 1, K};
    unsigned voffA[2], voffB[2];
#pragma unroll
    for (int i = 0; i < 2; ++i) { int R, C; stage_rc(tid * 16 + i * 8192, R, C); voffA[i] = (unsigned)(R * K + C) * 2u; voffB[i] = voffA[i]; }
    const size_t kstep = (size_t)(64 * 2), hstep = (size_t)128 * K * 2;
    const unsigned ldsw = (unsigned)wid * 1024u;
    const int aoff = lds_byte(wr * 64 + fr, fq * 8), boff = lds_byte(wc * 32 + fr, fq * 8);
#define PG8_SA(b, h) (((b) * 2 + (h)) * HTB)
#define PG8_SB(b, h) ((4 + (b) * 2 + (h)) * HTB)
#define PG8_STAGE(bufoff, gbase, voff) do { _Pragma("unroll") for (int _i = 0; _i < 2; ++_i) \
        __builtin_amdgcn_global_load_lds((const unsigned*)((const char*)(gbase) + (voff)[_i]), (LAS unsigned*)(lds + (bufoff) + ldsw + _i * 8192), 16, 0, 0); } while (0)
#define PG8_LDA(dst, b, h) do { _Pragma("unroll") for (int m = 0; m < 4; ++m) _Pragma("unroll") for (int k = 0; k < 2; ++k) dst[m][k] = *(const LAS bf16x8*)(lds + PG8_SA(b, h) + aoff + m * 2048 + k * 1024); } while (0)
#define PG8_LDB(dst, b, h) do { _Pragma("unroll") for (int n = 0; n < 2; ++n) _Pragma("unroll") for (int k = 0; k < 2; ++k) dst[n][k] = *(const LAS bf16x8*)(lds + PG8_SB(b, h) + boff + n * 2048 + k * 1024); } while (0)
#define PG8_MMA(ai, bj, At, Bt_) do { __builtin_amdgcn_s_setprio(1); _Pragma("unroll") for (int m = 0; m < 4; ++m) _Pragma("unroll") for (int n = 0; n < 2; ++n) _Pragma("unroll") for (int k = 0; k < 2; ++k) \
        acc[ai][bj][m][n] = __builtin_amdgcn_mfma_f32_16x16x32_bf16(Bt_[n][k], At[m][k], acc[ai][bj][m][n], 0, 0, 0); __builtin_amdgcn_s_setprio(0); } while (0)
#define PG8_WAIT_V(n) asm volatile("s_waitcnt vmcnt(" #n ")" ::: "memory")
#define PG8_WAIT_L(n) asm volatile("s_waitcnt lgkmcnt(" #n ")" ::: "memory")
#define PG8_BAR __builtin_amdgcn_s_barrier()
#define PG8_SCHED __builtin_amdgcn_sched_barrier(0)
    for (int ui = 0;; ++ui) {
        BUnit cur;
        int hm = -1;
        if (mode == 0) {
            if (F.G == 256 && ui == 2) { if (F.bid >= 120 || !big_next(g, 2, F.G, F.bid >> 1, cur)) break; hm = F.bid & 1; }
            else if (!big_next(g, ui, F.G, F.bid, cur)) break;
        } else if (mode == 1) {
            if (ui >= 2) break;
            BigDesc g23 = g; g23.nM = 23;
            if (!big_next(g23, ui, 256, F.bid, cur)) { cur.pm = 23; cur.pn = ui * 256 + F.bid - 506; }
        } else {
            if (ui >= 1 || F.bid >= 120) break;
            const int j = (F.bid >> 1) + 6; cur.pm = 23 + j / 22; cur.pn = j % 22; hm = F.bid & 1;
        }
        unsigned voffBh[2];
#pragma unroll
        for (int i = 0; i < 2; ++i) { int R, C; stage_rc(tid * 16 + i * 8192, R, C); const int Rs = hm < 0 ? R : R + 64 * hm + (R >= 64 ? 64 : 0); voffBh[i] = (unsigned)(Rs * K + C) * 2u; }
        int rowbase; { int a_, b_; bool c_, d_; upgate_tile(cur.pm, rowbase, a_, b_, c_, d_); }
        f32x4 acc[2][2][4][2];
#pragma unroll
        for (int a = 0; a < 2; ++a)
#pragma unroll
            for (int b = 0; b < 2; ++b)
#pragma unroll
                for (int m = 0; m < 4; ++m)
#pragma unroll
                    for (int n = 0; n < 2; ++n) acc[a][b][m][n] = (f32x4){0.f, 0.f, 0.f, 0.f};
        bf16x8 At[4][2], B0[2][2], B1[2][2];
        const char* cA = (const char*)A + (size_t)rowbase * K * 2; const char* cB = (const char*)Bt + (size_t)cur.pn * 2 * hstep;
        PG8_STAGE(PG8_SB(0, 0), cB, voffBh); PG8_STAGE(PG8_SB(0, 1), cB + hstep, voffB); PG8_STAGE(PG8_SA(0, 0), cA, voffA); PG8_STAGE(PG8_SA(0, 1), cA + hstep, voffA);
        if (wr == 1) PG8_BAR;
        PG8_WAIT_V(2); PG8_BAR;
        PG8_STAGE(PG8_SB(1, 0), cB + kstep, voffBh); PG8_STAGE(PG8_SA(1, 0), cA + kstep, voffA); PG8_STAGE(PG8_SB(1, 1), cB + hstep + kstep, voffB);
        PG8_WAIT_V(6); PG8_BAR;
        for (int t = 0; t < nt; t += 2) {
            const bool last = (t == nt - 2);
            const char* a1 = cA + (size_t)(t + 1) * kstep;
            const char* a2 = last ? cA : cA + (size_t)(t + 2) * kstep; const char* b2 = last ? cB : cB + (size_t)(t + 2) * kstep;
            const char* a3 = a2 + kstep; const char* b3 = b2 + kstep;
            PG8_LDB(B0, 0, 0); PG8_LDB(B1, 0, 1); PG8_SCHED; PG8_LDA(At, 0, 0); PG8_STAGE(PG8_SA(1, 1), a1 + hstep, voffA);
            PG8_WAIT_V(8); PG8_WAIT_L(0); PG8_BAR; PG8_MMA(0, 0, At, B0); if (hm < 0) PG8_MMA(0, 1, At, B1); PG8_BAR; PG8_SCHED;
            PG8_LDA(At, 0, 1); PG8_STAGE(PG8_SB(0, 0), b2, voffBh); PG8_STAGE(PG8_SB(0, 1), b2 + hstep, voffB); PG8_STAGE(PG8_SA(0, 0), a2, voffA);
            PG8_WAIT_V(8); PG8_WAIT_L(0); PG8_BAR; PG8_MMA(1, 0, At, B0); if (hm < 0) PG8_MMA(1, 1, At, B1); PG8_BAR; PG8_SCHED;
            PG8_LDB(B0, 1, 0); PG8_LDB(B1, 1, 1); PG8_SCHED; PG8_LDA(At, 1, 0); PG8_STAGE(PG8_SA(0, 1), a2 + hstep, voffA);
            PG8_WAIT_V(8); PG8_WAIT_L(0); PG8_BAR; PG8_MMA(0, 0, At, B0); if (hm < 0) PG8_MMA(0, 1, At, B1); PG8_BAR; PG8_SCHED;
            PG8_LDA(At, 1, 1); PG8_STAGE(PG8_SB(1, 0), b3, voffBh); PG8_STAGE(PG8_SB(1, 1), b3 + hstep, voffB); PG8_STAGE(PG8_SA(1, 0), a3, voffA);
            PG8_WAIT_V(8); PG8_WAIT_L(0); PG8_BAR; PG8_MMA(1, 0, At, B0); if (hm < 0) PG8_MMA(1, 1, At, B1); PG8_BAR; PG8_SCHED;
        }
        if (wr == 0) PG8_BAR;
        PG8_WAIT_V(0); PG8_BAR;
        asm volatile("" ::: "memory");
#pragma unroll
        for (int ai = 0; ai < 2; ++ai)
#pragma unroll
            for (int m = 0; m < 4; ++m)
#pragma unroll
                for (int bj = 0; bj < 2; ++bj)
#pragma unroll
                    for (int n = 0; n < 2; ++n) {
                        if (bj == 1 && hm >= 0) continue;
                        const f32x4 v = acc[ai][bj][m][n]; u32x2 w; w.x = pack2(v[0], v[1]); w.y = pack2(v[2], v[3]);
                        *(LAS u32x2*)(lds + (ai * 128 + wr * 64 + m * 16 + fr) * UP + (bj * 128 + wc * 32 + n * 16 + 4 * fq) * 2) = w;
                    }
        __syncthreads();
        __builtin_amdgcn_sched_barrier(0);
        int vlo, vhi; { int rb_; bool c_, d_; upgate_tile(cur.pm, rb_, vlo, vhi, c_, d_); }
        {
            const int c = hm < 0 ? (tid & 15) * 8 : (tid & 7) * 8, r0 = hm < 0 ? (tid >> 4) * 8 : (tid >> 3) * 4, nrow = hm < 0 ? 8 : 4, boffc = hm < 0 ? 128 : 64;
            const int ca = cur.pn * 128 + (hm < 0 ? 0 : 64 * hm) + c, cbn = 2816 + ca;
            float wa[3][8], wb[3][8], ba8[8], bb8[8];
#pragma unroll
            for (int q = 0; q < 2; ++q) {
#pragma unroll
                for (int tp = 0; tp < 3; ++tp) {
                    const f32x4 x = *(const f32x4*)(cw + tp * 5632 + ca + q * 4), y = *(const f32x4*)(cw + tp * 5632 + cbn + q * 4);
#pragma unroll
                    for (int jj = 0; jj < 4; ++jj) { wa[tp][q * 4 + jj] = x[jj]; wb[tp][q * 4 + jj] = y[jj]; }
                }
                const f32x4 x = *(const f32x4*)(cb + ca + q * 4), y = *(const f32x4*)(cb + cbn + q * 4);
#pragma unroll
                for (int jj = 0; jj < 4; ++jj) { ba8[q * 4 + jj] = x[jj]; bb8[q * 4 + jj] = y[jj]; }
            }
            const bf16x8 z = (bf16x8){0, 0, 0, 0, 0, 0, 0, 0};
            bf16x8 ap, bp, ac, bc, an, bn;
            {
                const bool hp0 = r0 > 0;
                ap = hp0 ? *(const LAS bf16x8*)(lds + (r0 - 1) * UP + c * 2) : z; bp = hp0 ? *(const LAS bf16x8*)(lds + (r0 - 1) * UP + (boffc + c) * 2) : z;
                ac = *(const LAS bf16x8*)(lds + r0 * UP + c * 2); bc = *(const LAS bf16x8*)(lds + r0 * UP + (boffc + c) * 2);
            }
#pragma unroll 1
            for (int i = 0; i < nrow; ++i) {
                const int r = r0 + i;
                const bool hn = r < 255;
                an = hn ? *(const LAS bf16x8*)(lds + (r + 1) * UP + c * 2) : z; bn = hn ? *(const LAS bf16x8*)(lds + (r + 1) * UP + (boffc + c) * 2) : z;
                if (r >= vlo && r <= vhi) {
                    float ov[8];
#pragma unroll
                    for (int e = 0; e < 8; ++e) {
                        const float ua = bf2f((unsigned short)ap[e]) * wa[0][e] + bf2f((unsigned short)ac[e]) * wa[1][e] + bf2f((unsigned short)an[e]) * wa[2][e] + ba8[e];
                        const float ub = bf2f((unsigned short)bp[e]) * wb[0][e] + bf2f((unsigned short)bc[e]) * wb[1][e] + bf2f((unsigned short)bn[e]) * wb[2][e] + bb8[e];
                        ov[e] = siluf_(ua) * ub;
                    }
                    u32x4 w; w.x = pack2(ov[0], ov[1]); w.y = pack2(ov[2], ov[3]); w.z = pack2(ov[4], ov[5]); w.w = pack2(ov[6], ov[7]);
                    *(u32x4*)(ACT + (size_t)(rowbase + r) * 2816 + ca) = w;
                }
                ap = ac; bp = bc; ac = an; bc = bn;
            }
        }
        __syncthreads();
    }
#undef PG8_SA
#undef PG8_SB
#undef PG8_STAGE
#undef PG8_LDA
#undef PG8_LDB
#undef PG8_MMA
#undef PG8_WAIT_V
#undef PG8_WAIT_L
#undef PG8_BAR
#undef PG8_SCHED
}

struct CvtJob { const float* src; bf16_t* dst; int K, N, Npad, tiles, upperm; };
template <int NT>
__device__ __forceinline__ void cvt_run(const Frame& F, const CvtJob& j, int t0, int nb) {
    LAS float* tiles = (LAS float*)F.lds;
    const int tk = j.K / 64, tid = F.tid;
    const int r = tid >> 4, c4 = (tid & 15) * 4, n = tid >> 3, kq = (tid & 7) * 8;
    f32x4 v[NT][2];
#define CVT_LOAD(tb) do { _Pragma("unroll") for (int q = 0; q < NT; ++q) { const int t = (tb) + q * nb; \
        _Pragma("unroll") for (int i = 0; i < 2; ++i) { v[q][i] = (f32x4){0.f, 0.f, 0.f, 0.f}; \
            if (t < j.tiles) { const int k0 = (t % tk) * 64, n0 = (t / tk) * 64; if (n0 + c4 < j.N) v[q][i] = *(const f32x4*)(j.src + (size_t)(k0 + r + 32 * i) * j.N + n0 + c4); } } } } while (0)
    CVT_LOAD(t0);
    for (int tb = t0; tb < j.tiles; tb += NT * nb) {
#pragma unroll
        for (int q = 0; q < NT; ++q)
#pragma unroll
            for (int i = 0; i < 2; ++i) { LAS float* tp = tiles + q * (64 * 65) + (r + 32 * i) * 65 + c4; tp[0] = v[q][i][0]; tp[1] = v[q][i][1]; tp[2] = v[q][i][2]; tp[3] = v[q][i][3]; }
        __syncthreads();
        CVT_LOAD(tb + NT * nb);
#pragma unroll
        for (int q = 0; q < NT; ++q) {
            const int t = tb + q * nb;
            if (t < j.tiles) {
                const int k0 = (t % tk) * 64, n0 = (t / tk) * 64;
                const LAS float* tile = tiles + q * (64 * 65);
                u32x4 w;
                w.x = pack2(tile[(kq + 0) * 65 + n], tile[(kq + 1) * 65 + n]); w.y = pack2(tile[(kq + 2) * 65 + n], tile[(kq + 3) * 65 + n]);
                w.z = pack2(tile[(kq + 4) * 65 + n], tile[(kq + 5) * 65 + n]); w.w = pack2(tile[(kq + 6) * 65 + n], tile[(kq + 7) * 65 + n]);
                const int drow = j.upperm ? (n0 < 2816 ? (n0 >> 7) * 256 + (n0 & 127) : ((n0 - 2816) >> 7) * 256 + 128 + ((n0 - 2816) & 127)) + n : n0 + n;
                *(u32x4*)(j.dst + (size_t)drow * j.K + k0 + kq) = w;
            }
        }
        __syncthreads();
    }
#undef CVT_LOAD
}

__device__ __forceinline__ void cvt_group(const Frame& F, const PRef& p, int group, int bfirst, int nb, int rot0) {
    if (F.bid < bfirst || F.bid >= bfirst + nb) return;
    unsigned char* ws = p.ws();
    const int vb = F.bid - bfirst;
    int rot = rot0;
#define CVT(srcp, dstoff, K_, N_, Npad_) do { CvtJob jb; jb.src = (srcp); jb.dst = (bf16_t*)(ws + (dstoff)); jb.K = (K_); jb.N = (N_); jb.Npad = (Npad_); jb.tiles = ((K_) / 64) * ((Npad_) / 64); jb.upperm = ((N_) == 5632); \
        cvt_run<4>(F, jb, (vb + nb - (rot % nb)) % nb, nb); rot += jb.tiles; } while (0)
    if (group == 0) {
        CVT(p.in(19), WS_WAIN, 1024, 1952, 2048);
        CVT(p.in(22), WS_WUQ, 256, 768, 768);
        CVT(p.in(23), WS_WUKV, 128, 1024, 1024);
    } else if (group == 1) {
        CVT(p.in(14), WS_WOUT, 1024, 1024, 1024);
        CVT(p.in(15), WS_WUP, 1024, 5632, 5632);
    } else if (group == 3) {
        CVT(p.in(18), WS_WDN, 2816, 1024, 1024);
    } else {
        CVT(p.in(28), WS_WBIN, 1024, 3456, 3584);
        CVT(p.in(14) + (size_t)1024 * 1024, WS_WOUT + (size_t)1024 * 1024 * 2, 1024, 1024, 1024);
        CVT(p.in(15) + (size_t)1024 * 5632, WS_WUP + (size_t)5632 * 1024 * 2, 1024, 5632, 5632);
        CVT(p.in(18) + (size_t)2816 * 1024, WS_WDN + (size_t)1024 * 2816 * 2, 2816, 1024, 1024);
        CVT(p.in(35), WS_WWUP, 64, 512, 512);
        CVT(p.in(35) + 64 * 512, WS_WWUP + 512 * 64 * 2, 64, 512, 512);
        CVT(p.in(37), WS_WAUP, 64, 512, 512);
        CVT(p.in(37) + 64 * 512, WS_WAUP + 512 * 64 * 2, 64, 512, 512);
        CVT(p.in(38), WS_WGUP, 128, 512, 512);
    }
#undef CVT
}
__device__ __forceinline__ void phase_prep(const Frame& F, const PRef& p) {
    unsigned char* ws = p.ws();
    {
        LAS float* sc = (LAS float*)F.lds;
        LAS float* red = sc + 3 * 1024;
        for (int i = F.tid; i < 3 * 1024; i += NTHREADS) {
            const int c = i >> 10, k = i & 1023;
            const float v = c == 0 ? p.in(9)[k] : p.in(8)[(c - 1) * 1024 + k];
            sc[i] = siluf_(v);
        }
        __syncthreads();
        float* mod = (float*)(ws + WS_MOD);
        FOR_UNITS(u, 192, 0) {
            const int l = u / 96, n0 = (u % 96) * 64, col = F.tid & 63, kg = F.tid >> 6;
            const float* w = p.in(10) + (size_t)l * 1024 * 6144 + (size_t)(kg * 128) * 6144 + n0 + col;
            float a0 = 0.f, a1 = 0.f, a2 = 0.f;
#pragma unroll 8
            for (int k = 0; k < 128; ++k) { const float wv = w[(size_t)k * 6144]; const int kk = kg * 128 + k; a0 += sc[kk] * wv; a1 += sc[1024 + kk] * wv; a2 += sc[2048 + kk] * wv; }
            red[(kg * 3 + 0) * 64 + col] = a0; red[(kg * 3 + 1) * 64 + col] = a1; red[(kg * 3 + 2) * 64 + col] = a2;
            __syncthreads();
            if (F.tid < 192) {
                const int c = F.tid >> 6, cc = F.tid & 63; float s = 0.f;
#pragma unroll
                for (int q = 0; q < 8; ++q) s += red[(q * 3 + c) * 64 + cc];
                mod[(size_t)(l * 3 + c) * 6144 + n0 + cc] = s + p.in(11)[l * 6144 + n0 + cc];
            }
            __syncthreads();
        }
    }
    cvt_group(F, p, 0, 0, F.G, 192);
}

__device__ __forceinline__ void phase_norm(const Frame& F, const float* xa, const float* xb, const bf16_t* part, const float* gate, float* xout,
                                           const float* g, const float* sc, const float* sh, bf16_t* hb, bool do_norm, const int q4row = NTOK) {
    const int nw = F.G * 8;
    for (int row = F.bid * 8 + F.wave; row < NTOK; row += nw) {
        const float* x = row < NCTX ? xa + (size_t)row * 1024 : xb + (size_t)(row - NCTX) * 1024;
        const int c = cond_of(row);
        f32x4 v[4]; float ss = 0.f;
#pragma unroll
        for (int i = 0; i < 4; ++i) {
            const int col = i * 256 + F.lane * 4;
            v[i] = *(const f32x4*)(x + col);
            if (part) {
                const u32x2 q0 = *(const u32x2*)(part + (size_t)row * 1024 + col), q1 = *(const u32x2*)(part + (size_t)NTOK * 1024 + (size_t)row * 1024 + col);
                f32x4 ps = (f32x4){bf2f(q0.x & 0xffffu) + bf2f(q1.x & 0xffffu), bf2f(q0.x >> 16) + bf2f(q1.x >> 16), bf2f(q0.y & 0xffffu) + bf2f(q1.y & 0xffffu), bf2f(q0.y >> 16) + bf2f(q1.y >> 16)};
                if (row >= q4row) {
                    const u32x2 q2 = *(const u32x2*)(part + (size_t)2 * NTOK * 1024 + (size_t)row * 1024 + col), q3 = *(const u32x2*)(part + (size_t)3 * NTOK * 1024 + (size_t)row * 1024 + col);
                    ps = ps + (f32x4){bf2f(q2.x & 0xffffu) + bf2f(q3.x & 0xffffu), bf2f(q2.x >> 16) + bf2f(q3.x >> 16), bf2f(q2.y & 0xffffu) + bf2f(q3.y & 0xffffu), bf2f(q2.y >> 16) + bf2f(q3.y >> 16)};
                }
                const f32x4 gt = *(const f32x4*)(gate + c * 6144 + col);
                v[i] = v[i] + gt * ps;
                *(f32x4*)(xout + (size_t)row * 1024 + col) = v[i];
            }
            ss += v[i][0] * v[i][0] + v[i][1] * v[i][1] + v[i][2] * v[i][2] + v[i][3] * v[i][3];
        }
        if (!do_norm) continue;
        ss = wave_sum(ss);
        const float rstd = rsqrtf(ss * (1.0f / 1024.0f) + EPS);
#pragma unroll
        for (int i = 0; i < 4; ++i) {
            const int col = i * 256 + F.lane * 4;
            const f32x4 gg = *(const f32x4*)(g + col), s1 = *(const f32x4*)(sc + c * 6144 + col), s0 = *(const f32x4*)(sh + c * 6144 + col);
            f32x4 h;
#pragma unroll
            for (int j = 0; j < 4; ++j) h[j] = v[i][j] * rstd * gg[j] * (1.0f + s1[j]) + s0[j];
            u32x2 w; w.x = pack2(h[0], h[1]); w.y = pack2(h[2], h[3]);
            *(u32x2*)(hb + (size_t)row * 1024 + col) = w;
        }
    }
}

__device__ __forceinline__ void seq_of_unit384(int u, int& s, int& c, int& h, int& tok0, int& nc) {
    if (u < 256) { s = u >> 4; c = (u >> 2) & 3; h = u & 3; tok0 = s * 256 + c * 64; nc = 4; }
    else { const int v = u - 256; s = 16 + (v >> 6); c = (v >> 2) & 15; h = v & 3; tok0 = NCTX + (s - 16) * 1024 + c * 64; nc = 16; }
}
__device__ __forceinline__ void phase_l0_tok(const Frame& F, const PRef& p) {
    unsigned char* ws = p.ws();
    const float* P = (const float*)(ws + WS_P0);
    bf16_t* cqn = (bf16_t*)(ws + WS_CQN); bf16_t* ckvn = (bf16_t*)(ws + WS_CKVN);
    const int nw = F.G * 8;
    for (int row = F.bid * 8 + F.wave; row < NKROW; row += nw) {
        if (row < NTOK) {
            const float* pr = P + (size_t)row * 2048;
            const f32x4 q = *(const f32x4*)(pr + F.lane * 4);
            float ss = wave_sum(q[0] * q[0] + q[1] * q[1] + q[2] * q[2] + q[3] * q[3]);
            float rstd = rsqrtf(ss * (1.0f / 256.0f) + EPS);
            const f32x4 gq = *(const f32x4*)(p.in(20) + F.lane * 4);
            u32x2 w; w.x = pack2(q[0] * rstd * gq[0], q[1] * rstd * gq[1]); w.y = pack2(q[2] * rstd * gq[2], q[3] * rstd * gq[3]);
            *(u32x2*)(cqn + (size_t)row * 256 + F.lane * 4) = w;
            const f32x2 kv = *(const f32x2*)(pr + 256 + F.lane * 2);
            ss = wave_sum(kv[0] * kv[0] + kv[1] * kv[1]);
            rstd = rsqrtf(ss * (1.0f / 128.0f) + EPS);
            const f32x2 gk = *(const f32x2*)(p.in(21) + F.lane * 2);
            const float o0 = kv[0] * rstd * gk[0], o1 = kv[1] * rstd * gk[1];
            *(unsigned*)(ckvn + (size_t)row * 128 + F.lane * 2) = pack2(o0, o1);
            if (row < NCTX) {
                *(f32x2*)(p.out() + OUT_CKV + (size_t)row * 128 + F.lane * 2) = (f32x2){o0, o1};
                if (F.lane < 32) p.out()[OUT_KROPE + (size_t)row * 32 + F.lane] = pr[384 + F.lane];
            }
        } else {
            const int i = row - NTOK;
            const f32x2 kv = *(const f32x2*)(p.in(2) + (size_t)i * 128 + F.lane * 2);
            *(unsigned*)(ckvn + (size_t)row * 128 + F.lane * 2) = pack2(kv[0], kv[1]);
        }
    }
    {
        LAS unsigned char* L = F.lds;
        constexpr int KPI = 160, VPI = 288, O_KF = 0, O_KB = 64 * KPI, O_V = 2 * 64 * KPI;
        float* KVS = (float*)(ws + WS_KVS);
        const int tid = F.tid, w = F.wave, fr = F.lane & 15, fq = F.lane >> 4;
        FOR_UNITS(u, 384, 0) {
            int s, c, h, tok0, nc; seq_of_unit384(u, s, c, h, tok0, nc);
            const float lgf = __logf(sigmoidf_(p.in(26)[h])), lgb = __logf(sigmoidf_(p.in(26)[4 + h]));
            {
                const int row = tid >> 3, ch = tid & 7;
                const float* pr = P + (size_t)(tok0 + row) * 2048;
                const f32x4 k0 = *(const f32x4*)(pr + 672 + h * 64 + ch * 8), k1 = *(const f32x4*)(pr + 672 + h * 64 + ch * 8 + 4);
                f32x4 vv[4];
#pragma unroll
                for (int i = 0; i < 4; ++i) vv[i] = *(const f32x4*)(pr + 928 + h * 128 + ch * 16 + i * 4);
                const float df = 0.125f * __expf(lgf * (float)(63 - row)), db = 0.125f * __expf(lgb * (float)row);
                u32x4 t;
                t.x = pack2(k0[0] * df, k0[1] * df); t.y = pack2(k0[2] * df, k0[3] * df); t.z = pack2(k1[0] * df, k1[1] * df); t.w = pack2(k1[2] * df, k1[3] * df); *(LAS u32x4*)(L + O_KF + row * KPI + ch * 16) = t;
                t.x = pack2(k0[0] * db, k0[1] * db); t.y = pack2(k0[2] * db, k0[3] * db); t.z = pack2(k1[0] * db, k1[1] * db); t.w = pack2(k1[2] * db, k1[3] * db); *(LAS u32x4*)(L + O_KB + row * KPI + ch * 16) = t;
#pragma unroll
                for (int i = 0; i < 2; ++i) { t.x = pack2(vv[2 * i][0], vv[2 * i][1]); t.y = pack2(vv[2 * i][2], vv[2 * i][3]); t.z = pack2(vv[2 * i + 1][0], vv[2 * i + 1][1]); t.w = pack2(vv[2 * i + 1][2], vv[2 * i + 1][3]);
                    *(LAS u32x4*)(L + O_V + row * VPI + ch * 32 + i * 16) = t; }
            }
            __syncthreads();
            bf16x8 Bf[2];
#pragma unroll
            for (int ks = 0; ks < 2; ++ks) {
                const LAS unsigned char* vp = L + O_V + (32 * ks + 8 * fq + (fr >> 2)) * VPI + (w * 16 + 4 * (fr & 3)) * 2;
                const bf16x4 v0 = __builtin_amdgcn_ds_read_tr16_b64_v4i16((LAS bf16x4*)vp), v1 = __builtin_amdgcn_ds_read_tr16_b64_v4i16((LAS bf16x4*)(vp + 4 * VPI));
                bf16x8 x; x[0] = v0[0]; x[1] = v0[1]; x[2] = v0[2]; x[3] = v0[3]; x[4] = v1[0]; x[5] = v1[1]; x[6] = v1[2]; x[7] = v1[3]; Bf[ks] = x;
            }
            float* o = KVS + (size_t)u * 2 * 8192;
#pragma unroll
            for (int d = 0; d < 2; ++d)
#pragma unroll
                for (int et = 0; et < 4; ++et) {
                    f32x4 a = (f32x4){0.f, 0.f, 0.f, 0.f};
#pragma unroll
                    for (int ks = 0; ks < 2; ++ks) {
                        const LAS unsigned char* kp = L + (d ? O_KB : O_KF) + (32 * ks + 8 * fq + (fr >> 2)) * KPI + (et * 16 + 4 * (fr & 3)) * 2;
                        const bf16x4 v0 = __builtin_amdgcn_ds_read_tr16_b64_v4i16((LAS bf16x4*)kp), v1 = __builtin_amdgcn_ds_read_tr16_b64_v4i16((LAS bf16x4*)(kp + 4 * KPI));
                        bf16x8 x; x[0] = v0[0]; x[1] = v0[1]; x[2] = v0[2]; x[3] = v0[3]; x[4] = v1[0]; x[5] = v1[1]; x[6] = v1[2]; x[7] = v1[3];
                        a = __builtin_amdgcn_mfma_f32_16x16x32_bf16(x, Bf[ks], a, 0, 0, 0);
                    }
#pragma unroll
                    for (int r = 0; r < 4; ++r) o[d * 8192 + (et * 16 + 4 * fq + r) * 128 + w * 16 + fr] = a[r];
                }
            __syncthreads();
        }
    }
}

__device__ __forceinline__ void phase_l0_prefix(const Frame& F, const PRef& p, int rot) {
    float* KVS = (float*)(p.ws() + WS_KVS);
    FOR_UNITS(u, 576, rot) {
        const int qd = u & 3, d = (u >> 2) & 1, h = (u >> 3) & 3, s = u >> 5;
        const int nc = s < 16 ? 4 : 16;
        const int ubase = s < 16 ? s * 16 + h : 256 + (s - 16) * 64 + h;
        const float g64 = __expf(64.0f * __logf(sigmoidf_(p.in(26)[d * 4 + h])));
        const int i = qd * 2048 + F.tid * 4;
        float* base = KVS + (size_t)ubase * 16384 + d * 8192 + i;
        f32x4 kv[16];
#pragma unroll
        for (int c = 0; c < 16; ++c) if (c < nc) kv[c] = *(const f32x4*)(base + (size_t)c * 4 * 16384);
        f32x4 S = (f32x4){0.f, 0.f, 0.f, 0.f};
        if (s >= 16) S = *(const f32x4*)(p.in(4) + (size_t)(((s - 16) * 2 + d) * 4 + h) * 8192 + i);
        if (d == 0) {
#pragma unroll
            for (int c = 0; c < 16; ++c) if (c < nc) { *(f32x4*)(base + (size_t)c * 4 * 16384) = S; S = S * g64 + kv[c]; }
        } else {
#pragma unroll
            for (int c = 15; c >= 0; --c) if (c < nc) { *(f32x4*)(base + (size_t)c * 4 * 16384) = S; S = S * g64 + kv[c]; }
        }
        if (s < 16) *(f32x4*)(p.out() + OUT_SRET + (size_t)((s * 2 + d) * 4 + h) * 8192 + i) = S;
    }
}

__device__ __forceinline__ size_t vt_base(int kr, int nheads, int dv, int& nkeys, int& key) {
    if (kr < NCTX) { nkeys = 256; key = kr & 255; return (size_t)(kr >> 8) * nheads * dv * 256; }
    const int v = kr - NCTX; const int b = v / 1536; nkeys = 1536; key = v - b * 1536;
    return (size_t)16 * nheads * dv * 256 + (size_t)b * nheads * dv * 1536;
}
__device__ __forceinline__ void phase_l0_qkv(const Frame& F, const PRef& p) {
    unsigned char* ws = p.ws();
    const float* P = (const float*)(ws + WS_P0); const float* QR = (const float*)(ws + WS_QRAW); const float* KVR = (const float*)(ws + WS_KVRAW);
    bf16_t* Q = (bf16_t*)(ws + WS_Q0); bf16_t* K = (bf16_t*)(ws + WS_K0); bf16_t* VT = (bf16_t*)(ws + WS_VT0);
    const int nw = F.G * 8, lane = F.lane;
    const float qscale = 0.10206207261596577f;
    for (int row = F.bid * 8 + F.wave; row < NKROW; row += nw) {
        const bool istok = row < NTOK, lat = istok && row >= NCTX;
        float cs = 1.f, sn = 0.f;
        if (lat && lane >= 32 && lane < 48) {
            const int t = (row - NCTX) & 1023, a = lane - 32;
            const float pos = a < 8 ? (float)(t >> 6) : (float)(t & 63);
            const float inv = __powf(10000.0f, -(float)(a & 7) * 0.125f);
            const float ang = pos * inv; cs = __cosf(ang); sn = __sinf(ang);
        }
        int kr;
        if (row < NCTX) kr = row; else if (row < NTOK) { const int v = row - NCTX; kr = NCTX + (v >> 10) * 1536 + (v & 1023); }
        else { const int i = row - NTOK; kr = NCTX + (i >> 9) * 1536 + 1024 + (i & 511); }
        const float* krope = istok ? P + (size_t)row * 2048 + 384 : p.in(3) + (size_t)(row - NTOK) * 32;
        f32x2 qv[8], kv2[8]; float vv[8];
        f32x2 kro = (f32x2){0.f, 0.f};
        if (lane >= 32 && lane < 48) kro = *(const f32x2*)(krope + 2 * (lane - 32));
#pragma unroll
        for (int h = 0; h < 8; ++h) {
            qv[h] = (f32x2){0.f, 0.f};
            if (istok && lane < 48) qv[h] = *(const f32x2*)(QR + (size_t)row * 768 + h * 96 + 2 * lane);
            kv2[h] = kro;
            if (lane < 32) kv2[h] = *(const f32x2*)(KVR + (size_t)row * 1024 + h * 128 + 2 * lane);
            vv[h] = KVR[(size_t)row * 1024 + h * 128 + 64 + lane];
        }
        f32x2 gq = (f32x2){0.f, 0.f}, gk = (f32x2){0.f, 0.f};
        if (lane < 48) { gq = *(const f32x2*)(p.in(24) + 2 * lane); gk = *(const f32x2*)(p.in(25) + 2 * lane); }
#pragma unroll
        for (int h = 0; h < 8; ++h) {
            if (istok) {
                float x1 = qv[h][0], x2 = qv[h][1];
                const float rstd = rsqrtf(wave_sum(x1 * x1 + x2 * x2) * (1.0f / 96.0f) + EPS);
                if (lane < 48) {
                    x1 = x1 * rstd * gq[0]; x2 = x2 * rstd * gq[1];
                    const float y1 = x1 * cs - x2 * sn, y2 = x1 * sn + x2 * cs;
                    *(unsigned*)(Q + (size_t)row * 768 + h * 96 + 2 * lane) = pack2(y1 * qscale, y2 * qscale);
                }
            }
            {
                float x1 = kv2[h][0], x2 = kv2[h][1];
                const float rstd = rsqrtf(wave_sum(x1 * x1 + x2 * x2) * (1.0f / 96.0f) + EPS);
                if (lane < 48) {
                    x1 = x1 * rstd * gk[0]; x2 = x2 * rstd * gk[1];
                    const float y1 = x1 * cs - x2 * sn, y2 = x1 * sn + x2 * cs;
                    *(unsigned*)(K + (size_t)kr * 768 + h * 96 + 2 * lane) = pack2(y1, y2);
                }
            }
            VT[(size_t)kr * 512 + h * 64 + lane] = f2bf(vv[h]);
        }
    }
}

template <int DQK, int DV, int NC, int NQT>
struct AttnState { f32x4 O[NC][DV / 16][NQT]; float l[NC][NQT]; };

template <int DQK, int DV, int NC, int NQT>
__device__ __forceinline__ void attn_wave(const bf16_t* __restrict__ Q, const bf16_t* __restrict__ K, const bf16_t* __restrict__ Vt,
                                          int qtok0, int krow0, int nkeys, int hh0  , int lane, AttnState<DQK, DV, NC, NQT>& st) {
    constexpr int NS = DQK / 32, NE = DV / 16, RS = 8 * DQK;
    const int fr = lane & 15, fq = lane >> 4;
    bf16x8 Qf[NC][NQT][NS];
#pragma unroll
    for (int c = 0; c < NC; ++c)
#pragma unroll
        for (int qt = 0; qt < NQT; ++qt)
#pragma unroll
            for (int s = 0; s < NS; ++s) Qf[c][qt][s] = *(const bf16x8*)(Q + (size_t)(qtok0 + qt * 16 + fr) * RS + (hh0 + c) * DQK + s * 32 + fq * 8);
    float m[NC][NQT];
#pragma unroll
    for (int c = 0; c < NC; ++c)
#pragma unroll
        for (int qt = 0; qt < NQT; ++qt) { m[c][qt] = -1e30f; st.l[c][qt] = 0.f;
#pragma unroll
            for (int e = 0; e < NE; ++e) st.O[c][e][qt] = (f32x4){0.f, 0.f, 0.f, 0.f}; }
    for (int key0 = 0; key0 < nkeys; key0 += 32) {
        bf16x8 Pf[NC][NQT];
#pragma unroll
        for (int c = 0; c < NC; ++c) {
            f32x4 S[2][NQT];
#pragma unroll
            for (int kt = 0; kt < 2; ++kt) {
                bf16x8 Kf[NS];
#pragma unroll
                for (int s = 0; s < NS; ++s) Kf[s] = *(const bf16x8*)(K + (size_t)(krow0 + key0 + kt * 16 + fr) * RS + (hh0 + c) * DQK + s * 32 + fq * 8);
#pragma unroll
                for (int qt = 0; qt < NQT; ++qt) {
                    f32x4 a = (f32x4){0.f, 0.f, 0.f, 0.f};
#pragma unroll
                    for (int s = 0; s < NS; ++s) a = __builtin_amdgcn_mfma_f32_16x16x32_bf16(Kf[s], Qf[c][qt][s], a, 0, 0, 0);
                    S[kt][qt] = a;
                }
            }
#pragma unroll
            for (int qt = 0; qt < NQT; ++qt) {
                float mx = fmaxf(fmaxf(fmaxf(S[0][qt][0], S[0][qt][1]), fmaxf(S[0][qt][2], S[0][qt][3])), fmaxf(fmaxf(S[1][qt][0], S[1][qt][1]), fmaxf(S[1][qt][2], S[1][qt][3])));
                mx = fmaxf(mx, __shfl_xor(mx, 16)); mx = fmaxf(mx, __shfl_xor(mx, 32));
                const float mn = fmaxf(m[c][qt], mx), alpha = __expf(m[c][qt] - mn);
                m[c][qt] = mn;
                float pv[8]; float ps = 0.f;
#pragma unroll
                for (int j = 0; j < 4; ++j) { pv[j] = __expf(S[0][qt][j] - mn); pv[4 + j] = __expf(S[1][qt][j] - mn); ps += pv[j] + pv[4 + j]; }
                st.l[c][qt] = st.l[c][qt] * alpha + ps;
#pragma unroll
                for (int e = 0; e < NE; ++e) st.O[c][e][qt] *= alpha;
                u32x4 pk; pk.x = pack2(pv[0], pv[1]); pk.y = pack2(pv[2], pv[3]); pk.z = pack2(pv[4], pv[5]); pk.w = pack2(pv[6], pv[7]);
                Pf[c][qt] = __builtin_bit_cast(bf16x8, pk);
            }
        }
#pragma unroll
        for (int e = 0; e < NE; ++e) {
            const bf16_t* vp = Vt + (size_t)(e * 16 + fr) * nkeys + key0 + 4 * fq;
            const bf16x4 v0 = *(const bf16x4*)vp, v1 = *(const bf16x4*)(vp + 16);
            bf16x8 Vf; Vf[0] = v0[0]; Vf[1] = v0[1]; Vf[2] = v0[2]; Vf[3] = v0[3]; Vf[4] = v1[0]; Vf[5] = v1[1]; Vf[6] = v1[2]; Vf[7] = v1[3];
#pragma unroll
            for (int c = 0; c < NC; ++c)
#pragma unroll
                for (int qt = 0; qt < NQT; ++qt) st.O[c][e][qt] = __builtin_amdgcn_mfma_f32_16x16x32_bf16(Vf, Pf[c][qt], st.O[c][e][qt], 0, 0, 0);
        }
    }
#pragma unroll
    for (int c = 0; c < NC; ++c)
#pragma unroll
        for (int qt = 0; qt < NQT; ++qt) { float l = st.l[c][qt]; l += __shfl_xor(l, 16); l += __shfl_xor(l, 32); st.l[c][qt] = 1.0f / l; }
}

__device__ __forceinline__ int attn_unit_xcd(int bid, int which) {
    const int x = bid & 7, idx = bid >> 3;
    return which == 0 ? (2 * x + (idx >> 4)) * 16 + (idx & 15) : 256 + (x * 16 + (idx >> 1)) * 2 + (idx & 1);
}
template <int DQK, int DV, int VH, class OutFn>
__device__ __forceinline__ void attn_block(const Frame& F, const bf16_t* __restrict__ Q, const bf16_t* __restrict__ K, const bf16_t* __restrict__ VT, const OutFn& out, int unit, float shift) {
    constexpr int NS = DQK / 32, NE = DV / 16, RS = 8 * DQK, KPC = DQK / 8;
    constexpr int KB = 128 * 256, VP = DV * 2 + 32, VB = 128 * VP, STG = KB + VB, VPC = DV / 8;
    constexpr int NKP = 128 * KPC / NTHREADS, NVP = 128 * VPC / NTHREADS;
    LAS unsigned char* lds = F.lds;
    const int lane = F.lane, fr = lane & 15, fq = lane >> 4, wave = F.wave, tid = F.tid;
    const bool lat = unit < 256;
    int ab, h, q0, nkeys, NQG;
    if (lat) { ab = 16 + (unit >> 7); h = (unit >> 4) & 7; q0 = (unit & 15) * 64; nkeys = 1536; NQG = 2; }
    else { const int v = unit - 256; ab = v >> 4; h = (v >> 1) & 7; q0 = (v & 1) * 128; nkeys = 256; NQG = 4; }
    const int NKS = 8 / NQG, qg = wave % NQG, ks = wave / NQG, kslice = 128 / NKS, nit = kslice / 32;
    const int qtok0 = (lat ? NCTX + (ab - 16) * 1024 : ab * 256) + q0 + qg * 32;
    const int krow0 = lat ? NCTX + (ab - 16) * 1536 : ab * 256;
    const bf16_t* vg = VT + (size_t)krow0 * (VH * DV) + (h * VH / 8) * DV;
    const bf16_t* kg = K + (size_t)krow0 * RS + h * DQK;
    bf16x8 Qf[2][NS];
#pragma unroll
    for (int qt = 0; qt < 2; ++qt)
#pragma unroll
        for (int s = 0; s < NS; ++s) Qf[qt][s] = *(const bf16x8*)(Q + (size_t)(qtok0 + qt * 16 + fr) * RS + h * DQK + s * 32 + fq * 8);
    f32x4 O[NE][2]; float l[2];
    const float sh2 = shift * 1.44269504f;
#pragma unroll
    for (int qt = 0; qt < 2; ++qt) { l[qt] = 0.f;
#pragma unroll
        for (int e = 0; e < NE; ++e) O[e][qt] = (f32x4){0.f, 0.f, 0.f, 0.f}; }
    u32x4 kregA[NKP], vregA[NVP], kregB[DV == 64 ? NKP : 1], vregB[DV == 64 ? NVP : 1];
#define AT_LOAD(kreg, vreg, st) do { \
        _Pragma("unroll") for (int i = 0; i < NKP; ++i) { const int pid = tid + i * NTHREADS, row = pid / KPC, ch = pid % KPC; kreg[i] = *(const u32x4*)(kg + (size_t)((st) * 128 + row) * RS + ch * 8); } \
        _Pragma("unroll") for (int i = 0; i < NVP; ++i) { const int pid = tid + i * NTHREADS, row = pid / VPC, ch = pid % VPC; vreg[i] = *(const u32x4*)(vg + (size_t)((st) * 128 + row) * (VH * DV) + ch * 8); } } while (0)
#define AT_WRITE(kreg, vreg, buf) do { \
        _Pragma("unroll") for (int i = 0; i < NKP; ++i) { const int pid = tid + i * NTHREADS, row = pid / KPC, ch = pid % KPC; *(LAS u32x4*)(lds + (buf) * STG + row * 256 + ((ch ^ (row & 15)) << 4)) = kreg[i]; } \
        _Pragma("unroll") for (int i = 0; i < NVP; ++i) { const int pid = tid + i * NTHREADS, row = pid / VPC, ch = pid % VPC; *(LAS u32x4*)(lds + (buf) * STG + KB + row * VP + ch * 16) = vreg[i]; } } while (0)
#define AT_COMPUTE(bufsel) do { \
        const LAS unsigned char* kb = lds + (bufsel) * STG; const LAS unsigned char* vb = kb + KB; \
        for (int it = 0; it < nit; ++it) { \
            const int key0 = ks * kslice + it * 32; \
            f32x4 S[2][2]; \
            _Pragma("unroll") for (int kt = 0; kt < 2; ++kt) { \
                const int row = key0 + kt * 16 + fr; \
                bf16x8 Kf[NS]; \
                _Pragma("unroll") for (int s_ = 0; s_ < NS; ++s_) Kf[s_] = *(const LAS bf16x8*)(kb + row * 256 + (((4 * s_ + fq) ^ (row & 15)) << 4)); \
                _Pragma("unroll") for (int qt = 0; qt < 2; ++qt) { \
                    f32x4 a = (f32x4){0.f, 0.f, 0.f, 0.f}; \
                    _Pragma("unroll") for (int s_ = 0; s_ < NS; ++s_) a = __builtin_amdgcn_mfma_f32_16x16x32_bf16(Kf[s_], Qf[qt][s_], a, 0, 0, 0); \
                    S[kt][qt] = a; } } \
            bf16x8 Pf[2]; \
            _Pragma("unroll") for (int qt = 0; qt < 2; ++qt) { \
                float pv[8]; float ps = 0.f; \
                _Pragma("unroll") for (int j = 0; j < 4; ++j) { pv[j] = __builtin_amdgcn_exp2f(S[0][qt][j] * 1.44269504f - sh2); pv[4 + j] = __builtin_amdgcn_exp2f(S[1][qt][j] * 1.44269504f - sh2); ps += pv[j] + pv[4 + j]; } \
                l[qt] += ps; \
                u32x4 pk; pk.x = pack2(pv[0], pv[1]); pk.y = pack2(pv[2], pv[3]); pk.z = pack2(pv[4], pv[5]); pk.w = pack2(pv[6], pv[7]); \
                Pf[qt] = __builtin_bit_cast(bf16x8, pk); } \
            _Pragma("unroll") for (int e = 0; e < NE; ++e) { \
                const LAS unsigned char* vp = vb + (key0 + 4 * fq + (fr >> 2)) * VP + (e * 16 + 4 * (fr & 3)) * 2; \
                const bf16x4 v0 = __builtin_amdgcn_ds_read_tr16_b64_v4i16((LAS bf16x4*)vp), v1 = __builtin_amdgcn_ds_read_tr16_b64_v4i16((LAS bf16x4*)(vp + 16 * VP)); \
                bf16x8 Vf; Vf[0] = v0[0]; Vf[1] = v0[1]; Vf[2] = v0[2]; Vf[3] = v0[3]; Vf[4] = v1[0]; Vf[5] = v1[1]; Vf[6] = v1[2]; Vf[7] = v1[3]; \
                _Pragma("unroll") for (int qt = 0; qt < 2; ++qt) O[e][qt] = __builtin_amdgcn_mfma_f32_16x16x32_bf16(Vf, Pf[qt], O[e][qt], 0, 0, 0); } } } while (0)
    const int nst = nkeys / 128;
    constexpr bool TWOSET = DV == 64;
    AT_LOAD(kregA, vregA, 0); if (TWOSET) AT_LOAD(kregB, vregB, 1); AT_WRITE(kregA, vregA, 0);
#pragma unroll
    for (int qt = 0; qt < 2; ++qt)
#pragma unroll
        for (int s_ = 0; s_ < NS; ++s_) asm volatile("" :: "v"(Qf[qt][s_]));
    __syncthreads();
    for (int st = 0; st < nst; st += 2) {
        if (TWOSET) {
            if (st + 2 < nst) AT_LOAD(kregA, vregA, st + 2);
            AT_COMPUTE(0);
            AT_WRITE(kregB, vregB, 1);
            __syncthreads();
            if (st + 3 < nst) AT_LOAD(kregB, vregB, st + 3);
            AT_COMPUTE(1);
            if (st + 2 < nst) AT_WRITE(kregA, vregA, 0);
            __syncthreads();
        } else {
            AT_LOAD(kregA, vregA, st + 1);
            AT_COMPUTE(0);
            AT_WRITE(kregA, vregA, 1);
            __syncthreads();
            if (st + 2 < nst) AT_LOAD(kregA, vregA, st + 2);
            AT_COMPUTE(1);
            if (st + 2 < nst) AT_WRITE(kregA, vregA, 0);
            __syncthreads();
        }
    }
#undef AT_COMPUTE
#undef AT_LOAD
#undef AT_WRITE
    LAS f32x4* Ost = (LAS f32x4*)lds; LAS float* LL = (LAS float*)(lds + 8 * 2 * NE * 1024);
#pragma unroll
    for (int qt = 0; qt < 2; ++qt) {
        float lt = l[qt]; lt += __shfl_xor(lt, 16); lt += __shfl_xor(lt, 32);
        if (fq == 0) LL[(wave * 2 + qt) * 16 + fr] = lt;
#pragma unroll
        for (int e = 0; e < NE; ++e) Ost[((wave * 2 + qt) * NE + e) * 64 + lane] = O[e][qt];
    }
    __syncthreads();
    const int epw = NE / NKS;
#pragma unroll
    for (int qt = 0; qt < 2; ++qt) {
        float L = 0.f;
        for (int j = 0; j < NKS; ++j) L += LL[((j * NQG + qg) * 2 + qt) * 16 + fr];
        const float invL = 1.0f / L;
        for (int ee = 0; ee < epw; ++ee) {
            const int e = ks * epw + ee;
            f32x4 o = (f32x4){0.f, 0.f, 0.f, 0.f};
            for (int j = 0; j < NKS; ++j) o += Ost[(((j * NQG + qg) * 2 + qt) * NE + e) * 64 + lane];
            out(qtok0 + qt * 16 + fr, h * DV + e * 16 + 4 * fq, o * invL);
        }
    }
    __syncthreads();
}
struct AttnOutBf16 { bf16_t* C; int ldc;
    __device__ __forceinline__ void operator()(int tok, int col, f32x4 o) const { u32x2 w; w.x = pack2(o[0], o[1]); w.y = pack2(o[2], o[3]); *(u32x2*)(C + (size_t)tok * ldc + col) = w; } };

__device__ __forceinline__ void attn_unit(int u, int wave, int& ab, int& h, int& q0) {
    if (u < 64) { ab = 16 + (u >> 5); h = (u >> 2) & 7; q0 = (u & 3) * 256 + wave * 32; }
    else { const int v = u - 64; ab = v >> 3; h = v & 7; q0 = wave * 32; }
}

__device__ __forceinline__ void phase_l0_mix(const Frame& F, const PRef& p) {
    unsigned char* ws = p.ws();
    const float* P = (const float*)(ws + WS_P0);
    bf16_t* OB = (bf16_t*)(ws + WS_OB);
    const bf16_t* Q = (const bf16_t*)(ws + WS_Q0); const bf16_t* K = (const bf16_t*)(ws + WS_K0); const bf16_t* VT = (const bf16_t*)(ws + WS_VT0);
    const int lane = F.lane, fr = lane & 15, fq = lane >> 4;
    {
        float gq = 0.f, gk = 0.f;
        for (int i = 0; i < 96; ++i) { gq = fmaxf(gq, fabsf(p.in(24)[i])); gk = fmaxf(gk, fabsf(p.in(25)[i])); }
        const float shift = 9.79795897f * gq * gk;
        AttnOutBf16 ao{OB, 1024};
#ifndef ATT_REP
#define ATT_REP 0
#endif
        for (int rp_ = 0; rp_ < 1 + (ATT_REP == 1); ++rp_) {
            for (int slot = 0; slot * F.G < 512; ++slot) { const int u = F.G == 256 ? attn_unit_xcd(F.bid, slot) : F.bid + slot * F.G; if (u < 512) for (int r2_ = 0; r2_ < 1 + ((ATT_REP == 3 && slot == 0) || (ATT_REP == 4 && slot == 1) ? 3 : 0); ++r2_) attn_block<96, 64, 8>(F, Q, K, VT, ao, u, shift); }
        } }
    {
        LAS unsigned char* L = F.lds;
        constexpr int T64 = 64 * 128, VPI = 288, T128 = 64 * VPI;
        constexpr int O_Q = 0, O_K = T64, O_QF = 2 * T64, O_QB = 3 * T64, O_W = 4 * T64, O_V = 5 * T64, O_SF = O_V + T128, O_SB = O_SF + T128, O_RED = O_SB + T128;
        const float* KVS = (const float*)(ws + WS_KVS);
        const int tid = F.tid, w = F.wave;
        for (int rp_ = 0; rp_ < 1 + (ATT_REP == 2); ++rp_)
        FOR_UNITS(u, 384, 128) {
            int s, c, h, tok0, nc; seq_of_unit384(u, s, c, h, tok0, nc);
            const float lgf = __logf(sigmoidf_(p.in(26)[h])), lgb = __logf(sigmoidf_(p.in(26)[4 + h]));
            {
                const int row = tid >> 3, ch = tid & 7;
                const float* pr = P + (size_t)(tok0 + row) * 2048;
                const f32x4 q0 = *(const f32x4*)(pr + 416 + h * 64 + ch * 8), q1 = *(const f32x4*)(pr + 416 + h * 64 + ch * 8 + 4);
                const f32x4 k0 = *(const f32x4*)(pr + 672 + h * 64 + ch * 8), k1 = *(const f32x4*)(pr + 672 + h * 64 + ch * 8 + 4);
                f32x4 vv[4], sf[4], sb[4];
#pragma unroll
                for (int i = 0; i < 4; ++i) { vv[i] = *(const f32x4*)(pr + 928 + h * 128 + ch * 16 + i * 4);
                    sf[i] = *(const f32x4*)(KVS + (size_t)u * 16384 + row * 128 + ch * 16 + i * 4); sb[i] = *(const f32x4*)(KVS + (size_t)u * 16384 + 8192 + row * 128 + ch * 16 + i * 4); }
                const float df = __expf(lgf * (float)(row + 1)), db = __expf(lgb * (float)(64 - row));
                const int so = row * 128 + ((ch ^ (row & 7)) << 4);
                u32x4 t;
                t.x = pack2(q0[0], q0[1]); t.y = pack2(q0[2], q0[3]); t.z = pack2(q1[0], q1[1]); t.w = pack2(q1[2], q1[3]); *(LAS u32x4*)(L + O_Q + so) = t;
                t.x = pack2(q0[0] * df, q0[1] * df); t.y = pack2(q0[2] * df, q0[3] * df); t.z = pack2(q1[0] * df, q1[1] * df); t.w = pack2(q1[2] * df, q1[3] * df); *(LAS u32x4*)(L + O_QF + so) = t;
                t.x = pack2(q0[0] * db, q0[1] * db); t.y = pack2(q0[2] * db, q0[3] * db); t.z = pack2(q1[0] * db, q1[1] * db); t.w = pack2(q1[2] * db, q1[3] * db); *(LAS u32x4*)(L + O_QB + so) = t;
                t.x = pack2(k0[0] * 0.125f, k0[1] * 0.125f); t.y = pack2(k0[2] * 0.125f, k0[3] * 0.125f); t.z = pack2(k1[0] * 0.125f, k1[1] * 0.125f); t.w = pack2(k1[2] * 0.125f, k1[3] * 0.125f); *(LAS u32x4*)(L + O_K + so) = t;
                const int vo = row * VPI + ch * 32;
#pragma unroll
                for (int i = 0; i < 2; ++i) {
                    t.x = pack2(vv[2 * i][0], vv[2 * i][1]); t.y = pack2(vv[2 * i][2], vv[2 * i][3]); t.z = pack2(vv[2 * i + 1][0], vv[2 * i + 1][1]); t.w = pack2(vv[2 * i + 1][2], vv[2 * i + 1][3]); *(LAS u32x4*)(L + O_V + vo + i * 16) = t;
                    t.x = pack2(sf[2 * i][0], sf[2 * i][1]); t.y = pack2(sf[2 * i][2], sf[2 * i][3]); t.z = pack2(sf[2 * i + 1][0], sf[2 * i + 1][1]); t.w = pack2(sf[2 * i + 1][2], sf[2 * i + 1][3]); *(LAS u32x4*)(L + O_SF + vo + i * 16) = t;
                    t.x = pack2(sb[2 * i][0], sb[2 * i][1]); t.y = pack2(sb[2 * i][2], sb[2 * i][3]); t.z = pack2(sb[2 * i + 1][0], sb[2 * i + 1][1]); t.w = pack2(sb[2 * i + 1][2], sb[2 * i + 1][3]); *(LAS u32x4*)(L + O_SB + vo + i * 16) = t;
                }
            }
            __syncthreads();
            {
                const int jt = w >> 1;
                bf16x8 Kf[2];
#pragma unroll
                for (int ks = 0; ks < 2; ++ks) { const int row = jt * 16 + fr; Kf[ks] = *(const LAS bf16x8*)(L + O_K + row * 128 + (((4 * ks + fq) ^ (row & 7)) << 4)); }
#pragma unroll
                for (int t2 = 0; t2 < 2; ++t2) {
                    const int it = (w & 1) * 2 + t2, irow = it * 16 + fr;
                    f32x4 d = (f32x4){0.f, 0.f, 0.f, 0.f};
#pragma unroll
                    for (int ks = 0; ks < 2; ++ks) { const bf16x8 Qf_ = *(const LAS bf16x8*)(L + O_Q + irow * 128 + (((4 * ks + fq) ^ (irow & 7)) << 4)); d = __builtin_amdgcn_mfma_f32_16x16x32_bf16(Kf[ks], Qf_, d, 0, 0, 0); }
                    float wv[4];
#pragma unroll
                    for (int r = 0; r < 4; ++r) { const int j = jt * 16 + 4 * fq + r; float dec = 0.f; if (j <= irow) dec += __expf(lgf * (float)(irow - j)); if (j >= irow) dec += __expf(lgb * (float)(j - irow)); wv[r] = d[r] * dec; }
                    u32x2 t; t.x = pack2(wv[0], wv[1]); t.y = pack2(wv[2], wv[3]);
                    *(LAS u32x2*)(L + O_W + irow * 128 + (((2 * jt + (fq >> 1)) ^ (irow & 7)) << 4) + (fq & 1) * 8) = t;
                }
            }
            __syncthreads();
            f32x4 acc[4];
#pragma unroll
            for (int it = 0; it < 4; ++it) acc[it] = (f32x4){0.f, 0.f, 0.f, 0.f};
            {
                bf16x8 Af[3][2];
#pragma unroll
                for (int a = 0; a < 3; ++a)
#pragma unroll
                    for (int ks = 0; ks < 2; ++ks) {
                        const LAS unsigned char* vp = L + (a == 0 ? O_V : (a == 1 ? O_SF : O_SB)) + (32 * ks + 8 * fq + (fr >> 2)) * VPI + (w * 16 + 4 * (fr & 3)) * 2;
                        const bf16x4 v0 = __builtin_amdgcn_ds_read_tr16_b64_v4i16((LAS bf16x4*)vp), v1 = __builtin_amdgcn_ds_read_tr16_b64_v4i16((LAS bf16x4*)(vp + 4 * VPI));
                        bf16x8 x; x[0] = v0[0]; x[1] = v0[1]; x[2] = v0[2]; x[3] = v0[3]; x[4] = v1[0]; x[5] = v1[1]; x[6] = v1[2]; x[7] = v1[3];
                        Af[a][ks] = x;
                    }
#pragma unroll
                for (int it = 0; it < 4; ++it) {
                    const int irow = it * 16 + fr;
#pragma unroll
                    for (int ks = 0; ks < 2; ++ks) {
                        const int so = irow * 128 + (((4 * ks + fq) ^ (irow & 7)) << 4);
                        const bf16x8 bw = *(const LAS bf16x8*)(L + O_W + so), bqf = *(const LAS bf16x8*)(L + O_QF + so), bqb = *(const LAS bf16x8*)(L + O_QB + so);
                        acc[it] = __builtin_amdgcn_mfma_f32_16x16x32_bf16(Af[0][ks], bw, acc[it], 0, 0, 0);
                        acc[it] = __builtin_amdgcn_mfma_f32_16x16x32_bf16(Af[1][ks], bqf, acc[it], 0, 0, 0);
                        acc[it] = __builtin_amdgcn_mfma_f32_16x16x32_bf16(Af[2][ks], bqb, acc[it], 0, 0, 0);
                    }
                }
            }
            LAS float* red = (LAS float*)(L + O_RED);
#pragma unroll
            for (int it = 0; it < 4; ++it) {
                float ss = acc[it][0] * acc[it][0] + acc[it][1] * acc[it][1] + acc[it][2] * acc[it][2] + acc[it][3] * acc[it][3];
                ss += __shfl_xor(ss, 16); ss += __shfl_xor(ss, 32);
                if (fq == 0) red[w * 64 + it * 16 + fr] = ss;
            }
            __syncthreads();
            {
                const f32x4 gn = *(const f32x4*)(p.in(27) + h * 128 + w * 16 + 4 * fq);
#pragma unroll
                for (int it = 0; it < 4; ++it) {
                    const int i = it * 16 + fr, tok = tok0 + i;
                    float ss = 0.f;
#pragma unroll
                    for (int q = 0; q < 8; ++q) ss += red[q * 64 + i];
                    const float rstd = rsqrtf(ss * (1.0f / 128.0f) + EPS);
                    const f32x4 rg = *(const f32x4*)(P + (size_t)tok * 2048 + 1440 + h * 128 + w * 16 + 4 * fq);
                    u32x2 t; t.x = pack2(siluf_(rg[0]) * acc[it][0] * rstd * gn[0], siluf_(rg[1]) * acc[it][1] * rstd * gn[1]);
                    t.y = pack2(siluf_(rg[2]) * acc[it][2] * rstd * gn[2], siluf_(rg[3]) * acc[it][3] * rstd * gn[3]);
                    *(u32x2*)(OB + (size_t)tok * 1024 + 512 + h * 128 + w * 16 + 4 * fq) = t;
                }
            }
            __syncthreads();
        }
    }
}

__device__ __forceinline__ void phase_gate(const Frame& F, const PRef& p, int l) {
    const bf16_t* U = (const bf16_t*)(p.ws() + WS_U); bf16_t* ACT = (bf16_t*)(p.ws() + WS_ACT);
    const float* cw = p.in(16) + (size_t)l * 3 * 5632; const float* cb = p.in(17) + (size_t)l * 5632;
    const int gt = F.bid * NTHREADS + F.tid, ngt = F.G * NTHREADS;
    const int cg = gt % 352, tslot = gt / 352, nslot = ngt / 352;
    if (tslot >= nslot) return;
    const int c0 = cg * 8;
    float w0[2][8], w1[2][8], w2[2][8], bb[2][8];
#pragma unroll
    for (int half = 0; half < 2; ++half) {
        const int col = c0 + half * 2816;
#pragma unroll
        for (int q = 0; q < 2; ++q) {
            const f32x4 a = *(const f32x4*)(cw + col + q * 4), b = *(const f32x4*)(cw + 5632 + col + q * 4), c = *(const f32x4*)(cw + 2 * 5632 + col + q * 4), d = *(const f32x4*)(cb + col + q * 4);
#pragma unroll
            for (int j = 0; j < 4; ++j) { w0[half][q * 4 + j] = a[j]; w1[half][q * 4 + j] = b[j]; w2[half][q * 4 + j] = c[j]; bb[half][q * 4 + j] = d[j]; }
        }
    }
    bf16x8 cx[2][3], nx[2][3];
#define GATE_LOAD(dst, tok_) do { const int t_ = (tok_) < NCTX ? ((tok_) & 255) : (((tok_) - NCTX) & 1023), n_ = (tok_) < NCTX ? 256 : 1024; \
        const bf16x8 z_ = (bf16x8){0, 0, 0, 0, 0, 0, 0, 0}; \
        _Pragma("unroll") for (int half = 0; half < 2; ++half) { const bf16_t* up_ = U + (size_t)(tok_) * 5632 + c0 + half * 2816; \
            dst[half][1] = *(const bf16x8*)up_; dst[half][0] = t_ > 0 ? *(const bf16x8*)(up_ - 5632) : z_; dst[half][2] = t_ < n_ - 1 ? *(const bf16x8*)(up_ + 5632) : z_; } } while (0)
    if (tslot < NTOK) GATE_LOAD(cx, tslot);
    for (int tok = tslot; tok < NTOK; tok += nslot) {
        if (tok + nslot < NTOK) GATE_LOAD(nx, tok + nslot);
        float u2[2][8];
#pragma unroll
        for (int half = 0; half < 2; ++half)
#pragma unroll
            for (int j = 0; j < 8; ++j)
                u2[half][j] = bf2f((unsigned short)cx[half][0][j]) * w0[half][j] + bf2f((unsigned short)cx[half][1][j]) * w1[half][j] + bf2f((unsigned short)cx[half][2][j]) * w2[half][j] + bb[half][j];
        u32x4 w;
        w.x = pack2(siluf_(u2[0][0]) * u2[1][0], siluf_(u2[0][1]) * u2[1][1]); w.y = pack2(siluf_(u2[0][2]) * u2[1][2], siluf_(u2[0][3]) * u2[1][3]);
        w.z = pack2(siluf_(u2[0][4]) * u2[1][4], siluf_(u2[0][5]) * u2[1][5]); w.w = pack2(siluf_(u2[0][6]) * u2[1][6], siluf_(u2[0][7]) * u2[1][7]);
        *(u32x4*)(ACT + (size_t)tok * 2816 + c0) = w;
#pragma unroll
        for (int half = 0; half < 2; ++half)
#pragma unroll
            for (int q = 0; q < 3; ++q) cx[half][q] = nx[half][q];
    }
#undef GATE_LOAD
}

__device__ __forceinline__ void phase_l1_tok(const Frame& F, const PRef& p) {
    unsigned char* ws = p.ws();
    const float* P = (const float*)(ws + WS_P1);
    bf16_t* QD = (bf16_t*)(ws + WS_QD); bf16_t* KD = (bf16_t*)(ws + WS_KD); bf16_t* VDT = (bf16_t*)(ws + WS_VDT);
    float* RR = (float*)(ws + WS_RR); float* KR = (float*)(ws + WS_KR); float* VV = (float*)(ws + WS_VV); float* KK = (float*)(ws + WS_KK);
    bf16_t* TW = (bf16_t*)(ws + WS_TW); bf16_t* AD = (bf16_t*)(ws + WS_AD); bf16_t* SG = (bf16_t*)(ws + WS_SG);
    const int nw = F.G * 8, lane = F.lane;
    const float* mu = p.in(33);
    for (int row = F.bid * 8 + F.wave; row < NKROW; row += nw) {
        const bool istok = row < NTOK, lat = istok && row >= NCTX;
        int kr;
        if (row < NCTX) kr = row; else if (row < NTOK) { const int v = row - NCTX; kr = NCTX + (v >> 10) * 1536 + (v & 1023); }
        else { const int i = row - NTOK; kr = NCTX + (i >> 9) * 1536 + 1024 + (i & 511); }
        if (!istok) {
            const int i = row - NTOK;
#pragma unroll
            for (int j = 0; j < 8; ++j) {
                const int col = j * 64 + lane;
                KD[(size_t)kr * 512 + col] = f2bf(p.in(5)[(size_t)i * 512 + col]);
                VDT[(size_t)kr * 512 + col] = f2bf(p.in(6)[(size_t)i * 512 + col]);
            }
            continue;
        }
        const float* pr = P + (size_t)row * 3584;
        float cs = 1.f, sn = 0.f;
        if (lat) {
            const int t = (row - NCTX) & 1023, a = lane & 31;
            const float pos = a < 16 ? (float)(t >> 6) : (float)(t & 63);
            const float inv = __powf(10000.0f, -(float)(a & 15) * 0.0625f);
            const float ang = pos * inv; cs = __cosf(ang); sn = __sinf(ang);
        }
        {
            const int pi = lane & 31;
            f32x2 qv[4], kv[4];
#pragma unroll
            for (int pass = 0; pass < 4; ++pass) { const int vec = pass * 2 + (lane >> 5); qv[pass] = *(const f32x2*)(pr + vec * 64 + 2 * pi); kv[pass] = *(const f32x2*)(pr + 512 + vec * 64 + 2 * pi); }
            const f32x2 gq = *(const f32x2*)(p.in(29) + 2 * pi), gk = *(const f32x2*)(p.in(30) + 2 * pi);
#pragma unroll
            for (int pass = 0; pass < 4; ++pass) {
                const int vec = pass * 2 + (lane >> 5);
                {
                    const f32x2 v = qv[pass];
                    const float rstd = rsqrtf(half_sum(v[0] * v[0] + v[1] * v[1], lane) * (1.0f / 64.0f) + EPS);
                    const float x1 = v[0] * rstd * gq[0], x2 = v[1] * rstd * gq[1];
                    *(unsigned*)(QD + (size_t)row * 512 + vec * 64 + 2 * pi) = pack2((x1 * cs - x2 * sn) * 0.125f, (x1 * sn + x2 * cs) * 0.125f);
                }
                {
                    const f32x2 v = kv[pass];
                    const float rstd = rsqrtf(half_sum(v[0] * v[0] + v[1] * v[1], lane) * (1.0f / 64.0f) + EPS);
                    const float x1 = v[0] * rstd * gk[0], x2 = v[1] * rstd * gk[1];
                    if (row < NCTX) *(f32x2*)(p.out() + OUT_DK + (size_t)row * 512 + vec * 64 + 2 * pi) = (f32x2){x1, x2};
                    *(unsigned*)(KD + (size_t)kr * 512 + vec * 64 + 2 * pi) = pack2(x1 * cs - x2 * sn, x1 * sn + x2 * cs);
                }
            }
        }
#pragma unroll
        for (int j = 0; j < 8; ++j) {
            const int col = j * 64 + lane; const float v = pr[1024 + col];
            if (row < NCTX) p.out()[OUT_DV + (size_t)row * 512 + col] = v;
            VDT[(size_t)kr * 512 + col] = f2bf(v);
        }
        const int t = row < NCTX ? (row & 255) : ((row - NCTX) & 1023), n = row < NCTX ? 256 : 1024;
        const bool hp = t > 0, hn = t < n - 1;
        const float* pp = pr + 1536;
        const float* pn = pp + 3584; const float* pv = pp - 3584;
#define SHIFT4(col) ({ const f32x4 _c = *(const f32x4*)(pp + (col)); const f32x4 _p = hp ? *(const f32x4*)(pv + (col)) : (f32x4){0.f, 0.f, 0.f, 0.f}; \
            const f32x4 _n = hn ? *(const f32x4*)(pn + (col)) : (f32x4){0.f, 0.f, 0.f, 0.f}; const f32x4 _m = *(const f32x4*)(mu + (col)); _c + (0.5f * (_p + _n) - _c) * _m; })
        {
            const size_t o = (size_t)row * 512 + lane * 8;
            const f32x4 r0 = SHIFT4(lane * 8), r1 = SHIFT4(lane * 8 + 4);
            *(f32x4*)(RR + o) = r0; *(f32x4*)(RR + o + 4) = r1;
            const f32x4 k0 = SHIFT4(512 + lane * 8), k1 = SHIFT4(512 + lane * 8 + 4);
            *(f32x4*)(KR + o) = k0; *(f32x4*)(KR + o + 4) = k1;
            const f32x4 v0 = SHIFT4(1024 + lane * 8), v1 = SHIFT4(1024 + lane * 8 + 4);
            *(f32x4*)(VV + o) = v0; *(f32x4*)(VV + o + 4) = v1;
            const f32x4 kk0 = k0 * *(const f32x4*)(p.in(39) + lane * 8), kk1 = k1 * *(const f32x4*)(p.in(39) + lane * 8 + 4);
            float ss = (kk0[0] * kk0[0] + kk0[1] * kk0[1]) + (kk0[2] * kk0[2] + kk0[3] * kk0[3]) + (kk1[0] * kk1[0] + kk1[1] * kk1[1]) + (kk1[2] * kk1[2] + kk1[3] * kk1[3]);
            ss = oct_sum(ss);
            const float rn = rsqrtf(ss + EPS);
            *(f32x4*)(KK + o) = kk0 * rn; *(f32x4*)(KK + o + 4) = kk1 * rn;
        }
        {
            const f32x4 a = SHIFT4(1536 + lane * 4);
            u32x2 w;
            if (lane < 32) { w.x = pack2(tanhf_(a[0]), tanhf_(a[1])); w.y = pack2(tanhf_(a[2]), tanhf_(a[3])); *(u32x2*)(TW + (size_t)row * 128 + lane * 4) = w; }
            else { w.x = pack2(a[0], a[1]); w.y = pack2(a[2], a[3]); *(u32x2*)(AD + (size_t)row * 128 + (lane - 32) * 4) = w; }
            if (lane < 32) { const f32x4 g = SHIFT4(1792 + lane * 4); w.x = pack2(sigmoidf_(g[0]), sigmoidf_(g[1])); w.y = pack2(sigmoidf_(g[2]), sigmoidf_(g[3])); *(u32x2*)(SG + (size_t)row * 128 + lane * 4) = w; }
        }
#define SHIFTED(col) 0
#undef SHIFTED
    }
}

constexpr int SC_T = 16;
constexpr int SC_BUF = 2 * SC_T * 6 * 64;
__device__ __forceinline__ void phase_l1_mix(const Frame& F, const PRef& p) {
    unsigned char* ws = p.ws();
    const bf16_t* Q = (const bf16_t*)(ws + WS_QD); const bf16_t* K = (const bf16_t*)(ws + WS_KD); const bf16_t* VT = (const bf16_t*)(ws + WS_VDT);
    AttnOutBf16 ao{(bf16_t*)(ws + WS_DO), 1024};
    float gq = 0.f, gk = 0.f;
    for (int i = 0; i < 64; ++i) { gq = fmaxf(gq, fabsf(p.in(29)[i])); gk = fmaxf(gk, fabsf(p.in(30)[i])); }
    const float shift = 8.0f * gq * gk;
    for (int slot = 0; slot * F.G < 512; ++slot) { const int u = F.G == 256 ? attn_unit_xcd(F.bid, slot) : F.bid + slot * F.G; if (u < 512) attn_block<64, 128, 4>(F, Q, K, VT, ao, u, shift); }
}

__device__ __forceinline__ float dpp_xor1(float x) { return __int_as_float(__builtin_amdgcn_update_dpp(0, __float_as_int(x), 0xB1, 0xF, 0xF, true)); }
__device__ __forceinline__ float dpp_xor2(float x) { return __int_as_float(__builtin_amdgcn_update_dpp(0, __float_as_int(x), 0x4E, 0xF, 0xF, true)); }
#define VFMA(d, a, b, c) asm("v_fma_f32 %0, %1, %2, %3" : "=v"(d) : "v"(a), "v"(b), "v"(c))
#define VFMAN(d, a, b, c) asm("v_fma_f32 %0, -%1, %2, %3" : "=v"(d) : "v"(a), "v"(b), "v"(c))
#define VMUL(d, a, b) asm("v_mul_f32 %0, %1, %2" : "=v"(d) : "v"(a), "v"(b))
#define VADD(d, a, b) asm("v_add_f32 %0, %1, %2" : "=v"(d) : "v"(a), "v"(b))
#define QUAD_SUM_ASM(x) asm("s_nop 1\n\tv_add_f32_dpp %0, %0, %0 quad_perm:[1,0,3,2] row_mask:0xf bank_mask:0xf bound_ctrl:1\n\ts_nop 1\n\t" \
    "v_add_f32_dpp %0, %0, %0 quad_perm:[2,3,0,1] row_mask:0xf bank_mask:0xf bound_ctrl:1" : "+v"(x))
#define ROW16_SUM_ASM(x) asm("s_nop 1\n\tv_add_f32_dpp %0, %0, %0 quad_perm:[1,0,3,2] row_mask:0xf bank_mask:0xf bound_ctrl:1\n\ts_nop 1\n\t" \
    "v_add_f32_dpp %0, %0, %0 quad_perm:[2,3,0,1] row_mask:0xf bank_mask:0xf bound_ctrl:1\n\ts_nop 1\n\t" \
    "v_add_f32_dpp %0, %0, %0 row_half_mirror row_mask:0xf bank_mask:0xf bound_ctrl:1\n\ts_nop 1\n\t" \
    "v_add_f32_dpp %0, %0, %0 row_mirror row_mask:0xf bank_mask:0xf bound_ctrl:1" : "+v"(x))
constexpr int SREC = 400;
template <int KPL> struct ScanVecs { f32x4 w[KPL / 4], kka[KPL / 4], kd[KPL / 4], kk[KPL / 4], r[KPL / 4]; float v, c1, c2; };
template <int KPL>
__device__ __forceinline__ void scan_load(ScanVecs<KPL>& x, const LAS float* v6, int koff, int row) {
#pragma unroll
    for (int q = 0; q < KPL / 4; ++q) {
        x.w[q] = *(const LAS f32x4*)(v6 + 0 * 64 + koff + q * 4); x.kka[q] = *(const LAS f32x4*)(v6 + 1 * 64 + koff + q * 4); x.kd[q] = *(const LAS f32x4*)(v6 + 2 * 64 + koff + q * 4);
        x.kk[q] = *(const LAS f32x4*)(v6 + 3 * 64 + koff + q * 4); x.r[q] = *(const LAS f32x4*)(v6 + 4 * 64 + koff + q * 4);
    }
    x.v = v6[5 * 64 + row]; x.c1 = v6[384]; x.c2 = v6[385];
}
template <int MODE>
__device__ __forceinline__ void scan_unit(const Frame& F, const PRef& p, int unit) {
    constexpr int T = 32, NSTEPS = MODE == 0 ? 1024 : 256, BUF = T * SREC, NCHUNK = NSTEPS / T;
    constexpr int KPL = MODE == 0 ? 4 : 16, NQ = KPL / 4;
    unsigned char* ws = p.ws();
    const float* RR = (const float*)(ws + WS_RR); const float* KR = (const float*)(ws + WS_KR); const float* VV = (const float*)(ws + WS_VV); const float* KK = (const float*)(ws + WS_KK);
    const float* DEC = (const float*)(ws + WS_DEC); const float* AA = (const float*)(ws + WS_AA);
    float* YY = (float*)(ws + WS_YY);
    const float* k_a = p.in(40);
    LAS float* sb = (LAS float*)F.lds;
    const int lane = F.lane;
    const bool loader = F.wave >= 4;
    const bool compute = F.wave < 4;
    const int cid = MODE == 0 ? (unit >> 2) : unit;
    const int cb = cid >> 4, chh = (cid >> 1) & 7, cd = cid & 1;
    const int cbase = MODE == 0 ? NCTX + cb * 1024 : cb * 256;
    if (loader) {
        const int lt = F.tid - 256;
        f32x4 pa[2][6], pb[2][6];
        const f32x4 ka4 = *(const f32x4*)(k_a + chh * 64 + (lt & 15) * 4), rk4 = *(const f32x4*)(p.in(41) + chh * 64 + (lt & 15) * 4);
        float* BON = (float*)(ws + WS_BON) + (size_t)cd * NTOK * 8 + chh;
        const bool wbon = MODE == 1 || (unit & 3) == 0;
#define SC_LOAD(pre, chunk) do { _Pragma("unroll") for (int it = 0; it < 2; ++it) { const int item = it * 256 + lt; const int stp = item >> 4, k = (item & 15) * 4; \
            const int j_ = (chunk) * T + stp; const int tok = cbase + (cd ? NSTEPS - 1 - j_ : j_); const size_t o_ = (size_t)tok * 512 + chh * 64 + k; \
            pre[it][0] = *(const f32x4*)(DEC + (size_t)cd * NTOK * 512 + o_); pre[it][1] = *(const f32x4*)(AA + (size_t)cd * NTOK * 512 + o_); pre[it][2] = *(const f32x4*)(KR + o_); \
            pre[it][3] = *(const f32x4*)(KK + o_); pre[it][4] = *(const f32x4*)(RR + o_); pre[it][5] = *(const f32x4*)(VV + o_); } } while (0)
#define SC_WRITE(pre, buf, chunk) do { _Pragma("unroll") for (int it = 0; it < 2; ++it) { const int item = it * 256 + lt; const int stp = item >> 4, k = (item & 15) * 4; \
            const f32x4 a_ = pre[it][1], kk_ = pre[it][3], r_ = pre[it][4], w_ = pre[it][0]; LAS float* d_ = sb + (buf) * BUF + stp * SREC + k; \
            const f32x4 bb_ = kk_ * a_, kd_ = pre[it][2] * (1.0f + (a_ - 1.0f) * ka4); \
            *(LAS f32x4*)(d_) = w_; *(LAS f32x4*)(d_ + 64) = bb_; *(LAS f32x4*)(d_ + 128) = kd_; *(LAS f32x4*)(d_ + 192) = kk_; \
            *(LAS f32x4*)(d_ + 256) = w_ * r_; *(LAS f32x4*)(d_ + 320) = pre[it][5]; \
            const f32x4 p1_ = bb_ * r_, p2_ = kd_ * r_; const float c1_ = row16_sum((p1_[0] + p1_[1]) + (p1_[2] + p1_[3])), c2_ = row16_sum((p2_[0] + p2_[1]) + (p2_[2] + p2_[3])); \
            const f32x4 p3_ = p2_ * rk4; const float c3_ = row16_sum((p3_[0] + p3_[1]) + (p3_[2] + p3_[3])); \
            if ((lt & 15) == 0) { LAS float* e_ = sb + (buf) * BUF + stp * SREC + 384; e_[0] = c1_; e_[1] = c2_; \
                if (wbon) { const int j2_ = (chunk) * T + stp; BON[(size_t)(cbase + (cd ? NSTEPS - 1 - j2_ : j2_)) * 8] = c3_; } } } } while (0)
        SC_LOAD(pa, 0); SC_LOAD(pb, 1); SC_WRITE(pa, 0, 0); SC_LOAD(pa, 2);
        __syncthreads();
        for (int cnk = 0; cnk < NCHUNK; cnk += 2) {
            if (cnk + 1 < NCHUNK) { SC_WRITE(pb, (cnk + 1) & 1, cnk + 1); if (cnk + 3 < NCHUNK) SC_LOAD(pb, cnk + 3); }
            __syncthreads();
            if (cnk + 2 < NCHUNK) { SC_WRITE(pa, (cnk + 2) & 1, cnk + 2); if (cnk + 4 < NCHUNK) SC_LOAD(pa, cnk + 4); }
            __syncthreads();
        }
#undef SC_LOAD
#undef SC_WRITE
    } else if (compute) {
        const int row = MODE == 0 ? (unit & 3) * 16 + F.wave * 4 + (lane >> 4) : F.wave * 16 + (lane >> 2);
        const int kq = MODE == 0 ? (lane & 15) : (lane & 3), koff = kq * KPL;
        f32x4 S[NQ];
        if (MODE == 0) {
            const float* s0 = p.in(7) + (size_t)(((cb * 2 + cd) * 8 + chh) * 64 + row) * 64 + koff;
#pragma unroll
            for (int q = 0; q < NQ; ++q) S[q] = *(const f32x4*)(s0 + q * 4);
        } else {
#pragma unroll
            for (int q = 0; q < NQ; ++q) S[q] = (f32x4){0.f, 0.f, 0.f, 0.f};
        }
        __syncthreads();
        float* yp = YY + (size_t)cd * NTOK * 512 + chh * 64 + row;
        for (int cnk = 0; cnk < NCHUNK; ++cnk) {
            const LAS float* bufp = sb + (cnk & 1) * BUF;
            ScanVecs<KPL> cur, nxt;
            scan_load<KPL>(cur, bufp, koff, row);
#pragma unroll 2
            for (int stp = 0; stp < T; ++stp) {
                scan_load<KPL>(nxt, bufp + (stp + 1 < T ? stp + 1 : stp) * SREC, koff, row);
                const int j_ = cnk * T + stp; const int tok = cbase + (cd ? NSTEPS - 1 - j_ : j_);
                f32x4 a4 = S[0] * cur.kk[0], y4 = S[0] * cur.r[0];
#pragma unroll
                for (int q = 1; q < NQ; ++q) { a4 = a4 + S[q] * cur.kk[q]; y4 = y4 + S[q] * cur.r[q]; }
                float sa = (a4[0] + a4[1]) + (a4[2] + a4[3]), ys = (y4[0] + y4[1]) + (y4[2] + y4[3]);
                if (MODE == 0) {
                    sa += DPPF(sa, 0xB1); ys += DPPF(ys, 0xB1); sa += DPPF(sa, 0x4E); ys += DPPF(ys, 0x4E);
                    sa += DPPF(sa, 0x141); ys += DPPF(ys, 0x141); sa += DPPF(sa, 0x140); ys += DPPF(ys, 0x140);
                } else { sa += DPPF(sa, 0xB1); ys += DPPF(ys, 0xB1); sa += DPPF(sa, 0x4E); ys += DPPF(ys, 0x4E); }
                const float vr = cur.v;
#pragma unroll
                for (int q = 0; q < NQ; ++q) S[q] = S[q] * cur.w[q] + (vr * cur.kd[q] - sa * cur.kka[q]);
                if (kq == 0) yp[(size_t)tok * 512] = ys - sa * cur.c1 + vr * cur.c2;
                cur = nxt;
            }
            __syncthreads();
        }
        if (MODE == 1) {
            float* so = p.out() + OUT_SRWKV + (size_t)(((cb * 2 + cd) * 8 + chh) * 64 + row) * 64 + koff;
#pragma unroll
            for (int q = 0; q < NQ; ++q) *(f32x4*)(so + q * 4) = S[q];
        }
    } else {
        __syncthreads();
        for (int cnk = 0; cnk < NCHUNK; ++cnk) __syncthreads();
    }
}
constexpr int CI_AP = 0, CI_RH = 2304, CI_BT = 4608, CI_KT = 7168, CI_MP = 9728, CI_PP = 10368, CI_GL = 11520, CI_VT = 11776, CI_SZ = 14336;
constexpr int CS_AH = 0, CS_BH = 2304, CS_KH = 4608, CS_SZ = 6912;
constexpr int CS_NM = CS_BH, CS_TM = CS_BH + 1024, CS_MM = CS_BH + 2048;
constexpr int CIMG0 = 0, CSCR0 = 8 * CI_SZ;
static_assert(CSCR0 + 4 * CS_SZ <= LDS_BYTES - LDS_WORK, "chunked scan LDS");
constexpr size_t WS_GIMG2 = WS_WUP;
constexpr size_t WS_GIMG = WS_HB;
static_assert((size_t)32 * 12 * 4 * CI_SZ <= (size_t)2 * NTOK * 1024 * 2, "hand-off images do not fit HB + OB");
constexpr int SCAN_FLAG_WORD = 3584;
template <int MODE, int ROLE>
__device__ __forceinline__ void scanc_unit(const Frame& F, const PRef& p, int cid, int hid = 0) {
    constexpr int NSTEPS = MODE == 0 ? 1024 : 256, NCH = NSTEPS / 16, NG = NCH / 4;
    unsigned char* ws = p.ws();
    const float* RR = (const float*)(ws + WS_RR); const float* KR = (const float*)(ws + WS_KR); const float* VV = (const float*)(ws + WS_VV); const float* KK = (const float*)(ws + WS_KK);
    const float* DEC = (const float*)(ws + WS_DEC); const float* AA = (const float*)(ws + WS_AA);
    float* YY = (float*)(ws + WS_YY);
    LAS unsigned char* L = F.lds;
    const int lane = F.lane, fr = lane & 15, g = lane >> 4, w = F.wave;
    const int cb = cid >> 4, chh = (cid >> 1) & 7, cd = cid & 1;
    const int cbase = MODE == 0 ? NCTX + cb * 1024 : cb * 256;
#define TOK_OF(step) (cbase + (cd ? NSTEPS - 1 - (step) : (step)))
    unsigned* hflag = (unsigned*)(ws + WS_BAR) + SCAN_FLAG_WORD + cid * 16;
    unsigned char* gimg = ws + WS_GIMG + (size_t)cid * 12 * 4 * CI_SZ;
    unsigned char* gimg2 = ws + WS_GIMG2 + (size_t)cid * 4 * 4 * CI_SZ;
    const __amdgpu_buffer_rsrc_t grs = wt_rsrc(gimg, (size_t)12 * 4 * CI_SZ), grs2 = wt_rsrc(gimg2, (size_t)4 * 4 * CI_SZ);
    if (w >= 4 || ROLE == 2) {
        if (ROLE == 2 && w < 4) {
            for (int grp = hid; grp < NG; grp += 3) {
                __syncthreads();
                for (int i = F.tid; i < 4 * CI_SZ / 16; i += NTHREADS) wt_store16(grp < 12 ? grs : grs2, (size_t)(grp < 12 ? grp : grp - 12) * 4 * CI_SZ + (size_t)i * 16, *(const LAS u32x4*)(L + CIMG0 + (size_t)i * 16));
                asm volatile("s_waitcnt vmcnt(0)" ::: "memory");
                __syncthreads();
                if (F.tid == 0) __hip_atomic_store(hflag + grp, 1u, __ATOMIC_RELAXED, __HIP_MEMORY_SCOPE_AGENT);
                __syncthreads();
            }
            return;
        }
        const int j = w - 4, k = lane;
        if constexpr (ROLE == 1) {
            u32x4 pf[CI_SZ / 16 / 64];
            unsigned known = 0u;
#define RUN_FETCH(grp_) do { const int g_ = (grp_); \
                if (!((known >> g_) & 1u)) { unsigned sp = 0; for (;;) { const unsigned fl = lane < 16 ? __hip_atomic_load(hflag + lane, __ATOMIC_RELAXED, __HIP_MEMORY_SCOPE_AGENT) : 0u; \
                    known = (unsigned)__builtin_amdgcn_ballot_w64(fl != 0u) & 0xffffu; if (((known >> g_) & 1u) || ++sp > (1u << 22)) break; __builtin_amdgcn_s_sleep(2); } } \
                asm volatile("" ::: "memory"); \
                _Pragma("unroll") for (int i = 0; i < CI_SZ / 16 / 64; ++i)        \
                    pf[i] = __builtin_bit_cast(u32x4, __builtin_amdgcn_raw_buffer_load_b128(g_ < 12 ? grs : grs2, (int)(((size_t)(g_ < 12 ? g_ : g_ - 12) * 4 + j) * CI_SZ + (size_t)(i * 64 + lane) * 16), 0, 16)); } while (0)
            RUN_FETCH(0);
            for (int grp = 0; grp < NG; ++grp) {
                LAS unsigned char* IM = L + CIMG0 + ((grp & 1) * 4 + j) * CI_SZ;
#pragma unroll
                for (int i = 0; i < CI_SZ / 16 / 64; ++i) *(LAS u32x4*)(IM + (size_t)(i * 64 + lane) * 16) = pf[i];
                if (grp + 1 < NG) RUN_FETCH(grp + 1);
                __syncthreads();
            }
            __syncthreads();
#undef RUN_FETCH
            return;
        }
        LAS unsigned char* SC = L + CSCR0 + j * CS_SZ;
        const float ka = p.in(40)[chh * 64 + k];
        const size_t colo = (size_t)chh * 64 + k;
        const float* decp = DEC + (size_t)cd * NTOK * 512; const float* aap = AA + (size_t)cd * NTOK * 512;
        float rw[16], rkk[16], ra[16], rkr[16], rr[16], rv[16];
#define PREP_LOAD(chunk) do { _Pragma("unroll") for (int t = 0; t < 16; ++t) { const size_t o_ = (size_t)TOK_OF((chunk) * 16 + t) * 512 + colo; \
            rw[t] = decp[o_]; rkk[t] = KK[o_]; ra[t] = aap[o_]; rkr[t] = KR[o_]; rr[t] = RR[o_]; rv[t] = VV[o_]; } } while (0)
        PREP_LOAD(ROLE == 2 ? hid * 4 + j : j);
        for (int grp = (ROLE == 2 ? hid : 0); grp < NG; grp += (ROLE == 2 ? 3 : 1)) {
            LAS unsigned char* IM = L + CIMG0 + ((ROLE == 2 ? 0 : (grp & 1) * 4) + j) * CI_SZ;
            float ah[16]; float G = 1.0f;
#pragma unroll
            for (int t2 = 0; t2 < 8; ++t2) {
                float bh2[2], kh2[2];
#pragma unroll
                for (int u = 0; u < 2; ++u) {
                    const int t = 2 * t2 + u;
                    const float bb = rkk[t] * ra[t], kd = rkr[t] * (1.0f + (ra[t] - 1.0f) * ka);
                    ah[t] = -rkk[t] * G;
                    G *= rw[t];
                    const float inv = __builtin_amdgcn_rcpf(G);
                    const float bh = bb * inv, kh = kd * inv, rh = rr[t] * G;
                    bh2[u] = bh; kh2[u] = kh;
                    *(LAS bf16_t*)(SC + CS_AH + t * 144 + k * 2) = f2bf(ah[t]);
                    *(LAS bf16_t*)(SC + CS_BH + t * 144 + k * 2) = f2bf(bh);
                    *(LAS bf16_t*)(SC + CS_KH + t * 144 + k * 2) = f2bf(kh);
                    *(LAS bf16_t*)(IM + CI_RH + t * 144 + k * 2) = f2bf(rh);
                }
                *(LAS unsigned*)(IM + CI_BT + k * 40 + t2 * 4) = pack2(bh2[0], bh2[1]);
                *(LAS unsigned*)(IM + CI_KT + k * 40 + t2 * 4) = pack2(kh2[0], kh2[1]);
                *(LAS unsigned*)(IM + CI_VT + k * 40 + t2 * 4) = pack2(rv[2 * t2], rv[2 * t2 + 1]);
            }
            *(LAS float*)(IM + CI_GL + k * 4) = G;
            { const int ng_ = grp + (ROLE == 0 ? 1 : 3); if (ng_ < NG) PREP_LOAD(ng_ * 4 + j); }
            f32x4 dN = (f32x4){0.f, 0.f, 0.f, 0.f}, dM = dN, dPb = dN, dPk = dN;
#pragma unroll
            for (int s = 0; s < 2; ++s) {
                const int fo = fr * 144 + (4 * s + g) * 16;
                const bf16x8 fa = *(const LAS bf16x8*)(SC + CS_AH + fo), fb = *(const LAS bf16x8*)(SC + CS_BH + fo), fk = *(const LAS bf16x8*)(SC + CS_KH + fo), frh = *(const LAS bf16x8*)(IM + CI_RH + fo);
                dN = __builtin_amdgcn_mfma_f32_16x16x32_bf16(fa, fb, dN, 0, 0, 0); dM = __builtin_amdgcn_mfma_f32_16x16x32_bf16(fa, fk, dM, 0, 0, 0);
                dPb = __builtin_amdgcn_mfma_f32_16x16x32_bf16(frh, fb, dPb, 0, 0, 0); dPk = __builtin_amdgcn_mfma_f32_16x16x32_bf16(frh, fk, dPk, 0, 0, 0);
            }
#pragma unroll
            for (int r = 0; r < 4; ++r) {
                const int t = 4 * g + r;
                *(LAS float*)(SC + CS_MM + (t * 16 + fr) * 4) = fr < t ? dM[r] : 0.f;
                *(LAS bf16_t*)(IM + CI_PP + t * 72 + fr * 2) = f2bf(fr <= t ? dPb[r] : 0.f);
                *(LAS bf16_t*)(IM + CI_PP + t * 72 + (16 + fr) * 2) = f2bf(fr <= t ? dPk[r] : 0.f);
            }
            float Tc[16];
            Tc[0] = fr == 0 ? 1.0f : 0.f;
#pragma unroll
            for (int i = 1; i < 16; ++i) {
                float s0_ = fr == i ? 1.0f : 0.f, s1_ = 0.f;
#pragma unroll
                for (int jj = 0; jj < i; ++jj) {
                    const float nij = RDLANE(dN[i & 3], jj + 16 * (i >> 2));
                    if (jj & 1) s1_ += nij * Tc[jj]; else s0_ += nij * Tc[jj];
                }
                Tc[i] = s0_ + s1_;
            }
            if (g == 0) {
#pragma unroll
                for (int i = 0; i < 16; ++i) *(LAS float*)(SC + CS_TM + (i * 16 + fr) * 4) = Tc[i];
            }
#pragma unroll
            for (int i = 0; i < 16; ++i) {
                float s0_ = 0.f, s1_ = 0.f;
#pragma unroll
                for (int jj = 0; jj <= i; ++jj) { const float tij = RDLANE(Tc[i], jj); if (jj & 1) s1_ += tij * ah[jj]; else s0_ += tij * ah[jj]; }
                *(LAS bf16_t*)(IM + CI_AP + i * 144 + k * 2) = f2bf(s0_ + s1_);
            }
            {
                const int i = lane >> 2, j4 = (lane & 3) * 4;
                f32x4 macc = (f32x4){0.f, 0.f, 0.f, 0.f};
#pragma unroll
                for (int t = 0; t < 16; ++t) macc += *(const LAS f32x4*)(SC + CS_MM + (t * 16 + j4) * 4) * *(const LAS float*)(SC + CS_TM + (i * 16 + t) * 4);
                u32x2 pk; pk.x = pack2(macc[0], macc[1]); pk.y = pack2(macc[2], macc[3]);
                *(LAS u32x2*)(IM + CI_MP + i * 40 + j4 * 2) = pk;
            }
            if (ROLE == 2) {
                __syncthreads();
                for (int i = F.tid; i < 4 * CI_SZ / 16; i += NTHREADS) wt_store16(grp < 12 ? grs : grs2, (size_t)(grp < 12 ? grp : grp - 12) * 4 * CI_SZ + (size_t)i * 16, *(const LAS u32x4*)(L + CIMG0 + (size_t)i * 16));
                asm volatile("s_waitcnt vmcnt(0)" ::: "memory");
                __syncthreads();
                __syncthreads();
                continue;
            }
            __syncthreads();
        }
        if (ROLE == 2) return;
        __syncthreads();
#undef PREP_LOAD
    } else {
        f32x4 S[4];
        if (MODE == 0) {
            const float* s0 = p.in(7) + (size_t)(((cb * 2 + cd) * 8 + chh) * 64 + 16 * w + fr) * 64;
#pragma unroll
            for (int kt = 0; kt < 4; ++kt) S[kt] = *(const f32x4*)(s0 + 16 * kt + 4 * g);
        } else {
#pragma unroll
            for (int kt = 0; kt < 4; ++kt) S[kt] = (f32x4){0.f, 0.f, 0.f, 0.f};
        }
        float* yp = YY + (size_t)cd * NTOK * 512 + chh * 64 + 16 * w + fr;
        __syncthreads();
        for (int grp = 0; grp < NG; ++grp) {
#pragma unroll 2
            for (int c4 = 0; c4 < 4; ++c4) {
                const LAS unsigned char* IM = L + CIMG0 + ((grp & 1) * 4 + c4) * CI_SZ;
                u32x2 oa[2][2], orh[2][2], obt[4], okt[4]; f32x4 ogl[4];
#pragma unroll
                for (int s = 0; s < 2; ++s) {
                    oa[s][0] = *(const LAS u32x2*)(IM + CI_AP + fr * 144 + (32 * s + 4 * g) * 2); oa[s][1] = *(const LAS u32x2*)(IM + CI_AP + fr * 144 + (32 * s + 16 + 4 * g) * 2);
                    orh[s][0] = *(const LAS u32x2*)(IM + CI_RH + fr * 144 + (32 * s + 4 * g) * 2); orh[s][1] = *(const LAS u32x2*)(IM + CI_RH + fr * 144 + (32 * s + 16 + 4 * g) * 2);
                }
                const u32x2 vq = *(const LAS u32x2*)(IM + CI_VT + (16 * w + fr) * 40 + g * 8);
                const u32x2 m0 = *(const LAS u32x2*)(IM + CI_MP + fr * 40 + g * 8);
                const u32x2 p0 = *(const LAS u32x2*)(IM + CI_PP + fr * 72 + g * 8), p1 = *(const LAS u32x2*)(IM + CI_PP + fr * 72 + 32 + g * 8);
#pragma unroll
                for (int kt = 0; kt < 4; ++kt) {
                    obt[kt] = *(const LAS u32x2*)(IM + CI_BT + (16 * kt + fr) * 40 + g * 8); okt[kt] = *(const LAS u32x2*)(IM + CI_KT + (16 * kt + fr) * 40 + g * 8);
                    ogl[kt] = *(const LAS f32x4*)(IM + CI_GL + (16 * kt + 4 * g) * 4);
                }
                bf16x8 Sp[2];
#pragma unroll
                for (int s = 0; s < 2; ++s) { u32x4 pk; pk.x = pack2(S[2 * s][0], S[2 * s][1]); pk.y = pack2(S[2 * s][2], S[2 * s][3]); pk.z = pack2(S[2 * s + 1][0], S[2 * s + 1][1]); pk.w = pack2(S[2 * s + 1][2], S[2 * s + 1][3]); Sp[s] = __builtin_bit_cast(bf16x8, pk); }
                f32x4 U = (f32x4){0.f, 0.f, 0.f, 0.f}, Y = U;
#pragma unroll
                for (int s = 0; s < 2; ++s) {
                    U = __builtin_amdgcn_mfma_f32_16x16x32_bf16(__builtin_bit_cast(bf16x8, (u32x4){oa[s][0].x, oa[s][0].y, oa[s][1].x, oa[s][1].y}), Sp[s], U, 0, 0, 0);
                    Y = __builtin_amdgcn_mfma_f32_16x16x32_bf16(__builtin_bit_cast(bf16x8, (u32x4){orh[s][0].x, orh[s][0].y, orh[s][1].x, orh[s][1].y}), Sp[s], Y, 0, 0, 0);
                }
                U = __builtin_amdgcn_mfma_f32_16x16x32_bf16(__builtin_bit_cast(bf16x8, (u32x4){m0.x, m0.y, 0u, 0u}), __builtin_bit_cast(bf16x8, (u32x4){vq.x, vq.y, vq.x, vq.y}), U, 0, 0, 0);
                u32x4 uvk; uvk.x = pack2(U[0], U[1]); uvk.y = pack2(U[2], U[3]); uvk.z = vq.x; uvk.w = vq.y;
                const bf16x8 UV = __builtin_bit_cast(bf16x8, uvk);
#pragma unroll
                for (int kt = 0; kt < 4; ++kt) {
                    const f32x4 acc = __builtin_amdgcn_mfma_f32_16x16x32_bf16(__builtin_bit_cast(bf16x8, (u32x4){obt[kt].x, obt[kt].y, okt[kt].x, okt[kt].y}), UV, S[kt], 0, 0, 0);
                    S[kt] = acc * ogl[kt];
                }
                Y = __builtin_amdgcn_mfma_f32_16x16x32_bf16(__builtin_bit_cast(bf16x8, (u32x4){p0.x, p0.y, p1.x, p1.y}), UV, Y, 0, 0, 0);
                const int step0 = (grp * 4 + c4) * 16 + 4 * g;
#pragma unroll
                for (int r = 0; r < 4; ++r) yp[(size_t)TOK_OF(step0 + r) * 512] = Y[r];
            }
            __syncthreads();
        }
        if (MODE == 1) {
            float* so = p.out() + OUT_SRWKV + (size_t)(((cb * 2 + cd) * 8 + chh) * 64 + 16 * w + fr) * 64;
#pragma unroll
            for (int kt = 0; kt < 4; ++kt) *(f32x4*)(so + 16 * kt + 4 * g) = S[kt];
        }
    }
#undef TOK_OF
}
__device__ __forceinline__ void phase_l1_scanc(const Frame& F, const PRef& p) {
    if (F.G > 128) {
        if (F.bid < 32) scanc_unit<0, 1>(F, p, F.bid);
        else if (F.bid < 128) scanc_unit<0, 2>(F, p, (F.bid - 32) & 31, (F.bid - 32) >> 5);
        else for (int u = F.bid - 128; u < 256; u += F.G - 128) scanc_unit<1, 0>(F, p, u);
    } else { FOR_UNITS(u, 288, 0) { if (u < 32) scanc_unit<0, 0>(F, p, u); else scanc_unit<1, 0>(F, p, u - 32); } }
}
__device__ __forceinline__ void phase_l1_scan(const Frame& F, const PRef& p) {
    const int half = F.G / 2;
    if (F.bid < half) {
        for (int u = F.bid; u < 128; u += half) { const int xcd = u & 7, idx = u >> 3; scan_unit<0>(F, p, (((idx >> 2) * 8 + xcd) << 2) | (idx & 3)); }
    } else {
        for (int u = F.bid - half; u < 256; u += F.G - half) scan_unit<1>(F, p, u);
    }
}

__device__ __forceinline__ void phase_l1_comb(const Frame& F, const PRef& p) {
    unsigned char* ws = p.ws();
    const float* RR = (const float*)(ws + WS_RR); const float* KR = (const float*)(ws + WS_KR); const float* VV = (const float*)(ws + WS_VV);
    const float* AA = (const float*)(ws + WS_AA); const float* GG = (const float*)(ws + WS_GG); const float* YY = (const float*)(ws + WS_YY);
    bf16_t* OB = (bf16_t*)(ws + WS_OB);
    const int nw = F.G * 8, lane = F.lane;
    const bf16_t* DO = (const bf16_t*)(ws + WS_DO);
    const float lam_init = 0.8f - 0.6f * 0.74081822068171788f;
    const float lam = __expf(wave_sum(p.in(31)[lane] * p.in(31)[64 + lane])) - __expf(wave_sum(p.in(31)[128 + lane] * p.in(31)[192 + lane])) + lam_init;
    for (int row = F.bid * 8 + F.wave; row < NTOK; row += nw) {
#pragma unroll
        for (int h = 0; h < 4; ++h) {
            const unsigned a = *(const unsigned*)(DO + (size_t)row * 1024 + (2 * h) * 128 + 2 * lane), b = *(const unsigned*)(DO + (size_t)row * 1024 + (2 * h + 1) * 128 + 2 * lane);
            const float d0 = bf2f(a & 0xffffu) - lam * bf2f(b & 0xffffu), d1 = bf2f(a >> 16) - lam * bf2f(b >> 16);
            const float rstd = rsqrtf(wave_sum(d0 * d0 + d1 * d1) * (1.0f / 128.0f) + EPS) * (1.0f - lam_init);
            const f32x2 gn = *(const f32x2*)(p.in(32) + h * 128 + 2 * lane);
            *(unsigned*)(OB + (size_t)row * 1024 + h * 128 + 2 * lane) = pack2(d0 * rstd * gn[0], d1 * rstd * gn[1]);
        }
        const size_t o = (size_t)row * 512 + lane * 8;
        const f32x4 yf0 = *(const f32x4*)(YY + o), yf1 = *(const f32x4*)(YY + o + 4), yb0 = *(const f32x4*)(YY + (size_t)NTOK * 512 + o), yb1 = *(const f32x4*)(YY + (size_t)NTOK * 512 + o + 4);
        const f32x4 v0 = *(const f32x4*)(VV + o), v1 = *(const f32x4*)(VV + o + 4), g0 = *(const f32x4*)(GG + o), g1 = *(const f32x4*)(GG + o + 4);
        const f32x4 n0 = *(const f32x4*)(p.in(42) + lane * 8), n1 = *(const f32x4*)(p.in(42) + lane * 8 + 4);
        const float* BON = (const float*)(ws + WS_BON);
#if CHUNKED_SCAN
        float bs = 0.f;
        {
            const f32x4 r0 = *(const f32x4*)(RR + o), r1 = *(const f32x4*)(RR + o + 4), k0 = *(const f32x4*)(KR + o), k1 = *(const f32x4*)(KR + o + 4);
            const f32x4 af0 = *(const f32x4*)(AA + o), af1 = *(const f32x4*)(AA + o + 4), ab0 = *(const f32x4*)(AA + (size_t)NTOK * 512 + o), ab1 = *(const f32x4*)(AA + (size_t)NTOK * 512 + o + 4);
            const f32x4 ka0 = *(const f32x4*)(p.in(40) + lane * 8), ka1 = *(const f32x4*)(p.in(40) + lane * 8 + 4), rk0 = *(const f32x4*)(p.in(41) + lane * 8), rk1 = *(const f32x4*)(p.in(41) + lane * 8 + 4);
            const f32x4 t0 = r0 * rk0 * k0 * (2.0f + (af0 + ab0 - 2.0f) * ka0), t1 = r1 * rk1 * k1 * (2.0f + (af1 + ab1 - 2.0f) * ka1);
            bs = oct_sum((t0[0] + t0[1]) + (t0[2] + t0[3]) + (t1[0] + t1[1]) + (t1[2] + t1[3]));
        }
#else
        const float bs = BON[(size_t)row * 8 + (lane >> 3)] + BON[(size_t)NTOK * 8 + (size_t)row * 8 + (lane >> 3)];
#endif
        const f32x4 y0 = yf0 + yb0, y1 = yf1 + yb1;
        float ss = (y0[0] * y0[0] + y0[1] * y0[1]) + (y0[2] * y0[2] + y0[3] * y0[3]) + (y1[0] * y1[0] + y1[1] * y1[1]) + (y1[2] * y1[2] + y1[3] * y1[3]);
        ss = oct_sum(ss);
        const float rstd = rsqrtf(ss * (1.0f / 64.0f) + EPS);
        const f32x4 o0 = (y0 * rstd * n0 + bs * v0) * g0, o1 = (y1 * rstd * n1 + bs * v1) * g1;
        u32x4 w; w.x = pack2(o0[0], o0[1]); w.y = pack2(o0[2], o0[3]); w.z = pack2(o1[0], o1[1]); w.w = pack2(o1[2], o1[3]);
        *(u32x4*)(OB + (size_t)row * 1024 + 512 + lane * 8) = w;
    }
}

constexpr int NPHASE = 26;
#ifndef PH_ONLY
#define PH_ONLY -1
#endif
#if ONE_LAUNCH
#define SEAM() xcd_barrier(bar)
#else
#define SEAM() do {} while (0)
#endif
#define IN(k) (lo <= (k) && (k) < hi && (PH_ONLY < 0 || (k) == PH_ONLY))
#define END(k) do { if (IN((k) + 1)) SEAM(); } while (0)
#ifndef REP_MASK
#define REP_MASK 0u
#endif
#define REPS(k) for (int rep_ = 0; rep_ < 1 + (int)(((unsigned)REP_MASK >> (k)) & 1u); ++rep_, __syncthreads())

constexpr size_t WS_PARTA = WS_BIG;
constexpr size_t WS_PARTD = WS_U;
static_assert(WS_PARTD + (size_t)2 * NTOK * 1024 * 4 <= WS_ACT, "down-projection slabs overlap ACT");
template <int l>
__device__ __forceinline__ void layer_phases(const Frame& F, const PRef& p, const int lo, const int hi, const XcdBarrier bar) {
    constexpr int pb = 1 + l * 12;
    if (IN(pb + 0)) { REPS(pb + 0) {
        unsigned char* ws = p.ws(); const float* ml = (const float*)(ws + WS_MOD) + (size_t)l * 3 * 6144;
        if (l == 0) phase_norm(F, p.in(0), p.in(1), nullptr, nullptr, nullptr, p.in(12), ml + 1024, ml + 0, (bf16_t*)(ws + WS_HB), true);
        else { float* xbuf = p.out(); phase_norm(F, xbuf, xbuf + (size_t)NCTX * 1024, (const bf16_t*)(ws + WS_PARTD), (const float*)(ws + WS_MOD) + 5120, xbuf, p.in(12) + 1024, ml + 1024, ml + 0, (bf16_t*)(ws + WS_HB), true); }
        } END(pb + 0); }
    if (IN(pb + 1)) { REPS(pb + 1) {
        unsigned char* ws = p.ws();
        if (l == 0) { BigDesc g{(const bf16_t*)(ws + WS_HB), (const bf16_t*)(ws + WS_WAIN), 1024, 1024, 24, 8, 1, 1024}; EpiF32WT E{wt_rsrc(ws + WS_P0, (size_t)NTOK * 2048 * 4), 2048}; gemm_big<false>(F, g, E); if (F.G == 256) cvt_group(F, p, 1, 192, 64, 0); else cvt_group(F, p, 1, 0, F.G, 0); }
        else {
            BigDesc g{(const bf16_t*)(ws + WS_HB), (const bf16_t*)(ws + WS_WBIN), 1024, 1024, 24, 14, 1, 1024}; EpiF32WT E{wt_rsrc(ws + WS_P1, (size_t)NTOK * 3584 * 4), 3584}; gemm_big<false, EpiF32WT, true>(F, g, E);
        }
        } END(pb + 1);
    }
    if (IN(pb + 2)) { REPS(pb + 2) { if (l == 0) phase_l0_tok(F, p); else phase_l1_tok(F, p); } END(pb + 2); }
    if (IN(pb + 3)) { REPS(pb + 3) {
        unsigned char* ws = p.ws();
        if (l == 0) {
            { GemmDesc g{(const bf16_t*)(ws + WS_CQN), (const bf16_t*)(ws + WS_WUQ), 256, 256, NTOK, 768, 256}; EpiF32 E{(float*)(ws + WS_QRAW), 768, 768}; gemm_s(F, g, E, 0); }
            { GemmDesc g{(const bf16_t*)(ws + WS_CKVN), (const bf16_t*)(ws + WS_WUKV), 128, 128, NKROW, 1024, 128}; EpiF32 E{(float*)(ws + WS_KVRAW), 1024, 1024}; gemm_s(F, g, E, 48 * 6); }
            phase_l0_prefix(F, p, 48 * 6 + 56 * 8);
        } else {
            const bf16_t* TW = (const bf16_t*)(ws + WS_TW); const bf16_t* AD = (const bf16_t*)(ws + WS_AD); const bf16_t* SG = (const bf16_t*)(ws + WS_SG);
            float* DEC = (float*)(ws + WS_DEC); float* AA = (float*)(ws + WS_AA);
            { GemmDesc g{TW, (const bf16_t*)(ws + WS_WWUP), 128, 64, NTOK, 512, 64}; EpiDecay E{DEC, p.in(34)}; gemm_s(F, g, E, 0); }
            { GemmDesc g{TW + 64, (const bf16_t*)(ws + WS_WWUP) + 512 * 64, 128, 64, NTOK, 512, 64}; EpiDecay E{DEC + (size_t)NTOK * 512, p.in(34) + 512}; gemm_s(F, g, E, 192); }
            { GemmDesc g{AD, (const bf16_t*)(ws + WS_WAUP), 128, 64, NTOK, 512, 64}; EpiSigm E{AA, p.in(36)}; gemm_s(F, g, E, 384); }
            { GemmDesc g{AD + 64, (const bf16_t*)(ws + WS_WAUP) + 512 * 64, 128, 64, NTOK, 512, 64}; EpiSigm E{AA + (size_t)NTOK * 512, p.in(36) + 512}; gemm_s(F, g, E, 576); }
            { GemmDesc g{SG, (const bf16_t*)(ws + WS_WGUP), 128, 128, NTOK, 512, 128}; EpiF32 E{(float*)(ws + WS_GG), 512, 512}; gemm_s(F, g, E, 768); }
            phase_l1_mix(F, p);
        }
        } END(pb + 3);
    }
    if (l == 0 && IN(pb + 4)) { REPS(pb + 4) { phase_l0_qkv(F, p); } END(pb + 4); }
    if (IN(pb + 5)) { REPS(pb + 5) { if (l == 0) phase_l0_mix(F, p); else {
#if CHUNKED_SCAN
            phase_l1_scanc(F, p);
#else
            phase_l1_scan(F, p);
#endif
        } } END(pb + 5); }
    if (l == 1 && IN(pb + 6)) { REPS(pb + 6) { phase_l1_comb(F, p); } END(pb + 6); }
    if (IN(pb + 7)) { REPS(pb + 7) {
        unsigned char* ws = p.ws();
        BigDesc g{(const bf16_t*)(ws + WS_OB), (const bf16_t*)(ws + WS_WOUT) + (size_t)l * 1024 * 1024, 1024, 1024, 24, 4, 2, 512};
        EpiPartWT E{wt_rsrc(ws + WS_PARTA, (size_t)2 * NTOK * 1024 * 2), (size_t)NTOK * 1024}; gemm_big<true>(F, g, E);
        if (l == 0) { if (F.G == 256) cvt_group(F, p, 3, 192, 64, 0); else cvt_group(F, p, 3, 0, F.G, 0); }
        } END(pb + 7);
    }
    if (IN(pb + 8)) { REPS(pb + 8) {
        unsigned char* ws = p.ws(); const float* ml = (const float*)(ws + WS_MOD) + (size_t)l * 3 * 6144; float* xbuf = p.out();
        const float* xa = l == 0 ? p.in(0) : xbuf; const float* xb = l == 0 ? p.in(1) : xbuf + (size_t)NCTX * 1024;
        phase_norm(F, xa, xb, (const bf16_t*)(ws + WS_PARTA), ml + 2048, xbuf, p.in(13) + l * 1024, ml + 4096, ml + 3072, (bf16_t*)(ws + WS_HB), true); } END(pb + 8); }
    if (IN(pb + 9)) { REPS(pb + 9) {
        unsigned char* ws = p.ws();
        const bf16_t* wup = (const bf16_t*)(ws + WS_WUP) + (size_t)l * 5632 * 1024;
        gemm_upgate(F, (const bf16_t*)(ws + WS_HB), wup, p.in(16) + (size_t)l * 3 * 5632, p.in(17) + (size_t)l * 5632, (bf16_t*)(ws + WS_ACT), (l == 1 && F.G == 256) ? 1 : 0);
        } END(pb + 9);
    }
    if (IN(pb + 11)) { REPS(pb + 11) {
        unsigned char* ws = p.ws();
        BigDesc g{(const bf16_t*)(ws + WS_ACT), (const bf16_t*)(ws + WS_WDN) + (size_t)l * 1024 * 2816, 2816, 2816, 24, 4, 2, 1408};
        if (l == 1 && F.G == 256) {
            unsigned* updone = (unsigned*)(ws + WS_BAR) + UPDONE_WORD;
            if (F.bid < 120) {
                const bf16_t* wup = (const bf16_t*)(ws + WS_WUP) + (size_t)l * 5632 * 1024;
                gemm_upgate(F, (const bf16_t*)(ws + WS_HB), wup, p.in(16) + (size_t)l * 3 * 5632, p.in(17) + (size_t)l * 5632, (bf16_t*)(ws + WS_ACT), 2);
                asm volatile("s_waitcnt vmcnt(0)" ::: "memory");
                __syncthreads();
                if (F.tid == 0) {
                    __builtin_amdgcn_fence(__ATOMIC_RELEASE, "agent");
                    (void)xb_add(updone, 1u);
                    if (F.bid >= 64 && F.bid < 112) { XB_SPIN(xb_ld(updone) < 120u, (unsigned*)(ws + WS_BAR)); __builtin_amdgcn_fence(__ATOMIC_ACQUIRE, "agent"); }
                }
                __syncthreads();
            }
            EpiPartWT E{wt_rsrc(ws + WS_PARTD, (size_t)4 * NTOK * 1024 * 2), (size_t)NTOK * 1024}; gemm_big<true, EpiPartWT, false, 1>(F, g, E);
        } else {
            EpiPartWT E{wt_rsrc(ws + WS_PARTD, (size_t)2 * NTOK * 1024 * 2), (size_t)NTOK * 1024}; gemm_big<true>(F, g, E);
            if (l == 0) { if (F.G == 256) cvt_group(F, p, 2, 192, 64, 0); else cvt_group(F, p, 2, 0, F.G, 0); }
        }
        } END(pb + 11);
    }
}

__global__ void __launch_bounds__(NTHREADS, 2) fwd_kernel(Params kp) {
    extern __shared__ __attribute__((aligned(16))) unsigned char lds_raw[];
    Frame F;
    F.lds = (LAS unsigned char*)lds_raw + LDS_WORK;
    F.tid = threadIdx.x; F.lane = F.tid & 63; F.wave = __builtin_amdgcn_readfirstlane(F.tid >> 6); F.G = gridDim.x; F.bid = blockIdx.x;
    {
        LAS unsigned* pw = (LAS unsigned*)((LAS unsigned char*)lds_raw + 64);
        if (F.tid < (int)(sizeof(Params) / 4)) pw[F.tid] = ((const unsigned*)&kp)[F.tid];
        if (F.tid < 4) ((LAS unsigned*)((LAS unsigned char*)lds_raw))[F.tid] = 0u;
    }
    __syncthreads();
    PRef p; p.w = (const LAS unsigned*)((LAS unsigned char*)lds_raw + 64);
    const int lo = kp.ph_lo, hi = kp.ph_hi;
    XcdBarrier bar; bar.bar = nullptr; bar.x = 0; bar.st = nullptr;
#if ONE_LAUNCH
    bar = xcd_barrier_post((unsigned*)(p.ws() + WS_BAR), (volatile LAS unsigned*)((LAS unsigned char*)lds_raw));
#endif
#ifdef EXTRA_BARS
    for (int i_ = 0; i_ < EXTRA_BARS; ++i_) SEAM();
#endif
    if (IN(0)) { REPS(0) { phase_prep(F, p); } END(0); }
    layer_phases<0>(F, p, lo, hi, bar);
    layer_phases<1>(F, p, lo, hi, bar);
    if (IN(25)) {
        unsigned char* ws = p.ws(); float* xbuf = p.out();
        phase_norm(F, xbuf, xbuf + (size_t)NCTX * 1024, (const bf16_t*)(ws + WS_PARTD), (const float*)(ws + WS_MOD) + 3 * 6144 + 5120, xbuf, nullptr, nullptr, nullptr, nullptr, false, F.G == 256 ? 17 * 256 : NTOK);
    }
}

extern "C" void kernel_launch(void* const* d_in, const int* in_sizes, int n_in, void* d_out, int out_size, void* d_ws, size_t ws_size, hipStream_t stream) {
    static int grid = 0;
    if (grid == 0) {
        if (n_in != 43 || (size_t)out_size != OUT_END || ws_size < WS_END) { fprintf(stderr, "kernel_launch: unexpected shapes: n_in %d out %d ws %zu (need %zu)\n", n_in, out_size, ws_size, (size_t)WS_END); grid = -1; return; }
        int dev = 0, cus = 0, per_cu = 0;
        if (hipGetDevice(&dev) != hipSuccess || hipDeviceGetAttribute(&cus, hipDeviceAttributeMultiprocessorCount, dev) != hipSuccess) { grid = -1; return; }
        if (hipFuncSetAttribute((const void*)fwd_kernel, hipFuncAttributeMaxDynamicSharedMemorySize, LDS_BYTES) != hipSuccess) { fprintf(stderr, "kernel_launch: hipFuncSetAttribute failed\n"); grid = -1; return; }
        if (hipOccupancyMaxActiveBlocksPerMultiprocessor(&per_cu, (const void*)fwd_kernel, NTHREADS, LDS_BYTES) != hipSuccess || per_cu < 1) { fprintf(stderr, "kernel_launch: occupancy query says %d blocks per CU\n", per_cu); grid = -1; (void)hipGetLastError(); return; }
        grid = cus;
    }
    if (grid < 0) return;
    Params p{};
    for (int i = 0; i < 43; ++i) p.in[i] = (const float*)d_in[i];
    p.out = (float*)d_out; p.ws = (unsigned char*)d_ws;
#if ONE_LAUNCH
    (void)hipMemsetAsync((char*)d_ws + WS_BAR, 0, 16384, stream);
    p.ph_lo = 0; p.ph_hi = NPHASE;
    void* args[] = {&p};
    hipError_t e = hipLaunchCooperativeKernel((const void*)fwd_kernel, dim3(grid), dim3(NTHREADS), args, LDS_BYTES, stream);
    if (e != hipSuccess) fprintf(stderr, "cooperative launch failed: %s (grid %d)\n", hipGetErrorString(e), grid);
#else
    for (int ph = 0; ph < NPHASE; ++ph) {
        p.ph_lo = ph; p.ph_hi = ph + 1;
        hipLaunchKernelGGL(fwd_kernel, dim3(grid), dim3(NTHREADS), LDS_BYTES, stream, p);
    }
#endif
}
```

```cpp
#include <hip/hip_runtime.h>
#include <cstdio>
#include <cstdint>

#define LAS __attribute__((address_space(3)))
typedef unsigned short bf16_t;
typedef short bf16x8 __attribute__((ext_vector_type(8)));
typedef short bf16x4 __attribute__((ext_vector_type(4)));
typedef float f32x4 __attribute__((ext_vector_type(4)));
typedef float f32x2 __attribute__((ext_vector_type(2)));
typedef unsigned u32x2 __attribute__((ext_vector_type(2)));
typedef unsigned u32x4 __attribute__((ext_vector_type(4)));

#define REP_MASK 0u
#define ATT_REP 0
#define SCAN_REP 0
#ifndef CHUNKED_SCAN
#define CHUNKED_SCAN 1
#endif
#ifndef ONE_LAUNCH
#define ONE_LAUNCH 1
#endif

constexpr int NTHREADS = 512;
constexpr int LDS_BYTES = 144 * 1024;
constexpr int LDS_WORK = 1024;
constexpr int DM = 1024, NCTX = 4096, NLAT = 2048, NTOK = 6144, NKROW = 7168, DFF = 2816;
constexpr float EPS = 1e-6f;

constexpr size_t al256(size_t x) { return (x + 255) & ~(size_t)255; }
constexpr size_t WS_BAR = 0;
constexpr size_t WS_MOD = WS_BAR + 16384;
constexpr size_t WS_WAIN = al256(WS_MOD + 2 * 3 * 6144 * 4);
constexpr size_t WS_WUQ = WS_WAIN + (size_t)2048 * 1024 * 2;
constexpr size_t WS_WUKV = WS_WUQ + (size_t)768 * 256 * 2;
constexpr size_t WS_WOUT = WS_WUKV + (size_t)1024 * 128 * 2;
constexpr size_t WS_WUP = WS_WOUT + (size_t)2 * 1024 * 1024 * 2;
constexpr size_t WS_WDN = WS_WUP + (size_t)2 * 5632 * 1024 * 2;
constexpr size_t WS_WBIN = WS_WDN + (size_t)2 * 1024 * 2816 * 2;
constexpr size_t WS_WWUP = WS_WBIN + (size_t)3584 * 1024 * 2;
constexpr size_t WS_WAUP = WS_WWUP + (size_t)2 * 512 * 64 * 2;
constexpr size_t WS_WGUP = WS_WAUP + (size_t)2 * 512 * 64 * 2;
constexpr size_t WS_HB = WS_WGUP + (size_t)512 * 128 * 2;
constexpr size_t WS_OB = WS_HB + (size_t)NTOK * 1024 * 2;
constexpr size_t WS_BIG = WS_OB + (size_t)NTOK * 1024 * 2;
constexpr size_t WS_P0 = WS_BIG;
constexpr size_t WS_CQN = WS_P0 + (size_t)NTOK * 2048 * 4;
constexpr size_t WS_CKVN = WS_CQN + (size_t)NTOK * 256 * 2;
constexpr size_t WS_QRAW = WS_CKVN + (size_t)NKROW * 128 * 2;
constexpr size_t WS_KVRAW = WS_QRAW + (size_t)NTOK * 768 * 4;
constexpr size_t WS_Q0 = WS_KVRAW + (size_t)NKROW * 1024 * 4;
constexpr size_t WS_K0 = WS_Q0 + (size_t)NTOK * 768 * 2;
constexpr size_t WS_VT0 = WS_K0 + (size_t)NKROW * 768 * 2;
constexpr size_t WS_KVS = WS_VT0 + (size_t)NKROW * 512 * 2;
constexpr size_t WS_L0END = WS_KVS + (size_t)384 * 2 * 8192 * 4;
constexpr size_t WS_U = WS_BIG;
constexpr size_t WS_ACT = WS_U + (size_t)NTOK * 5632 * 2;
constexpr size_t WS_FFNEND = WS_ACT + (size_t)NTOK * 2816 * 2;
constexpr size_t WS_P1 = WS_BIG;
constexpr size_t WS_DEC = WS_BIG;
constexpr size_t WS_AA = WS_DEC + (size_t)2 * NTOK * 512 * 4;
constexpr size_t WS_GG = WS_AA + (size_t)2 * NTOK * 512 * 4;
constexpr size_t WS_YY = WS_GG + (size_t)NTOK * 512 * 4;
constexpr size_t WS_QD = WS_P1 + (size_t)NTOK * 3584 * 4;
constexpr size_t WS_KD = WS_QD + (size_t)NTOK * 512 * 2;
constexpr size_t WS_VDT = WS_KD + (size_t)NKROW * 512 * 2;
constexpr size_t WS_RR = WS_VDT + (size_t)NKROW * 512 * 2;
constexpr size_t WS_KR = WS_RR + (size_t)NTOK * 512 * 4;
constexpr size_t WS_VV = WS_KR + (size_t)NTOK * 512 * 4;
constexpr size_t WS_KK = WS_VV + (size_t)NTOK * 512 * 4;
constexpr size_t WS_TW = WS_KK + (size_t)NTOK * 512 * 4;
constexpr size_t WS_AD = WS_TW + (size_t)NTOK * 128 * 2;
constexpr size_t WS_SG = WS_AD + (size_t)NTOK * 128 * 2;
constexpr size_t WS_DO = WS_SG + (size_t)NTOK * 128 * 2;
constexpr size_t WS_BON = WS_DO + (size_t)NTOK * 1024 * 2;
constexpr size_t WS_L1END = WS_BON + (size_t)2 * NTOK * 8 * 4;
constexpr size_t cmax(size_t a, size_t b) { return a > b ? a : b; }
constexpr size_t WS_END = cmax(cmax(WS_L0END, WS_FFNEND), WS_L1END);
static_assert(WS_YY + (size_t)2 * NTOK * 512 * 4 <= WS_QD, "layer-1 overlay");
static_assert(WS_END <= (size_t)256 * 1024 * 1024, "workspace exceeds 256 MiB");

constexpr size_t OUT_X = 0;
constexpr size_t OUT_CKV = (size_t)NTOK * 1024;
constexpr size_t OUT_KROPE = OUT_CKV + (size_t)NCTX * 128;
constexpr size_t OUT_SRET = OUT_KROPE + (size_t)NCTX * 32;
constexpr size_t OUT_DK = OUT_SRET + (size_t)16 * 2 * 4 * 8192;
constexpr size_t OUT_DV = OUT_DK + (size_t)NCTX * 512;
constexpr size_t OUT_SRWKV = OUT_DV + (size_t)NCTX * 512;
constexpr size_t OUT_END = OUT_SRWKV + (size_t)16 * 2 * 8 * 4096;

struct Params {
    const float* in[43];
    float* out;
    unsigned char* ws;
    int ph_lo, ph_hi;
};

struct PRef {
    const LAS unsigned* w;
    __device__ __forceinline__ unsigned long long q(int i) const {
        const unsigned lo = (unsigned)__builtin_amdgcn_readfirstlane((int)w[2 * i]), hi = (unsigned)__builtin_amdgcn_readfirstlane((int)w[2 * i + 1]);
        return ((unsigned long long)hi << 32) | lo; }
    __device__ __forceinline__ const float* in(int k) const { return (const float*)(const __attribute__((address_space(1))) float*)q(k); }
    __device__ __forceinline__ float* out() const { return (float*)(__attribute__((address_space(1))) float*)q(43); }
    __device__ __forceinline__ unsigned char* ws() const { return (unsigned char*)(__attribute__((address_space(1))) unsigned char*)q(44); }
};

typedef __bf16 hwbf16x2 __attribute__((ext_vector_type(2)));
__device__ __forceinline__ unsigned pack2(float a, float b) { const f32x2 v = (f32x2){a, b}; return __builtin_bit_cast(unsigned, __builtin_convertvector(v, hwbf16x2)); }
__device__ __forceinline__ bf16_t f2bf(float f) { return (bf16_t)(pack2(f, 0.f) & 0xffffu); }
__device__ __forceinline__ float bf2f(unsigned b) { return __uint_as_float(b << 16); }
#define RDLANE(x, l) __int_as_float(__builtin_amdgcn_readlane(__float_as_int(x), (l)))
#define DPPF(x, ctrl) __int_as_float(__builtin_amdgcn_update_dpp(0, __float_as_int(x), (ctrl), 0xF, 0xF, true))
__device__ __forceinline__ float row16_sum(float v) {
    v += DPPF(v, 0xB1); v += DPPF(v, 0x4E); v += DPPF(v, 0x141); v += DPPF(v, 0x140); return v; }
__device__ __forceinline__ float oct_sum(float v) {
    v += DPPF(v, 0xB1); v += DPPF(v, 0x4E); v += DPPF(v, 0x141); return v; }
__device__ __forceinline__ float wave_sum(float v) {
    v = row16_sum(v);
    return (RDLANE(v, 0) + RDLANE(v, 16)) + (RDLANE(v, 32) + RDLANE(v, 48));
}
__device__ __forceinline__ float half_sum(float v, int lane) {
    v = row16_sum(v);
    const float a = RDLANE(v, 0) + RDLANE(v, 16), b = RDLANE(v, 32) + RDLANE(v, 48);
    return lane < 32 ? a : b;
}
__device__ __forceinline__ float sigmoidf_(float x) { return __builtin_amdgcn_rcpf(1.0f + __expf(-x)); }
__device__ __forceinline__ float siluf_(float x) { return x * sigmoidf_(x); }
__device__ __forceinline__ float tanhf_(float x) { return 1.0f - 2.0f * __builtin_amdgcn_rcpf(__expf(2.0f * x) + 1.0f); }
__device__ __forceinline__ int cond_of(int row) { return row < NCTX ? 0 : 1 + ((row - NCTX) >> 10); }

#define XB_TMO      128
#define XB_XCNT(j)  (256  + 64 * (j))
#define XB_XSUB(j)  (1280 + 64 * (j))
#define XB_XGEN(j)  (2304 + 64 * (j))
#define XB_TOP      3328
#define XB_TOPGEN   3392
#define XCD_BAR_WORDS 3456
#define UPDONE_WORD 3520
#define XB_SPIN_CAP (1u << 20)
__device__ __forceinline__ unsigned xb_ld(unsigned* p) { return __hip_atomic_load(p, __ATOMIC_RELAXED, __HIP_MEMORY_SCOPE_AGENT); }
__device__ __forceinline__ unsigned xb_add(unsigned* p, unsigned v) { return __hip_atomic_fetch_add(p, v, __ATOMIC_RELAXED, __HIP_MEMORY_SCOPE_AGENT); }
__device__ __forceinline__ unsigned xb_xcc_id() { return (unsigned)__builtin_amdgcn_s_getreg((3 << 11) | 20) & 0xFu; }
#define XB_SPIN(cond, bar) do { unsigned _sp = 0; while (cond) { __builtin_amdgcn_s_sleep(1); \
    if ((++_sp & 255u) == 0u) { if (xb_ld(&(bar)[XB_TMO])) break; if (_sp > XB_SPIN_CAP) { atomicAdd(&(bar)[XB_TMO], 1u); break; } } } } while (0)
struct XcdBarrier { unsigned* bar; unsigned x; volatile LAS unsigned* st; };
__device__ __forceinline__ XcdBarrier xcd_barrier_post(unsigned* bar, volatile LAS unsigned* st) {
    XcdBarrier b; b.bar = bar; b.x = xb_xcc_id(); b.st = st;
    if (threadIdx.x == 0) (void)xb_add(&bar[XB_XCNT(b.x)], 1u);
    return b;
}
__device__ __forceinline__ void xcd_barrier_complete(unsigned* bar, unsigned x, unsigned& nloc, unsigned& nx) {
    const unsigned G = gridDim.x * gridDim.y * gridDim.z;
    unsigned sum, cnt, mine, sp = 0u;
    for (;;) {
        sum = 0u; cnt = 0u; mine = 0u;
#pragma unroll
        for (unsigned j = 0; j < 16; ++j) { const unsigned c = xb_ld(&bar[XB_XCNT(j)]); sum += c; cnt += (c > 0u) ? 1u : 0u; mine = (j == x) ? c : mine; }
        if (sum == G) break;
        __builtin_amdgcn_s_sleep(1);
        if ((++sp & 255u) == 0u) { if (xb_ld(&bar[XB_TMO])) break; if (sp > XB_SPIN_CAP) { atomicAdd(&bar[XB_TMO], 1u); break; } }
    }
    nloc = mine > 0u ? mine : 1u; nx = cnt > 0u ? cnt : 1u;
}
__device__ __forceinline__ void xcd_barrier(const XcdBarrier& b) {
    asm volatile("s_waitcnt vmcnt(0)" ::: "memory");
    __syncthreads();
    if (threadIdx.x == 0) {
        unsigned* bar = b.bar;
        __builtin_amdgcn_s_waitcnt(0);
        unsigned nloc = b.st[0], nx = b.st[1];
        if (nloc == 0u) { xcd_barrier_complete(bar, b.x, nloc, nx); b.st[0] = nloc; b.st[1] = nx; }
        const unsigned old = xb_add(&bar[XB_XSUB(b.x)], 1u);
        const unsigned gen = old / nloc;
        if (old + 1u == (gen + 1u) * nloc) {
            __builtin_amdgcn_fence(__ATOMIC_RELEASE, "agent");
            asm volatile("s_waitcnt vmcnt(0)" ::: "memory");
            const unsigned og = xb_add(&bar[XB_TOP], 1u);
            const unsigned tg = og / nx;
            if (og + 1u == (tg + 1u) * nx) xb_add(&bar[XB_TOPGEN], 1u);
            else XB_SPIN(xb_ld(&bar[XB_TOPGEN]) == tg, bar);
            __builtin_amdgcn_fence(__ATOMIC_ACQUIRE, "agent");
            xb_add(&bar[XB_XGEN(b.x)], 1u);
            asm volatile("s_waitcnt vmcnt(0)" ::: "memory");
        } else {
            XB_SPIN(xb_ld(&bar[XB_XGEN(b.x)]) == gen, bar);
            __builtin_amdgcn_fence(__ATOMIC_ACQUIRE, "agent");
            asm volatile("s_waitcnt vmcnt(0)" ::: "memory");
        }
    }
    __syncthreads();
}

struct Frame {
    LAS unsigned char* lds;
    int tid, lane, wave, G, bid;
};
#define FOR_UNITS(u, n, rot) for (int u = (int)((F.bid + F.G - ((rot) % F.G)) % F.G); u < (n); u += F.G)

__device__ __forceinline__ int lds_byte(int r, int c) { const int st = (r >> 4) * 2 + (c >> 5), rr = r & 15, cc = c & 31, ob = rr * 64 + cc * 2; return st * 1024 + (ob ^ (((ob >> 9) & 1) << 5)); }
__device__ __forceinline__ void stage_rc(int b, int& R, int& C) { const int st = b / 1024, sb = b % 1024, swz = sb ^ (((sb >> 9) & 1) << 5); R = (st >> 1) * 16 + swz / 64; C = (st & 1) * 32 + (swz % 64) / 2; }

struct GemmDesc { const bf16_t* A; const bf16_t* Bt; int lda, ldb, M, N, K; };

typedef unsigned u32x4v __attribute__((ext_vector_type(4)));
__device__ __forceinline__ __amdgpu_buffer_rsrc_t wt_rsrc(void* base, size_t bytes) { return __builtin_amdgcn_make_buffer_rsrc(base, 0, (int)bytes, 0x00020000); }
__device__ __forceinline__ void wt_store16(const __amdgpu_buffer_rsrc_t r, size_t byte_off, u32x4 v) { __builtin_amdgcn_raw_buffer_store_b128(v, r, (int)byte_off, 0, 16); }
struct EpiF32 { float* C; int ldc, ncols;
    __device__ __forceinline__ void operator()(int r, int c, f32x4 v, int ks = 0) const { if (c < ncols) *(f32x4*)(C + (size_t)r * ldc + c) = v; } };
struct EpiF32WT { __amdgpu_buffer_rsrc_t R; int ldc;
    __device__ __forceinline__ void operator()(int r, int c, f32x4 v, int ks = 0) const { wt_store16(R, ((size_t)r * ldc + c) * 4, __builtin_bit_cast(u32x4, v)); } };
struct EpiBf16 { bf16_t* C; int ldc, ncols;
    __device__ __forceinline__ void e8(int r, int c, f32x4 v0, f32x4 v1, int ks = 0) const { u32x4 w; w.x = pack2(v0[0], v0[1]); w.y = pack2(v0[2], v0[3]); w.z = pack2(v1[0], v1[1]); w.w = pack2(v1[2], v1[3]); *(u32x4*)(C + (size_t)r * ldc + c) = w; }
    __device__ __forceinline__ void operator()(int r, int c, f32x4 v, int ks = 0) const { if (c < ncols) { u32x2 w; w.x = pack2(v[0], v[1]); w.y = pack2(v[2], v[3]); *(u32x2*)(C + (size_t)r * ldc + c) = w; } } };
struct EpiPart { bf16_t* C; size_t kstride;
    __device__ __forceinline__ void e8(int r, int c, f32x4 v0, f32x4 v1, int ks) const { u32x4 w; w.x = pack2(v0[0], v0[1]); w.y = pack2(v0[2], v0[3]); w.z = pack2(v1[0], v1[1]); w.w = pack2(v1[2], v1[3]);
        *(u32x4*)(C + (size_t)ks * kstride + (size_t)r * 1024 + c) = w; } };
struct EpiBf16WT { __amdgpu_buffer_rsrc_t R; int ldc;
    __device__ __forceinline__ void e8(int r, int c, f32x4 v0, f32x4 v1, int ks = 0) const { u32x4 w; w.x = pack2(v0[0], v0[1]); w.y = pack2(v0[2], v0[3]); w.z = pack2(v1[0], v1[1]); w.w = pack2(v1[2], v1[3]);
        wt_store16(R, ((size_t)r * ldc + c) * 2, w); } };
struct EpiPartWT { __amdgpu_buffer_rsrc_t R; size_t kstride;
    __device__ __forceinline__ void e8(int r, int c, f32x4 v0, f32x4 v1, int ks) const { u32x4 w; w.x = pack2(v0[0], v0[1]); w.y = pack2(v0[2], v0[3]); w.z = pack2(v1[0], v1[1]); w.w = pack2(v1[2], v1[3]);
        wt_store16(R, ((size_t)ks * kstride + (size_t)r * 1024 + c) * 2, w); } };
struct EpiResid { const float* xa; const float* xb; float* xo; const float* gate;
    __device__ __forceinline__ void operator()(int r, int c, f32x4 v, int ks = 0) const {
        const float* xs = r < NCTX ? xa + (size_t)r * 1024 : xb + (size_t)(r - NCTX) * 1024;
        const f32x4 x = *(const f32x4*)(xs + c); const f32x4 g = *(const f32x4*)(gate + cond_of(r) * 6144 + c);
        *(f32x4*)(xo + (size_t)r * 1024 + c) = x + g * v; } };
struct EpiDecay { float* C; const float* w0;
    __device__ __forceinline__ void operator()(int r, int c, f32x4 v, int ks = 0) const { const f32x4 b = *(const f32x4*)(w0 + c); f32x4 o;
#pragma unroll
        for (int j = 0; j < 4; ++j) o[j] = __expf(-0.60653065971f * sigmoidf_(b[j] + v[j]));
        *(f32x4*)(C + (size_t)r * 512 + c) = o; } };
struct EpiSigm { float* C; const float* a0;
    __device__ __forceinline__ void operator()(int r, int c, f32x4 v, int ks = 0) const { const f32x4 b = *(const f32x4*)(a0 + c); f32x4 o;
#pragma unroll
        for (int j = 0; j < 4; ++j) o[j] = sigmoidf_(b[j] + v[j]);
        *(f32x4*)(C + (size_t)r * 512 + c) = o; } };

template <class Epi>
__device__ __forceinline__ void gemm_s(const Frame& F, const GemmDesc g, const Epi& E, int rot, int ufirst = -1, int ustep = 0, int ulast = 0) {
    LAS unsigned char* lds = F.lds;
    const int tid = F.tid, wid = F.wave, lane = F.lane, wr = wid >> 2, wc = wid & 3, fr = lane & 15, fq = lane >> 4;
    const int nM = g.M / 128, nN = g.N / 128, nU = nM * nN, nt = g.K / 64;
    int R0, C0, R1, C1; stage_rc(tid * 16, R0, C0); stage_rc(tid * 16 + 8192, R1, C1);
    const int aoff = lds_byte(wr * 64 + fr, fq * 8), boff = lds_byte(wc * 32 + fr, fq * 8);
    const unsigned ldsw = (unsigned)wid * 1024u;
#define GS_STAGE(buf, t) do { \
        __builtin_amdgcn_global_load_lds((const unsigned*)(Ag + (size_t)R0 * g.lda + (t) * 64 + C0), (LAS unsigned*)(lds + (buf) * 32768 + ldsw), 16, 0, 0); \
        __builtin_amdgcn_global_load_lds((const unsigned*)(Ag + (size_t)R1 * g.lda + (t) * 64 + C1), (LAS unsigned*)(lds + (buf) * 32768 + ldsw + 8192), 16, 0, 0); \
        __builtin_amdgcn_global_load_lds((const unsigned*)(Bg + (size_t)R0 * g.ldb + (t) * 64 + C0), (LAS unsigned*)(lds + (buf) * 32768 + 16384 + ldsw), 16, 0, 0); \
        __builtin_amdgcn_global_load_lds((const unsigned*)(Bg + (size_t)R1 * g.ldb + (t) * 64 + C1), (LAS unsigned*)(lds + (buf) * 32768 + 16384 + ldsw + 8192), 16, 0, 0); } while (0)
    const int u0 = ufirst >= 0 ? ufirst : (int)((F.bid + F.G - (rot % F.G)) % F.G), us = ufirst >= 0 ? ustep : F.G, ue = ufirst >= 0 ? ulast : nU;
    for (int u = u0; u < ue; u += us) {
        const int pm = u % nM, pn = u / nM;
        const bf16_t* Ag = g.A + (size_t)(pm * 128) * g.lda; const bf16_t* Bg = g.Bt + (size_t)(pn * 128) * g.ldb;
        f32x4 acc[4][2];
#pragma unroll
        for (int m = 0; m < 4; ++m)
#pragma unroll
            for (int n = 0; n < 2; ++n) acc[m][n] = (f32x4){0.f, 0.f, 0.f, 0.f};
        GS_STAGE(0, 0);
        if (nt > 1) GS_STAGE(1, 1);
        int b = 0, bn = 2;
        for (int t = 0; t < nt; ++t) {
            if (t + 2 < nt) { GS_STAGE(bn, t + 2); asm volatile("s_waitcnt vmcnt(8)" ::: "memory"); }
            else if (t + 1 < nt) asm volatile("s_waitcnt vmcnt(4)" ::: "memory");
            else asm volatile("s_waitcnt vmcnt(0)" ::: "memory");
            __builtin_amdgcn_s_barrier(); asm volatile("" ::: "memory");
            bf16x8 Af[4][2], Bf[2][2];
#pragma unroll
            for (int m = 0; m < 4; ++m)
#pragma unroll
                for (int k = 0; k < 2; ++k) Af[m][k] = *(const LAS bf16x8*)(lds + b * 32768 + aoff + m * 2048 + k * 1024);
#pragma unroll
            for (int n = 0; n < 2; ++n)
#pragma unroll
                for (int k = 0; k < 2; ++k) Bf[n][k] = *(const LAS bf16x8*)(lds + b * 32768 + 16384 + boff + n * 2048 + k * 1024);
#pragma unroll
            for (int k = 0; k < 2; ++k)
#pragma unroll
                for (int m = 0; m < 4; ++m)
#pragma unroll
                    for (int n = 0; n < 2; ++n) acc[m][n] = __builtin_amdgcn_mfma_f32_16x16x32_bf16(Bf[n][k], Af[m][k], acc[m][n], 0, 0, 0);
            asm volatile("s_waitcnt lgkmcnt(0)" ::: "memory");
            __builtin_amdgcn_s_barrier(); asm volatile("" ::: "memory");
            b = b == 2 ? 0 : b + 1; bn = bn == 2 ? 0 : bn + 1;
        }
#pragma unroll
        for (int m = 0; m < 4; ++m)
#pragma unroll
            for (int n = 0; n < 2; ++n) E(pm * 128 + wr * 64 + m * 16 + fr, pn * 128 + wc * 32 + n * 16 + 4 * fq, acc[m][n]);
    }
#undef GS_STAGE
}

constexpr int HTB = 128 * 64 * 2;
struct BigDesc { const bf16_t* A; const bf16_t* Bt; int lda, ldb, nM, nN, nKS, Ksp; };
struct BUnit { int pm, pn, ks, hm; };
__device__ __forceinline__ bool big_next(const BigDesc& g, int i, int G, int c, BUnit& u) {
    const int nNp = g.nN * g.nKS, nwg = g.nM * nNp;
    const long L = (long)i * G + c; if (L >= nwg) return false;
    int wgid = (int)L; { const int q = nwg / 8, r = nwg % 8, xcd = wgid % 8, off = wgid / 8; wgid = (xcd < r ? xcd * (q + 1) : r * (q + 1) + (xcd - r) * q) + off; }
    const int nig = 8 * nNp, gid = wgid / nig, fm = gid * 8, gsz = (g.nM - fm) < 8 ? (g.nM - fm) : 8;
    u.pm = fm + ((wgid % nig) % gsz); const int pnp = (wgid % nig) / gsz; u.pn = pnp / g.nKS; u.ks = pnp % g.nKS; u.hm = -1; return true;
}
template <bool HALFTAIL>
__device__ __forceinline__ bool big_next_h(const BigDesc& g, int i, int G, int c, BUnit& u) {
    if constexpr (!HALFTAIL) return big_next(g, i, G, c, u);
    else {
        const int nwg = g.nM * g.nN * g.nKS, nfr = nwg / G, rem = nwg - nfr * G;
        if (i < nfr || 2 * rem > G) return big_next(g, i, G, c, u);
        if (i > nfr || c >= 2 * rem) return false;
        big_next(g, nfr, G, c >> 1, u); u.hm = c & 1; return true;
    }
}
__device__ __forceinline__ bool down_merged_unit(int i, int bid, BUnit& u) {
    if (i > 0 || (bid >= 112 && bid < 120)) return false;
    u.hm = -1;
    if (bid >= 120) { const int a = bid - 120, tl = a >> 1; u.ks = a & 1; u.pm = tl >> 2; u.pn = tl & 3; }
    else { const int tl = 68 + (bid >> 2); u.ks = bid & 3; u.pm = tl >> 2; u.pn = tl & 3; }
    return true;
}
__device__ __forceinline__ int down_merged_k0(int bid, int ks) { return bid >= 120 ? ks * 1408 : (ks == 0 ? 0 : (ks == 1 ? 12 : (ks == 2 ? 22 : 34))) * 64; }
__device__ __forceinline__ int down_merged_nt(int bid, int ks) { return bid >= 120 ? 22 : ((ks & 1) ? 10 : 12); }
__device__ __forceinline__ int perm32(int rho) { const int n = rho >> 4, i = rho & 15; return 8 * (i >> 2) + 4 * n + (i & 3); }
template <bool PERM, class Epi, bool HALFTAIL = false, int UMODE = 0>
__device__ __forceinline__ void gemm_big(const Frame& F, const BigDesc g, const Epi& E) {
    LAS unsigned char* lds = F.lds;
    const int tid = F.tid, wid = F.wave, lane = F.lane, wr = wid >> 2, wc = wid & 3, fr = lane & 15, fq = lane >> 4;
    unsigned voffA[2], voffB[2];
#pragma unroll
    for (int i = 0; i < 2; ++i) { int R, C; stage_rc(tid * 16 + i * 8192, R, C); const int Rb = PERM ? ((R & ~31) + perm32(R & 31)) : R; voffA[i] = (unsigned)(R * g.lda + C) * 2u; voffB[i] = (unsigned)(Rb * g.ldb + C) * 2u; }
    const size_t kstep = (size_t)(64 * 2);
    const size_t hstepA = (size_t)128 * g.lda * 2, hstepB = (size_t)128 * g.ldb * 2;
    const unsigned ldsw = (unsigned)wid * 1024u;
    const int aoff = lds_byte(wr * 64 + fr, fq * 8), boff = lds_byte(wc * 32 + fr, fq * 8);
#define PG8_SA(b, h) (((b) * 2 + (h)) * HTB)
#define PG8_SB(b, h) ((4 + (b) * 2 + (h)) * HTB)
#define PG8_STAGE(bufoff, gbase, voff) do { _Pragma("unroll") for (int _i = 0; _i < 2; ++_i) \
        __builtin_amdgcn_global_load_lds((const unsigned*)((const char*)(gbase) + (voff)[_i]), (LAS unsigned*)(lds + (bufoff) + ldsw + _i * 8192), 16, 0, 0); } while (0)
#define PG8_LDA(dst, b, h) do { _Pragma("unroll") for (int m = 0; m < 4; ++m) _Pragma("unroll") for (int k = 0; k < 2; ++k) dst[m][k] = *(const LAS bf16x8*)(lds + PG8_SA(b, h) + aoff + m * 2048 + k * 1024); } while (0)
#define PG8_LDB(dst, b, h) do { _Pragma("unroll") for (int n = 0; n < 2; ++n) _Pragma("unroll") for (int k = 0; k < 2; ++k) dst[n][k] = *(const LAS bf16x8*)(lds + PG8_SB(b, h) + boff + n * 2048 + k * 1024); } while (0)
#define PG8_MMA(ai, bj, At, Bt) do { __builtin_amdgcn_s_setprio(1); _Pragma("unroll") for (int m = 0; m < 4; ++m) _Pragma("unroll") for (int n = 0; n < 2; ++n) _Pragma("unroll") for (int k = 0; k < 2; ++k) \
        acc[ai][bj][m][n] = __builtin_amdgcn_mfma_f32_16x16x32_bf16(Bt[n][k], At[m][k], acc[ai][bj][m][n], 0, 0, 0); __builtin_amdgcn_s_setprio(0); } while (0)
#define PG8_WAIT_V(n) asm volatile("s_waitcnt vmcnt(" #n ")" ::: "memory")
#define PG8_WAIT_L(n) asm volatile("s_waitcnt lgkmcnt(" #n ")" ::: "memory")
#define PG8_BAR __builtin_amdgcn_s_barrier()
#define PG8_SCHED __builtin_amdgcn_sched_barrier(0)
#define PG8_K0(u) (UMODE == 1 ? down_merged_k0(F.bid, (u).ks) : (u).ks * g.Ksp)
#define PG8_UA(u) ((const char*)g.A + (size_t)(u).pm * 2 * hstepA + (size_t)PG8_K0(u) * 2)
#define PG8_UB(u) ((const char*)g.Bt + (size_t)((u).pn * 2 + (HALFTAIL && (u).hm > 0 ? 1 : 0)) * hstepB + (size_t)PG8_K0(u) * 2)
#define PG8_NEXT(i, u) (UMODE == 1 ? down_merged_unit(i, F.bid, u) : big_next_h<HALFTAIL>(g, i, F.G, F.bid, u))
#define PG8_UH(u) ((HALFTAIL && (u).hm >= 0) ? (size_t)0 : hstepB)
    BUnit cur, nxt; int ui = 0;
    if (!PG8_NEXT(0, cur)) return;
    f32x4 acc[2][2][4][2];
#pragma unroll
    for (int a = 0; a < 2; ++a)
#pragma unroll
        for (int b = 0; b < 2; ++b)
#pragma unroll
            for (int m = 0; m < 4; ++m)
#pragma unroll
                for (int n = 0; n < 2; ++n) acc[a][b][m][n] = (f32x4){0.f, 0.f, 0.f, 0.f};
    bf16x8 At[4][2], B0[2][2], B1[2][2];
    const char* cA = PG8_UA(cur); const char* cB = PG8_UB(cur); size_t cH = PG8_UH(cur);
    PG8_STAGE(PG8_SB(0, 0), cB, voffB); PG8_STAGE(PG8_SB(0, 1), cB + cH, voffB); PG8_STAGE(PG8_SA(0, 0), cA, voffA); PG8_STAGE(PG8_SA(0, 1), cA + hstepA, voffA);
    if (wr == 1) PG8_BAR;
    PG8_WAIT_V(2); PG8_BAR;
    PG8_STAGE(PG8_SB(1, 0), cB + kstep, voffB); PG8_STAGE(PG8_SA(1, 0), cA + kstep, voffA); PG8_STAGE(PG8_SB(1, 1), cB + cH + kstep, voffB);
    PG8_WAIT_V(6); PG8_BAR;
    for (;;) {
        const bool has_next = PG8_NEXT(ui + 1, nxt);
        const int nt = UMODE == 1 ? down_merged_nt(F.bid, cur.ks) : g.Ksp / 64;
        const char* nA = has_next ? PG8_UA(nxt) : cA; const char* nB = has_next ? PG8_UB(nxt) : cB; const size_t nH = has_next ? PG8_UH(nxt) : cH;
        const bool full = !HALFTAIL || cur.hm < 0;
        for (int t = 0; t < nt; t += 2) {
            const bool last = (t == nt - 2);
            const char* a1 = cA + (size_t)(t + 1) * kstep;
            const char* a2 = last ? nA : cA + (size_t)(t + 2) * kstep; const char* b2 = last ? nB : cB + (size_t)(t + 2) * kstep;
            const char* a3 = a2 + kstep; const char* b3 = b2 + kstep; const size_t h2 = last ? nH : cH;
            PG8_LDB(B0, 0, 0); if (full) PG8_LDB(B1, 0, 1); PG8_SCHED; PG8_LDA(At, 0, 0); PG8_STAGE(PG8_SA(1, 1), a1 + hstepA, voffA);
            PG8_WAIT_V(8); PG8_WAIT_L(0); PG8_BAR; PG8_MMA(0, 0, At, B0); if (full) PG8_MMA(0, 1, At, B1); PG8_BAR; PG8_SCHED;
            PG8_LDA(At, 0, 1); PG8_STAGE(PG8_SB(0, 0), b2, voffB); PG8_STAGE(PG8_SB(0, 1), b2 + h2, voffB); PG8_STAGE(PG8_SA(0, 0), a2, voffA);
            PG8_WAIT_V(8); PG8_WAIT_L(0); PG8_BAR; PG8_MMA(1, 0, At, B0); if (full) PG8_MMA(1, 1, At, B1); PG8_BAR; PG8_SCHED;
            PG8_LDB(B0, 1, 0); if (full) PG8_LDB(B1, 1, 1); PG8_SCHED; PG8_LDA(At, 1, 0); PG8_STAGE(PG8_SA(0, 1), a2 + hstepA, voffA);
            PG8_WAIT_V(8); PG8_WAIT_L(0); PG8_BAR; PG8_MMA(0, 0, At, B0); if (full) PG8_MMA(0, 1, At, B1); PG8_BAR; PG8_SCHED;
            PG8_LDA(At, 1, 1); PG8_STAGE(PG8_SB(1, 0), b3, voffB); PG8_STAGE(PG8_SB(1, 1), b3 + h2, voffB); PG8_STAGE(PG8_SA(1, 0), a3, voffA);
            PG8_WAIT_V(8); PG8_WAIT_L(0); PG8_BAR; PG8_MMA(1, 0, At, B0); if (full) PG8_MMA(1, 1, At, B1); PG8_BAR; PG8_SCHED;
        }
        if (wr == 0) PG8_BAR;
        {
            const int row0 = cur.pm * 256 + wr * 64 + fr, col0 = cur.pn * 256 + (HALFTAIL && cur.hm > 0 ? 128 : 0) + wc * 32 + (PERM ? 8 : 4) * fq;
#pragma unroll
            for (int ai = 0; ai < 2; ++ai)
#pragma unroll
                for (int m = 0; m < 4; ++m)
#pragma unroll
                    for (int bj = 0; bj < 2; ++bj) {
                        if (bj == 1 && !full) continue;
                        if constexpr (PERM) E.e8(row0 + ai * 128 + m * 16, col0 + bj * 128, acc[ai][bj][m][0], acc[ai][bj][m][1], cur.ks);
                        else {
#pragma unroll
                            for (int n = 0; n < 2; ++n) E(row0 + ai * 128 + m * 16, col0 + bj * 128 + n * 16, acc[ai][bj][m][n], cur.ks);
                        }
                    }
        }
        if (!has_next) break;
#pragma unroll
        for (int a = 0; a < 2; ++a)
#pragma unroll
            for (int b = 0; b < 2; ++b)
#pragma unroll
                for (int m = 0; m < 4; ++m)
#pragma unroll
                    for (int n = 0; n < 2; ++n) acc[a][b][m][n] = (f32x4){0.f, 0.f, 0.f, 0.f};
        cur = nxt; cA = nA; cB = nB; cH = nH; ++ui;
        if (wr == 1) PG8_BAR;
    }
    PG8_WAIT_V(0);
    PG8_BAR;
#undef PG8_SA
#undef PG8_SB
#undef PG8_STAGE
#undef PG8_LDA
#undef PG8_LDB
#undef PG8_MMA
#undef PG8_WAIT_V
#undef PG8_WAIT_L
#undef PG8_BAR
#undef PG8_SCHED
#undef PG8_UA
#undef PG8_UB
#undef PG8_UH
#undef PG8_NEXT
#undef PG8_K0
}

__device__ __forceinline__ void upgate_tile(int pm, int& rowbase, int& vlo, int& vhi, bool& first, bool& last) {
    if (pm < 16) { rowbase = pm * 256; vlo = 0; vhi = 255; first = true; last = true; return; }
    const int s = (pm - 16) / 5, i = (pm - 16) % 5;
    const int start = i == 0 ? 0 : (i == 1 ? 254 : (i == 2 ? 508 : (i == 3 ? 762 : 768)));
    rowbase = NCTX + s * 1024 + start; first = i == 0; last = i == 4;
    vlo = i == 0 ? 0 : (i == 4 ? 249 : 1); vhi = i == 4 ? 255 : 254;
}
__device__ __forceinline__ void gemm_upgate(const Frame& F, const bf16_t* A, const bf16_t* Bt, const float* cw, const float* cb, bf16_t* ACT, const int mode) {
    LAS unsigned char* lds = F.lds;
    const int tid = F.tid, wid = F.wave, lane = F.lane, wr = wid >> 2, wc = wid & 3, fr = lane & 15, fq = lane >> 4;
    constexpr int K = 1024, nt = K / 64, UP = 528;
    BigDesc g{A, Bt, K, K, 26, 22, 1, K};
    unsigned voffA[2], voffB[2];
#pragma unroll
    for (int i = 0; i < 2; ++i) { int R, C; stage_rc(tid * 16 + i * 8192, R, C); voffA[i] = (unsigned)(R * K + C) * 2u; voffB[i] = voffA[i]; }
    const size_t kstep = (size_t)(64 * 2), hstep = (size_t)128 * K * 2;
    const unsigned ldsw = (unsigned)wid * 1024u;
    const int aoff = lds_byte(wr * 64 + fr, fq * 8), boff = lds_byte(wc * 32 + fr, fq * 8);
#define PG8_SA(b, h) (((b) * 2 + (h)) * HTB)
#define PG8_SB(b, h) ((4 + (b) * 2 + (h)) * HTB)
#define PG8_STAGE(bufoff, gbase, voff) do { _Pragma("unroll") for (int _i = 0; _i < 2; ++_i) \
        __builtin_amdgcn_global_load_lds((const unsigned*)((const char*)(gbase) + (voff)[_i]), (LAS unsigned*)(lds + (bufoff) + ldsw + _i * 8192), 16, 0, 0); } while (0)
#define PG8_LDA(dst, b, h) do { _Pragma("unroll") for (int m = 0; m < 4; ++m) _Pragma("unroll") for (int k = 0; k < 2; ++k) dst[m][k] = *(const LAS bf16x8*)(lds + PG8_SA(b, h) + aoff + m * 2048 + k * 1024); } while (0)
#define PG8_LDB(dst, b, h) do { _Pragma("unroll") for (int n = 0; n < 2; ++n) _Pragma("unroll") for (int k = 0; k < 2; ++k) dst[n][k] = *(const LAS bf16x8*)(lds + PG8_SB(b, h) + boff + n * 2048 + k * 1024); } while (0)
#define PG8_MMA(ai, bj, At, Bt_) do { __builtin_amdgcn_s_setprio(1); _Pragma("unroll") for (int m = 0; m < 4; ++m) _Pragma("unroll") for (int n = 0; n < 2; ++n) _Pragma("unroll") for (int k = 0; k < 2; ++k) \
        acc[ai][bj][m][n] = __builtin_amdgcn_mfma_f32_16x16x32_bf16(Bt_[n][k], At[m][k], acc[ai][bj][m][n], 0, 0, 0); __builtin_amdgcn_s_setprio(0); } while (0)
#define PG8_WAIT_V(n) asm volatile("s_waitcnt vmcnt(" #n ")" ::: "memory")
#define PG8_WAIT_L(n) asm volatile("s_waitcnt lgkmcnt(" #n ")" ::: "memory")
#define PG8_BAR __builtin_amdgcn_s_barrier()
#define PG8_SCHED __builtin_amdgcn_sched_barrier(0)
    for (int ui = 0;; ++ui) {
        BUnit cur;
        int hm = -1;
        if (mode == 0) {
            if (F.G == 256 && ui == 2) { if (F.bid >= 120 || !big_next(g, 2, F.G, F.bid >> 1, cur)) break; hm = F.bid & 1; }
            else if (!big_next(g, ui, F.G, F.bid, cur)) break;
        } else if (mode == 1) {
            if (ui >= 2) break;
            BigDesc g23 = g; g23.nM = 23;
            if (!big_next(g23, ui, 256, F.bid, cur)) { cur.pm = 23; cur.pn = ui * 256 + F.bid - 506; }
        } else {
            if (ui >= 1 || F.bid >= 120) break;
            const int j = (F.bid >> 1) + 6; cur.pm = 23 + j / 22; cur.pn = j % 22; hm = F.bid & 1;
        }
        unsigned voffBh[2];
#pragma unroll
        for (int i = 0; i < 2; ++i) { int R, C; stage_rc(tid * 16 + i * 8192, R, C); const int Rs = hm < 0 ? R : R + 64 * hm + (R >= 64 ? 64 : 0); voffBh[i] = (unsigned)(Rs * K + C) * 2u; }
        int rowbase; { int a_, b_; bool c_, d_; upgate_tile(cur.pm, rowbase, a_, b_, c_, d_); }
        f32x4 acc[2][2][4][2];
#pragma unroll
        for (int a = 0; a < 2; ++a)
#pragma unroll
            for (int b = 0; b < 2; ++b)
#pragma unroll
                for (int m = 0; m < 4; ++m)
#pragma unroll
                    for (int n = 0; n < 2; ++n) acc[a][b][m][n] = (f32x4){0.f, 0.f, 0.f, 0.f};
        bf16x8 At[4][2], B0[2][2], B1[2][2];
        const char* cA = (const char*)A + (size_t)rowbase * K * 2; const char* cB = (const char*)Bt + (size_t)cur.pn * 2 * hstep;
        PG8_STAGE(PG8_SB(0, 0), cB, voffBh); PG8_STAGE(PG8_SB(0, 1), cB + hstep, voffB); PG8_STAGE(PG8_SA(0, 0), cA, voffA); PG8_STAGE(PG8_SA(0, 1), cA + hstep, voffA);
        if (wr == 1) PG8_BAR;
        PG8_WAIT_V(2); PG8_BAR;
        PG8_STAGE(PG8_SB(1, 0), cB + kstep, voffBh); PG8_STAGE(PG8_SA(1, 0), cA + kstep, voffA); PG8_STAGE(PG8_SB(1, 1), cB + hstep + kstep, voffB);
        PG8_WAIT_V(6); PG8_BAR;
        for (int t = 0; t < nt; t += 2) {
            const bool last = (t == nt - 2);
            const char* a1 = cA + (size_t)(t + 1) * kstep;
            const char* a2 = last ? cA : cA + (size_t)(t + 2) * kstep; const char* b2 = last ? cB : cB + (size_t)(t + 2) * kstep;
            const char* a3 = a2 + kstep; const char* b3 = b2 + kstep;
            PG8_LDB(B0, 0, 0); if (hm < 0) PG8_LDB(B1, 0, 1); PG8_SCHED; PG8_LDA(At, 0, 0); PG8_STAGE(PG8_SA(1, 1), a1 + hstep, voffA);
            PG8_WAIT_V(8); PG8_WAIT_L(0); PG8_BAR; PG8_MMA(0, 0, At, B0); if (hm < 0) PG8_MMA(0, 1, At, B1); PG8_BAR; PG8_SCHED;
            PG8_LDA(At, 0, 1); PG8_STAGE(PG8_SB(0, 0), b2, voffBh); PG8_STAGE(PG8_SB(0, 1), b2 + hstep, voffB); PG8_STAGE(PG8_SA(0, 0), a2, voffA);
            PG8_WAIT_V(8); PG8_WAIT_L(0); PG8_BAR; PG8_MMA(1, 0, At, B0); if (hm < 0) PG8_MMA(1, 1, At, B1); PG8_BAR; PG8_SCHED;
            PG8_LDB(B0, 1, 0); if (hm < 0) PG8_LDB(B1, 1, 1); PG8_SCHED; PG8_LDA(At, 1, 0); PG8_STAGE(PG8_SA(0, 1), a2 + hstep, voffA);
            PG8_WAIT_V(8); PG8_WAIT_L(0); PG8_BAR; PG8_MMA(0, 0, At, B0); if (hm < 0) PG8_MMA(0, 1, At, B1); PG8_BAR; PG8_SCHED;
            PG8_LDA(At, 1, 1); PG8_STAGE(PG8_SB(1, 0), b3, voffBh); PG8_STAGE(PG8_SB(1, 1), b3 + hstep, voffB); PG8_STAGE(PG8_SA(1, 0), a3, voffA);
            PG8_WAIT_V(8); PG8_WAIT_L(0); PG8_BAR; PG8_MMA(1, 0, At, B0); if (hm < 0) PG8_MMA(1, 1, At, B1); PG8_BAR; PG8_SCHED;
        }
        if (wr == 0) PG8_BAR;
        PG8_WAIT_V(0); PG8_BAR;
        asm volatile("" ::: "memory");
        int vlo, vhi; { int rb_; bool c_, d_; upgate_tile(cur.pm, rb_, vlo, vhi, c_, d_); }
        const int c = hm < 0 ? (tid & 15) * 8 : (tid & 7) * 8, r0 = hm < 0 ? (tid >> 4) * 8 : (tid >> 3) * 4, nrow = hm < 0 ? 8 : 4, boffc = hm < 0 ? 128 : 64;
        const int ca = cur.pn * 128 + (hm < 0 ? 0 : 64 * hm) + c, cbn = 2816 + ca;
        float wa[3][8], wb[3][8], ba8[8], bb8[8];
#define UW_HALF(ai) do { _Pragma("unroll") for (int m = 0; m < 4; ++m) _Pragma("unroll") for (int bj = 0; bj < 2; ++bj) _Pragma("unroll") for (int n = 0; n < 2; ++n) { \
            if (bj == 1 && hm >= 0) continue; \
            const f32x4 v = acc[ai][bj][m][n]; u32x2 w; w.x = pack2(v[0], v[1]); w.y = pack2(v[2], v[3]); \
            *(LAS u32x2*)(lds + ((ai) * 128 + wr * 64 + m * 16 + fr) * UP + (bj * 128 + wc * 32 + n * 16 + 4 * fq) * 2) = w; } } while (0)
        UW_HALF(0);
        __builtin_amdgcn_sched_barrier(0);
#pragma unroll
        for (int q = 0; q < 2; ++q) {
#pragma unroll
            for (int tp = 0; tp < 3; ++tp) {
                const f32x4 x = *(const f32x4*)(cw + tp * 5632 + ca + q * 4), y = *(const f32x4*)(cw + tp * 5632 + cbn + q * 4);
#pragma unroll
                for (int jj = 0; jj < 4; ++jj) { wa[tp][q * 4 + jj] = x[jj]; wb[tp][q * 4 + jj] = y[jj]; }
            }
            const f32x4 x = *(const f32x4*)(cb + ca + q * 4), y = *(const f32x4*)(cb + cbn + q * 4);
#pragma unroll
            for (int jj = 0; jj < 4; ++jj) { ba8[q * 4 + jj] = x[jj]; bb8[q * 4 + jj] = y[jj]; }
        }
        __builtin_amdgcn_sched_barrier(0);
        UW_HALF(1);
#undef UW_HALF
        {
            __builtin_amdgcn_sched_barrier(0);
            asm volatile("s_waitcnt lgkmcnt(0)" ::: "memory");
            __builtin_amdgcn_s_barrier();
            __builtin_amdgcn_sched_barrier(0);
            const bf16x8 z = (bf16x8){0, 0, 0, 0, 0, 0, 0, 0};
            bf16x8 ap, bp, ac, bc, an, bn;
            {
                const bool hp0 = r0 > 0;
                ap = hp0 ? *(const LAS bf16x8*)(lds + (r0 - 1) * UP + c * 2) : z; bp = hp0 ? *(const LAS bf16x8*)(lds + (r0 - 1) * UP + (boffc + c) * 2) : z;
                ac = *(const LAS bf16x8*)(lds + r0 * UP + c * 2); bc = *(const LAS bf16x8*)(lds + r0 * UP + (boffc + c) * 2);
            }
#pragma unroll 4
            for (int i = 0; i < nrow; ++i) {
                const int r = r0 + i;
                const bool hn = r < 255;
                an = hn ? *(const LAS bf16x8*)(lds + (r + 1) * UP + c * 2) : z; bn = hn ? *(const LAS bf16x8*)(lds + (r + 1) * UP + (boffc + c) * 2) : z;
                if (r >= vlo && r <= vhi) {
                    float ov[8];
#pragma unroll
                    for (int e = 0; e < 8; ++e) {
                        const float ua = bf2f((unsigned short)ap[e]) * wa[0][e] + bf2f((unsigned short)ac[e]) * wa[1][e] + bf2f((unsigned short)an[e]) * wa[2][e] + ba8[e];
                        const float ub = bf2f((unsigned short)bp[e]) * wb[0][e] + bf2f((unsigned short)bc[e]) * wb[1][e] + bf2f((unsigned short)bn[e]) * wb[2][e] + bb8[e];
                        ov[e] = siluf_(ua) * ub;
                    }
                    u32x4 w; w.x = pack2(ov[0], ov[1]); w.y = pack2(ov[2], ov[3]); w.z = pack2(ov[4], ov[5]); w.w = pack2(ov[6], ov[7]);
                    *(u32x4*)(ACT + (size_t)(rowbase + r) * 2816 + ca) = w;
                }
                ap = ac; bp = bc; ac = an; bc = bn;
            }
        }
        asm volatile("s_waitcnt lgkmcnt(0)" ::: "memory");
        __builtin_amdgcn_s_barrier();
        asm volatile("" ::: "memory");
    }
#undef PG8_SA
#undef PG8_SB
#undef PG8_STAGE
#undef PG8_LDA
#undef PG8_LDB
#undef PG8_MMA
#undef PG8_WAIT_V
#undef PG8_WAIT_L
#undef PG8_BAR
#undef PG8_SCHED
}

struct CvtJob { const float* src; bf16_t* dst; int K, N, Npad, tiles, upperm; };
template <int NT> struct CvtRegs { f32x4 v[NT][2]; };
template <int NT>
__device__ __forceinline__ void cvt_issue(const Frame& F, const CvtJob& j, int tb, int nb, CvtRegs<NT>& R) {
    const int tk = j.K / 64, r = F.tid >> 4, c4 = (F.tid & 15) * 4;
#pragma unroll
    for (int q = 0; q < NT; ++q) {
        const int t = tb + q * nb;
#pragma unroll
        for (int i = 0; i < 2; ++i) {
            R.v[q][i] = (f32x4){0.f, 0.f, 0.f, 0.f};
            if (t < j.tiles) { const int k0 = (t % tk) * 64, n0 = (t / tk) * 64; if (n0 + c4 < j.N) R.v[q][i] = *(const f32x4*)(j.src + (size_t)(k0 + r + 32 * i) * j.N + n0 + c4); }
        }
    }
}
template <int NT>
__device__ __forceinline__ void cvt_to_lds(const Frame& F, const CvtRegs<NT>& R) {
    LAS float* tiles = (LAS float*)F.lds;
    const int r = F.tid >> 4, c4 = (F.tid & 15) * 4;
#pragma unroll
    for (int q = 0; q < NT; ++q)
#pragma unroll
        for (int i = 0; i < 2; ++i) { LAS float* tp = tiles + q * (64 * 65) + (r + 32 * i) * 65 + c4; tp[0] = R.v[q][i][0]; tp[1] = R.v[q][i][1]; tp[2] = R.v[q][i][2]; tp[3] = R.v[q][i][3]; }
}
template <int NT>
__device__ __forceinline__ void cvt_store(const Frame& F, const CvtJob& j, int tb, int nb) {
    const LAS float* tiles = (const LAS float*)F.lds;
    const int tk = j.K / 64, n = F.tid >> 3, kq = (F.tid & 7) * 8;
#pragma unroll
    for (int q = 0; q < NT; ++q) {
        const int t = tb + q * nb;
        if (t < j.tiles) {
            const int k0 = (t % tk) * 64, n0 = (t / tk) * 64;
            const LAS float* tile = tiles + q * (64 * 65);
            u32x4 w;
            w.x = pack2(tile[(kq + 0) * 65 + n], tile[(kq + 1) * 65 + n]); w.y = pack2(tile[(kq + 2) * 65 + n], tile[(kq + 3) * 65 + n]);
            w.z = pack2(tile[(kq + 4) * 65 + n], tile[(kq + 5) * 65 + n]); w.w = pack2(tile[(kq + 6) * 65 + n], tile[(kq + 7) * 65 + n]);
            const int drow = j.upperm ? (n0 < 2816 ? (n0 >> 7) * 256 + (n0 & 127) : ((n0 - 2816) >> 7) * 256 + 128 + ((n0 - 2816) & 127)) + n : n0 + n;
            *(u32x4*)(j.dst + (size_t)drow * j.K + k0 + kq) = w;
        }
    }
}
template <int NT>
__device__ __forceinline__ void cvt_run(const Frame& F, const CvtJob& j, int t0, int nb) {
    CvtRegs<NT> R;
    cvt_issue<NT>(F, j, t0, nb, R);
    for (int tb = t0; tb < j.tiles; tb += NT * nb) {
        cvt_to_lds<NT>(F, R);
        __syncthreads();
        cvt_issue<NT>(F, j, tb + NT * nb, nb, R);
        cvt_store<NT>(F, j, tb, nb);
        __syncthreads();
    }
}

__device__ __forceinline__ void cvt_group(const Frame& F, const PRef& p, int group, int bfirst, int nb, int rot0) {
    if (F.bid < bfirst || F.bid >= bfirst + nb) return;
    unsigned char* ws = p.ws();
    const int vb = F.bid - bfirst;
    int rot = rot0;
#define CVT(srcp, dstoff, K_, N_, Npad_) do { CvtJob jb; jb.src = (srcp); jb.dst = (bf16_t*)(ws + (dstoff)); jb.K = (K_); jb.N = (N_); jb.Npad = (Npad_); jb.tiles = ((K_) / 64) * ((Npad_) / 64); jb.upperm = ((N_) == 5632); \
        cvt_run<4>(F, jb, (vb + nb - (rot % nb)) % nb, nb); rot += jb.tiles; } while (0)
    if (group == 0 || group == 5) {
        if (group == 0) CVT(p.in(19), WS_WAIN, 1024, 1952, 2048); else rot += 512;
        CVT(p.in(22), WS_WUQ, 256, 768, 768);
        CVT(p.in(23), WS_WUKV, 128, 1024, 1024);
    } else if (group == 1) {
        CVT(p.in(14), WS_WOUT, 1024, 1024, 1024);
        CVT(p.in(15), WS_WUP, 1024, 5632, 5632);
    } else if (group == 3) {
        CVT(p.in(18), WS_WDN, 2816, 1024, 1024);
    } else {
        if (group == 4) {
            CVT(p.in(15) + (size_t)1024 * 5632, WS_WUP + (size_t)5632 * 1024 * 2, 1024, 5632, 5632);
            CVT(p.in(18) + (size_t)2816 * 1024, WS_WDN + (size_t)1024 * 2816 * 2, 2816, 1024, 1024);
            return;
        }
        CVT(p.in(28), WS_WBIN, 1024, 3456, 3584);
        CVT(p.in(14) + (size_t)1024 * 1024, WS_WOUT + (size_t)1024 * 1024 * 2, 1024, 1024, 1024);
        if (F.G != 256) {
            CVT(p.in(15) + (size_t)1024 * 5632, WS_WUP + (size_t)5632 * 1024 * 2, 1024, 5632, 5632);
            CVT(p.in(18) + (size_t)2816 * 1024, WS_WDN + (size_t)1024 * 2816 * 2, 2816, 1024, 1024);
        }
        CVT(p.in(35), WS_WWUP, 64, 512, 512);
        CVT(p.in(35) + 64 * 512, WS_WWUP + 512 * 64 * 2, 64, 512, 512);
        CVT(p.in(37), WS_WAUP, 64, 512, 512);
        CVT(p.in(37) + 64 * 512, WS_WAUP + 512 * 64 * 2, 64, 512, 512);
        CVT(p.in(38), WS_WGUP, 128, 512, 512);
    }
#undef CVT
}
__device__ __forceinline__ void phase_prep(const Frame& F, const PRef& p) {
    unsigned char* ws = p.ws();
    CvtJob ja; ja.src = p.in(19); ja.dst = (bf16_t*)(ws + WS_WAIN); ja.K = 1024; ja.N = 1952; ja.Npad = 2048; ja.tiles = 16 * 32; ja.upperm = 0;
    const int ta0 = (F.bid + F.G - (192 % F.G)) % F.G;
    CvtRegs<2> RA;
    if (F.G == 256) cvt_issue<2>(F, ja, ta0, F.G, RA);
    {
        LAS float* sc = (LAS float*)F.lds;
        LAS float* red = sc + 3 * 1024;
        for (int i = F.tid; i < 3 * 1024; i += NTHREADS) {
            const int c = i >> 10, k = i & 1023;
            const float v = c == 0 ? p.in(9)[k] : p.in(8)[(c - 1) * 1024 + k];
            sc[i] = siluf_(v);
        }
        __syncthreads();
        float* mod = (float*)(ws + WS_MOD);
        FOR_UNITS(u, 192, 0) {
            const int l = u / 96, n0 = (u % 96) * 64, col = F.tid & 63, kg = F.tid >> 6;
            const float* w = p.in(10) + (size_t)l * 1024 * 6144 + (size_t)(kg * 128) * 6144 + n0 + col;
            float a0 = 0.f, a1 = 0.f, a2 = 0.f;
#pragma unroll 8
            for (int k = 0; k < 128; ++k) { const float wv = w[(size_t)k * 6144]; const int kk = kg * 128 + k; a0 += sc[kk] * wv; a1 += sc[1024 + kk] * wv; a2 += sc[2048 + kk] * wv; }
            red[(kg * 3 + 0) * 64 + col] = a0; red[(kg * 3 + 1) * 64 + col] = a1; red[(kg * 3 + 2) * 64 + col] = a2;
            __syncthreads();
            if (F.tid < 192) {
                const int c = F.tid >> 6, cc = F.tid & 63; float s = 0.f;
#pragma unroll
                for (int q = 0; q < 8; ++q) s += red[(q * 3 + c) * 64 + cc];
                mod[(size_t)(l * 3 + c) * 6144 + n0 + cc] = s + p.in(11)[l * 6144 + n0 + cc];
            }
            __syncthreads();
        }
    }
    if (F.G == 256) {
        cvt_to_lds<2>(F, RA);
        __syncthreads();
        cvt_store<2>(F, ja, ta0, F.G);
        __syncthreads();
        cvt_group(F, p, 5, 0, F.G, 192);
    } else cvt_group(F, p, 0, 0, F.G, 192);
}

__device__ __forceinline__ void phase_norm(const Frame& F, const float* xa, const float* xb, const bf16_t* part, const float* gate, float* xout,
                                           const float* g, const float* sc, const float* sh, bf16_t* hb, bool do_norm, const int q4row = NTOK) {
    const int nw = F.G * 8;
    for (int row = F.bid * 8 + F.wave; row < NTOK; row += nw) {
        const float* x = row < NCTX ? xa + (size_t)row * 1024 : xb + (size_t)(row - NCTX) * 1024;
        const int c = cond_of(row);
        f32x4 v[4]; float ss = 0.f;
#pragma unroll
        for (int i = 0; i < 4; ++i) {
            const int col = i * 256 + F.lane * 4;
            v[i] = *(const f32x4*)(x + col);
            if (part) {
                const u32x2 q0 = *(const u32x2*)(part + (size_t)row * 1024 + col), q1 = *(const u32x2*)(part + (size_t)NTOK * 1024 + (size_t)row * 1024 + col);
                f32x4 ps = (f32x4){bf2f(q0.x & 0xffffu) + bf2f(q1.x & 0xffffu), bf2f(q0.x >> 16) + bf2f(q1.x >> 16), bf2f(q0.y & 0xffffu) + bf2f(q1.y & 0xffffu), bf2f(q0.y >> 16) + bf2f(q1.y >> 16)};
                if (row >= q4row) {
                    const u32x2 q2 = *(const u32x2*)(part + (size_t)2 * NTOK * 1024 + (size_t)row * 1024 + col), q3 = *(const u32x2*)(part + (size_t)3 * NTOK * 1024 + (size_t)row * 1024 + col);
                    ps = ps + (f32x4){bf2f(q2.x & 0xffffu) + bf2f(q3.x & 0xffffu), bf2f(q2.x >> 16) + bf2f(q3.x >> 16), bf2f(q2.y & 0xffffu) + bf2f(q3.y & 0xffffu), bf2f(q2.y >> 16) + bf2f(q3.y >> 16)};
                }
                const f32x4 gt = *(const f32x4*)(gate + c * 6144 + col);
                v[i] = v[i] + gt * ps;
                *(f32x4*)(xout + (size_t)row * 1024 + col) = v[i];
            }
            ss += v[i][0] * v[i][0] + v[i][1] * v[i][1] + v[i][2] * v[i][2] + v[i][3] * v[i][3];
        }
        if (!do_norm) continue;
        ss = wave_sum(ss);
        const float rstd = rsqrtf(ss * (1.0f / 1024.0f) + EPS);
#pragma unroll
        for (int i = 0; i < 4; ++i) {
            const int col = i * 256 + F.lane * 4;
            const f32x4 gg = *(const f32x4*)(g + col), s1 = *(const f32x4*)(sc + c * 6144 + col), s0 = *(const f32x4*)(sh + c * 6144 + col);
            f32x4 h;
#pragma unroll
            for (int j = 0; j < 4; ++j) h[j] = v[i][j] * rstd * gg[j] * (1.0f + s1[j]) + s0[j];
            u32x2 w; w.x = pack2(h[0], h[1]); w.y = pack2(h[2], h[3]);
            *(u32x2*)(hb + (size_t)row * 1024 + col) = w;
        }
    }
}

__device__ __forceinline__ void seq_of_unit384(int u, int& s, int& c, int& h, int& tok0, int& nc) {
    if (u < 256) { s = u >> 4; c = (u >> 2) & 3; h = u & 3; tok0 = s * 256 + c * 64; nc = 4; }
    else { const int v = u - 256; s = 16 + (v >> 6); c = (v >> 2) & 15; h = v & 3; tok0 = NCTX + (s - 16) * 1024 + c * 64; nc = 16; }
}
__device__ __forceinline__ void phase_l0_tok(const Frame& F, const PRef& p) {
    unsigned char* ws = p.ws();
    const float* P = (const float*)(ws + WS_P0);
    bf16_t* cqn = (bf16_t*)(ws + WS_CQN); bf16_t* ckvn = (bf16_t*)(ws + WS_CKVN);
    const int nw = F.G * 8;
    for (int row = F.bid * 8 + F.wave; row < NKROW; row += nw) {
        if (row < NTOK) {
            const float* pr = P + (size_t)row * 2048;
            const f32x4 q = *(const f32x4*)(pr + F.lane * 4);
            const f32x2 kv = *(const f32x2*)(pr + 256 + F.lane * 2);
            float kro = 0.f; if (row < NCTX && F.lane < 32) kro = pr[384 + F.lane];
            asm volatile("" ::: "memory");
            float ss = wave_sum(q[0] * q[0] + q[1] * q[1] + q[2] * q[2] + q[3] * q[3]);
            float rstd = rsqrtf(ss * (1.0f / 256.0f) + EPS);
            const f32x4 gq = *(const f32x4*)(p.in(20) + F.lane * 4);
            u32x2 w; w.x = pack2(q[0] * rstd * gq[0], q[1] * rstd * gq[1]); w.y = pack2(q[2] * rstd * gq[2], q[3] * rstd * gq[3]);
            *(u32x2*)(cqn + (size_t)row * 256 + F.lane * 4) = w;
            ss = wave_sum(kv[0] * kv[0] + kv[1] * kv[1]);
            rstd = rsqrtf(ss * (1.0f / 128.0f) + EPS);
            const f32x2 gk = *(const f32x2*)(p.in(21) + F.lane * 2);
            const float o0 = kv[0] * rstd * gk[0], o1 = kv[1] * rstd * gk[1];
            *(unsigned*)(ckvn + (size_t)row * 128 + F.lane * 2) = pack2(o0, o1);
            if (row < NCTX) {
                *(f32x2*)(p.out() + OUT_CKV + (size_t)row * 128 + F.lane * 2) = (f32x2){o0, o1};
                if (F.lane < 32) p.out()[OUT_KROPE + (size_t)row * 32 + F.lane] = kro;
            }
        } else {
            const int i = row - NTOK;
            const f32x2 kv = *(const f32x2*)(p.in(2) + (size_t)i * 128 + F.lane * 2);
            *(unsigned*)(ckvn + (size_t)row * 128 + F.lane * 2) = pack2(kv[0], kv[1]);
        }
    }
    {
        LAS unsigned char* L = F.lds;
        constexpr int KPI = 160, VPI = 288, O_KF = 0, O_KB = 64 * KPI, O_V = 2 * 64 * KPI;
        float* KVS = (float*)(ws + WS_KVS);
        const int tid = F.tid, w = F.wave, fr = F.lane & 15, fq = F.lane >> 4;
        FOR_UNITS(u, 384, 0) {
            int s, c, h, tok0, nc; seq_of_unit384(u, s, c, h, tok0, nc);
            const float lgf = __logf(sigmoidf_(p.in(26)[h])), lgb = __logf(sigmoidf_(p.in(26)[4 + h]));
            {
                const int row = tid >> 3, ch = tid & 7;
                const float* pr = P + (size_t)(tok0 + row) * 2048;
                const f32x4 k0 = *(const f32x4*)(pr + 672 + h * 64 + ch * 8), k1 = *(const f32x4*)(pr + 672 + h * 64 + ch * 8 + 4);
                f32x4 vv[4];
#pragma unroll
                for (int i = 0; i < 4; ++i) vv[i] = *(const f32x4*)(pr + 928 + h * 128 + ch * 16 + i * 4);
                const float df = 0.125f * __expf(lgf * (float)(63 - row)), db = 0.125f * __expf(lgb * (float)row);
                u32x4 t;
                t.x = pack2(k0[0] * df, k0[1] * df); t.y = pack2(k0[2] * df, k0[3] * df); t.z = pack2(k1[0] * df, k1[1] * df); t.w = pack2(k1[2] * df, k1[3] * df); *(LAS u32x4*)(L + O_KF + row * KPI + ch * 16) = t;
                t.x = pack2(k0[0] * db, k0[1] * db); t.y = pack2(k0[2] * db, k0[3] * db); t.z = pack2(k1[0] * db, k1[1] * db); t.w = pack2(k1[2] * db, k1[3] * db); *(LAS u32x4*)(L + O_KB + row * KPI + ch * 16) = t;
#pragma unroll
                for (int i = 0; i < 2; ++i) { t.x = pack2(vv[2 * i][0], vv[2 * i][1]); t.y = pack2(vv[2 * i][2], vv[2 * i][3]); t.z = pack2(vv[2 * i + 1][0], vv[2 * i + 1][1]); t.w = pack2(vv[2 * i + 1][2], vv[2 * i + 1][3]);
                    *(LAS u32x4*)(L + O_V + row * VPI + ch * 32 + i * 16) = t; }
            }
            __syncthreads();
            bf16x8 Bf[2];
#pragma unroll
            for (int ks = 0; ks < 2; ++ks) {
                const LAS unsigned char* vp = L + O_V + (32 * ks + 8 * fq + (fr >> 2)) * VPI + (w * 16 + 4 * (fr & 3)) * 2;
                const bf16x4 v0 = __builtin_amdgcn_ds_read_tr16_b64_v4i16((LAS bf16x4*)vp), v1 = __builtin_amdgcn_ds_read_tr16_b64_v4i16((LAS bf16x4*)(vp + 4 * VPI));
                bf16x8 x; x[0] = v0[0]; x[1] = v0[1]; x[2] = v0[2]; x[3] = v0[3]; x[4] = v1[0]; x[5] = v1[1]; x[6] = v1[2]; x[7] = v1[3]; Bf[ks] = x;
            }
            float* o = KVS + (size_t)u * 2 * 8192;
#pragma unroll
            for (int d = 0; d < 2; ++d)
#pragma unroll
                for (int et = 0; et < 4; ++et) {
                    f32x4 a = (f32x4){0.f, 0.f, 0.f, 0.f};
#pragma unroll
                    for (int ks = 0; ks < 2; ++ks) {
                        const LAS unsigned char* kp = L + (d ? O_KB : O_KF) + (32 * ks + 8 * fq + (fr >> 2)) * KPI + (et * 16 + 4 * (fr & 3)) * 2;
                        const bf16x4 v0 = __builtin_amdgcn_ds_read_tr16_b64_v4i16((LAS bf16x4*)kp), v1 = __builtin_amdgcn_ds_read_tr16_b64_v4i16((LAS bf16x4*)(kp + 4 * KPI));
                        bf16x8 x; x[0] = v0[0]; x[1] = v0[1]; x[2] = v0[2]; x[3] = v0[3]; x[4] = v1[0]; x[5] = v1[1]; x[6] = v1[2]; x[7] = v1[3];
                        a = __builtin_amdgcn_mfma_f32_16x16x32_bf16(x, Bf[ks], a, 0, 0, 0);
                    }
#pragma unroll
                    for (int r = 0; r < 4; ++r) o[d * 8192 + (et * 16 + 4 * fq + r) * 128 + w * 16 + fr] = a[r];
                }
            __syncthreads();
        }
    }
}

__device__ __forceinline__ void phase_l0_prefix(const Frame& F, const PRef& p, int rot) {
    float* KVS = (float*)(p.ws() + WS_KVS);
    FOR_UNITS(u, 576, rot) {
        const int qd = u & 3, d = (u >> 2) & 1, h = (u >> 3) & 3, s = u >> 5;
        const int nc = s < 16 ? 4 : 16;
        const int ubase = s < 16 ? s * 16 + h : 256 + (s - 16) * 64 + h;
        const float g64 = __expf(64.0f * __logf(sigmoidf_(p.in(26)[d * 4 + h])));
        const int i = qd * 2048 + F.tid * 4;
        float* base = KVS + (size_t)ubase * 16384 + d * 8192 + i;
        f32x4 kv[16];
#pragma unroll
        for (int c = 0; c < 16; ++c) if (c < nc) kv[c] = *(const f32x4*)(base + (size_t)c * 4 * 16384);
        f32x4 S = (f32x4){0.f, 0.f, 0.f, 0.f};
        if (s >= 16) S = *(const f32x4*)(p.in(4) + (size_t)(((s - 16) * 2 + d) * 4 + h) * 8192 + i);
        if (d == 0) {
#pragma unroll
            for (int c = 0; c < 16; ++c) if (c < nc) { *(f32x4*)(base + (size_t)c * 4 * 16384) = S; S = S * g64 + kv[c]; }
        } else {
#pragma unroll
            for (int c = 15; c >= 0; --c) if (c < nc) { *(f32x4*)(base + (size_t)c * 4 * 16384) = S; S = S * g64 + kv[c]; }
        }
        if (s < 16) *(f32x4*)(p.out() + OUT_SRET + (size_t)((s * 2 + d) * 4 + h) * 8192 + i) = S;
    }
}

__device__ __forceinline__ size_t vt_base(int kr, int nheads, int dv, int& nkeys, int& key) {
    if (kr < NCTX) { nkeys = 256; key = kr & 255; return (size_t)(kr >> 8) * nheads * dv * 256; }
    const int v = kr - NCTX; const int b = v / 1536; nkeys = 1536; key = v - b * 1536;
    return (size_t)16 * nheads * dv * 256 + (size_t)b * nheads * dv * 1536;
}
__device__ __forceinline__ void phase_l0_qkv(const Frame& F, const PRef& p) {
    unsigned char* ws = p.ws();
    const float* P = (const float*)(ws + WS_P0); const float* QR = (const float*)(ws + WS_QRAW); const float* KVR = (const float*)(ws + WS_KVRAW);
    bf16_t* Q = (bf16_t*)(ws + WS_Q0); bf16_t* K = (bf16_t*)(ws + WS_K0); bf16_t* VT = (bf16_t*)(ws + WS_VT0);
    const int nw = F.G * 8, lane = F.lane;
    const float qscale = 0.10206207261596577f;
    for (int row = F.bid * 8 + F.wave; row < NKROW; row += nw) {
        const bool istok = row < NTOK, lat = istok && row >= NCTX;
        float cs = 1.f, sn = 0.f;
        if (lat && lane >= 32 && lane < 48) {
            const int t = (row - NCTX) & 1023, a = lane - 32;
            const float pos = a < 8 ? (float)(t >> 6) : (float)(t & 63);
            const float inv = __powf(10000.0f, -(float)(a & 7) * 0.125f);
            const float ang = pos * inv; cs = __cosf(ang); sn = __sinf(ang);
        }
        int kr;
        if (row < NCTX) kr = row; else if (row < NTOK) { const int v = row - NCTX; kr = NCTX + (v >> 10) * 1536 + (v & 1023); }
        else { const int i = row - NTOK; kr = NCTX + (i >> 9) * 1536 + 1024 + (i & 511); }
        const float* krope = istok ? P + (size_t)row * 2048 + 384 : p.in(3) + (size_t)(row - NTOK) * 32;
        f32x2 qv[8], kv2[8]; float vv[8];
        f32x2 kro = (f32x2){0.f, 0.f};
        if (lane >= 32 && lane < 48) kro = *(const f32x2*)(krope + 2 * (lane - 32));
#pragma unroll
        for (int h = 0; h < 8; ++h) {
            qv[h] = (f32x2){0.f, 0.f};
            if (istok && lane < 48) qv[h] = *(const f32x2*)(QR + (size_t)row * 768 + h * 96 + 2 * lane);
            kv2[h] = kro;
            if (lane < 32) kv2[h] = *(const f32x2*)(KVR + (size_t)row * 1024 + h * 128 + 2 * lane);
            vv[h] = KVR[(size_t)row * 1024 + h * 128 + 64 + lane];
        }
        f32x2 gq = (f32x2){0.f, 0.f}, gk = (f32x2){0.f, 0.f};
        if (lane < 48) { gq = *(const f32x2*)(p.in(24) + 2 * lane); gk = *(const f32x2*)(p.in(25) + 2 * lane); }
#pragma unroll
        for (int h = 0; h < 8; ++h) {
            if (istok) {
                float x1 = qv[h][0], x2 = qv[h][1];
                const float rstd = rsqrtf(wave_sum(x1 * x1 + x2 * x2) * (1.0f / 96.0f) + EPS);
                if (lane < 48) {
                    x1 = x1 * rstd * gq[0]; x2 = x2 * rstd * gq[1];
                    const float y1 = x1 * cs - x2 * sn, y2 = x1 * sn + x2 * cs;
                    *(unsigned*)(Q + (size_t)row * 768 + h * 96 + 2 * lane) = pack2(y1 * qscale, y2 * qscale);
                }
            }
            {
                float x1 = kv2[h][0], x2 = kv2[h][1];
                const float rstd = rsqrtf(wave_sum(x1 * x1 + x2 * x2) * (1.0f / 96.0f) + EPS);
                if (lane < 48) {
                    x1 = x1 * rstd * gk[0]; x2 = x2 * rstd * gk[1];
                    const float y1 = x1 * cs - x2 * sn, y2 = x1 * sn + x2 * cs;
                    *(unsigned*)(K + (size_t)kr * 768 + h * 96 + 2 * lane) = pack2(y1, y2);
                }
            }
            VT[(size_t)kr * 512 + h * 64 + lane] = f2bf(vv[h]);
        }
    }
}

template <int DQK, int DV, int NC, int NQT>
struct AttnState { f32x4 O[NC][DV / 16][NQT]; float l[NC][NQT]; };

template <int DQK, int DV, int NC, int NQT>
__device__ __forceinline__ void attn_wave(const bf16_t* __restrict__ Q, const bf16_t* __restrict__ K, const bf16_t* __restrict__ Vt,
                                          int qtok0, int krow0, int nkeys, int hh0  , int lane, AttnState<DQK, DV, NC, NQT>& st) {
    constexpr int NS = DQK / 32, NE = DV / 16, RS = 8 * DQK;
    const int fr = lane & 15, fq = lane >> 4;
    bf16x8 Qf[NC][NQT][NS];
#pragma unroll
    for (int c = 0; c < NC; ++c)
#pragma unroll
        for (int qt = 0; qt < NQT; ++qt)
#pragma unroll
            for (int s = 0; s < NS; ++s) Qf[c][qt][s] = *(const bf16x8*)(Q + (size_t)(qtok0 + qt * 16 + fr) * RS + (hh0 + c) * DQK + s * 32 + fq * 8);
    float m[NC][NQT];
#pragma unroll
    for (int c = 0; c < NC; ++c)
#pragma unroll
        for (int qt = 0; qt < NQT; ++qt) { m[c][qt] = -1e30f; st.l[c][qt] = 0.f;
#pragma unroll
            for (int e = 0; e < NE; ++e) st.O[c][e][qt] = (f32x4){0.f, 0.f, 0.f, 0.f}; }
    for (int key0 = 0; key0 < nkeys; key0 += 32) {
        bf16x8 Pf[NC][NQT];
#pragma unroll
        for (int c = 0; c < NC; ++c) {
            f32x4 S[2][NQT];
#pragma unroll
            for (int kt = 0; kt < 2; ++kt) {
                bf16x8 Kf[NS];
#pragma unroll
                for (int s = 0; s < NS; ++s) Kf[s] = *(const bf16x8*)(K + (size_t)(krow0 + key0 + kt * 16 + fr) * RS + (hh0 + c) * DQK + s * 32 + fq * 8);
#pragma unroll
                for (int qt = 0; qt < NQT; ++qt) {
                    f32x4 a = (f32x4){0.f, 0.f, 0.f, 0.f};
#pragma unroll
                    for (int s = 0; s < NS; ++s) a = __builtin_amdgcn_mfma_f32_16x16x32_bf16(Kf[s], Qf[c][qt][s], a, 0, 0, 0);
                    S[kt][qt] = a;
                }
            }
#pragma unroll
            for (int qt = 0; qt < NQT; ++qt) {
                float mx = fmaxf(fmaxf(fmaxf(S[0][qt][0], S[0][qt][1]), fmaxf(S[0][qt][2], S[0][qt][3])), fmaxf(fmaxf(S[1][qt][0], S[1][qt][1]), fmaxf(S[1][qt][2], S[1][qt][3])));
                mx = fmaxf(mx, __shfl_xor(mx, 16)); mx = fmaxf(mx, __shfl_xor(mx, 32));
                const float mn = fmaxf(m[c][qt], mx), alpha = __expf(m[c][qt] - mn);
                m[c][qt] = mn;
                float pv[8]; float ps = 0.f;
#pragma unroll
                for (int j = 0; j < 4; ++j) { pv[j] = __expf(S[0][qt][j] - mn); pv[4 + j] = __expf(S[1][qt][j] - mn); ps += pv[j] + pv[4 + j]; }
                st.l[c][qt] = st.l[c][qt] * alpha + ps;
#pragma unroll
                for (int e = 0; e < NE; ++e) st.O[c][e][qt] *= alpha;
                u32x4 pk; pk.x = pack2(pv[0], pv[1]); pk.y = pack2(pv[2], pv[3]); pk.z = pack2(pv[4], pv[5]); pk.w = pack2(pv[6], pv[7]);
                Pf[c][qt] = __builtin_bit_cast(bf16x8, pk);
            }
        }
#pragma unroll
        for (int e = 0; e < NE; ++e) {
            const bf16_t* vp = Vt + (size_t)(e * 16 + fr) * nkeys + key0 + 4 * fq;
            const bf16x4 v0 = *(const bf16x4*)vp, v1 = *(const bf16x4*)(vp + 16);
            bf16x8 Vf; Vf[0] = v0[0]; Vf[1] = v0[1]; Vf[2] = v0[2]; Vf[3] = v0[3]; Vf[4] = v1[0]; Vf[5] = v1[1]; Vf[6] = v1[2]; Vf[7] = v1[3];
#pragma unroll
            for (int c = 0; c < NC; ++c)
#pragma unroll
                for (int qt = 0; qt < NQT; ++qt) st.O[c][e][qt] = __builtin_amdgcn_mfma_f32_16x16x32_bf16(Vf, Pf[c][qt], st.O[c][e][qt], 0, 0, 0);
        }
    }
#pragma unroll
    for (int c = 0; c < NC; ++c)
#pragma unroll
        for (int qt = 0; qt < NQT; ++qt) { float l = st.l[c][qt]; l += __shfl_xor(l, 16); l += __shfl_xor(l, 32); st.l[c][qt] = 1.0f / l; }
}

__device__ __forceinline__ int attn_unit_xcd(int bid, int which) {
    const int x = bid & 7, idx = bid >> 3;
    return which == 0 ? (2 * x + (idx >> 4)) * 16 + (idx & 15) : 256 + (x * 16 + (idx >> 1)) * 2 + (idx & 1);
}
template <int DQK, int DV, int VH, class OutFn>
__device__ __forceinline__ void attn_block(const Frame& F, const bf16_t* __restrict__ Q, const bf16_t* __restrict__ K, const bf16_t* __restrict__ VT, const OutFn& out, int unit, float shift) {
    constexpr int NS = DQK / 32, NE = DV / 16, RS = 8 * DQK, KPC = DQK / 8;
    constexpr int KB = 128 * 256, VP = DV * 2 + 32, VB = 128 * VP, STG = KB + VB, VPC = DV / 8;
    constexpr int NKP = 128 * KPC / NTHREADS, NVP = 128 * VPC / NTHREADS;
    LAS unsigned char* lds = F.lds;
    const int lane = F.lane, fr = lane & 15, fq = lane >> 4, wave = F.wave, tid = F.tid;
    const bool lat = unit < 256;
    int ab, h, q0, nkeys, NQG;
    if (lat) { ab = 16 + (unit >> 7); h = (unit >> 4) & 7; q0 = (unit & 15) * 64; nkeys = 1536; NQG = 2; }
    else { const int v = unit - 256; ab = v >> 4; h = (v >> 1) & 7; q0 = (v & 1) * 128; nkeys = 256; NQG = 4; }
    const int NKS = 8 / NQG, qg = wave % NQG, ks = wave / NQG, kslice = 128 / NKS, nit = kslice / 32;
    const int qtok0 = (lat ? NCTX + (ab - 16) * 1024 : ab * 256) + q0 + qg * 32;
    const int krow0 = lat ? NCTX + (ab - 16) * 1536 : ab * 256;
    const bf16_t* vg = VT + (size_t)krow0 * (VH * DV) + (h * VH / 8) * DV;
    const bf16_t* kg = K + (size_t)krow0 * RS + h * DQK;
    bf16x8 Qf[2][NS];
#pragma unroll
    for (int qt = 0; qt < 2; ++qt)
#pragma unroll
        for (int s = 0; s < NS; ++s) Qf[qt][s] = *(const bf16x8*)(Q + (size_t)(qtok0 + qt * 16 + fr) * RS + h * DQK + s * 32 + fq * 8);
    f32x4 O[NE][2]; float l[2];
    const float sh2 = shift * 1.44269504f;
#pragma unroll
    for (int qt = 0; qt < 2; ++qt) { l[qt] = 0.f;
#pragma unroll
        for (int e = 0; e < NE; ++e) O[e][qt] = (f32x4){0.f, 0.f, 0.f, 0.f}; }
    u32x4 kregA[NKP], vregA[NVP], kregB[DV == 64 ? NKP : 1], vregB[DV == 64 ? NVP : 1];
#define AT_LOAD(kreg, vreg, st) do { \
        _Pragma("unroll") for (int i = 0; i < NKP; ++i) { const int pid = tid + i * NTHREADS, row = pid / KPC, ch = pid % KPC; kreg[i] = *(const u32x4*)(kg + (size_t)((st) * 128 + row) * RS + ch * 8); } \
        _Pragma("unroll") for (int i = 0; i < NVP; ++i) { const int pid = tid + i * NTHREADS, row = pid / VPC, ch = pid % VPC; vreg[i] = *(const u32x4*)(vg + (size_t)((st) * 128 + row) * (VH * DV) + ch * 8); } } while (0)
#define AT_WRITE(kreg, vreg, buf) do { \
        _Pragma("unroll") for (int i = 0; i < NKP; ++i) { const int pid = tid + i * NTHREADS, row = pid / KPC, ch = pid % KPC; *(LAS u32x4*)(lds + (buf) * STG + row * 256 + ((ch ^ (row & 15)) << 4)) = kreg[i]; } \
        _Pragma("unroll") for (int i = 0; i < NVP; ++i) { const int pid = tid + i * NTHREADS, row = pid / VPC, ch = pid % VPC; *(LAS u32x4*)(lds + (buf) * STG + KB + row * VP + ch * 16) = vreg[i]; } } while (0)
#define AT_COMPUTE(bufsel) do { \
        const LAS unsigned char* kb = lds + (bufsel) * STG; const LAS unsigned char* vb = kb + KB; \
        for (int it = 0; it < nit; ++it) { \
            const int key0 = ks * kslice + it * 32; \
            f32x4 S[2][2]; \
            _Pragma("unroll") for (int kt = 0; kt < 2; ++kt) { \
                const int row = key0 + kt * 16 + fr; \
                bf16x8 Kf[NS]; \
                _Pragma("unroll") for (int s_ = 0; s_ < NS; ++s_) Kf[s_] = *(const LAS bf16x8*)(kb + row * 256 + (((4 * s_ + fq) ^ (row & 15)) << 4)); \
                _Pragma("unroll") for (int qt = 0; qt < 2; ++qt) { \
                    f32x4 a = (f32x4){0.f, 0.f, 0.f, 0.f}; \
                    _Pragma("unroll") for (int s_ = 0; s_ < NS; ++s_) a = __builtin_amdgcn_mfma_f32_16x16x32_bf16(Kf[s_], Qf[qt][s_], a, 0, 0, 0); \
                    S[kt][qt] = a; } } \
            bf16x8 Pf[2]; \
            _Pragma("unroll") for (int qt = 0; qt < 2; ++qt) { \
                float pv[8]; float ps = 0.f; \
                _Pragma("unroll") for (int j = 0; j < 4; ++j) { pv[j] = __builtin_amdgcn_exp2f(S[0][qt][j] * 1.44269504f - sh2); pv[4 + j] = __builtin_amdgcn_exp2f(S[1][qt][j] * 1.44269504f - sh2); ps += pv[j] + pv[4 + j]; } \
                l[qt] += ps; \
                u32x4 pk; pk.x = pack2(pv[0], pv[1]); pk.y = pack2(pv[2], pv[3]); pk.z = pack2(pv[4], pv[5]); pk.w = pack2(pv[6], pv[7]); \
                Pf[qt] = __builtin_bit_cast(bf16x8, pk); } \
            _Pragma("unroll") for (int e = 0; e < NE; ++e) { \
                const LAS unsigned char* vp = vb + (key0 + 4 * fq + (fr >> 2)) * VP + (e * 16 + 4 * (fr & 3)) * 2; \
                const bf16x4 v0 = __builtin_amdgcn_ds_read_tr16_b64_v4i16((LAS bf16x4*)vp), v1 = __builtin_amdgcn_ds_read_tr16_b64_v4i16((LAS bf16x4*)(vp + 16 * VP)); \
                bf16x8 Vf; Vf[0] = v0[0]; Vf[1] = v0[1]; Vf[2] = v0[2]; Vf[3] = v0[3]; Vf[4] = v1[0]; Vf[5] = v1[1]; Vf[6] = v1[2]; Vf[7] = v1[3]; \
                _Pragma("unroll") for (int qt = 0; qt < 2; ++qt) O[e][qt] = __builtin_amdgcn_mfma_f32_16x16x32_bf16(Vf, Pf[qt], O[e][qt], 0, 0, 0); } } } while (0)
    const int nst = nkeys / 128;
    constexpr bool TWOSET = DV == 64;
    AT_LOAD(kregA, vregA, 0); if (TWOSET) AT_LOAD(kregB, vregB, 1); AT_WRITE(kregA, vregA, 0);
#pragma unroll
    for (int qt = 0; qt < 2; ++qt)
#pragma unroll
        for (int s_ = 0; s_ < NS; ++s_) asm volatile("" :: "v"(Qf[qt][s_]));
    __syncthreads();
    for (int st = 0; st < nst; st += 2) {
        if (TWOSET) {
            if (st + 2 < nst) AT_LOAD(kregA, vregA, st + 2);
            AT_COMPUTE(0);
            AT_WRITE(kregB, vregB, 1);
            __syncthreads();
            if (st + 3 < nst) AT_LOAD(kregB, vregB, st + 3);
            AT_COMPUTE(1);
            if (st + 2 < nst) AT_WRITE(kregA, vregA, 0);
            __syncthreads();
        } else {
            AT_LOAD(kregA, vregA, st + 1);
            AT_COMPUTE(0);
            AT_WRITE(kregA, vregA, 1);
            __syncthreads();
            if (st + 2 < nst) AT_LOAD(kregA, vregA, st + 2);
            AT_COMPUTE(1);
            if (st + 2 < nst) AT_WRITE(kregA, vregA, 0);
            __syncthreads();
        }
    }
#undef AT_COMPUTE
#undef AT_LOAD
#undef AT_WRITE
    LAS f32x4* Ost = (LAS f32x4*)lds; LAS float* LL = (LAS float*)(lds + 8 * 2 * NE * 1024);
#pragma unroll
    for (int qt = 0; qt < 2; ++qt) {
        float lt = l[qt]; lt += __shfl_xor(lt, 16); lt += __shfl_xor(lt, 32);
        if (fq == 0) LL[(wave * 2 + qt) * 16 + fr] = lt;
#pragma unroll
        for (int e = 0; e < NE; ++e) Ost[((wave * 2 + qt) * NE + e) * 64 + lane] = O[e][qt];
    }
    __syncthreads();
    const int epw = NE / NKS;
#pragma unroll
    for (int qt = 0; qt < 2; ++qt) {
        float L = 0.f;
        for (int j = 0; j < NKS; ++j) L += LL[((j * NQG + qg) * 2 + qt) * 16 + fr];
        const float invL = 1.0f / L;
        for (int ee = 0; ee < epw; ++ee) {
            const int e = ks * epw + ee;
            f32x4 o = (f32x4){0.f, 0.f, 0.f, 0.f};
            for (int j = 0; j < NKS; ++j) o += Ost[(((j * NQG + qg) * 2 + qt) * NE + e) * 64 + lane];
            out(qtok0 + qt * 16 + fr, h * DV + e * 16 + 4 * fq, o * invL);
        }
    }
    __syncthreads();
}
struct AttnOutBf16 { bf16_t* C; int ldc;
    __device__ __forceinline__ void operator()(int tok, int col, f32x4 o) const { u32x2 w; w.x = pack2(o[0], o[1]); w.y = pack2(o[2], o[3]); *(u32x2*)(C + (size_t)tok * ldc + col) = w; } };

__device__ __forceinline__ void attn_unit(int u, int wave, int& ab, int& h, int& q0) {
    if (u < 64) { ab = 16 + (u >> 5); h = (u >> 2) & 7; q0 = (u & 3) * 256 + wave * 32; }
    else { const int v = u - 64; ab = v >> 3; h = v & 7; q0 = wave * 32; }
}

__device__ __forceinline__ void phase_l0_mix(const Frame& F, const PRef& p) {
    unsigned char* ws = p.ws();
    const float* P = (const float*)(ws + WS_P0);
    bf16_t* OB = (bf16_t*)(ws + WS_OB);
    const bf16_t* Q = (const bf16_t*)(ws + WS_Q0); const bf16_t* K = (const bf16_t*)(ws + WS_K0); const bf16_t* VT = (const bf16_t*)(ws + WS_VT0);
    const int lane = F.lane, fr = lane & 15, fq = lane >> 4;
    {
        float gq = 0.f, gk = 0.f;
        for (int i = 0; i < 96; ++i) { gq = fmaxf(gq, fabsf(p.in(24)[i])); gk = fmaxf(gk, fabsf(p.in(25)[i])); }
        const float shift = 9.79795897f * gq * gk;
        AttnOutBf16 ao{OB, 1024};
#ifndef ATT_REP
#define ATT_REP 0
#endif
        for (int rp_ = 0; rp_ < 1 + (ATT_REP == 1); ++rp_) {
            for (int slot = 0; slot * F.G < 512; ++slot) { const int u = F.G == 256 ? attn_unit_xcd(F.bid, slot) : F.bid + slot * F.G; if (u < 512) for (int r2_ = 0; r2_ < 1 + ((ATT_REP == 3 && slot == 0) || (ATT_REP == 4 && slot == 1) ? 3 : 0); ++r2_) attn_block<96, 64, 8>(F, Q, K, VT, ao, u, shift); }
        } }
    {
        LAS unsigned char* L = F.lds;
        constexpr int T64 = 64 * 128, VPI = 288, T128 = 64 * VPI;
        constexpr int O_Q = 0, O_K = T64, O_QF = 2 * T64, O_QB = 3 * T64, O_W = 4 * T64, O_V = 5 * T64, O_SF = O_V + T128, O_SB = O_SF + T128, O_RED = O_SB + T128;
        const float* KVS = (const float*)(ws + WS_KVS);
        const int tid = F.tid, w = F.wave;
        for (int rp_ = 0; rp_ < 1 + (ATT_REP == 2); ++rp_)
        FOR_UNITS(u, 384, 128) {
            int s, c, h, tok0, nc; seq_of_unit384(u, s, c, h, tok0, nc);
            const float lgf = __logf(sigmoidf_(p.in(26)[h])), lgb = __logf(sigmoidf_(p.in(26)[4 + h]));
            {
                const int row = tid >> 3, ch = tid & 7;
                const float* pr = P + (size_t)(tok0 + row) * 2048;
                const f32x4 q0 = *(const f32x4*)(pr + 416 + h * 64 + ch * 8), q1 = *(const f32x4*)(pr + 416 + h * 64 + ch * 8 + 4);
                const f32x4 k0 = *(const f32x4*)(pr + 672 + h * 64 + ch * 8), k1 = *(const f32x4*)(pr + 672 + h * 64 + ch * 8 + 4);
                f32x4 vv[4], sf[4], sb[4];
#pragma unroll
                for (int i = 0; i < 4; ++i) { vv[i] = *(const f32x4*)(pr + 928 + h * 128 + ch * 16 + i * 4);
                    sf[i] = *(const f32x4*)(KVS + (size_t)u * 16384 + row * 128 + ch * 16 + i * 4); sb[i] = *(const f32x4*)(KVS + (size_t)u * 16384 + 8192 + row * 128 + ch * 16 + i * 4); }
                const float df = __expf(lgf * (float)(row + 1)), db = __expf(lgb * (float)(64 - row));
                const int so = row * 128 + ((ch ^ (row & 7)) << 4);
                u32x4 t;
                t.x = pack2(q0[0], q0[1]); t.y = pack2(q0[2], q0[3]); t.z = pack2(q1[0], q1[1]); t.w = pack2(q1[2], q1[3]); *(LAS u32x4*)(L + O_Q + so) = t;
                t.x = pack2(q0[0] * df, q0[1] * df); t.y = pack2(q0[2] * df, q0[3] * df); t.z = pack2(q1[0] * df, q1[1] * df); t.w = pack2(q1[2] * df, q1[3] * df); *(LAS u32x4*)(L + O_QF + so) = t;
                t.x = pack2(q0[0] * db, q0[1] * db); t.y = pack2(q0[2] * db, q0[3] * db); t.z = pack2(q1[0] * db, q1[1] * db); t.w = pack2(q1[2] * db, q1[3] * db); *(LAS u32x4*)(L + O_QB + so) = t;
                t.x = pack2(k0[0] * 0.125f, k0[1] * 0.125f); t.y = pack2(k0[2] * 0.125f, k0[3] * 0.125f); t.z = pack2(k1[0] * 0.125f, k1[1] * 0.125f); t.w = pack2(k1[2] * 0.125f, k1[3] * 0.125f); *(LAS u32x4*)(L + O_K + so) = t;
                const int vo = row * VPI + ch * 32;
#pragma unroll
                for (int i = 0; i < 2; ++i) {
                    t.x = pack2(vv[2 * i][0], vv[2 * i][1]); t.y = pack2(vv[2 * i][2], vv[2 * i][3]); t.z = pack2(vv[2 * i + 1][0], vv[2 * i + 1][1]); t.w = pack2(vv[2 * i + 1][2], vv[2 * i + 1][3]); *(LAS u32x4*)(L + O_V + vo + i * 16) = t;
                    t.x = pack2(sf[2 * i][0], sf[2 * i][1]); t.y = pack2(sf[2 * i][2], sf[2 * i][3]); t.z = pack2(sf[2 * i + 1][0], sf[2 * i + 1][1]); t.w = pack2(sf[2 * i + 1][2], sf[2 * i + 1][3]); *(LAS u32x4*)(L + O_SF + vo + i * 16) = t;
                    t.x = pack2(sb[2 * i][0], sb[2 * i][1]); t.y = pack2(sb[2 * i][2], sb[2 * i][3]); t.z = pack2(sb[2 * i + 1][0], sb[2 * i + 1][1]); t.w = pack2(sb[2 * i + 1][2], sb[2 * i + 1][3]); *(LAS u32x4*)(L + O_SB + vo + i * 16) = t;
                }
            }
            __syncthreads();
            {
                const int jt = w >> 1;
                bf16x8 Kf[2];
#pragma unroll
                for (int ks = 0; ks < 2; ++ks) { const int row = jt * 16 + fr; Kf[ks] = *(const LAS bf16x8*)(L + O_K + row * 128 + (((4 * ks + fq) ^ (row & 7)) << 4)); }
#pragma unroll
                for (int t2 = 0; t2 < 2; ++t2) {
                    const int it = (w & 1) * 2 + t2, irow = it * 16 + fr;
                    f32x4 d = (f32x4){0.f, 0.f, 0.f, 0.f};
#pragma unroll
                    for (int ks = 0; ks < 2; ++ks) { const bf16x8 Qf_ = *(const LAS bf16x8*)(L + O_Q + irow * 128 + (((4 * ks + fq) ^ (irow & 7)) << 4)); d = __builtin_amdgcn_mfma_f32_16x16x32_bf16(Kf[ks], Qf_, d, 0, 0, 0); }
                    float wv[4];
#pragma unroll
                    for (int r = 0; r < 4; ++r) { const int j = jt * 16 + 4 * fq + r; float dec = 0.f; if (j <= irow) dec += __expf(lgf * (float)(irow - j)); if (j >= irow) dec += __expf(lgb * (float)(j - irow)); wv[r] = d[r] * dec; }
                    u32x2 t; t.x = pack2(wv[0], wv[1]); t.y = pack2(wv[2], wv[3]);
                    *(LAS u32x2*)(L + O_W + irow * 128 + (((2 * jt + (fq >> 1)) ^ (irow & 7)) << 4) + (fq & 1) * 8) = t;
                }
            }
            __syncthreads();
            f32x4 acc[4];
#pragma unroll
            for (int it = 0; it < 4; ++it) acc[it] = (f32x4){0.f, 0.f, 0.f, 0.f};
            {
                bf16x8 Af[3][2];
#pragma unroll
                for (int a = 0; a < 3; ++a)
#pragma unroll
                    for (int ks = 0; ks < 2; ++ks) {
                        const LAS unsigned char* vp = L + (a == 0 ? O_V : (a == 1 ? O_SF : O_SB)) + (32 * ks + 8 * fq + (fr >> 2)) * VPI + (w * 16 + 4 * (fr & 3)) * 2;
                        const bf16x4 v0 = __builtin_amdgcn_ds_read_tr16_b64_v4i16((LAS bf16x4*)vp), v1 = __builtin_amdgcn_ds_read_tr16_b64_v4i16((LAS bf16x4*)(vp + 4 * VPI));
                        bf16x8 x; x[0] = v0[0]; x[1] = v0[1]; x[2] = v0[2]; x[3] = v0[3]; x[4] = v1[0]; x[5] = v1[1]; x[6] = v1[2]; x[7] = v1[3];
                        Af[a][ks] = x;
                    }
#pragma unroll
                for (int it = 0; it < 4; ++it) {
                    const int irow = it * 16 + fr;
#pragma unroll
                    for (int ks = 0; ks < 2; ++ks) {
                        const int so = irow * 128 + (((4 * ks + fq) ^ (irow & 7)) << 4);
                        const bf16x8 bw = *(const LAS bf16x8*)(L + O_W + so), bqf = *(const LAS bf16x8*)(L + O_QF + so), bqb = *(const LAS bf16x8*)(L + O_QB + so);
                        acc[it] = __builtin_amdgcn_mfma_f32_16x16x32_bf16(Af[0][ks], bw, acc[it], 0, 0, 0);
                        acc[it] = __builtin_amdgcn_mfma_f32_16x16x32_bf16(Af[1][ks], bqf, acc[it], 0, 0, 0);
                        acc[it] = __builtin_amdgcn_mfma_f32_16x16x32_bf16(Af[2][ks], bqb, acc[it], 0, 0, 0);
                    }
                }
            }
            LAS float* red = (LAS float*)(L + O_RED);
#pragma unroll
            for (int it = 0; it < 4; ++it) {
                float ss = acc[it][0] * acc[it][0] + acc[it][1] * acc[it][1] + acc[it][2] * acc[it][2] + acc[it][3] * acc[it][3];
                ss += __shfl_xor(ss, 16); ss += __shfl_xor(ss, 32);
                if (fq == 0) red[w * 64 + it * 16 + fr] = ss;
            }
            __syncthreads();
            {
                const f32x4 gn = *(const f32x4*)(p.in(27) + h * 128 + w * 16 + 4 * fq);
#pragma unroll
                for (int it = 0; it < 4; ++it) {
                    const int i = it * 16 + fr, tok = tok0 + i;
                    float ss = 0.f;
#pragma unroll
                    for (int q = 0; q < 8; ++q) ss += red[q * 64 + i];
                    const float rstd = rsqrtf(ss * (1.0f / 128.0f) + EPS);
                    const f32x4 rg = *(const f32x4*)(P + (size_t)tok * 2048 + 1440 + h * 128 + w * 16 + 4 * fq);
                    u32x2 t; t.x = pack2(siluf_(rg[0]) * acc[it][0] * rstd * gn[0], siluf_(rg[1]) * acc[it][1] * rstd * gn[1]);
                    t.y = pack2(siluf_(rg[2]) * acc[it][2] * rstd * gn[2], siluf_(rg[3]) * acc[it][3] * rstd * gn[3]);
                    *(u32x2*)(OB + (size_t)tok * 1024 + 512 + h * 128 + w * 16 + 4 * fq) = t;
                }
            }
            __syncthreads();
        }
    }
}

__device__ __forceinline__ void phase_gate(const Frame& F, const PRef& p, int l) {
    const bf16_t* U = (const bf16_t*)(p.ws() + WS_U); bf16_t* ACT = (bf16_t*)(p.ws() + WS_ACT);
    const float* cw = p.in(16) + (size_t)l * 3 * 5632; const float* cb = p.in(17) + (size_t)l * 5632;
    const int gt = F.bid * NTHREADS + F.tid, ngt = F.G * NTHREADS;
    const int cg = gt % 352, tslot = gt / 352, nslot = ngt / 352;
    if (tslot >= nslot) return;
    const int c0 = cg * 8;
    float w0[2][8], w1[2][8], w2[2][8], bb[2][8];
#pragma unroll
    for (int half = 0; half < 2; ++half) {
        const int col = c0 + half * 2816;
#pragma unroll
        for (int q = 0; q < 2; ++q) {
            const f32x4 a = *(const f32x4*)(cw + col + q * 4), b = *(const f32x4*)(cw + 5632 + col + q * 4), c = *(const f32x4*)(cw + 2 * 5632 + col + q * 4), d = *(const f32x4*)(cb + col + q * 4);
#pragma unroll
            for (int j = 0; j < 4; ++j) { w0[half][q * 4 + j] = a[j]; w1[half][q * 4 + j] = b[j]; w2[half][q * 4 + j] = c[j]; bb[half][q * 4 + j] = d[j]; }
        }
    }
    bf16x8 cx[2][3], nx[2][3];
#define GATE_LOAD(dst, tok_) do { const int t_ = (tok_) < NCTX ? ((tok_) & 255) : (((tok_) - NCTX) & 1023), n_ = (tok_) < NCTX ? 256 : 1024; \
        const bf16x8 z_ = (bf16x8){0, 0, 0, 0, 0, 0, 0, 0}; \
        _Pragma("unroll") for (int half = 0; half < 2; ++half) { const bf16_t* up_ = U + (size_t)(tok_) * 5632 + c0 + half * 2816; \
            dst[half][1] = *(const bf16x8*)up_; dst[half][0] = t_ > 0 ? *(const bf16x8*)(up_ - 5632) : z_; dst[half][2] = t_ < n_ - 1 ? *(const bf16x8*)(up_ + 5632) : z_; } } while (0)
    if (tslot < NTOK) GATE_LOAD(cx, tslot);
    for (int tok = tslot; tok < NTOK; tok += nslot) {
        if (tok + nslot < NTOK) GATE_LOAD(nx, tok + nslot);
        float u2[2][8];
#pragma unroll
        for (int half = 0; half < 2; ++half)
#pragma unroll
            for (int j = 0; j < 8; ++j)
                u2[half][j] = bf2f((unsigned short)cx[half][0][j]) * w0[half][j] + bf2f((unsigned short)cx[half][1][j]) * w1[half][j] + bf2f((unsigned short)cx[half][2][j]) * w2[half][j] + bb[half][j];
        u32x4 w;
        w.x = pack2(siluf_(u2[0][0]) * u2[1][0], siluf_(u2[0][1]) * u2[1][1]); w.y = pack2(siluf_(u2[0][2]) * u2[1][2], siluf_(u2[0][3]) * u2[1][3]);
        w.z = pack2(siluf_(u2[0][4]) * u2[1][4], siluf_(u2[0][5]) * u2[1][5]); w.w = pack2(siluf_(u2[0][6]) * u2[1][6], siluf_(u2[0][7]) * u2[1][7]);
        *(u32x4*)(ACT + (size_t)tok * 2816 + c0) = w;
#pragma unroll
        for (int half = 0; half < 2; ++half)
#pragma unroll
            for (int q = 0; q < 3; ++q) cx[half][q] = nx[half][q];
    }
#undef GATE_LOAD
}

__device__ __forceinline__ void phase_l1_tok(const Frame& F, const PRef& p) {
    unsigned char* ws = p.ws();
    const float* P = (const float*)(ws + WS_P1);
    bf16_t* QD = (bf16_t*)(ws + WS_QD); bf16_t* KD = (bf16_t*)(ws + WS_KD); bf16_t* VDT = (bf16_t*)(ws + WS_VDT);
    float* RR = (float*)(ws + WS_RR); float* KR = (float*)(ws + WS_KR); float* VV = (float*)(ws + WS_VV); float* KK = (float*)(ws + WS_KK);
    bf16_t* TW = (bf16_t*)(ws + WS_TW); bf16_t* AD = (bf16_t*)(ws + WS_AD); bf16_t* SG = (bf16_t*)(ws + WS_SG);
    const int nw = F.G * 8, lane = F.lane;
    const float* mu = p.in(33);
    for (int row = F.bid * 8 + F.wave; row < NKROW; row += nw) {
        const bool istok = row < NTOK, lat = istok && row >= NCTX;
        int kr;
        if (row < NCTX) kr = row; else if (row < NTOK) { const int v = row - NCTX; kr = NCTX + (v >> 10) * 1536 + (v & 1023); }
        else { const int i = row - NTOK; kr = NCTX + (i >> 9) * 1536 + 1024 + (i & 511); }
        if (!istok) {
            const int i = row - NTOK;
#pragma unroll
            for (int j = 0; j < 8; ++j) {
                const int col = j * 64 + lane;
                KD[(size_t)kr * 512 + col] = f2bf(p.in(5)[(size_t)i * 512 + col]);
                VDT[(size_t)kr * 512 + col] = f2bf(p.in(6)[(size_t)i * 512 + col]);
            }
            continue;
        }
        const float* pr = P + (size_t)row * 3584;
        const int pi = lane & 31;
        f32x2 qv[4], kv[4];
#pragma unroll
        for (int pass = 0; pass < 4; ++pass) { const int vec = pass * 2 + (lane >> 5); qv[pass] = *(const f32x2*)(pr + vec * 64 + 2 * pi); kv[pass] = *(const f32x2*)(pr + 512 + vec * 64 + 2 * pi); }
        float vd[8];
#pragma unroll
        for (int j = 0; j < 8; ++j) vd[j] = pr[1024 + j * 64 + lane];
        const int t = row < NCTX ? (row & 255) : ((row - NCTX) & 1023), n = row < NCTX ? 256 : 1024;
        const bool hp = t > 0, hn = t < n - 1;
        const float* pp = pr + 1536;
        const float* pn = pp + 3584; const float* pv = pp - 3584;
#define SHIFT4(col) ({ const f32x4 _c = *(const f32x4*)(pp + (col)); const f32x4 _p = hp ? *(const f32x4*)(pv + (col)) : (f32x4){0.f, 0.f, 0.f, 0.f}; \
            const f32x4 _n = hn ? *(const f32x4*)(pn + (col)) : (f32x4){0.f, 0.f, 0.f, 0.f}; const f32x4 _m = *(const f32x4*)(mu + (col)); _c + (0.5f * (_p + _n) - _c) * _m; })
        const f32x4 r0 = SHIFT4(lane * 8), r1 = SHIFT4(lane * 8 + 4);
        const f32x4 k0 = SHIFT4(512 + lane * 8), k1 = SHIFT4(512 + lane * 8 + 4);
        const f32x4 v0 = SHIFT4(1024 + lane * 8), v1 = SHIFT4(1024 + lane * 8 + 4);
        const f32x4 la = SHIFT4(1536 + lane * 4);
        f32x4 lg = (f32x4){0.f, 0.f, 0.f, 0.f};
        if (lane < 32) lg = SHIFT4(1792 + lane * 4);
        const f32x4 kw0 = *(const f32x4*)(p.in(39) + lane * 8), kw1 = *(const f32x4*)(p.in(39) + lane * 8 + 4);
        const f32x2 gq = *(const f32x2*)(p.in(29) + 2 * pi), gk = *(const f32x2*)(p.in(30) + 2 * pi);
        asm volatile("" ::: "memory");
        float cs = 1.f, sn = 0.f;
        if (lat) {
            const int tt = (row - NCTX) & 1023, a = lane & 31;
            const float pos = a < 16 ? (float)(tt >> 6) : (float)(tt & 63);
            const float inv = __powf(10000.0f, -(float)(a & 15) * 0.0625f);
            const float ang = pos * inv; cs = __cosf(ang); sn = __sinf(ang);
        }
        {
#pragma unroll
            for (int pass = 0; pass < 4; ++pass) {
                const int vec = pass * 2 + (lane >> 5);
                {
                    const f32x2 v = qv[pass];
                    const float rstd = rsqrtf(half_sum(v[0] * v[0] + v[1] * v[1], lane) * (1.0f / 64.0f) + EPS);
                    const float x1 = v[0] * rstd * gq[0], x2 = v[1] * rstd * gq[1];
                    *(unsigned*)(QD + (size_t)row * 512 + vec * 64 + 2 * pi) = pack2((x1 * cs - x2 * sn) * 0.125f, (x1 * sn + x2 * cs) * 0.125f);
                }
                {
                    const f32x2 v = kv[pass];
                    const float rstd = rsqrtf(half_sum(v[0] * v[0] + v[1] * v[1], lane) * (1.0f / 64.0f) + EPS);
                    const float x1 = v[0] * rstd * gk[0], x2 = v[1] * rstd * gk[1];
                    if (row < NCTX) *(f32x2*)(p.out() + OUT_DK + (size_t)row * 512 + vec * 64 + 2 * pi) = (f32x2){x1, x2};
                    *(unsigned*)(KD + (size_t)kr * 512 + vec * 64 + 2 * pi) = pack2(x1 * cs - x2 * sn, x1 * sn + x2 * cs);
                }
            }
        }
#pragma unroll
        for (int j = 0; j < 8; ++j) {
            const int col = j * 64 + lane; const float v = vd[j];
            if (row < NCTX) p.out()[OUT_DV + (size_t)row * 512 + col] = v;
            VDT[(size_t)kr * 512 + col] = f2bf(v);
        }
        {
            const size_t o = (size_t)row * 512 + lane * 8;
            *(f32x4*)(RR + o) = r0; *(f32x4*)(RR + o + 4) = r1;
            *(f32x4*)(KR + o) = k0; *(f32x4*)(KR + o + 4) = k1;
            *(f32x4*)(VV + o) = v0; *(f32x4*)(VV + o + 4) = v1;
            const f32x4 kk0 = k0 * kw0, kk1 = k1 * kw1;
            float ss = (kk0[0] * kk0[0] + kk0[1] * kk0[1]) + (kk0[2] * kk0[2] + kk0[3] * kk0[3]) + (kk1[0] * kk1[0] + kk1[1] * kk1[1]) + (kk1[2] * kk1[2] + kk1[3] * kk1[3]);
            ss = oct_sum(ss);
            const float rn = rsqrtf(ss + EPS);
            *(f32x4*)(KK + o) = kk0 * rn; *(f32x4*)(KK + o + 4) = kk1 * rn;
        }
        {
            u32x2 w;
            if (lane < 32) { w.x = pack2(tanhf_(la[0]), tanhf_(la[1])); w.y = pack2(tanhf_(la[2]), tanhf_(la[3])); *(u32x2*)(TW + (size_t)row * 128 + lane * 4) = w; }
            else { w.x = pack2(la[0], la[1]); w.y = pack2(la[2], la[3]); *(u32x2*)(AD + (size_t)row * 128 + (lane - 32) * 4) = w; }
            if (lane < 32) { w.x = pack2(sigmoidf_(lg[0]), sigmoidf_(lg[1])); w.y = pack2(sigmoidf_(lg[2]), sigmoidf_(lg[3])); *(u32x2*)(SG + (size_t)row * 128 + lane * 4) = w; }
        }
#undef SHIFT4
#define SHIFTED(col) 0
#undef SHIFTED
    }
}

constexpr int SC_T = 16;
constexpr int SC_BUF = 2 * SC_T * 6 * 64;
__device__ __forceinline__ void phase_l1_mix(const Frame& F, const PRef& p) {
    unsigned char* ws = p.ws();
    const bf16_t* Q = (const bf16_t*)(ws + WS_QD); const bf16_t* K = (const bf16_t*)(ws + WS_KD); const bf16_t* VT = (const bf16_t*)(ws + WS_VDT);
    AttnOutBf16 ao{(bf16_t*)(ws + WS_DO), 1024};
    float gq = 0.f, gk = 0.f;
    for (int i = 0; i < 64; ++i) { gq = fmaxf(gq, fabsf(p.in(29)[i])); gk = fmaxf(gk, fabsf(p.in(30)[i])); }
    const float shift = 8.0f * gq * gk;
    for (int slot = 0; slot * F.G < 512; ++slot) { const int u = F.G == 256 ? attn_unit_xcd(F.bid, slot) : F.bid + slot * F.G; if (u < 512) attn_block<64, 128, 4>(F, Q, K, VT, ao, u, shift); }
}

__device__ __forceinline__ float dpp_xor1(float x) { return __int_as_float(__builtin_amdgcn_update_dpp(0, __float_as_int(x), 0xB1, 0xF, 0xF, true)); }
__device__ __forceinline__ float dpp_xor2(float x) { return __int_as_float(__builtin_amdgcn_update_dpp(0, __float_as_int(x), 0x4E, 0xF, 0xF, true)); }
#define VFMA(d, a, b, c) asm("v_fma_f32 %0, %1, %2, %3" : "=v"(d) : "v"(a), "v"(b), "v"(c))
#define VFMAN(d, a, b, c) asm("v_fma_f32 %0, -%1, %2, %3" : "=v"(d) : "v"(a), "v"(b), "v"(c))
#define VMUL(d, a, b) asm("v_mul_f32 %0, %1, %2" : "=v"(d) : "v"(a), "v"(b))
#define VADD(d, a, b) asm("v_add_f32 %0, %1, %2" : "=v"(d) : "v"(a), "v"(b))
#define QUAD_SUM_ASM(x) asm("s_nop 1\n\tv_add_f32_dpp %0, %0, %0 quad_perm:[1,0,3,2] row_mask:0xf bank_mask:0xf bound_ctrl:1\n\ts_nop 1\n\t" \
    "v_add_f32_dpp %0, %0, %0 quad_perm:[2,3,0,1] row_mask:0xf bank_mask:0xf bound_ctrl:1" : "+v"(x))
#define ROW16_SUM_ASM(x) asm("s_nop 1\n\tv_add_f32_dpp %0, %0, %0 quad_perm:[1,0,3,2] row_mask:0xf bank_mask:0xf bound_ctrl:1\n\ts_nop 1\n\t" \
    "v_add_f32_dpp %0, %0, %0 quad_perm:[2,3,0,1] row_mask:0xf bank_mask:0xf bound_ctrl:1\n\ts_nop 1\n\t" \
    "v_add_f32_dpp %0, %0, %0 row_half_mirror row_mask:0xf bank_mask:0xf bound_ctrl:1\n\ts_nop 1\n\t" \
    "v_add_f32_dpp %0, %0, %0 row_mirror row_mask:0xf bank_mask:0xf bound_ctrl:1" : "+v"(x))
constexpr int SREC = 400;
template <int KPL> struct ScanVecs { f32x4 w[KPL / 4], kka[KPL / 4], kd[KPL / 4], kk[KPL / 4], r[KPL / 4]; float v, c1, c2; };
template <int KPL>
__device__ __forceinline__ void scan_load(ScanVecs<KPL>& x, const LAS float* v6, int koff, int row) {
#pragma unroll
    for (int q = 0; q < KPL / 4; ++q) {
        x.w[q] = *(const LAS f32x4*)(v6 + 0 * 64 + koff + q * 4); x.kka[q] = *(const LAS f32x4*)(v6 + 1 * 64 + koff + q * 4); x.kd[q] = *(const LAS f32x4*)(v6 + 2 * 64 + koff + q * 4);
        x.kk[q] = *(const LAS f32x4*)(v6 + 3 * 64 + koff + q * 4); x.r[q] = *(const LAS f32x4*)(v6 + 4 * 64 + koff + q * 4);
    }
    x.v = v6[5 * 64 + row]; x.c1 = v6[384]; x.c2 = v6[385];
}
template <int MODE>
__device__ __forceinline__ void scan_unit(const Frame& F, const PRef& p, int unit) {
    constexpr int T = 32, NSTEPS = MODE == 0 ? 1024 : 256, BUF = T * SREC, NCHUNK = NSTEPS / T;
    constexpr int KPL = MODE == 0 ? 4 : 16, NQ = KPL / 4;
    unsigned char* ws = p.ws();
    const float* RR = (const float*)(ws + WS_RR); const float* KR = (const float*)(ws + WS_KR); const float* VV = (const float*)(ws + WS_VV); const float* KK = (const float*)(ws + WS_KK);
    const float* DEC = (const float*)(ws + WS_DEC); const float* AA = (const float*)(ws + WS_AA);
    float* YY = (float*)(ws + WS_YY);
    const float* k_a = p.in(40);
    LAS float* sb = (LAS float*)F.lds;
    const int lane = F.lane;
    const bool loader = F.wave >= 4;
    const bool compute = F.wave < 4;
    const int cid = MODE == 0 ? (unit >> 2) : unit;
    const int cb = cid >> 4, chh = (cid >> 1) & 7, cd = cid & 1;
    const int cbase = MODE == 0 ? NCTX + cb * 1024 : cb * 256;
    if (loader) {
        const int lt = F.tid - 256;
        f32x4 pa[2][6], pb[2][6];
        const f32x4 ka4 = *(const f32x4*)(k_a + chh * 64 + (lt & 15) * 4), rk4 = *(const f32x4*)(p.in(41) + chh * 64 + (lt & 15) * 4);
        float* BON = (float*)(ws + WS_BON) + (size_t)cd * NTOK * 8 + chh;
        const bool wbon = MODE == 1 || (unit & 3) == 0;
#define SC_LOAD(pre, chunk) do { _Pragma("unroll") for (int it = 0; it < 2; ++it) { const int item = it * 256 + lt; const int stp = item >> 4, k = (item & 15) * 4; \
            const int j_ = (chunk) * T + stp; const int tok = cbase + (cd ? NSTEPS - 1 - j_ : j_); const size_t o_ = (size_t)tok * 512 + chh * 64 + k; \
            pre[it][0] = *(const f32x4*)(DEC + (size_t)cd * NTOK * 512 + o_); pre[it][1] = *(const f32x4*)(AA + (size_t)cd * NTOK * 512 + o_); pre[it][2] = *(const f32x4*)(KR + o_); \
            pre[it][3] = *(const f32x4*)(KK + o_); pre[it][4] = *(const f32x4*)(RR + o_); pre[it][5] = *(const f32x4*)(VV + o_); } } while (0)
#define SC_WRITE(pre, buf, chunk) do { _Pragma("unroll") for (int it = 0; it < 2; ++it) { const int item = it * 256 + lt; const int stp = item >> 4, k = (item & 15) * 4; \
            const f32x4 a_ = pre[it][1], kk_ = pre[it][3], r_ = pre[it][4], w_ = pre[it][0]; LAS float* d_ = sb + (buf) * BUF + stp * SREC + k; \
            const f32x4 bb_ = kk_ * a_, kd_ = pre[it][2] * (1.0f + (a_ - 1.0f) * ka4); \
            *(LAS f32x4*)(d_) = w_; *(LAS f32x4*)(d_ + 64) = bb_; *(LAS f32x4*)(d_ + 128) = kd_; *(LAS f32x4*)(d_ + 192) = kk_; \
            *(LAS f32x4*)(d_ + 256) = w_ * r_; *(LAS f32x4*)(d_ + 320) = pre[it][5]; \
            const f32x4 p1_ = bb_ * r_, p2_ = kd_ * r_; const float c1_ = row16_sum((p1_[0] + p1_[1]) + (p1_[2] + p1_[3])), c2_ = row16_sum((p2_[0] + p2_[1]) + (p2_[2] + p2_[3])); \
            const f32x4 p3_ = p2_ * rk4; const float c3_ = row16_sum((p3_[0] + p3_[1]) + (p3_[2] + p3_[3])); \
            if ((lt & 15) == 0) { LAS float* e_ = sb + (buf) * BUF + stp * SREC + 384; e_[0] = c1_; e_[1] = c2_; \
                if (wbon) { const int j2_ = (chunk) * T + stp; BON[(size_t)(cbase + (cd ? NSTEPS - 1 - j2_ : j2_)) * 8] = c3_; } } } } while (0)
        SC_LOAD(pa, 0); SC_LOAD(pb, 1); SC_WRITE(pa, 0, 0); SC_LOAD(pa, 2);
        __syncthreads();
        for (int cnk = 0; cnk < NCHUNK; cnk += 2) {
            if (cnk + 1 < NCHUNK) { SC_WRITE(pb, (cnk + 1) & 1, cnk + 1); if (cnk + 3 < NCHUNK) SC_LOAD(pb, cnk + 3); }
            __syncthreads();
            if (cnk + 2 < NCHUNK) { SC_WRITE(pa, (cnk + 2) & 1, cnk + 2); if (cnk + 4 < NCHUNK) SC_LOAD(pa, cnk + 4); }
            __syncthreads();
        }
#undef SC_LOAD
#undef SC_WRITE
    } else if (compute) {
        const int row = MODE == 0 ? (unit & 3) * 16 + F.wave * 4 + (lane >> 4) : F.wave * 16 + (lane >> 2);
        const int kq = MODE == 0 ? (lane & 15) : (lane & 3), koff = kq * KPL;
        f32x4 S[NQ];
        if (MODE == 0) {
            const float* s0 = p.in(7) + (size_t)(((cb * 2 + cd) * 8 + chh) * 64 + row) * 64 + koff;
#pragma unroll
            for (int q = 0; q < NQ; ++q) S[q] = *(const f32x4*)(s0 + q * 4);
        } else {
#pragma unroll
            for (int q = 0; q < NQ; ++q) S[q] = (f32x4){0.f, 0.f, 0.f, 0.f};
        }
        __syncthreads();
        float* yp = YY + (size_t)cd * NTOK * 512 + chh * 64 + row;
        for (int cnk = 0; cnk < NCHUNK; ++cnk) {
            const LAS float* bufp = sb + (cnk & 1) * BUF;
            ScanVecs<KPL> cur, nxt;
            scan_load<KPL>(cur, bufp, koff, row);
#pragma unroll 2
            for (int stp = 0; stp < T; ++stp) {
                scan_load<KPL>(nxt, bufp + (stp + 1 < T ? stp + 1 : stp) * SREC, koff, row);
                const int j_ = cnk * T + stp; const int tok = cbase + (cd ? NSTEPS - 1 - j_ : j_);
                f32x4 a4 = S[0] * cur.kk[0], y4 = S[0] * cur.r[0];
#pragma unroll
                for (int q = 1; q < NQ; ++q) { a4 = a4 + S[q] * cur.kk[q]; y4 = y4 + S[q] * cur.r[q]; }
                float sa = (a4[0] + a4[1]) + (a4[2] + a4[3]), ys = (y4[0] + y4[1]) + (y4[2] + y4[3]);
                if (MODE == 0) {
                    sa += DPPF(sa, 0xB1); ys += DPPF(ys, 0xB1); sa += DPPF(sa, 0x4E); ys += DPPF(ys, 0x4E);
                    sa += DPPF(sa, 0x141); ys += DPPF(ys, 0x141); sa += DPPF(sa, 0x140); ys += DPPF(ys, 0x140);
                } else { sa += DPPF(sa, 0xB1); ys += DPPF(ys, 0xB1); sa += DPPF(sa, 0x4E); ys += DPPF(ys, 0x4E); }
                const float vr = cur.v;
#pragma unroll
                for (int q = 0; q < NQ; ++q) S[q] = S[q] * cur.w[q] + (vr * cur.kd[q] - sa * cur.kka[q]);
                if (kq == 0) yp[(size_t)tok * 512] = ys - sa * cur.c1 + vr * cur.c2;
                cur = nxt;
            }
            __syncthreads();
        }
        if (MODE == 1) {
            float* so = p.out() + OUT_SRWKV + (size_t)(((cb * 2 + cd) * 8 + chh) * 64 + row) * 64 + koff;
#pragma unroll
            for (int q = 0; q < NQ; ++q) *(f32x4*)(so + q * 4) = S[q];
        }
    } else {
        __syncthreads();
        for (int cnk = 0; cnk < NCHUNK; ++cnk) __syncthreads();
    }
}
constexpr int CI_AP = 0, CI_RH = 2304, CI_BT = 4608, CI_KT = 7168, CI_MP = 9728, CI_PP = 10368, CI_GL = 11520, CI_VT = 11776, CI_SZ = 14336;
constexpr int CS_AH = 0, CS_BH = 2304, CS_KH = 4608, CS_SZ = 6912;
constexpr int CS_NM = CS_BH, CS_TM = CS_BH + 1024, CS_MM = CS_BH + 2048;
constexpr int CIMG0 = 0, CSCR0 = 8 * CI_SZ;
static_assert(CSCR0 + 4 * CS_SZ <= LDS_BYTES - LDS_WORK, "chunked scan LDS");
constexpr size_t WS_GIMG2 = WS_WUP;
constexpr size_t WS_GIMG = WS_HB;
static_assert((size_t)32 * 12 * 4 * CI_SZ <= (size_t)2 * NTOK * 1024 * 2, "hand-off images do not fit HB + OB");
constexpr int SCAN_FLAG_WORD = 3584;
template <int MODE, int ROLE>
__device__ __forceinline__ void scanc_unit(const Frame& F, const PRef& p, int cid, int hid = 0, const bool first = true, const bool last = true) {
    constexpr int NSTEPS = MODE == 0 ? 1024 : 256, NCH = NSTEPS / 16, NG = NCH / 4;
    unsigned char* ws = p.ws();
    const float* RR = (const float*)(ws + WS_RR); const float* KR = (const float*)(ws + WS_KR); const float* VV = (const float*)(ws + WS_VV); const float* KK = (const float*)(ws + WS_KK);
    const float* DEC = (const float*)(ws + WS_DEC); const float* AA = (const float*)(ws + WS_AA);
    float* YY = (float*)(ws + WS_YY);
    LAS unsigned char* L = F.lds;
    const int lane = F.lane, fr = lane & 15, g = lane >> 4, w = F.wave;
    const int cb = cid >> 4, chh = (cid >> 1) & 7, cd = cid & 1;
    const int cbase = MODE == 0 ? NCTX + cb * 1024 : cb * 256;
#define TOK_OF(step) (cbase + (cd ? NSTEPS - 1 - (step) : (step)))
    unsigned* hflag = (unsigned*)(ws + WS_BAR) + SCAN_FLAG_WORD + cid * 16;
    unsigned char* gimg = ws + WS_GIMG + (size_t)cid * 12 * 4 * CI_SZ;
    unsigned char* gimg2 = ws + WS_GIMG2 + (size_t)cid * 4 * 4 * CI_SZ;
    const __amdgpu_buffer_rsrc_t grs = wt_rsrc(gimg, (size_t)12 * 4 * CI_SZ), grs2 = wt_rsrc(gimg2, (size_t)4 * 4 * CI_SZ);
    if (w >= 4 || ROLE == 2) {
        if (ROLE == 2 && w < 4) {
            for (int grp = hid; grp < NG; grp += 3) {
                __syncthreads();
                for (int i = F.tid; i < 4 * CI_SZ / 16; i += NTHREADS) wt_store16(grp < 12 ? grs : grs2, (size_t)(grp < 12 ? grp : grp - 12) * 4 * CI_SZ + (size_t)i * 16, *(const LAS u32x4*)(L + CIMG0 + (size_t)i * 16));
                asm volatile("s_waitcnt vmcnt(0)" ::: "memory");
                __syncthreads();
                if (F.tid == 0) __hip_atomic_store(hflag + grp, 1u, __ATOMIC_RELAXED, __HIP_MEMORY_SCOPE_AGENT);
                __syncthreads();
            }
            return;
        }
        const int j = w - 4, k = lane;
        if constexpr (ROLE == 1) {
            u32x4 pf[CI_SZ / 16 / 64];
            unsigned known = 0u;
#define RUN_FETCH(grp_) do { const int g_ = (grp_); \
                if (!((known >> g_) & 1u)) { unsigned sp = 0; for (;;) { const unsigned fl = lane < 16 ? __hip_atomic_load(hflag + lane, __ATOMIC_RELAXED, __HIP_MEMORY_SCOPE_AGENT) : 0u; \
                    known = (unsigned)__builtin_amdgcn_ballot_w64(fl != 0u) & 0xffffu; if (((known >> g_) & 1u) || ++sp > (1u << 22)) break; __builtin_amdgcn_s_sleep(2); } } \
                asm volatile("" ::: "memory"); \
                _Pragma("unroll") for (int i = 0; i < CI_SZ / 16 / 64; ++i)        \
                    pf[i] = __builtin_bit_cast(u32x4, __builtin_amdgcn_raw_buffer_load_b128(g_ < 12 ? grs : grs2, (int)(((size_t)(g_ < 12 ? g_ : g_ - 12) * 4 + j) * CI_SZ + (size_t)(i * 64 + lane) * 16), 0, 16)); } while (0)
            RUN_FETCH(0);
            for (int grp = 0; grp < NG; ++grp) {
                LAS unsigned char* IM = L + CIMG0 + ((grp & 1) * 4 + j) * CI_SZ;
#pragma unroll
                for (int i = 0; i < CI_SZ / 16 / 64; ++i) *(LAS u32x4*)(IM + (size_t)(i * 64 + lane) * 16) = pf[i];
                if (grp + 1 < NG) RUN_FETCH(grp + 1);
                __syncthreads();
            }
            __syncthreads();
#undef RUN_FETCH
            return;
        }
        LAS unsigned char* SC = L + CSCR0 + j * CS_SZ;
        const float ka = p.in(40)[chh * 64 + k];
        const size_t colo = (size_t)chh * 64 + k;
        const float* decp = DEC + (size_t)cd * NTOK * 512; const float* aap = AA + (size_t)cd * NTOK * 512;
        float rw[16], rkk[16], ra[16], rkr[16], rr[16], rv[16];
        const size_t arrb = (size_t)NTOK * 512 * 4;
        const __amdgpu_buffer_rsrc_t rsW = wt_rsrc((void*)decp, arrb), rsKK = wt_rsrc((void*)KK, arrb), rsA = wt_rsrc((void*)aap, arrb), rsKR = wt_rsrc((void*)KR, arrb), rsR = wt_rsrc((void*)RR, arrb), rsV = wt_rsrc((void*)VV, arrb);
#define PREP_VOFF(chunk) ((unsigned)(((size_t)(cbase + (cd ? NSTEPS - 16 - (chunk) * 16 : (chunk) * 16)) * 512 + colo) * 4))
#define PREP_LOAD_T(chunk, t) do { const unsigned vo_ = PREP_VOFF(chunk); const int so_ = (cd ? 15 - (t) : (t)) * 2048; \
            rw[t] = __builtin_bit_cast(float, __builtin_amdgcn_raw_buffer_load_b32(rsW, vo_, so_, 0)); rkk[t] = __builtin_bit_cast(float, __builtin_amdgcn_raw_buffer_load_b32(rsKK, vo_, so_, 0)); \
            ra[t] = __builtin_bit_cast(float, __builtin_amdgcn_raw_buffer_load_b32(rsA, vo_, so_, 0)); rkr[t] = __builtin_bit_cast(float, __builtin_amdgcn_raw_buffer_load_b32(rsKR, vo_, so_, 0)); \
            rr[t] = __builtin_bit_cast(float, __builtin_amdgcn_raw_buffer_load_b32(rsR, vo_, so_, 0)); rv[t] = __builtin_bit_cast(float, __builtin_amdgcn_raw_buffer_load_b32(rsV, vo_, so_, 0)); \
            asm volatile("" ::: "memory");   } while (0)
#define PREP_LOAD(chunk) do { _Pragma("unroll") for (int t = 0; t < 16; ++t) PREP_LOAD_T(chunk, t); } while (0)
        PREP_LOAD(ROLE == 2 ? hid * 4 + j : j);
        __builtin_amdgcn_s_setprio(2);
        for (int grp = (ROLE == 2 ? hid : 0); grp < NG; grp += (ROLE == 2 ? 3 : 1)) {
            LAS unsigned char* IM = L + CIMG0 + ((ROLE == 2 ? 0 : (grp & 1) * 4) + j) * CI_SZ;
            float ah[16]; float G = 1.0f;
            const int ng_ = grp + (ROLE == 0 ? 1 : 3), nchunk_ = (ng_ < NG ? ng_ : grp) * 4 + j;
#pragma unroll
            for (int t2 = 0; t2 < 8; ++t2) {
                float bh2[2], kh2[2];
#pragma unroll
                for (int u = 0; u < 2; ++u) {
                    const int t = 2 * t2 + u;
                    const float bb = rkk[t] * ra[t], kd = rkr[t] * (1.0f + (ra[t] - 1.0f) * ka);
                    ah[t] = -rkk[t] * G;
                    G *= rw[t];
                    const float inv = __builtin_amdgcn_rcpf(G);
                    const float bh = bb * inv, kh = kd * inv, rh = rr[t] * G;
                    bh2[u] = bh; kh2[u] = kh;
                    *(LAS bf16_t*)(SC + CS_AH + t * 144 + k * 2) = f2bf(ah[t]);
                    *(LAS bf16_t*)(SC + CS_BH + t * 144 + k * 2) = f2bf(bh);
                    *(LAS bf16_t*)(SC + CS_KH + t * 144 + k * 2) = f2bf(kh);
                    *(LAS bf16_t*)(IM + CI_RH + t * 144 + k * 2) = f2bf(rh);
                }
                *(LAS unsigned*)(IM + CI_BT + k * 40 + t2 * 4) = pack2(bh2[0], bh2[1]);
                *(LAS unsigned*)(IM + CI_KT + k * 40 + t2 * 4) = pack2(kh2[0], kh2[1]);
                *(LAS unsigned*)(IM + CI_VT + k * 40 + t2 * 4) = pack2(rv[2 * t2], rv[2 * t2 + 1]);
                PREP_LOAD_T(nchunk_, 2 * t2); PREP_LOAD_T(nchunk_, 2 * t2 + 1);
            }
            *(LAS float*)(IM + CI_GL + k * 4) = G;
            f32x4 dN = (f32x4){0.f, 0.f, 0.f, 0.f}, dM = dN, dPb = dN, dPk = dN;
#pragma unroll
            for (int s = 0; s < 2; ++s) {
                const int fo = fr * 144 + (4 * s + g) * 16;
                const bf16x8 fa = *(const LAS bf16x8*)(SC + CS_AH + fo), fb = *(const LAS bf16x8*)(SC + CS_BH + fo), fk = *(const LAS bf16x8*)(SC + CS_KH + fo), frh = *(const LAS bf16x8*)(IM + CI_RH + fo);
                dN = __builtin_amdgcn_mfma_f32_16x16x32_bf16(fa, fb, dN, 0, 0, 0); dM = __builtin_amdgcn_mfma_f32_16x16x32_bf16(fa, fk, dM, 0, 0, 0);
                dPb = __builtin_amdgcn_mfma_f32_16x16x32_bf16(frh, fb, dPb, 0, 0, 0); dPk = __builtin_amdgcn_mfma_f32_16x16x32_bf16(frh, fk, dPk, 0, 0, 0);
            }
#pragma unroll
            for (int r = 0; r < 4; ++r) {
                const int t = 4 * g + r;
                *(LAS bf16_t*)(IM + CI_PP + t * 72 + fr * 2) = f2bf(fr <= t ? dPb[r] : 0.f);
                *(LAS bf16_t*)(IM + CI_PP + t * 72 + (16 + fr) * 2) = f2bf(fr <= t ? dPk[r] : 0.f);
            }
            bf16x4 Ta;
            {
                const f32x4 z4 = (f32x4){0.f, 0.f, 0.f, 0.f};
                const bf16x4 idm = (bf16x4){(short)(fr == 4 * g + 0 ? 0x3F80 : 0), (short)(fr == 4 * g + 1 ? 0x3F80 : 0), (short)(fr == 4 * g + 2 ? 0x3F80 : 0), (short)(fr == 4 * g + 3 ? 0x3F80 : 0)};
                const bf16x4 dmk = (bf16x4){(short)(fr == 4 * g + 0 ? -1 : 0), (short)(fr == 4 * g + 1 ? -1 : 0), (short)(fr == 4 * g + 2 ? -1 : 0), (short)(fr == 4 * g + 3 ? -1 : 0)};
#define WITHI(x) ((bf16x4)(((x) & ~dmk) | idm))
#define PK4(v) ({ u32x2 q_; q_.x = pack2((v)[0], (v)[1]); q_.y = pack2((v)[2], (v)[3]); __builtin_bit_cast(bf16x4, q_); })
#define TRANSP(dst, src, off) do { const bf16x4 s_ = (src); _Pragma("unroll") for (int j = 0; j < 4; ++j) *(LAS bf16_t*)(SC + (off) + (4 * g + j) * 32 + fr * 2) = (bf16_t)s_[j]; \
                dst = *(const LAS bf16x4*)(SC + (off) + fr * 32 + 8 * g); } while (0)
                f32x4 nm;
#pragma unroll
                for (int r = 0; r < 4; ++r) nm[r] = fr < 4 * g + r ? dN[r] : 0.f;
                const bf16x4 nB = PK4(nm); bf16x4 nA; TRANSP(nA, nB, CS_NM);
                const f32x4 d1 = __builtin_amdgcn_mfma_f32_16x16x16bf16_1k(nA, nB, z4, 0, 0, 0);
                const bf16x4 p1B = PK4(d1); bf16x4 p1A; TRANSP(p1A, p1B, CS_NM + 512);
                const f32x4 d2 = __builtin_amdgcn_mfma_f32_16x16x16bf16_1k(p1A, p1B, z4, 0, 0, 0);
                const bf16x4 p2B = PK4(d2); bf16x4 p2A; TRANSP(p2A, p2B, CS_MM);
                f32x4 d3 = __builtin_amdgcn_mfma_f32_16x16x16bf16_1k(p2A, p2B, z4, 0, 0, 0);
#pragma unroll
                for (int j = 0; j < 4; ++j) d3[j] += (fr == 4 * g + j) ? 1.0f : 0.f;
                const f32x4 r2 = __builtin_amdgcn_mfma_f32_16x16x16bf16_1k(WITHI(p2A), PK4(d3), z4, 0, 0, 0);
                const f32x4 r1 = __builtin_amdgcn_mfma_f32_16x16x16bf16_1k(WITHI(p1A), PK4(r2), z4, 0, 0, 0);
                const f32x4 tt = __builtin_amdgcn_mfma_f32_16x16x16bf16_1k(WITHI(nA), PK4(r1), z4, 0, 0, 0);
                TRANSP(Ta, PK4(tt), CS_TM);
#undef TRANSP
#undef WITHI
#undef PK4
            }
            {
                u32x4 w0, w1;
                w0.x = pack2(ah[0], ah[1]); w0.y = pack2(ah[2], ah[3]); w0.z = pack2(ah[4], ah[5]); w0.w = pack2(ah[6], ah[7]);
                w1.x = pack2(ah[8], ah[9]); w1.y = pack2(ah[10], ah[11]); w1.z = pack2(ah[12], ah[13]); w1.w = pack2(ah[14], ah[15]);
                *(LAS u32x4*)(SC + CS_KH + k * 32) = w0; *(LAS u32x4*)(SC + CS_KH + k * 32 + 16) = w1;
                const f32x4 z4 = (f32x4){0.f, 0.f, 0.f, 0.f};
#pragma unroll
                for (int nb = 0; nb < 4; ++nb) {
                    const bf16x4 Bb = *(const LAS bf16x4*)(SC + CS_KH + (16 * nb + fr) * 32 + 8 * g);
                    const f32x4 d = __builtin_amdgcn_mfma_f32_16x16x16bf16_1k(Ta, Bb, z4, 0, 0, 0);
#pragma unroll
                    for (int j = 0; j < 4; ++j) *(LAS bf16_t*)(IM + CI_AP + (4 * g + j) * 144 + (16 * nb + fr) * 2) = f2bf(d[j]);
                }
                u32x2 mb; mb.x = pack2(fr < 4 * g + 0 ? dM[0] : 0.f, fr < 4 * g + 1 ? dM[1] : 0.f); mb.y = pack2(fr < 4 * g + 2 ? dM[2] : 0.f, fr < 4 * g + 3 ? dM[3] : 0.f);
                const f32x4 dm = __builtin_amdgcn_mfma_f32_16x16x16bf16_1k(Ta, __builtin_bit_cast(bf16x4, mb), z4, 0, 0, 0);
#pragma unroll
                for (int j = 0; j < 4; ++j) *(LAS bf16_t*)(IM + CI_MP + (4 * g + j) * 40 + fr * 2) = f2bf(dm[j]);
            }
            if (ROLE == 2) {
                __syncthreads();
                for (int i = F.tid; i < 4 * CI_SZ / 16; i += NTHREADS) wt_store16(grp < 12 ? grs : grs2, (size_t)(grp < 12 ? grp : grp - 12) * 4 * CI_SZ + (size_t)i * 16, *(const LAS u32x4*)(L + CIMG0 + (size_t)i * 16));
                asm volatile("s_waitcnt vmcnt(0)" ::: "memory");
                __syncthreads();
                __syncthreads();
                continue;
            }
            __syncthreads();
        }
        __builtin_amdgcn_s_setprio(0);
        if (ROLE == 2) return;
        if (last) __syncthreads();
#undef PREP_LOAD
#undef PREP_LOAD_T
#undef PREP_VOFF
    } else {
        f32x4 S[4];
        if (MODE == 0) {
            const float* s0 = p.in(7) + (size_t)(((cb * 2 + cd) * 8 + chh) * 64 + 16 * w + fr) * 64;
#pragma unroll
            for (int kt = 0; kt < 4; ++kt) S[kt] = *(const f32x4*)(s0 + 16 * kt + 4 * g);
        } else {
#pragma unroll
            for (int kt = 0; kt < 4; ++kt) S[kt] = (f32x4){0.f, 0.f, 0.f, 0.f};
        }
        const __amdgpu_buffer_rsrc_t rsY = wt_rsrc((void*)(YY + (size_t)cd * NTOK * 512), (size_t)NTOK * 512 * 4);
        const unsigned yvo = (unsigned)(((size_t)(cbase + (cd ? 12 - 4 * g : 4 * g)) * 512 + chh * 64 + 16 * w + fr) * 4);
        if (first) __syncthreads();
        if (ROLE == 1) __builtin_amdgcn_s_setprio(2);
        for (int grp = 0; grp < NG; ++grp) {
#pragma unroll 2
            for (int c4 = 0; c4 < 4; ++c4) {
                const LAS unsigned char* IM = L + CIMG0 + ((grp & 1) * 4 + c4) * CI_SZ;
                u32x2 oa[2][2], orh[2][2], obt[4], okt[4]; f32x4 ogl[4];
#pragma unroll
                for (int s = 0; s < 2; ++s) {
                    oa[s][0] = *(const LAS u32x2*)(IM + CI_AP + fr * 144 + (32 * s + 4 * g) * 2); oa[s][1] = *(const LAS u32x2*)(IM + CI_AP + fr * 144 + (32 * s + 16 + 4 * g) * 2);
                    orh[s][0] = *(const LAS u32x2*)(IM + CI_RH + fr * 144 + (32 * s + 4 * g) * 2); orh[s][1] = *(const LAS u32x2*)(IM + CI_RH + fr * 144 + (32 * s + 16 + 4 * g) * 2);
                }
                const u32x2 vq = *(const LAS u32x2*)(IM + CI_VT + (16 * w + fr) * 40 + g * 8);
                const u32x2 m0 = *(const LAS u32x2*)(IM + CI_MP + fr * 40 + g * 8);
                const u32x2 p0 = *(const LAS u32x2*)(IM + CI_PP + fr * 72 + g * 8), p1 = *(const LAS u32x2*)(IM + CI_PP + fr * 72 + 32 + g * 8);
#pragma unroll
                for (int kt = 0; kt < 4; ++kt) {
                    obt[kt] = *(const LAS u32x2*)(IM + CI_BT + (16 * kt + fr) * 40 + g * 8); okt[kt] = *(const LAS u32x2*)(IM + CI_KT + (16 * kt + fr) * 40 + g * 8);
                    ogl[kt] = *(const LAS f32x4*)(IM + CI_GL + (16 * kt + 4 * g) * 4);
                }
                bf16x8 Sp[2];
#pragma unroll
                for (int s = 0; s < 2; ++s) { u32x4 pk; pk.x = pack2(S[2 * s][0], S[2 * s][1]); pk.y = pack2(S[2 * s][2], S[2 * s][3]); pk.z = pack2(S[2 * s + 1][0], S[2 * s + 1][1]); pk.w = pack2(S[2 * s + 1][2], S[2 * s + 1][3]); Sp[s] = __builtin_bit_cast(bf16x8, pk); }
                f32x4 U = (f32x4){0.f, 0.f, 0.f, 0.f}, Y = U;
#pragma unroll
                for (int s = 0; s < 2; ++s) {
                    U = __builtin_amdgcn_mfma_f32_16x16x32_bf16(__builtin_bit_cast(bf16x8, (u32x4){oa[s][0].x, oa[s][0].y, oa[s][1].x, oa[s][1].y}), Sp[s], U, 0, 0, 0);
                    Y = __builtin_amdgcn_mfma_f32_16x16x32_bf16(__builtin_bit_cast(bf16x8, (u32x4){orh[s][0].x, orh[s][0].y, orh[s][1].x, orh[s][1].y}), Sp[s], Y, 0, 0, 0);
                }
                U = __builtin_amdgcn_mfma_f32_16x16x32_bf16(__builtin_bit_cast(bf16x8, (u32x4){m0.x, m0.y, 0u, 0u}), __builtin_bit_cast(bf16x8, (u32x4){vq.x, vq.y, vq.x, vq.y}), U, 0, 0, 0);
                u32x4 uvk; uvk.x = pack2(U[0], U[1]); uvk.y = pack2(U[2], U[3]); uvk.z = vq.x; uvk.w = vq.y;
                const bf16x8 UV = __builtin_bit_cast(bf16x8, uvk);
#pragma unroll
                for (int kt = 0; kt < 4; ++kt) {
                    const f32x4 acc = __builtin_amdgcn_mfma_f32_16x16x32_bf16(__builtin_bit_cast(bf16x8, (u32x4){obt[kt].x, obt[kt].y, okt[kt].x, okt[kt].y}), UV, S[kt], 0, 0, 0);
                    S[kt] = acc * ogl[kt];
                }
                Y = __builtin_amdgcn_mfma_f32_16x16x32_bf16(__builtin_bit_cast(bf16x8, (u32x4){p0.x, p0.y, p1.x, p1.y}), UV, Y, 0, 0, 0);
                const int ysb = cd ? NSTEPS - 16 - (grp * 4 + c4) * 16 : (grp * 4 + c4) * 16;
#pragma unroll
                for (int r = 0; r < 4; ++r) __builtin_amdgcn_raw_buffer_store_b32(__float_as_uint(Y[r]), rsY, yvo, (ysb + (cd ? 3 - r : r)) * 2048, 0);
            }
            __syncthreads();
        }
        if (ROLE == 1) __builtin_amdgcn_s_setprio(0);
        if (MODE == 1) {
            float* so = p.out() + OUT_SRWKV + (size_t)(((cb * 2 + cd) * 8 + chh) * 64 + 16 * w + fr) * 64;
#pragma unroll
            for (int kt = 0; kt < 4; ++kt) *(f32x4*)(so + 16 * kt + 4 * g) = S[kt];
        }
    }
#undef TOK_OF
}
__device__ __forceinline__ void phase_l1_scanc(const Frame& F, const PRef& p) {
    if (F.G > 128) {
        if (F.bid < 32) scanc_unit<0, 1>(F, p, F.bid);
        else if (F.bid < 128) {
            scanc_unit<0, 2>(F, p, (F.bid - 32) & 31, (F.bid - 32) >> 5);
            if (F.G == 256) {
                unsigned char* ws = p.ws();
                __syncthreads();
                GemmDesc g{(const bf16_t*)(ws + WS_SG), (const bf16_t*)(ws + WS_WGUP), 128, 128, NTOK, 512, 128}; EpiF32 E{(float*)(ws + WS_GG), 512, 512}; gemm_s(F, g, E, 0, F.bid - 32, 96, 192);
            }
        }
        else for (int u = F.bid - 128; u < 256; u += F.G - 128) scanc_unit<1, 0>(F, p, u, 0, u == F.bid - 128, u + (F.G - 128) >= 256);
    } else { FOR_UNITS(u, 288, 0) { if (u < 32) scanc_unit<0, 0>(F, p, u); else scanc_unit<1, 0>(F, p, u - 32); } }
}
__device__ __forceinline__ void phase_l1_scan(const Frame& F, const PRef& p) {
    const int half = F.G / 2;
    if (F.bid < half) {
        for (int u = F.bid; u < 128; u += half) { const int xcd = u & 7, idx = u >> 3; scan_unit<0>(F, p, (((idx >> 2) * 8 + xcd) << 2) | (idx & 3)); }
    } else {
        for (int u = F.bid - half; u < 256; u += F.G - half) scan_unit<1>(F, p, u);
    }
}

__device__ __forceinline__ void phase_l1_comb(const Frame& F, const PRef& p) {
    unsigned char* ws = p.ws();
    const float* RR = (const float*)(ws + WS_RR); const float* KR = (const float*)(ws + WS_KR); const float* VV = (const float*)(ws + WS_VV);
    const float* AA = (const float*)(ws + WS_AA); const float* GG = (const float*)(ws + WS_GG); const float* YY = (const float*)(ws + WS_YY);
    bf16_t* OB = (bf16_t*)(ws + WS_OB);
    const int nw = F.G * 8, lane = F.lane;
    const bf16_t* DO = (const bf16_t*)(ws + WS_DO);
    const float lam_init = 0.8f - 0.6f * 0.74081822068171788f;
    const float lam = __expf(wave_sum(p.in(31)[lane] * p.in(31)[64 + lane])) - __expf(wave_sum(p.in(31)[128 + lane] * p.in(31)[192 + lane])) + lam_init;
    for (int row = F.bid * 8 + F.wave; row < NTOK; row += nw) {
        unsigned da[4], db[4];
#pragma unroll
        for (int h = 0; h < 4; ++h) { da[h] = *(const unsigned*)(DO + (size_t)row * 1024 + (2 * h) * 128 + 2 * lane); db[h] = *(const unsigned*)(DO + (size_t)row * 1024 + (2 * h + 1) * 128 + 2 * lane); }
        const size_t o = (size_t)row * 512 + lane * 8;
        const f32x4 yf0 = *(const f32x4*)(YY + o), yf1 = *(const f32x4*)(YY + o + 4), yb0 = *(const f32x4*)(YY + (size_t)NTOK * 512 + o), yb1 = *(const f32x4*)(YY + (size_t)NTOK * 512 + o + 4);
        const f32x4 v0 = *(const f32x4*)(VV + o), v1 = *(const f32x4*)(VV + o + 4), g0 = *(const f32x4*)(GG + o), g1 = *(const f32x4*)(GG + o + 4);
        const f32x4 n0 = *(const f32x4*)(p.in(42) + lane * 8), n1 = *(const f32x4*)(p.in(42) + lane * 8 + 4);
        const f32x4 r0 = *(const f32x4*)(RR + o), r1 = *(const f32x4*)(RR + o + 4), k0 = *(const f32x4*)(KR + o), k1 = *(const f32x4*)(KR + o + 4);
        const f32x4 af0 = *(const f32x4*)(AA + o), af1 = *(const f32x4*)(AA + o + 4), ab0 = *(const f32x4*)(AA + (size_t)NTOK * 512 + o), ab1 = *(const f32x4*)(AA + (size_t)NTOK * 512 + o + 4);
        const f32x4 ka0 = *(const f32x4*)(p.in(40) + lane * 8), ka1 = *(const f32x4*)(p.in(40) + lane * 8 + 4), rk0 = *(const f32x4*)(p.in(41) + lane * 8), rk1 = *(const f32x4*)(p.in(41) + lane * 8 + 4);
        f32x2 gn[4];
#pragma unroll
        for (int h = 0; h < 4; ++h) gn[h] = *(const f32x2*)(p.in(32) + h * 128 + 2 * lane);
        asm volatile("" ::: "memory");
#pragma unroll
        for (int h = 0; h < 4; ++h) {
            const unsigned a = da[h], b = db[h];
            const float d0 = bf2f(a & 0xffffu) - lam * bf2f(b & 0xffffu), d1 = bf2f(a >> 16) - lam * bf2f(b >> 16);
            const float rstd = rsqrtf(wave_sum(d0 * d0 + d1 * d1) * (1.0f / 128.0f) + EPS) * (1.0f - lam_init);
            *(unsigned*)(OB + (size_t)row * 1024 + h * 128 + 2 * lane) = pack2(d0 * rstd * gn[h][0], d1 * rstd * gn[h][1]);
        }
        float bs;
        {
            const f32x4 t0 = r0 * rk0 * k0 * (2.0f + (af0 + ab0 - 2.0f) * ka0), t1 = r1 * rk1 * k1 * (2.0f + (af1 + ab1 - 2.0f) * ka1);
            bs = oct_sum((t0[0] + t0[1]) + (t0[2] + t0[3]) + (t1[0] + t1[1]) + (t1[2] + t1[3]));
        }
        const f32x4 y0 = yf0 + yb0, y1 = yf1 + yb1;
        float ss = (y0[0] * y0[0] + y0[1] * y0[1]) + (y0[2] * y0[2] + y0[3] * y0[3]) + (y1[0] * y1[0] + y1[1] * y1[1]) + (y1[2] * y1[2] + y1[3] * y1[3]);
        ss = oct_sum(ss);
        const float rstd = rsqrtf(ss * (1.0f / 64.0f) + EPS);
        const f32x4 o0 = (y0 * rstd * n0 + bs * v0) * g0, o1 = (y1 * rstd * n1 + bs * v1) * g1;
        u32x4 w; w.x = pack2(o0[0], o0[1]); w.y = pack2(o0[2], o0[3]); w.z = pack2(o1[0], o1[1]); w.w = pack2(o1[2], o1[3]);
        *(u32x4*)(OB + (size_t)row * 1024 + 512 + lane * 8) = w;
    }
}

constexpr int NPHASE = 26;
#ifndef PH_ONLY
#define PH_ONLY -1
#endif
#if ONE_LAUNCH
#define SEAM() xcd_barrier(bar)
#else
#define SEAM() do {} while (0)
#endif
#define IN(k) (lo <= (k) && (k) < hi && (PH_ONLY < 0 || (k) == PH_ONLY))
#define END(k) do { if (IN((k) + 1)) SEAM(); } while (0)
#ifndef REP_MASK
#define REP_MASK 0u
#endif
#define REPS(k) for (int rep_ = 0; rep_ < 1 + (int)(((unsigned)REP_MASK >> (k)) & 1u); ++rep_, __syncthreads())

constexpr size_t WS_PARTA = WS_BIG;
constexpr size_t WS_PARTD = WS_U;
static_assert(WS_PARTD + (size_t)2 * NTOK * 1024 * 4 <= WS_ACT, "down-projection slabs overlap ACT");
template <int l>
__device__ __forceinline__ void layer_phases(const Frame& F, const PRef& p, const int lo, const int hi, const XcdBarrier bar) {
    constexpr int pb = 1 + l * 12;
    if (IN(pb + 0)) { REPS(pb + 0) {
        unsigned char* ws = p.ws(); const float* ml = (const float*)(ws + WS_MOD) + (size_t)l * 3 * 6144;
        if (l == 0) phase_norm(F, p.in(0), p.in(1), nullptr, nullptr, nullptr, p.in(12), ml + 1024, ml + 0, (bf16_t*)(ws + WS_HB), true);
        else { float* xbuf = p.out(); phase_norm(F, xbuf, xbuf + (size_t)NCTX * 1024, (const bf16_t*)(ws + WS_PARTD), (const float*)(ws + WS_MOD) + 5120, xbuf, p.in(12) + 1024, ml + 1024, ml + 0, (bf16_t*)(ws + WS_HB), true); }
        } END(pb + 0); }
    if (IN(pb + 1)) { REPS(pb + 1) {
        unsigned char* ws = p.ws();
        if (l == 0) { BigDesc g{(const bf16_t*)(ws + WS_HB), (const bf16_t*)(ws + WS_WAIN), 1024, 1024, 24, 8, 1, 1024}; EpiF32WT E{wt_rsrc(ws + WS_P0, (size_t)NTOK * 2048 * 4), 2048}; gemm_big<false>(F, g, E); if (F.G == 256) cvt_group(F, p, 1, 192, 64, 0); else cvt_group(F, p, 1, 0, F.G, 0); }
        else {
            BigDesc g{(const bf16_t*)(ws + WS_HB), (const bf16_t*)(ws + WS_WBIN), 1024, 1024, 24, 14, 1, 1024}; EpiF32WT E{wt_rsrc(ws + WS_P1, (size_t)NTOK * 3584 * 4), 3584}; gemm_big<false, EpiF32WT, true>(F, g, E);
        }
        } END(pb + 1);
    }
    if (IN(pb + 2)) { REPS(pb + 2) { if (l == 0) phase_l0_tok(F, p); else phase_l1_tok(F, p); } END(pb + 2); }
    if (IN(pb + 3)) { REPS(pb + 3) {
        unsigned char* ws = p.ws();
        if (l == 0) {
            { GemmDesc g{(const bf16_t*)(ws + WS_CQN), (const bf16_t*)(ws + WS_WUQ), 256, 256, NTOK, 768, 256}; EpiF32 E{(float*)(ws + WS_QRAW), 768, 768}; gemm_s(F, g, E, 0); }
            { GemmDesc g{(const bf16_t*)(ws + WS_CKVN), (const bf16_t*)(ws + WS_WUKV), 128, 128, NKROW, 1024, 128}; EpiF32 E{(float*)(ws + WS_KVRAW), 1024, 1024}; gemm_s(F, g, E, 48 * 6); }
            phase_l0_prefix(F, p, 48 * 6 + 56 * 8);
        } else {
            const bf16_t* TW = (const bf16_t*)(ws + WS_TW); const bf16_t* AD = (const bf16_t*)(ws + WS_AD); const bf16_t* SG = (const bf16_t*)(ws + WS_SG);
            float* DEC = (float*)(ws + WS_DEC); float* AA = (float*)(ws + WS_AA);
            { GemmDesc g{TW, (const bf16_t*)(ws + WS_WWUP), 128, 64, NTOK, 512, 64}; EpiDecay E{DEC, p.in(34)}; gemm_s(F, g, E, 0); }
            { GemmDesc g{TW + 64, (const bf16_t*)(ws + WS_WWUP) + 512 * 64, 128, 64, NTOK, 512, 64}; EpiDecay E{DEC + (size_t)NTOK * 512, p.in(34) + 512}; gemm_s(F, g, E, 192); }
            { GemmDesc g{AD, (const bf16_t*)(ws + WS_WAUP), 128, 64, NTOK, 512, 64}; EpiSigm E{AA, p.in(36)}; gemm_s(F, g, E, 384); }
            { GemmDesc g{AD + 64, (const bf16_t*)(ws + WS_WAUP) + 512 * 64, 128, 64, NTOK, 512, 64}; EpiSigm E{AA + (size_t)NTOK * 512, p.in(36) + 512}; gemm_s(F, g, E, 576); }
            if (F.G != 256) { GemmDesc g{SG, (const bf16_t*)(ws + WS_WGUP), 128, 128, NTOK, 512, 128}; EpiF32 E{(float*)(ws + WS_GG), 512, 512}; gemm_s(F, g, E, 768); }
            phase_l1_mix(F, p);
        }
        } END(pb + 3);
    }
    if (l == 0 && IN(pb + 4)) { REPS(pb + 4) { phase_l0_qkv(F, p); } END(pb + 4); }
    if (IN(pb + 5)) { REPS(pb + 5) { if (l == 0) phase_l0_mix(F, p); else {
#if CHUNKED_SCAN
            phase_l1_scanc(F, p);
#else
            phase_l1_scan(F, p);
#endif
        } } END(pb + 5); }
    if (l == 1 && IN(pb + 6)) { REPS(pb + 6) { phase_l1_comb(F, p); } END(pb + 6); }
    if (IN(pb + 7)) { REPS(pb + 7) {
        unsigned char* ws = p.ws();
        BigDesc g{(const bf16_t*)(ws + WS_OB), (const bf16_t*)(ws + WS_WOUT) + (size_t)l * 1024 * 1024, 1024, 1024, 24, 4, 2, 512};
        EpiPartWT E{wt_rsrc(ws + WS_PARTA, (size_t)2 * NTOK * 1024 * 2), (size_t)NTOK * 1024}; gemm_big<true>(F, g, E);
        if (l == 0) { if (F.G == 256) cvt_group(F, p, 3, 192, 64, 0); else cvt_group(F, p, 3, 0, F.G, 0); }
        } END(pb + 7);
    }
    if (IN(pb + 8)) { REPS(pb + 8) {
        unsigned char* ws = p.ws(); const float* ml = (const float*)(ws + WS_MOD) + (size_t)l * 3 * 6144; float* xbuf = p.out();
        const float* xa = l == 0 ? p.in(0) : xbuf; const float* xb = l == 0 ? p.in(1) : xbuf + (size_t)NCTX * 1024;
        phase_norm(F, xa, xb, (const bf16_t*)(ws + WS_PARTA), ml + 2048, xbuf, p.in(13) + l * 1024, ml + 4096, ml + 3072, (bf16_t*)(ws + WS_HB), true); } END(pb + 8); }
    if (IN(pb + 9)) { REPS(pb + 9) {
        unsigned char* ws = p.ws();
        const bf16_t* wup = (const bf16_t*)(ws + WS_WUP) + (size_t)l * 5632 * 1024;
        gemm_upgate(F, (const bf16_t*)(ws + WS_HB), wup, p.in(16) + (size_t)l * 3 * 5632, p.in(17) + (size_t)l * 5632, (bf16_t*)(ws + WS_ACT), (l == 1 && F.G == 256) ? 1 : 0);
        if (l == 0 && F.G == 256) cvt_group(F, p, 4, 120, 136, 0);
        } END(pb + 9);
    }
    if (IN(pb + 11)) { REPS(pb + 11) {
        unsigned char* ws = p.ws();
        BigDesc g{(const bf16_t*)(ws + WS_ACT), (const bf16_t*)(ws + WS_WDN) + (size_t)l * 1024 * 2816, 2816, 2816, 24, 4, 2, 1408};
        if (l == 1 && F.G == 256) {
            unsigned* updone = (unsigned*)(ws + WS_BAR) + UPDONE_WORD;
            if (F.bid < 120) {
                const bf16_t* wup = (const bf16_t*)(ws + WS_WUP) + (size_t)l * 5632 * 1024;
                gemm_upgate(F, (const bf16_t*)(ws + WS_HB), wup, p.in(16) + (size_t)l * 3 * 5632, p.in(17) + (size_t)l * 5632, (bf16_t*)(ws + WS_ACT), 2);
                asm volatile("s_waitcnt vmcnt(0)" ::: "memory");
                __syncthreads();
                if (F.tid == 0) {
                    __builtin_amdgcn_fence(__ATOMIC_RELEASE, "agent");
                    (void)xb_add(updone, 1u);
                    if (F.bid >= 64 && F.bid < 112) { XB_SPIN(xb_ld(updone) < 120u, (unsigned*)(ws + WS_BAR)); __builtin_amdgcn_fence(__ATOMIC_ACQUIRE, "agent"); }
                }
                __syncthreads();
            }
            EpiPartWT E{wt_rsrc(ws + WS_PARTD, (size_t)4 * NTOK * 1024 * 2), (size_t)NTOK * 1024}; gemm_big<true, EpiPartWT, false, 1>(F, g, E);
        } else {
            EpiPartWT E{wt_rsrc(ws + WS_PARTD, (size_t)2 * NTOK * 1024 * 2), (size_t)NTOK * 1024}; gemm_big<true>(F, g, E);
            if (l == 0) { if (F.G == 256) cvt_group(F, p, 2, 192, 64, 0); else cvt_group(F, p, 2, 0, F.G, 0); }
        }
        } END(pb + 11);
    }
}

__global__ void __launch_bounds__(NTHREADS, 2) fwd_kernel(Params kp) {
    extern __shared__ __attribute__((aligned(16))) unsigned char lds_raw[];
    Frame F;
    F.lds = (LAS unsigned char*)lds_raw + LDS_WORK;
    F.tid = threadIdx.x; F.lane = F.tid & 63; F.wave = __builtin_amdgcn_readfirstlane(F.tid >> 6); F.G = gridDim.x; F.bid = blockIdx.x;
    {
        LAS unsigned* pw = (LAS unsigned*)((LAS unsigned char*)lds_raw + 64);
        if (F.tid < (int)(sizeof(Params) / 4)) pw[F.tid] = ((const unsigned*)&kp)[F.tid];
        if (F.tid < 4) ((LAS unsigned*)((LAS unsigned char*)lds_raw))[F.tid] = 0u;
    }
    __syncthreads();
    PRef p; p.w = (const LAS unsigned*)((LAS unsigned char*)lds_raw + 64);
    const int lo = kp.ph_lo, hi = kp.ph_hi;
    XcdBarrier bar; bar.bar = nullptr; bar.x = 0; bar.st = nullptr;
#if ONE_LAUNCH
    bar = xcd_barrier_post((unsigned*)(p.ws() + WS_BAR), (volatile LAS unsigned*)((LAS unsigned char*)lds_raw));
#endif
#ifdef EXTRA_BARS
    for (int i_ = 0; i_ < EXTRA_BARS; ++i_) SEAM();
#endif
    if (IN(0)) { REPS(0) { phase_prep(F, p); } END(0); }
    layer_phases<0>(F, p, lo, hi, bar);
    layer_phases<1>(F, p, lo, hi, bar);
    if (IN(25)) {
        unsigned char* ws = p.ws(); float* xbuf = p.out();
        phase_norm(F, xbuf, xbuf + (size_t)NCTX * 1024, (const bf16_t*)(ws + WS_PARTD), (const float*)(ws + WS_MOD) + 3 * 6144 + 5120, xbuf, nullptr, nullptr, nullptr, nullptr, false, F.G == 256 ? 17 * 256 : NTOK);
    }
}

extern "C" void kernel_launch(void* const* d_in, const int* in_sizes, int n_in, void* d_out, int out_size, void* d_ws, size_t ws_size, hipStream_t stream) {
    static int grid = 0;
    if (grid == 0) {
        if (n_in != 43 || (size_t)out_size != OUT_END || ws_size < WS_END) { fprintf(stderr, "kernel_launch: unexpected shapes: n_in %d out %d ws %zu (need %zu)\n", n_in, out_size, ws_size, (size_t)WS_END); grid = -1; return; }
        int dev = 0, cus = 0, per_cu = 0;
        if (hipGetDevice(&dev) != hipSuccess || hipDeviceGetAttribute(&cus, hipDeviceAttributeMultiprocessorCount, dev) != hipSuccess) { grid = -1; return; }
        if (hipFuncSetAttribute((const void*)fwd_kernel, hipFuncAttributeMaxDynamicSharedMemorySize, LDS_BYTES) != hipSuccess) { fprintf(stderr, "kernel_launch: hipFuncSetAttribute failed\n"); grid = -1; return; }
        if (hipOccupancyMaxActiveBlocksPerMultiprocessor(&per_cu, (const void*)fwd_kernel, NTHREADS, LDS_BYTES) != hipSuccess || per_cu < 1) { fprintf(stderr, "kernel_launch: occupancy query says %d blocks per CU\n", per_cu); grid = -1; (void)hipGetLastError(); return; }
        grid = cus;
    }
    if (grid < 0) return;
    Params p{};
    for (int i = 0; i < 43; ++i) p.in[i] = (const float*)d_in[i];
    p.out = (float*)d_out; p.ws = (unsigned char*)d_ws;
#if ONE_LAUNCH
    (void)hipMemsetAsync((char*)d_ws + WS_BAR, 0, 16384, stream);
    p.ph_lo = 0; p.ph_hi = NPHASE;
    void* args[] = {&p};
    hipError_t e = hipLaunchCooperativeKernel((const void*)fwd_kernel, dim3(grid), dim3(NTHREADS), args, LDS_BYTES, stream);
    if (e != hipSuccess) fprintf(stderr, "cooperative launch failed: %s (grid %d)\n", hipGetErrorString(e), grid);
#else
    for (int ph = 0; ph < NPHASE; ++ph) {
        p.ph_lo = ph; p.ph_hi = ph + 1;
        hipLaunchKernelGGL(fwd_kernel, dim3(grid), dim3(NTHREADS), LDS_BYTES, stream, p);
    }
#endif
}
```
